# Optimizing an MI355X kernel written in HIP

```python
import jax, jax.numpy as jnp
from jax import lax
import numpy as np

D_MODEL = 1024
BATCH = 4
SEQ = 4096
DEPTH = 1
DEC_BATCH = 128
DEC_SEQ = 8
PAST_LEN = 16384
PAGE_SIZE = 128

LRU_WIDTH = D_MODEL
LRU_BLOCKS = 16
LRU_BLOCK = LRU_WIDTH // LRU_BLOCKS
CONV_WIDTH = 4
LRU_C = 8.0
N_HEADS = 16
N_KV_HEADS = 4
HEAD_DIM = 64
GROUP = N_HEADS // N_KV_HEADS
Q_WIDTH = N_HEADS * HEAD_DIM
KV_WIDTH = N_KV_HEADS * HEAD_DIM
WINDOW = 128
ATTN_BLOCK = 128
PEER_HEADS = 8
N_KEYS = 128
N_EXPERTS = N_KEYS * N_KEYS
KEY_DIM = 128
PEER_TOPK = 16
N_ACTIVE = PEER_HEADS * PEER_TOPK
PEER_CHUNK = 128
IN_SPLITS = (LRU_WIDTH, LRU_WIDTH, Q_WIDTH, KV_WIDTH, KV_WIDTH, D_MODEL, D_MODEL)
IN_COLS = LRU_WIDTH * 2 + Q_WIDTH + KV_WIDTH * 2 + D_MODEL * 2
EPS = 1e-6
NEG_INF = -1e30

kernel_name = 'griffin_swa_sink_peer_hybrid_step'


def _rmsnorm(x, g):
    xf = x.astype(jnp.float32)
    y = xf * lax.rsqrt(jnp.mean(xf * xf, axis=-1, keepdims=True) + EPS)
    return (y * g.astype(jnp.float32)).astype(x.dtype)


def _split_in(z):
    parts, start = [], 0
    for w in IN_SPLITS:
        parts.append(z[..., start:start + w])
        start += w
    return parts


def _alibi_slopes():
    return 2.0 ** (-8.0 * jnp.arange(1, N_HEADS + 1, dtype=jnp.float32) / N_HEADS)


def _causal_conv(xr, buf, w, b):
    T = xr.shape[1]
    full = jnp.concatenate([buf.astype(xr.dtype), xr], axis=1)
    y = sum(full[:, j:j + T] * w[j] for j in range(CONV_WIDTH)) + b
    return y, full[:, -(CONV_WIDTH - 1):]


def _lin_combine(left, right):
    a1, b1 = left
    a2, b2 = right
    return a1 * a2, a2 * b1 + b2


def _rglru(xc, h0, w_a, b_a, w_x, b_x, lam):
    B, T, C = xc.shape
    xb = xc.reshape(B, T, LRU_BLOCKS, LRU_BLOCK)
    r = jax.nn.sigmoid((jnp.einsum('btnj,njk->btnk', xb, w_a).reshape(B, T, C) + b_a).astype(jnp.float32))
    i = jax.nn.sigmoid((jnp.einsum('btnj,njk->btnk', xb, w_x).reshape(B, T, C) + b_x).astype(jnp.float32))
    log_a = LRU_C * r * jax.nn.log_sigmoid(lam.astype(jnp.float32))
    a = jnp.exp(log_a)
    bterm = jnp.sqrt(-jnp.expm1(2.0 * log_a)) * (i * xc.astype(jnp.float32))
    bterm = bterm.at[:, 0].add(a[:, 0] * h0.astype(jnp.float32))
    _, h = lax.associative_scan(_lin_combine, (a, bterm), axis=1)
    return h, h[:, -1]


def _window_attend(q, k, v, qpos, kpos, sinks):
    B, L, Tq = q.shape[:3]
    s = jnp.einsum('blqkgd,blskd->blkgqs', q, k).astype(jnp.float32) * (HEAD_DIM ** -0.5)
    dist = qpos[:, :, None] - kpos[:, None, :]
    valid = (dist >= 0) & (dist <= WINDOW) & (kpos[:, None, :] >= 0)
    slopes = _alibi_slopes().reshape(N_KV_HEADS, GROUP)
    s = s - slopes[None, None, :, :, None, None] * dist.astype(jnp.float32)[None, :, None, None]
    s = jnp.where(valid[None, :, None, None], s, NEG_INF)
    sink = jnp.broadcast_to(sinks.astype(jnp.float32).reshape(1, 1, N_KV_HEADS, GROUP, 1, 1), s.shape[:-1] + (1,))
    p = jax.nn.softmax(jnp.concatenate([s, sink], axis=-1), axis=-1)[..., :-1]
    o = jnp.einsum('blkgqs,blskd->blqkgd', p.astype(v.dtype), v)
    return o.reshape(B, L * Tq, Q_WIDTH)


def _band(t):
    B, S = t.shape[:2]
    tb = t.reshape(B, S // ATTN_BLOCK, ATTN_BLOCK, N_KV_HEADS, HEAD_DIM)
    prev = jnp.concatenate([jnp.zeros_like(tb[:, :1]), tb[:, :-1]], axis=1)
    return jnp.concatenate([prev, tb], axis=2)


def _peer(xn, w_query, sub_keys, expert_u, expert_v):
    B, T, D = xn.shape
    n = B * T
    xt = xn.reshape(n, D)
    qr = (xt @ w_query).reshape(n, PEER_HEADS, 2, KEY_DIM)
    s = jnp.einsum('nhpd,hpkd->nhpk', qr, sub_keys).astype(jnp.float32)
    s_top, i_top = lax.top_k(s, PEER_TOPK)
    cand = (s_top[:, :, 0, :, None] + s_top[:, :, 1, None, :]).reshape(n, PEER_HEADS, PEER_TOPK * PEER_TOPK)
    cand_idx = (i_top[:, :, 0, :, None] * N_KEYS + i_top[:, :, 1, None, :]).reshape(n, PEER_HEADS, PEER_TOPK * PEER_TOPK)
    best, pos = lax.top_k(cand, PEER_TOPK)
    idx = jnp.take_along_axis(cand_idx, pos, axis=-1).reshape(n, N_ACTIVE)
    g = jax.nn.softmax(best, axis=-1).reshape(n, N_ACTIVE).astype(xt.dtype)
    pad = (-n) % PEER_CHUNK
    xt_p = jnp.pad(xt, ((0, pad), (0, 0))).reshape(-1, PEER_CHUNK, D)
    idx_p = jnp.pad(idx, ((0, pad), (0, 0))).reshape(-1, PEER_CHUNK, N_ACTIVE)
    g_p = jnp.pad(g, ((0, pad), (0, 0))).reshape(-1, PEER_CHUNK, N_ACTIVE)

    def expert_block(args):
        xc, ic, gc = args
        act = jax.nn.gelu(jnp.einsum('cd,ced->ce', xc, expert_u[ic])) * gc
        return jnp.einsum('ce,ced->cd', act, expert_v[ic])

    out = lax.map(expert_block, (xt_p, idx_p, g_p)).reshape(-1, D)[:n]
    return out.reshape(B, T, D)


def _layer(x, conv_buf, h0, k_past, v_past, norm1_g, w_in, conv_w, conv_b, rg_w_a, rg_b_a, rg_w_x, rg_b_x,
           rg_lambda, q_norm_g, k_norm_g, attn_sinks, w_branch_lru, w_branch_attn, w_out, norm2_g,
           peer_w_query, peer_sub_keys, expert_u, expert_v):
    B, T, _ = x.shape
    xn = _rmsnorm(x, norm1_g)
    xr, gr, q, k, v, ga, gb = _split_in(xn @ w_in)
    xc, new_conv = _causal_conv(xr, conv_buf, conv_w, conv_b)
    h, h_last = _rglru(xc, h0, rg_w_a, rg_b_a, rg_w_x, rg_b_x, rg_lambda)
    lru_out = h.astype(x.dtype) * jax.nn.gelu(gr)
    q = _rmsnorm(q.reshape(B, T, N_KV_HEADS, GROUP, HEAD_DIM), q_norm_g)
    k = _rmsnorm(k.reshape(B, T, N_KV_HEADS, HEAD_DIM), k_norm_g)
    v = v.reshape(B, T, N_KV_HEADS, HEAD_DIM)
    if k_past is None:
        nb = T // ATTN_BLOCK
        start = jnp.arange(nb)[:, None] * ATTN_BLOCK
        qpos = start + jnp.arange(ATTN_BLOCK)[None]
        kpos = start - ATTN_BLOCK + jnp.arange(2 * ATTN_BLOCK)[None]
        qb = q.reshape(B, nb, ATTN_BLOCK, N_KV_HEADS, GROUP, HEAD_DIM)
        attn = _window_attend(qb, _band(k), _band(v), qpos, kpos, attn_sinks)
        new_k, new_v = k[:, -WINDOW:], v[:, -WINDOW:]
    else:
        kk = jnp.concatenate([k_past.astype(k.dtype), k], axis=1)
        vv = jnp.concatenate([v_past.astype(v.dtype), v], axis=1)
        qpos = (PAST_LEN + jnp.arange(T))[None]
        kpos = (PAST_LEN - WINDOW + jnp.arange(WINDOW + T))[None]
        attn = _window_attend(q[:, None], kk[:, None], vv[:, None], qpos, kpos, attn_sinks)
        new_k, new_v = kk[:, -WINDOW:], vv[:, -WINDOW:]
    merged = jax.nn.sigmoid(ga) * (lru_out @ w_branch_lru) + jax.nn.sigmoid(gb) * (attn @ w_branch_attn)
    hres = x + merged @ w_out
    y = hres + _peer(_rmsnorm(hres, norm2_g), peer_w_query, peer_sub_keys, expert_u, expert_v)
    return y, new_conv, h_last, new_k, new_v


def setup_inputs(seed: int = 0) -> dict:
    key = jax.random.key(seed)
    ks = jax.random.split(key, 32)
    f32 = jnp.float32
    nrm = lambda k, shape, scale: jax.random.normal(k, shape, f32) * scale
    u = jax.random.uniform(ks[14], (DEPTH, LRU_WIDTH), f32, minval=0.9, maxval=0.999)
    sg = u ** (1.0 / LRU_C)
    lam = jnp.log(sg) - jnp.log1p(-sg)
    return {
        'x_prompt': nrm(ks[0], (BATCH, SEQ, D_MODEL), 1.0),
        'x_sample': nrm(ks[1], (DEC_BATCH, DEC_SEQ, D_MODEL), 1.0),
        'cache_conv': nrm(ks[2], (DEPTH, DEC_BATCH, CONV_WIDTH - 1, LRU_WIDTH), 1.0),
        'state_lru': nrm(ks[3], (DEPTH, DEC_BATCH, LRU_WIDTH), 0.5),
        'cache_k': nrm(ks[4], (DEPTH, DEC_BATCH, WINDOW, N_KV_HEADS, HEAD_DIM), 1.0),
        'cache_v': nrm(ks[5], (DEPTH, DEC_BATCH, WINDOW, N_KV_HEADS, HEAD_DIM), 1.0),
        'norm1_g': 1.0 + nrm(ks[6], (DEPTH, D_MODEL), 0.02),
        'w_in': nrm(ks[7], (DEPTH, D_MODEL, IN_COLS), D_MODEL ** -0.5),
        'conv_w': nrm(ks[8], (DEPTH, CONV_WIDTH, LRU_WIDTH), CONV_WIDTH ** -0.5),
        'conv_b': nrm(ks[9], (DEPTH, LRU_WIDTH), 0.01),
        'rg_w_a': nrm(ks[10], (DEPTH, LRU_BLOCKS, LRU_BLOCK, LRU_BLOCK), LRU_BLOCK ** -0.5),
        'rg_b_a': nrm(ks[11], (DEPTH, LRU_WIDTH), 0.01),
        'rg_w_x': nrm(ks[12], (DEPTH, LRU_BLOCKS, LRU_BLOCK, LRU_BLOCK), LRU_BLOCK ** -0.5),
        'rg_b_x': nrm(ks[13], (DEPTH, LRU_WIDTH), 0.01),
        'rg_lambda': lam,
        'q_norm_g': 1.0 + nrm(ks[15], (DEPTH, HEAD_DIM), 0.02),
        'k_norm_g': 1.0 + nrm(ks[16], (DEPTH, HEAD_DIM), 0.02),
        'attn_sinks': nrm(ks[17], (DEPTH, N_HEADS), 0.5),
        'w_branch_lru': nrm(ks[18], (DEPTH, LRU_WIDTH, D_MODEL), LRU_WIDTH ** -0.5),
        'w_branch_attn': nrm(ks[19], (DEPTH, Q_WIDTH, D_MODEL), Q_WIDTH ** -0.5),
        'w_out': nrm(ks[20], (DEPTH, D_MODEL, D_MODEL), D_MODEL ** -0.5),
        'norm2_g': 1.0 + nrm(ks[21], (DEPTH, D_MODEL), 0.02),
        'peer_w_query': nrm(ks[22], (DEPTH, D_MODEL, PEER_HEADS * 2 * KEY_DIM), D_MODEL ** -0.5),
        'peer_sub_keys': nrm(ks[23], (DEPTH, PEER_HEADS, 2, N_KEYS, KEY_DIM), KEY_DIM ** -0.5),
        'expert_u': nrm(ks[24], (DEPTH, N_EXPERTS, D_MODEL), D_MODEL ** -0.5),
        'expert_v': nrm(ks[25], (DEPTH, N_EXPERTS, D_MODEL), 0.1),
    }


def reference(x_prompt, x_sample, cache_conv, state_lru, cache_k, cache_v, norm1_g, w_in, conv_w, conv_b,
              rg_w_a, rg_b_a, rg_w_x, rg_b_x, rg_lambda, q_norm_g, k_norm_g, attn_sinks, w_branch_lru,
              w_branch_attn, w_out, norm2_g, peer_w_query, peer_sub_keys, expert_u, expert_v):
    yp, ys = x_prompt, x_sample
    conv_p, lru_p, k_p, v_p = [], [], [], []
    conv_s, lru_s, k_s, v_s = [], [], [], []
    for l in range(DEPTH):
        lp = (norm1_g[l], w_in[l], conv_w[l], conv_b[l], rg_w_a[l], rg_b_a[l], rg_w_x[l], rg_b_x[l],
              rg_lambda[l], q_norm_g[l], k_norm_g[l], attn_sinks[l], w_branch_lru[l], w_branch_attn[l],
              w_out[l], norm2_g[l], peer_w_query[l], peer_sub_keys[l], expert_u[l], expert_v[l])
        zero_buf = jnp.zeros((yp.shape[0], CONV_WIDTH - 1, LRU_WIDTH), yp.dtype)
        zero_h = jnp.zeros((yp.shape[0], LRU_WIDTH), jnp.float32)
        yp, c, h, kw, vw = _layer(yp, zero_buf, zero_h, None, None, *lp)
        conv_p.append(c); lru_p.append(h); k_p.append(kw); v_p.append(vw)
        ys, c, h, kw, vw = _layer(ys, cache_conv[l], state_lru[l], cache_k[l], cache_v[l], *lp)
        conv_s.append(c); lru_s.append(h); k_s.append(kw); v_s.append(vw)
    new_conv_p, new_lru_p = jnp.stack(conv_p), jnp.stack(lru_p)
    new_k_p, new_v_p = jnp.stack(k_p), jnp.stack(v_p)
    new_conv_s, new_lru_s = jnp.stack(conv_s), jnp.stack(lru_s)
    new_k_s, new_v_s = jnp.stack(k_s), jnp.stack(v_s)
    return (yp, ys, new_conv_p, new_lru_p, new_k_p, new_v_p, new_conv_s, new_lru_s, new_k_s, new_v_s)
```

```cpp
#include <hip/hip_runtime.h>
#include <hip/hip_cooperative_groups.h>
#include <stdint.h>
#include <cstdio>
namespace cg = cooperative_groups;

typedef unsigned short u16;
typedef __attribute__((ext_vector_type(8))) short bf16x8;
typedef __attribute__((ext_vector_type(4))) float f32x4;

constexpr int D = 1024;
constexpr int NP = 16384;
constexpr int NTOK = 17408;
constexpr int SEQ = 4096;
constexpr int MT = 136;
constexpr float EPS = 1e-6f;

constexpr size_t O_Y = 0;
constexpr size_t O_CONVP = 17825792;
constexpr size_t O_LRUP = O_CONVP + 12288;
constexpr size_t O_KP = O_LRUP + 4096;
constexpr size_t O_VP = O_KP + 131072;
constexpr size_t O_CONVS = O_VP + 131072;
constexpr size_t O_LRUS = O_CONVS + 393216;
constexpr size_t O_KS = O_LRUS + 131072;
constexpr size_t O_VS = O_KS + 4194304;

constexpr size_t W_WTIN = 0;
constexpr size_t W_WTLRU = W_WTIN + (size_t)5632 * 1024 * 2;
constexpr size_t W_WTATTN = W_WTLRU + (size_t)1024 * 1024 * 2;
constexpr size_t W_WTOUT = W_WTATTN + (size_t)1024 * 1024 * 2;
constexpr size_t W_WTQ = W_WTOUT + (size_t)1024 * 1024 * 2;
constexpr size_t W_SK = W_WTQ + (size_t)2048 * 1024 * 2;
constexpr size_t W_RGA = W_SK + (size_t)16 * 128 * 128 * 2;
constexpr size_t W_RGX = W_RGA + (size_t)65536 * 2;
constexpr size_t W_EU = W_RGX + (size_t)65536 * 2;
constexpr size_t W_EV = W_EU + (size_t)16384 * 1024 * 2;
constexpr size_t W_XN = W_EV + (size_t)16384 * 1024 * 2;
constexpr size_t W_ZA = W_XN + (size_t)NTOK * 1024 * 2;
constexpr size_t W_ZB = W_ZA + (size_t)NTOK * 2048 * 2;
constexpr size_t W_AGG = W_ZB + (size_t)NTOK * 1536 * 2;
constexpr size_t W_SSQ = W_AGG + (size_t)128 * 1024 * 2 * 4;
constexpr size_t W_END = W_SSQ + (size_t)NTOK * 8 * 4;

constexpr int SMEM_BYTES = 81920;

struct Params {
  const float *x_prompt, *x_sample, *cache_conv, *state_lru, *cache_k, *cache_v, *norm1_g, *w_in, *conv_w,
      *conv_b, *rg_w_a, *rg_b_a, *rg_w_x, *rg_b_x, *rg_lambda, *q_norm_g, *k_norm_g, *attn_sinks,
      *w_branch_lru, *w_branch_attn, *w_out, *norm2_g, *peer_w_query, *peer_sub_keys, *expert_u, *expert_v;
  float* out;
  char* ws;
};

__device__ __forceinline__ u16 f2bf(float f) {
  uint32_t u = __float_as_uint(f);
  u += 0x7FFFu + ((u >> 16) & 1u);
  return (u16)(u >> 16);
}
__device__ __forceinline__ float bf2f(u16 h) { return __uint_as_float(((uint32_t)h) << 16); }
__device__ __forceinline__ uint32_t pack2(float a, float b) {
  return (uint32_t)f2bf(a) | ((uint32_t)f2bf(b) << 16);
}
__device__ __forceinline__ uint4 pack8(const float* v) {
  uint4 o;
  o.x = pack2(v[0], v[1]); o.y = pack2(v[2], v[3]); o.z = pack2(v[4], v[5]); o.w = pack2(v[6], v[7]);
  return o;
}
__device__ __forceinline__ void unpack8(uint4 u, float* v) {
  v[0] = __uint_as_float(u.x << 16); v[1] = __uint_as_float(u.x & 0xFFFF0000u);
  v[2] = __uint_as_float(u.y << 16); v[3] = __uint_as_float(u.y & 0xFFFF0000u);
  v[4] = __uint_as_float(u.z << 16); v[5] = __uint_as_float(u.z & 0xFFFF0000u);
  v[6] = __uint_as_float(u.w << 16); v[7] = __uint_as_float(u.w & 0xFFFF0000u);
}
__device__ __forceinline__ float sigmoidf_(float x) { return 1.f / (1.f + __expf(-x)); }
__device__ __forceinline__ float gelu_tanh(float x) {
  float y = 0.7978845608028654f * (x + 0.044715f * x * x * x);
  float t = 1.f - 2.f / (__expf(2.f * y) + 1.f);
  return 0.5f * x * (1.f + t);
}
__device__ __forceinline__ uint32_t ordf(float f) {
  uint32_t u = __float_as_uint(f);
  return (u & 0x80000000u) ? ~u : (u | 0x80000000u);
}
__device__ __forceinline__ float unordf(uint32_t o) {
  uint32_t u = (o & 0x80000000u) ? (o ^ 0x80000000u) : ~o;
  return __uint_as_float(u);
}
__device__ __forceinline__ const float* xrow(const Params& p, int row) {
  return row < NP ? p.x_prompt + (size_t)row * D : p.x_sample + (size_t)(row - NP) * D;
}

#define INS16(T, V)                                  \
  {                                                  \
    uint32_t _v = (V);                               \
    _Pragma("unroll") for (int _q = 0; _q < 16; _q++) { \
      uint32_t _hi = max(T[_q], _v);                 \
      _v = min(T[_q], _v);                           \
      T[_q] = _hi;                                   \
    }                                                \
  }

__device__ __forceinline__ void transpose_cvt(const float* __restrict__ W, u16* __restrict__ Wt, int K, int N,
                                              size_t gtid, size_t gsz) {
  size_t total = (size_t)N * (K / 8);
  for (size_t c = gtid; c < total; c += gsz) {
    int n = (int)(c % N);
    int kg = (int)(c / N);
    float v[8];
#pragma unroll
    for (int i = 0; i < 8; i++) v[i] = W[(size_t)(kg * 8 + i) * N + n];
    *(uint4*)(Wt + (size_t)n * K + kg * 8) = pack8(v);
  }
}
__device__ __forceinline__ void plain_cvt(const float* __restrict__ S, u16* __restrict__ Dst, size_t n, size_t gtid,
                                          size_t gsz) {
  size_t total = n / 8;
  const float4* s4 = (const float4*)S;
  for (size_t c = gtid; c < total; c += gsz) {
    float4 a = s4[2 * c], b = s4[2 * c + 1];
    float v[8] = {a.x, a.y, a.z, a.w, b.x, b.y, b.z, b.w};
    *(uint4*)(Dst + c * 8) = pack8(v);
  }
}

__device__ void phase0(const Params& p) {
  const int tid = threadIdx.x;
  const size_t gtid = (size_t)blockIdx.x * 256 + tid, gsz = (size_t)gridDim.x * 256;
  char* ws = p.ws;
  {
    const int lane = tid & 63;
    const int gw = (int)(gtid >> 6), nw = (int)(gsz >> 6);
    u16* XN = (u16*)(ws + W_XN);
    for (int row = gw; row < NTOK; row += nw) {
      const float4* xr = (const float4*)xrow(p, row);
      float4 v[4];
      float ss = 0.f;
#pragma unroll
      for (int i = 0; i < 4; i++) {
        v[i] = xr[lane + i * 64];
        ss += v[i].x * v[i].x + v[i].y * v[i].y + v[i].z * v[i].z + v[i].w * v[i].w;
      }
#pragma unroll
      for (int o = 32; o > 0; o >>= 1) ss += __shfl_xor(ss, o);
      float rstd = rsqrtf(ss * (1.f / 1024.f) + EPS);
      const float4* g4 = (const float4*)p.norm1_g;
#pragma unroll
      for (int i = 0; i < 4; i++) {
        float4 g = g4[lane + i * 64];
        uint2 o;
        o.x = pack2(v[i].x * rstd * g.x, v[i].y * rstd * g.y);
        o.y = pack2(v[i].z * rstd * g.z, v[i].w * rstd * g.w);
        *(uint2*)(XN + (size_t)row * D + (lane + i * 64) * 4) = o;
      }
    }
  }
  transpose_cvt(p.w_in, (u16*)(ws + W_WTIN), 1024, 5632, gtid, gsz);
  transpose_cvt(p.w_branch_lru, (u16*)(ws + W_WTLRU), 1024, 1024, gtid, gsz);
  transpose_cvt(p.w_branch_attn, (u16*)(ws + W_WTATTN), 1024, 1024, gtid, gsz);
  transpose_cvt(p.w_out, (u16*)(ws + W_WTOUT), 1024, 1024, gtid, gsz);
  transpose_cvt(p.peer_w_query, (u16*)(ws + W_WTQ), 1024, 2048, gtid, gsz);
  {
    u16* RA = (u16*)(ws + W_RGA);
    u16* RX = (u16*)(ws + W_RGX);
    for (size_t e = gtid; e < 65536; e += gsz) {
      int n = (int)(e >> 12), k = (int)((e >> 6) & 63), j = (int)(e & 63);
      RA[e] = f2bf(p.rg_w_a[n * 4096 + j * 64 + k]);
      RX[e] = f2bf(p.rg_w_x[n * 4096 + j * 64 + k]);
    }
  }
  plain_cvt(p.peer_sub_keys, (u16*)(ws + W_SK), (size_t)16 * 128 * 128, gtid, gsz);
  plain_cvt(p.expert_u, (u16*)(ws + W_EU), (size_t)16384 * 1024, gtid, gsz);
  plain_cvt(p.expert_v, (u16*)(ws + W_EV), (size_t)16384 * 1024, gtid, gsz);
}

constexpr int LDT = 72;
constexpr int CS_LD = 132;

__device__ __forceinline__ void gemm_tile(const u16* __restrict__ A, int lda, const u16* __restrict__ Bt, int ldb,
                                          int K, f32x4 (&acc)[4][4], u16* As, u16* Bs, int tid) {
  const int lane = tid & 63, w = tid >> 6;
  const int wm = w >> 1, wn = w & 1;
  const int l15 = lane & 15, quad = lane >> 4;
  const int lrow = tid >> 3, lcol = (tid & 7) * 8;
  const u16* Ap = A + (size_t)lrow * lda + lcol;
  const u16* Bp = Bt + (size_t)lrow * ldb + lcol;
  const size_t sa = (size_t)32 * lda, sb = (size_t)32 * ldb;
  uint4 ra0 = *(const uint4*)(Ap), ra1 = *(const uint4*)(Ap + sa), ra2 = *(const uint4*)(Ap + 2 * sa),
        ra3 = *(const uint4*)(Ap + 3 * sa);
  uint4 rb0 = *(const uint4*)(Bp), rb1 = *(const uint4*)(Bp + sb), rb2 = *(const uint4*)(Bp + 2 * sb),
        rb3 = *(const uint4*)(Bp + 3 * sb);
  u16* Asw = As + lrow * LDT + lcol;
  u16* Bsw = Bs + lrow * LDT + lcol;
  for (int k0 = 0; k0 < K; k0 += 64) {
    __syncthreads();
    *(uint4*)(Asw) = ra0; *(uint4*)(Asw + 32 * LDT) = ra1; *(uint4*)(Asw + 64 * LDT) = ra2; *(uint4*)(Asw + 96 * LDT) = ra3;
    *(uint4*)(Bsw) = rb0; *(uint4*)(Bsw + 32 * LDT) = rb1; *(uint4*)(Bsw + 64 * LDT) = rb2; *(uint4*)(Bsw + 96 * LDT) = rb3;
    __syncthreads();
    if (k0 + 64 < K) {
      Ap += 64; Bp += 64;
      ra0 = *(const uint4*)(Ap); ra1 = *(const uint4*)(Ap + sa); ra2 = *(const uint4*)(Ap + 2 * sa); ra3 = *(const uint4*)(Ap + 3 * sa);
      rb0 = *(const uint4*)(Bp); rb1 = *(const uint4*)(Bp + sb); rb2 = *(const uint4*)(Bp + 2 * sb); rb3 = *(const uint4*)(Bp + 3 * sb);
    }
#pragma unroll
    for (int ks = 0; ks < 2; ks++) {
      bf16x8 a[4], b[4];
#pragma unroll
      for (int i = 0; i < 4; i++) {
        a[i] = *(const bf16x8*)(As + (wm * 64 + i * 16 + l15) * LDT + ks * 32 + quad * 8);
        b[i] = *(const bf16x8*)(Bs + (wn * 64 + i * 16 + l15) * LDT + ks * 32 + quad * 8);
      }
#pragma unroll
      for (int i = 0; i < 4; i++)
#pragma unroll
        for (int j = 0; j < 4; j++) acc[i][j] = __builtin_amdgcn_mfma_f32_16x16x32_bf16(a[i], b[j], acc[i][j], 0, 0, 0);
    }
  }
}

__device__ __forceinline__ void zero_acc(f32x4 (&acc)[4][4]) {
#pragma unroll
  for (int i = 0; i < 4; i++)
#pragma unroll
    for (int j = 0; j < 4; j++) acc[i][j] = (f32x4){0.f, 0.f, 0.f, 0.f};
}

__device__ __forceinline__ void acc_to_cs(const f32x4 (&acc)[4][4], float* Cs, int tid) {
  const int lane = tid & 63, w = tid >> 6;
  const int wm = w >> 1, wn = w & 1;
  const int l15 = lane & 15, quad = lane >> 4;
#pragma unroll
  for (int i = 0; i < 4; i++)
#pragma unroll
    for (int j = 0; j < 4; j++)
#pragma unroll
      for (int e = 0; e < 4; e++)
        Cs[(wm * 64 + i * 16 + quad * 4 + e) * CS_LD + wn * 64 + j * 16 + l15] = acc[i][j][e];
}

__device__ void phase_g1(const Params& p, char* smem) {
  const int tid = threadIdx.x;
  u16* As = (u16*)smem;
  u16* Bs = As + 128 * LDT;
  float* Cs = (float*)smem;
  const u16* XN = (const u16*)(p.ws + W_XN);
  const u16* WT = (const u16*)(p.ws + W_WTIN);
  for (int t = blockIdx.x; t < MT * 44; t += gridDim.x) {
    const int mt = t / 44, nt = t % 44;
    f32x4 acc[4][4];
    zero_acc(acc);
    gemm_tile(XN + (size_t)mt * 128 * 1024, 1024, WT + (size_t)nt * 128 * 1024, 1024, 1024, acc, As, Bs, tid);
    __syncthreads();
    acc_to_cs(acc, Cs, tid);
    __syncthreads();
    const int n0 = nt * 128;
    u16* dst;
    int ldd, col;
    if (n0 < 2048) { dst = (u16*)(p.ws + W_ZA); ldd = 2048; col = n0; }
    else if (n0 < 3584) { dst = (u16*)(p.ws + W_ZB); ldd = 1536; col = n0 - 2048; }
    else { dst = (u16*)p.out; ldd = 2048; col = n0 - 3584; }
    const int cc = (tid & 15) * 8;
#pragma unroll
    for (int i = 0; i < 8; i++) {
      const int r = (tid >> 4) + 16 * i;
      float4 a = *(const float4*)(Cs + r * CS_LD + cc), b = *(const float4*)(Cs + r * CS_LD + cc + 4);
      float v[8] = {a.x, a.y, a.z, a.w, b.x, b.y, b.z, b.w};
      *(uint4*)(dst + (size_t)(mt * 128 + r) * ldd + col + cc) = pack8(v);
    }
    __syncthreads();
  }
}

constexpr int KS_LD = 72, VT_LD = 200, PS_LD = 168;
__device__ void attn_item(const Params& p, char* smem, int item) {
  const int tid = threadIdx.x, lane = tid & 63, w = tid >> 6, l15 = lane & 15, quad = lane >> 4;
  u16* Ks = (u16*)smem;
  u16* Vt = Ks + 192 * KS_LD;
  u16* Ps = Vt + 64 * VT_LD + w * 16 * PS_LD;
  const u16* ZB = (const u16*)(p.ws + W_ZB);
  u16* ATT = (u16*)(p.ws + W_XN);
  const bool sample = item >= 1024;
  int b, qb = 0, kv, rowbase, p0 = 0;
  if (!sample) {
    kv = item & 3; qb = (item >> 2) & 63; b = item >> 8;
    p0 = qb * 64;
    rowbase = b * SEQ + p0;
  } else {
    int it = item - 1024;
    kv = it & 3; b = it >> 2;
    rowbase = NP + b * 8;
  }
  __syncthreads();
  {
    const int ch = tid & 7;
    float kg[8];
#pragma unroll
    for (int i = 0; i < 8; i++) kg[i] = p.k_norm_g[ch * 8 + i];
    const int nrows = sample ? 160 : 192;
    for (int c = tid; c < nrows * 8; c += 256) {
      const int row = c >> 3;
      float kf[8], vf[8];
      bool valid, donorm;
      if (!sample) {
        const int pos = p0 - 128 + row;
        valid = pos >= 0;
        donorm = true;
        if (valid) {
          const u16* src = ZB + (size_t)(b * SEQ + pos) * 1536 + 1024 + kv * 64 + ch * 8;
          unpack8(*(const uint4*)src, kf);
          unpack8(*(const uint4*)(src + 256), vf);
        }
      } else {
        valid = row < 136;
        donorm = row >= 128;
        if (row < 128) {
          const float* sk = p.cache_k + ((size_t)(b * 128 + row) * 4 + kv) * 64 + ch * 8;
          const float* sv = p.cache_v + ((size_t)(b * 128 + row) * 4 + kv) * 64 + ch * 8;
          float4 a0 = *(const float4*)sk, a1 = *(const float4*)(sk + 4);
          float4 b0 = *(const float4*)sv, b1 = *(const float4*)(sv + 4);
          kf[0] = a0.x; kf[1] = a0.y; kf[2] = a0.z; kf[3] = a0.w; kf[4] = a1.x; kf[5] = a1.y; kf[6] = a1.z; kf[7] = a1.w;
          vf[0] = b0.x; vf[1] = b0.y; vf[2] = b0.z; vf[3] = b0.w; vf[4] = b1.x; vf[5] = b1.y; vf[6] = b1.z; vf[7] = b1.w;
        } else if (valid) {
          const u16* src = ZB + (size_t)(NP + b * 8 + (row - 128)) * 1536 + 1024 + kv * 64 + ch * 8;
          unpack8(*(const uint4*)src, kf);
          unpack8(*(const uint4*)(src + 256), vf);
        }
      }
      if (!valid) {
#pragma unroll
        for (int i = 0; i < 8; i++) { kf[i] = 0.f; vf[i] = 0.f; }
      }
      float ss = 0.f;
#pragma unroll
      for (int i = 0; i < 8; i++) ss += kf[i] * kf[i];
      ss += __shfl_xor(ss, 1);
      ss += __shfl_xor(ss, 2);
      ss += __shfl_xor(ss, 4);
      if (donorm) {
        const float rstd = rsqrtf(ss * (1.f / 64.f) + EPS);
#pragma unroll
        for (int i = 0; i < 8; i++) kf[i] = kf[i] * rstd * kg[i];
      }
      *(uint4*)(Ks + row * KS_LD + ch * 8) = pack8(kf);
#pragma unroll
      for (int i = 0; i < 8; i++) Vt[(ch * 8 + i) * VT_LD + row] = f2bf(vf[i]);
      if (!sample) {
        if (qb >= 62 && row >= 128) {
          const int wpos = p0 + (row - 128) - (SEQ - 128);
          float* ko = p.out + O_KP + ((size_t)(b * 128 + wpos) * 4 + kv) * 64 + ch * 8;
          float* vo = p.out + O_VP + ((size_t)(b * 128 + wpos) * 4 + kv) * 64 + ch * 8;
          *(float4*)ko = make_float4(kf[0], kf[1], kf[2], kf[3]);
          *(float4*)(ko + 4) = make_float4(kf[4], kf[5], kf[6], kf[7]);
          *(float4*)vo = make_float4(vf[0], vf[1], vf[2], vf[3]);
          *(float4*)(vo + 4) = make_float4(vf[4], vf[5], vf[6], vf[7]);
        }
      } else {
        if (row >= 8 && row < 136) {
          float* ko = p.out + O_KS + ((size_t)(b * 128 + (row - 8)) * 4 + kv) * 64 + ch * 8;
          float* vo = p.out + O_VS + ((size_t)(b * 128 + (row - 8)) * 4 + kv) * 64 + ch * 8;
          *(float4*)ko = make_float4(kf[0], kf[1], kf[2], kf[3]);
          *(float4*)(ko + 4) = make_float4(kf[4], kf[5], kf[6], kf[7]);
          *(float4*)vo = make_float4(vf[0], vf[1], vf[2], vf[3]);
          *(float4*)(vo + 4) = make_float4(vf[4], vf[5], vf[6], vf[7]);
        }
      }
    }
  }
  __syncthreads();
  const int hq = kv * 4 + w;
  const float slope = exp2f(-0.5f * (float)(hq + 1));
  const float sink = p.attn_sinks[hq];
  float qg[2][8];
#pragma unroll
  for (int ks = 0; ks < 2; ks++)
#pragma unroll
    for (int i = 0; i < 8; i++) qg[ks][i] = p.q_norm_g[ks * 32 + quad * 8 + i] * 0.125f;
  const int nsub = sample ? 1 : 4;
  for (int sb = 0; sb < nsub; sb++) {
    const int r0 = sb * 16;
    const int ws0 = r0 < 32 ? r0 : 32;
    bf16x8 qa[2];
    {
      const int qr = sample ? (l15 & 7) : (r0 + l15);
      const u16* src = ZB + (size_t)(rowbase + qr) * 1536 + hq * 64 + quad * 8;
      float q0[8], q1[8];
      unpack8(*(const uint4*)src, q0);
      unpack8(*(const uint4*)(src + 32), q1);
      float ss = 0.f;
#pragma unroll
      for (int i = 0; i < 8; i++) ss += q0[i] * q0[i] + q1[i] * q1[i];
      ss += __shfl_xor(ss, 16);
      ss += __shfl_xor(ss, 32);
      const float rstd = rsqrtf(ss * (1.f / 64.f) + EPS);
#pragma unroll
      for (int i = 0; i < 8; i++) { q0[i] *= rstd * qg[0][i]; q1[i] *= rstd * qg[1][i]; }
      uint4 u0 = pack8(q0), u1 = pack8(q1);
      qa[0] = __builtin_bit_cast(bf16x8, u0);
      qa[1] = __builtin_bit_cast(bf16x8, u1);
    }
    f32x4 s[10];
#pragma unroll
    for (int kt = 0; kt < 10; kt++) {
      const u16* kp = Ks + (ws0 + kt * 16 + l15) * KS_LD + quad * 8;
      bf16x8 b0 = *(const bf16x8*)kp, b1 = *(const bf16x8*)(kp + 32);
      f32x4 z = {0.f, 0.f, 0.f, 0.f};
      z = __builtin_amdgcn_mfma_f32_16x16x32_bf16(qa[0], b0, z, 0, 0, 0);
      s[kt] = __builtin_amdgcn_mfma_f32_16x16x32_bf16(qa[1], b1, z, 0, 0, 0);
    }
    float mx[4] = {-1e30f, -1e30f, -1e30f, -1e30f};
#pragma unroll
    for (int kt = 0; kt < 10; kt++) {
      const int jj = ws0 + kt * 16 + l15;
      const bool posok = sample ? (jj < 136) : (p0 - 128 + jj >= 0);
#pragma unroll
      for (int e = 0; e < 4; e++) {
        const int r = r0 + quad * 4 + e;
        const int dist = r + 128 - jj;
        const bool ok = posok && dist >= 0 && dist <= 128;
        float v = ok ? (s[kt][e] - slope * (float)dist) : -1e30f;
        s[kt][e] = v;
        mx[e] = fmaxf(mx[e], v);
      }
    }
    float sum[4];
#pragma unroll
    for (int e = 0; e < 4; e++) {
      float m = mx[e];
      m = fmaxf(m, __shfl_xor(m, 1));
      m = fmaxf(m, __shfl_xor(m, 2));
      m = fmaxf(m, __shfl_xor(m, 4));
      m = fmaxf(m, __shfl_xor(m, 8));
      m = fmaxf(m, sink);
      mx[e] = m;
      sum[e] = 0.f;
    }
#pragma unroll
    for (int kt = 0; kt < 10; kt++) {
#pragma unroll
      for (int e = 0; e < 4; e++) {
        float pv = __expf(s[kt][e] - mx[e]);
        sum[e] += pv;
        Ps[(quad * 4 + e) * PS_LD + kt * 16 + l15] = f2bf(pv);
      }
    }
#pragma unroll
    for (int e = 0; e < 4; e++) {
      float t = sum[e];
      t += __shfl_xor(t, 1);
      t += __shfl_xor(t, 2);
      t += __shfl_xor(t, 4);
      t += __shfl_xor(t, 8);
      sum[e] = 1.f / (t + __expf(sink - mx[e]));
    }
    __syncthreads();
    f32x4 o[4];
#pragma unroll
    for (int nt = 0; nt < 4; nt++) o[nt] = (f32x4){0.f, 0.f, 0.f, 0.f};
#pragma unroll
    for (int kk = 0; kk < 5; kk++) {
      bf16x8 pa = *(const bf16x8*)(Ps + l15 * PS_LD + kk * 32 + quad * 8);
#pragma unroll
      for (int nt = 0; nt < 4; nt++) {
        bf16x8 vb = *(const bf16x8*)(Vt + (nt * 16 + l15) * VT_LD + ws0 + kk * 32 + quad * 8);
        o[nt] = __builtin_amdgcn_mfma_f32_16x16x32_bf16(pa, vb, o[nt], 0, 0, 0);
      }
    }
#pragma unroll
    for (int e = 0; e < 4; e++) {
      const int r = quad * 4 + e;
      if (!sample || r < 8) {
        u16* dst = ATT + (size_t)(rowbase + r0 + r) * 1024 + hq * 64 + l15;
#pragma unroll
        for (int nt = 0; nt < 4; nt++) dst[nt * 16] = f2bf(o[nt][e] * sum[e]);
      }
    }
    __syncthreads();
  }
}

constexpr int XC_LD = 68;
__device__ void lru_tile(const Params& p, char* smem, int mt, int nb, int mode) {
  const int tid = threadIdx.x, lane = tid & 63, w = tid >> 6, l15 = lane & 15, quad = lane >> 4;
  float* xcF = (float*)smem;
  float* aL = xcF + 128 * XC_LD;
  float* aggL = aL + 128 * XC_LD;
  const u16* ZA = (const u16*)(p.ws + W_ZA);
  const bool sample = mt >= 128;
  const int m0 = mt * 128;
  const int cb = nb * 64;
  __syncthreads();
  {
    const int ch = tid & 7;
    float cw[4][8], cbias[8];
#pragma unroll
    for (int j = 0; j < 4; j++)
#pragma unroll
      for (int i = 0; i < 8; i++) cw[j][i] = p.conv_w[j * 1024 + cb + ch * 8 + i];
#pragma unroll
    for (int i = 0; i < 8; i++) cbias[i] = p.conv_b[cb + ch * 8 + i];
#pragma unroll
    for (int it = 0; it < 4; it++) {
      const int r = (tid >> 3) + it * 32;
      const int grow = m0 + r;
      const int t = sample ? (r & 7) : ((mt & 31) * 128 + r);
      float y[8];
#pragma unroll
      for (int i = 0; i < 8; i++) y[i] = cbias[i];
#pragma unroll
      for (int d = 0; d < 4; d++) {
        float xv[8];
        if (t - d >= 0) {
          unpack8(*(const uint4*)(ZA + (size_t)(grow - d) * 2048 + cb + ch * 8), xv);
        } else if (sample) {
          const int bb = (m0 - NP + r) >> 3;
          const float* src = p.cache_conv + ((size_t)bb * 3 + (3 + t - d)) * 1024 + cb + ch * 8;
          float4 a = *(const float4*)src, b4 = *(const float4*)(src + 4);
          xv[0] = a.x; xv[1] = a.y; xv[2] = a.z; xv[3] = a.w; xv[4] = b4.x; xv[5] = b4.y; xv[6] = b4.z; xv[7] = b4.w;
        } else {
#pragma unroll
          for (int i = 0; i < 8; i++) xv[i] = 0.f;
        }
#pragma unroll
        for (int i = 0; i < 8; i++) y[i] += cw[3 - d][i] * xv[i];
        if (d == 0 && mode == 1) {
          if (!sample) {
            if ((mt & 31) == 31 && r >= 125) {
              float* dst = p.out + O_CONVP + ((size_t)(mt >> 5) * 3 + (r - 125)) * 1024 + cb + ch * 8;
              *(float4*)dst = make_float4(xv[0], xv[1], xv[2], xv[3]);
              *(float4*)(dst + 4) = make_float4(xv[4], xv[5], xv[6], xv[7]);
            }
          } else if (t >= 5) {
            const int bb = (m0 - NP + r) >> 3;
            float* dst = p.out + O_CONVS + ((size_t)bb * 3 + (t - 5)) * 1024 + cb + ch * 8;
            *(float4*)dst = make_float4(xv[0], xv[1], xv[2], xv[3]);
            *(float4*)(dst + 4) = make_float4(xv[4], xv[5], xv[6], xv[7]);
          }
        }
      }
      *(float4*)(xcF + r * XC_LD + ch * 8) = make_float4(y[0], y[1], y[2], y[3]);
      *(float4*)(xcF + r * XC_LD + ch * 8 + 4) = make_float4(y[4], y[5], y[6], y[7]);
    }
  }
  __syncthreads();
  {
    const u16* RA = (const u16*)(p.ws + W_RGA) + nb * 4096;
    const u16* RX = (const u16*)(p.ws + W_RGX) + nb * 4096;
    f32x4 aR[2][4], aI[2][4];
#pragma unroll
    for (int i = 0; i < 2; i++)
#pragma unroll
      for (int j = 0; j < 4; j++) { aR[i][j] = (f32x4){0.f, 0.f, 0.f, 0.f}; aI[i][j] = (f32x4){0.f, 0.f, 0.f, 0.f}; }
#pragma unroll
    for (int ks = 0; ks < 2; ks++) {
      bf16x8 a[2];
#pragma unroll
      for (int i = 0; i < 2; i++) {
        const float* src = xcF + (w * 32 + i * 16 + l15) * XC_LD + ks * 32 + quad * 8;
        float4 x0 = *(const float4*)src, x1 = *(const float4*)(src + 4);
        float v[8] = {x0.x, x0.y, x0.z, x0.w, x1.x, x1.y, x1.z, x1.w};
        uint4 u = pack8(v);
        a[i] = __builtin_bit_cast(bf16x8, u);
      }
#pragma unroll
      for (int j = 0; j < 4; j++) {
        bf16x8 ba = *(const bf16x8*)(RA + (j * 16 + l15) * 64 + ks * 32 + quad * 8);
        bf16x8 bx = *(const bf16x8*)(RX + (j * 16 + l15) * 64 + ks * 32 + quad * 8);
#pragma unroll
        for (int i = 0; i < 2; i++) {
          aR[i][j] = __builtin_amdgcn_mfma_f32_16x16x32_bf16(a[i], ba, aR[i][j], 0, 0, 0);
          aI[i][j] = __builtin_amdgcn_mfma_f32_16x16x32_bf16(a[i], bx, aI[i][j], 0, 0, 0);
        }
      }
    }
#pragma unroll
    for (int j = 0; j < 4; j++) {
      const int c = cb + j * 16 + l15;
      const float ba = p.rg_b_a[c], bx = p.rg_b_x[c];
      const float ls = -log1pf(__expf(-p.rg_lambda[c]));
#pragma unroll
      for (int i = 0; i < 2; i++)
#pragma unroll
        for (int e = 0; e < 4; e++) {
          const int row = w * 32 + i * 16 + quad * 4 + e;
          const float rg = sigmoidf_(aR[i][j][e] + ba);
          const float ig = sigmoidf_(aI[i][j][e] + bx);
          const float la = 8.f * rg * ls;
          const float av = __expf(la);
          const float mult = sqrtf(fmaxf(-expm1f(2.f * la), 0.f));
          const int idx = row * XC_LD + j * 16 + l15;
          const float xv = xcF[idx];
          aL[idx] = av;
          xcF[idx] = mult * ig * xv;
        }
    }
  }
  __syncthreads();
  const int c = cb + lane;
  if (!sample) {
    float P = 1.f, h = 0.f;
    for (int rr = 0; rr < 32; rr++) {
      const float av = aL[(w * 32 + rr) * XC_LD + lane], bv = xcF[(w * 32 + rr) * XC_LD + lane];
      h = av * h + bv;
      P *= av;
    }
    aggL[(w * 64 + lane) * 2] = P;
    aggL[(w * 64 + lane) * 2 + 1] = h;
    __syncthreads();
    float* AGGP = (float*)(p.ws + W_AGG);
    float* AGGH = AGGP + 128 * 1024;
    if (mode == 0) {
      if (w == 0) {
        float Pt = 1.f, ht = 0.f;
#pragma unroll
        for (int q = 0; q < 4; q++) {
          const float Pq = aggL[(q * 64 + lane) * 2], hq = aggL[(q * 64 + lane) * 2 + 1];
          ht = Pq * ht + hq;
          Pt *= Pq;
        }
        AGGP[mt * 1024 + c] = Pt;
        AGGH[mt * 1024 + c] = ht;
      }
    } else {
      const int chunk = mt & 31, base = mt - chunk;
      float hin = 0.f;
      for (int q = 0; q < chunk; q++) hin = AGGP[(base + q) * 1024 + c] * hin + AGGH[(base + q) * 1024 + c];
      for (int q = 0; q < w; q++) hin = aggL[(q * 64 + lane) * 2] * hin + aggL[(q * 64 + lane) * 2 + 1];
      float hh = hin;
      u16* LO = (u16*)(p.ws + W_ZB);
      for (int rr = 0; rr < 32; rr++) {
        const int row = w * 32 + rr;
        const float av = aL[row * XC_LD + lane], bv = xcF[row * XC_LD + lane];
        hh = av * hh + bv;
        const float gr = bf2f(ZA[(size_t)(m0 + row) * 2048 + 1024 + c]);
        LO[(size_t)(m0 + row) * 1024 + c] = f2bf(hh * gelu_tanh(gr));
      }
      if (chunk == 31 && w == 3) p.out[O_LRUP + (size_t)(mt >> 5) * 1024 + c] = hh;
    }
  } else {
    float hh = 0.f;
    u16* LO = (u16*)(p.ws + W_ZB);
    for (int rr = 0; rr < 32; rr++) {
      const int row = w * 32 + rr;
      const int bb = (m0 - NP + row) >> 3;
      const int t = row & 7;
      if (t == 0) hh = p.state_lru[(size_t)bb * 1024 + c];
      const float av = aL[row * XC_LD + lane], bv = xcF[row * XC_LD + lane];
      hh = av * hh + bv;
      const float gr = bf2f(ZA[(size_t)(m0 + row) * 2048 + 1024 + c]);
      LO[(size_t)(m0 + row) * 1024 + c] = f2bf(hh * gelu_tanh(gr));
      if (t == 7) p.out[O_LRUS + (size_t)bb * 1024 + c] = hh;
    }
  }
}

__device__ void phase_g3(const Params& p, char* smem) {
  const int tid = threadIdx.x, lane = tid & 63, w = tid >> 6, wm = w >> 1, wn = w & 1, l15 = lane & 15, quad = lane >> 4;
  u16* As = (u16*)smem;
  u16* Bs = As + 128 * LDT;
  float* Cs = (float*)smem;
  const u16* LO = (const u16*)(p.ws + W_ZB);
  const u16* ATT = (const u16*)(p.ws + W_XN);
  const u16* WL = (const u16*)(p.ws + W_WTLRU);
  const u16* WA = (const u16*)(p.ws + W_WTATTN);
  const u16* ZC = (const u16*)p.out;
  u16* MG = (u16*)(p.ws + W_ZA);
  for (int t = blockIdx.x; t < MT * 8; t += gridDim.x) {
    const int mt = t >> 3, nt = t & 7;
    f32x4 acc[4][4], acc2[4][4];
    zero_acc(acc);
    gemm_tile(LO + (size_t)mt * 128 * 1024, 1024, WL + (size_t)nt * 128 * 1024, 1024, 1024, acc, As, Bs, tid);
#pragma unroll
    for (int i = 0; i < 4; i++)
#pragma unroll
      for (int j = 0; j < 4; j++)
#pragma unroll
        for (int e = 0; e < 4; e++) {
          const int row = mt * 128 + wm * 64 + i * 16 + quad * 4 + e, col = nt * 128 + wn * 64 + j * 16 + l15;
          acc[i][j][e] *= sigmoidf_(bf2f(ZC[(size_t)row * 2048 + col]));
        }
    zero_acc(acc2);
    gemm_tile(ATT + (size_t)mt * 128 * 1024, 1024, WA + (size_t)nt * 128 * 1024, 1024, 1024, acc2, As, Bs, tid);
#pragma unroll
    for (int i = 0; i < 4; i++)
#pragma unroll
      for (int j = 0; j < 4; j++)
#pragma unroll
        for (int e = 0; e < 4; e++) {
          const int row = mt * 128 + wm * 64 + i * 16 + quad * 4 + e, col = nt * 128 + wn * 64 + j * 16 + l15;
          acc[i][j][e] += acc2[i][j][e] * sigmoidf_(bf2f(ZC[(size_t)row * 2048 + 1024 + col]));
        }
    __syncthreads();
    acc_to_cs(acc, Cs, tid);
    __syncthreads();
    const int cc = (tid & 15) * 8;
#pragma unroll
    for (int i = 0; i < 8; i++) {
      const int r = (tid >> 4) + 16 * i;
      float4 a = *(const float4*)(Cs + r * CS_LD + cc), b = *(const float4*)(Cs + r * CS_LD + cc + 4);
      float v[8] = {a.x, a.y, a.z, a.w, b.x, b.y, b.z, b.w};
      *(uint4*)(MG + (size_t)(mt * 128 + r) * 1024 + nt * 128 + cc) = pack8(v);
    }
    __syncthreads();
  }
}

__device__ void phase_g4(const Params& p, char* smem) {
  const int tid = threadIdx.x;
  u16* As = (u16*)smem;
  u16* Bs = As + 128 * LDT;
  float* Cs = (float*)smem;
  const u16* MG = (const u16*)(p.ws + W_ZA);
  const u16* WO = (const u16*)(p.ws + W_WTOUT);
  u16* HG = (u16*)(p.ws + W_ZB);
  float* SSQ = (float*)(p.ws + W_SSQ);
  for (int t = blockIdx.x; t < MT * 8; t += gridDim.x) {
    const int mt = t >> 3, nt = t & 7;
    f32x4 acc[4][4];
    zero_acc(acc);
    gemm_tile(MG + (size_t)mt * 128 * 1024, 1024, WO + (size_t)nt * 128 * 1024, 1024, 1024, acc, As, Bs, tid);
    __syncthreads();
    acc_to_cs(acc, Cs, tid);
    __syncthreads();
    const int cc = (tid & 15) * 8;
    const float4 g0 = *(const float4*)(p.norm2_g + nt * 128 + cc), g1 = *(const float4*)(p.norm2_g + nt * 128 + cc + 4);
#pragma unroll
    for (int i = 0; i < 8; i++) {
      const int r = (tid >> 4) + 16 * i;
      const int row = mt * 128 + r;
      float4 a = *(const float4*)(Cs + r * CS_LD + cc), b = *(const float4*)(Cs + r * CS_LD + cc + 4);
      const float* xr = xrow(p, row) + nt * 128 + cc;
      float4 x0 = *(const float4*)xr, x1 = *(const float4*)(xr + 4);
      a.x += x0.x; a.y += x0.y; a.z += x0.z; a.w += x0.w;
      b.x += x1.x; b.y += x1.y; b.z += x1.z; b.w += x1.w;
      float* ho = p.out + O_Y + (size_t)row * 1024 + nt * 128 + cc;
      *(float4*)ho = a;
      *(float4*)(ho + 4) = b;
      float v[8] = {a.x * g0.x, a.y * g0.y, a.z * g0.z, a.w * g0.w, b.x * g1.x, b.y * g1.y, b.z * g1.z, b.w * g1.w};
      *(uint4*)(HG + (size_t)row * 1024 + nt * 128 + cc) = pack8(v);
      float ss = a.x * a.x + a.y * a.y + a.z * a.z + a.w * a.w + b.x * b.x + b.y * b.y + b.z * b.z + b.w * b.w;
      ss += __shfl_xor(ss, 1);
      ss += __shfl_xor(ss, 2);
      ss += __shfl_xor(ss, 4);
      ss += __shfl_xor(ss, 8);
      if ((tid & 15) == 0) SSQ[(size_t)row * 8 + nt] = ss;
    }
    __syncthreads();
  }
}

__device__ __forceinline__ float row_rstd(const float* SSQ, int row) {
  const float4 a = *(const float4*)(SSQ + (size_t)row * 8), b = *(const float4*)(SSQ + (size_t)row * 8 + 4);
  const float ss = ((a.x + a.y) + (a.z + a.w)) + ((b.x + b.y) + (b.z + b.w));
  return rsqrtf(ss * (1.f / 1024.f) + EPS);
}

__device__ void phase_g5(const Params& p, char* smem) {
  const int tid = threadIdx.x;
  u16* As = (u16*)smem;
  u16* Bs = As + 128 * LDT;
  float* Cs = (float*)smem;
  const u16* HG = (const u16*)(p.ws + W_ZB);
  const u16* WQ = (const u16*)(p.ws + W_WTQ);
  const float* SSQ = (const float*)(p.ws + W_SSQ);
  u16* QR = (u16*)(p.ws + W_ZA);
  for (int t = blockIdx.x; t < MT * 16; t += gridDim.x) {
    const int mt = t >> 4, nt = t & 15;
    f32x4 acc[4][4];
    zero_acc(acc);
    gemm_tile(HG + (size_t)mt * 128 * 1024, 1024, WQ + (size_t)nt * 128 * 1024, 1024, 1024, acc, As, Bs, tid);
    __syncthreads();
    acc_to_cs(acc, Cs, tid);
    __syncthreads();
    const int cc = (tid & 15) * 8;
#pragma unroll
    for (int i = 0; i < 8; i++) {
      const int r = (tid >> 4) + 16 * i;
      const int row = mt * 128 + r;
      const float rs = row_rstd(SSQ, row);
      float4 a = *(const float4*)(Cs + r * CS_LD + cc), b = *(const float4*)(Cs + r * CS_LD + cc + 4);
      float v[8] = {a.x * rs, a.y * rs, a.z * rs, a.w * rs, b.x * rs, b.y * rs, b.z * rs, b.w * rs};
      *(uint4*)(QR + (size_t)row * 2048 + nt * 128 + cc) = pack8(v);
    }
    __syncthreads();
  }
}

__device__ void phase_g6(const Params& p, char* smem) {
  const int tid = threadIdx.x;
  u16* As = (u16*)smem;
  u16* Bs = As + 128 * LDT;
  float* Cs = (float*)smem;
  uint32_t* Cu = (uint32_t*)smem;
  uint32_t* TK0 = (uint32_t*)(smem + 128 * CS_LD * 4);
  const u16* QR = (const u16*)(p.ws + W_ZA);
  const u16* SK = (const u16*)(p.ws + W_SK);
  int* IDX = (int*)(p.ws + W_XN);
  float* GW = (float*)(p.ws + W_XN + (size_t)NTOK * 128 * 4);
  const int row = tid >> 1, half = tid & 1;
  for (int t = blockIdx.x; t < MT * 8; t += gridDim.x) {
    const int mt = t >> 3, h = t & 7;
    uint32_t tk[16];
    for (int pp = 0; pp < 2; pp++) {
      f32x4 acc[4][4];
      zero_acc(acc);
      gemm_tile(QR + (size_t)mt * 128 * 2048 + h * 256 + pp * 128, 2048, SK + (size_t)(h * 2 + pp) * 16384, 128, 128, acc,
                As, Bs, tid);
      __syncthreads();
      acc_to_cs(acc, Cs, tid);
      __syncthreads();
#pragma unroll
      for (int q = 0; q < 16; q++) tk[q] = 0u;
      for (int cix = 0; cix < 64; cix++) {
        const int col = half * 64 + cix;
        const float v = Cs[row * CS_LD + col];
        const uint32_t key = (ordf(v) & ~0x7Fu) | (uint32_t)(127 - col);
        INS16(tk, key);
      }
      __syncthreads();
      if (half == 1) {
#pragma unroll
        for (int q = 0; q < 16; q++) Cu[row * 16 + q] = tk[q];
      }
      __syncthreads();
      if (half == 0) {
#pragma unroll
        for (int q = 0; q < 16; q++) {
          const uint32_t k2 = Cu[row * 16 + q];
          INS16(tk, k2);
        }
        if (pp == 0) {
#pragma unroll
          for (int q = 0; q < 16; q++) TK0[row * 16 + q] = tk[q];
        } else {
#pragma unroll
          for (int q = 0; q < 16; q++) Cu[2048 + row * 16 + q] = tk[q];
        }
      }
      __syncthreads();
    }
    if (half == 0) {
      float va[16], vb[16];
#pragma unroll
      for (int q = 0; q < 16; q++) {
        va[q] = unordf(TK0[row * 16 + q] & ~0x7Fu);
        vb[q] = unordf(tk[q] & ~0x7Fu);
      }
      uint32_t cd[16];
#pragma unroll
      for (int q = 0; q < 16; q++) cd[q] = 0u;
#pragma unroll
      for (int i = 0; i < 16; i++) {
#pragma unroll
        for (int j = 0; j < 16; j++) {
          if ((i + 1) * (j + 1) <= 16) {
            const float sv = va[i] + vb[j];
            const uint32_t key = (ordf(sv) & ~0xFFu) | (uint32_t)(i * 16 + j);
            INS16(cd, key);
          }
        }
      }
      float ev[16];
      const float m0v = unordf(cd[0] & ~0xFFu);
      float esum = 0.f;
#pragma unroll
      for (int q = 0; q < 16; q++) {
        ev[q] = __expf(unordf(cd[q] & ~0xFFu) - m0v);
        esum += ev[q];
      }
      const float inv = 1.f / esum;
      const size_t ob = (size_t)(mt * 128 + row) * 128 + h * 16;
#pragma unroll
      for (int q = 0; q < 16; q++) {
        const int ij = cd[q] & 0xFF;
        const int i0 = 127 - (int)(TK0[row * 16 + (ij >> 4)] & 0x7Fu);
        const int i1 = 127 - (int)(Cu[2048 + row * 16 + (ij & 15)] & 0x7Fu);
        IDX[ob + q] = i0 * 128 + i1;
        GW[ob + q] = ev[q] * inv;
      }
    }
    __syncthreads();
  }
}

__device__ __forceinline__ float dot16(const float* xh, uint4 u0, uint4 u1) {
  float a[8], b[8];
  unpack8(u0, a);
  unpack8(u1, b);
  float s = 0.f;
#pragma unroll
  for (int i = 0; i < 8; i++) s += xh[i] * a[i];
#pragma unroll
  for (int i = 0; i < 8; i++) s += xh[8 + i] * b[i];
  return s;
}

__device__ void phase7(const Params& p) {
  const int tid = threadIdx.x, lane = tid & 63, w = tid >> 6;
  const u16* HG = (const u16*)(p.ws + W_ZB);
  const float* SSQ = (const float*)(p.ws + W_SSQ);
  const int* IDX = (const int*)(p.ws + W_XN);
  const float* GW = (const float*)(p.ws + W_XN + (size_t)NTOK * 128 * 4);
  const u16* EU = (const u16*)(p.ws + W_EU);
  const u16* EV = (const u16*)(p.ws + W_EV);
  const int b0 = lane & 1, b1 = (lane >> 1) & 1, b2 = (lane >> 2) & 1;
  for (int tok = blockIdx.x * 4 + w; tok < NTOK; tok += gridDim.x * 4) {
    const float rs = row_rstd(SSQ, tok);
    float xh[16];
    {
      const uint4* hp = (const uint4*)(HG + (size_t)tok * 1024);
      unpack8(hp[lane], xh);
      unpack8(hp[64 + lane], xh + 8);
#pragma unroll
      for (int i = 0; i < 16; i++) xh[i] *= rs;
    }
    const int iA = IDX[(size_t)tok * 128 + lane], iB = IDX[(size_t)tok * 128 + 64 + lane];
    const float gA = GW[(size_t)tok * 128 + lane], gB = GW[(size_t)tok * 128 + 64 + lane];
    float dA = 0.f, dB = 0.f;
    for (int bb = 0; bb < 16; bb++) {
      const int isrc = bb < 8 ? iA : iB;
      float d[8];
#pragma unroll
      for (int k = 0; k < 8; k++) {
        const int id = __builtin_amdgcn_readlane(isrc, (bb & 7) * 8 + k);
        const uint4* up = (const uint4*)(EU + (size_t)id * 1024);
        d[k] = dot16(xh, up[lane], up[64 + lane]);
      }
      float e4[4], e2[2], e1;
#pragma unroll
      for (int i = 0; i < 4; i++) {
        const float keep = b0 ? d[2 * i + 1] : d[2 * i];
        const float send = b0 ? d[2 * i] : d[2 * i + 1];
        e4[i] = keep + __shfl_xor(send, 1);
      }
#pragma unroll
      for (int i = 0; i < 2; i++) {
        const float keep = b1 ? e4[2 * i + 1] : e4[2 * i];
        const float send = b1 ? e4[2 * i] : e4[2 * i + 1];
        e2[i] = keep + __shfl_xor(send, 2);
      }
      {
        const float keep = b2 ? e2[1] : e2[0];
        const float send = b2 ? e2[0] : e2[1];
        e1 = keep + __shfl_xor(send, 4);
      }
      e1 += __shfl_xor(e1, 8);
      e1 += __shfl_xor(e1, 16);
      e1 += __shfl_xor(e1, 32);
      const bool mine = (lane >> 3) == (bb & 7);
      if (bb < 8) dA = mine ? e1 : dA; else dB = mine ? e1 : dB;
    }
    const float actA = gelu_tanh(dA) * gA, actB = gelu_tanh(dB) * gB;
    float o[16];
#pragma unroll
    for (int i = 0; i < 16; i++) o[i] = 0.f;
    for (int bb = 0; bb < 16; bb++) {
      const int isrc = bb < 8 ? iA : iB;
      const float asrc = bb < 8 ? actA : actB;
#pragma unroll
      for (int k = 0; k < 8; k++) {
        const int id = __builtin_amdgcn_readlane(isrc, (bb & 7) * 8 + k);
        const float a = __uint_as_float(__builtin_amdgcn_readlane(__float_as_uint(asrc), (bb & 7) * 8 + k));
        const uint4* vp = (const uint4*)(EV + (size_t)id * 1024);
        float v0[8], v1[8];
        unpack8(vp[lane], v0);
        unpack8(vp[64 + lane], v1);
#pragma unroll
        for (int i = 0; i < 8; i++) { o[i] += a * v0[i]; o[8 + i] += a * v1[i]; }
      }
    }
    float* yo = p.out + O_Y + (size_t)tok * 1024;
    {
      float4 h0 = *(const float4*)(yo + lane * 8), h1 = *(const float4*)(yo + lane * 8 + 4);
      float4 h2 = *(const float4*)(yo + 512 + lane * 8), h3 = *(const float4*)(yo + 512 + lane * 8 + 4);
      h0.x += o[0]; h0.y += o[1]; h0.z += o[2]; h0.w += o[3];
      h1.x += o[4]; h1.y += o[5]; h1.z += o[6]; h1.w += o[7];
      h2.x += o[8]; h2.y += o[9]; h2.z += o[10]; h2.w += o[11];
      h3.x += o[12]; h3.y += o[13]; h3.z += o[14]; h3.w += o[15];
      *(float4*)(yo + lane * 8) = h0;
      *(float4*)(yo + lane * 8 + 4) = h1;
      *(float4*)(yo + 512 + lane * 8) = h2;
      *(float4*)(yo + 512 + lane * 8 + 4) = h3;
    }
  }
}

__global__ void __launch_bounds__(256) fwd_megakernel(Params p) {
  extern __shared__ __attribute__((aligned(16))) char smem[];
  cg::grid_group grid = cg::this_grid();
  phase0(p);
  grid.sync();
  phase_g1(p, smem);
  grid.sync();
  for (int it = blockIdx.x; it < 1536 + 2048; it += gridDim.x) {
    if (it < 1536) attn_item(p, smem, it);
    else { const int q = it - 1536; lru_tile(p, smem, q >> 4, q & 15, 0); }
  }
  grid.sync();
  for (int it = blockIdx.x; it < MT * 16; it += gridDim.x) lru_tile(p, smem, it >> 4, it & 15, 1);
  grid.sync();
  phase_g3(p, smem);
  grid.sync();
  phase_g4(p, smem);
  grid.sync();
  phase_g5(p, smem);
  grid.sync();
  phase_g6(p, smem);
  grid.sync();
  phase7(p);
}

extern "C" void kernel_launch(void* const* d_in, const int* in_sizes, int n_in, void* d_out, int out_size, void* d_ws,
                              size_t ws_size, hipStream_t stream) {
  static int grid_blocks = 0;
  if (!grid_blocks) {
    int dev = 0, cus = 0, per_cu = 0;
    hipGetDevice(&dev);
    hipDeviceGetAttribute(&cus, hipDeviceAttributeMultiprocessorCount, dev);
    hipFuncSetAttribute((const void*)fwd_megakernel, hipFuncAttributeMaxDynamicSharedMemorySize, SMEM_BYTES);
    hipOccupancyMaxActiveBlocksPerMultiprocessor(&per_cu, fwd_megakernel, 256, SMEM_BYTES);
    if (per_cu < 1) per_cu = 1;
    grid_blocks = cus * per_cu;
  }
  Params p{};
  const float** pp = (const float**)&p;
  for (int i = 0; i < 26; i++) pp[i] = (const float*)d_in[i];
  p.out = (float*)d_out;
  p.ws = (char*)d_ws;
  void* args[] = {&p};
  hipError_t e = hipLaunchCooperativeKernel((void*)fwd_megakernel, dim3(grid_blocks), dim3(256), args, SMEM_BYTES, stream);
  if (e != hipSuccess) fprintf(stderr, "cooperative launch failed: %s (grid %d)\n", hipGetErrorString(e), grid_blocks);
}
```

```cpp
#include <hip/hip_runtime.h>
#include <hip/hip_cooperative_groups.h>
#include <stdint.h>
#include <cstdio>
namespace cg = cooperative_groups;

typedef unsigned short u16;
typedef __attribute__((ext_vector_type(8))) short bf16x8;
typedef __attribute__((ext_vector_type(4))) float f32x4;

constexpr int D = 1024;
constexpr int NP = 16384;
constexpr int NTOK = 17408;
constexpr int SEQ = 4096;
constexpr int MT = 136;
constexpr float EPS = 1e-6f;

constexpr size_t O_Y = 0;
constexpr size_t O_CONVP = 17825792;
constexpr size_t O_LRUP = O_CONVP + 12288;
constexpr size_t O_KP = O_LRUP + 4096;
constexpr size_t O_VP = O_KP + 131072;
constexpr size_t O_CONVS = O_VP + 131072;
constexpr size_t O_LRUS = O_CONVS + 393216;
constexpr size_t O_KS = O_LRUS + 131072;
constexpr size_t O_VS = O_KS + 4194304;

constexpr size_t W_WTIN = 0;
constexpr size_t W_WTLRU = W_WTIN + (size_t)5632 * 1024 * 2;
constexpr size_t W_WTATTN = W_WTLRU + (size_t)1024 * 1024 * 2;
constexpr size_t W_WTOUT = W_WTATTN + (size_t)1024 * 1024 * 2;
constexpr size_t W_WTQ = W_WTOUT + (size_t)1024 * 1024 * 2;
constexpr size_t W_SK = W_WTQ + (size_t)2048 * 1024 * 2;
constexpr size_t W_RGA = W_SK + (size_t)16 * 128 * 128 * 2;
constexpr size_t W_RGX = W_RGA + (size_t)65536 * 2;
constexpr size_t W_EU = W_RGX + (size_t)65536 * 2;
constexpr size_t W_EV = W_EU + (size_t)16384 * 1024 * 2;
constexpr size_t W_XN = W_EV + (size_t)16384 * 1024 * 2;
constexpr size_t W_ZA = W_XN + (size_t)NTOK * 1024 * 2;
constexpr size_t W_ZB = W_ZA + (size_t)NTOK * 2048 * 2;
constexpr size_t W_AGG = W_ZB + (size_t)NTOK * 1536 * 2;
constexpr size_t W_SSQ = W_AGG + (size_t)128 * 1024 * 2 * 4;
constexpr size_t W_END = W_SSQ + (size_t)NTOK * 8 * 4;

constexpr int SMEM_BYTES = 81920;

struct Params {
  const float *x_prompt, *x_sample, *cache_conv, *state_lru, *cache_k, *cache_v, *norm1_g, *w_in, *conv_w,
      *conv_b, *rg_w_a, *rg_b_a, *rg_w_x, *rg_b_x, *rg_lambda, *q_norm_g, *k_norm_g, *attn_sinks,
      *w_branch_lru, *w_branch_attn, *w_out, *norm2_g, *peer_w_query, *peer_sub_keys, *expert_u, *expert_v;
  float* out;
  char* ws;
};

__device__ __forceinline__ u16 f2bf(float f) {
  uint32_t u = __float_as_uint(f);
  u += 0x7FFFu + ((u >> 16) & 1u);
  return (u16)(u >> 16);
}
__device__ __forceinline__ float bf2f(u16 h) { return __uint_as_float(((uint32_t)h) << 16); }
__device__ __forceinline__ uint32_t pack2(float a, float b) {
  return (uint32_t)f2bf(a) | ((uint32_t)f2bf(b) << 16);
}
__device__ __forceinline__ uint4 pack8(const float* v) {
  uint4 o;
  o.x = pack2(v[0], v[1]); o.y = pack2(v[2], v[3]); o.z = pack2(v[4], v[5]); o.w = pack2(v[6], v[7]);
  return o;
}
__device__ __forceinline__ void unpack8(uint4 u, float* v) {
  v[0] = __uint_as_float(u.x << 16); v[1] = __uint_as_float(u.x & 0xFFFF0000u);
  v[2] = __uint_as_float(u.y << 16); v[3] = __uint_as_float(u.y & 0xFFFF0000u);
  v[4] = __uint_as_float(u.z << 16); v[5] = __uint_as_float(u.z & 0xFFFF0000u);
  v[6] = __uint_as_float(u.w << 16); v[7] = __uint_as_float(u.w & 0xFFFF0000u);
}
__device__ __forceinline__ float sigmoidf_(float x) { return 1.f / (1.f + __expf(-x)); }
__device__ __forceinline__ float gelu_tanh(float x) {
  float y = 0.7978845608028654f * (x + 0.044715f * x * x * x);
  float t = 1.f - 2.f / (__expf(2.f * y) + 1.f);
  return 0.5f * x * (1.f + t);
}
__device__ __forceinline__ uint32_t ordf(float f) {
  uint32_t u = __float_as_uint(f);
  return (u & 0x80000000u) ? ~u : (u | 0x80000000u);
}
__device__ __forceinline__ float unordf(uint32_t o) {
  uint32_t u = (o & 0x80000000u) ? (o ^ 0x80000000u) : ~o;
  return __uint_as_float(u);
}
__device__ __forceinline__ const float* xrow(const Params& p, int row) {
  return row < NP ? p.x_prompt + (size_t)row * D : p.x_sample + (size_t)(row - NP) * D;
}

#define INS16(T, V)                                  \
  {                                                  \
    uint32_t _v = (V);                               \
    _Pragma("unroll") for (int _q = 0; _q < 16; _q++) { \
      uint32_t _hi = max(T[_q], _v);                 \
      _v = min(T[_q], _v);                           \
      T[_q] = _hi;                                   \
    }                                                \
  }

__device__ __forceinline__ void transpose_cvt(const float* __restrict__ W, u16* __restrict__ Wt, int K, int N,
                                              size_t gtid, size_t gsz) {
  size_t total = (size_t)N * (K / 8);
  for (size_t c = gtid; c < total; c += gsz) {
    int n = (int)(c % N);
    int kg = (int)(c / N);
    float v[8];
#pragma unroll
    for (int i = 0; i < 8; i++) v[i] = W[(size_t)(kg * 8 + i) * N + n];
    *(uint4*)(Wt + (size_t)n * K + kg * 8) = pack8(v);
  }
}
__device__ __forceinline__ void plain_cvt(const float* __restrict__ S, u16* __restrict__ Dst, size_t n, size_t gtid,
                                          size_t gsz) {
  size_t total = n / 8;
  const float4* s4 = (const float4*)S;
  for (size_t c = gtid; c < total; c += gsz) {
    float4 a = s4[2 * c], b = s4[2 * c + 1];
    float v[8] = {a.x, a.y, a.z, a.w, b.x, b.y, b.z, b.w};
    *(uint4*)(Dst + c * 8) = pack8(v);
  }
}

__device__ __forceinline__ void phase0(const Params& p) {
  const int tid = threadIdx.x;
  const size_t gtid = (size_t)blockIdx.x * 256 + tid, gsz = (size_t)gridDim.x * 256;
  char* ws = p.ws;
  {
    const int lane = tid & 63;
    const int gw = (int)(gtid >> 6), nw = (int)(gsz >> 6);
    u16* XN = (u16*)(ws + W_XN);
    for (int row = gw; row < NTOK; row += nw) {
      const float4* xr = (const float4*)xrow(p, row);
      float4 v[4];
      float ss = 0.f;
#pragma unroll
      for (int i = 0; i < 4; i++) {
        v[i] = xr[lane + i * 64];
        ss += v[i].x * v[i].x + v[i].y * v[i].y + v[i].z * v[i].z + v[i].w * v[i].w;
      }
#pragma unroll
      for (int o = 32; o > 0; o >>= 1) ss += __shfl_xor(ss, o);
      float rstd = rsqrtf(ss * (1.f / 1024.f) + EPS);
      const float4* g4 = (const float4*)p.norm1_g;
#pragma unroll
      for (int i = 0; i < 4; i++) {
        float4 g = g4[lane + i * 64];
        uint2 o;
        o.x = pack2(v[i].x * rstd * g.x, v[i].y * rstd * g.y);
        o.y = pack2(v[i].z * rstd * g.z, v[i].w * rstd * g.w);
        *(uint2*)(XN + (size_t)row * D + (lane + i * 64) * 4) = o;
      }
    }
  }
  transpose_cvt(p.w_in, (u16*)(ws + W_WTIN), 1024, 5632, gtid, gsz);
  transpose_cvt(p.w_branch_lru, (u16*)(ws + W_WTLRU), 1024, 1024, gtid, gsz);
  transpose_cvt(p.w_branch_attn, (u16*)(ws + W_WTATTN), 1024, 1024, gtid, gsz);
  transpose_cvt(p.w_out, (u16*)(ws + W_WTOUT), 1024, 1024, gtid, gsz);
  transpose_cvt(p.peer_w_query, (u16*)(ws + W_WTQ), 1024, 2048, gtid, gsz);
  {
    u16* RA = (u16*)(ws + W_RGA);
    u16* RX = (u16*)(ws + W_RGX);
    for (size_t e = gtid; e < 65536; e += gsz) {
      int n = (int)(e >> 12), k = (int)((e >> 6) & 63), j = (int)(e & 63);
      RA[e] = f2bf(p.rg_w_a[n * 4096 + j * 64 + k]);
      RX[e] = f2bf(p.rg_w_x[n * 4096 + j * 64 + k]);
    }
  }
  plain_cvt(p.peer_sub_keys, (u16*)(ws + W_SK), (size_t)16 * 128 * 128, gtid, gsz);
  plain_cvt(p.expert_u, (u16*)(ws + W_EU), (size_t)16384 * 1024, gtid, gsz);
  plain_cvt(p.expert_v, (u16*)(ws + W_EV), (size_t)16384 * 1024, gtid, gsz);
}

constexpr int LDT = 72;
constexpr int CS_LD = 132;

__device__ __forceinline__ void gemm_tile(const u16* __restrict__ A, int lda, const u16* __restrict__ Bt, int ldb,
                                          int K, f32x4 (&acc)[4][4], u16* As, u16* Bs, int tid) {
  const int lane = tid & 63, w = tid >> 6;
  const int wm = w >> 1, wn = w & 1;
  const int l15 = lane & 15, quad = lane >> 4;
  const int lrow = tid >> 3, lcol = (tid & 7) * 8;
  const u16* Ap = A + (size_t)lrow * lda + lcol;
  const u16* Bp = Bt + (size_t)lrow * ldb + lcol;
  const size_t sa = (size_t)32 * lda, sb = (size_t)32 * ldb;
  uint4 ra0 = *(const uint4*)(Ap), ra1 = *(const uint4*)(Ap + sa), ra2 = *(const uint4*)(Ap + 2 * sa),
        ra3 = *(const uint4*)(Ap + 3 * sa);
  uint4 rb0 = *(const uint4*)(Bp), rb1 = *(const uint4*)(Bp + sb), rb2 = *(const uint4*)(Bp + 2 * sb),
        rb3 = *(const uint4*)(Bp + 3 * sb);
  u16* Asw = As + lrow * LDT + lcol;
  u16* Bsw = Bs + lrow * LDT + lcol;
  for (int k0 = 0; k0 < K; k0 += 64) {
    __syncthreads();
    *(uint4*)(Asw) = ra0; *(uint4*)(Asw + 32 * LDT) = ra1; *(uint4*)(Asw + 64 * LDT) = ra2; *(uint4*)(Asw + 96 * LDT) = ra3;
    *(uint4*)(Bsw) = rb0; *(uint4*)(Bsw + 32 * LDT) = rb1; *(uint4*)(Bsw + 64 * LDT) = rb2; *(uint4*)(Bsw + 96 * LDT) = rb3;
    __syncthreads();
    if (k0 + 64 < K) {
      Ap += 64; Bp += 64;
      ra0 = *(const uint4*)(Ap); ra1 = *(const uint4*)(Ap + sa); ra2 = *(const uint4*)(Ap + 2 * sa); ra3 = *(const uint4*)(Ap + 3 * sa);
      rb0 = *(const uint4*)(Bp); rb1 = *(const uint4*)(Bp + sb); rb2 = *(const uint4*)(Bp + 2 * sb); rb3 = *(const uint4*)(Bp + 3 * sb);
    }
#pragma unroll
    for (int ks = 0; ks < 2; ks++) {
      bf16x8 a[4], b[4];
#pragma unroll
      for (int i = 0; i < 4; i++) {
        a[i] = *(const bf16x8*)(As + (wm * 64 + i * 16 + l15) * LDT + ks * 32 + quad * 8);
        b[i] = *(const bf16x8*)(Bs + (wn * 64 + i * 16 + l15) * LDT + ks * 32 + quad * 8);
      }
#pragma unroll
      for (int i = 0; i < 4; i++)
#pragma unroll
        for (int j = 0; j < 4; j++) acc[i][j] = __builtin_amdgcn_mfma_f32_16x16x32_bf16(a[i], b[j], acc[i][j], 0, 0, 0);
    }
  }
}

__device__ __forceinline__ void zero_acc(f32x4 (&acc)[4][4]) {
#pragma unroll
  for (int i = 0; i < 4; i++)
#pragma unroll
    for (int j = 0; j < 4; j++) acc[i][j] = (f32x4){0.f, 0.f, 0.f, 0.f};
}

__device__ __forceinline__ void acc_to_cs(const f32x4 (&acc)[4][4], float* Cs, int tid) {
  const int lane = tid & 63, w = tid >> 6;
  const int wm = w >> 1, wn = w & 1;
  const int l15 = lane & 15, quad = lane >> 4;
#pragma unroll
  for (int i = 0; i < 4; i++)
#pragma unroll
    for (int j = 0; j < 4; j++)
#pragma unroll
      for (int e = 0; e < 4; e++)
        Cs[(wm * 64 + i * 16 + quad * 4 + e) * CS_LD + wn * 64 + j * 16 + l15] = acc[i][j][e];
}

__device__ __forceinline__ void phase_g1(const Params& p, char* smem) {
  const int tid = threadIdx.x;
  u16* As = (u16*)smem;
  u16* Bs = As + 128 * LDT;
  float* Cs = (float*)smem;
  const u16* XN = (const u16*)(p.ws + W_XN);
  const u16* WT = (const u16*)(p.ws + W_WTIN);
  for (int t = blockIdx.x; t < MT * 44; t += gridDim.x) {
    const int mt = t / 44, nt = t % 44;
    f32x4 acc[4][4];
    zero_acc(acc);
    gemm_tile(XN + (size_t)mt * 128 * 1024, 1024, WT + (size_t)nt * 128 * 1024, 1024, 1024, acc, As, Bs, tid);
    __syncthreads();
    acc_to_cs(acc, Cs, tid);
    __syncthreads();
    const int n0 = nt * 128;
    u16* dst;
    int ldd, col;
    if (n0 < 2048) { dst = (u16*)(p.ws + W_ZA); ldd = 2048; col = n0; }
    else if (n0 < 3584) { dst = (u16*)(p.ws + W_ZB); ldd = 1536; col = n0 - 2048; }
    else { dst = (u16*)p.out; ldd = 2048; col = n0 - 3584; }
    const int cc = (tid & 15) * 8;
#pragma unroll
    for (int i = 0; i < 8; i++) {
      const int r = (tid >> 4) + 16 * i;
      float4 a = *(const float4*)(Cs + r * CS_LD + cc), b = *(const float4*)(Cs + r * CS_LD + cc + 4);
      float v[8] = {a.x, a.y, a.z, a.w, b.x, b.y, b.z, b.w};
      *(uint4*)(dst + (size_t)(mt * 128 + r) * ldd + col + cc) = pack8(v);
    }
    __syncthreads();
  }
}

constexpr int KS_LD = 72, VT_LD = 200, PS_LD = 168;
__device__ __forceinline__ void attn_item(const Params& p, char* smem, int item) {
  const int tid = threadIdx.x, lane = tid & 63, w = tid >> 6, l15 = lane & 15, quad = lane >> 4;
  u16* Ks = (u16*)smem;
  u16* Vt = Ks + 192 * KS_LD;
  u16* Ps = Vt + 64 * VT_LD + w * 16 * PS_LD;
  const u16* ZB = (const u16*)(p.ws + W_ZB);
  u16* ATT = (u16*)(p.ws + W_XN);
  const bool sample = item >= 1024;
  int b, qb = 0, kv, rowbase, p0 = 0;
  if (!sample) {
    kv = item & 3; qb = (item >> 2) & 63; b = item >> 8;
    p0 = qb * 64;
    rowbase = b * SEQ + p0;
  } else {
    int it = item - 1024;
    kv = it & 3; b = it >> 2;
    rowbase = NP + b * 8;
  }
  __syncthreads();
  {
    const int ch = tid & 7;
    float kg[8];
#pragma unroll
    for (int i = 0; i < 8; i++) kg[i] = p.k_norm_g[ch * 8 + i];
    const int nrows = sample ? 160 : 192;
    for (int c = tid; c < nrows * 8; c += 256) {
      const int row = c >> 3;
      float kf[8], vf[8];
      bool valid, donorm;
      if (!sample) {
        const int pos = p0 - 128 + row;
        valid = pos >= 0;
        donorm = true;
        if (valid) {
          const u16* src = ZB + (size_t)(b * SEQ + pos) * 1536 + 1024 + kv * 64 + ch * 8;
          unpack8(*(const uint4*)src, kf);
          unpack8(*(const uint4*)(src + 256), vf);
        }
      } else {
        valid = row < 136;
        donorm = row >= 128;
        if (row < 128) {
          const float* sk = p.cache_k + ((size_t)(b * 128 + row) * 4 + kv) * 64 + ch * 8;
          const float* sv = p.cache_v + ((size_t)(b * 128 + row) * 4 + kv) * 64 + ch * 8;
          float4 a0 = *(const float4*)sk, a1 = *(const float4*)(sk + 4);
          float4 b0 = *(const float4*)sv, b1 = *(const float4*)(sv + 4);
          kf[0] = a0.x; kf[1] = a0.y; kf[2] = a0.z; kf[3] = a0.w; kf[4] = a1.x; kf[5] = a1.y; kf[6] = a1.z; kf[7] = a1.w;
          vf[0] = b0.x; vf[1] = b0.y; vf[2] = b0.z; vf[3] = b0.w; vf[4] = b1.x; vf[5] = b1.y; vf[6] = b1.z; vf[7] = b1.w;
        } else if (valid) {
          const u16* src = ZB + (size_t)(NP + b * 8 + (row - 128)) * 1536 + 1024 + kv * 64 + ch * 8;
          unpack8(*(const uint4*)src, kf);
          unpack8(*(const uint4*)(src + 256), vf);
        }
      }
      if (!valid) {
#pragma unroll
        for (int i = 0; i < 8; i++) { kf[i] = 0.f; vf[i] = 0.f; }
      }
      float ss = 0.f;
#pragma unroll
      for (int i = 0; i < 8; i++) ss += kf[i] * kf[i];
      ss += __shfl_xor(ss, 1);
      ss += __shfl_xor(ss, 2);
      ss += __shfl_xor(ss, 4);
      if (donorm) {
        const float rstd = rsqrtf(ss * (1.f / 64.f) + EPS);
#pragma unroll
        for (int i = 0; i < 8; i++) kf[i] = kf[i] * rstd * kg[i];
      }
      *(uint4*)(Ks + row * KS_LD + ch * 8) = pack8(kf);
#pragma unroll
      for (int i = 0; i < 8; i++) Vt[(ch * 8 + i) * VT_LD + row] = f2bf(vf[i]);
      if (!sample) {
        if (qb >= 62 && row >= 128) {
          const int wpos = p0 + (row - 128) - (SEQ - 128);
          float* ko = p.out + O_KP + ((size_t)(b * 128 + wpos) * 4 + kv) * 64 + ch * 8;
          float* vo = p.out + O_VP + ((size_t)(b * 128 + wpos) * 4 + kv) * 64 + ch * 8;
          *(float4*)ko = make_float4(kf[0], kf[1], kf[2], kf[3]);
          *(float4*)(ko + 4) = make_float4(kf[4], kf[5], kf[6], kf[7]);
          *(float4*)vo = make_float4(vf[0], vf[1], vf[2], vf[3]);
          *(float4*)(vo + 4) = make_float4(vf[4], vf[5], vf[6], vf[7]);
        }
      } else {
        if (row >= 8 && row < 136) {
          float* ko = p.out + O_KS + ((size_t)(b * 128 + (row - 8)) * 4 + kv) * 64 + ch * 8;
          float* vo = p.out + O_VS + ((size_t)(b * 128 + (row - 8)) * 4 + kv) * 64 + ch * 8;
          *(float4*)ko = make_float4(kf[0], kf[1], kf[2], kf[3]);
          *(float4*)(ko + 4) = make_float4(kf[4], kf[5], kf[6], kf[7]);
          *(float4*)vo = make_float4(vf[0], vf[1], vf[2], vf[3]);
          *(float4*)(vo + 4) = make_float4(vf[4], vf[5], vf[6], vf[7]);
        }
      }
    }
  }
  __syncthreads();
  const int hq = kv * 4 + w;
  const float slope = exp2f(-0.5f * (float)(hq + 1));
  const float sink = p.attn_sinks[hq];
  float qg[2][8];
#pragma unroll
  for (int ks = 0; ks < 2; ks++)
#pragma unroll
    for (int i = 0; i < 8; i++) qg[ks][i] = p.q_norm_g[ks * 32 + quad * 8 + i] * 0.125f;
  const int nsub = sample ? 1 : 4;
  for (int sb = 0; sb < nsub; sb++) {
    const int r0 = sb * 16;
    const int ws0 = r0 < 32 ? r0 : 32;
    bf16x8 qa[2];
    {
      const int qr = sample ? (l15 & 7) : (r0 + l15);
      const u16* src = ZB + (size_t)(rowbase + qr) * 1536 + hq * 64 + quad * 8;
      float q0[8], q1[8];
      unpack8(*(const uint4*)src, q0);
      unpack8(*(const uint4*)(src + 32), q1);
      float ss = 0.f;
#pragma unroll
      for (int i = 0; i < 8; i++) ss += q0[i] * q0[i] + q1[i] * q1[i];
      ss += __shfl_xor(ss, 16);
      ss += __shfl_xor(ss, 32);
      const float rstd = rsqrtf(ss * (1.f / 64.f) + EPS);
#pragma unroll
      for (int i = 0; i < 8; i++) { q0[i] *= rstd * qg[0][i]; q1[i] *= rstd * qg[1][i]; }
      uint4 u0 = pack8(q0), u1 = pack8(q1);
      qa[0] = __builtin_bit_cast(bf16x8, u0);
      qa[1] = __builtin_bit_cast(bf16x8, u1);
    }
    f32x4 s[10];
#pragma unroll
    for (int kt = 0; kt < 10; kt++) {
      const u16* kp = Ks + (ws0 + kt * 16 + l15) * KS_LD + quad * 8;
      bf16x8 b0 = *(const bf16x8*)kp, b1 = *(const bf16x8*)(kp + 32);
      f32x4 z = {0.f, 0.f, 0.f, 0.f};
      z = __builtin_amdgcn_mfma_f32_16x16x32_bf16(qa[0], b0, z, 0, 0, 0);
      s[kt] = __builtin_amdgcn_mfma_f32_16x16x32_bf16(qa[1], b1, z, 0, 0, 0);
    }
    float mx[4] = {-1e30f, -1e30f, -1e30f, -1e30f};
#pragma unroll
    for (int kt = 0; kt < 10; kt++) {
      const int jj = ws0 + kt * 16 + l15;
      const bool posok = sample ? (jj < 136) : (p0 - 128 + jj >= 0);
#pragma unroll
      for (int e = 0; e < 4; e++) {
        const int r = r0 + quad * 4 + e;
        const int dist = r + 128 - jj;
        const bool ok = posok && dist >= 0 && dist <= 128;
        float v = ok ? (s[kt][e] - slope * (float)dist) : -1e30f;
        s[kt][e] = v;
        mx[e] = fmaxf(mx[e], v);
      }
    }
    float sum[4];
#pragma unroll
    for (int e = 0; e < 4; e++) {
      float m = mx[e];
      m = fmaxf(m, __shfl_xor(m, 1));
      m = fmaxf(m, __shfl_xor(m, 2));
      m = fmaxf(m, __shfl_xor(m, 4));
      m = fmaxf(m, __shfl_xor(m, 8));
      m = fmaxf(m, sink);
      mx[e] = m;
      sum[e] = 0.f;
    }
#pragma unroll
    for (int kt = 0; kt < 10; kt++) {
#pragma unroll
      for (int e = 0; e < 4; e++) {
        float pv = __expf(s[kt][e] - mx[e]);
        sum[e] += pv;
        Ps[(quad * 4 + e) * PS_LD + kt * 16 + l15] = f2bf(pv);
      }
    }
#pragma unroll
    for (int e = 0; e < 4; e++) {
      float t = sum[e];
      t += __shfl_xor(t, 1);
      t += __shfl_xor(t, 2);
      t += __shfl_xor(t, 4);
      t += __shfl_xor(t, 8);
      sum[e] = 1.f / (t + __expf(sink - mx[e]));
    }
    __syncthreads();
    f32x4 o[4];
#pragma unroll
    for (int nt = 0; nt < 4; nt++) o[nt] = (f32x4){0.f, 0.f, 0.f, 0.f};
#pragma unroll
    for (int kk = 0; kk < 5; kk++) {
      bf16x8 pa = *(const bf16x8*)(Ps + l15 * PS_LD + kk * 32 + quad * 8);
#pragma unroll
      for (int nt = 0; nt < 4; nt++) {
        bf16x8 vb = *(const bf16x8*)(Vt + (nt * 16 + l15) * VT_LD + ws0 + kk * 32 + quad * 8);
        o[nt] = __builtin_amdgcn_mfma_f32_16x16x32_bf16(pa, vb, o[nt], 0, 0, 0);
      }
    }
#pragma unroll
    for (int e = 0; e < 4; e++) {
      const int r = quad * 4 + e;
      if (!sample || r < 8) {
        u16* dst = ATT + (size_t)(rowbase + r0 + r) * 1024 + hq * 64 + l15;
#pragma unroll
        for (int nt = 0; nt < 4; nt++) dst[nt * 16] = f2bf(o[nt][e] * sum[e]);
      }
    }
    __syncthreads();
  }
}

constexpr int XC_LD = 68;
__device__ __forceinline__ void lru_tile(const Params& p, char* smem, int mt, int nb, int mode) {
  const int tid = threadIdx.x, lane = tid & 63, w = tid >> 6, l15 = lane & 15, quad = lane >> 4;
  float* xcF = (float*)smem;
  float* aL = xcF + 128 * XC_LD;
  float* aggL = aL + 128 * XC_LD;
  const u16* ZA = (const u16*)(p.ws + W_ZA);
  const bool sample = mt >= 128;
  const int m0 = mt * 128;
  const int cb = nb * 64;
  __syncthreads();
  {
    const int ch = tid & 7;
    float cw[4][8], cbias[8];
#pragma unroll
    for (int j = 0; j < 4; j++)
#pragma unroll
      for (int i = 0; i < 8; i++) cw[j][i] = p.conv_w[j * 1024 + cb + ch * 8 + i];
#pragma unroll
    for (int i = 0; i < 8; i++) cbias[i] = p.conv_b[cb + ch * 8 + i];
#pragma unroll
    for (int it = 0; it < 4; it++) {
      const int r = (tid >> 3) + it * 32;
      const int grow = m0 + r;
      const int t = sample ? (r & 7) : ((mt & 31) * 128 + r);
      float y[8];
#pragma unroll
      for (int i = 0; i < 8; i++) y[i] = cbias[i];
#pragma unroll
      for (int d = 0; d < 4; d++) {
        float xv[8];
        if (t - d >= 0) {
          unpack8(*(const uint4*)(ZA + (size_t)(grow - d) * 2048 + cb + ch * 8), xv);
        } else if (sample) {
          const int bb = (m0 - NP + r) >> 3;
          const float* src = p.cache_conv + ((size_t)bb * 3 + (3 + t - d)) * 1024 + cb + ch * 8;
          float4 a = *(const float4*)src, b4 = *(const float4*)(src + 4);
          xv[0] = a.x; xv[1] = a.y; xv[2] = a.z; xv[3] = a.w; xv[4] = b4.x; xv[5] = b4.y; xv[6] = b4.z; xv[7] = b4.w;
        } else {
#pragma unroll
          for (int i = 0; i < 8; i++) xv[i] = 0.f;
        }
#pragma unroll
        for (int i = 0; i < 8; i++) y[i] += cw[3 - d][i] * xv[i];
        if (d == 0 && mode == 1) {
          if (!sample) {
            if ((mt & 31) == 31 && r >= 125) {
              float* dst = p.out + O_CONVP + ((size_t)(mt >> 5) * 3 + (r - 125)) * 1024 + cb + ch * 8;
              *(float4*)dst = make_float4(xv[0], xv[1], xv[2], xv[3]);
              *(float4*)(dst + 4) = make_float4(xv[4], xv[5], xv[6], xv[7]);
            }
          } else if (t >= 5) {
            const int bb = (m0 - NP + r) >> 3;
            float* dst = p.out + O_CONVS + ((size_t)bb * 3 + (t - 5)) * 1024 + cb + ch * 8;
            *(float4*)dst = make_float4(xv[0], xv[1], xv[2], xv[3]);
            *(float4*)(dst + 4) = make_float4(xv[4], xv[5], xv[6], xv[7]);
          }
        }
      }
      *(float4*)(xcF + r * XC_LD + ch * 8) = make_float4(y[0], y[1], y[2], y[3]);
      *(float4*)(xcF + r * XC_LD + ch * 8 + 4) = make_float4(y[4], y[5], y[6], y[7]);
    }
  }
  __syncthreads();
  {
    const u16* RA = (const u16*)(p.ws + W_RGA) + nb * 4096;
    const u16* RX = (const u16*)(p.ws + W_RGX) + nb * 4096;
    f32x4 aR[2][4], aI[2][4];
#pragma unroll
    for (int i = 0; i < 2; i++)
#pragma unroll
      for (int j = 0; j < 4; j++) { aR[i][j] = (f32x4){0.f, 0.f, 0.f, 0.f}; aI[i][j] = (f32x4){0.f, 0.f, 0.f, 0.f}; }
#pragma unroll
    for (int ks = 0; ks < 2; ks++) {
      bf16x8 a[2];
#pragma unroll
      for (int i = 0; i < 2; i++) {
        const float* src = xcF + (w * 32 + i * 16 + l15) * XC_LD + ks * 32 + quad * 8;
        float4 x0 = *(const float4*)src, x1 = *(const float4*)(src + 4);
        float v[8] = {x0.x, x0.y, x0.z, x0.w, x1.x, x1.y, x1.z, x1.w};
        uint4 u = pack8(v);
        a[i] = __builtin_bit_cast(bf16x8, u);
      }
#pragma unroll
      for (int j = 0; j < 4; j++) {
        bf16x8 ba = *(const bf16x8*)(RA + (j * 16 + l15) * 64 + ks * 32 + quad * 8);
        bf16x8 bx = *(const bf16x8*)(RX + (j * 16 + l15) * 64 + ks * 32 + quad * 8);
#pragma unroll
        for (int i = 0; i < 2; i++) {
          aR[i][j] = __builtin_amdgcn_mfma_f32_16x16x32_bf16(a[i], ba, aR[i][j], 0, 0, 0);
          aI[i][j] = __builtin_amdgcn_mfma_f32_16x16x32_bf16(a[i], bx, aI[i][j], 0, 0, 0);
        }
      }
    }
#pragma unroll
    for (int j = 0; j < 4; j++) {
      const int c = cb + j * 16 + l15;
      const float ba = p.rg_b_a[c], bx = p.rg_b_x[c];
      const float ls = -log1pf(__expf(-p.rg_lambda[c]));
#pragma unroll
      for (int i = 0; i < 2; i++)
#pragma unroll
        for (int e = 0; e < 4; e++) {
          const int row = w * 32 + i * 16 + quad * 4 + e;
          const float rg = sigmoidf_(aR[i][j][e] + ba);
          const float ig = sigmoidf_(aI[i][j][e] + bx);
          const float la = 8.f * rg * ls;
          const float av = __expf(la);
          const float mult = sqrtf(fmaxf(-expm1f(2.f * la), 0.f));
          const int idx = row * XC_LD + j * 16 + l15;
          const float xv = xcF[idx];
          aL[idx] = av;
          xcF[idx] = mult * ig * xv;
        }
    }
  }
  __syncthreads();
  const int c = cb + lane;
  if (!sample) {
    float P = 1.f, h = 0.f;
    for (int rr = 0; rr < 32; rr++) {
      const float av = aL[(w * 32 + rr) * XC_LD + lane], bv = xcF[(w * 32 + rr) * XC_LD + lane];
      h = av * h + bv;
      P *= av;
    }
    aggL[(w * 64 + lane) * 2] = P;
    aggL[(w * 64 + lane) * 2 + 1] = h;
    __syncthreads();
    float* AGGP = (float*)(p.ws + W_AGG);
    float* AGGH = AGGP + 128 * 1024;
    if (mode == 0) {
      if (w == 0) {
        float Pt = 1.f, ht = 0.f;
#pragma unroll
        for (int q = 0; q < 4; q++) {
          const float Pq = aggL[(q * 64 + lane) * 2], hq = aggL[(q * 64 + lane) * 2 + 1];
          ht = Pq * ht + hq;
          Pt *= Pq;
        }
        AGGP[mt * 1024 + c] = Pt;
        AGGH[mt * 1024 + c] = ht;
      }
    } else {
      const int chunk = mt & 31, base = mt - chunk;
      float hin = 0.f;
      for (int q = 0; q < chunk; q++) hin = AGGP[(base + q) * 1024 + c] * hin + AGGH[(base + q) * 1024 + c];
      for (int q = 0; q < w; q++) hin = aggL[(q * 64 + lane) * 2] * hin + aggL[(q * 64 + lane) * 2 + 1];
      float hh = hin;
      u16* LO = (u16*)(p.ws + W_ZB);
      for (int rr = 0; rr < 32; rr++) {
        const int row = w * 32 + rr;
        const float av = aL[row * XC_LD + lane], bv = xcF[row * XC_LD + lane];
        hh = av * hh + bv;
        const float gr = bf2f(ZA[(size_t)(m0 + row) * 2048 + 1024 + c]);
        LO[(size_t)(m0 + row) * 1024 + c] = f2bf(hh * gelu_tanh(gr));
      }
      if (chunk == 31 && w == 3) p.out[O_LRUP + (size_t)(mt >> 5) * 1024 + c] = hh;
    }
  } else {
    float hh = 0.f;
    u16* LO = (u16*)(p.ws + W_ZB);
    for (int rr = 0; rr < 32; rr++) {
      const int row = w * 32 + rr;
      const int bb = (m0 - NP + row) >> 3;
      const int t = row & 7;
      if (t == 0) hh = p.state_lru[(size_t)bb * 1024 + c];
      const float av = aL[row * XC_LD + lane], bv = xcF[row * XC_LD + lane];
      hh = av * hh + bv;
      const float gr = bf2f(ZA[(size_t)(m0 + row) * 2048 + 1024 + c]);
      LO[(size_t)(m0 + row) * 1024 + c] = f2bf(hh * gelu_tanh(gr));
      if (t == 7) p.out[O_LRUS + (size_t)bb * 1024 + c] = hh;
    }
  }
}

__device__ __forceinline__ void phase_g3(const Params& p, char* smem) {
  const int tid = threadIdx.x;
  u16* As = (u16*)smem;
  u16* Bs = As + 128 * LDT;
  float* Cs = (float*)smem;
  const u16* LO = (const u16*)(p.ws + W_ZB);
  const u16* ATT = (const u16*)(p.ws + W_XN);
  const u16* WL = (const u16*)(p.ws + W_WTLRU);
  const u16* WA = (const u16*)(p.ws + W_WTATTN);
  const u16* ZC = (const u16*)p.out;
  u16* MG = (u16*)(p.ws + W_ZA);
  for (int t = blockIdx.x; t < MT * 8; t += gridDim.x) {
    const int mt = t >> 3, nt = t & 7;
    const int cc = (tid & 15) * 8;
#pragma unroll 1
    for (int pass = 0; pass < 2; pass++) {
      f32x4 acc[4][4];
      zero_acc(acc);
      gemm_tile((pass ? ATT : LO) + (size_t)mt * 128 * 1024, 1024, (pass ? WA : WL) + (size_t)nt * 128 * 1024, 1024, 1024,
                acc, As, Bs, tid);
      __syncthreads();
      acc_to_cs(acc, Cs, tid);
      __syncthreads();
#pragma unroll
      for (int i = 0; i < 8; i++) {
        const int r = (tid >> 4) + 16 * i;
        const size_t row = (size_t)(mt * 128 + r);
        float4 a = *(const float4*)(Cs + r * CS_LD + cc), b = *(const float4*)(Cs + r * CS_LD + cc + 4);
        float v[8] = {a.x, a.y, a.z, a.w, b.x, b.y, b.z, b.w};
        float g[8];
        unpack8(*(const uint4*)(ZC + row * 2048 + pass * 1024 + nt * 128 + cc), g);
        u16* mp = MG + row * 1024 + nt * 128 + cc;
        if (pass == 0) {
#pragma unroll
          for (int q = 0; q < 8; q++) v[q] *= sigmoidf_(g[q]);
        } else {
          float pv[8];
          unpack8(*(const uint4*)mp, pv);
#pragma unroll
          for (int q = 0; q < 8; q++) v[q] = pv[q] + v[q] * sigmoidf_(g[q]);
        }
        *(uint4*)mp = pack8(v);
      }
      __syncthreads();
    }
  }
}

__device__ __forceinline__ void phase_g4(const Params& p, char* smem) {
  const int tid = threadIdx.x;
  u16* As = (u16*)smem;
  u16* Bs = As + 128 * LDT;
  float* Cs = (float*)smem;
  const u16* MG = (const u16*)(p.ws + W_ZA);
  const u16* WO = (const u16*)(p.ws + W_WTOUT);
  u16* HG = (u16*)(p.ws + W_ZB);
  float* SSQ = (float*)(p.ws + W_SSQ);
  for (int t = blockIdx.x; t < MT * 8; t += gridDim.x) {
    const int mt = t >> 3, nt = t & 7;
    f32x4 acc[4][4];
    zero_acc(acc);
    gemm_tile(MG + (size_t)mt * 128 * 1024, 1024, WO + (size_t)nt * 128 * 1024, 1024, 1024, acc, As, Bs, tid);
    __syncthreads();
    acc_to_cs(acc, Cs, tid);
    __syncthreads();
    const int cc = (tid & 15) * 8;
    const float4 g0 = *(const float4*)(p.norm2_g + nt * 128 + cc), g1 = *(const float4*)(p.norm2_g + nt * 128 + cc + 4);
#pragma unroll
    for (int i = 0; i < 8; i++) {
      const int r = (tid >> 4) + 16 * i;
      const int row = mt * 128 + r;
      float4 a = *(const float4*)(Cs + r * CS_LD + cc), b = *(const float4*)(Cs + r * CS_LD + cc + 4);
      const float* xr = xrow(p, row) + nt * 128 + cc;
      float4 x0 = *(const float4*)xr, x1 = *(const float4*)(xr + 4);
      a.x += x0.x; a.y += x0.y; a.z += x0.z; a.w += x0.w;
      b.x += x1.x; b.y += x1.y; b.z += x1.z; b.w += x1.w;
      float* ho = p.out + O_Y + (size_t)row * 1024 + nt * 128 + cc;
      *(float4*)ho = a;
      *(float4*)(ho + 4) = b;
      float v[8] = {a.x * g0.x, a.y * g0.y, a.z * g0.z, a.w * g0.w, b.x * g1.x, b.y * g1.y, b.z * g1.z, b.w * g1.w};
      *(uint4*)(HG + (size_t)row * 1024 + nt * 128 + cc) = pack8(v);
      float ss = a.x * a.x + a.y * a.y + a.z * a.z + a.w * a.w + b.x * b.x + b.y * b.y + b.z * b.z + b.w * b.w;
      ss += __shfl_xor(ss, 1);
      ss += __shfl_xor(ss, 2);
      ss += __shfl_xor(ss, 4);
      ss += __shfl_xor(ss, 8);
      if ((tid & 15) == 0) SSQ[(size_t)row * 8 + nt] = ss;
    }
    __syncthreads();
  }
}

__device__ __forceinline__ float row_rstd(const float* SSQ, int row) {
  const float4 a = *(const float4*)(SSQ + (size_t)row * 8), b = *(const float4*)(SSQ + (size_t)row * 8 + 4);
  const float ss = ((a.x + a.y) + (a.z + a.w)) + ((b.x + b.y) + (b.z + b.w));
  return rsqrtf(ss * (1.f / 1024.f) + EPS);
}

__device__ __forceinline__ void phase_g5(const Params& p, char* smem) {
  const int tid = threadIdx.x;
  u16* As = (u16*)smem;
  u16* Bs = As + 128 * LDT;
  float* Cs = (float*)smem;
  const u16* HG = (const u16*)(p.ws + W_ZB);
  const u16* WQ = (const u16*)(p.ws + W_WTQ);
  const float* SSQ = (const float*)(p.ws + W_SSQ);
  u16* QR = (u16*)(p.ws + W_ZA);
  for (int t = blockIdx.x; t < MT * 16; t += gridDim.x) {
    const int mt = t >> 4, nt = t & 15;
    f32x4 acc[4][4];
    zero_acc(acc);
    gemm_tile(HG + (size_t)mt * 128 * 1024, 1024, WQ + (size_t)nt * 128 * 1024, 1024, 1024, acc, As, Bs, tid);
    __syncthreads();
    acc_to_cs(acc, Cs, tid);
    __syncthreads();
    const int cc = (tid & 15) * 8;
#pragma unroll
    for (int i = 0; i < 8; i++) {
      const int r = (tid >> 4) + 16 * i;
      const int row = mt * 128 + r;
      const float rs = row_rstd(SSQ, row);
      float4 a = *(const float4*)(Cs + r * CS_LD + cc), b = *(const float4*)(Cs + r * CS_LD + cc + 4);
      float v[8] = {a.x * rs, a.y * rs, a.z * rs, a.w * rs, b.x * rs, b.y * rs, b.z * rs, b.w * rs};
      *(uint4*)(QR + (size_t)row * 2048 + nt * 128 + cc) = pack8(v);
    }
    __syncthreads();
  }
}

__device__ __forceinline__ void phase_g6(const Params& p, char* smem) {
  const int tid = threadIdx.x;
  u16* As = (u16*)smem;
  u16* Bs = As + 128 * LDT;
  float* Cs = (float*)smem;
  uint32_t* Cu = (uint32_t*)smem;
  uint32_t* TK0 = (uint32_t*)(smem + 128 * CS_LD * 4);
  const u16* QR = (const u16*)(p.ws + W_ZA);
  const u16* SK = (const u16*)(p.ws + W_SK);
  int* IDX = (int*)(p.ws + W_XN);
  float* GW = (float*)(p.ws + W_XN + (size_t)NTOK * 128 * 4);
  const int row = tid >> 1, half = tid & 1;
  for (int t = blockIdx.x; t < MT * 8; t += gridDim.x) {
    const int mt = t >> 3, h = t & 7;
    uint32_t tk[16];
    for (int pp = 0; pp < 2; pp++) {
      f32x4 acc[4][4];
      zero_acc(acc);
      gemm_tile(QR + (size_t)mt * 128 * 2048 + h * 256 + pp * 128, 2048, SK + (size_t)(h * 2 + pp) * 16384, 128, 128, acc,
                As, Bs, tid);
      __syncthreads();
      acc_to_cs(acc, Cs, tid);
      __syncthreads();
#pragma unroll
      for (int q = 0; q < 16; q++) tk[q] = 0u;
      for (int cix = 0; cix < 64; cix++) {
        const int col = half * 64 + cix;
        const float v = Cs[row * CS_LD + col];
        const uint32_t key = (ordf(v) & ~0x7Fu) | (uint32_t)(127 - col);
        INS16(tk, key);
      }
      __syncthreads();
      if (half == 1) {
#pragma unroll
        for (int q = 0; q < 16; q++) Cu[row * 16 + q] = tk[q];
      }
      __syncthreads();
      if (half == 0) {
#pragma unroll
        for (int q = 0; q < 16; q++) {
          const uint32_t k2 = Cu[row * 16 + q];
          INS16(tk, k2);
        }
        if (pp == 0) {
#pragma unroll
          for (int q = 0; q < 16; q++) TK0[row * 16 + q] = tk[q];
        } else {
#pragma unroll
          for (int q = 0; q < 16; q++) Cu[2048 + row * 16 + q] = tk[q];
        }
      }
      __syncthreads();
    }
    if (half == 0) {
      float va[16], vb[16];
#pragma unroll
      for (int q = 0; q < 16; q++) {
        va[q] = unordf(TK0[row * 16 + q] & ~0x7Fu);
        vb[q] = unordf(tk[q] & ~0x7Fu);
      }
      uint32_t cd[16];
#pragma unroll
      for (int q = 0; q < 16; q++) cd[q] = 0u;
#pragma unroll
      for (int i = 0; i < 16; i++) {
#pragma unroll
        for (int j = 0; j < 16; j++) {
          if ((i + 1) * (j + 1) <= 16) {
            const float sv = va[i] + vb[j];
            const uint32_t key = (ordf(sv) & ~0xFFu) | (uint32_t)(i * 16 + j);
            INS16(cd, key);
          }
        }
      }
      float ev[16];
      const float m0v = unordf(cd[0] & ~0xFFu);
      float esum = 0.f;
#pragma unroll
      for (int q = 0; q < 16; q++) {
        ev[q] = __expf(unordf(cd[q] & ~0xFFu) - m0v);
        esum += ev[q];
      }
      const float inv = 1.f / esum;
      const size_t ob = (size_t)(mt * 128 + row) * 128 + h * 16;
#pragma unroll
      for (int q = 0; q < 16; q++) {
        const int ij = cd[q] & 0xFF;
        const int i0 = 127 - (int)(TK0[row * 16 + (ij >> 4)] & 0x7Fu);
        const int i1 = 127 - (int)(Cu[2048 + row * 16 + (ij & 15)] & 0x7Fu);
        IDX[ob + q] = i0 * 128 + i1;
        GW[ob + q] = ev[q] * inv;
      }
    }
    __syncthreads();
  }
}

__device__ __forceinline__ float dot16(const float* xh, uint4 u0, uint4 u1) {
  float a[8], b[8];
  unpack8(u0, a);
  unpack8(u1, b);
  float s = 0.f;
#pragma unroll
  for (int i = 0; i < 8; i++) s += xh[i] * a[i];
#pragma unroll
  for (int i = 0; i < 8; i++) s += xh[8 + i] * b[i];
  return s;
}

__device__ __forceinline__ void phase7(const Params& p) {
  const int tid = threadIdx.x, lane = tid & 63, w = tid >> 6;
  const u16* HG = (const u16*)(p.ws + W_ZB);
  const float* SSQ = (const float*)(p.ws + W_SSQ);
  const int* IDX = (const int*)(p.ws + W_XN);
  const float* GW = (const float*)(p.ws + W_XN + (size_t)NTOK * 128 * 4);
  const u16* EU = (const u16*)(p.ws + W_EU);
  const u16* EV = (const u16*)(p.ws + W_EV);
  const int b0 = lane & 1, b1 = (lane >> 1) & 1, b2 = (lane >> 2) & 1;
  for (int tok = blockIdx.x * 4 + w; tok < NTOK; tok += gridDim.x * 4) {
    const float rs = row_rstd(SSQ, tok);
    float xh[16];
    {
      const uint4* hp = (const uint4*)(HG + (size_t)tok * 1024);
      unpack8(hp[lane], xh);
      unpack8(hp[64 + lane], xh + 8);
#pragma unroll
      for (int i = 0; i < 16; i++) xh[i] *= rs;
    }
    const int iA = IDX[(size_t)tok * 128 + lane], iB = IDX[(size_t)tok * 128 + 64 + lane];
    const float gA = GW[(size_t)tok * 128 + lane], gB = GW[(size_t)tok * 128 + 64 + lane];
    float dA = 0.f, dB = 0.f;
    for (int bb = 0; bb < 16; bb++) {
      const int isrc = bb < 8 ? iA : iB;
      float d[8];
#pragma unroll
      for (int k = 0; k < 8; k++) {
        const int id = __builtin_amdgcn_readlane(isrc, (bb & 7) * 8 + k);
        const uint4* up = (const uint4*)(EU + (size_t)id * 1024);
        d[k] = dot16(xh, up[lane], up[64 + lane]);
      }
      float e4[4], e2[2], e1;
#pragma unroll
      for (int i = 0; i < 4; i++) {
        const float keep = b0 ? d[2 * i + 1] : d[2 * i];
        const float send = b0 ? d[2 * i] : d[2 * i + 1];
        e4[i] = keep + __shfl_xor(send, 1);
      }
#pragma unroll
      for (int i = 0; i < 2; i++) {
        const float keep = b1 ? e4[2 * i + 1] : e4[2 * i];
        const float send = b1 ? e4[2 * i] : e4[2 * i + 1];
        e2[i] = keep + __shfl_xor(send, 2);
      }
      {
        const float keep = b2 ? e2[1] : e2[0];
        const float send = b2 ? e2[0] : e2[1];
        e1 = keep + __shfl_xor(send, 4);
      }
      e1 += __shfl_xor(e1, 8);
      e1 += __shfl_xor(e1, 16);
      e1 += __shfl_xor(e1, 32);
      const bool mine = (lane >> 3) == (bb & 7);
      if (bb < 8) dA = mine ? e1 : dA; else dB = mine ? e1 : dB;
    }
    const float actA = gelu_tanh(dA) * gA, actB = gelu_tanh(dB) * gB;
    float o[16];
#pragma unroll
    for (int i = 0; i < 16; i++) o[i] = 0.f;
    for (int bb = 0; bb < 16; bb++) {
      const int isrc = bb < 8 ? iA : iB;
      const float asrc = bb < 8 ? actA : actB;
#pragma unroll
      for (int k = 0; k < 8; k++) {
        const int id = __builtin_amdgcn_readlane(isrc, (bb & 7) * 8 + k);
        const float a = __uint_as_float(__builtin_amdgcn_readlane(__float_as_uint(asrc), (bb & 7) * 8 + k));
        const uint4* vp = (const uint4*)(EV + (size_t)id * 1024);
        float v0[8], v1[8];
        unpack8(vp[lane], v0);
        unpack8(vp[64 + lane], v1);
#pragma unroll
        for (int i = 0; i < 8; i++) { o[i] += a * v0[i]; o[8 + i] += a * v1[i]; }
      }
    }
    float* yo = p.out + O_Y + (size_t)tok * 1024;
    {
      float4 h0 = *(const float4*)(yo + lane * 8), h1 = *(const float4*)(yo + lane * 8 + 4);
      float4 h2 = *(const float4*)(yo + 512 + lane * 8), h3 = *(const float4*)(yo + 512 + lane * 8 + 4);
      h0.x += o[0]; h0.y += o[1]; h0.z += o[2]; h0.w += o[3];
      h1.x += o[4]; h1.y += o[5]; h1.z += o[6]; h1.w += o[7];
      h2.x += o[8]; h2.y += o[9]; h2.z += o[10]; h2.w += o[11];
      h3.x += o[12]; h3.y += o[13]; h3.z += o[14]; h3.w += o[15];
      *(float4*)(yo + lane * 8) = h0;
      *(float4*)(yo + lane * 8 + 4) = h1;
      *(float4*)(yo + 512 + lane * 8) = h2;
      *(float4*)(yo + 512 + lane * 8 + 4) = h3;
    }
  }
}

__global__ void __launch_bounds__(256, 2) fwd_megakernel(Params p) {
  extern __shared__ __attribute__((aligned(16))) char smem[];
  cg::grid_group grid = cg::this_grid();
  phase0(p);
  grid.sync();
  phase_g1(p, smem);
  grid.sync();
  for (int it = blockIdx.x; it < 1536 + 2048; it += gridDim.x) {
    if (it < 1536) attn_item(p, smem, it);
    else { const int q = it - 1536; lru_tile(p, smem, q >> 4, q & 15, 0); }
  }
  grid.sync();
  for (int it = blockIdx.x; it < MT * 16; it += gridDim.x) lru_tile(p, smem, it >> 4, it & 15, 1);
  grid.sync();
  phase_g3(p, smem);
  grid.sync();
  phase_g4(p, smem);
  grid.sync();
  phase_g5(p, smem);
  grid.sync();
  phase_g6(p, smem);
  grid.sync();
  phase7(p);
}

extern "C" void kernel_launch(void* const* d_in, const int* in_sizes, int n_in, void* d_out, int out_size, void* d_ws,
                              size_t ws_size, hipStream_t stream) {
  static int grid_blocks = 0;
  if (!grid_blocks) {
    int dev = 0, cus = 0, per_cu = 0;
    hipGetDevice(&dev);
    hipDeviceGetAttribute(&cus, hipDeviceAttributeMultiprocessorCount, dev);
    hipFuncSetAttribute((const void*)fwd_megakernel, hipFuncAttributeMaxDynamicSharedMemorySize, SMEM_BYTES);
    hipOccupancyMaxActiveBlocksPerMultiprocessor(&per_cu, fwd_megakernel, 256, SMEM_BYTES);
    if (per_cu < 1) per_cu = 1;
    grid_blocks = cus * per_cu;
  }
  Params p{};
  const float** pp = (const float**)&p;
  for (int i = 0; i < 26; i++) pp[i] = (const float*)d_in[i];
  p.out = (float*)d_out;
  p.ws = (char*)d_ws;
  void* args[] = {&p};
  hipError_t e = hipLaunchCooperativeKernel((void*)fwd_megakernel, dim3(grid_blocks), dim3(256), args, SMEM_BYTES, stream);
  if (e != hipSuccess) fprintf(stderr, "cooperative launch failed: %s (grid %d)\n", hipGetErrorString(e), grid_blocks);
}
```

```cpp
#include <hip/hip_runtime.h>
#include <hip/hip_cooperative_groups.h>
#include <stdint.h>
#include <cstdio>
namespace cg = cooperative_groups;

typedef unsigned short u16;
typedef __attribute__((ext_vector_type(8))) short bf16x8;
typedef __attribute__((ext_vector_type(4))) float f32x4;

constexpr int D = 1024;
constexpr int NP = 16384;
constexpr int NTOK = 17408;
constexpr int SEQ = 4096;
constexpr int MT = 136;
constexpr float EPS = 1e-6f;

constexpr size_t O_Y = 0;
constexpr size_t O_CONVP = 17825792;
constexpr size_t O_LRUP = O_CONVP + 12288;
constexpr size_t O_KP = O_LRUP + 4096;
constexpr size_t O_VP = O_KP + 131072;
constexpr size_t O_CONVS = O_VP + 131072;
constexpr size_t O_LRUS = O_CONVS + 393216;
constexpr size_t O_KS = O_LRUS + 131072;
constexpr size_t O_VS = O_KS + 4194304;

constexpr size_t W_WTIN = 0;
constexpr size_t W_WTLRU = W_WTIN + (size_t)5632 * 1024 * 2;
constexpr size_t W_WTATTN = W_WTLRU + (size_t)1024 * 1024 * 2;
constexpr size_t W_WTOUT = W_WTATTN + (size_t)1024 * 1024 * 2;
constexpr size_t W_WTQ = W_WTOUT + (size_t)1024 * 1024 * 2;
constexpr size_t W_SK = W_WTQ + (size_t)2048 * 1024 * 2;
constexpr size_t W_RGA = W_SK + (size_t)16 * 128 * 128 * 2;
constexpr size_t W_RGX = W_RGA + (size_t)65536 * 2;
constexpr size_t W_EU = W_RGX + (size_t)65536 * 2;
constexpr size_t W_EV = W_EU + (size_t)16384 * 1024;
constexpr size_t W_ESC = W_EV + (size_t)16384 * 1024;
constexpr size_t W_XN = W_ESC + (size_t)32768 * 4;
constexpr size_t W_ZA = W_XN + (size_t)NTOK * 1024 * 2;
constexpr size_t W_ZB = W_ZA + (size_t)NTOK * 2048 * 2;
constexpr size_t W_AGG = W_ZB + (size_t)NTOK * 1536 * 2;
constexpr size_t W_SSQ = W_AGG + (size_t)128 * 1024 * 2 * 4;
constexpr size_t W_END = W_SSQ + (size_t)NTOK * 8 * 4;

constexpr int SMEM_BYTES = 81920;

struct Params {
  const float *x_prompt, *x_sample, *cache_conv, *state_lru, *cache_k, *cache_v, *norm1_g, *w_in, *conv_w,
      *conv_b, *rg_w_a, *rg_b_a, *rg_w_x, *rg_b_x, *rg_lambda, *q_norm_g, *k_norm_g, *attn_sinks,
      *w_branch_lru, *w_branch_attn, *w_out, *norm2_g, *peer_w_query, *peer_sub_keys, *expert_u, *expert_v;
  float* out;
  char* ws;
};

__device__ __forceinline__ u16 f2bf(float f) {
  uint32_t u = __float_as_uint(f);
  u += 0x7FFFu + ((u >> 16) & 1u);
  return (u16)(u >> 16);
}
__device__ __forceinline__ float bf2f(u16 h) { return __uint_as_float(((uint32_t)h) << 16); }
__device__ __forceinline__ uint32_t pack2(float a, float b) {
  return (uint32_t)f2bf(a) | ((uint32_t)f2bf(b) << 16);
}
__device__ __forceinline__ uint4 pack8(const float* v) {
  uint4 o;
  o.x = pack2(v[0], v[1]); o.y = pack2(v[2], v[3]); o.z = pack2(v[4], v[5]); o.w = pack2(v[6], v[7]);
  return o;
}
__device__ __forceinline__ void unpack8(uint4 u, float* v) {
  v[0] = __uint_as_float(u.x << 16); v[1] = __uint_as_float(u.x & 0xFFFF0000u);
  v[2] = __uint_as_float(u.y << 16); v[3] = __uint_as_float(u.y & 0xFFFF0000u);
  v[4] = __uint_as_float(u.z << 16); v[5] = __uint_as_float(u.z & 0xFFFF0000u);
  v[6] = __uint_as_float(u.w << 16); v[7] = __uint_as_float(u.w & 0xFFFF0000u);
}
__device__ __forceinline__ float sigmoidf_(float x) { return 1.f / (1.f + __expf(-x)); }
__device__ __forceinline__ float gelu_tanh(float x) {
  float y = 0.7978845608028654f * (x + 0.044715f * x * x * x);
  float t = 1.f - 2.f / (__expf(2.f * y) + 1.f);
  return 0.5f * x * (1.f + t);
}
__device__ __forceinline__ uint32_t ordf(float f) {
  uint32_t u = __float_as_uint(f);
  return (u & 0x80000000u) ? ~u : (u | 0x80000000u);
}
__device__ __forceinline__ float unordf(uint32_t o) {
  uint32_t u = (o & 0x80000000u) ? (o ^ 0x80000000u) : ~o;
  return __uint_as_float(u);
}
__device__ __forceinline__ const float* xrow(const Params& p, int row) {
  return row < NP ? p.x_prompt + (size_t)row * D : p.x_sample + (size_t)(row - NP) * D;
}

#define INS16(T, V)                                  \
  {                                                  \
    uint32_t _v = (V);                               \
    _Pragma("unroll") for (int _q = 0; _q < 16; _q++) { \
      uint32_t _hi = max(T[_q], _v);                 \
      _v = min(T[_q], _v);                           \
      T[_q] = _hi;                                   \
    }                                                \
  }

__device__ __forceinline__ void transpose_cvt(const float* __restrict__ W, u16* __restrict__ Wt, int K, int N,
                                              size_t gtid, size_t gsz) {
  size_t total = (size_t)N * (K / 8);
  for (size_t c = gtid; c < total; c += gsz) {
    int n = (int)(c % N);
    int kg = (int)(c / N);
    float v[8];
#pragma unroll
    for (int i = 0; i < 8; i++) v[i] = W[(size_t)(kg * 8 + i) * N + n];
    *(uint4*)(Wt + (size_t)n * K + kg * 8) = pack8(v);
  }
}
__device__ __forceinline__ void plain_cvt(const float* __restrict__ S, u16* __restrict__ Dst, size_t n, size_t gtid,
                                          size_t gsz) {
  size_t total = n / 8;
  const float4* s4 = (const float4*)S;
  for (size_t c = gtid; c < total; c += gsz) {
    float4 a = s4[2 * c], b = s4[2 * c + 1];
    float v[8] = {a.x, a.y, a.z, a.w, b.x, b.y, b.z, b.w};
    *(uint4*)(Dst + c * 8) = pack8(v);
  }
}

__device__ __forceinline__ void phase0(const Params& p) {
  const int tid = threadIdx.x;
  const size_t gtid = (size_t)blockIdx.x * 256 + tid, gsz = (size_t)gridDim.x * 256;
  char* ws = p.ws;
  {
    const int lane = tid & 63;
    const int gw = (int)(gtid >> 6), nw = (int)(gsz >> 6);
    u16* XN = (u16*)(ws + W_XN);
    for (int row = gw; row < NTOK; row += nw) {
      const float4* xr = (const float4*)xrow(p, row);
      float4 v[4];
      float ss = 0.f;
#pragma unroll
      for (int i = 0; i < 4; i++) {
        v[i] = xr[lane + i * 64];
        ss += v[i].x * v[i].x + v[i].y * v[i].y + v[i].z * v[i].z + v[i].w * v[i].w;
      }
#pragma unroll
      for (int o = 32; o > 0; o >>= 1) ss += __shfl_xor(ss, o);
      float rstd = rsqrtf(ss * (1.f / 1024.f) + EPS);
      const float4* g4 = (const float4*)p.norm1_g;
#pragma unroll
      for (int i = 0; i < 4; i++) {
        float4 g = g4[lane + i * 64];
        uint2 o;
        o.x = pack2(v[i].x * rstd * g.x, v[i].y * rstd * g.y);
        o.y = pack2(v[i].z * rstd * g.z, v[i].w * rstd * g.w);
        *(uint2*)(XN + (size_t)row * D + (lane + i * 64) * 4) = o;
      }
    }
  }
  transpose_cvt(p.w_in, (u16*)(ws + W_WTIN), 1024, 5632, gtid, gsz);
  transpose_cvt(p.w_branch_lru, (u16*)(ws + W_WTLRU), 1024, 1024, gtid, gsz);
  transpose_cvt(p.w_branch_attn, (u16*)(ws + W_WTATTN), 1024, 1024, gtid, gsz);
  transpose_cvt(p.w_out, (u16*)(ws + W_WTOUT), 1024, 1024, gtid, gsz);
  transpose_cvt(p.peer_w_query, (u16*)(ws + W_WTQ), 1024, 2048, gtid, gsz);
  {
    u16* RA = (u16*)(ws + W_RGA);
    u16* RX = (u16*)(ws + W_RGX);
    for (size_t e = gtid; e < 65536; e += gsz) {
      int n = (int)(e >> 12), k = (int)((e >> 6) & 63), j = (int)(e & 63);
      RA[e] = f2bf(p.rg_w_a[n * 4096 + j * 64 + k]);
      RX[e] = f2bf(p.rg_w_x[n * 4096 + j * 64 + k]);
    }
  }
  plain_cvt(p.peer_sub_keys, (u16*)(ws + W_SK), (size_t)16 * 128 * 128, gtid, gsz);
  {
    const int lane = tid & 63;
    const int gw = (int)(gtid >> 6), nw = (int)(gsz >> 6);
    unsigned char* E8 = (unsigned char*)(ws + W_EU);
    float* ESC = (float*)(ws + W_ESC);
    for (int r = gw; r < 32768; r += nw) {
      const float* src = (r < 16384 ? p.expert_u : p.expert_v) + (size_t)(r & 16383) * 1024 + lane * 16;
      const float4 a0 = *(const float4*)src, a1 = *(const float4*)(src + 4), a2 = *(const float4*)(src + 8),
                   a3 = *(const float4*)(src + 12);
      float am = fmaxf(fmaxf(fmaxf(fabsf(a0.x), fabsf(a0.y)), fmaxf(fabsf(a0.z), fabsf(a0.w))),
                       fmaxf(fmaxf(fabsf(a1.x), fabsf(a1.y)), fmaxf(fabsf(a1.z), fabsf(a1.w))));
      am = fmaxf(am, fmaxf(fmaxf(fmaxf(fabsf(a2.x), fabsf(a2.y)), fmaxf(fabsf(a2.z), fabsf(a2.w))),
                           fmaxf(fmaxf(fabsf(a3.x), fabsf(a3.y)), fmaxf(fabsf(a3.z), fabsf(a3.w)))));
#pragma unroll
      for (int o = 32; o > 0; o >>= 1) am = fmaxf(am, __shfl_xor(am, o));
      const float sc = am > 0.f ? 224.f / am : 1.f;
      uint4 o4;
      int wv;
      wv = __builtin_amdgcn_cvt_pk_fp8_f32(a0.x * sc, a0.y * sc, 0, false);
      wv = __builtin_amdgcn_cvt_pk_fp8_f32(a0.z * sc, a0.w * sc, wv, true);
      o4.x = (uint32_t)wv;
      wv = __builtin_amdgcn_cvt_pk_fp8_f32(a1.x * sc, a1.y * sc, 0, false);
      wv = __builtin_amdgcn_cvt_pk_fp8_f32(a1.z * sc, a1.w * sc, wv, true);
      o4.y = (uint32_t)wv;
      wv = __builtin_amdgcn_cvt_pk_fp8_f32(a2.x * sc, a2.y * sc, 0, false);
      wv = __builtin_amdgcn_cvt_pk_fp8_f32(a2.z * sc, a2.w * sc, wv, true);
      o4.z = (uint32_t)wv;
      wv = __builtin_amdgcn_cvt_pk_fp8_f32(a3.x * sc, a3.y * sc, 0, false);
      wv = __builtin_amdgcn_cvt_pk_fp8_f32(a3.z * sc, a3.w * sc, wv, true);
      o4.w = (uint32_t)wv;
      *(uint4*)(E8 + (size_t)r * 1024 + lane * 16) = o4;
      if (lane == 0) ESC[r] = am > 0.f ? am * (1.f / 224.f) : 1.f;
    }
  }
}

constexpr int LDT = 72;
constexpr int CS_LD = 132;

__device__ __forceinline__ void gemm_tile(const u16* __restrict__ A, int lda, const u16* __restrict__ Bt, int ldb,
                                          int K, f32x4 (&acc)[4][4], u16* As, u16* Bs, int tid) {
  const int lane = tid & 63, w = tid >> 6;
  const int wm = w >> 1, wn = w & 1;
  const int l15 = lane & 15, quad = lane >> 4;
  const int lrow = tid >> 3, lcol = (tid & 7) * 8;
  const u16* Ap = A + (size_t)lrow * lda + lcol;
  const u16* Bp = Bt + (size_t)lrow * ldb + lcol;
  const size_t sa = (size_t)32 * lda, sb = (size_t)32 * ldb;
  uint4 ra0 = *(const uint4*)(Ap), ra1 = *(const uint4*)(Ap + sa), ra2 = *(const uint4*)(Ap + 2 * sa),
        ra3 = *(const uint4*)(Ap + 3 * sa);
  uint4 rb0 = *(const uint4*)(Bp), rb1 = *(const uint4*)(Bp + sb), rb2 = *(const uint4*)(Bp + 2 * sb),
        rb3 = *(const uint4*)(Bp + 3 * sb);
  u16* Asw = As + lrow * LDT + lcol;
  u16* Bsw = Bs + lrow * LDT + lcol;
  for (int k0 = 0; k0 < K; k0 += 64) {
    __syncthreads();
    *(uint4*)(Asw) = ra0; *(uint4*)(Asw + 32 * LDT) = ra1; *(uint4*)(Asw + 64 * LDT) = ra2; *(uint4*)(Asw + 96 * LDT) = ra3;
    *(uint4*)(Bsw) = rb0; *(uint4*)(Bsw + 32 * LDT) = rb1; *(uint4*)(Bsw + 64 * LDT) = rb2; *(uint4*)(Bsw + 96 * LDT) = rb3;
    __syncthreads();
    if (k0 + 64 < K) {
      Ap += 64; Bp += 64;
      ra0 = *(const uint4*)(Ap); ra1 = *(const uint4*)(Ap + sa); ra2 = *(const uint4*)(Ap + 2 * sa); ra3 = *(const uint4*)(Ap + 3 * sa);
      rb0 = *(const uint4*)(Bp); rb1 = *(const uint4*)(Bp + sb); rb2 = *(const uint4*)(Bp + 2 * sb); rb3 = *(const uint4*)(Bp + 3 * sb);
    }
#pragma unroll
    for (int ks = 0; ks < 2; ks++) {
      bf16x8 a[4], b[4];
#pragma unroll
      for (int i = 0; i < 4; i++) {
        a[i] = *(const bf16x8*)(As + (wm * 64 + i * 16 + l15) * LDT + ks * 32 + quad * 8);
        b[i] = *(const bf16x8*)(Bs + (wn * 64 + i * 16 + l15) * LDT + ks * 32 + quad * 8);
      }
#pragma unroll
      for (int i = 0; i < 4; i++)
#pragma unroll
        for (int j = 0; j < 4; j++) acc[i][j] = __builtin_amdgcn_mfma_f32_16x16x32_bf16(a[i], b[j], acc[i][j], 0, 0, 0);
    }
  }
}

__device__ __forceinline__ void zero_acc(f32x4 (&acc)[4][4]) {
#pragma unroll
  for (int i = 0; i < 4; i++)
#pragma unroll
    for (int j = 0; j < 4; j++) acc[i][j] = (f32x4){0.f, 0.f, 0.f, 0.f};
}

__device__ __forceinline__ void acc_to_cs(const f32x4 (&acc)[4][4], float* Cs, int tid) {
  const int lane = tid & 63, w = tid >> 6;
  const int wm = w >> 1, wn = w & 1;
  const int l15 = lane & 15, quad = lane >> 4;
#pragma unroll
  for (int i = 0; i < 4; i++)
#pragma unroll
    for (int j = 0; j < 4; j++)
#pragma unroll
      for (int e = 0; e < 4; e++)
        Cs[(wm * 64 + i * 16 + quad * 4 + e) * CS_LD + wn * 64 + j * 16 + l15] = acc[i][j][e];
}

__device__ __forceinline__ void phase_g1(const Params& p, char* smem) {
  const int tid = threadIdx.x;
  u16* As = (u16*)smem;
  u16* Bs = As + 128 * LDT;
  float* Cs = (float*)smem;
  const u16* XN = (const u16*)(p.ws + W_XN);
  const u16* WT = (const u16*)(p.ws + W_WTIN);
  for (int t = blockIdx.x; t < MT * 44; t += gridDim.x) {
    const int mt = t / 44, nt = t % 44;
    f32x4 acc[4][4];
    zero_acc(acc);
    gemm_tile(XN + (size_t)mt * 128 * 1024, 1024, WT + (size_t)nt * 128 * 1024, 1024, 1024, acc, As, Bs, tid);
    __syncthreads();
    acc_to_cs(acc, Cs, tid);
    __syncthreads();
    const int n0 = nt * 128;
    u16* dst;
    int ldd, col;
    if (n0 < 2048) { dst = (u16*)(p.ws + W_ZA); ldd = 2048; col = n0; }
    else if (n0 < 3584) { dst = (u16*)(p.ws + W_ZB); ldd = 1536; col = n0 - 2048; }
    else { dst = (u16*)p.out; ldd = 2048; col = n0 - 3584; }
    const int cc = (tid & 15) * 8;
#pragma unroll
    for (int i = 0; i < 8; i++) {
      const int r = (tid >> 4) + 16 * i;
      float4 a = *(const float4*)(Cs + r * CS_LD + cc), b = *(const float4*)(Cs + r * CS_LD + cc + 4);
      float v[8] = {a.x, a.y, a.z, a.w, b.x, b.y, b.z, b.w};
      *(uint4*)(dst + (size_t)(mt * 128 + r) * ldd + col + cc) = pack8(v);
    }
    __syncthreads();
  }
}

constexpr int KS_LD = 72, VT_LD = 200, PS_LD = 168;
__device__ __forceinline__ void attn_item(const Params& p, char* smem, int item) {
  const int tid = threadIdx.x, lane = tid & 63, w = tid >> 6, l15 = lane & 15, quad = lane >> 4;
  u16* Ks = (u16*)smem;
  u16* Vt = Ks + 192 * KS_LD;
  u16* Ps = Vt + 64 * VT_LD + w * 16 * PS_LD;
  const u16* ZB = (const u16*)(p.ws + W_ZB);
  u16* ATT = (u16*)(p.ws + W_XN);
  const bool sample = item >= 1024;
  int b, qb = 0, kv, rowbase, p0 = 0;
  if (!sample) {
    kv = item & 3; qb = (item >> 2) & 63; b = item >> 8;
    p0 = qb * 64;
    rowbase = b * SEQ + p0;
  } else {
    int it = item - 1024;
    kv = it & 3; b = it >> 2;
    rowbase = NP + b * 8;
  }
  __syncthreads();
  {
    const int ch = tid & 7;
    float kg[8];
#pragma unroll
    for (int i = 0; i < 8; i++) kg[i] = p.k_norm_g[ch * 8 + i];
    const int nrows = sample ? 160 : 192;
    for (int c = tid; c < nrows * 8; c += 256) {
      const int row = c >> 3;
      float kf[8], vf[8];
      bool valid, donorm;
      if (!sample) {
        const int pos = p0 - 128 + row;
        valid = pos >= 0;
        donorm = true;
        if (valid) {
          const u16* src = ZB + (size_t)(b * SEQ + pos) * 1536 + 1024 + kv * 64 + ch * 8;
          unpack8(*(const uint4*)src, kf);
          unpack8(*(const uint4*)(src + 256), vf);
        }
      } else {
        valid = row < 136;
        donorm = row >= 128;
        if (row < 128) {
          const float* sk = p.cache_k + ((size_t)(b * 128 + row) * 4 + kv) * 64 + ch * 8;
          const float* sv = p.cache_v + ((size_t)(b * 128 + row) * 4 + kv) * 64 + ch * 8;
          float4 a0 = *(const float4*)sk, a1 = *(const float4*)(sk + 4);
          float4 b0 = *(const float4*)sv, b1 = *(const float4*)(sv + 4);
          kf[0] = a0.x; kf[1] = a0.y; kf[2] = a0.z; kf[3] = a0.w; kf[4] = a1.x; kf[5] = a1.y; kf[6] = a1.z; kf[7] = a1.w;
          vf[0] = b0.x; vf[1] = b0.y; vf[2] = b0.z; vf[3] = b0.w; vf[4] = b1.x; vf[5] = b1.y; vf[6] = b1.z; vf[7] = b1.w;
        } else if (valid) {
          const u16* src = ZB + (size_t)(NP + b * 8 + (row - 128)) * 1536 + 1024 + kv * 64 + ch * 8;
          unpack8(*(const uint4*)src, kf);
          unpack8(*(const uint4*)(src + 256), vf);
        }
      }
      if (!valid) {
#pragma unroll
        for (int i = 0; i < 8; i++) { kf[i] = 0.f; vf[i] = 0.f; }
      }
      float ss = 0.f;
#pragma unroll
      for (int i = 0; i < 8; i++) ss += kf[i] * kf[i];
      ss += __shfl_xor(ss, 1);
      ss += __shfl_xor(ss, 2);
      ss += __shfl_xor(ss, 4);
      if (donorm) {
        const float rstd = rsqrtf(ss * (1.f / 64.f) + EPS);
#pragma unroll
        for (int i = 0; i < 8; i++) kf[i] = kf[i] * rstd * kg[i];
      }
      *(uint4*)(Ks + row * KS_LD + ch * 8) = pack8(kf);
#pragma unroll
      for (int i = 0; i < 8; i++) Vt[(ch * 8 + i) * VT_LD + row] = f2bf(vf[i]);
      if (!sample) {
        if (qb >= 62 && row >= 128) {
          const int wpos = p0 + (row - 128) - (SEQ - 128);
          float* ko = p.out + O_KP + ((size_t)(b * 128 + wpos) * 4 + kv) * 64 + ch * 8;
          float* vo = p.out + O_VP + ((size_t)(b * 128 + wpos) * 4 + kv) * 64 + ch * 8;
          *(float4*)ko = make_float4(kf[0], kf[1], kf[2], kf[3]);
          *(float4*)(ko + 4) = make_float4(kf[4], kf[5], kf[6], kf[7]);
          *(float4*)vo = make_float4(vf[0], vf[1], vf[2], vf[3]);
          *(float4*)(vo + 4) = make_float4(vf[4], vf[5], vf[6], vf[7]);
        }
      } else {
        if (row >= 8 && row < 136) {
          float* ko = p.out + O_KS + ((size_t)(b * 128 + (row - 8)) * 4 + kv) * 64 + ch * 8;
          float* vo = p.out + O_VS + ((size_t)(b * 128 + (row - 8)) * 4 + kv) * 64 + ch * 8;
          *(float4*)ko = make_float4(kf[0], kf[1], kf[2], kf[3]);
          *(float4*)(ko + 4) = make_float4(kf[4], kf[5], kf[6], kf[7]);
          *(float4*)vo = make_float4(vf[0], vf[1], vf[2], vf[3]);
          *(float4*)(vo + 4) = make_float4(vf[4], vf[5], vf[6], vf[7]);
        }
      }
    }
  }
  __syncthreads();
  const int hq = kv * 4 + w;
  const float slope = exp2f(-0.5f * (float)(hq + 1));
  const float sink = p.attn_sinks[hq];
  float qg[2][8];
#pragma unroll
  for (int ks = 0; ks < 2; ks++)
#pragma unroll
    for (int i = 0; i < 8; i++) qg[ks][i] = p.q_norm_g[ks * 32 + quad * 8 + i] * 0.125f;
  const int nsub = sample ? 1 : 4;
  for (int sb = 0; sb < nsub; sb++) {
    const int r0 = sb * 16;
    const int ws0 = r0 < 32 ? r0 : 32;
    bf16x8 qa[2];
    {
      const int qr = sample ? (l15 & 7) : (r0 + l15);
      const u16* src = ZB + (size_t)(rowbase + qr) * 1536 + hq * 64 + quad * 8;
      float q0[8], q1[8];
      unpack8(*(const uint4*)src, q0);
      unpack8(*(const uint4*)(src + 32), q1);
      float ss = 0.f;
#pragma unroll
      for (int i = 0; i < 8; i++) ss += q0[i] * q0[i] + q1[i] * q1[i];
      ss += __shfl_xor(ss, 16);
      ss += __shfl_xor(ss, 32);
      const float rstd = rsqrtf(ss * (1.f / 64.f) + EPS);
#pragma unroll
      for (int i = 0; i < 8; i++) { q0[i] *= rstd * qg[0][i]; q1[i] *= rstd * qg[1][i]; }
      uint4 u0 = pack8(q0), u1 = pack8(q1);
      qa[0] = __builtin_bit_cast(bf16x8, u0);
      qa[1] = __builtin_bit_cast(bf16x8, u1);
    }
    f32x4 s[10];
#pragma unroll
    for (int kt = 0; kt < 10; kt++) {
      const u16* kp = Ks + (ws0 + kt * 16 + l15) * KS_LD + quad * 8;
      bf16x8 b0 = *(const bf16x8*)kp, b1 = *(const bf16x8*)(kp + 32);
      f32x4 z = {0.f, 0.f, 0.f, 0.f};
      z = __builtin_amdgcn_mfma_f32_16x16x32_bf16(qa[0], b0, z, 0, 0, 0);
      s[kt] = __builtin_amdgcn_mfma_f32_16x16x32_bf16(qa[1], b1, z, 0, 0, 0);
    }
    float mx[4] = {-1e30f, -1e30f, -1e30f, -1e30f};
#pragma unroll
    for (int kt = 0; kt < 10; kt++) {
      const int jj = ws0 + kt * 16 + l15;
      const bool posok = sample ? (jj < 136) : (p0 - 128 + jj >= 0);
#pragma unroll
      for (int e = 0; e < 4; e++) {
        const int r = r0 + quad * 4 + e;
        const int dist = r + 128 - jj;
        const bool ok = posok && dist >= 0 && dist <= 128;
        float v = ok ? (s[kt][e] - slope * (float)dist) : -1e30f;
        s[kt][e] = v;
        mx[e] = fmaxf(mx[e], v);
      }
    }
    float sum[4];
#pragma unroll
    for (int e = 0; e < 4; e++) {
      float m = mx[e];
      m = fmaxf(m, __shfl_xor(m, 1));
      m = fmaxf(m, __shfl_xor(m, 2));
      m = fmaxf(m, __shfl_xor(m, 4));
      m = fmaxf(m, __shfl_xor(m, 8));
      m = fmaxf(m, sink);
      mx[e] = m;
      sum[e] = 0.f;
    }
#pragma unroll
    for (int kt = 0; kt < 10; kt++) {
#pragma unroll
      for (int e = 0; e < 4; e++) {
        float pv = __expf(s[kt][e] - mx[e]);
        sum[e] += pv;
        Ps[(quad * 4 + e) * PS_LD + kt * 16 + l15] = f2bf(pv);
      }
    }
#pragma unroll
    for (int e = 0; e < 4; e++) {
      float t = sum[e];
      t += __shfl_xor(t, 1);
      t += __shfl_xor(t, 2);
      t += __shfl_xor(t, 4);
      t += __shfl_xor(t, 8);
      sum[e] = 1.f / (t + __expf(sink - mx[e]));
    }
    __syncthreads();
    f32x4 o[4];
#pragma unroll
    for (int nt = 0; nt < 4; nt++) o[nt] = (f32x4){0.f, 0.f, 0.f, 0.f};
#pragma unroll
    for (int kk = 0; kk < 5; kk++) {
      bf16x8 pa = *(const bf16x8*)(Ps + l15 * PS_LD + kk * 32 + quad * 8);
#pragma unroll
      for (int nt = 0; nt < 4; nt++) {
        bf16x8 vb = *(const bf16x8*)(Vt + (nt * 16 + l15) * VT_LD + ws0 + kk * 32 + quad * 8);
        o[nt] = __builtin_amdgcn_mfma_f32_16x16x32_bf16(pa, vb, o[nt], 0, 0, 0);
      }
    }
#pragma unroll
    for (int e = 0; e < 4; e++) {
      const int r = quad * 4 + e;
      if (!sample || r < 8) {
        u16* dst = ATT + (size_t)(rowbase + r0 + r) * 1024 + hq * 64 + l15;
#pragma unroll
        for (int nt = 0; nt < 4; nt++) dst[nt * 16] = f2bf(o[nt][e] * sum[e]);
      }
    }
    __syncthreads();
  }
}

constexpr int XC_LD = 68;
__device__ __forceinline__ void lru_tile(const Params& p, char* smem, int mt, int nb, int mode) {
  const int tid = threadIdx.x, lane = tid & 63, w = tid >> 6, l15 = lane & 15, quad = lane >> 4;
  float* xcF = (float*)smem;
  float* aL = xcF + 128 * XC_LD;
  float* aggL = aL + 128 * XC_LD;
  const u16* ZA = (const u16*)(p.ws + W_ZA);
  const bool sample = mt >= 128;
  const int m0 = mt * 128;
  const int cb = nb * 64;
  __syncthreads();
  {
    const int ch = tid & 7;
    float cw[4][8], cbias[8];
#pragma unroll
    for (int j = 0; j < 4; j++)
#pragma unroll
      for (int i = 0; i < 8; i++) cw[j][i] = p.conv_w[j * 1024 + cb + ch * 8 + i];
#pragma unroll
    for (int i = 0; i < 8; i++) cbias[i] = p.conv_b[cb + ch * 8 + i];
#pragma unroll
    for (int it = 0; it < 4; it++) {
      const int r = (tid >> 3) + it * 32;
      const int grow = m0 + r;
      const int t = sample ? (r & 7) : ((mt & 31) * 128 + r);
      float y[8];
#pragma unroll
      for (int i = 0; i < 8; i++) y[i] = cbias[i];
#pragma unroll
      for (int d = 0; d < 4; d++) {
        float xv[8];
        if (t - d >= 0) {
          unpack8(*(const uint4*)(ZA + (size_t)(grow - d) * 2048 + cb + ch * 8), xv);
        } else if (sample) {
          const int bb = (m0 - NP + r) >> 3;
          const float* src = p.cache_conv + ((size_t)bb * 3 + (3 + t - d)) * 1024 + cb + ch * 8;
          float4 a = *(const float4*)src, b4 = *(const float4*)(src + 4);
          xv[0] = a.x; xv[1] = a.y; xv[2] = a.z; xv[3] = a.w; xv[4] = b4.x; xv[5] = b4.y; xv[6] = b4.z; xv[7] = b4.w;
        } else {
#pragma unroll
          for (int i = 0; i < 8; i++) xv[i] = 0.f;
        }
#pragma unroll
        for (int i = 0; i < 8; i++) y[i] += cw[3 - d][i] * xv[i];
        if (d == 0 && mode == 1) {
          if (!sample) {
            if ((mt & 31) == 31 && r >= 125) {
              float* dst = p.out + O_CONVP + ((size_t)(mt >> 5) * 3 + (r - 125)) * 1024 + cb + ch * 8;
              *(float4*)dst = make_float4(xv[0], xv[1], xv[2], xv[3]);
              *(float4*)(dst + 4) = make_float4(xv[4], xv[5], xv[6], xv[7]);
            }
          } else if (t >= 5) {
            const int bb = (m0 - NP + r) >> 3;
            float* dst = p.out + O_CONVS + ((size_t)bb * 3 + (t - 5)) * 1024 + cb + ch * 8;
            *(float4*)dst = make_float4(xv[0], xv[1], xv[2], xv[3]);
            *(float4*)(dst + 4) = make_float4(xv[4], xv[5], xv[6], xv[7]);
          }
        }
      }
      *(float4*)(xcF + r * XC_LD + ch * 8) = make_float4(y[0], y[1], y[2], y[3]);
      *(float4*)(xcF + r * XC_LD + ch * 8 + 4) = make_float4(y[4], y[5], y[6], y[7]);
    }
  }
  __syncthreads();
  {
    const u16* RA = (const u16*)(p.ws + W_RGA) + nb * 4096;
    const u16* RX = (const u16*)(p.ws + W_RGX) + nb * 4096;
    f32x4 aR[2][4], aI[2][4];
#pragma unroll
    for (int i = 0; i < 2; i++)
#pragma unroll
      for (int j = 0; j < 4; j++) { aR[i][j] = (f32x4){0.f, 0.f, 0.f, 0.f}; aI[i][j] = (f32x4){0.f, 0.f, 0.f, 0.f}; }
#pragma unroll
    for (int ks = 0; ks < 2; ks++) {
      bf16x8 a[2];
#pragma unroll
      for (int i = 0; i < 2; i++) {
        const float* src = xcF + (w * 32 + i * 16 + l15) * XC_LD + ks * 32 + quad * 8;
        float4 x0 = *(const float4*)src, x1 = *(const float4*)(src + 4);
        float v[8] = {x0.x, x0.y, x0.z, x0.w, x1.x, x1.y, x1.z, x1.w};
        uint4 u = pack8(v);
        a[i] = __builtin_bit_cast(bf16x8, u);
      }
#pragma unroll
      for (int j = 0; j < 4; j++) {
        bf16x8 ba = *(const bf16x8*)(RA + (j * 16 + l15) * 64 + ks * 32 + quad * 8);
        bf16x8 bx = *(const bf16x8*)(RX + (j * 16 + l15) * 64 + ks * 32 + quad * 8);
#pragma unroll
        for (int i = 0; i < 2; i++) {
          aR[i][j] = __builtin_amdgcn_mfma_f32_16x16x32_bf16(a[i], ba, aR[i][j], 0, 0, 0);
          aI[i][j] = __builtin_amdgcn_mfma_f32_16x16x32_bf16(a[i], bx, aI[i][j], 0, 0, 0);
        }
      }
    }
#pragma unroll
    for (int j = 0; j < 4; j++) {
      const int c = cb + j * 16 + l15;
      const float ba = p.rg_b_a[c], bx = p.rg_b_x[c];
      const float ls = -log1pf(__expf(-p.rg_lambda[c]));
#pragma unroll
      for (int i = 0; i < 2; i++)
#pragma unroll
        for (int e = 0; e < 4; e++) {
          const int row = w * 32 + i * 16 + quad * 4 + e;
          const float rg = sigmoidf_(aR[i][j][e] + ba);
          const float ig = sigmoidf_(aI[i][j][e] + bx);
          const float la = 8.f * rg * ls;
          const float av = __expf(la);
          const float mult = sqrtf(fmaxf(-expm1f(2.f * la), 0.f));
          const int idx = row * XC_LD + j * 16 + l15;
          const float xv = xcF[idx];
          aL[idx] = av;
          xcF[idx] = mult * ig * xv;
        }
    }
  }
  __syncthreads();
  const int c = cb + lane;
  float* carL = aggL + 512;
  if (!sample) {
    float* AGGP = (float*)(p.ws + W_AGG);
    float* AGGH = AGGP + 128 * 1024;
    const int chunk = mt & 31, base = mt - chunk;
    if (mode == 1) {
      float Pq[8], Hq[8];
#pragma unroll
      for (int k = 0; k < 8; k++) {
        const int q = w * 8 + k;
        const bool ok = q < chunk;
        Pq[k] = ok ? AGGP[(base + q) * 1024 + c] : 1.f;
        Hq[k] = ok ? AGGH[(base + q) * 1024 + c] : 0.f;
      }
      float Pc = 1.f, hc = 0.f;
#pragma unroll
      for (int k = 0; k < 8; k++) { hc = Pq[k] * hc + Hq[k]; Pc *= Pq[k]; }
      carL[(w * 64 + lane) * 2] = Pc;
      carL[(w * 64 + lane) * 2 + 1] = hc;
    }
    float P = 1.f, h = 0.f;
#pragma unroll 8
    for (int rr = 0; rr < 32; rr++) {
      const float av = aL[(w * 32 + rr) * XC_LD + lane], bv = xcF[(w * 32 + rr) * XC_LD + lane];
      h = av * h + bv;
      P *= av;
    }
    aggL[(w * 64 + lane) * 2] = P;
    aggL[(w * 64 + lane) * 2 + 1] = h;
    __syncthreads();
    if (mode == 0) {
      if (w == 0) {
        float Pt = 1.f, ht = 0.f;
#pragma unroll
        for (int q = 0; q < 4; q++) {
          const float Pq = aggL[(q * 64 + lane) * 2], hq = aggL[(q * 64 + lane) * 2 + 1];
          ht = Pq * ht + hq;
          Pt *= Pq;
        }
        AGGP[mt * 1024 + c] = Pt;
        AGGH[mt * 1024 + c] = ht;
      }
    } else {
      float hin = 0.f;
#pragma unroll
      for (int q = 0; q < 4; q++) hin = carL[(q * 64 + lane) * 2] * hin + carL[(q * 64 + lane) * 2 + 1];
      for (int q = 0; q < w; q++) hin = aggL[(q * 64 + lane) * 2] * hin + aggL[(q * 64 + lane) * 2 + 1];
      float hh = hin;
#pragma unroll 8
      for (int rr = 0; rr < 32; rr++) {
        const int row = w * 32 + rr;
        const float av = aL[row * XC_LD + lane], bv = xcF[row * XC_LD + lane];
        hh = av * hh + bv;
        xcF[row * XC_LD + lane] = hh;
      }
      if (chunk == 31 && w == 3) p.out[O_LRUP + (size_t)(mt >> 5) * 1024 + c] = hh;
    }
  } else {
    float hh = 0.f;
    float h0v[4];
#pragma unroll
    for (int k = 0; k < 4; k++) h0v[k] = p.state_lru[(size_t)(((m0 - NP + w * 32) >> 3) + k) * 1024 + c];
#pragma unroll
    for (int rr = 0; rr < 32; rr++) {
      const int row = w * 32 + rr;
      const int bb = (m0 - NP + row) >> 3;
      const int t = row & 7;
      if (t == 0) hh = h0v[rr >> 3];
      const float av = aL[row * XC_LD + lane], bv = xcF[row * XC_LD + lane];
      hh = av * hh + bv;
      xcF[row * XC_LD + lane] = hh;
      if (t == 7) p.out[O_LRUS + (size_t)bb * 1024 + c] = hh;
    }
  }
  if (mode == 1) {
    __syncthreads();
    u16* LO = (u16*)(p.ws + W_ZB);
    const int ch = tid & 7;
#pragma unroll
    for (int it = 0; it < 4; it++) {
      const int r = (tid >> 3) + it * 32;
      float g[8];
      unpack8(*(const uint4*)(ZA + (size_t)(m0 + r) * 2048 + 1024 + cb + ch * 8), g);
      const float4 h0 = *(const float4*)(xcF + r * XC_LD + ch * 8), h1 = *(const float4*)(xcF + r * XC_LD + ch * 8 + 4);
      float v[8] = {h0.x * gelu_tanh(g[0]), h0.y * gelu_tanh(g[1]), h0.z * gelu_tanh(g[2]), h0.w * gelu_tanh(g[3]),
                    h1.x * gelu_tanh(g[4]), h1.y * gelu_tanh(g[5]), h1.z * gelu_tanh(g[6]), h1.w * gelu_tanh(g[7])};
      *(uint4*)(LO + (size_t)(m0 + r) * 1024 + cb + ch * 8) = pack8(v);
    }
  }
}

__device__ __forceinline__ void phase_g3(const Params& p, char* smem) {
  const int tid = threadIdx.x;
  u16* As = (u16*)smem;
  u16* Bs = As + 128 * LDT;
  float* Cs = (float*)smem;
  const u16* LO = (const u16*)(p.ws + W_ZB);
  const u16* ATT = (const u16*)(p.ws + W_XN);
  const u16* WL = (const u16*)(p.ws + W_WTLRU);
  const u16* WA = (const u16*)(p.ws + W_WTATTN);
  const u16* ZC = (const u16*)p.out;
  u16* MG = (u16*)(p.ws + W_ZA);
  for (int t = blockIdx.x; t < MT * 8; t += gridDim.x) {
    const int mt = t >> 3, nt = t & 7;
    const int cc = (tid & 15) * 8;
#pragma unroll 1
    for (int pass = 0; pass < 2; pass++) {
      f32x4 acc[4][4];
      zero_acc(acc);
      gemm_tile((pass ? ATT : LO) + (size_t)mt * 128 * 1024, 1024, (pass ? WA : WL) + (size_t)nt * 128 * 1024, 1024, 1024,
                acc, As, Bs, tid);
      __syncthreads();
      acc_to_cs(acc, Cs, tid);
      __syncthreads();
#pragma unroll
      for (int i = 0; i < 8; i++) {
        const int r = (tid >> 4) + 16 * i;
        const size_t row = (size_t)(mt * 128 + r);
        float4 a = *(const float4*)(Cs + r * CS_LD + cc), b = *(const float4*)(Cs + r * CS_LD + cc + 4);
        float v[8] = {a.x, a.y, a.z, a.w, b.x, b.y, b.z, b.w};
        float g[8];
        unpack8(*(const uint4*)(ZC + row * 2048 + pass * 1024 + nt * 128 + cc), g);
        u16* mp = MG + row * 1024 + nt * 128 + cc;
        if (pass == 0) {
#pragma unroll
          for (int q = 0; q < 8; q++) v[q] *= sigmoidf_(g[q]);
        } else {
          float pv[8];
          unpack8(*(const uint4*)mp, pv);
#pragma unroll
          for (int q = 0; q < 8; q++) v[q] = pv[q] + v[q] * sigmoidf_(g[q]);
        }
        *(uint4*)mp = pack8(v);
      }
      __syncthreads();
    }
  }
}

__device__ __forceinline__ void phase_g4(const Params& p, char* smem) {
  const int tid = threadIdx.x;
  u16* As = (u16*)smem;
  u16* Bs = As + 128 * LDT;
  float* Cs = (float*)smem;
  const u16* MG = (const u16*)(p.ws + W_ZA);
  const u16* WO = (const u16*)(p.ws + W_WTOUT);
  u16* HG = (u16*)(p.ws + W_ZB);
  float* SSQ = (float*)(p.ws + W_SSQ);
  for (int t = blockIdx.x; t < MT * 8; t += gridDim.x) {
    const int mt = t >> 3, nt = t & 7;
    f32x4 acc[4][4];
    zero_acc(acc);
    gemm_tile(MG + (size_t)mt * 128 * 1024, 1024, WO + (size_t)nt * 128 * 1024, 1024, 1024, acc, As, Bs, tid);
    __syncthreads();
    acc_to_cs(acc, Cs, tid);
    __syncthreads();
    const int cc = (tid & 15) * 8;
    const float4 g0 = *(const float4*)(p.norm2_g + nt * 128 + cc), g1 = *(const float4*)(p.norm2_g + nt * 128 + cc + 4);
#pragma unroll
    for (int i = 0; i < 8; i++) {
      const int r = (tid >> 4) + 16 * i;
      const int row = mt * 128 + r;
      float4 a = *(const float4*)(Cs + r * CS_LD + cc), b = *(const float4*)(Cs + r * CS_LD + cc + 4);
      const float* xr = xrow(p, row) + nt * 128 + cc;
      float4 x0 = *(const float4*)xr, x1 = *(const float4*)(xr + 4);
      a.x += x0.x; a.y += x0.y; a.z += x0.z; a.w += x0.w;
      b.x += x1.x; b.y += x1.y; b.z += x1.z; b.w += x1.w;
      float* ho = p.out + O_Y + (size_t)row * 1024 + nt * 128 + cc;
      *(float4*)ho = a;
      *(float4*)(ho + 4) = b;
      float v[8] = {a.x * g0.x, a.y * g0.y, a.z * g0.z, a.w * g0.w, b.x * g1.x, b.y * g1.y, b.z * g1.z, b.w * g1.w};
      *(uint4*)(HG + (size_t)row * 1024 + nt * 128 + cc) = pack8(v);
      float ss = a.x * a.x + a.y * a.y + a.z * a.z + a.w * a.w + b.x * b.x + b.y * b.y + b.z * b.z + b.w * b.w;
      ss += __shfl_xor(ss, 1);
      ss += __shfl_xor(ss, 2);
      ss += __shfl_xor(ss, 4);
      ss += __shfl_xor(ss, 8);
      if ((tid & 15) == 0) SSQ[(size_t)row * 8 + nt] = ss;
    }
    __syncthreads();
  }
}

__device__ __forceinline__ float row_rstd(const float* SSQ, int row) {
  const float4 a = *(const float4*)(SSQ + (size_t)row * 8), b = *(const float4*)(SSQ + (size_t)row * 8 + 4);
  const float ss = ((a.x + a.y) + (a.z + a.w)) + ((b.x + b.y) + (b.z + b.w));
  return rsqrtf(ss * (1.f / 1024.f) + EPS);
}

__device__ __forceinline__ void phase_g5(const Params& p, char* smem) {
  const int tid = threadIdx.x;
  u16* As = (u16*)smem;
  u16* Bs = As + 128 * LDT;
  float* Cs = (float*)smem;
  const u16* HG = (const u16*)(p.ws + W_ZB);
  const u16* WQ = (const u16*)(p.ws + W_WTQ);
  const float* SSQ = (const float*)(p.ws + W_SSQ);
  u16* QR = (u16*)(p.ws + W_ZA);
  for (int t = blockIdx.x; t < MT * 16; t += gridDim.x) {
    const int mt = t >> 4, nt = t & 15;
    f32x4 acc[4][4];
    zero_acc(acc);
    gemm_tile(HG + (size_t)mt * 128 * 1024, 1024, WQ + (size_t)nt * 128 * 1024, 1024, 1024, acc, As, Bs, tid);
    __syncthreads();
    acc_to_cs(acc, Cs, tid);
    __syncthreads();
    const int cc = (tid & 15) * 8;
#pragma unroll
    for (int i = 0; i < 8; i++) {
      const int r = (tid >> 4) + 16 * i;
      const int row = mt * 128 + r;
      const float rs = row_rstd(SSQ, row);
      float4 a = *(const float4*)(Cs + r * CS_LD + cc), b = *(const float4*)(Cs + r * CS_LD + cc + 4);
      float v[8] = {a.x * rs, a.y * rs, a.z * rs, a.w * rs, b.x * rs, b.y * rs, b.z * rs, b.w * rs};
      *(uint4*)(QR + (size_t)row * 2048 + nt * 128 + cc) = pack8(v);
    }
    __syncthreads();
  }
}

__device__ __forceinline__ void phase_g6(const Params& p, char* smem) {
  const int tid = threadIdx.x;
  u16* As = (u16*)smem;
  u16* Bs = As + 128 * LDT;
  float* Cs = (float*)smem;
  uint32_t* Cu = (uint32_t*)smem;
  uint32_t* TK0 = (uint32_t*)(smem + 128 * CS_LD * 4);
  const u16* QR = (const u16*)(p.ws + W_ZA);
  const u16* SK = (const u16*)(p.ws + W_SK);
  int* IDX = (int*)(p.ws + W_XN);
  float* GW = (float*)(p.ws + W_XN + (size_t)NTOK * 128 * 4);
  const int row = tid >> 1, half = tid & 1;
  for (int t = blockIdx.x; t < MT * 8; t += gridDim.x) {
    const int mt = t >> 3, h = t & 7;
    uint32_t tk[16];
    for (int pp = 0; pp < 2; pp++) {
      f32x4 acc[4][4];
      zero_acc(acc);
      gemm_tile(QR + (size_t)mt * 128 * 2048 + h * 256 + pp * 128, 2048, SK + (size_t)(h * 2 + pp) * 16384, 128, 128, acc,
                As, Bs, tid);
      __syncthreads();
      acc_to_cs(acc, Cs, tid);
      __syncthreads();
#pragma unroll
      for (int q = 0; q < 16; q++) tk[q] = 0u;
      for (int cix = 0; cix < 64; cix++) {
        const int col = half * 64 + cix;
        const float v = Cs[row * CS_LD + col];
        const uint32_t key = (ordf(v) & ~0x7Fu) | (uint32_t)(127 - col);
        INS16(tk, key);
      }
      __syncthreads();
      if (half == 1) {
#pragma unroll
        for (int q = 0; q < 16; q++) Cu[row * 16 + q] = tk[q];
      }
      __syncthreads();
      if (half == 0) {
#pragma unroll
        for (int q = 0; q < 16; q++) {
          const uint32_t k2 = Cu[row * 16 + q];
          INS16(tk, k2);
        }
        if (pp == 0) {
#pragma unroll
          for (int q = 0; q < 16; q++) TK0[row * 16 + q] = tk[q];
        } else {
#pragma unroll
          for (int q = 0; q < 16; q++) Cu[2048 + row * 16 + q] = tk[q];
        }
      }
      __syncthreads();
    }
    if (half == 0) {
      float va[16], vb[16];
#pragma unroll
      for (int q = 0; q < 16; q++) {
        va[q] = unordf(TK0[row * 16 + q] & ~0x7Fu);
        vb[q] = unordf(tk[q] & ~0x7Fu);
      }
      uint32_t cd[16];
#pragma unroll
      for (int q = 0; q < 16; q++) cd[q] = 0u;
#pragma unroll
      for (int i = 0; i < 16; i++) {
#pragma unroll
        for (int j = 0; j < 16; j++) {
          if ((i + 1) * (j + 1) <= 16) {
            const float sv = va[i] + vb[j];
            const uint32_t key = (ordf(sv) & ~0xFFu) | (uint32_t)(i * 16 + j);
            INS16(cd, key);
          }
        }
      }
      float ev[16];
      const float m0v = unordf(cd[0] & ~0xFFu);
      float esum = 0.f;
#pragma unroll
      for (int q = 0; q < 16; q++) {
        ev[q] = __expf(unordf(cd[q] & ~0xFFu) - m0v);
        esum += ev[q];
      }
      const float inv = 1.f / esum;
      const size_t ob = (size_t)(mt * 128 + row) * 128 + h * 16;
#pragma unroll
      for (int q = 0; q < 16; q++) {
        const int ij = cd[q] & 0xFF;
        const int i0 = 127 - (int)(TK0[row * 16 + (ij >> 4)] & 0x7Fu);
        const int i1 = 127 - (int)(Cu[2048 + row * 16 + (ij & 15)] & 0x7Fu);
        IDX[ob + q] = i0 * 128 + i1;
        GW[ob + q] = ev[q] * inv;
      }
    }
    __syncthreads();
  }
}

typedef __attribute__((ext_vector_type(2))) float f32x2;
__device__ __forceinline__ void dec16(uint4 u, float* v) {
  f32x2 t;
  t = __builtin_amdgcn_cvt_pk_f32_fp8((int)u.x, false); v[0] = t.x; v[1] = t.y;
  t = __builtin_amdgcn_cvt_pk_f32_fp8((int)u.x, true); v[2] = t.x; v[3] = t.y;
  t = __builtin_amdgcn_cvt_pk_f32_fp8((int)u.y, false); v[4] = t.x; v[5] = t.y;
  t = __builtin_amdgcn_cvt_pk_f32_fp8((int)u.y, true); v[6] = t.x; v[7] = t.y;
  t = __builtin_amdgcn_cvt_pk_f32_fp8((int)u.z, false); v[8] = t.x; v[9] = t.y;
  t = __builtin_amdgcn_cvt_pk_f32_fp8((int)u.z, true); v[10] = t.x; v[11] = t.y;
  t = __builtin_amdgcn_cvt_pk_f32_fp8((int)u.w, false); v[12] = t.x; v[13] = t.y;
  t = __builtin_amdgcn_cvt_pk_f32_fp8((int)u.w, true); v[14] = t.x; v[15] = t.y;
}

__device__ __forceinline__ void phase7(const Params& p) {
  const int tid = threadIdx.x, lane = tid & 63, w = tid >> 6;
  const u16* HG = (const u16*)(p.ws + W_ZB);
  const float* SSQ = (const float*)(p.ws + W_SSQ);
  const int* IDX = (const int*)(p.ws + W_XN);
  const float* GW = (const float*)(p.ws + W_XN + (size_t)NTOK * 128 * 4);
  const unsigned char* EU = (const unsigned char*)(p.ws + W_EU);
  const unsigned char* EV = (const unsigned char*)(p.ws + W_EV);
  const float* ESC = (const float*)(p.ws + W_ESC);
  const int b0 = lane & 1, b1 = (lane >> 1) & 1, b2 = (lane >> 2) & 1;
  for (int tok = blockIdx.x * 4 + w; tok < NTOK; tok += gridDim.x * 4) {
    const float rs = row_rstd(SSQ, tok);
    float xh[16];
    {
      const uint4* hp = (const uint4*)(HG + (size_t)tok * 1024 + lane * 16);
      unpack8(hp[0], xh);
      unpack8(hp[1], xh + 8);
#pragma unroll
      for (int i = 0; i < 16; i++) xh[i] *= rs;
    }
    const int iA = IDX[(size_t)tok * 128 + lane], iB = IDX[(size_t)tok * 128 + 64 + lane];
    const float gA = GW[(size_t)tok * 128 + lane] * ESC[16384 + iA], gB = GW[(size_t)tok * 128 + 64 + lane] * ESC[16384 + iB];
    const float suA = ESC[iA], suB = ESC[iB];
    float dA = 0.f, dB = 0.f;
    for (int bb = 0; bb < 16; bb++) {
      const int isrc = bb < 8 ? iA : iB;
      float d[8];
#pragma unroll
      for (int k = 0; k < 8; k++) {
        const int id = __builtin_amdgcn_readlane(isrc, (bb & 7) * 8 + k);
        const uint4 u = *(const uint4*)(EU + (size_t)id * 1024 + lane * 16);
        float uv[16];
        dec16(u, uv);
        float sacc = 0.f;
#pragma unroll
        for (int i = 0; i < 16; i++) sacc += xh[i] * uv[i];
        d[k] = sacc;
      }
      float e4[4], e2[2], e1;
#pragma unroll
      for (int i = 0; i < 4; i++) {
        const float keep = b0 ? d[2 * i + 1] : d[2 * i];
        const float send = b0 ? d[2 * i] : d[2 * i + 1];
        e4[i] = keep + __shfl_xor(send, 1);
      }
#pragma unroll
      for (int i = 0; i < 2; i++) {
        const float keep = b1 ? e4[2 * i + 1] : e4[2 * i];
        const float send = b1 ? e4[2 * i] : e4[2 * i + 1];
        e2[i] = keep + __shfl_xor(send, 2);
      }
      {
        const float keep = b2 ? e2[1] : e2[0];
        const float send = b2 ? e2[0] : e2[1];
        e1 = keep + __shfl_xor(send, 4);
      }
      e1 += __shfl_xor(e1, 8);
      e1 += __shfl_xor(e1, 16);
      e1 += __shfl_xor(e1, 32);
      const bool mine = (lane >> 3) == (bb & 7);
      if (bb < 8) dA = mine ? e1 : dA; else dB = mine ? e1 : dB;
    }
    const float actA = gelu_tanh(dA * suA) * gA, actB = gelu_tanh(dB * suB) * gB;
    float o[16];
#pragma unroll
    for (int i = 0; i < 16; i++) o[i] = 0.f;
    for (int bb = 0; bb < 16; bb++) {
      const int isrc = bb < 8 ? iA : iB;
      const float asrc = bb < 8 ? actA : actB;
#pragma unroll
      for (int k = 0; k < 8; k++) {
        const int id = __builtin_amdgcn_readlane(isrc, (bb & 7) * 8 + k);
        const float a = __uint_as_float(__builtin_amdgcn_readlane(__float_as_uint(asrc), (bb & 7) * 8 + k));
        const uint4 u = *(const uint4*)(EV + (size_t)id * 1024 + lane * 16);
        float vv[16];
        dec16(u, vv);
#pragma unroll
        for (int i = 0; i < 16; i++) o[i] += a * vv[i];
      }
    }
    float* yo = p.out + O_Y + (size_t)tok * 1024 + lane * 16;
#pragma unroll
    for (int q = 0; q < 4; q++) {
      float4 h = *(const float4*)(yo + q * 4);
      h.x += o[q * 4]; h.y += o[q * 4 + 1]; h.z += o[q * 4 + 2]; h.w += o[q * 4 + 3];
      *(float4*)(yo + q * 4) = h;
    }
  }
}

#ifndef REP_MASK
#define REP_MASK 0
#endif
#define REPS(k) for (int _rep = 0; _rep < (((REP_MASK) >> (k)) & 1) + 1; _rep++)
__global__ void __launch_bounds__(256, 2) fwd_megakernel(Params p) {
  extern __shared__ __attribute__((aligned(16))) char smem[];
  cg::grid_group grid = cg::this_grid();
  REPS(0) { phase0(p); grid.sync(); }
  REPS(1) { phase_g1(p, smem); grid.sync(); }
  REPS(2) {
    for (int it = blockIdx.x; it < 1536 + 2048; it += gridDim.x) {
      if (it < 1536) attn_item(p, smem, it);
      else { const int q = it - 1536; lru_tile(p, smem, q >> 4, q & 15, 0); }
    }
    grid.sync();
  }
  REPS(3) {
    for (int it = blockIdx.x; it < MT * 16; it += gridDim.x) lru_tile(p, smem, it >> 4, it & 15, 1);
    grid.sync();
  }
  REPS(4) { phase_g3(p, smem); grid.sync(); }
  REPS(5) { phase_g4(p, smem); grid.sync(); }
  REPS(6) { phase_g5(p, smem); grid.sync(); }
  REPS(7) { phase_g6(p, smem); grid.sync(); }
  phase7(p);
}

extern "C" void kernel_launch(void* const* d_in, const int* in_sizes, int n_in, void* d_out, int out_size, void* d_ws,
                              size_t ws_size, hipStream_t stream) {
  static int grid_blocks = 0;
  if (!grid_blocks) {
    int dev = 0, cus = 0, per_cu = 0;
    hipGetDevice(&dev);
    hipDeviceGetAttribute(&cus, hipDeviceAttributeMultiprocessorCount, dev);
    hipFuncSetAttribute((const void*)fwd_megakernel, hipFuncAttributeMaxDynamicSharedMemorySize, SMEM_BYTES);
    hipOccupancyMaxActiveBlocksPerMultiprocessor(&per_cu, fwd_megakernel, 256, SMEM_BYTES);
    if (per_cu < 1) per_cu = 1;
    grid_blocks = cus * per_cu;
  }
  Params p{};
  const float** pp = (const float**)&p;
  for (int i = 0; i < 26; i++) pp[i] = (const float*)d_in[i];
  p.out = (float*)d_out;
  p.ws = (char*)d_ws;
  void* args[] = {&p};
  hipError_t e = hipLaunchCooperativeKernel((void*)fwd_megakernel, dim3(grid_blocks), dim3(256), args, SMEM_BYTES, stream);
  if (e != hipSuccess) fprintf(stderr, "cooperative launch failed: %s (grid %d)\n", hipGetErrorString(e), grid_blocks);
}
```

```cpp
#include <hip/hip_runtime.h>
#include <hip/hip_cooperative_groups.h>
#include <stdint.h>
#include <cstdio>
namespace cg = cooperative_groups;

typedef unsigned short u16;
typedef __attribute__((ext_vector_type(8))) short bf16x8;
typedef __attribute__((ext_vector_type(4))) float f32x4;

constexpr int D = 1024;
constexpr int NP = 16384;
constexpr int NTOK = 17408;
constexpr int SEQ = 4096;
constexpr int MT = 136;
constexpr float EPS = 1e-6f;

constexpr size_t O_Y = 0;
constexpr size_t O_CONVP = 17825792;
constexpr size_t O_LRUP = O_CONVP + 12288;
constexpr size_t O_KP = O_LRUP + 4096;
constexpr size_t O_VP = O_KP + 131072;
constexpr size_t O_CONVS = O_VP + 131072;
constexpr size_t O_LRUS = O_CONVS + 393216;
constexpr size_t O_KS = O_LRUS + 131072;
constexpr size_t O_VS = O_KS + 4194304;

constexpr size_t W_WTIN = 0;
constexpr size_t W_WTLRU = W_WTIN + (size_t)5632 * 1024 * 2;
constexpr size_t W_WTATTN = W_WTLRU + (size_t)1024 * 1024 * 2;
constexpr size_t W_WTOUT = W_WTATTN + (size_t)1024 * 1024 * 2;
constexpr size_t W_WTQ = W_WTOUT + (size_t)1024 * 1024 * 2;
constexpr size_t W_SK = W_WTQ + (size_t)2048 * 1024 * 2;
constexpr size_t W_RGA = W_SK + (size_t)16 * 128 * 128 * 2;
constexpr size_t W_RGX = W_RGA + (size_t)65536 * 2;
constexpr size_t W_EU = W_RGX + (size_t)65536 * 2;
constexpr size_t W_EV = W_EU + (size_t)16384 * 1024;
constexpr size_t W_ESC = W_EV + (size_t)16384 * 1024;
constexpr size_t W_XN = W_ESC + (size_t)32768 * 4;
constexpr size_t W_ZA = W_XN + (size_t)NTOK * 1024 * 2;
constexpr size_t W_ZB = W_ZA + (size_t)NTOK * 2048 * 2;
constexpr size_t W_AGG = W_ZB + (size_t)NTOK * 1536 * 2;
constexpr size_t W_SSQ = W_AGG + (size_t)128 * 1024 * 2 * 4;
constexpr size_t W_END = W_SSQ + (size_t)NTOK * 8 * 4;

constexpr int SMEM_BYTES = 81920;

struct Params {
  const float *x_prompt, *x_sample, *cache_conv, *state_lru, *cache_k, *cache_v, *norm1_g, *w_in, *conv_w,
      *conv_b, *rg_w_a, *rg_b_a, *rg_w_x, *rg_b_x, *rg_lambda, *q_norm_g, *k_norm_g, *attn_sinks,
      *w_branch_lru, *w_branch_attn, *w_out, *norm2_g, *peer_w_query, *peer_sub_keys, *expert_u, *expert_v;
  float* out;
  char* ws;
};

__device__ __forceinline__ u16 f2bf(float f) {
  uint32_t u = __float_as_uint(f);
  u += 0x7FFFu + ((u >> 16) & 1u);
  return (u16)(u >> 16);
}
__device__ __forceinline__ float bf2f(u16 h) { return __uint_as_float(((uint32_t)h) << 16); }
__device__ __forceinline__ uint32_t pack2(float a, float b) {
  return (uint32_t)f2bf(a) | ((uint32_t)f2bf(b) << 16);
}
__device__ __forceinline__ uint4 pack8(const float* v) {
  uint4 o;
  o.x = pack2(v[0], v[1]); o.y = pack2(v[2], v[3]); o.z = pack2(v[4], v[5]); o.w = pack2(v[6], v[7]);
  return o;
}
__device__ __forceinline__ void unpack8(uint4 u, float* v) {
  v[0] = __uint_as_float(u.x << 16); v[1] = __uint_as_float(u.x & 0xFFFF0000u);
  v[2] = __uint_as_float(u.y << 16); v[3] = __uint_as_float(u.y & 0xFFFF0000u);
  v[4] = __uint_as_float(u.z << 16); v[5] = __uint_as_float(u.z & 0xFFFF0000u);
  v[6] = __uint_as_float(u.w << 16); v[7] = __uint_as_float(u.w & 0xFFFF0000u);
}
__device__ __forceinline__ float sigmoidf_(float x) { return 1.f / (1.f + __expf(-x)); }
__device__ __forceinline__ float gelu_tanh(float x) {
  float y = 0.7978845608028654f * (x + 0.044715f * x * x * x);
  float t = 1.f - 2.f / (__expf(2.f * y) + 1.f);
  return 0.5f * x * (1.f + t);
}
__device__ __forceinline__ uint32_t ordf(float f) {
  uint32_t u = __float_as_uint(f);
  return (u & 0x80000000u) ? ~u : (u | 0x80000000u);
}
__device__ __forceinline__ float unordf(uint32_t o) {
  uint32_t u = (o & 0x80000000u) ? (o ^ 0x80000000u) : ~o;
  return __uint_as_float(u);
}
__device__ __forceinline__ int opaque_tid() {
  int t = threadIdx.x;
  asm volatile("" : "+v"(t));
  return t;
}
__device__ __forceinline__ const float* xrow(const Params& p, int row) {
  return row < NP ? p.x_prompt + (size_t)row * D : p.x_sample + (size_t)(row - NP) * D;
}

#define INS16(T, V)                                  \
  {                                                  \
    uint32_t _v = (V);                               \
    _Pragma("unroll") for (int _q = 0; _q < 16; _q++) { \
      uint32_t _hi = max(T[_q], _v);                 \
      _v = min(T[_q], _v);                           \
      T[_q] = _hi;                                   \
    }                                                \
  }

#define CE_DESC(A_, B_) { const uint32_t _h = max(A_, B_), _l = min(A_, B_); A_ = _h; B_ = _l; }
__device__ __forceinline__ void sort16_desc(uint32_t (&t)[16]) {
#pragma unroll
  for (int k = 2; k <= 16; k <<= 1) {
#pragma unroll
    for (int j = k >> 1; j > 0; j >>= 1) {
#pragma unroll
      for (int i = 0; i < 16; i++) {
        const int l = i ^ j;
        if (l > i) {
          if ((i & k) == 0) { CE_DESC(t[i], t[l]); } else { CE_DESC(t[l], t[i]); }
        }
      }
    }
  }
}
__device__ __forceinline__ void merge16_desc(uint32_t (&T)[16], const uint32_t (&S)[16]) {
#pragma unroll
  for (int i = 0; i < 16; i++) T[i] = max(T[i], S[15 - i]);
#pragma unroll
  for (int j = 8; j > 0; j >>= 1) {
#pragma unroll
    for (int i = 0; i < 16; i++) {
      const int l = i ^ j;
      if (l > i) { CE_DESC(T[i], T[l]); }
    }
  }
}

__device__ __forceinline__ void transpose_cvt(const float* __restrict__ W, u16* __restrict__ Wt, int K, int N,
                                              size_t gtid, size_t gsz) {
  size_t total = (size_t)N * (K / 8);
  for (size_t c = gtid; c < total; c += gsz) {
    int n = (int)(c % N);
    int kg = (int)(c / N);
    float v[8];
#pragma unroll
    for (int i = 0; i < 8; i++) v[i] = W[(size_t)(kg * 8 + i) * N + n];
    *(uint4*)(Wt + (size_t)n * K + kg * 8) = pack8(v);
  }
}
__device__ __forceinline__ void plain_cvt(const float* __restrict__ S, u16* __restrict__ Dst, size_t n, size_t gtid,
                                          size_t gsz) {
  size_t total = n / 8;
  const float4* s4 = (const float4*)S;
  for (size_t c = gtid; c < total; c += gsz) {
    float4 a = s4[2 * c], b = s4[2 * c + 1];
    float v[8] = {a.x, a.y, a.z, a.w, b.x, b.y, b.z, b.w};
    *(uint4*)(Dst + c * 8) = pack8(v);
  }
}

__device__ __forceinline__ void phase0(const Params& p, char* smem) {
  const int tid = opaque_tid();
  const size_t gtid = (size_t)blockIdx.x * 256 + tid, gsz = (size_t)gridDim.x * 256;
  char* ws = p.ws;
  {
    const int lane = tid & 63;
    const int gw = (int)(gtid >> 6), nw = (int)(gsz >> 6);
    u16* XN = (u16*)(ws + W_XN);
    for (int row = gw; row < NTOK; row += nw) {
      const float4* xr = (const float4*)xrow(p, row);
      float4 v[4];
      float ss = 0.f;
#pragma unroll
      for (int i = 0; i < 4; i++) {
        v[i] = xr[lane + i * 64];
        ss += v[i].x * v[i].x + v[i].y * v[i].y + v[i].z * v[i].z + v[i].w * v[i].w;
      }
#pragma unroll
      for (int o = 32; o > 0; o >>= 1) ss += __shfl_xor(ss, o);
      float rstd = rsqrtf(ss * (1.f / 1024.f) + EPS);
      const float4* g4 = (const float4*)p.norm1_g;
#pragma unroll
      for (int i = 0; i < 4; i++) {
        float4 g = g4[lane + i * 64];
        uint2 o;
        o.x = pack2(v[i].x * rstd * g.x, v[i].y * rstd * g.y);
        o.y = pack2(v[i].z * rstd * g.z, v[i].w * rstd * g.w);
        *(uint2*)(XN + (size_t)row * D + (lane + i * 64) * 4) = o;
      }
    }
  }
  {
    float* T = (float*)smem;
    for (int tile = blockIdx.x; tile < 2688; tile += gridDim.x) {
      const float* W;
      u16* Wt;
      int N, tl;
      if (tile < 1408) { W = p.w_in; Wt = (u16*)(ws + W_WTIN); N = 5632; tl = tile; }
      else if (tile < 1664) { W = p.w_branch_lru; Wt = (u16*)(ws + W_WTLRU); N = 1024; tl = tile - 1408; }
      else if (tile < 1920) { W = p.w_branch_attn; Wt = (u16*)(ws + W_WTATTN); N = 1024; tl = tile - 1664; }
      else if (tile < 2176) { W = p.w_out; Wt = (u16*)(ws + W_WTOUT); N = 1024; tl = tile - 1920; }
      else { W = p.peer_w_query; Wt = (u16*)(ws + W_WTQ); N = 2048; tl = tile - 2176; }
      const int ntn = N >> 6;
      const int kt = tl / ntn, nt = tl - kt * ntn;
      __syncthreads();
      {
        const float* src = W + (size_t)(kt * 64 + (tid >> 2)) * N + nt * 64 + (tid & 3) * 16;
        const float4 a0 = *(const float4*)src, a1 = *(const float4*)(src + 4), a2 = *(const float4*)(src + 8),
                     a3 = *(const float4*)(src + 12);
        float* d = T + (tid >> 2) * 65 + (tid & 3) * 16;
        d[0] = a0.x; d[1] = a0.y; d[2] = a0.z; d[3] = a0.w; d[4] = a1.x; d[5] = a1.y; d[6] = a1.z; d[7] = a1.w;
        d[8] = a2.x; d[9] = a2.y; d[10] = a2.z; d[11] = a2.w; d[12] = a3.x; d[13] = a3.y; d[14] = a3.z; d[15] = a3.w;
      }
      __syncthreads();
      {
        const int n = tid >> 2, kc = (tid & 3) * 16;
        float v[16];
#pragma unroll
        for (int i = 0; i < 16; i++) v[i] = T[(kc + i) * 65 + n];
        u16* dst = Wt + (size_t)(nt * 64 + n) * 1024 + kt * 64 + kc;
        *(uint4*)dst = pack8(v);
        *(uint4*)(dst + 8) = pack8(v + 8);
      }
    }
  }
  {
    u16* RA = (u16*)(ws + W_RGA);
    u16* RX = (u16*)(ws + W_RGX);
    for (size_t e = gtid; e < 65536; e += gsz) {
      int n = (int)(e >> 12), k = (int)((e >> 6) & 63), j = (int)(e & 63);
      RA[e] = f2bf(p.rg_w_a[n * 4096 + j * 64 + k]);
      RX[e] = f2bf(p.rg_w_x[n * 4096 + j * 64 + k]);
    }
  }
  plain_cvt(p.peer_sub_keys, (u16*)(ws + W_SK), (size_t)16 * 128 * 128, gtid, gsz);
  {
    const int lane = tid & 63;
    const int gw = (int)(gtid >> 6), nw = (int)(gsz >> 6);
    unsigned char* E8 = (unsigned char*)(ws + W_EU);
    float* ESC = (float*)(ws + W_ESC);
    for (int r = gw; r < 32768; r += nw) {
      const float* src = (r < 16384 ? p.expert_u : p.expert_v) + (size_t)(r & 16383) * 1024 + lane * 16;
      const float4 a0 = *(const float4*)src, a1 = *(const float4*)(src + 4), a2 = *(const float4*)(src + 8),
                   a3 = *(const float4*)(src + 12);
      float am = fmaxf(fmaxf(fmaxf(fabsf(a0.x), fabsf(a0.y)), fmaxf(fabsf(a0.z), fabsf(a0.w))),
                       fmaxf(fmaxf(fabsf(a1.x), fabsf(a1.y)), fmaxf(fabsf(a1.z), fabsf(a1.w))));
      am = fmaxf(am, fmaxf(fmaxf(fmaxf(fabsf(a2.x), fabsf(a2.y)), fmaxf(fabsf(a2.z), fabsf(a2.w))),
                           fmaxf(fmaxf(fabsf(a3.x), fabsf(a3.y)), fmaxf(fabsf(a3.z), fabsf(a3.w)))));
#pragma unroll
      for (int o = 32; o > 0; o >>= 1) am = fmaxf(am, __shfl_xor(am, o));
      const float sc = am > 0.f ? 224.f / am : 1.f;
      uint4 o4;
      int wv;
      wv = __builtin_amdgcn_cvt_pk_fp8_f32(a0.x * sc, a0.y * sc, 0, false);
      wv = __builtin_amdgcn_cvt_pk_fp8_f32(a0.z * sc, a0.w * sc, wv, true);
      o4.x = (uint32_t)wv;
      wv = __builtin_amdgcn_cvt_pk_fp8_f32(a1.x * sc, a1.y * sc, 0, false);
      wv = __builtin_amdgcn_cvt_pk_fp8_f32(a1.z * sc, a1.w * sc, wv, true);
      o4.y = (uint32_t)wv;
      wv = __builtin_amdgcn_cvt_pk_fp8_f32(a2.x * sc, a2.y * sc, 0, false);
      wv = __builtin_amdgcn_cvt_pk_fp8_f32(a2.z * sc, a2.w * sc, wv, true);
      o4.z = (uint32_t)wv;
      wv = __builtin_amdgcn_cvt_pk_fp8_f32(a3.x * sc, a3.y * sc, 0, false);
      wv = __builtin_amdgcn_cvt_pk_fp8_f32(a3.z * sc, a3.w * sc, wv, true);
      o4.w = (uint32_t)wv;
      *(uint4*)(E8 + (size_t)r * 1024 + lane * 16) = o4;
      if (lane == 0) ESC[r] = am > 0.f ? am * (1.f / 224.f) : 1.f;
    }
  }
}

constexpr int LDT = 72;
constexpr int CS_LD = 132;

__device__ __forceinline__ void gemm_tile(const u16* __restrict__ A, int lda, const u16* __restrict__ Bt, int ldb,
                                          int K, f32x4 (&acc)[4][4], char* smem, int tid) {
  const int lane = tid & 63, w = tid >> 6;
  const int wm = w >> 1, wn = w & 1;
  const int l15 = lane & 15, quad = lane >> 4;
  const int lr = w * 8 + (lane >> 3);
  const int lc = ((lane & 7) ^ ((lane >> 3) & 7)) * 8;
  const char* Ab = (const char*)A;
  const char* Bb = (const char*)Bt;
  const uint32_t ao = (uint32_t)(lr * lda + lc) * 2u, bo = (uint32_t)(lr * ldb + lc) * 2u;
  const uint32_t sa2 = 64u * (uint32_t)lda, sb2 = 64u * (uint32_t)ldb;
  const uint32_t kmask = (uint32_t)K - 1u, kst = (((uint32_t)blockIdx.x >> 3) * 64u) & kmask;
  char* lw = smem + w * 1024 + lane * 16;
  const int swz = l15 & 7;
  const char* Ar = smem + (wm * 64 + l15) * 128 + ((quad ^ swz) * 16);
  const char* Br = smem + 16384 + (wn * 64 + l15) * 128 + ((quad ^ swz) * 16);
  const char* Ar1 = smem + (wm * 64 + l15) * 128 + (((4 + quad) ^ swz) * 16);
  const char* Br1 = smem + 16384 + (wn * 64 + l15) * 128 + (((4 + quad) ^ swz) * 16);
#define GT_ISSUE(st, off)                                                                                   \
  {                                                                                                         \
    const uint32_t _o = (((uint32_t)(off) + kst) & kmask) * 2u;                                             \
    char* _l = lw + (st) * 32768;                                                                           \
    _Pragma("unroll") for (int j = 0; j < 4; j++) {                                                         \
      __builtin_amdgcn_global_load_lds((const unsigned*)(Ab + (size_t)(ao + j * sa2 + _o)), (unsigned*)(_l + j * 4096), 16, 0, 0);          \
      __builtin_amdgcn_global_load_lds((const unsigned*)(Bb + (size_t)(bo + j * sb2 + _o)), (unsigned*)(_l + 16384 + j * 4096), 16, 0, 0);  \
    }                                                                                                       \
  }
#define GT_MMA(st)                                                                                          \
  {                                                                                                         \
    const char* _ar = Ar + (st) * 32768; const char* _br = Br + (st) * 32768;                               \
    const char* _ar1 = Ar1 + (st) * 32768; const char* _br1 = Br1 + (st) * 32768;                           \
    bf16x8 a0[4], b0[4], a1[4], b1[4];                                                                      \
    _Pragma("unroll") for (int i = 0; i < 4; i++) {                                                         \
      a0[i] = *(const bf16x8*)(_ar + i * 2048);                                                             \
      b0[i] = *(const bf16x8*)(_br + i * 2048);                                                             \
    }                                                                                                       \
    _Pragma("unroll") for (int i = 0; i < 4; i++) {                                                         \
      a1[i] = *(const bf16x8*)(_ar1 + i * 2048);                                                            \
      b1[i] = *(const bf16x8*)(_br1 + i * 2048);                                                            \
    }                                                                                                       \
    _Pragma("unroll") for (int i = 0; i < 4; i++)                                                           \
      _Pragma("unroll") for (int j = 0; j < 4; j++)                                                         \
        acc[i][j] = __builtin_amdgcn_mfma_f32_16x16x32_bf16(a0[i], b0[j], acc[i][j], 0, 0, 0);              \
    _Pragma("unroll") for (int i = 0; i < 4; i++)                                                           \
      _Pragma("unroll") for (int j = 0; j < 4; j++)                                                         \
        acc[i][j] = __builtin_amdgcn_mfma_f32_16x16x32_bf16(a1[i], b1[j], acc[i][j], 0, 0, 0);              \
  }
  __syncthreads();
  GT_ISSUE(0, 0);
  for (int k0 = 0; k0 < K; k0 += 128) {
    asm volatile("s_waitcnt vmcnt(0) lgkmcnt(0)" ::: "memory");
    __builtin_amdgcn_s_barrier();
    asm volatile("" ::: "memory");
    GT_ISSUE(1, k0 + 64);
    GT_MMA(0);
    asm volatile("s_waitcnt vmcnt(0) lgkmcnt(0)" ::: "memory");
    __builtin_amdgcn_s_barrier();
    asm volatile("" ::: "memory");
    if (k0 + 128 < K) GT_ISSUE(0, k0 + 128);
    GT_MMA(1);
  }
#undef GT_ISSUE
#undef GT_MMA
}

__device__ __forceinline__ void tile_map(int it, int total, int NT, int& mt, int& nt) {
  const int G = gridDim.x;
  int T = it;
  if ((G & 7) == 0) {
    const int round = it / G, b = it - round * G;
    if (round * G + G <= total) T = round * G + (b & 7) * (G >> 3) + (b >> 3);
  }
  const int g = T / (8 * NT), r = T - g * (8 * NT);
  nt = r >> 3;
  mt = g * 8 + (r & 7);
}

__device__ __forceinline__ void zero_acc(f32x4 (&acc)[4][4]) {
#pragma unroll
  for (int i = 0; i < 4; i++)
#pragma unroll
    for (int j = 0; j < 4; j++) acc[i][j] = (f32x4){0.f, 0.f, 0.f, 0.f};
}

__device__ __forceinline__ void acc_to_cs(const f32x4 (&acc)[4][4], float* Cs, int tid) {
  const int lane = tid & 63, w = tid >> 6;
  const int wm = w >> 1, wn = w & 1;
  const int l15 = lane & 15, quad = lane >> 4;
#pragma unroll
  for (int i = 0; i < 4; i++)
#pragma unroll
    for (int j = 0; j < 4; j++)
#pragma unroll
      for (int e = 0; e < 4; e++)
        Cs[(wm * 64 + i * 16 + quad * 4 + e) * CS_LD + wn * 64 + j * 16 + l15] = acc[i][j][e];
}

__device__ __forceinline__ void phase_g1(const Params& p, char* smem) {
  const int tid = opaque_tid();
  u16* As = (u16*)smem;
  u16* Bs = As + 2 * 128 * LDT;
  float* Cs = (float*)smem;
  const u16* XN = (const u16*)(p.ws + W_XN);
  const u16* WT = (const u16*)(p.ws + W_WTIN);
  for (int t = blockIdx.x; t < MT * 44; t += gridDim.x) {
    int mt, nt;
    tile_map(t, MT * 44, 44, mt, nt);
    f32x4 acc[4][4];
    zero_acc(acc);
    gemm_tile(XN + (size_t)mt * 128 * 1024, 1024, WT + (size_t)nt * 128 * 1024, 1024, 1024, acc, smem, tid);
    __syncthreads();
    acc_to_cs(acc, Cs, tid);
    __syncthreads();
    const int n0 = nt * 128;
    u16* dst;
    int ldd, col;
    if (n0 < 2048) { dst = (u16*)(p.ws + W_ZA); ldd = 2048; col = n0; }
    else if (n0 < 3584) { dst = (u16*)(p.ws + W_ZB); ldd = 1536; col = n0 - 2048; }
    else { dst = (u16*)p.out; ldd = 2048; col = n0 - 3584; }
    const int cc = (tid & 15) * 8;
#pragma unroll
    for (int i = 0; i < 8; i++) {
      const int r = (tid >> 4) + 16 * i;
      float4 a = *(const float4*)(Cs + r * CS_LD + cc), b = *(const float4*)(Cs + r * CS_LD + cc + 4);
      float v[8] = {a.x, a.y, a.z, a.w, b.x, b.y, b.z, b.w};
      *(uint4*)(dst + (size_t)(mt * 128 + r) * ldd + col + cc) = pack8(v);
    }
    __syncthreads();
  }
}

constexpr int KS_LD = 72, VT_LD = 200, PS_LD = 168;
__device__ __forceinline__ void attn_item(const Params& p, char* smem, int item) {
  const int tid = opaque_tid(), lane = tid & 63, w = tid >> 6, l15 = lane & 15, quad = lane >> 4;
  u16* Ks = (u16*)smem;
  u16* Vt = Ks + 192 * KS_LD;
  u16* Ps = Vt + 64 * VT_LD + w * 16 * PS_LD;
  const u16* ZB = (const u16*)(p.ws + W_ZB);
  u16* ATT = (u16*)(p.ws + W_XN);
  const bool sample = item >= 1024;
  int b, qb = 0, kv, rowbase, p0 = 0;
  if (!sample) {
    kv = item & 3; qb = (item >> 2) & 63; b = item >> 8;
    p0 = qb * 64;
    rowbase = b * SEQ + p0;
  } else {
    int it = item - 1024;
    kv = it & 3; b = it >> 2;
    rowbase = NP + b * 8;
  }
  __syncthreads();
  {
    const int ch = tid & 7;
    float kg[8];
#pragma unroll
    for (int i = 0; i < 8; i++) kg[i] = p.k_norm_g[ch * 8 + i];
    const int nrows = sample ? 160 : 192;
    for (int c = tid; c < nrows * 8; c += 256) {
      const int row = c >> 3;
      float kf[8], vf[8];
      bool valid, donorm;
      if (!sample) {
        const int pos = p0 - 128 + row;
        valid = pos >= 0;
        donorm = true;
        if (valid) {
          const u16* src = ZB + (size_t)(b * SEQ + pos) * 1536 + 1024 + kv * 64 + ch * 8;
          unpack8(*(const uint4*)src, kf);
          unpack8(*(const uint4*)(src + 256), vf);
        }
      } else {
        valid = row < 136;
        donorm = row >= 128;
        if (row < 128) {
          const float* sk = p.cache_k + ((size_t)(b * 128 + row) * 4 + kv) * 64 + ch * 8;
          const float* sv = p.cache_v + ((size_t)(b * 128 + row) * 4 + kv) * 64 + ch * 8;
          float4 a0 = *(const float4*)sk, a1 = *(const float4*)(sk + 4);
          float4 b0 = *(const float4*)sv, b1 = *(const float4*)(sv + 4);
          kf[0] = a0.x; kf[1] = a0.y; kf[2] = a0.z; kf[3] = a0.w; kf[4] = a1.x; kf[5] = a1.y; kf[6] = a1.z; kf[7] = a1.w;
          vf[0] = b0.x; vf[1] = b0.y; vf[2] = b0.z; vf[3] = b0.w; vf[4] = b1.x; vf[5] = b1.y; vf[6] = b1.z; vf[7] = b1.w;
        } else if (valid) {
          const u16* src = ZB + (size_t)(NP + b * 8 + (row - 128)) * 1536 + 1024 + kv * 64 + ch * 8;
          unpack8(*(const uint4*)src, kf);
          unpack8(*(const uint4*)(src + 256), vf);
        }
      }
      if (!valid) {
#pragma unroll
        for (int i = 0; i < 8; i++) { kf[i] = 0.f; vf[i] = 0.f; }
      }
      float ss = 0.f;
#pragma unroll
      for (int i = 0; i < 8; i++) ss += kf[i] * kf[i];
      ss += __shfl_xor(ss, 1);
      ss += __shfl_xor(ss, 2);
      ss += __shfl_xor(ss, 4);
      if (donorm) {
        const float rstd = rsqrtf(ss * (1.f / 64.f) + EPS);
#pragma unroll
        for (int i = 0; i < 8; i++) kf[i] = kf[i] * rstd * kg[i];
      }
      *(uint4*)(Ks + row * KS_LD + ch * 8) = pack8(kf);
#pragma unroll
      for (int i = 0; i < 8; i++) Vt[(ch * 8 + i) * VT_LD + row] = f2bf(vf[i]);
      if (!sample) {
        if (qb >= 62 && row >= 128) {
          const int wpos = p0 + (row - 128) - (SEQ - 128);
          float* ko = p.out + O_KP + ((size_t)(b * 128 + wpos) * 4 + kv) * 64 + ch * 8;
          float* vo = p.out + O_VP + ((size_t)(b * 128 + wpos) * 4 + kv) * 64 + ch * 8;
          *(float4*)ko = make_float4(kf[0], kf[1], kf[2], kf[3]);
          *(float4*)(ko + 4) = make_float4(kf[4], kf[5], kf[6], kf[7]);
          *(float4*)vo = make_float4(vf[0], vf[1], vf[2], vf[3]);
          *(float4*)(vo + 4) = make_float4(vf[4], vf[5], vf[6], vf[7]);
        }
      } else {
        if (row >= 8 && row < 136) {
          float* ko = p.out + O_KS + ((size_t)(b * 128 + (row - 8)) * 4 + kv) * 64 + ch * 8;
          float* vo = p.out + O_VS + ((size_t)(b * 128 + (row - 8)) * 4 + kv) * 64 + ch * 8;
          *(float4*)ko = make_float4(kf[0], kf[1], kf[2], kf[3]);
          *(float4*)(ko + 4) = make_float4(kf[4], kf[5], kf[6], kf[7]);
          *(float4*)vo = make_float4(vf[0], vf[1], vf[2], vf[3]);
          *(float4*)(vo + 4) = make_float4(vf[4], vf[5], vf[6], vf[7]);
        }
      }
    }
  }
  __syncthreads();
  const int hq = kv * 4 + w;
  const float slope = exp2f(-0.5f * (float)(hq + 1));
  const float sink = p.attn_sinks[hq];
  float qg[2][8];
#pragma unroll
  for (int ks = 0; ks < 2; ks++)
#pragma unroll
    for (int i = 0; i < 8; i++) qg[ks][i] = p.q_norm_g[ks * 32 + quad * 8 + i] * 0.125f;
  const int nsub = sample ? 1 : 4;
  for (int sb = 0; sb < nsub; sb++) {
    const int r0 = sb * 16;
    const int ws0 = r0 < 32 ? r0 : 32;
    bf16x8 qa[2];
    {
      const int qr = sample ? (l15 & 7) : (r0 + l15);
      const u16* src = ZB + (size_t)(rowbase + qr) * 1536 + hq * 64 + quad * 8;
      float q0[8], q1[8];
      unpack8(*(const uint4*)src, q0);
      unpack8(*(const uint4*)(src + 32), q1);
      float ss = 0.f;
#pragma unroll
      for (int i = 0; i < 8; i++) ss += q0[i] * q0[i] + q1[i] * q1[i];
      ss += __shfl_xor(ss, 16);
      ss += __shfl_xor(ss, 32);
      const float rstd = rsqrtf(ss * (1.f / 64.f) + EPS);
#pragma unroll
      for (int i = 0; i < 8; i++) { q0[i] *= rstd * qg[0][i]; q1[i] *= rstd * qg[1][i]; }
      uint4 u0 = pack8(q0), u1 = pack8(q1);
      qa[0] = __builtin_bit_cast(bf16x8, u0);
      qa[1] = __builtin_bit_cast(bf16x8, u1);
    }
    f32x4 s[10];
#pragma unroll
    for (int kt = 0; kt < 10; kt++) {
      const u16* kp = Ks + (ws0 + kt * 16 + l15) * KS_LD + quad * 8;
      bf16x8 b0 = *(const bf16x8*)kp, b1 = *(const bf16x8*)(kp + 32);
      f32x4 z = {0.f, 0.f, 0.f, 0.f};
      z = __builtin_amdgcn_mfma_f32_16x16x32_bf16(qa[0], b0, z, 0, 0, 0);
      s[kt] = __builtin_amdgcn_mfma_f32_16x16x32_bf16(qa[1], b1, z, 0, 0, 0);
    }
    float mx[4] = {-1e30f, -1e30f, -1e30f, -1e30f};
#pragma unroll
    for (int kt = 0; kt < 10; kt++) {
      const int jj = ws0 + kt * 16 + l15;
      const bool posok = sample ? (jj < 136) : (p0 - 128 + jj >= 0);
#pragma unroll
      for (int e = 0; e < 4; e++) {
        const int r = r0 + quad * 4 + e;
        const int dist = r + 128 - jj;
        const bool ok = posok && dist >= 0 && dist <= 128;
        float v = ok ? (s[kt][e] - slope * (float)dist) : -1e30f;
        s[kt][e] = v;
        mx[e] = fmaxf(mx[e], v);
      }
    }
    float sum[4];
#pragma unroll
    for (int e = 0; e < 4; e++) {
      float m = mx[e];
      m = fmaxf(m, __shfl_xor(m, 1));
      m = fmaxf(m, __shfl_xor(m, 2));
      m = fmaxf(m, __shfl_xor(m, 4));
      m = fmaxf(m, __shfl_xor(m, 8));
      m = fmaxf(m, sink);
      mx[e] = m;
      sum[e] = 0.f;
    }
#pragma unroll
    for (int kt = 0; kt < 10; kt++) {
#pragma unroll
      for (int e = 0; e < 4; e++) {
        float pv = __expf(s[kt][e] - mx[e]);
        sum[e] += pv;
        Ps[(quad * 4 + e) * PS_LD + kt * 16 + l15] = f2bf(pv);
      }
    }
#pragma unroll
    for (int e = 0; e < 4; e++) {
      float t = sum[e];
      t += __shfl_xor(t, 1);
      t += __shfl_xor(t, 2);
      t += __shfl_xor(t, 4);
      t += __shfl_xor(t, 8);
      sum[e] = 1.f / (t + __expf(sink - mx[e]));
    }
    __syncthreads();
    f32x4 o[4];
#pragma unroll
    for (int nt = 0; nt < 4; nt++) o[nt] = (f32x4){0.f, 0.f, 0.f, 0.f};
#pragma unroll
    for (int kk = 0; kk < 5; kk++) {
      bf16x8 pa = *(const bf16x8*)(Ps + l15 * PS_LD + kk * 32 + quad * 8);
#pragma unroll
      for (int nt = 0; nt < 4; nt++) {
        bf16x8 vb = *(const bf16x8*)(Vt + (nt * 16 + l15) * VT_LD + ws0 + kk * 32 + quad * 8);
        o[nt] = __builtin_amdgcn_mfma_f32_16x16x32_bf16(pa, vb, o[nt], 0, 0, 0);
      }
    }
#pragma unroll
    for (int e = 0; e < 4; e++) {
      const int r = quad * 4 + e;
      if (!sample || r < 8) {
        u16* dst = ATT + (size_t)(rowbase + r0 + r) * 1024 + hq * 64 + l15;
#pragma unroll
        for (int nt = 0; nt < 4; nt++) dst[nt * 16] = f2bf(o[nt][e] * sum[e]);
      }
    }
    __syncthreads();
  }
}

constexpr int XC_LD = 68;
__device__ __forceinline__ void lru_tile(const Params& p, char* smem, int mt, int nb, int mode) {
  const int tid = opaque_tid(), lane = tid & 63, w = tid >> 6, l15 = lane & 15, quad = lane >> 4;
  float* xcF = (float*)smem;
  float* aL = xcF + 128 * XC_LD;
  float* aggL = aL + 128 * XC_LD;
  const u16* ZA = (const u16*)(p.ws + W_ZA);
  const bool sample = mt >= 128;
  const int m0 = mt * 128;
  const int cb = nb * 64;
  __syncthreads();
  {
    const int ch = tid & 7;
    float cw[4][8], cbias[8];
#pragma unroll
    for (int j = 0; j < 4; j++)
#pragma unroll
      for (int i = 0; i < 8; i++) cw[j][i] = p.conv_w[j * 1024 + cb + ch * 8 + i];
#pragma unroll
    for (int i = 0; i < 8; i++) cbias[i] = p.conv_b[cb + ch * 8 + i];
#pragma unroll
    for (int it = 0; it < 4; it++) {
      const int r = (tid >> 3) + it * 32;
      const int grow = m0 + r;
      const int t = sample ? (r & 7) : ((mt & 31) * 128 + r);
      float y[8];
#pragma unroll
      for (int i = 0; i < 8; i++) y[i] = cbias[i];
#pragma unroll
      for (int d = 0; d < 4; d++) {
        float xv[8];
        if (t - d >= 0) {
          unpack8(*(const uint4*)(ZA + (size_t)(grow - d) * 2048 + cb + ch * 8), xv);
        } else if (sample) {
          const int bb = (m0 - NP + r) >> 3;
          const float* src = p.cache_conv + ((size_t)bb * 3 + (3 + t - d)) * 1024 + cb + ch * 8;
          float4 a = *(const float4*)src, b4 = *(const float4*)(src + 4);
          xv[0] = a.x; xv[1] = a.y; xv[2] = a.z; xv[3] = a.w; xv[4] = b4.x; xv[5] = b4.y; xv[6] = b4.z; xv[7] = b4.w;
        } else {
#pragma unroll
          for (int i = 0; i < 8; i++) xv[i] = 0.f;
        }
#pragma unroll
        for (int i = 0; i < 8; i++) y[i] += cw[3 - d][i] * xv[i];
        if (d == 0 && mode == 1) {
          if (!sample) {
            if ((mt & 31) == 31 && r >= 125) {
              float* dst = p.out + O_CONVP + ((size_t)(mt >> 5) * 3 + (r - 125)) * 1024 + cb + ch * 8;
              *(float4*)dst = make_float4(xv[0], xv[1], xv[2], xv[3]);
              *(float4*)(dst + 4) = make_float4(xv[4], xv[5], xv[6], xv[7]);
            }
          } else if (t >= 5) {
            const int bb = (m0 - NP + r) >> 3;
            float* dst = p.out + O_CONVS + ((size_t)bb * 3 + (t - 5)) * 1024 + cb + ch * 8;
            *(float4*)dst = make_float4(xv[0], xv[1], xv[2], xv[3]);
            *(float4*)(dst + 4) = make_float4(xv[4], xv[5], xv[6], xv[7]);
          }
        }
      }
      *(float4*)(xcF + r * XC_LD + ch * 8) = make_float4(y[0], y[1], y[2], y[3]);
      *(float4*)(xcF + r * XC_LD + ch * 8 + 4) = make_float4(y[4], y[5], y[6], y[7]);
    }
  }
  __syncthreads();
  {
    const u16* RA = (const u16*)(p.ws + W_RGA) + nb * 4096;
    const u16* RX = (const u16*)(p.ws + W_RGX) + nb * 4096;
    f32x4 aR[2][4], aI[2][4];
#pragma unroll
    for (int i = 0; i < 2; i++)
#pragma unroll
      for (int j = 0; j < 4; j++) { aR[i][j] = (f32x4){0.f, 0.f, 0.f, 0.f}; aI[i][j] = (f32x4){0.f, 0.f, 0.f, 0.f}; }
#pragma unroll
    for (int ks = 0; ks < 2; ks++) {
      bf16x8 a[2];
#pragma unroll
      for (int i = 0; i < 2; i++) {
        const float* src = xcF + (w * 32 + i * 16 + l15) * XC_LD + ks * 32 + quad * 8;
        float4 x0 = *(const float4*)src, x1 = *(const float4*)(src + 4);
        float v[8] = {x0.x, x0.y, x0.z, x0.w, x1.x, x1.y, x1.z, x1.w};
        uint4 u = pack8(v);
        a[i] = __builtin_bit_cast(bf16x8, u);
      }
#pragma unroll
      for (int j = 0; j < 4; j++) {
        bf16x8 ba = *(const bf16x8*)(RA + (j * 16 + l15) * 64 + ks * 32 + quad * 8);
        bf16x8 bx = *(const bf16x8*)(RX + (j * 16 + l15) * 64 + ks * 32 + quad * 8);
#pragma unroll
        for (int i = 0; i < 2; i++) {
          aR[i][j] = __builtin_amdgcn_mfma_f32_16x16x32_bf16(a[i], ba, aR[i][j], 0, 0, 0);
          aI[i][j] = __builtin_amdgcn_mfma_f32_16x16x32_bf16(a[i], bx, aI[i][j], 0, 0, 0);
        }
      }
    }
#pragma unroll
    for (int j = 0; j < 4; j++) {
      const int c = cb + j * 16 + l15;
      const float ba = p.rg_b_a[c], bx = p.rg_b_x[c];
      const float ls = -log1pf(__expf(-p.rg_lambda[c]));
#pragma unroll
      for (int i = 0; i < 2; i++)
#pragma unroll
        for (int e = 0; e < 4; e++) {
          const int row = w * 32 + i * 16 + quad * 4 + e;
          const float rg = sigmoidf_(aR[i][j][e] + ba);
          const float ig = sigmoidf_(aI[i][j][e] + bx);
          const float la = 8.f * rg * ls;
          const float av = __expf(la);
          const float mult = sqrtf(fmaxf(-expm1f(2.f * la), 0.f));
          const int idx = row * XC_LD + j * 16 + l15;
          const float xv = xcF[idx];
          aL[idx] = av;
          xcF[idx] = mult * ig * xv;
        }
    }
  }
  __syncthreads();
  const int c = cb + lane;
  float* carL = aggL + 512;
  if (!sample) {
    float* AGGP = (float*)(p.ws + W_AGG);
    float* AGGH = AGGP + 128 * 1024;
    const int chunk = mt & 31, base = mt - chunk;
    if (mode == 1) {
      float Pq[8], Hq[8];
#pragma unroll
      for (int k = 0; k < 8; k++) {
        const int q = w * 8 + k;
        const bool ok = q < chunk;
        Pq[k] = ok ? AGGP[(base + q) * 1024 + c] : 1.f;
        Hq[k] = ok ? AGGH[(base + q) * 1024 + c] : 0.f;
      }
      float Pc = 1.f, hc = 0.f;
#pragma unroll
      for (int k = 0; k < 8; k++) { hc = Pq[k] * hc + Hq[k]; Pc *= Pq[k]; }
      carL[(w * 64 + lane) * 2] = Pc;
      carL[(w * 64 + lane) * 2 + 1] = hc;
    }
    float P = 1.f, h = 0.f;
#pragma unroll 8
    for (int rr = 0; rr < 32; rr++) {
      const float av = aL[(w * 32 + rr) * XC_LD + lane], bv = xcF[(w * 32 + rr) * XC_LD + lane];
      h = av * h + bv;
      P *= av;
    }
    aggL[(w * 64 + lane) * 2] = P;
    aggL[(w * 64 + lane) * 2 + 1] = h;
    __syncthreads();
    if (mode == 0) {
      if (w == 0) {
        float Pt = 1.f, ht = 0.f;
#pragma unroll
        for (int q = 0; q < 4; q++) {
          const float Pq = aggL[(q * 64 + lane) * 2], hq = aggL[(q * 64 + lane) * 2 + 1];
          ht = Pq * ht + hq;
          Pt *= Pq;
        }
        AGGP[mt * 1024 + c] = Pt;
        AGGH[mt * 1024 + c] = ht;
      }
    } else {
      float hin = 0.f;
#pragma unroll
      for (int q = 0; q < 4; q++) hin = carL[(q * 64 + lane) * 2] * hin + carL[(q * 64 + lane) * 2 + 1];
      for (int q = 0; q < w; q++) hin = aggL[(q * 64 + lane) * 2] * hin + aggL[(q * 64 + lane) * 2 + 1];
      float hh = hin;
#pragma unroll 8
      for (int rr = 0; rr < 32; rr++) {
        const int row = w * 32 + rr;
        const float av = aL[row * XC_LD + lane], bv = xcF[row * XC_LD + lane];
        hh = av * hh + bv;
        xcF[row * XC_LD + lane] = hh;
      }
      if (chunk == 31 && w == 3) p.out[O_LRUP + (size_t)(mt >> 5) * 1024 + c] = hh;
    }
  } else {
    float hh = 0.f;
    float h0v[4];
#pragma unroll
    for (int k = 0; k < 4; k++) h0v[k] = p.state_lru[(size_t)(((m0 - NP + w * 32) >> 3) + k) * 1024 + c];
#pragma unroll
    for (int rr = 0; rr < 32; rr++) {
      const int row = w * 32 + rr;
      const int bb = (m0 - NP + row) >> 3;
      const int t = row & 7;
      if (t == 0) hh = h0v[rr >> 3];
      const float av = aL[row * XC_LD + lane], bv = xcF[row * XC_LD + lane];
      hh = av * hh + bv;
      xcF[row * XC_LD + lane] = hh;
      if (t == 7) p.out[O_LRUS + (size_t)bb * 1024 + c] = hh;
    }
  }
  if (mode == 1) {
    __syncthreads();
    u16* LO = (u16*)(p.ws + W_ZB);
    const int ch = tid & 7;
#pragma unroll
    for (int it = 0; it < 4; it++) {
      const int r = (tid >> 3) + it * 32;
      float g[8];
      unpack8(*(const uint4*)(ZA + (size_t)(m0 + r) * 2048 + 1024 + cb + ch * 8), g);
      const float4 h0 = *(const float4*)(xcF + r * XC_LD + ch * 8), h1 = *(const float4*)(xcF + r * XC_LD + ch * 8 + 4);
      float v[8] = {h0.x * gelu_tanh(g[0]), h0.y * gelu_tanh(g[1]), h0.z * gelu_tanh(g[2]), h0.w * gelu_tanh(g[3]),
                    h1.x * gelu_tanh(g[4]), h1.y * gelu_tanh(g[5]), h1.z * gelu_tanh(g[6]), h1.w * gelu_tanh(g[7])};
      *(uint4*)(LO + (size_t)(m0 + r) * 1024 + cb + ch * 8) = pack8(v);
    }
  }
}

__device__ __forceinline__ void phase_g3(const Params& p, char* smem) {
  const int tid = opaque_tid();
  u16* As = (u16*)smem;
  u16* Bs = As + 2 * 128 * LDT;
  float* Cs = (float*)smem;
  const u16* LO = (const u16*)(p.ws + W_ZB);
  const u16* ATT = (const u16*)(p.ws + W_XN);
  const u16* WL = (const u16*)(p.ws + W_WTLRU);
  const u16* WA = (const u16*)(p.ws + W_WTATTN);
  const u16* ZC = (const u16*)p.out;
  u16* MG = (u16*)(p.ws + W_ZA);
  for (int t = blockIdx.x; t < MT * 8; t += gridDim.x) {
    int mt, nt;
    tile_map(t, MT * 8, 8, mt, nt);
    const int cc = (tid & 15) * 8;
#pragma unroll
    for (int pass = 0; pass < 2; pass++) {
      f32x4 acc[4][4];
      zero_acc(acc);
      gemm_tile((pass ? ATT : LO) + (size_t)mt * 128 * 1024, 1024, (pass ? WA : WL) + (size_t)nt * 128 * 1024, 1024, 1024,
                acc, smem, tid);
      __syncthreads();
      acc_to_cs(acc, Cs, tid);
      __syncthreads();
#pragma unroll
      for (int i = 0; i < 8; i++) {
        const int r = (tid >> 4) + 16 * i;
        const size_t row = (size_t)(mt * 128 + r);
        float4 a = *(const float4*)(Cs + r * CS_LD + cc), b = *(const float4*)(Cs + r * CS_LD + cc + 4);
        float v[8] = {a.x, a.y, a.z, a.w, b.x, b.y, b.z, b.w};
        float g[8];
        unpack8(*(const uint4*)(ZC + row * 2048 + pass * 1024 + nt * 128 + cc), g);
        u16* mp = MG + row * 1024 + nt * 128 + cc;
        if (pass == 0) {
#pragma unroll
          for (int q = 0; q < 8; q++) v[q] *= sigmoidf_(g[q]);
        } else {
          float pv[8];
          unpack8(*(const uint4*)mp, pv);
#pragma unroll
          for (int q = 0; q < 8; q++) v[q] = pv[q] + v[q] * sigmoidf_(g[q]);
        }
        *(uint4*)mp = pack8(v);
      }
      __syncthreads();
    }
  }
}

__device__ __forceinline__ void phase_g4(const Params& p, char* smem) {
  const int tid = opaque_tid();
  u16* As = (u16*)smem;
  u16* Bs = As + 2 * 128 * LDT;
  float* Cs = (float*)smem;
  const u16* MG = (const u16*)(p.ws + W_ZA);
  const u16* WO = (const u16*)(p.ws + W_WTOUT);
  u16* HG = (u16*)(p.ws + W_ZB);
  float* SSQ = (float*)(p.ws + W_SSQ);
  for (int t = blockIdx.x; t < MT * 8; t += gridDim.x) {
    int mt, nt;
    tile_map(t, MT * 8, 8, mt, nt);
    f32x4 acc[4][4];
    zero_acc(acc);
    gemm_tile(MG + (size_t)mt * 128 * 1024, 1024, WO + (size_t)nt * 128 * 1024, 1024, 1024, acc, smem, tid);
    __syncthreads();
    acc_to_cs(acc, Cs, tid);
    __syncthreads();
    const int cc = (tid & 15) * 8;
    const float4 g0 = *(const float4*)(p.norm2_g + nt * 128 + cc), g1 = *(const float4*)(p.norm2_g + nt * 128 + cc + 4);
#pragma unroll
    for (int i = 0; i < 8; i++) {
      const int r = (tid >> 4) + 16 * i;
      const int row = mt * 128 + r;
      float4 a = *(const float4*)(Cs + r * CS_LD + cc), b = *(const float4*)(Cs + r * CS_LD + cc + 4);
      const float* xr = xrow(p, row) + nt * 128 + cc;
      float4 x0 = *(const float4*)xr, x1 = *(const float4*)(xr + 4);
      a.x += x0.x; a.y += x0.y; a.z += x0.z; a.w += x0.w;
      b.x += x1.x; b.y += x1.y; b.z += x1.z; b.w += x1.w;
      float* ho = p.out + O_Y + (size_t)row * 1024 + nt * 128 + cc;
      *(float4*)ho = a;
      *(float4*)(ho + 4) = b;
      float v[8] = {a.x * g0.x, a.y * g0.y, a.z * g0.z, a.w * g0.w, b.x * g1.x, b.y * g1.y, b.z * g1.z, b.w * g1.w};
      *(uint4*)(HG + (size_t)row * 1024 + nt * 128 + cc) = pack8(v);
      float ss = a.x * a.x + a.y * a.y + a.z * a.z + a.w * a.w + b.x * b.x + b.y * b.y + b.z * b.z + b.w * b.w;
      ss += __shfl_xor(ss, 1);
      ss += __shfl_xor(ss, 2);
      ss += __shfl_xor(ss, 4);
      ss += __shfl_xor(ss, 8);
      if ((tid & 15) == 0) SSQ[(size_t)row * 8 + nt] = ss;
    }
    __syncthreads();
  }
}

__device__ __forceinline__ float row_rstd(const float* SSQ, int row) {
  const float4 a = *(const float4*)(SSQ + (size_t)row * 8), b = *(const float4*)(SSQ + (size_t)row * 8 + 4);
  const float ss = ((a.x + a.y) + (a.z + a.w)) + ((b.x + b.y) + (b.z + b.w));
  return rsqrtf(ss * (1.f / 1024.f) + EPS);
}

__device__ __forceinline__ void phase_g5(const Params& p, char* smem) {
  const int tid = opaque_tid();
  u16* As = (u16*)smem;
  u16* Bs = As + 2 * 128 * LDT;
  float* Cs = (float*)smem;
  const u16* HG = (const u16*)(p.ws + W_ZB);
  const u16* WQ = (const u16*)(p.ws + W_WTQ);
  const float* SSQ = (const float*)(p.ws + W_SSQ);
  u16* QR = (u16*)(p.ws + W_ZA);
  for (int t = blockIdx.x; t < MT * 16; t += gridDim.x) {
    int mt, nt;
    tile_map(t, MT * 16, 16, mt, nt);
    f32x4 acc[4][4];
    zero_acc(acc);
    gemm_tile(HG + (size_t)mt * 128 * 1024, 1024, WQ + (size_t)nt * 128 * 1024, 1024, 1024, acc, smem, tid);
    __syncthreads();
    acc_to_cs(acc, Cs, tid);
    __syncthreads();
    const int cc = (tid & 15) * 8;
#pragma unroll
    for (int i = 0; i < 8; i++) {
      const int r = (tid >> 4) + 16 * i;
      const int row = mt * 128 + r;
      const float rs = row_rstd(SSQ, row);
      float4 a = *(const float4*)(Cs + r * CS_LD + cc), b = *(const float4*)(Cs + r * CS_LD + cc + 4);
      float v[8] = {a.x * rs, a.y * rs, a.z * rs, a.w * rs, b.x * rs, b.y * rs, b.z * rs, b.w * rs};
      *(uint4*)(QR + (size_t)row * 2048 + nt * 128 + cc) = pack8(v);
    }
    __syncthreads();
  }
}

__device__ __forceinline__ void phase_g6(const Params& p, char* smem) {
  const int tid = opaque_tid();
  u16* As = (u16*)smem;
  u16* Bs = As + 2 * 128 * LDT;
  float* Cs = (float*)smem;
  uint32_t* Cu = (uint32_t*)smem;
  uint32_t* TK0 = (uint32_t*)(smem + 4 * 128 * LDT * 2);
  const u16* QR = (const u16*)(p.ws + W_ZA);
  const u16* SK = (const u16*)(p.ws + W_SK);
  int* IDX = (int*)(p.ws + W_XN);
  float* GW = (float*)(p.ws + W_XN + (size_t)NTOK * 128 * 4);
  const int row = tid >> 1, half = tid & 1;
  for (int t = blockIdx.x; t < MT * 8; t += gridDim.x) {
    int mt, h;
    tile_map(t, MT * 8, 8, mt, h);
    uint32_t tk[16];
    for (int pp = 0; pp < 2; pp++) {
      f32x4 acc[4][4];
      zero_acc(acc);
      gemm_tile(QR + (size_t)mt * 128 * 2048 + h * 256 + pp * 128, 2048, SK + (size_t)(h * 2 + pp) * 16384, 128, 128, acc,
                smem, tid);
      __syncthreads();
      acc_to_cs(acc, Cs, tid);
      __syncthreads();
#pragma unroll
      for (int g = 0; g < 4; g++) {
        uint32_t sg[16];
#pragma unroll
        for (int q4 = 0; q4 < 4; q4++) {
          const int col = half * 64 + g * 16 + q4 * 4;
          const float4 v = *(const float4*)(Cs + row * CS_LD + col);
          sg[q4 * 4 + 0] = (ordf(v.x) & ~0x7Fu) | (uint32_t)(127 - col);
          sg[q4 * 4 + 1] = (ordf(v.y) & ~0x7Fu) | (uint32_t)(126 - col);
          sg[q4 * 4 + 2] = (ordf(v.z) & ~0x7Fu) | (uint32_t)(125 - col);
          sg[q4 * 4 + 3] = (ordf(v.w) & ~0x7Fu) | (uint32_t)(124 - col);
        }
        sort16_desc(sg);
        if (g == 0) {
#pragma unroll
          for (int q = 0; q < 16; q++) tk[q] = sg[q];
        } else {
          merge16_desc(tk, sg);
        }
      }
      __syncthreads();
      if (half == 1) {
#pragma unroll
        for (int q = 0; q < 16; q++) Cu[row * 16 + q] = tk[q];
      }
      __syncthreads();
      if (half == 0) {
        {
          uint32_t sg[16];
#pragma unroll
          for (int q4 = 0; q4 < 4; q4++) {
            const uint4 u = *(const uint4*)(Cu + row * 16 + q4 * 4);
            sg[q4 * 4] = u.x; sg[q4 * 4 + 1] = u.y; sg[q4 * 4 + 2] = u.z; sg[q4 * 4 + 3] = u.w;
          }
          merge16_desc(tk, sg);
        }
        if (pp == 0) {
#pragma unroll
          for (int q = 0; q < 16; q++) TK0[row * 16 + q] = tk[q];
        } else {
#pragma unroll
          for (int q = 0; q < 16; q++) Cu[2048 + row * 16 + q] = tk[q];
        }
      }
      __syncthreads();
    }
    if (half == 0) {
      float va[16], vb[16];
#pragma unroll
      for (int q = 0; q < 16; q++) {
        va[q] = unordf(TK0[row * 16 + q] & ~0x7Fu);
        vb[q] = unordf(tk[q] & ~0x7Fu);
      }
      uint32_t cd[16];
#pragma unroll
      for (int q = 0; q < 16; q++) cd[q] = (ordf(va[0] + vb[q]) & ~0xFFu) | (uint32_t)(255 - q);
#pragma unroll
      for (int i = 1; i < 16; i++) {
#pragma unroll
        for (int j = 0; j < 16; j++) {
          if ((i + 1) * (j + 1) <= 16) {
            const float sv = va[i] + vb[j];
            const uint32_t key = (ordf(sv) & ~0xFFu) | (uint32_t)(255 - (i * 16 + j));
            INS16(cd, key);
          }
        }
      }
      float ev[16];
      const float m0v = unordf(cd[0] & ~0xFFu);
      float esum = 0.f;
#pragma unroll
      for (int q = 0; q < 16; q++) {
        ev[q] = __expf(unordf(cd[q] & ~0xFFu) - m0v);
        esum += ev[q];
      }
      const float inv = 1.f / esum;
      const size_t ob = (size_t)(mt * 128 + row) * 128 + h * 16;
#pragma unroll
      for (int q = 0; q < 16; q++) {
        const int ij = 255 - (int)(cd[q] & 0xFFu);
        const int i0 = 127 - (int)(TK0[row * 16 + (ij >> 4)] & 0x7Fu);
        const int i1 = 127 - (int)(Cu[2048 + row * 16 + (ij & 15)] & 0x7Fu);
        IDX[ob + q] = i0 * 128 + i1;
        GW[ob + q] = ev[q] * inv;
      }
    }
    __syncthreads();
  }
}

typedef __attribute__((ext_vector_type(2))) float f32x2;
__device__ __forceinline__ void dec16(uint4 u, float* v) {
  f32x2 t;
  t = __builtin_amdgcn_cvt_pk_f32_fp8((int)u.x, false); v[0] = t.x; v[1] = t.y;
  t = __builtin_amdgcn_cvt_pk_f32_fp8((int)u.x, true); v[2] = t.x; v[3] = t.y;
  t = __builtin_amdgcn_cvt_pk_f32_fp8((int)u.y, false); v[4] = t.x; v[5] = t.y;
  t = __builtin_amdgcn_cvt_pk_f32_fp8((int)u.y, true); v[6] = t.x; v[7] = t.y;
  t = __builtin_amdgcn_cvt_pk_f32_fp8((int)u.z, false); v[8] = t.x; v[9] = t.y;
  t = __builtin_amdgcn_cvt_pk_f32_fp8((int)u.z, true); v[10] = t.x; v[11] = t.y;
  t = __builtin_amdgcn_cvt_pk_f32_fp8((int)u.w, false); v[12] = t.x; v[13] = t.y;
  t = __builtin_amdgcn_cvt_pk_f32_fp8((int)u.w, true); v[14] = t.x; v[15] = t.y;
}

__device__ __forceinline__ void phase7(const Params& p) {
  const int tid = opaque_tid(), lane = tid & 63, w = tid >> 6;
  const u16* HG = (const u16*)(p.ws + W_ZB);
  const float* SSQ = (const float*)(p.ws + W_SSQ);
  const int* IDX = (const int*)(p.ws + W_XN);
  const float* GW = (const float*)(p.ws + W_XN + (size_t)NTOK * 128 * 4);
  const unsigned char* EU = (const unsigned char*)(p.ws + W_EU);
  const unsigned char* EV = (const unsigned char*)(p.ws + W_EV);
  const float* ESC = (const float*)(p.ws + W_ESC);
  const int b0 = lane & 1, b1 = (lane >> 1) & 1, b2 = (lane >> 2) & 1;
  for (int tok = blockIdx.x * 4 + w; tok < NTOK; tok += gridDim.x * 4) {
    const float rs = row_rstd(SSQ, tok);
    float xh[16];
    {
      const uint4* hp = (const uint4*)(HG + (size_t)tok * 1024 + lane * 16);
      unpack8(hp[0], xh);
      unpack8(hp[1], xh + 8);
#pragma unroll
      for (int i = 0; i < 16; i++) xh[i] *= rs;
    }
    const int iA = IDX[(size_t)tok * 128 + lane], iB = IDX[(size_t)tok * 128 + 64 + lane];
    const float gA = GW[(size_t)tok * 128 + lane] * ESC[16384 + iA], gB = GW[(size_t)tok * 128 + 64 + lane] * ESC[16384 + iB];
    const float suA = ESC[iA], suB = ESC[iB];
    float dA = 0.f, dB = 0.f;
    for (int bb = 0; bb < 16; bb++) {
      const int isrc = bb < 8 ? iA : iB;
      float d[8];
#pragma unroll
      for (int k = 0; k < 8; k++) {
        const int id = __builtin_amdgcn_readlane(isrc, (bb & 7) * 8 + k);
        const uint4 u = *(const uint4*)(EU + (size_t)id * 1024 + lane * 16);
        float uv[16];
        dec16(u, uv);
        float sacc = 0.f;
#pragma unroll
        for (int i = 0; i < 16; i++) sacc += xh[i] * uv[i];
        d[k] = sacc;
      }
      float e4[4], e2[2], e1;
#pragma unroll
      for (int i = 0; i < 4; i++) {
        const float keep = b0 ? d[2 * i + 1] : d[2 * i];
        const float send = b0 ? d[2 * i] : d[2 * i + 1];
        e4[i] = keep + __shfl_xor(send, 1);
      }
#pragma unroll
      for (int i = 0; i < 2; i++) {
        const float keep = b1 ? e4[2 * i + 1] : e4[2 * i];
        const float send = b1 ? e4[2 * i] : e4[2 * i + 1];
        e2[i] = keep + __shfl_xor(send, 2);
      }
      {
        const float keep = b2 ? e2[1] : e2[0];
        const float send = b2 ? e2[0] : e2[1];
        e1 = keep + __shfl_xor(send, 4);
      }
      e1 += __shfl_xor(e1, 8);
      e1 += __shfl_xor(e1, 16);
      e1 += __shfl_xor(e1, 32);
      const bool mine = (lane >> 3) == (bb & 7);
      if (bb < 8) dA = mine ? e1 : dA; else dB = mine ? e1 : dB;
    }
    const float actA = gelu_tanh(dA * suA) * gA, actB = gelu_tanh(dB * suB) * gB;
    float o[16];
#pragma unroll
    for (int i = 0; i < 16; i++) o[i] = 0.f;
    for (int bb = 0; bb < 16; bb++) {
      const int isrc = bb < 8 ? iA : iB;
      const float asrc = bb < 8 ? actA : actB;
#pragma unroll
      for (int k = 0; k < 8; k++) {
        const int id = __builtin_amdgcn_readlane(isrc, (bb & 7) * 8 + k);
        const float a = __uint_as_float(__builtin_amdgcn_readlane(__float_as_uint(asrc), (bb & 7) * 8 + k));
        const uint4 u = *(const uint4*)(EV + (size_t)id * 1024 + lane * 16);
        float vv[16];
        dec16(u, vv);
#pragma unroll
        for (int i = 0; i < 16; i++) o[i] += a * vv[i];
      }
    }
    float* yo = p.out + O_Y + (size_t)tok * 1024 + lane * 16;
#pragma unroll
    for (int q = 0; q < 4; q++) {
      float4 h = *(const float4*)(yo + q * 4);
      h.x += o[q * 4]; h.y += o[q * 4 + 1]; h.z += o[q * 4 + 2]; h.w += o[q * 4 + 3];
      *(float4*)(yo + q * 4) = h;
    }
  }
}

#ifndef REP_MASK
#define REP_MASK 0
#endif
#define REPS(k) for (int _rep = 0; _rep < (((REP_MASK) >> (k)) & 1) + 1; _rep++)
__global__ void __launch_bounds__(256, 2) fwd_megakernel(Params p) {
  extern __shared__ __attribute__((aligned(16))) char smem[];
  cg::grid_group grid = cg::this_grid();
  REPS(0) { phase0(p, smem); grid.sync(); }
  REPS(1) { phase_g1(p, smem); grid.sync(); }
  REPS(2) {
    for (int it = blockIdx.x; it < 1536 + 2048; it += gridDim.x) {
      if (it < 1536) attn_item(p, smem, it);
      else { const int q = it - 1536; lru_tile(p, smem, q >> 4, q & 15, 0); }
    }
    grid.sync();
  }
  REPS(3) {
    for (int it = blockIdx.x; it < MT * 16; it += gridDim.x) lru_tile(p, smem, it >> 4, it & 15, 1);
    grid.sync();
  }
  REPS(4) { phase_g3(p, smem); grid.sync(); }
  REPS(5) { phase_g4(p, smem); grid.sync(); }
  REPS(6) { phase_g5(p, smem); grid.sync(); }
  REPS(7) { phase_g6(p, smem); grid.sync(); }
  phase7(p);
}

extern "C" void kernel_launch(void* const* d_in, const int* in_sizes, int n_in, void* d_out, int out_size, void* d_ws,
                              size_t ws_size, hipStream_t stream) {
  static int grid_blocks = 0;
  if (!grid_blocks) {
    int dev = 0, cus = 0, per_cu = 0;
    hipGetDevice(&dev);
    hipDeviceGetAttribute(&cus, hipDeviceAttributeMultiprocessorCount, dev);
    hipFuncSetAttribute((const void*)fwd_megakernel, hipFuncAttributeMaxDynamicSharedMemorySize, SMEM_BYTES);
    hipOccupancyMaxActiveBlocksPerMultiprocessor(&per_cu, fwd_megakernel, 256, SMEM_BYTES);
    if (per_cu < 1) per_cu = 1;
    grid_blocks = cus * per_cu;
  }
  Params p{};
  const float** pp = (const float**)&p;
  for (int i = 0; i < 26; i++) pp[i] = (const float*)d_in[i];
  p.out = (float*)d_out;
  p.ws = (char*)d_ws;
  void* args[] = {&p};
  hipError_t e = hipLaunchCooperativeKernel((void*)fwd_megakernel, dim3(grid_blocks), dim3(256), args, SMEM_BYTES, stream);
  if (e != hipSuccess) fprintf(stderr, "cooperative launch failed: %s (grid %d)\n", hipGetErrorString(e), grid_blocks);
}
```

```cpp
#include <hip/hip_runtime.h>
#include <hip/hip_cooperative_groups.h>
#include <stdint.h>
#include <cstdio>
namespace cg = cooperative_groups;

typedef unsigned short u16;
typedef __attribute__((ext_vector_type(8))) short bf16x8;
typedef __attribute__((ext_vector_type(4))) float f32x4;

constexpr int D = 1024;
constexpr int NP = 16384;
constexpr int NTOK = 17408;
constexpr int SEQ = 4096;
constexpr int MT = 136;
constexpr float EPS = 1e-6f;

constexpr size_t O_Y = 0;
constexpr size_t O_CONVP = 17825792;
constexpr size_t O_LRUP = O_CONVP + 12288;
constexpr size_t O_KP = O_LRUP + 4096;
constexpr size_t O_VP = O_KP + 131072;
constexpr size_t O_CONVS = O_VP + 131072;
constexpr size_t O_LRUS = O_CONVS + 393216;
constexpr size_t O_KS = O_LRUS + 131072;
constexpr size_t O_VS = O_KS + 4194304;

constexpr size_t W_WTIN = 0;
constexpr size_t W_WTLRU = W_WTIN + (size_t)5632 * 1024 * 2;
constexpr size_t W_WTATTN = W_WTLRU + (size_t)1024 * 1024 * 2;
constexpr size_t W_WTOUT = W_WTATTN + (size_t)1024 * 1024 * 2;
constexpr size_t W_WTQ = W_WTOUT + (size_t)1024 * 1024 * 2;
constexpr size_t W_SK = W_WTQ + (size_t)2048 * 1024 * 2;
constexpr size_t W_RGA = W_SK + (size_t)16 * 128 * 128 * 2;
constexpr size_t W_RGX = W_RGA + (size_t)65536 * 2;
constexpr size_t W_EU = W_RGX + (size_t)65536 * 2;
constexpr size_t W_EV = W_EU + (size_t)16384 * 1024;
constexpr size_t W_ESC = W_EV + (size_t)16384 * 1024;
constexpr size_t W_XN = W_ESC + (size_t)32768 * 4;
constexpr size_t W_ZA = W_XN + (size_t)NTOK * 1024 * 2;
constexpr size_t W_ZB = W_ZA + (size_t)NTOK * 2048 * 2;
constexpr size_t W_AGG = W_ZB + (size_t)NTOK * 1536 * 2;
constexpr size_t W_SSQ = W_AGG + (size_t)128 * 1024 * 2 * 4;
constexpr size_t W_BAR = W_SSQ + (size_t)NTOK * 8 * 4;
constexpr size_t W_END = W_BAR + (size_t)3456 * 4;

constexpr int SMEM_BYTES = 81920;

struct Params {
  const float *x_prompt, *x_sample, *cache_conv, *state_lru, *cache_k, *cache_v, *norm1_g, *w_in, *conv_w,
      *conv_b, *rg_w_a, *rg_b_a, *rg_w_x, *rg_b_x, *rg_lambda, *q_norm_g, *k_norm_g, *attn_sinks,
      *w_branch_lru, *w_branch_attn, *w_out, *norm2_g, *peer_w_query, *peer_sub_keys, *expert_u, *expert_v;
  float* out;
  char* ws;
};

__device__ __forceinline__ u16 f2bf(float f) {
  uint32_t u = __float_as_uint(f);
  u += 0x7FFFu + ((u >> 16) & 1u);
  return (u16)(u >> 16);
}
__device__ __forceinline__ float bf2f(u16 h) { return __uint_as_float(((uint32_t)h) << 16); }
__device__ __forceinline__ uint32_t pack2(float a, float b) {
  return (uint32_t)f2bf(a) | ((uint32_t)f2bf(b) << 16);
}
__device__ __forceinline__ uint4 pack8(const float* v) {
  uint4 o;
  o.x = pack2(v[0], v[1]); o.y = pack2(v[2], v[3]); o.z = pack2(v[4], v[5]); o.w = pack2(v[6], v[7]);
  return o;
}
__device__ __forceinline__ void unpack8(uint4 u, float* v) {
  v[0] = __uint_as_float(u.x << 16); v[1] = __uint_as_float(u.x & 0xFFFF0000u);
  v[2] = __uint_as_float(u.y << 16); v[3] = __uint_as_float(u.y & 0xFFFF0000u);
  v[4] = __uint_as_float(u.z << 16); v[5] = __uint_as_float(u.z & 0xFFFF0000u);
  v[6] = __uint_as_float(u.w << 16); v[7] = __uint_as_float(u.w & 0xFFFF0000u);
}
__device__ __forceinline__ float sigmoidf_(float x) { return 1.f / (1.f + __expf(-x)); }
__device__ __forceinline__ float gelu_tanh(float x) {
  float y = 0.7978845608028654f * (x + 0.044715f * x * x * x);
  float t = 1.f - 2.f / (__expf(2.f * y) + 1.f);
  return 0.5f * x * (1.f + t);
}
__device__ __forceinline__ uint32_t ordf(float f) {
  uint32_t u = __float_as_uint(f);
  return (u & 0x80000000u) ? ~u : (u | 0x80000000u);
}
__device__ __forceinline__ float unordf(uint32_t o) {
  uint32_t u = (o & 0x80000000u) ? (o ^ 0x80000000u) : ~o;
  return __uint_as_float(u);
}
__device__ __forceinline__ int opaque_tid() {
  int t = threadIdx.x;
  asm volatile("" : "+v"(t));
  return t;
}
__device__ __forceinline__ const float* xrow(const Params& p, int row) {
  return row < NP ? p.x_prompt + (size_t)row * D : p.x_sample + (size_t)(row - NP) * D;
}

#define INS16(T, V)                                  \
  {                                                  \
    uint32_t _v = (V);                               \
    _Pragma("unroll") for (int _q = 0; _q < 16; _q++) { \
      uint32_t _hi = max(T[_q], _v);                 \
      _v = min(T[_q], _v);                           \
      T[_q] = _hi;                                   \
    }                                                \
  }

#define CE_DESC(A_, B_) { const uint32_t _h = max(A_, B_), _l = min(A_, B_); A_ = _h; B_ = _l; }
__device__ __forceinline__ void sort16_desc(uint32_t (&t)[16]) {
#pragma unroll
  for (int k = 2; k <= 16; k <<= 1) {
#pragma unroll
    for (int j = k >> 1; j > 0; j >>= 1) {
#pragma unroll
      for (int i = 0; i < 16; i++) {
        const int l = i ^ j;
        if (l > i) {
          if ((i & k) == 0) { CE_DESC(t[i], t[l]); } else { CE_DESC(t[l], t[i]); }
        }
      }
    }
  }
}
__device__ __forceinline__ void merge16_desc(uint32_t (&T)[16], const uint32_t (&S)[16]) {
#pragma unroll
  for (int i = 0; i < 16; i++) T[i] = max(T[i], S[15 - i]);
#pragma unroll
  for (int j = 8; j > 0; j >>= 1) {
#pragma unroll
    for (int i = 0; i < 16; i++) {
      const int l = i ^ j;
      if (l > i) { CE_DESC(T[i], T[l]); }
    }
  }
}

__device__ __forceinline__ void transpose_cvt(const float* __restrict__ W, u16* __restrict__ Wt, int K, int N,
                                              size_t gtid, size_t gsz) {
  size_t total = (size_t)N * (K / 8);
  for (size_t c = gtid; c < total; c += gsz) {
    int n = (int)(c % N);
    int kg = (int)(c / N);
    float v[8];
#pragma unroll
    for (int i = 0; i < 8; i++) v[i] = W[(size_t)(kg * 8 + i) * N + n];
    *(uint4*)(Wt + (size_t)n * K + kg * 8) = pack8(v);
  }
}
__device__ __forceinline__ void plain_cvt(const float* __restrict__ S, u16* __restrict__ Dst, size_t n, size_t gtid,
                                          size_t gsz) {
  size_t total = n / 8;
  const float4* s4 = (const float4*)S;
  for (size_t c = gtid; c < total; c += gsz) {
    float4 a = s4[2 * c], b = s4[2 * c + 1];
    float v[8] = {a.x, a.y, a.z, a.w, b.x, b.y, b.z, b.w};
    *(uint4*)(Dst + c * 8) = pack8(v);
  }
}

__device__ __forceinline__ void phase0(const Params& p, char* smem) {
  const int tid = opaque_tid();
  const size_t gtid = (size_t)blockIdx.x * 256 + tid, gsz = (size_t)gridDim.x * 256;
  char* ws = p.ws;
  {
    const int lane = tid & 63;
    const int gw = (int)(gtid >> 6), nw = (int)(gsz >> 6);
    u16* XN = (u16*)(ws + W_XN);
    for (int row = gw; row < NTOK; row += nw) {
      const float4* xr = (const float4*)xrow(p, row);
      float4 v[4];
      float ss = 0.f;
#pragma unroll
      for (int i = 0; i < 4; i++) {
        v[i] = xr[lane + i * 64];
        ss += v[i].x * v[i].x + v[i].y * v[i].y + v[i].z * v[i].z + v[i].w * v[i].w;
      }
#pragma unroll
      for (int o = 32; o > 0; o >>= 1) ss += __shfl_xor(ss, o);
      float rstd = rsqrtf(ss * (1.f / 1024.f) + EPS);
      const float4* g4 = (const float4*)p.norm1_g;
#pragma unroll
      for (int i = 0; i < 4; i++) {
        float4 g = g4[lane + i * 64];
        uint2 o;
        o.x = pack2(v[i].x * rstd * g.x, v[i].y * rstd * g.y);
        o.y = pack2(v[i].z * rstd * g.z, v[i].w * rstd * g.w);
        *(uint2*)(XN + (size_t)row * D + (lane + i * 64) * 4) = o;
      }
    }
  }
  {
    float* T = (float*)smem;
    for (int tile = blockIdx.x; tile < 2688; tile += gridDim.x) {
      const float* W;
      u16* Wt;
      int N, tl;
      if (tile < 1408) { W = p.w_in; Wt = (u16*)(ws + W_WTIN); N = 5632; tl = tile; }
      else if (tile < 1664) { W = p.w_branch_lru; Wt = (u16*)(ws + W_WTLRU); N = 1024; tl = tile - 1408; }
      else if (tile < 1920) { W = p.w_branch_attn; Wt = (u16*)(ws + W_WTATTN); N = 1024; tl = tile - 1664; }
      else if (tile < 2176) { W = p.w_out; Wt = (u16*)(ws + W_WTOUT); N = 1024; tl = tile - 1920; }
      else { W = p.peer_w_query; Wt = (u16*)(ws + W_WTQ); N = 2048; tl = tile - 2176; }
      const int ntn = N >> 6;
      const int kt = tl / ntn, nt = tl - kt * ntn;
      __syncthreads();
      {
        const float* src = W + (size_t)(kt * 64 + (tid >> 2)) * N + nt * 64 + (tid & 3) * 16;
        const float4 a0 = *(const float4*)src, a1 = *(const float4*)(src + 4), a2 = *(const float4*)(src + 8),
                     a3 = *(const float4*)(src + 12);
        float* d = T + (tid >> 2) * 65 + (tid & 3) * 16;
        d[0] = a0.x; d[1] = a0.y; d[2] = a0.z; d[3] = a0.w; d[4] = a1.x; d[5] = a1.y; d[6] = a1.z; d[7] = a1.w;
        d[8] = a2.x; d[9] = a2.y; d[10] = a2.z; d[11] = a2.w; d[12] = a3.x; d[13] = a3.y; d[14] = a3.z; d[15] = a3.w;
      }
      __syncthreads();
      {
        const int n = tid >> 2, kc = (tid & 3) * 16;
        float v[16];
#pragma unroll
        for (int i = 0; i < 16; i++) v[i] = T[(kc + i) * 65 + n];
        u16* dst = Wt + (size_t)(nt * 64 + n) * 1024 + kt * 64 + kc;
        *(uint4*)dst = pack8(v);
        *(uint4*)(dst + 8) = pack8(v + 8);
      }
    }
  }
  {
    u16* RA = (u16*)(ws + W_RGA);
    u16* RX = (u16*)(ws + W_RGX);
    for (size_t e = gtid; e < 65536; e += gsz) {
      int n = (int)(e >> 12), k = (int)((e >> 6) & 63), j = (int)(e & 63);
      RA[e] = f2bf(p.rg_w_a[n * 4096 + j * 64 + k]);
      RX[e] = f2bf(p.rg_w_x[n * 4096 + j * 64 + k]);
    }
  }
  plain_cvt(p.peer_sub_keys, (u16*)(ws + W_SK), (size_t)16 * 128 * 128, gtid, gsz);
  {
    const int lane = tid & 63;
    const int gw = (int)(gtid >> 6), nw = (int)(gsz >> 6);
    unsigned char* E8 = (unsigned char*)(ws + W_EU);
    float* ESC = (float*)(ws + W_ESC);
    for (int r = gw; r < 32768; r += nw) {
      const float* src = (r < 16384 ? p.expert_u : p.expert_v) + (size_t)(r & 16383) * 1024 + lane * 16;
      const float4 a0 = *(const float4*)src, a1 = *(const float4*)(src + 4), a2 = *(const float4*)(src + 8),
                   a3 = *(const float4*)(src + 12);
      float am = fmaxf(fmaxf(fmaxf(fabsf(a0.x), fabsf(a0.y)), fmaxf(fabsf(a0.z), fabsf(a0.w))),
                       fmaxf(fmaxf(fabsf(a1.x), fabsf(a1.y)), fmaxf(fabsf(a1.z), fabsf(a1.w))));
      am = fmaxf(am, fmaxf(fmaxf(fmaxf(fabsf(a2.x), fabsf(a2.y)), fmaxf(fabsf(a2.z), fabsf(a2.w))),
                           fmaxf(fmaxf(fabsf(a3.x), fabsf(a3.y)), fmaxf(fabsf(a3.z), fabsf(a3.w)))));
#pragma unroll
      for (int o = 32; o > 0; o >>= 1) am = fmaxf(am, __shfl_xor(am, o));
      const float sc = am > 0.f ? 224.f / am : 1.f;
      uint4 o4;
      int wv;
      wv = __builtin_amdgcn_cvt_pk_fp8_f32(a0.x * sc, a0.y * sc, 0, false);
      wv = __builtin_amdgcn_cvt_pk_fp8_f32(a0.z * sc, a0.w * sc, wv, true);
      o4.x = (uint32_t)wv;
      wv = __builtin_amdgcn_cvt_pk_fp8_f32(a1.x * sc, a1.y * sc, 0, false);
      wv = __builtin_amdgcn_cvt_pk_fp8_f32(a1.z * sc, a1.w * sc, wv, true);
      o4.y = (uint32_t)wv;
      wv = __builtin_amdgcn_cvt_pk_fp8_f32(a2.x * sc, a2.y * sc, 0, false);
      wv = __builtin_amdgcn_cvt_pk_fp8_f32(a2.z * sc, a2.w * sc, wv, true);
      o4.z = (uint32_t)wv;
      wv = __builtin_amdgcn_cvt_pk_fp8_f32(a3.x * sc, a3.y * sc, 0, false);
      wv = __builtin_amdgcn_cvt_pk_fp8_f32(a3.z * sc, a3.w * sc, wv, true);
      o4.w = (uint32_t)wv;
      *(uint4*)(E8 + (size_t)r * 1024 + lane * 16) = o4;
      if (lane == 0) ESC[r] = am > 0.f ? am * (1.f / 224.f) : 1.f;
    }
  }
}

constexpr int LDT = 72;
constexpr int CS_LD = 132;

__device__ __forceinline__ void gemm_tile(const u16* __restrict__ A, int lda, const u16* __restrict__ Bt, int ldb,
                                          int K, f32x4 (&acc)[4][4], char* smem, int tid) {
  const int lane = tid & 63, w = tid >> 6;
  const int wm = w >> 1, wn = w & 1;
  const int l15 = lane & 15, quad = lane >> 4;
  const int lr = w * 8 + (lane >> 3);
  const int lc = ((lane & 7) ^ ((lane >> 3) & 7)) * 8;
  const char* Ab = (const char*)A;
  const char* Bb = (const char*)Bt;
  const uint32_t ao = (uint32_t)(lr * lda + lc) * 2u, bo = (uint32_t)(lr * ldb + lc) * 2u;
  const uint32_t sa2 = 64u * (uint32_t)lda, sb2 = 64u * (uint32_t)ldb;
  const uint32_t kmask = (uint32_t)K - 1u, kst = (((uint32_t)blockIdx.x >> 3) * 64u) & kmask;
  char* lw = smem + w * 1024 + lane * 16;
  const int swz = l15 & 7;
  const char* Ar = smem + (wm * 64 + l15) * 128 + ((quad ^ swz) * 16);
  const char* Br = smem + 16384 + (wn * 64 + l15) * 128 + ((quad ^ swz) * 16);
  const char* Ar1 = smem + (wm * 64 + l15) * 128 + (((4 + quad) ^ swz) * 16);
  const char* Br1 = smem + 16384 + (wn * 64 + l15) * 128 + (((4 + quad) ^ swz) * 16);
#define GT_ISSUE(st, off)                                                                                   \
  {                                                                                                         \
    const uint32_t _o = (((uint32_t)(off) + kst) & kmask) * 2u;                                             \
    char* _l = lw + (st) * 32768;                                                                           \
    _Pragma("unroll") for (int j = 0; j < 4; j++) {                                                         \
      __builtin_amdgcn_global_load_lds((const unsigned*)(Ab + (size_t)(ao + j * sa2 + _o)), (unsigned*)(_l + j * 4096), 16, 0, 0);          \
      __builtin_amdgcn_global_load_lds((const unsigned*)(Bb + (size_t)(bo + j * sb2 + _o)), (unsigned*)(_l + 16384 + j * 4096), 16, 0, 0);  \
    }                                                                                                       \
  }
#define GT_MMA(st)                                                                                          \
  {                                                                                                         \
    const char* _ar = Ar + (st) * 32768; const char* _br = Br + (st) * 32768;                               \
    const char* _ar1 = Ar1 + (st) * 32768; const char* _br1 = Br1 + (st) * 32768;                           \
    bf16x8 a0[4], b0[4], a1[4], b1[4];                                                                      \
    _Pragma("unroll") for (int i = 0; i < 4; i++) {                                                         \
      a0[i] = *(const bf16x8*)(_ar + i * 2048);                                                             \
      b0[i] = *(const bf16x8*)(_br + i * 2048);                                                             \
    }                                                                                                       \
    _Pragma("unroll") for (int i = 0; i < 4; i++) {                                                         \
      a1[i] = *(const bf16x8*)(_ar1 + i * 2048);                                                            \
      b1[i] = *(const bf16x8*)(_br1 + i * 2048);                                                            \
    }                                                                                                       \
    _Pragma("unroll") for (int i = 0; i < 4; i++)                                                           \
      _Pragma("unroll") for (int j = 0; j < 4; j++)                                                         \
        acc[i][j] = __builtin_amdgcn_mfma_f32_16x16x32_bf16(a0[i], b0[j], acc[i][j], 0, 0, 0);              \
    _Pragma("unroll") for (int i = 0; i < 4; i++)                                                           \
      _Pragma("unroll") for (int j = 0; j < 4; j++)                                                         \
        acc[i][j] = __builtin_amdgcn_mfma_f32_16x16x32_bf16(a1[i], b1[j], acc[i][j], 0, 0, 0);              \
  }
  __syncthreads();
  GT_ISSUE(0, 0);
  for (int k0 = 0; k0 < K; k0 += 128) {
    asm volatile("s_waitcnt vmcnt(0) lgkmcnt(0)" ::: "memory");
    __builtin_amdgcn_s_barrier();
    asm volatile("" ::: "memory");
    GT_ISSUE(1, k0 + 64);
    GT_MMA(0);
    asm volatile("s_waitcnt vmcnt(0) lgkmcnt(0)" ::: "memory");
    __builtin_amdgcn_s_barrier();
    asm volatile("" ::: "memory");
    if (k0 + 128 < K) GT_ISSUE(0, k0 + 128);
    GT_MMA(1);
  }
#undef GT_ISSUE
#undef GT_MMA
}

__device__ __forceinline__ void tile_map(int it, int total, int NT, int& mt, int& nt) {
  const int G = gridDim.x;
  int T = it;
  if ((G & 7) == 0) {
    const int round = it / G, b = it - round * G;
    if (round * G + G <= total) T = round * G + (b & 7) * (G >> 3) + (b >> 3);
  }
  const int g = T / (8 * NT), r = T - g * (8 * NT);
  nt = r >> 3;
  mt = g * 8 + (r & 7);
}

__device__ __forceinline__ void zero_acc(f32x4 (&acc)[4][4]) {
#pragma unroll
  for (int i = 0; i < 4; i++)
#pragma unroll
    for (int j = 0; j < 4; j++) acc[i][j] = (f32x4){0.f, 0.f, 0.f, 0.f};
}

__device__ __forceinline__ void acc_to_cs(const f32x4 (&acc)[4][4], float* Cs, int tid) {
  const int lane = tid & 63, w = tid >> 6;
  const int wm = w >> 1, wn = w & 1;
  const int l15 = lane & 15, quad = lane >> 4;
#pragma unroll
  for (int i = 0; i < 4; i++)
#pragma unroll
    for (int j = 0; j < 4; j++)
#pragma unroll
      for (int e = 0; e < 4; e++)
        Cs[(wm * 64 + i * 16 + quad * 4 + e) * CS_LD + wn * 64 + j * 16 + l15] = acc[i][j][e];
}

__device__ __forceinline__ void phase_g1(const Params& p, char* smem) {
  const int tid = opaque_tid();
  u16* As = (u16*)smem;
  u16* Bs = As + 2 * 128 * LDT;
  float* Cs = (float*)smem;
  const u16* XN = (const u16*)(p.ws + W_XN);
  const u16* WT = (const u16*)(p.ws + W_WTIN);
  for (int t = blockIdx.x; t < MT * 44; t += gridDim.x) {
    int mt, nt;
    tile_map(t, MT * 44, 44, mt, nt);
    f32x4 acc[4][4];
    zero_acc(acc);
    gemm_tile(XN + (size_t)mt * 128 * 1024, 1024, WT + (size_t)nt * 128 * 1024, 1024, 1024, acc, smem, tid);
    __syncthreads();
    acc_to_cs(acc, Cs, tid);
    __syncthreads();
    const int n0 = nt * 128;
    u16* dst;
    int ldd, col;
    if (n0 < 2048) { dst = (u16*)(p.ws + W_ZA); ldd = 2048; col = n0; }
    else if (n0 < 3584) { dst = (u16*)(p.ws + W_ZB); ldd = 1536; col = n0 - 2048; }
    else { dst = (u16*)p.out; ldd = 2048; col = n0 - 3584; }
    const int cc = (tid & 15) * 8;
#pragma unroll
    for (int i = 0; i < 8; i++) {
      const int r = (tid >> 4) + 16 * i;
      float4 a = *(const float4*)(Cs + r * CS_LD + cc), b = *(const float4*)(Cs + r * CS_LD + cc + 4);
      float v[8] = {a.x, a.y, a.z, a.w, b.x, b.y, b.z, b.w};
      *(uint4*)(dst + (size_t)(mt * 128 + r) * ldd + col + cc) = pack8(v);
    }
    __syncthreads();
  }
}

constexpr int KS_LD = 72, VT_LD = 200, PS_LD = 168;
__device__ __forceinline__ void attn_item(const Params& p, char* smem, int item) {
  const int tid = opaque_tid(), lane = tid & 63, w = tid >> 6, l15 = lane & 15, quad = lane >> 4;
  u16* Ks = (u16*)smem;
  u16* Vt = Ks + 192 * KS_LD;
  u16* Ps = Vt + 64 * VT_LD + w * 16 * PS_LD;
  const u16* ZB = (const u16*)(p.ws + W_ZB);
  u16* ATT = (u16*)(p.ws + W_XN);
  const bool sample = item >= 1024;
  int b, qb = 0, kv, rowbase, p0 = 0;
  if (!sample) {
    kv = item & 3; qb = (item >> 2) & 63; b = item >> 8;
    p0 = qb * 64;
    rowbase = b * SEQ + p0;
  } else {
    int it = item - 1024;
    kv = it & 3; b = it >> 2;
    rowbase = NP + b * 8;
  }
  __syncthreads();
  {
    const int ch = tid & 7;
    float kg[8];
#pragma unroll
    for (int i = 0; i < 8; i++) kg[i] = p.k_norm_g[ch * 8 + i];
    const int nrows = sample ? 160 : 192;
    for (int c = tid; c < nrows * 8; c += 256) {
      const int row = c >> 3;
      float kf[8], vf[8];
      bool valid, donorm;
      if (!sample) {
        const int pos = p0 - 128 + row;
        valid = pos >= 0;
        donorm = true;
        if (valid) {
          const u16* src = ZB + (size_t)(b * SEQ + pos) * 1536 + 1024 + kv * 64 + ch * 8;
          unpack8(*(const uint4*)src, kf);
          unpack8(*(const uint4*)(src + 256), vf);
        }
      } else {
        valid = row < 136;
        donorm = row >= 128;
        if (row < 128) {
          const float* sk = p.cache_k + ((size_t)(b * 128 + row) * 4 + kv) * 64 + ch * 8;
          const float* sv = p.cache_v + ((size_t)(b * 128 + row) * 4 + kv) * 64 + ch * 8;
          float4 a0 = *(const float4*)sk, a1 = *(const float4*)(sk + 4);
          float4 b0 = *(const float4*)sv, b1 = *(const float4*)(sv + 4);
          kf[0] = a0.x; kf[1] = a0.y; kf[2] = a0.z; kf[3] = a0.w; kf[4] = a1.x; kf[5] = a1.y; kf[6] = a1.z; kf[7] = a1.w;
          vf[0] = b0.x; vf[1] = b0.y; vf[2] = b0.z; vf[3] = b0.w; vf[4] = b1.x; vf[5] = b1.y; vf[6] = b1.z; vf[7] = b1.w;
        } else if (valid) {
          const u16* src = ZB + (size_t)(NP + b * 8 + (row - 128)) * 1536 + 1024 + kv * 64 + ch * 8;
          unpack8(*(const uint4*)src, kf);
          unpack8(*(const uint4*)(src + 256), vf);
        }
      }
      if (!valid) {
#pragma unroll
        for (int i = 0; i < 8; i++) { kf[i] = 0.f; vf[i] = 0.f; }
      }
      float ss = 0.f;
#pragma unroll
      for (int i = 0; i < 8; i++) ss += kf[i] * kf[i];
      ss += __shfl_xor(ss, 1);
      ss += __shfl_xor(ss, 2);
      ss += __shfl_xor(ss, 4);
      if (donorm) {
        const float rstd = rsqrtf(ss * (1.f / 64.f) + EPS);
#pragma unroll
        for (int i = 0; i < 8; i++) kf[i] = kf[i] * rstd * kg[i];
      }
      *(uint4*)(Ks + row * KS_LD + ch * 8) = pack8(kf);
#pragma unroll
      for (int i = 0; i < 8; i++) Vt[(ch * 8 + i) * VT_LD + row] = f2bf(vf[i]);
      if (!sample) {
        if (qb >= 62 && row >= 128) {
          const int wpos = p0 + (row - 128) - (SEQ - 128);
          float* ko = p.out + O_KP + ((size_t)(b * 128 + wpos) * 4 + kv) * 64 + ch * 8;
          float* vo = p.out + O_VP + ((size_t)(b * 128 + wpos) * 4 + kv) * 64 + ch * 8;
          *(float4*)ko = make_float4(kf[0], kf[1], kf[2], kf[3]);
          *(float4*)(ko + 4) = make_float4(kf[4], kf[5], kf[6], kf[7]);
          *(float4*)vo = make_float4(vf[0], vf[1], vf[2], vf[3]);
          *(float4*)(vo + 4) = make_float4(vf[4], vf[5], vf[6], vf[7]);
        }
      } else {
        if (row >= 8 && row < 136) {
          float* ko = p.out + O_KS + ((size_t)(b * 128 + (row - 8)) * 4 + kv) * 64 + ch * 8;
          float* vo = p.out + O_VS + ((size_t)(b * 128 + (row - 8)) * 4 + kv) * 64 + ch * 8;
          *(float4*)ko = make_float4(kf[0], kf[1], kf[2], kf[3]);
          *(float4*)(ko + 4) = make_float4(kf[4], kf[5], kf[6], kf[7]);
          *(float4*)vo = make_float4(vf[0], vf[1], vf[2], vf[3]);
          *(float4*)(vo + 4) = make_float4(vf[4], vf[5], vf[6], vf[7]);
        }
      }
    }
  }
  __syncthreads();
  const int hq = kv * 4 + w;
  const float slope = exp2f(-0.5f * (float)(hq + 1));
  const float sink = p.attn_sinks[hq];
  float qg[2][8];
#pragma unroll
  for (int ks = 0; ks < 2; ks++)
#pragma unroll
    for (int i = 0; i < 8; i++) qg[ks][i] = p.q_norm_g[ks * 32 + quad * 8 + i] * 0.125f;
  const int nsub = sample ? 1 : 4;
  for (int sb = 0; sb < nsub; sb++) {
    const int r0 = sb * 16;
    const int ws0 = r0 < 32 ? r0 : 32;
    bf16x8 qa[2];
    {
      const int qr = sample ? (l15 & 7) : (r0 + l15);
      const u16* src = ZB + (size_t)(rowbase + qr) * 1536 + hq * 64 + quad * 8;
      float q0[8], q1[8];
      unpack8(*(const uint4*)src, q0);
      unpack8(*(const uint4*)(src + 32), q1);
      float ss = 0.f;
#pragma unroll
      for (int i = 0; i < 8; i++) ss += q0[i] * q0[i] + q1[i] * q1[i];
      ss += __shfl_xor(ss, 16);
      ss += __shfl_xor(ss, 32);
      const float rstd = rsqrtf(ss * (1.f / 64.f) + EPS);
#pragma unroll
      for (int i = 0; i < 8; i++) { q0[i] *= rstd * qg[0][i]; q1[i] *= rstd * qg[1][i]; }
      uint4 u0 = pack8(q0), u1 = pack8(q1);
      qa[0] = __builtin_bit_cast(bf16x8, u0);
      qa[1] = __builtin_bit_cast(bf16x8, u1);
    }
    f32x4 s[10];
#pragma unroll
    for (int kt = 0; kt < 10; kt++) {
      const u16* kp = Ks + (ws0 + kt * 16 + l15) * KS_LD + quad * 8;
      bf16x8 b0 = *(const bf16x8*)kp, b1 = *(const bf16x8*)(kp + 32);
      f32x4 z = {0.f, 0.f, 0.f, 0.f};
      z = __builtin_amdgcn_mfma_f32_16x16x32_bf16(qa[0], b0, z, 0, 0, 0);
      s[kt] = __builtin_amdgcn_mfma_f32_16x16x32_bf16(qa[1], b1, z, 0, 0, 0);
    }
    float mx[4] = {-1e30f, -1e30f, -1e30f, -1e30f};
#pragma unroll
    for (int kt = 0; kt < 10; kt++) {
      const int jj = ws0 + kt * 16 + l15;
      const bool posok = sample ? (jj < 136) : (p0 - 128 + jj >= 0);
#pragma unroll
      for (int e = 0; e < 4; e++) {
        const int r = r0 + quad * 4 + e;
        const int dist = r + 128 - jj;
        const bool ok = posok && dist >= 0 && dist <= 128;
        float v = ok ? (s[kt][e] - slope * (float)dist) : -1e30f;
        s[kt][e] = v;
        mx[e] = fmaxf(mx[e], v);
      }
    }
    float sum[4];
#pragma unroll
    for (int e = 0; e < 4; e++) {
      float m = mx[e];
      m = fmaxf(m, __shfl_xor(m, 1));
      m = fmaxf(m, __shfl_xor(m, 2));
      m = fmaxf(m, __shfl_xor(m, 4));
      m = fmaxf(m, __shfl_xor(m, 8));
      m = fmaxf(m, sink);
      mx[e] = m;
      sum[e] = 0.f;
    }
#pragma unroll
    for (int kt = 0; kt < 10; kt++) {
#pragma unroll
      for (int e = 0; e < 4; e++) {
        float pv = __expf(s[kt][e] - mx[e]);
        sum[e] += pv;
        Ps[(quad * 4 + e) * PS_LD + kt * 16 + l15] = f2bf(pv);
      }
    }
#pragma unroll
    for (int e = 0; e < 4; e++) {
      float t = sum[e];
      t += __shfl_xor(t, 1);
      t += __shfl_xor(t, 2);
      t += __shfl_xor(t, 4);
      t += __shfl_xor(t, 8);
      sum[e] = 1.f / (t + __expf(sink - mx[e]));
    }
    __syncthreads();
    f32x4 o[4];
#pragma unroll
    for (int nt = 0; nt < 4; nt++) o[nt] = (f32x4){0.f, 0.f, 0.f, 0.f};
#pragma unroll
    for (int kk = 0; kk < 5; kk++) {
      bf16x8 pa = *(const bf16x8*)(Ps + l15 * PS_LD + kk * 32 + quad * 8);
#pragma unroll
      for (int nt = 0; nt < 4; nt++) {
        bf16x8 vb = *(const bf16x8*)(Vt + (nt * 16 + l15) * VT_LD + ws0 + kk * 32 + quad * 8);
        o[nt] = __builtin_amdgcn_mfma_f32_16x16x32_bf16(pa, vb, o[nt], 0, 0, 0);
      }
    }
#pragma unroll
    for (int e = 0; e < 4; e++) {
      const int r = quad * 4 + e;
      if (!sample || r < 8) {
        u16* dst = ATT + (size_t)(rowbase + r0 + r) * 1024 + hq * 64 + l15;
#pragma unroll
        for (int nt = 0; nt < 4; nt++) dst[nt * 16] = f2bf(o[nt][e] * sum[e]);
      }
    }
    __syncthreads();
  }
}

constexpr int XC_LD = 68;
__device__ __forceinline__ void lru_tile(const Params& p, char* smem, int mt, int nb, int mode) {
  const int tid = opaque_tid(), lane = tid & 63, w = tid >> 6, l15 = lane & 15, quad = lane >> 4;
  float* xcF = (float*)smem;
  float* aL = xcF + 128 * XC_LD;
  float* aggL = aL + 128 * XC_LD;
  const u16* ZA = (const u16*)(p.ws + W_ZA);
  const bool sample = mt >= 128;
  const int m0 = mt * 128;
  const int cb = nb * 64;
  __syncthreads();
  {
    const int ch = tid & 7;
    float cw[4][8], cbias[8];
#pragma unroll
    for (int j = 0; j < 4; j++)
#pragma unroll
      for (int i = 0; i < 8; i++) cw[j][i] = p.conv_w[j * 1024 + cb + ch * 8 + i];
#pragma unroll
    for (int i = 0; i < 8; i++) cbias[i] = p.conv_b[cb + ch * 8 + i];
#pragma unroll
    for (int it = 0; it < 4; it++) {
      const int r = (tid >> 3) + it * 32;
      const int grow = m0 + r;
      const int t = sample ? (r & 7) : ((mt & 31) * 128 + r);
      float y[8];
#pragma unroll
      for (int i = 0; i < 8; i++) y[i] = cbias[i];
#pragma unroll
      for (int d = 0; d < 4; d++) {
        float xv[8];
        if (t - d >= 0) {
          unpack8(*(const uint4*)(ZA + (size_t)(grow - d) * 2048 + cb + ch * 8), xv);
        } else if (sample) {
          const int bb = (m0 - NP + r) >> 3;
          const float* src = p.cache_conv + ((size_t)bb * 3 + (3 + t - d)) * 1024 + cb + ch * 8;
          float4 a = *(const float4*)src, b4 = *(const float4*)(src + 4);
          xv[0] = a.x; xv[1] = a.y; xv[2] = a.z; xv[3] = a.w; xv[4] = b4.x; xv[5] = b4.y; xv[6] = b4.z; xv[7] = b4.w;
        } else {
#pragma unroll
          for (int i = 0; i < 8; i++) xv[i] = 0.f;
        }
#pragma unroll
        for (int i = 0; i < 8; i++) y[i] += cw[3 - d][i] * xv[i];
        if (d == 0 && mode == 1) {
          if (!sample) {
            if ((mt & 31) == 31 && r >= 125) {
              float* dst = p.out + O_CONVP + ((size_t)(mt >> 5) * 3 + (r - 125)) * 1024 + cb + ch * 8;
              *(float4*)dst = make_float4(xv[0], xv[1], xv[2], xv[3]);
              *(float4*)(dst + 4) = make_float4(xv[4], xv[5], xv[6], xv[7]);
            }
          } else if (t >= 5) {
            const int bb = (m0 - NP + r) >> 3;
            float* dst = p.out + O_CONVS + ((size_t)bb * 3 + (t - 5)) * 1024 + cb + ch * 8;
            *(float4*)dst = make_float4(xv[0], xv[1], xv[2], xv[3]);
            *(float4*)(dst + 4) = make_float4(xv[4], xv[5], xv[6], xv[7]);
          }
        }
      }
      *(float4*)(xcF + r * XC_LD + ch * 8) = make_float4(y[0], y[1], y[2], y[3]);
      *(float4*)(xcF + r * XC_LD + ch * 8 + 4) = make_float4(y[4], y[5], y[6], y[7]);
    }
  }
  __syncthreads();
  {
    const u16* RA = (const u16*)(p.ws + W_RGA) + nb * 4096;
    const u16* RX = (const u16*)(p.ws + W_RGX) + nb * 4096;
    f32x4 aR[2][4], aI[2][4];
#pragma unroll
    for (int i = 0; i < 2; i++)
#pragma unroll
      for (int j = 0; j < 4; j++) { aR[i][j] = (f32x4){0.f, 0.f, 0.f, 0.f}; aI[i][j] = (f32x4){0.f, 0.f, 0.f, 0.f}; }
#pragma unroll
    for (int ks = 0; ks < 2; ks++) {
      bf16x8 a[2];
#pragma unroll
      for (int i = 0; i < 2; i++) {
        const float* src = xcF + (w * 32 + i * 16 + l15) * XC_LD + ks * 32 + quad * 8;
        float4 x0 = *(const float4*)src, x1 = *(const float4*)(src + 4);
        float v[8] = {x0.x, x0.y, x0.z, x0.w, x1.x, x1.y, x1.z, x1.w};
        uint4 u = pack8(v);
        a[i] = __builtin_bit_cast(bf16x8, u);
      }
#pragma unroll
      for (int j = 0; j < 4; j++) {
        bf16x8 ba = *(const bf16x8*)(RA + (j * 16 + l15) * 64 + ks * 32 + quad * 8);
        bf16x8 bx = *(const bf16x8*)(RX + (j * 16 + l15) * 64 + ks * 32 + quad * 8);
#pragma unroll
        for (int i = 0; i < 2; i++) {
          aR[i][j] = __builtin_amdgcn_mfma_f32_16x16x32_bf16(a[i], ba, aR[i][j], 0, 0, 0);
          aI[i][j] = __builtin_amdgcn_mfma_f32_16x16x32_bf16(a[i], bx, aI[i][j], 0, 0, 0);
        }
      }
    }
#pragma unroll
    for (int j = 0; j < 4; j++) {
      const int c = cb + j * 16 + l15;
      const float ba = p.rg_b_a[c], bx = p.rg_b_x[c];
      const float ls = -log1pf(__expf(-p.rg_lambda[c]));
#pragma unroll
      for (int i = 0; i < 2; i++)
#pragma unroll
        for (int e = 0; e < 4; e++) {
          const int row = w * 32 + i * 16 + quad * 4 + e;
          const float rg = sigmoidf_(aR[i][j][e] + ba);
          const float ig = sigmoidf_(aI[i][j][e] + bx);
          const float la = 8.f * rg * ls;
          const float av = __expf(la);
          const float mult = sqrtf(fmaxf(-expm1f(2.f * la), 0.f));
          const int idx = row * XC_LD + j * 16 + l15;
          const float xv = xcF[idx];
          aL[idx] = av;
          xcF[idx] = mult * ig * xv;
        }
    }
  }
  __syncthreads();
  const int c = cb + lane;
  float* carL = aggL + 512;
  if (!sample) {
    float* AGGP = (float*)(p.ws + W_AGG);
    float* AGGH = AGGP + 128 * 1024;
    const int chunk = mt & 31, base = mt - chunk;
    if (mode == 1) {
      float Pq[8], Hq[8];
#pragma unroll
      for (int k = 0; k < 8; k++) {
        const int q = w * 8 + k;
        const bool ok = q < chunk;
        Pq[k] = ok ? AGGP[(base + q) * 1024 + c] : 1.f;
        Hq[k] = ok ? AGGH[(base + q) * 1024 + c] : 0.f;
      }
      float Pc = 1.f, hc = 0.f;
#pragma unroll
      for (int k = 0; k < 8; k++) { hc = Pq[k] * hc + Hq[k]; Pc *= Pq[k]; }
      carL[(w * 64 + lane) * 2] = Pc;
      carL[(w * 64 + lane) * 2 + 1] = hc;
    }
    float P = 1.f, h = 0.f;
#pragma unroll 8
    for (int rr = 0; rr < 32; rr++) {
      const float av = aL[(w * 32 + rr) * XC_LD + lane], bv = xcF[(w * 32 + rr) * XC_LD + lane];
      h = av * h + bv;
      P *= av;
    }
    aggL[(w * 64 + lane) * 2] = P;
    aggL[(w * 64 + lane) * 2 + 1] = h;
    __syncthreads();
    if (mode == 0) {
      if (w == 0) {
        float Pt = 1.f, ht = 0.f;
#pragma unroll
        for (int q = 0; q < 4; q++) {
          const float Pq = aggL[(q * 64 + lane) * 2], hq = aggL[(q * 64 + lane) * 2 + 1];
          ht = Pq * ht + hq;
          Pt *= Pq;
        }
        AGGP[mt * 1024 + c] = Pt;
        AGGH[mt * 1024 + c] = ht;
      }
    } else {
      float hin = 0.f;
#pragma unroll
      for (int q = 0; q < 4; q++) hin = carL[(q * 64 + lane) * 2] * hin + carL[(q * 64 + lane) * 2 + 1];
      for (int q = 0; q < w; q++) hin = aggL[(q * 64 + lane) * 2] * hin + aggL[(q * 64 + lane) * 2 + 1];
      float hh = hin;
#pragma unroll 8
      for (int rr = 0; rr < 32; rr++) {
        const int row = w * 32 + rr;
        const float av = aL[row * XC_LD + lane], bv = xcF[row * XC_LD + lane];
        hh = av * hh + bv;
        xcF[row * XC_LD + lane] = hh;
      }
      if (chunk == 31 && w == 3) p.out[O_LRUP + (size_t)(mt >> 5) * 1024 + c] = hh;
    }
  } else {
    float hh = 0.f;
    float h0v[4];
#pragma unroll
    for (int k = 0; k < 4; k++) h0v[k] = p.state_lru[(size_t)(((m0 - NP + w * 32) >> 3) + k) * 1024 + c];
#pragma unroll
    for (int rr = 0; rr < 32; rr++) {
      const int row = w * 32 + rr;
      const int bb = (m0 - NP + row) >> 3;
      const int t = row & 7;
      if (t == 0) hh = h0v[rr >> 3];
      const float av = aL[row * XC_LD + lane], bv = xcF[row * XC_LD + lane];
      hh = av * hh + bv;
      xcF[row * XC_LD + lane] = hh;
      if (t == 7) p.out[O_LRUS + (size_t)bb * 1024 + c] = hh;
    }
  }
  if (mode == 1) {
    __syncthreads();
    u16* LO = (u16*)(p.ws + W_ZB);
    const int ch = tid & 7;
#pragma unroll
    for (int it = 0; it < 4; it++) {
      const int r = (tid >> 3) + it * 32;
      float g[8];
      unpack8(*(const uint4*)(ZA + (size_t)(m0 + r) * 2048 + 1024 + cb + ch * 8), g);
      const float4 h0 = *(const float4*)(xcF + r * XC_LD + ch * 8), h1 = *(const float4*)(xcF + r * XC_LD + ch * 8 + 4);
      float v[8] = {h0.x * gelu_tanh(g[0]), h0.y * gelu_tanh(g[1]), h0.z * gelu_tanh(g[2]), h0.w * gelu_tanh(g[3]),
                    h1.x * gelu_tanh(g[4]), h1.y * gelu_tanh(g[5]), h1.z * gelu_tanh(g[6]), h1.w * gelu_tanh(g[7])};
      *(uint4*)(LO + (size_t)(m0 + r) * 1024 + cb + ch * 8) = pack8(v);
    }
  }
}

__device__ __forceinline__ void phase_g3(const Params& p, char* smem) {
  const int tid = opaque_tid();
  u16* As = (u16*)smem;
  u16* Bs = As + 2 * 128 * LDT;
  float* Cs = (float*)smem;
  const u16* LO = (const u16*)(p.ws + W_ZB);
  const u16* ATT = (const u16*)(p.ws + W_XN);
  const u16* WL = (const u16*)(p.ws + W_WTLRU);
  const u16* WA = (const u16*)(p.ws + W_WTATTN);
  const u16* ZC = (const u16*)p.out;
  u16* MG = (u16*)(p.ws + W_ZA);
  for (int t = blockIdx.x; t < MT * 8; t += gridDim.x) {
    int mt, nt;
    tile_map(t, MT * 8, 8, mt, nt);
    const int cc = (tid & 15) * 8;
#pragma unroll
    for (int pass = 0; pass < 2; pass++) {
      f32x4 acc[4][4];
      zero_acc(acc);
      gemm_tile((pass ? ATT : LO) + (size_t)mt * 128 * 1024, 1024, (pass ? WA : WL) + (size_t)nt * 128 * 1024, 1024, 1024,
                acc, smem, tid);
      __syncthreads();
      acc_to_cs(acc, Cs, tid);
      __syncthreads();
#pragma unroll
      for (int i = 0; i < 8; i++) {
        const int r = (tid >> 4) + 16 * i;
        const size_t row = (size_t)(mt * 128 + r);
        float4 a = *(const float4*)(Cs + r * CS_LD + cc), b = *(const float4*)(Cs + r * CS_LD + cc + 4);
        float v[8] = {a.x, a.y, a.z, a.w, b.x, b.y, b.z, b.w};
        float g[8];
        unpack8(*(const uint4*)(ZC + row * 2048 + pass * 1024 + nt * 128 + cc), g);
        u16* mp = MG + row * 1024 + nt * 128 + cc;
        if (pass == 0) {
#pragma unroll
          for (int q = 0; q < 8; q++) v[q] *= sigmoidf_(g[q]);
        } else {
          float pv[8];
          unpack8(*(const uint4*)mp, pv);
#pragma unroll
          for (int q = 0; q < 8; q++) v[q] = pv[q] + v[q] * sigmoidf_(g[q]);
        }
        *(uint4*)mp = pack8(v);
      }
      __syncthreads();
    }
  }
}

__device__ __forceinline__ void phase_g4(const Params& p, char* smem) {
  const int tid = opaque_tid();
  u16* As = (u16*)smem;
  u16* Bs = As + 2 * 128 * LDT;
  float* Cs = (float*)smem;
  const u16* MG = (const u16*)(p.ws + W_ZA);
  const u16* WO = (const u16*)(p.ws + W_WTOUT);
  u16* HG = (u16*)(p.ws + W_ZB);
  float* SSQ = (float*)(p.ws + W_SSQ);
  for (int t = blockIdx.x; t < MT * 8; t += gridDim.x) {
    int mt, nt;
    tile_map(t, MT * 8, 8, mt, nt);
    f32x4 acc[4][4];
    zero_acc(acc);
    gemm_tile(MG + (size_t)mt * 128 * 1024, 1024, WO + (size_t)nt * 128 * 1024, 1024, 1024, acc, smem, tid);
    __syncthreads();
    acc_to_cs(acc, Cs, tid);
    __syncthreads();
    const int cc = (tid & 15) * 8;
    const float4 g0 = *(const float4*)(p.norm2_g + nt * 128 + cc), g1 = *(const float4*)(p.norm2_g + nt * 128 + cc + 4);
#pragma unroll
    for (int i = 0; i < 8; i++) {
      const int r = (tid >> 4) + 16 * i;
      const int row = mt * 128 + r;
      float4 a = *(const float4*)(Cs + r * CS_LD + cc), b = *(const float4*)(Cs + r * CS_LD + cc + 4);
      const float* xr = xrow(p, row) + nt * 128 + cc;
      float4 x0 = *(const float4*)xr, x1 = *(const float4*)(xr + 4);
      a.x += x0.x; a.y += x0.y; a.z += x0.z; a.w += x0.w;
      b.x += x1.x; b.y += x1.y; b.z += x1.z; b.w += x1.w;
      float* ho = p.out + O_Y + (size_t)row * 1024 + nt * 128 + cc;
      *(float4*)ho = a;
      *(float4*)(ho + 4) = b;
      float v[8] = {a.x * g0.x, a.y * g0.y, a.z * g0.z, a.w * g0.w, b.x * g1.x, b.y * g1.y, b.z * g1.z, b.w * g1.w};
      *(uint4*)(HG + (size_t)row * 1024 + nt * 128 + cc) = pack8(v);
      float ss = a.x * a.x + a.y * a.y + a.z * a.z + a.w * a.w + b.x * b.x + b.y * b.y + b.z * b.z + b.w * b.w;
      ss += __shfl_xor(ss, 1);
      ss += __shfl_xor(ss, 2);
      ss += __shfl_xor(ss, 4);
      ss += __shfl_xor(ss, 8);
      if ((tid & 15) == 0) SSQ[(size_t)row * 8 + nt] = ss;
    }
    __syncthreads();
  }
}

__device__ __forceinline__ float row_rstd(const float* SSQ, int row) {
  const float4 a = *(const float4*)(SSQ + (size_t)row * 8), b = *(const float4*)(SSQ + (size_t)row * 8 + 4);
  const float ss = ((a.x + a.y) + (a.z + a.w)) + ((b.x + b.y) + (b.z + b.w));
  return rsqrtf(ss * (1.f / 1024.f) + EPS);
}

__device__ __forceinline__ void phase_g5(const Params& p, char* smem) {
  const int tid = opaque_tid();
  u16* As = (u16*)smem;
  u16* Bs = As + 2 * 128 * LDT;
  float* Cs = (float*)smem;
  const u16* HG = (const u16*)(p.ws + W_ZB);
  const u16* WQ = (const u16*)(p.ws + W_WTQ);
  const float* SSQ = (const float*)(p.ws + W_SSQ);
  u16* QR = (u16*)(p.ws + W_ZA);
  for (int t = blockIdx.x; t < MT * 16; t += gridDim.x) {
    int mt, nt;
    tile_map(t, MT * 16, 16, mt, nt);
    f32x4 acc[4][4];
    zero_acc(acc);
    gemm_tile(HG + (size_t)mt * 128 * 1024, 1024, WQ + (size_t)nt * 128 * 1024, 1024, 1024, acc, smem, tid);
    __syncthreads();
    acc_to_cs(acc, Cs, tid);
    __syncthreads();
    const int cc = (tid & 15) * 8;
#pragma unroll
    for (int i = 0; i < 8; i++) {
      const int r = (tid >> 4) + 16 * i;
      const int row = mt * 128 + r;
      const float rs = row_rstd(SSQ, row);
      float4 a = *(const float4*)(Cs + r * CS_LD + cc), b = *(const float4*)(Cs + r * CS_LD + cc + 4);
      float v[8] = {a.x * rs, a.y * rs, a.z * rs, a.w * rs, b.x * rs, b.y * rs, b.z * rs, b.w * rs};
      *(uint4*)(QR + (size_t)row * 2048 + nt * 128 + cc) = pack8(v);
    }
    __syncthreads();
  }
}

__device__ __forceinline__ void phase_g6(const Params& p, char* smem) {
  const int tid = opaque_tid();
  u16* As = (u16*)smem;
  u16* Bs = As + 2 * 128 * LDT;
  float* Cs = (float*)smem;
  uint32_t* Cu = (uint32_t*)smem;
  uint32_t* TK0 = (uint32_t*)(smem + 128 * CS_LD * 4);
  const u16* QR = (const u16*)(p.ws + W_ZA);
  const u16* SK = (const u16*)(p.ws + W_SK);
  int* IDX = (int*)(p.ws + W_XN);
  float* GW = (float*)(p.ws + W_XN + (size_t)NTOK * 128 * 4);
  const int row = tid >> 1, half = tid & 1;
  for (int t = blockIdx.x; t < MT * 8; t += gridDim.x) {
    int mt, h;
    tile_map(t, MT * 8, 8, mt, h);
    uint32_t tk[16];
    for (int pp = 0; pp < 2; pp++) {
      f32x4 acc[4][4];
      zero_acc(acc);
      gemm_tile(QR + (size_t)mt * 128 * 2048 + h * 256 + pp * 128, 2048, SK + (size_t)(h * 2 + pp) * 16384, 128, 128, acc,
                smem, tid);
      __syncthreads();
      acc_to_cs(acc, Cs, tid);
      __syncthreads();
#pragma unroll
      for (int g = 0; g < 4; g++) {
        uint32_t sg[16];
#pragma unroll
        for (int q4 = 0; q4 < 4; q4++) {
          const int col = half * 64 + g * 16 + q4 * 4;
          const float4 v = *(const float4*)(Cs + row * CS_LD + col);
          sg[q4 * 4 + 0] = (ordf(v.x) & ~0x7Fu) | (uint32_t)(127 - col);
          sg[q4 * 4 + 1] = (ordf(v.y) & ~0x7Fu) | (uint32_t)(126 - col);
          sg[q4 * 4 + 2] = (ordf(v.z) & ~0x7Fu) | (uint32_t)(125 - col);
          sg[q4 * 4 + 3] = (ordf(v.w) & ~0x7Fu) | (uint32_t)(124 - col);
        }
        sort16_desc(sg);
        if (g == 0) {
#pragma unroll
          for (int q = 0; q < 16; q++) tk[q] = sg[q];
        } else {
          merge16_desc(tk, sg);
        }
      }
      __syncthreads();
      if (half == 1) {
#pragma unroll
        for (int q = 0; q < 16; q++) Cu[row * 16 + q] = tk[q];
      }
      __syncthreads();
      if (half == 0) {
        {
          uint32_t sg[16];
#pragma unroll
          for (int q4 = 0; q4 < 4; q4++) {
            const uint4 u = *(const uint4*)(Cu + row * 16 + q4 * 4);
            sg[q4 * 4] = u.x; sg[q4 * 4 + 1] = u.y; sg[q4 * 4 + 2] = u.z; sg[q4 * 4 + 3] = u.w;
          }
          merge16_desc(tk, sg);
        }
        if (pp == 0) {
#pragma unroll
          for (int q = 0; q < 16; q++) TK0[row * 16 + q] = tk[q];
        } else {
#pragma unroll
          for (int q = 0; q < 16; q++) Cu[2048 + row * 16 + q] = tk[q];
        }
      }
      __syncthreads();
    }
    if (half == 0) {
      float va[16], vb[16];
#pragma unroll
      for (int q = 0; q < 16; q++) {
        va[q] = unordf(TK0[row * 16 + q] & ~0x7Fu);
        vb[q] = unordf(tk[q] & ~0x7Fu);
      }
      uint32_t cd[16];
#pragma unroll
      for (int q = 0; q < 16; q++) cd[q] = (ordf(va[0] + vb[q]) & ~0xFFu) | (uint32_t)(255 - q);
#pragma unroll
      for (int i = 1; i < 16; i++) {
#pragma unroll
        for (int j = 0; j < 16; j++) {
          if ((i + 1) * (j + 1) <= 16) {
            const float sv = va[i] + vb[j];
            const uint32_t key = (ordf(sv) & ~0xFFu) | (uint32_t)(255 - (i * 16 + j));
            INS16(cd, key);
          }
        }
      }
      float ev[16];
      const float m0v = unordf(cd[0] & ~0xFFu);
      float esum = 0.f;
#pragma unroll
      for (int q = 0; q < 16; q++) {
        ev[q] = __expf(unordf(cd[q] & ~0xFFu) - m0v);
        esum += ev[q];
      }
      const float inv = 1.f / esum;
      const size_t ob = (size_t)(mt * 128 + row) * 128 + h * 16;
#pragma unroll
      for (int q = 0; q < 16; q++) {
        const int ij = 255 - (int)(cd[q] & 0xFFu);
        const int i0 = 127 - (int)(TK0[row * 16 + (ij >> 4)] & 0x7Fu);
        const int i1 = 127 - (int)(Cu[2048 + row * 16 + (ij & 15)] & 0x7Fu);
        IDX[ob + q] = i0 * 128 + i1;
        GW[ob + q] = ev[q] * inv;
      }
    }
    __syncthreads();
  }
}

typedef __attribute__((ext_vector_type(2))) float f32x2;
__device__ __forceinline__ void dec16(uint4 u, float* v) {
  f32x2 t;
  t = __builtin_amdgcn_cvt_pk_f32_fp8((int)u.x, false); v[0] = t.x; v[1] = t.y;
  t = __builtin_amdgcn_cvt_pk_f32_fp8((int)u.x, true); v[2] = t.x; v[3] = t.y;
  t = __builtin_amdgcn_cvt_pk_f32_fp8((int)u.y, false); v[4] = t.x; v[5] = t.y;
  t = __builtin_amdgcn_cvt_pk_f32_fp8((int)u.y, true); v[6] = t.x; v[7] = t.y;
  t = __builtin_amdgcn_cvt_pk_f32_fp8((int)u.z, false); v[8] = t.x; v[9] = t.y;
  t = __builtin_amdgcn_cvt_pk_f32_fp8((int)u.z, true); v[10] = t.x; v[11] = t.y;
  t = __builtin_amdgcn_cvt_pk_f32_fp8((int)u.w, false); v[12] = t.x; v[13] = t.y;
  t = __builtin_amdgcn_cvt_pk_f32_fp8((int)u.w, true); v[14] = t.x; v[15] = t.y;
}

__device__ __forceinline__ void phase7(const Params& p) {
  const int tid = opaque_tid(), lane = tid & 63, w = tid >> 6;
  const u16* HG = (const u16*)(p.ws + W_ZB);
  const float* SSQ = (const float*)(p.ws + W_SSQ);
  const int* IDX = (const int*)(p.ws + W_XN);
  const float* GW = (const float*)(p.ws + W_XN + (size_t)NTOK * 128 * 4);
  const unsigned char* EU = (const unsigned char*)(p.ws + W_EU);
  const unsigned char* EV = (const unsigned char*)(p.ws + W_EV);
  const float* ESC = (const float*)(p.ws + W_ESC);
  const int b0 = lane & 1, b1 = (lane >> 1) & 1, b2 = (lane >> 2) & 1;
  for (int tok = blockIdx.x * 4 + w; tok < NTOK; tok += gridDim.x * 4) {
    const float rs = row_rstd(SSQ, tok);
    float xh[16];
    {
      const uint4* hp = (const uint4*)(HG + (size_t)tok * 1024 + lane * 16);
      unpack8(hp[0], xh);
      unpack8(hp[1], xh + 8);
#pragma unroll
      for (int i = 0; i < 16; i++) xh[i] *= rs;
    }
    const int iA = IDX[(size_t)tok * 128 + lane], iB = IDX[(size_t)tok * 128 + 64 + lane];
    const float gA = GW[(size_t)tok * 128 + lane] * ESC[16384 + iA], gB = GW[(size_t)tok * 128 + 64 + lane] * ESC[16384 + iB];
    const float suA = ESC[iA], suB = ESC[iB];
    float dA = 0.f, dB = 0.f;
    for (int bb = 0; bb < 16; bb++) {
      const int isrc = bb < 8 ? iA : iB;
      float d[8];
#pragma unroll
      for (int k = 0; k < 8; k++) {
        const int id = __builtin_amdgcn_readlane(isrc, (bb & 7) * 8 + k);
        const uint4 u = *(const uint4*)(EU + (size_t)id * 1024 + lane * 16);
        float uv[16];
        dec16(u, uv);
        float sacc = 0.f;
#pragma unroll
        for (int i = 0; i < 16; i++) sacc += xh[i] * uv[i];
        d[k] = sacc;
      }
      float e4[4], e2[2], e1;
#pragma unroll
      for (int i = 0; i < 4; i++) {
        const float keep = b0 ? d[2 * i + 1] : d[2 * i];
        const float send = b0 ? d[2 * i] : d[2 * i + 1];
        e4[i] = keep + __shfl_xor(send, 1);
      }
#pragma unroll
      for (int i = 0; i < 2; i++) {
        const float keep = b1 ? e4[2 * i + 1] : e4[2 * i];
        const float send = b1 ? e4[2 * i] : e4[2 * i + 1];
        e2[i] = keep + __shfl_xor(send, 2);
      }
      {
        const float keep = b2 ? e2[1] : e2[0];
        const float send = b2 ? e2[0] : e2[1];
        e1 = keep + __shfl_xor(send, 4);
      }
      e1 += __shfl_xor(e1, 8);
      e1 += __shfl_xor(e1, 16);
      e1 += __shfl_xor(e1, 32);
      const bool mine = (lane >> 3) == (bb & 7);
      if (bb < 8) dA = mine ? e1 : dA; else dB = mine ? e1 : dB;
    }
    const float actA = gelu_tanh(dA * suA) * gA, actB = gelu_tanh(dB * suB) * gB;
    float o[16];
#pragma unroll
    for (int i = 0; i < 16; i++) o[i] = 0.f;
    for (int bb = 0; bb < 16; bb++) {
      const int isrc = bb < 8 ? iA : iB;
      const float asrc = bb < 8 ? actA : actB;
#pragma unroll
      for (int k = 0; k < 8; k++) {
        const int id = __builtin_amdgcn_readlane(isrc, (bb & 7) * 8 + k);
        const float a = __uint_as_float(__builtin_amdgcn_readlane(__float_as_uint(asrc), (bb & 7) * 8 + k));
        const uint4 u = *(const uint4*)(EV + (size_t)id * 1024 + lane * 16);
        float vv[16];
        dec16(u, vv);
#pragma unroll
        for (int i = 0; i < 16; i++) o[i] += a * vv[i];
      }
    }
    float* yo = p.out + O_Y + (size_t)tok * 1024 + lane * 16;
#pragma unroll
    for (int q = 0; q < 4; q++) {
      float4 h = *(const float4*)(yo + q * 4);
      h.x += o[q * 4]; h.y += o[q * 4 + 1]; h.z += o[q * 4 + 2]; h.w += o[q * 4 + 3];
      *(float4*)(yo + q * 4) = h;
    }
  }
}

#define XB_TMO      128
#define XB_XCNT(j)  (256  + 64 * (j))
#define XB_XSUB(j)  (1280 + 64 * (j))
#define XB_XGEN(j)  (2304 + 64 * (j))
#define XB_TOP      3328
#define XB_TOPGEN   3392
#define XCD_BAR_WORDS 3456
#define XB_SPIN_CAP (1u << 18)
#define LAS __attribute__((address_space(3)))
__device__ __forceinline__ unsigned xb_ld(unsigned* p) { return __hip_atomic_load(p, __ATOMIC_RELAXED, __HIP_MEMORY_SCOPE_AGENT); }
__device__ __forceinline__ unsigned xb_add(unsigned* p, unsigned v) { return __hip_atomic_fetch_add(p, v, __ATOMIC_RELAXED, __HIP_MEMORY_SCOPE_AGENT); }
__device__ __forceinline__ unsigned xb_xcc_id() { return (unsigned)__builtin_amdgcn_s_getreg((3 << 11) | 20) & 0xFu; }
#define XB_SPIN(cond, bar) do { unsigned _sp = 0; while (cond) { __builtin_amdgcn_s_sleep(1); \
    if ((++_sp & 255u) == 0u) { if (xb_ld(&(bar)[XB_TMO])) break; if (_sp > XB_SPIN_CAP) { atomicAdd(&(bar)[XB_TMO], 1u); break; } } } } while (0)
struct XcdBarrier { unsigned* bar; unsigned x; volatile LAS unsigned* st; };
__device__ __forceinline__ XcdBarrier xcd_barrier_post(unsigned* bar, volatile LAS unsigned* st) {
  XcdBarrier b; b.bar = bar; b.x = xb_xcc_id(); b.st = st;
  if (threadIdx.x == 0) (void)xb_add(&bar[XB_XCNT(b.x)], 1u);
  return b;
}
__device__ __forceinline__ void xcd_barrier_complete(unsigned* bar, unsigned x, unsigned& nloc, unsigned& nx) {
  const unsigned G = gridDim.x * gridDim.y * gridDim.z;
  unsigned sum, cnt, mine, sp = 0u;
  for (;;) {
    sum = 0u; cnt = 0u; mine = 0u;
#pragma unroll
    for (unsigned j = 0; j < 16; ++j) { const unsigned c = xb_ld(&bar[XB_XCNT(j)]); sum += c; cnt += (c > 0u) ? 1u : 0u; mine = (j == x) ? c : mine; }
    if (sum == G) break;
    __builtin_amdgcn_s_sleep(1);
    if ((++sp & 255u) == 0u) { if (xb_ld(&bar[XB_TMO])) break; if (sp > XB_SPIN_CAP) { atomicAdd(&bar[XB_TMO], 1u); break; } }
  }
  nloc = mine > 0u ? mine : 1u; nx = cnt > 0u ? cnt : 1u;
}
__device__ __forceinline__ void xcd_barrier(const XcdBarrier& b) {
  asm volatile("s_waitcnt vmcnt(0)" ::: "memory");
  __syncthreads();
  if (threadIdx.x == 0) {
    unsigned* bar = b.bar;
    __builtin_amdgcn_s_waitcnt(0);
    unsigned nloc = b.st[0], nx = b.st[1];
    if (nloc == 0u) { xcd_barrier_complete(bar, b.x, nloc, nx); b.st[0] = nloc; b.st[1] = nx; }
    const unsigned old = xb_add(&bar[XB_XSUB(b.x)], 1u);
    const unsigned gen = old / nloc;
    if (old + 1u == (gen + 1u) * nloc) {
      __builtin_amdgcn_fence(__ATOMIC_RELEASE, "agent");
      asm volatile("s_waitcnt vmcnt(0)" ::: "memory");
      const unsigned og = xb_add(&bar[XB_TOP], 1u);
      const unsigned tg = og / nx;
      if (og + 1u == (tg + 1u) * nx) xb_add(&bar[XB_TOPGEN], 1u);
      else XB_SPIN(xb_ld(&bar[XB_TOPGEN]) == tg, bar);
      __builtin_amdgcn_fence(__ATOMIC_ACQUIRE, "agent");
      xb_add(&bar[XB_XGEN(b.x)], 1u);
      asm volatile("s_waitcnt vmcnt(0)" ::: "memory");
    } else {
      XB_SPIN(xb_ld(&bar[XB_XGEN(b.x)]) == gen, bar);
      __builtin_amdgcn_fence(__ATOMIC_ACQUIRE, "agent");
      asm volatile("s_waitcnt vmcnt(0)" ::: "memory");
    }
  }
  __syncthreads();
}

#ifndef REP_MASK
#define REP_MASK 0
#endif
#define REPS(k) for (int _rep = 0; _rep < (((REP_MASK) >> (k)) & 1) + 1; _rep++)
__global__ void __launch_bounds__(256, 2) fwd_megakernel(Params p) {
  extern __shared__ __attribute__((aligned(16))) char smem[];
  cg::grid_group grid = cg::this_grid();
  if (p.ws == nullptr) grid.sync();
  volatile LAS unsigned* xst = (volatile LAS unsigned*)(smem + SMEM_BYTES - 16);
  if (threadIdx.x == 0) { xst[0] = 0u; xst[1] = 0u; xst[2] = 0u; xst[3] = 0u; }
  __syncthreads();
  const XcdBarrier xb = xcd_barrier_post((unsigned*)(p.ws + W_BAR), xst);
  REPS(0) { phase0(p, smem); xcd_barrier(xb); }
  REPS(1) { phase_g1(p, smem); xcd_barrier(xb); }
  REPS(2) {
    for (int it = blockIdx.x; it < 1536 + 2048; it += gridDim.x) {
      if (it < 1536) attn_item(p, smem, it);
      else { const int q = it - 1536; lru_tile(p, smem, q >> 4, q & 15, 0); }
    }
    xcd_barrier(xb);
  }
  REPS(3) {
    for (int it = blockIdx.x; it < MT * 16; it += gridDim.x) lru_tile(p, smem, it >> 4, it & 15, 1);
    xcd_barrier(xb);
  }
  REPS(4) { phase_g3(p, smem); xcd_barrier(xb); }
  REPS(5) { phase_g4(p, smem); xcd_barrier(xb); }
  REPS(6) { phase_g5(p, smem); xcd_barrier(xb); }
  REPS(7) { phase_g6(p, smem); xcd_barrier(xb); }
  phase7(p);
}

extern "C" void kernel_launch(void* const* d_in, const int* in_sizes, int n_in, void* d_out, int out_size, void* d_ws,
                              size_t ws_size, hipStream_t stream) {
  static int grid_blocks = 0;
  if (!grid_blocks) {
    int dev = 0, cus = 0, per_cu = 0;
    hipGetDevice(&dev);
    hipDeviceGetAttribute(&cus, hipDeviceAttributeMultiprocessorCount, dev);
    hipFuncSetAttribute((const void*)fwd_megakernel, hipFuncAttributeMaxDynamicSharedMemorySize, SMEM_BYTES);
    hipOccupancyMaxActiveBlocksPerMultiprocessor(&per_cu, fwd_megakernel, 256, SMEM_BYTES);
    if (per_cu < 1) per_cu = 1;
    grid_blocks = cus * per_cu;
  }
  Params p{};
  const float** pp = (const float**)&p;
  for (int i = 0; i < 26; i++) pp[i] = (const float*)d_in[i];
  p.out = (float*)d_out;
  p.ws = (char*)d_ws;
  (void)hipMemsetAsync((char*)d_ws + W_BAR, 0, (size_t)3456 * 4, stream);
  void* args[] = {&p};
  hipError_t e = hipLaunchCooperativeKernel((void*)fwd_megakernel, dim3(grid_blocks), dim3(256), args, SMEM_BYTES, stream);
  if (e != hipSuccess) fprintf(stderr, "cooperative launch failed: %s (grid %d)\n", hipGetErrorString(e), grid_blocks);
}
```

```cpp
#include <hip/hip_runtime.h>
#include <hip/hip_cooperative_groups.h>
#include <stdint.h>
#include <cstdio>
namespace cg = cooperative_groups;

typedef unsigned short u16;
typedef __attribute__((ext_vector_type(8))) short bf16x8;
typedef __attribute__((ext_vector_type(4))) float f32x4;

constexpr int D = 1024;
constexpr int NP = 16384;
constexpr int NTOK = 17408;
constexpr int SEQ = 4096;
constexpr int MT = 136;
constexpr float EPS = 1e-6f;

constexpr size_t O_Y = 0;
constexpr size_t O_CONVP = 17825792;
constexpr size_t O_LRUP = O_CONVP + 12288;
constexpr size_t O_KP = O_LRUP + 4096;
constexpr size_t O_VP = O_KP + 131072;
constexpr size_t O_CONVS = O_VP + 131072;
constexpr size_t O_LRUS = O_CONVS + 393216;
constexpr size_t O_KS = O_LRUS + 131072;
constexpr size_t O_VS = O_KS + 4194304;

constexpr size_t W_WTIN = 0;
constexpr size_t W_WTLRU = W_WTIN + (size_t)5632 * 1024 * 2;
constexpr size_t W_WTATTN = W_WTLRU + (size_t)1024 * 1024 * 2;
constexpr size_t W_WTOUT = W_WTATTN + (size_t)1024 * 1024 * 2;
constexpr size_t W_WTQ = W_WTOUT + (size_t)1024 * 1024 * 2;
constexpr size_t W_SK = W_WTQ + (size_t)2048 * 1024 * 2;
constexpr size_t W_RGA = W_SK + (size_t)16 * 128 * 128 * 2;
constexpr size_t W_RGX = W_RGA + (size_t)65536 * 2;
constexpr size_t W_EU = W_RGX + (size_t)65536 * 2;
constexpr size_t W_EV = W_EU + (size_t)16384 * 1024;
constexpr size_t W_ESC = W_EV + (size_t)16384 * 1024;
constexpr size_t W_XN = W_ESC + (size_t)32768 * 4;
constexpr size_t W_ZA = W_XN + (size_t)NTOK * 1024 * 2;
constexpr size_t W_ZB = W_ZA + (size_t)NTOK * 2048 * 2;
constexpr size_t W_AGG = W_ZB + (size_t)NTOK * 1536 * 2;
constexpr size_t W_SSQ = W_AGG + (size_t)128 * 1024 * 2 * 4;
constexpr size_t W_BAR = W_SSQ + (size_t)NTOK * 8 * 4;
constexpr size_t W_Q = W_BAR + (size_t)3456 * 4;
constexpr size_t W_ACT = W_Q + (size_t)8 * 256;
constexpr size_t W_END = W_ACT + (size_t)NTOK * 128 * 4;

constexpr int SMEM_BYTES = 81920;

struct Params {
  const float *x_prompt, *x_sample, *cache_conv, *state_lru, *cache_k, *cache_v, *norm1_g, *w_in, *conv_w,
      *conv_b, *rg_w_a, *rg_b_a, *rg_w_x, *rg_b_x, *rg_lambda, *q_norm_g, *k_norm_g, *attn_sinks,
      *w_branch_lru, *w_branch_attn, *w_out, *norm2_g, *peer_w_query, *peer_sub_keys, *expert_u, *expert_v;
  float* out;
  char* ws;
};

typedef const __attribute__((address_space(4))) Params KParams;
__device__ __forceinline__ KParams* fresh_params() {
  unsigned long long k = (unsigned long long)__builtin_amdgcn_kernarg_segment_ptr();
  asm volatile("" : "+s"(k));
  return (KParams*)k;
}
__device__ __forceinline__ u16 f2bf(float f) {
  uint32_t u = __float_as_uint(f);
  u += 0x7FFFu + ((u >> 16) & 1u);
  return (u16)(u >> 16);
}
__device__ __forceinline__ float bf2f(u16 h) { return __uint_as_float(((uint32_t)h) << 16); }
__device__ __forceinline__ uint32_t pack2(float a, float b) {
  return (uint32_t)f2bf(a) | ((uint32_t)f2bf(b) << 16);
}
__device__ __forceinline__ uint4 pack8(const float* v) {
  uint4 o;
  o.x = pack2(v[0], v[1]); o.y = pack2(v[2], v[3]); o.z = pack2(v[4], v[5]); o.w = pack2(v[6], v[7]);
  return o;
}
__device__ __forceinline__ void unpack8(uint4 u, float* v) {
  v[0] = __uint_as_float(u.x << 16); v[1] = __uint_as_float(u.x & 0xFFFF0000u);
  v[2] = __uint_as_float(u.y << 16); v[3] = __uint_as_float(u.y & 0xFFFF0000u);
  v[4] = __uint_as_float(u.z << 16); v[5] = __uint_as_float(u.z & 0xFFFF0000u);
  v[6] = __uint_as_float(u.w << 16); v[7] = __uint_as_float(u.w & 0xFFFF0000u);
}
__device__ __forceinline__ float sigmoidf_(float x) { return 1.f / (1.f + __expf(-x)); }
__device__ __forceinline__ float gelu_tanh(float x) {
  float y = 0.7978845608028654f * (x + 0.044715f * x * x * x);
  float t = 1.f - 2.f / (__expf(2.f * y) + 1.f);
  return 0.5f * x * (1.f + t);
}
__device__ __forceinline__ uint32_t ordf(float f) {
  uint32_t u = __float_as_uint(f);
  return (u & 0x80000000u) ? ~u : (u | 0x80000000u);
}
__device__ __forceinline__ float unordf(uint32_t o) {
  uint32_t u = (o & 0x80000000u) ? (o ^ 0x80000000u) : ~o;
  return __uint_as_float(u);
}
__device__ __forceinline__ unsigned hw_xcc_id() { return (unsigned)__builtin_amdgcn_s_getreg((3 << 11) | 20) & 0xFu; }
__device__ __forceinline__ int opaque_tid() {
  int t = threadIdx.x;
  asm volatile("" : "+v"(t));
  return t;
}
__device__ __forceinline__ const float* xrow(KParams& p, int row) {
  return row < NP ? p.x_prompt + (size_t)row * D : p.x_sample + (size_t)(row - NP) * D;
}

#define INS16(T, V)                                  \
  {                                                  \
    uint32_t _v = (V);                               \
    _Pragma("unroll") for (int _q = 0; _q < 16; _q++) { \
      uint32_t _hi = max(T[_q], _v);                 \
      _v = min(T[_q], _v);                           \
      T[_q] = _hi;                                   \
    }                                                \
  }

#define CE_DESC(A_, B_) { const uint32_t _h = max(A_, B_), _l = min(A_, B_); A_ = _h; B_ = _l; }
__device__ __forceinline__ void sort16_desc(uint32_t (&t)[16]) {
#pragma unroll
  for (int k = 2; k <= 16; k <<= 1) {
#pragma unroll
    for (int j = k >> 1; j > 0; j >>= 1) {
#pragma unroll
      for (int i = 0; i < 16; i++) {
        const int l = i ^ j;
        if (l > i) {
          if ((i & k) == 0) { CE_DESC(t[i], t[l]); } else { CE_DESC(t[l], t[i]); }
        }
      }
    }
  }
}
__device__ __forceinline__ void merge16_desc(uint32_t (&T)[16], const uint32_t (&S)[16]) {
#pragma unroll
  for (int i = 0; i < 16; i++) T[i] = max(T[i], S[15 - i]);
#pragma unroll
  for (int j = 8; j > 0; j >>= 1) {
#pragma unroll
    for (int i = 0; i < 16; i++) {
      const int l = i ^ j;
      if (l > i) { CE_DESC(T[i], T[l]); }
    }
  }
}

__device__ __forceinline__ void transpose_cvt(const float* __restrict__ W, u16* __restrict__ Wt, int K, int N,
                                              size_t gtid, size_t gsz) {
  size_t total = (size_t)N * (K / 8);
  for (size_t c = gtid; c < total; c += gsz) {
    int n = (int)(c % N);
    int kg = (int)(c / N);
    float v[8];
#pragma unroll
    for (int i = 0; i < 8; i++) v[i] = W[(size_t)(kg * 8 + i) * N + n];
    *(uint4*)(Wt + (size_t)n * K + kg * 8) = pack8(v);
  }
}
__device__ __forceinline__ void plain_cvt(const float* __restrict__ S, u16* __restrict__ Dst, size_t n, size_t gtid,
                                          size_t gsz) {
  size_t total = n / 8;
  const float4* s4 = (const float4*)S;
  for (size_t c = gtid; c < total; c += gsz) {
    float4 a = s4[2 * c], b = s4[2 * c + 1];
    float v[8] = {a.x, a.y, a.z, a.w, b.x, b.y, b.z, b.w};
    *(uint4*)(Dst + c * 8) = pack8(v);
  }
}

__device__ __forceinline__ void phase0(KParams& p, char* smem) {
  const int tid = opaque_tid();
  const size_t gtid = (size_t)blockIdx.x * 256 + tid, gsz = (size_t)gridDim.x * 256;
  char* ws = p.ws;
  {
    const int lane = tid & 63;
    const int gw = (int)(gtid >> 6), nw = (int)(gsz >> 6);
    u16* XN = (u16*)(ws + W_XN);
    for (int row = gw; row < NTOK; row += nw) {
      const float4* xr = (const float4*)xrow(p, row);
      float4 v[4];
      float ss = 0.f;
#pragma unroll
      for (int i = 0; i < 4; i++) {
        v[i] = xr[lane + i * 64];
        ss += v[i].x * v[i].x + v[i].y * v[i].y + v[i].z * v[i].z + v[i].w * v[i].w;
      }
#pragma unroll
      for (int o = 32; o > 0; o >>= 1) ss += __shfl_xor(ss, o);
      float rstd = rsqrtf(ss * (1.f / 1024.f) + EPS);
      const float4* g4 = (const float4*)p.norm1_g;
#pragma unroll
      for (int i = 0; i < 4; i++) {
        float4 g = g4[lane + i * 64];
        uint2 o;
        o.x = pack2(v[i].x * rstd * g.x, v[i].y * rstd * g.y);
        o.y = pack2(v[i].z * rstd * g.z, v[i].w * rstd * g.w);
        *(uint2*)(XN + (size_t)row * D + (lane + i * 64) * 4) = o;
      }
    }
  }
  {
    float* T = (float*)smem;
    for (int tile = blockIdx.x; tile < 2688; tile += gridDim.x) {
      const float* W;
      u16* Wt;
      int N, tl;
      if (tile < 1408) { W = p.w_in; Wt = (u16*)(ws + W_WTIN); N = 5632; tl = tile; }
      else if (tile < 1664) { W = p.w_branch_lru; Wt = (u16*)(ws + W_WTLRU); N = 1024; tl = tile - 1408; }
      else if (tile < 1920) { W = p.w_branch_attn; Wt = (u16*)(ws + W_WTATTN); N = 1024; tl = tile - 1664; }
      else if (tile < 2176) { W = p.w_out; Wt = (u16*)(ws + W_WTOUT); N = 1024; tl = tile - 1920; }
      else { W = p.peer_w_query; Wt = (u16*)(ws + W_WTQ); N = 2048; tl = tile - 2176; }
      const int ntn = N >> 6;
      const int kt = tl / ntn, nt = tl - kt * ntn;
      __syncthreads();
      {
        const float* src = W + (size_t)(kt * 64 + (tid >> 2)) * N + nt * 64 + (tid & 3) * 16;
        const float4 a0 = *(const float4*)src, a1 = *(const float4*)(src + 4), a2 = *(const float4*)(src + 8),
                     a3 = *(const float4*)(src + 12);
        float* d = T + (tid >> 2) * 65 + (tid & 3) * 16;
        d[0] = a0.x; d[1] = a0.y; d[2] = a0.z; d[3] = a0.w; d[4] = a1.x; d[5] = a1.y; d[6] = a1.z; d[7] = a1.w;
        d[8] = a2.x; d[9] = a2.y; d[10] = a2.z; d[11] = a2.w; d[12] = a3.x; d[13] = a3.y; d[14] = a3.z; d[15] = a3.w;
      }
      __syncthreads();
      {
        const int n = tid >> 2, kc = (tid & 3) * 16;
        float v[16];
#pragma unroll
        for (int i = 0; i < 16; i++) v[i] = T[(kc + i) * 65 + n];
        u16* dst = Wt + (size_t)(nt * 64 + n) * 1024 + kt * 64 + kc;
        *(uint4*)dst = pack8(v);
        *(uint4*)(dst + 8) = pack8(v + 8);
      }
    }
  }
  {
    u16* RA = (u16*)(ws + W_RGA);
    u16* RX = (u16*)(ws + W_RGX);
    for (size_t e = gtid; e < 65536; e += gsz) {
      int n = (int)(e >> 12), k = (int)((e >> 6) & 63), j = (int)(e & 63);
      RA[e] = f2bf(p.rg_w_a[n * 4096 + j * 64 + k]);
      RX[e] = f2bf(p.rg_w_x[n * 4096 + j * 64 + k]);
    }
  }
  plain_cvt(p.peer_sub_keys, (u16*)(ws + W_SK), (size_t)16 * 128 * 128, gtid, gsz);
  {
    const int lane = tid & 63;
    const int gw = (int)(gtid >> 6), nw = (int)(gsz >> 6);
    unsigned char* E8 = (unsigned char*)(ws + W_EU);
    float* ESC = (float*)(ws + W_ESC);
    for (int r = gw; r < 32768; r += nw) {
      const float* src = (r < 16384 ? p.expert_u : p.expert_v) + (size_t)(r & 16383) * 1024 + lane * 16;
      const float4 a0 = *(const float4*)src, a1 = *(const float4*)(src + 4), a2 = *(const float4*)(src + 8),
                   a3 = *(const float4*)(src + 12);
      float am = fmaxf(fmaxf(fmaxf(fabsf(a0.x), fabsf(a0.y)), fmaxf(fabsf(a0.z), fabsf(a0.w))),
                       fmaxf(fmaxf(fabsf(a1.x), fabsf(a1.y)), fmaxf(fabsf(a1.z), fabsf(a1.w))));
      am = fmaxf(am, fmaxf(fmaxf(fmaxf(fabsf(a2.x), fabsf(a2.y)), fmaxf(fabsf(a2.z), fabsf(a2.w))),
                           fmaxf(fmaxf(fabsf(a3.x), fabsf(a3.y)), fmaxf(fabsf(a3.z), fabsf(a3.w)))));
#pragma unroll
      for (int o = 32; o > 0; o >>= 1) am = fmaxf(am, __shfl_xor(am, o));
      const float sc = am > 0.f ? 224.f / am : 1.f;
      uint4 o4;
      int wv;
      wv = __builtin_amdgcn_cvt_pk_fp8_f32(a0.x * sc, a0.y * sc, 0, false);
      wv = __builtin_amdgcn_cvt_pk_fp8_f32(a0.z * sc, a0.w * sc, wv, true);
      o4.x = (uint32_t)wv;
      wv = __builtin_amdgcn_cvt_pk_fp8_f32(a1.x * sc, a1.y * sc, 0, false);
      wv = __builtin_amdgcn_cvt_pk_fp8_f32(a1.z * sc, a1.w * sc, wv, true);
      o4.y = (uint32_t)wv;
      wv = __builtin_amdgcn_cvt_pk_fp8_f32(a2.x * sc, a2.y * sc, 0, false);
      wv = __builtin_amdgcn_cvt_pk_fp8_f32(a2.z * sc, a2.w * sc, wv, true);
      o4.z = (uint32_t)wv;
      wv = __builtin_amdgcn_cvt_pk_fp8_f32(a3.x * sc, a3.y * sc, 0, false);
      wv = __builtin_amdgcn_cvt_pk_fp8_f32(a3.z * sc, a3.w * sc, wv, true);
      o4.w = (uint32_t)wv;
      if (r < 16384) *(uint4*)(E8 + (size_t)r * 1024 + lane * 16) = o4;
      else *(uint4*)(E8 + (size_t)16384 * 1024 + (size_t)(lane >> 3) * (16384 * 128) + (size_t)(r - 16384) * 128 + (lane & 7) * 16) = o4;
      if (lane == 0) ESC[r] = am > 0.f ? am * (1.f / 224.f) : 1.f;
    }
  }
}

constexpr int LDT = 72;
constexpr int CS_LD = 132;

__device__ __forceinline__ void gemm_tile(const u16* __restrict__ A, int lda, const u16* __restrict__ Bt, int ldb,
                                          int K, f32x4 (&acc)[4][4], char* smem, int tid) {
  const int lane = tid & 63, w = tid >> 6;
  const int wm = w >> 1, wn = w & 1;
  const int l15 = lane & 15, quad = lane >> 4;
  const int lr = w * 8 + (lane >> 3);
  const int lc = ((lane & 7) ^ ((lane >> 3) & 7)) * 8;
  const char* Ab = (const char*)A;
  const char* Bb = (const char*)Bt;
  const uint32_t ao = (uint32_t)(lr * lda + lc) * 2u, bo = (uint32_t)(lr * ldb + lc) * 2u;
  const uint32_t sa2 = 64u * (uint32_t)lda, sb2 = 64u * (uint32_t)ldb;
  const uint32_t kmask = (uint32_t)K - 1u, kst = (((uint32_t)blockIdx.x >> 3) * 64u) & kmask;
  char* lw = smem + w * 1024 + lane * 16;
  const int swz = l15 & 7;
  const char* Ar = smem + (wm * 64 + l15) * 128 + ((quad ^ swz) * 16);
  const char* Br = smem + 16384 + (wn * 64 + l15) * 128 + ((quad ^ swz) * 16);
  const char* Ar1 = smem + (wm * 64 + l15) * 128 + (((4 + quad) ^ swz) * 16);
  const char* Br1 = smem + 16384 + (wn * 64 + l15) * 128 + (((4 + quad) ^ swz) * 16);
#define GT_ISSUE(st, off)                                                                                   \
  {                                                                                                         \
    const uint32_t _o = (((uint32_t)(off) + kst) & kmask) * 2u;                                             \
    char* _l = lw + (st) * 32768;                                                                           \
    _Pragma("unroll") for (int j = 0; j < 4; j++) {                                                         \
      __builtin_amdgcn_global_load_lds((const unsigned*)(Ab + (size_t)(ao + j * sa2 + _o)), (unsigned*)(_l + j * 4096), 16, 0, 0);          \
      __builtin_amdgcn_global_load_lds((const unsigned*)(Bb + (size_t)(bo + j * sb2 + _o)), (unsigned*)(_l + 16384 + j * 4096), 16, 0, 0);  \
    }                                                                                                       \
  }
#define GT_MMA(st)                                                                                          \
  {                                                                                                         \
    const char* _ar = Ar + (st) * 32768; const char* _br = Br + (st) * 32768;                               \
    const char* _ar1 = Ar1 + (st) * 32768; const char* _br1 = Br1 + (st) * 32768;                           \
    bf16x8 a0[4], b0[4], a1[4], b1[4];                                                                      \
    _Pragma("unroll") for (int i = 0; i < 4; i++) {                                                         \
      a0[i] = *(const bf16x8*)(_ar + i * 2048);                                                             \
      b0[i] = *(const bf16x8*)(_br + i * 2048);                                                             \
    }                                                                                                       \
    _Pragma("unroll") for (int i = 0; i < 4; i++) {                                                         \
      a1[i] = *(const bf16x8*)(_ar1 + i * 2048);                                                            \
      b1[i] = *(const bf16x8*)(_br1 + i * 2048);                                                            \
    }                                                                                                       \
    _Pragma("unroll") for (int i = 0; i < 4; i++)                                                           \
      _Pragma("unroll") for (int j = 0; j < 4; j++)                                                         \
        acc[i][j] = __builtin_amdgcn_mfma_f32_16x16x32_bf16(a0[i], b0[j], acc[i][j], 0, 0, 0);              \
    _Pragma("unroll") for (int i = 0; i < 4; i++)                                                           \
      _Pragma("unroll") for (int j = 0; j < 4; j++)                                                         \
        acc[i][j] = __builtin_amdgcn_mfma_f32_16x16x32_bf16(a1[i], b1[j], acc[i][j], 0, 0, 0);              \
  }
  __syncthreads();
  GT_ISSUE(0, 0);
  for (int k0 = 0; k0 < K; k0 += 128) {
    asm volatile("s_waitcnt vmcnt(0) lgkmcnt(0)" ::: "memory");
    __builtin_amdgcn_s_barrier();
    asm volatile("" ::: "memory");
    GT_ISSUE(1, k0 + 64);
    GT_MMA(0);
    asm volatile("s_waitcnt vmcnt(0) lgkmcnt(0)" ::: "memory");
    __builtin_amdgcn_s_barrier();
    asm volatile("" ::: "memory");
    if (k0 + 128 < K) GT_ISSUE(0, k0 + 128);
    GT_MMA(1);
  }
#undef GT_ISSUE
#undef GT_MMA
}

__device__ __forceinline__ void tile_map(int it, int total, int NT, int& mt, int& nt, int vb) {
  const int G = gridDim.x;
  int T = it;
  {
    const int round = it / G;
    if (round * G + G <= total) T = round * G + vb;
  }
  const int g = T / (8 * NT), r = T - g * (8 * NT);
  nt = r >> 3;
  mt = g * 8 + (r & 7);
}

__device__ __forceinline__ void zero_acc(f32x4 (&acc)[4][4]) {
#pragma unroll
  for (int i = 0; i < 4; i++)
#pragma unroll
    for (int j = 0; j < 4; j++) acc[i][j] = (f32x4){0.f, 0.f, 0.f, 0.f};
}

__device__ __forceinline__ void acc_to_cs(const f32x4 (&acc)[4][4], float* Cs, int tid) {
  const int lane = tid & 63, w = tid >> 6;
  const int wm = w >> 1, wn = w & 1;
  const int l15 = lane & 15, quad = lane >> 4;
#pragma unroll
  for (int i = 0; i < 4; i++)
#pragma unroll
    for (int j = 0; j < 4; j++)
#pragma unroll
      for (int e = 0; e < 4; e++)
        Cs[(wm * 64 + i * 16 + quad * 4 + e) * CS_LD + wn * 64 + j * 16 + l15] = acc[i][j][e];
}

__device__ __forceinline__ void phase_g1(KParams& p, char* smem, int vb) {
  const int tid = opaque_tid();
  u16* As = (u16*)smem;
  u16* Bs = As + 2 * 128 * LDT;
  float* Cs = (float*)smem;
  const u16* XN = (const u16*)(p.ws + W_XN);
  const u16* WT = (const u16*)(p.ws + W_WTIN);
  for (int t = blockIdx.x; t < MT * 44; t += gridDim.x) {
    int mt, nt;
    tile_map(t, MT * 44, 44, mt, nt, vb);
    f32x4 acc[4][4];
    zero_acc(acc);
    gemm_tile(XN + (size_t)mt * 128 * 1024, 1024, WT + (size_t)nt * 128 * 1024, 1024, 1024, acc, smem, tid);
    __syncthreads();
    acc_to_cs(acc, Cs, tid);
    __syncthreads();
    const int n0 = nt * 128;
    u16* dst;
    int ldd, col;
    if (n0 < 2048) { dst = (u16*)(p.ws + W_ZA); ldd = 2048; col = n0; }
    else if (n0 < 3584) { dst = (u16*)(p.ws + W_ZB); ldd = 1536; col = n0 - 2048; }
    else { dst = (u16*)p.out; ldd = 2048; col = n0 - 3584; }
    const int cc = (tid & 15) * 8;
#pragma unroll
    for (int i = 0; i < 8; i++) {
      const int r = (tid >> 4) + 16 * i;
      float4 a = *(const float4*)(Cs + r * CS_LD + cc), b = *(const float4*)(Cs + r * CS_LD + cc + 4);
      float v[8] = {a.x, a.y, a.z, a.w, b.x, b.y, b.z, b.w};
      *(uint4*)(dst + (size_t)(mt * 128 + r) * ldd + col + cc) = pack8(v);
    }
    __syncthreads();
  }
}

constexpr int KS_LD = 72, VT_LD = 200, PS_LD = 168;
__device__ __forceinline__ void attn_item(KParams& p, char* smem, int item) {
  const int tid = opaque_tid(), lane = tid & 63, w = tid >> 6, l15 = lane & 15, quad = lane >> 4;
  u16* Ks = (u16*)smem;
  u16* Vt = Ks + 192 * KS_LD;
  u16* Ps = Vt + 64 * VT_LD + w * 16 * PS_LD;
  const u16* ZB = (const u16*)(p.ws + W_ZB);
  u16* ATT = (u16*)(p.ws + W_XN);
  const bool sample = item >= 1024;
  int b, qb = 0, kv, rowbase, p0 = 0;
  if (!sample) {
    kv = item & 3; qb = (item >> 2) & 63; b = item >> 8;
    p0 = qb * 64;
    rowbase = b * SEQ + p0;
  } else {
    int it = item - 1024;
    kv = it & 3; b = it >> 2;
    rowbase = NP + b * 8;
  }
  __syncthreads();
  {
    const int ch = tid & 7;
    float kg[8];
#pragma unroll
    for (int i = 0; i < 8; i++) kg[i] = p.k_norm_g[ch * 8 + i];
    const int nrows = sample ? 160 : 192;
    for (int c = tid; c < nrows * 8; c += 256) {
      const int row = c >> 3;
      float kf[8], vf[8];
      bool valid, donorm;
      if (!sample) {
        const int pos = p0 - 128 + row;
        valid = pos >= 0;
        donorm = true;
        if (valid) {
          const u16* src = ZB + (size_t)(b * SEQ + pos) * 1536 + 1024 + kv * 64 + ch * 8;
          unpack8(*(const uint4*)src, kf);
          unpack8(*(const uint4*)(src + 256), vf);
        }
      } else {
        valid = row < 136;
        donorm = row >= 128;
        if (row < 128) {
          const float* sk = p.cache_k + ((size_t)(b * 128 + row) * 4 + kv) * 64 + ch * 8;
          const float* sv = p.cache_v + ((size_t)(b * 128 + row) * 4 + kv) * 64 + ch * 8;
          float4 a0 = *(const float4*)sk, a1 = *(const float4*)(sk + 4);
          float4 b0 = *(const float4*)sv, b1 = *(const float4*)(sv + 4);
          kf[0] = a0.x; kf[1] = a0.y; kf[2] = a0.z; kf[3] = a0.w; kf[4] = a1.x; kf[5] = a1.y; kf[6] = a1.z; kf[7] = a1.w;
          vf[0] = b0.x; vf[1] = b0.y; vf[2] = b0.z; vf[3] = b0.w; vf[4] = b1.x; vf[5] = b1.y; vf[6] = b1.z; vf[7] = b1.w;
        } else if (valid) {
          const u16* src = ZB + (size_t)(NP + b * 8 + (row - 128)) * 1536 + 1024 + kv * 64 + ch * 8;
          unpack8(*(const uint4*)src, kf);
          unpack8(*(const uint4*)(src + 256), vf);
        }
      }
      if (!valid) {
#pragma unroll
        for (int i = 0; i < 8; i++) { kf[i] = 0.f; vf[i] = 0.f; }
      }
      float ss = 0.f;
#pragma unroll
      for (int i = 0; i < 8; i++) ss += kf[i] * kf[i];
      ss += __shfl_xor(ss, 1);
      ss += __shfl_xor(ss, 2);
      ss += __shfl_xor(ss, 4);
      if (donorm) {
        const float rstd = rsqrtf(ss * (1.f / 64.f) + EPS);
#pragma unroll
        for (int i = 0; i < 8; i++) kf[i] = kf[i] * rstd * kg[i];
      }
      *(uint4*)(Ks + row * KS_LD + ch * 8) = pack8(kf);
#pragma unroll
      for (int i = 0; i < 8; i++) Vt[(ch * 8 + i) * VT_LD + row] = f2bf(vf[i]);
      if (!sample) {
        if (qb >= 62 && row >= 128) {
          const int wpos = p0 + (row - 128) - (SEQ - 128);
          float* ko = p.out + O_KP + ((size_t)(b * 128 + wpos) * 4 + kv) * 64 + ch * 8;
          float* vo = p.out + O_VP + ((size_t)(b * 128 + wpos) * 4 + kv) * 64 + ch * 8;
          *(float4*)ko = make_float4(kf[0], kf[1], kf[2], kf[3]);
          *(float4*)(ko + 4) = make_float4(kf[4], kf[5], kf[6], kf[7]);
          *(float4*)vo = make_float4(vf[0], vf[1], vf[2], vf[3]);
          *(float4*)(vo + 4) = make_float4(vf[4], vf[5], vf[6], vf[7]);
        }
      } else {
        if (row >= 8 && row < 136) {
          float* ko = p.out + O_KS + ((size_t)(b * 128 + (row - 8)) * 4 + kv) * 64 + ch * 8;
          float* vo = p.out + O_VS + ((size_t)(b * 128 + (row - 8)) * 4 + kv) * 64 + ch * 8;
          *(float4*)ko = make_float4(kf[0], kf[1], kf[2], kf[3]);
          *(float4*)(ko + 4) = make_float4(kf[4], kf[5], kf[6], kf[7]);
          *(float4*)vo = make_float4(vf[0], vf[1], vf[2], vf[3]);
          *(float4*)(vo + 4) = make_float4(vf[4], vf[5], vf[6], vf[7]);
        }
      }
    }
  }
  __syncthreads();
  const int hq = kv * 4 + w;
  const float slope = exp2f(-0.5f * (float)(hq + 1));
  const float sink = p.attn_sinks[hq];
  float qg[2][8];
#pragma unroll
  for (int ks = 0; ks < 2; ks++)
#pragma unroll
    for (int i = 0; i < 8; i++) qg[ks][i] = p.q_norm_g[ks * 32 + quad * 8 + i] * 0.125f;
  const int nsub = sample ? 1 : 4;
  for (int sb = 0; sb < nsub; sb++) {
    const int r0 = sb * 16;
    const int ws0 = r0 < 32 ? r0 : 32;
    bf16x8 qa[2];
    {
      const int qr = sample ? (l15 & 7) : (r0 + l15);
      const u16* src = ZB + (size_t)(rowbase + qr) * 1536 + hq * 64 + quad * 8;
      float q0[8], q1[8];
      unpack8(*(const uint4*)src, q0);
      unpack8(*(const uint4*)(src + 32), q1);
      float ss = 0.f;
#pragma unroll
      for (int i = 0; i < 8; i++) ss += q0[i] * q0[i] + q1[i] * q1[i];
      ss += __shfl_xor(ss, 16);
      ss += __shfl_xor(ss, 32);
      const float rstd = rsqrtf(ss * (1.f / 64.f) + EPS);
#pragma unroll
      for (int i = 0; i < 8; i++) { q0[i] *= rstd * qg[0][i]; q1[i] *= rstd * qg[1][i]; }
      uint4 u0 = pack8(q0), u1 = pack8(q1);
      qa[0] = __builtin_bit_cast(bf16x8, u0);
      qa[1] = __builtin_bit_cast(bf16x8, u1);
    }
    f32x4 s[10];
#pragma unroll
    for (int kt = 0; kt < 10; kt++) {
      const u16* kp = Ks + (ws0 + kt * 16 + l15) * KS_LD + quad * 8;
      bf16x8 b0 = *(const bf16x8*)kp, b1 = *(const bf16x8*)(kp + 32);
      f32x4 z = {0.f, 0.f, 0.f, 0.f};
      z = __builtin_amdgcn_mfma_f32_16x16x32_bf16(qa[0], b0, z, 0, 0, 0);
      s[kt] = __builtin_amdgcn_mfma_f32_16x16x32_bf16(qa[1], b1, z, 0, 0, 0);
    }
    float mx[4] = {-1e30f, -1e30f, -1e30f, -1e30f};
#pragma unroll
    for (int kt = 0; kt < 10; kt++) {
      const int jj = ws0 + kt * 16 + l15;
      const bool posok = sample ? (jj < 136) : (p0 - 128 + jj >= 0);
#pragma unroll
      for (int e = 0; e < 4; e++) {
        const int r = r0 + quad * 4 + e;
        const int dist = r + 128 - jj;
        const bool ok = posok && dist >= 0 && dist <= 128;
        float v = ok ? (s[kt][e] - slope * (float)dist) : -1e30f;
        s[kt][e] = v;
        mx[e] = fmaxf(mx[e], v);
      }
    }
    float sum[4];
#pragma unroll
    for (int e = 0; e < 4; e++) {
      float m = mx[e];
      m = fmaxf(m, __shfl_xor(m, 1));
      m = fmaxf(m, __shfl_xor(m, 2));
      m = fmaxf(m, __shfl_xor(m, 4));
      m = fmaxf(m, __shfl_xor(m, 8));
      m = fmaxf(m, sink);
      mx[e] = m;
      sum[e] = 0.f;
    }
#pragma unroll
    for (int kt = 0; kt < 10; kt++) {
#pragma unroll
      for (int e = 0; e < 4; e++) {
        float pv = __expf(s[kt][e] - mx[e]);
        sum[e] += pv;
        Ps[(quad * 4 + e) * PS_LD + kt * 16 + l15] = f2bf(pv);
      }
    }
#pragma unroll
    for (int e = 0; e < 4; e++) {
      float t = sum[e];
      t += __shfl_xor(t, 1);
      t += __shfl_xor(t, 2);
      t += __shfl_xor(t, 4);
      t += __shfl_xor(t, 8);
      sum[e] = 1.f / (t + __expf(sink - mx[e]));
    }
    __syncthreads();
    f32x4 o[4];
#pragma unroll
    for (int nt = 0; nt < 4; nt++) o[nt] = (f32x4){0.f, 0.f, 0.f, 0.f};
#pragma unroll
    for (int kk = 0; kk < 5; kk++) {
      bf16x8 pa = *(const bf16x8*)(Ps + l15 * PS_LD + kk * 32 + quad * 8);
#pragma unroll
      for (int nt = 0; nt < 4; nt++) {
        bf16x8 vb = *(const bf16x8*)(Vt + (nt * 16 + l15) * VT_LD + ws0 + kk * 32 + quad * 8);
        o[nt] = __builtin_amdgcn_mfma_f32_16x16x32_bf16(pa, vb, o[nt], 0, 0, 0);
      }
    }
#pragma unroll
    for (int e = 0; e < 4; e++) {
      const int r = quad * 4 + e;
      if (!sample || r < 8) {
        u16* dst = ATT + (size_t)(rowbase + r0 + r) * 1024 + hq * 64 + l15;
#pragma unroll
        for (int nt = 0; nt < 4; nt++) dst[nt * 16] = f2bf(o[nt][e] * sum[e]);
      }
    }
    __syncthreads();
  }
}

constexpr int XC_LD = 68;
__device__ __forceinline__ void lru_tile(KParams& p, char* smem, int mt, int nb, int mode) {
  const int tid = opaque_tid(), lane = tid & 63, w = tid >> 6, l15 = lane & 15, quad = lane >> 4;
  float* xcF = (float*)smem;
  float* aL = xcF + 128 * XC_LD;
  float* aggL = aL + 128 * XC_LD;
  const u16* ZA = (const u16*)(p.ws + W_ZA);
  const bool sample = mt >= 128;
  const int m0 = mt * 128;
  const int cb = nb * 64;
  __syncthreads();
  {
    const int ch = tid & 7;
    float cw[4][8], cbias[8];
#pragma unroll
    for (int j = 0; j < 4; j++)
#pragma unroll
      for (int i = 0; i < 8; i++) cw[j][i] = p.conv_w[j * 1024 + cb + ch * 8 + i];
#pragma unroll
    for (int i = 0; i < 8; i++) cbias[i] = p.conv_b[cb + ch * 8 + i];
#pragma unroll
    for (int it = 0; it < 4; it++) {
      const int r = (tid >> 3) + it * 32;
      const int grow = m0 + r;
      const int t = sample ? (r & 7) : ((mt & 31) * 128 + r);
      float y[8];
#pragma unroll
      for (int i = 0; i < 8; i++) y[i] = cbias[i];
#pragma unroll
      for (int d = 0; d < 4; d++) {
        float xv[8];
        if (t - d >= 0) {
          unpack8(*(const uint4*)(ZA + (size_t)(grow - d) * 2048 + cb + ch * 8), xv);
        } else if (sample) {
          const int bb = (m0 - NP + r) >> 3;
          const float* src = p.cache_conv + ((size_t)bb * 3 + (3 + t - d)) * 1024 + cb + ch * 8;
          float4 a = *(const float4*)src, b4 = *(const float4*)(src + 4);
          xv[0] = a.x; xv[1] = a.y; xv[2] = a.z; xv[3] = a.w; xv[4] = b4.x; xv[5] = b4.y; xv[6] = b4.z; xv[7] = b4.w;
        } else {
#pragma unroll
          for (int i = 0; i < 8; i++) xv[i] = 0.f;
        }
#pragma unroll
        for (int i = 0; i < 8; i++) y[i] += cw[3 - d][i] * xv[i];
        if (d == 0 && mode == 1) {
          if (!sample) {
            if ((mt & 31) == 31 && r >= 125) {
              float* dst = p.out + O_CONVP + ((size_t)(mt >> 5) * 3 + (r - 125)) * 1024 + cb + ch * 8;
              *(float4*)dst = make_float4(xv[0], xv[1], xv[2], xv[3]);
              *(float4*)(dst + 4) = make_float4(xv[4], xv[5], xv[6], xv[7]);
            }
          } else if (t >= 5) {
            const int bb = (m0 - NP + r) >> 3;
            float* dst = p.out + O_CONVS + ((size_t)bb * 3 + (t - 5)) * 1024 + cb + ch * 8;
            *(float4*)dst = make_float4(xv[0], xv[1], xv[2], xv[3]);
            *(float4*)(dst + 4) = make_float4(xv[4], xv[5], xv[6], xv[7]);
          }
        }
      }
      *(float4*)(xcF + r * XC_LD + ch * 8) = make_float4(y[0], y[1], y[2], y[3]);
      *(float4*)(xcF + r * XC_LD + ch * 8 + 4) = make_float4(y[4], y[5], y[6], y[7]);
    }
  }
  __syncthreads();
  {
    const u16* RA = (const u16*)(p.ws + W_RGA) + nb * 4096;
    const u16* RX = (const u16*)(p.ws + W_RGX) + nb * 4096;
    f32x4 aR[2][4], aI[2][4];
#pragma unroll
    for (int i = 0; i < 2; i++)
#pragma unroll
      for (int j = 0; j < 4; j++) { aR[i][j] = (f32x4){0.f, 0.f, 0.f, 0.f}; aI[i][j] = (f32x4){0.f, 0.f, 0.f, 0.f}; }
#pragma unroll
    for (int ks = 0; ks < 2; ks++) {
      bf16x8 a[2];
#pragma unroll
      for (int i = 0; i < 2; i++) {
        const float* src = xcF + (w * 32 + i * 16 + l15) * XC_LD + ks * 32 + quad * 8;
        float4 x0 = *(const float4*)src, x1 = *(const float4*)(src + 4);
        float v[8] = {x0.x, x0.y, x0.z, x0.w, x1.x, x1.y, x1.z, x1.w};
        uint4 u = pack8(v);
        a[i] = __builtin_bit_cast(bf16x8, u);
      }
#pragma unroll
      for (int j = 0; j < 4; j++) {
        bf16x8 ba = *(const bf16x8*)(RA + (j * 16 + l15) * 64 + ks * 32 + quad * 8);
        bf16x8 bx = *(const bf16x8*)(RX + (j * 16 + l15) * 64 + ks * 32 + quad * 8);
#pragma unroll
        for (int i = 0; i < 2; i++) {
          aR[i][j] = __builtin_amdgcn_mfma_f32_16x16x32_bf16(a[i], ba, aR[i][j], 0, 0, 0);
          aI[i][j] = __builtin_amdgcn_mfma_f32_16x16x32_bf16(a[i], bx, aI[i][j], 0, 0, 0);
        }
      }
    }
#pragma unroll
    for (int j = 0; j < 4; j++) {
      const int c = cb + j * 16 + l15;
      const float ba = p.rg_b_a[c], bx = p.rg_b_x[c];
      const float ls = -log1pf(__expf(-p.rg_lambda[c]));
#pragma unroll
      for (int i = 0; i < 2; i++)
#pragma unroll
        for (int e = 0; e < 4; e++) {
          const int row = w * 32 + i * 16 + quad * 4 + e;
          const float rg = sigmoidf_(aR[i][j][e] + ba);
          const float ig = sigmoidf_(aI[i][j][e] + bx);
          const float la = 8.f * rg * ls;
          const float av = __expf(la);
          const float mult = sqrtf(fmaxf(-expm1f(2.f * la), 0.f));
          const int idx = row * XC_LD + j * 16 + l15;
          const float xv = xcF[idx];
          aL[idx] = av;
          xcF[idx] = mult * ig * xv;
        }
    }
  }
  __syncthreads();
  const int c = cb + lane;
  float* carL = aggL + 512;
  if (!sample) {
    float* AGGP = (float*)(p.ws + W_AGG);
    float* AGGH = AGGP + 128 * 1024;
    const int chunk = mt & 31, base = mt - chunk;
    if (mode == 1) {
      float Pq[8], Hq[8];
#pragma unroll
      for (int k = 0; k < 8; k++) {
        const int q = w * 8 + k;
        const bool ok = q < chunk;
        Pq[k] = ok ? AGGP[(base + q) * 1024 + c] : 1.f;
        Hq[k] = ok ? AGGH[(base + q) * 1024 + c] : 0.f;
      }
      float Pc = 1.f, hc = 0.f;
#pragma unroll
      for (int k = 0; k < 8; k++) { hc = Pq[k] * hc + Hq[k]; Pc *= Pq[k]; }
      carL[(w * 64 + lane) * 2] = Pc;
      carL[(w * 64 + lane) * 2 + 1] = hc;
    }
    float P = 1.f, h = 0.f;
#pragma unroll 8
    for (int rr = 0; rr < 32; rr++) {
      const float av = aL[(w * 32 + rr) * XC_LD + lane], bv = xcF[(w * 32 + rr) * XC_LD + lane];
      h = av * h + bv;
      P *= av;
    }
    aggL[(w * 64 + lane) * 2] = P;
    aggL[(w * 64 + lane) * 2 + 1] = h;
    __syncthreads();
    if (mode == 0) {
      if (w == 0) {
        float Pt = 1.f, ht = 0.f;
#pragma unroll
        for (int q = 0; q < 4; q++) {
          const float Pq = aggL[(q * 64 + lane) * 2], hq = aggL[(q * 64 + lane) * 2 + 1];
          ht = Pq * ht + hq;
          Pt *= Pq;
        }
        AGGP[mt * 1024 + c] = Pt;
        AGGH[mt * 1024 + c] = ht;
      }
    } else {
      float hin = 0.f;
#pragma unroll
      for (int q = 0; q < 4; q++) hin = carL[(q * 64 + lane) * 2] * hin + carL[(q * 64 + lane) * 2 + 1];
      for (int q = 0; q < w; q++) hin = aggL[(q * 64 + lane) * 2] * hin + aggL[(q * 64 + lane) * 2 + 1];
      float hh = hin;
#pragma unroll 8
      for (int rr = 0; rr < 32; rr++) {
        const int row = w * 32 + rr;
        const float av = aL[row * XC_LD + lane], bv = xcF[row * XC_LD + lane];
        hh = av * hh + bv;
        xcF[row * XC_LD + lane] = hh;
      }
      if (chunk == 31 && w == 3) p.out[O_LRUP + (size_t)(mt >> 5) * 1024 + c] = hh;
    }
  } else {
    float hh = 0.f;
    float h0v[4];
#pragma unroll
    for (int k = 0; k < 4; k++) h0v[k] = p.state_lru[(size_t)(((m0 - NP + w * 32) >> 3) + k) * 1024 + c];
#pragma unroll
    for (int rr = 0; rr < 32; rr++) {
      const int row = w * 32 + rr;
      const int bb = (m0 - NP + row) >> 3;
      const int t = row & 7;
      if (t == 0) hh = h0v[rr >> 3];
      const float av = aL[row * XC_LD + lane], bv = xcF[row * XC_LD + lane];
      hh = av * hh + bv;
      xcF[row * XC_LD + lane] = hh;
      if (t == 7) p.out[O_LRUS + (size_t)bb * 1024 + c] = hh;
    }
  }
  if (mode == 1) {
    __syncthreads();
    u16* LO = (u16*)(p.ws + W_ZB);
    const int ch = tid & 7;
#pragma unroll
    for (int it = 0; it < 4; it++) {
      const int r = (tid >> 3) + it * 32;
      float g[8];
      unpack8(*(const uint4*)(ZA + (size_t)(m0 + r) * 2048 + 1024 + cb + ch * 8), g);
      const float4 h0 = *(const float4*)(xcF + r * XC_LD + ch * 8), h1 = *(const float4*)(xcF + r * XC_LD + ch * 8 + 4);
      float v[8] = {h0.x * gelu_tanh(g[0]), h0.y * gelu_tanh(g[1]), h0.z * gelu_tanh(g[2]), h0.w * gelu_tanh(g[3]),
                    h1.x * gelu_tanh(g[4]), h1.y * gelu_tanh(g[5]), h1.z * gelu_tanh(g[6]), h1.w * gelu_tanh(g[7])};
      *(uint4*)(LO + (size_t)(m0 + r) * 1024 + cb + ch * 8) = pack8(v);
    }
  }
}

__device__ __forceinline__ void phase_g3(KParams& p, char* smem, int vb) {
  const int tid = opaque_tid();
  u16* As = (u16*)smem;
  u16* Bs = As + 2 * 128 * LDT;
  float* Cs = (float*)smem;
  const u16* LO = (const u16*)(p.ws + W_ZB);
  const u16* ATT = (const u16*)(p.ws + W_XN);
  const u16* WL = (const u16*)(p.ws + W_WTLRU);
  const u16* WA = (const u16*)(p.ws + W_WTATTN);
  const u16* ZC = (const u16*)p.out;
  u16* MG = (u16*)(p.ws + W_ZA);
  for (int t = blockIdx.x; t < MT * 8; t += gridDim.x) {
    int mt, nt;
    tile_map(t, MT * 8, 8, mt, nt, vb);
    const int cc = (tid & 15) * 8;
#pragma unroll
    for (int pass = 0; pass < 2; pass++) {
      f32x4 acc[4][4];
      zero_acc(acc);
      gemm_tile((pass ? ATT : LO) + (size_t)mt * 128 * 1024, 1024, (pass ? WA : WL) + (size_t)nt * 128 * 1024, 1024, 1024,
                acc, smem, tid);
      __syncthreads();
      acc_to_cs(acc, Cs, tid);
      __syncthreads();
#pragma unroll
      for (int i = 0; i < 8; i++) {
        const int r = (tid >> 4) + 16 * i;
        const size_t row = (size_t)(mt * 128 + r);
        float4 a = *(const float4*)(Cs + r * CS_LD + cc), b = *(const float4*)(Cs + r * CS_LD + cc + 4);
        float v[8] = {a.x, a.y, a.z, a.w, b.x, b.y, b.z, b.w};
        float g[8];
        unpack8(*(const uint4*)(ZC + row * 2048 + pass * 1024 + nt * 128 + cc), g);
        u16* mp = MG + row * 1024 + nt * 128 + cc;
        if (pass == 0) {
#pragma unroll
          for (int q = 0; q < 8; q++) v[q] *= sigmoidf_(g[q]);
        } else {
          float pv[8];
          unpack8(*(const uint4*)mp, pv);
#pragma unroll
          for (int q = 0; q < 8; q++) v[q] = pv[q] + v[q] * sigmoidf_(g[q]);
        }
        *(uint4*)mp = pack8(v);
      }
      __syncthreads();
    }
  }
}

__device__ __forceinline__ void phase_g4(KParams& p, char* smem, int vb) {
  const int tid = opaque_tid();
  u16* As = (u16*)smem;
  u16* Bs = As + 2 * 128 * LDT;
  float* Cs = (float*)smem;
  const u16* MG = (const u16*)(p.ws + W_ZA);
  const u16* WO = (const u16*)(p.ws + W_WTOUT);
  u16* HG = (u16*)(p.ws + W_ZB);
  float* SSQ = (float*)(p.ws + W_SSQ);
  for (int t = blockIdx.x; t < MT * 8; t += gridDim.x) {
    int mt, nt;
    tile_map(t, MT * 8, 8, mt, nt, vb);
    f32x4 acc[4][4];
    zero_acc(acc);
    gemm_tile(MG + (size_t)mt * 128 * 1024, 1024, WO + (size_t)nt * 128 * 1024, 1024, 1024, acc, smem, tid);
    __syncthreads();
    acc_to_cs(acc, Cs, tid);
    __syncthreads();
    const int cc = (tid & 15) * 8;
    const float4 g0 = *(const float4*)(p.norm2_g + nt * 128 + cc), g1 = *(const float4*)(p.norm2_g + nt * 128 + cc + 4);
#pragma unroll
    for (int i = 0; i < 8; i++) {
      const int r = (tid >> 4) + 16 * i;
      const int row = mt * 128 + r;
      float4 a = *(const float4*)(Cs + r * CS_LD + cc), b = *(const float4*)(Cs + r * CS_LD + cc + 4);
      const float* xr = xrow(p, row) + nt * 128 + cc;
      float4 x0 = *(const float4*)xr, x1 = *(const float4*)(xr + 4);
      a.x += x0.x; a.y += x0.y; a.z += x0.z; a.w += x0.w;
      b.x += x1.x; b.y += x1.y; b.z += x1.z; b.w += x1.w;
      float* ho = p.out + O_Y + (size_t)row * 1024 + nt * 128 + cc;
      *(float4*)ho = a;
      *(float4*)(ho + 4) = b;
      float v[8] = {a.x * g0.x, a.y * g0.y, a.z * g0.z, a.w * g0.w, b.x * g1.x, b.y * g1.y, b.z * g1.z, b.w * g1.w};
      *(uint4*)(HG + (size_t)row * 1024 + nt * 128 + cc) = pack8(v);
      float ss = a.x * a.x + a.y * a.y + a.z * a.z + a.w * a.w + b.x * b.x + b.y * b.y + b.z * b.z + b.w * b.w;
      ss += __shfl_xor(ss, 1);
      ss += __shfl_xor(ss, 2);
      ss += __shfl_xor(ss, 4);
      ss += __shfl_xor(ss, 8);
      if ((tid & 15) == 0) SSQ[(size_t)row * 8 + nt] = ss;
    }
    __syncthreads();
  }
}

__device__ __forceinline__ float row_rstd(const float* SSQ, int row) {
  const float4 a = *(const float4*)(SSQ + (size_t)row * 8), b = *(const float4*)(SSQ + (size_t)row * 8 + 4);
  const float ss = ((a.x + a.y) + (a.z + a.w)) + ((b.x + b.y) + (b.z + b.w));
  return rsqrtf(ss * (1.f / 1024.f) + EPS);
}

__device__ __forceinline__ void phase_g5(KParams& p, char* smem, int vb) {
  const int tid = opaque_tid();
  u16* As = (u16*)smem;
  u16* Bs = As + 2 * 128 * LDT;
  float* Cs = (float*)smem;
  const u16* HG = (const u16*)(p.ws + W_ZB);
  const u16* WQ = (const u16*)(p.ws + W_WTQ);
  const float* SSQ = (const float*)(p.ws + W_SSQ);
  u16* QR = (u16*)(p.ws + W_ZA);
  for (int t = blockIdx.x; t < MT * 16; t += gridDim.x) {
    int mt, nt;
    tile_map(t, MT * 16, 16, mt, nt, vb);
    f32x4 acc[4][4];
    zero_acc(acc);
    gemm_tile(HG + (size_t)mt * 128 * 1024, 1024, WQ + (size_t)nt * 128 * 1024, 1024, 1024, acc, smem, tid);
    __syncthreads();
    acc_to_cs(acc, Cs, tid);
    __syncthreads();
    const int cc = (tid & 15) * 8;
#pragma unroll
    for (int i = 0; i < 8; i++) {
      const int r = (tid >> 4) + 16 * i;
      const int row = mt * 128 + r;
      const float rs = row_rstd(SSQ, row);
      float4 a = *(const float4*)(Cs + r * CS_LD + cc), b = *(const float4*)(Cs + r * CS_LD + cc + 4);
      float v[8] = {a.x * rs, a.y * rs, a.z * rs, a.w * rs, b.x * rs, b.y * rs, b.z * rs, b.w * rs};
      *(uint4*)(QR + (size_t)row * 2048 + nt * 128 + cc) = pack8(v);
    }
    __syncthreads();
  }
}

__device__ __forceinline__ void phase_g6(KParams& p, char* smem, int vb) {
  const int tid = opaque_tid();
  u16* As = (u16*)smem;
  u16* Bs = As + 2 * 128 * LDT;
  float* Cs = (float*)smem;
  uint32_t* Cu = (uint32_t*)smem;
  uint32_t* TK0 = (uint32_t*)(smem + 128 * CS_LD * 4);
  const u16* QR = (const u16*)(p.ws + W_ZA);
  const u16* SK = (const u16*)(p.ws + W_SK);
  int* IDX = (int*)(p.ws + W_XN);
  float* GW = (float*)(p.ws + W_XN + (size_t)NTOK * 128 * 4);
  const int row = tid >> 1, half = tid & 1;
  for (int t = blockIdx.x; t < MT * 8; t += gridDim.x) {
    int mt, h;
    tile_map(t, MT * 8, 8, mt, h, vb);
    uint32_t tk[16];
    for (int pp = 0; pp < 2; pp++) {
      f32x4 acc[4][4];
      zero_acc(acc);
      gemm_tile(QR + (size_t)mt * 128 * 2048 + h * 256 + pp * 128, 2048, SK + (size_t)(h * 2 + pp) * 16384, 128, 128, acc,
                smem, tid);
      __syncthreads();
      acc_to_cs(acc, Cs, tid);
      __syncthreads();
#pragma unroll
      for (int g = 0; g < 4; g++) {
        uint32_t sg[16];
#pragma unroll
        for (int q4 = 0; q4 < 4; q4++) {
          const int col = half * 64 + g * 16 + q4 * 4;
          const float4 v = *(const float4*)(Cs + row * CS_LD + col);
          sg[q4 * 4 + 0] = (ordf(v.x) & ~0x7Fu) | (uint32_t)(127 - col);
          sg[q4 * 4 + 1] = (ordf(v.y) & ~0x7Fu) | (uint32_t)(126 - col);
          sg[q4 * 4 + 2] = (ordf(v.z) & ~0x7Fu) | (uint32_t)(125 - col);
          sg[q4 * 4 + 3] = (ordf(v.w) & ~0x7Fu) | (uint32_t)(124 - col);
        }
        sort16_desc(sg);
        if (g == 0) {
#pragma unroll
          for (int q = 0; q < 16; q++) tk[q] = sg[q];
        } else {
          merge16_desc(tk, sg);
        }
      }
      __syncthreads();
      if (half == 1) {
#pragma unroll
        for (int q = 0; q < 16; q++) Cu[row * 16 + q] = tk[q];
      }
      __syncthreads();
      if (half == 0) {
        {
          uint32_t sg[16];
#pragma unroll
          for (int q4 = 0; q4 < 4; q4++) {
            const uint4 u = *(const uint4*)(Cu + row * 16 + q4 * 4);
            sg[q4 * 4] = u.x; sg[q4 * 4 + 1] = u.y; sg[q4 * 4 + 2] = u.z; sg[q4 * 4 + 3] = u.w;
          }
          merge16_desc(tk, sg);
        }
        if (pp == 0) {
#pragma unroll
          for (int q = 0; q < 16; q++) TK0[row * 16 + q] = tk[q];
        } else {
#pragma unroll
          for (int q = 0; q < 16; q++) Cu[2048 + row * 16 + q] = tk[q];
        }
      }
      __syncthreads();
    }
    if (half == 0) {
      float va[16], vb[16];
#pragma unroll
      for (int q = 0; q < 16; q++) {
        va[q] = unordf(TK0[row * 16 + q] & ~0x7Fu);
        vb[q] = unordf(tk[q] & ~0x7Fu);
      }
      uint32_t cd[16];
#pragma unroll
      for (int q = 0; q < 16; q++) cd[q] = (ordf(va[0] + vb[q]) & ~0xFFu) | (uint32_t)(255 - q);
#pragma unroll
      for (int i = 1; i < 16; i++) {
#pragma unroll
        for (int j = 0; j < 16; j++) {
          if ((i + 1) * (j + 1) <= 16) {
            const float sv = va[i] + vb[j];
            const uint32_t key = (ordf(sv) & ~0xFFu) | (uint32_t)(255 - (i * 16 + j));
            INS16(cd, key);
          }
        }
      }
      float ev[16];
      const float m0v = unordf(cd[0] & ~0xFFu);
      float esum = 0.f;
#pragma unroll
      for (int q = 0; q < 16; q++) {
        ev[q] = __expf(unordf(cd[q] & ~0xFFu) - m0v);
        esum += ev[q];
      }
      const float inv = 1.f / esum;
      const size_t ob = (size_t)(mt * 128 + row) * 128 + h * 16;
#pragma unroll
      for (int q = 0; q < 16; q++) {
        const int ij = 255 - (int)(cd[q] & 0xFFu);
        const int i0 = 127 - (int)(TK0[row * 16 + (ij >> 4)] & 0x7Fu);
        const int i1 = 127 - (int)(Cu[2048 + row * 16 + (ij & 15)] & 0x7Fu);
        IDX[ob + q] = i0 * 128 + i1;
        GW[ob + q] = ev[q] * inv;
      }
    }
    __syncthreads();
  }
}

typedef __attribute__((ext_vector_type(2))) float f32x2;
__device__ __forceinline__ void dec16(uint4 u, float* v) {
  f32x2 t;
  t = __builtin_amdgcn_cvt_pk_f32_fp8((int)u.x, false); v[0] = t.x; v[1] = t.y;
  t = __builtin_amdgcn_cvt_pk_f32_fp8((int)u.x, true); v[2] = t.x; v[3] = t.y;
  t = __builtin_amdgcn_cvt_pk_f32_fp8((int)u.y, false); v[4] = t.x; v[5] = t.y;
  t = __builtin_amdgcn_cvt_pk_f32_fp8((int)u.y, true); v[6] = t.x; v[7] = t.y;
  t = __builtin_amdgcn_cvt_pk_f32_fp8((int)u.z, false); v[8] = t.x; v[9] = t.y;
  t = __builtin_amdgcn_cvt_pk_f32_fp8((int)u.z, true); v[10] = t.x; v[11] = t.y;
  t = __builtin_amdgcn_cvt_pk_f32_fp8((int)u.w, false); v[12] = t.x; v[13] = t.y;
  t = __builtin_amdgcn_cvt_pk_f32_fp8((int)u.w, true); v[14] = t.x; v[15] = t.y;
}

__device__ __forceinline__ void phase7(KParams& p) {
  const int tid = opaque_tid(), lane = tid & 63, w = tid >> 6;
  const u16* HG = (const u16*)(p.ws + W_ZB);
  const float* SSQ = (const float*)(p.ws + W_SSQ);
  const int* IDX = (const int*)(p.ws + W_XN);
  const float* GW = (const float*)(p.ws + W_XN + (size_t)NTOK * 128 * 4);
  const unsigned char* EU = (const unsigned char*)(p.ws + W_EU);
  const unsigned char* EV = (const unsigned char*)(p.ws + W_EV);
  const float* ESC = (const float*)(p.ws + W_ESC);
  const int b0 = lane & 1, b1 = (lane >> 1) & 1, b2 = (lane >> 2) & 1;
  for (int tok = blockIdx.x * 4 + w; tok < NTOK; tok += gridDim.x * 4) {
    const float rs = row_rstd(SSQ, tok);
    float xh[16];
    {
      const uint4* hp = (const uint4*)(HG + (size_t)tok * 1024 + lane * 16);
      unpack8(hp[0], xh);
      unpack8(hp[1], xh + 8);
#pragma unroll
      for (int i = 0; i < 16; i++) xh[i] *= rs;
    }
    const int iA = IDX[(size_t)tok * 128 + lane], iB = IDX[(size_t)tok * 128 + 64 + lane];
    const float gA = GW[(size_t)tok * 128 + lane] * ESC[16384 + iA], gB = GW[(size_t)tok * 128 + 64 + lane] * ESC[16384 + iB];
    const float suA = ESC[iA], suB = ESC[iB];
    float dA = 0.f, dB = 0.f;
#pragma unroll 2
    for (int bb = 0; bb < 16; bb++) {
      const int isrc = bb < 8 ? iA : iB;
      float d[8];
      uint4 ur[8];
#pragma unroll
      for (int k = 0; k < 8; k++) {
        const int id = __builtin_amdgcn_readlane(isrc, (bb & 7) * 8 + k);
        ur[k] = *(const uint4*)(EU + (size_t)id * 1024 + lane * 16);
      }
#pragma unroll
      for (int k = 0; k < 8; k++) {
        float uv[16];
        dec16(ur[k], uv);
        float sacc = 0.f;
#pragma unroll
        for (int i = 0; i < 16; i++) sacc += xh[i] * uv[i];
        d[k] = sacc;
      }
      float e4[4], e2[2], e1;
#pragma unroll
      for (int i = 0; i < 4; i++) {
        const float keep = b0 ? d[2 * i + 1] : d[2 * i];
        const float send = b0 ? d[2 * i] : d[2 * i + 1];
        e4[i] = keep + __shfl_xor(send, 1);
      }
#pragma unroll
      for (int i = 0; i < 2; i++) {
        const float keep = b1 ? e4[2 * i + 1] : e4[2 * i];
        const float send = b1 ? e4[2 * i] : e4[2 * i + 1];
        e2[i] = keep + __shfl_xor(send, 2);
      }
      {
        const float keep = b2 ? e2[1] : e2[0];
        const float send = b2 ? e2[0] : e2[1];
        e1 = keep + __shfl_xor(send, 4);
      }
      e1 += __shfl_xor(e1, 8);
      e1 += __shfl_xor(e1, 16);
      e1 += __shfl_xor(e1, 32);
      const bool mine = (lane >> 3) == (bb & 7);
      if (bb < 8) dA = mine ? e1 : dA; else dB = mine ? e1 : dB;
    }
    const float actA = gelu_tanh(dA * suA) * gA, actB = gelu_tanh(dB * suB) * gB;
    float* ACT = (float*)(p.ws + W_ACT);
    ACT[(size_t)tok * 128 + lane] = actA;
    ACT[(size_t)tok * 128 + 64 + lane] = actB;
  }
}

__device__ __forceinline__ void phase7b(KParams& p) {
  const int tid = opaque_tid(), lane = tid & 63;
  const char* IDXb = (const char*)(p.ws + W_XN);
  const char* ACTb = (const char*)(p.ws + W_ACT);
  const char* EVb = (const char*)(p.ws + W_EV);
  char* Yb = (char*)(p.out + O_Y);
  unsigned* Q = (unsigned*)(p.ws + W_Q);
  const int esub = lane >> 3, c = lane & 7;
  const int pref = (int)(hw_xcc_id() & 7u);
  const int b3 = (lane >> 3) & 1, b4 = (lane >> 4) & 1, b5 = (lane >> 5) & 1;
  const uint32_t lane4 = (uint32_t)lane * 4u;
  const uint32_t yl = (uint32_t)(c * 16 + b3 * 8 + b4 * 4 + b5 * 2) * 4u;
  for (int k = 0; k < 8; k++) {
    const int sl = (pref + k) & 7;
    const char* Vs = EVb + (size_t)sl * (16384 * 128);
    const uint32_t vl = (uint32_t)c * 16u;
    for (;;) {
      unsigned it = 0;
      if (lane == 0) it = atomicAdd(Q + sl * 64, 1u);
      it = (unsigned)__builtin_amdgcn_readfirstlane((int)it);
      if (it >= (unsigned)(NTOK / 8)) break;
      const int tok0 = (int)it * 8;
#pragma unroll 2
      for (int t = 0; t < 8; t++) {
        const int tok = tok0 + t;
        const char* ib = IDXb + (size_t)tok * 512;
        const char* ab = ACTb + (size_t)tok * 512;
        char* yb = Yb + (size_t)tok * 4096 + sl * 512;
        const int idA = *(const int*)(ib + lane4), idB = *(const int*)(ib + 256 + lane4);
        const float acA = *(const float*)(ab + lane4), acB = *(const float*)(ab + 256 + lane4);
        const float2 yv = *(const float2*)(yb + yl);
        float o[16];
#pragma unroll
        for (int q = 0; q < 16; q++) o[q] = 0.f;
#pragma unroll
        for (int hf = 0; hf < 2; hf++) {
          uint4 vr[8];
#pragma unroll
          for (int i = 0; i < 8; i++) {
            const uint32_t id = (uint32_t)__shfl(hf ? idB : idA, i * 8 + esub);
            vr[i] = *(const uint4*)(Vs + (id * 128u + vl));
          }
#pragma unroll
          for (int i = 0; i < 8; i++) {
            float vv[16];
            dec16(vr[i], vv);
            const float a = __shfl(hf ? acB : acA, i * 8 + esub);
#pragma unroll
            for (int q = 0; q < 16; q++) o[q] += a * vv[q];
          }
        }
        float r8[8], r4[4], r2[2];
#pragma unroll
        for (int q = 0; q < 8; q++) {
          const float keep = b3 ? o[q + 8] : o[q];
          const float send = b3 ? o[q] : o[q + 8];
          r8[q] = keep + __shfl_xor(send, 8);
        }
#pragma unroll
        for (int q = 0; q < 4; q++) {
          const float keep = b4 ? r8[q + 4] : r8[q];
          const float send = b4 ? r8[q] : r8[q + 4];
          r4[q] = keep + __shfl_xor(send, 16);
        }
#pragma unroll
        for (int q = 0; q < 2; q++) {
          const float keep = b5 ? r4[q + 2] : r4[q];
          const float send = b5 ? r4[q] : r4[q + 2];
          r2[q] = keep + __shfl_xor(send, 32);
        }
        float2 h = yv;
        h.x += r2[0];
        h.y += r2[1];
        *(float2*)(yb + yl) = h;
      }
    }
  }
}

#define XB_TMO      128
#define XB_XCNT(j)  (256  + 64 * (j))
#define XB_XSUB(j)  (1280 + 64 * (j))
#define XB_XGEN(j)  (2304 + 64 * (j))
#define XB_TOP      3328
#define XB_TOPGEN   3392
#define XCD_BAR_WORDS 3456
#define XB_SPIN_CAP (1u << 18)
#define LAS __attribute__((address_space(3)))
__device__ __forceinline__ unsigned xb_ld(unsigned* p) { return __hip_atomic_load(p, __ATOMIC_RELAXED, __HIP_MEMORY_SCOPE_AGENT); }
__device__ __forceinline__ unsigned xb_add(unsigned* p, unsigned v) { return __hip_atomic_fetch_add(p, v, __ATOMIC_RELAXED, __HIP_MEMORY_SCOPE_AGENT); }
__device__ __forceinline__ unsigned xb_xcc_id() { return (unsigned)__builtin_amdgcn_s_getreg((3 << 11) | 20) & 0xFu; }
#define XB_SPIN(cond, bar) do { unsigned _sp = 0; while (cond) { __builtin_amdgcn_s_sleep(1); \
    if ((++_sp & 255u) == 0u) { if (xb_ld(&(bar)[XB_TMO])) break; if (_sp > XB_SPIN_CAP) { atomicAdd(&(bar)[XB_TMO], 1u); break; } } } } while (0)
struct XcdBarrier { unsigned* bar; unsigned x; volatile LAS unsigned* st; };
__device__ __forceinline__ XcdBarrier xcd_barrier_post(unsigned* bar, volatile LAS unsigned* st) {
  XcdBarrier b; b.bar = bar; b.x = xb_xcc_id(); b.st = st;
  if (threadIdx.x == 0) st[2] = xb_add(&bar[XB_XCNT(b.x)], 1u);
  return b;
}
__device__ __forceinline__ void xcd_barrier_complete(unsigned* bar, unsigned x, unsigned& nloc, unsigned& nx) {
  const unsigned G = gridDim.x * gridDim.y * gridDim.z;
  unsigned sum, cnt, mine, sp = 0u;
  for (;;) {
    sum = 0u; cnt = 0u; mine = 0u;
#pragma unroll
    for (unsigned j = 0; j < 16; ++j) { const unsigned c = xb_ld(&bar[XB_XCNT(j)]); sum += c; cnt += (c > 0u) ? 1u : 0u; mine = (j == x) ? c : mine; }
    if (sum == G) break;
    __builtin_amdgcn_s_sleep(1);
    if ((++sp & 255u) == 0u) { if (xb_ld(&bar[XB_TMO])) break; if (sp > XB_SPIN_CAP) { atomicAdd(&bar[XB_TMO], 1u); break; } }
  }
  nloc = mine > 0u ? mine : 1u; nx = cnt > 0u ? cnt : 1u;
}
__device__ __forceinline__ void xcd_barrier(const XcdBarrier& b) {
  asm volatile("s_waitcnt vmcnt(0)" ::: "memory");
  __syncthreads();
  if (threadIdx.x == 0) {
    unsigned* bar = b.bar;
    __builtin_amdgcn_s_waitcnt(0);
    unsigned nloc = b.st[0], nx = b.st[1];
    if (nloc == 0u) { xcd_barrier_complete(bar, b.x, nloc, nx); b.st[0] = nloc; b.st[1] = nx; }
    const unsigned old = xb_add(&bar[XB_XSUB(b.x)], 1u);
    const unsigned gen = old / nloc;
    if (old + 1u == (gen + 1u) * nloc) {
      __builtin_amdgcn_fence(__ATOMIC_RELEASE, "agent");
      asm volatile("s_waitcnt vmcnt(0)" ::: "memory");
      const unsigned og = xb_add(&bar[XB_TOP], 1u);
      const unsigned tg = og / nx;
      if (og + 1u == (tg + 1u) * nx) xb_add(&bar[XB_TOPGEN], 1u);
      else XB_SPIN(xb_ld(&bar[XB_TOPGEN]) == tg, bar);
      __builtin_amdgcn_fence(__ATOMIC_ACQUIRE, "agent");
      xb_add(&bar[XB_XGEN(b.x)], 1u);
      asm volatile("s_waitcnt vmcnt(0)" ::: "memory");
    } else {
      XB_SPIN(xb_ld(&bar[XB_XGEN(b.x)]) == gen, bar);
      __builtin_amdgcn_fence(__ATOMIC_ACQUIRE, "agent");
      asm volatile("s_waitcnt vmcnt(0)" ::: "memory");
    }
  }
  __syncthreads();
}

#ifndef REP_MASK
#define REP_MASK 0
#endif
#define REPS(k) for (int _rep = 0; _rep < (((REP_MASK) >> (k)) & 1) + 1; _rep++)
__global__ void __launch_bounds__(256, 2) fwd_megakernel(Params p_) {
  extern __shared__ __attribute__((aligned(16))) char smem[];
  cg::grid_group grid = cg::this_grid();
  if (p_.ws == nullptr) grid.sync();
  volatile LAS unsigned* xst = (volatile LAS unsigned*)(smem + SMEM_BYTES - 16);
  if (threadIdx.x == 0) { xst[0] = 0u; xst[1] = 0u; xst[2] = 0u; xst[3] = 0u; }
  __syncthreads();
  const XcdBarrier xb = xcd_barrier_post((unsigned*)(p_.ws + W_BAR), xst);
  REPS(0) { phase0(*fresh_params(), smem); xcd_barrier(xb); }
  if (threadIdx.x == 0) {
    unsigned* bar = (unsigned*)(p_.ws + W_BAR);
    const unsigned per = gridDim.x >> 3;
    bool uni = (gridDim.x & 7u) == 0u;
    for (unsigned j = 0; j < 16; ++j) { const unsigned cnt = xb_ld(&bar[XB_XCNT(j)]); if (cnt != (j < 8 ? per : 0u)) uni = false; }
    xst[3] = uni ? (xb.x * per + xst[2]) : blockIdx.x;
  }
  __syncthreads();
  const int vb = (int)xst[3];
  REPS(1) { phase_g1(*fresh_params(), smem, vb); xcd_barrier(xb); }
  REPS(2) {
    for (int it = blockIdx.x; it < 1536 + 2048; it += gridDim.x) {
      if (it < 1536) attn_item(*fresh_params(), smem, it);
      else { const int q = it - 1536; lru_tile(*fresh_params(), smem, q >> 4, q & 15, 0); }
    }
    xcd_barrier(xb);
  }
  REPS(3) {
    for (int it = blockIdx.x; it < MT * 16; it += gridDim.x) lru_tile(*fresh_params(), smem, it >> 4, it & 15, 1);
    xcd_barrier(xb);
  }
  REPS(4) { phase_g3(*fresh_params(), smem, vb); xcd_barrier(xb); }
  REPS(5) { phase_g4(*fresh_params(), smem, vb); xcd_barrier(xb); }
  REPS(6) { phase_g5(*fresh_params(), smem, vb); xcd_barrier(xb); }
  REPS(7) { phase_g6(*fresh_params(), smem, vb); xcd_barrier(xb); }
  phase7(*fresh_params());
  xcd_barrier(xb);
  phase7b(*fresh_params());
}

extern "C" void kernel_launch(void* const* d_in, const int* in_sizes, int n_in, void* d_out, int out_size, void* d_ws,
                              size_t ws_size, hipStream_t stream) {
  static int grid_blocks = 0;
  if (!grid_blocks) {
    int dev = 0, cus = 0, per_cu = 0;
    hipGetDevice(&dev);
    hipDeviceGetAttribute(&cus, hipDeviceAttributeMultiprocessorCount, dev);
    hipFuncSetAttribute((const void*)fwd_megakernel, hipFuncAttributeMaxDynamicSharedMemorySize, SMEM_BYTES);
    hipOccupancyMaxActiveBlocksPerMultiprocessor(&per_cu, fwd_megakernel, 256, SMEM_BYTES);
    if (per_cu < 1) per_cu = 1;
    grid_blocks = cus * per_cu;
  }
  Params p{};
  const float** pp = (const float**)&p;
  for (int i = 0; i < 26; i++) pp[i] = (const float*)d_in[i];
  p.out = (float*)d_out;
  p.ws = (char*)d_ws;
  (void)hipMemsetAsync((char*)d_ws + W_BAR, 0, (size_t)3456 * 4 + 8 * 256, stream);
  void* args[] = {&p};
  hipError_t e = hipLaunchCooperativeKernel((void*)fwd_megakernel, dim3(grid_blocks), dim3(256), args, SMEM_BYTES, stream);
  if (e != hipSuccess) fprintf(stderr, "cooperative launch failed: %s (grid %d)\n", hipGetErrorString(e), grid_blocks);
}
```

```cpp
#include <hip/hip_runtime.h>
#include <hip/hip_cooperative_groups.h>
#include <stdint.h>
#include <cstdio>
namespace cg = cooperative_groups;

typedef unsigned short u16;
typedef __attribute__((ext_vector_type(8))) short bf16x8;
typedef __attribute__((ext_vector_type(4))) float f32x4;

constexpr int D = 1024;
constexpr int NP = 16384;
constexpr int NTOK = 17408;
constexpr int SEQ = 4096;
constexpr int MT = 136;
constexpr float EPS = 1e-6f;

constexpr size_t O_Y = 0;
constexpr size_t O_CONVP = 17825792;
constexpr size_t O_LRUP = O_CONVP + 12288;
constexpr size_t O_KP = O_LRUP + 4096;
constexpr size_t O_VP = O_KP + 131072;
constexpr size_t O_CONVS = O_VP + 131072;
constexpr size_t O_LRUS = O_CONVS + 393216;
constexpr size_t O_KS = O_LRUS + 131072;
constexpr size_t O_VS = O_KS + 4194304;

constexpr size_t W_WTIN = 0;
constexpr size_t W_WTLRU = W_WTIN + (size_t)5632 * 1024 * 2;
constexpr size_t W_WTATTN = W_WTLRU + (size_t)1024 * 1024 * 2;
constexpr size_t W_WTOUT = W_WTATTN + (size_t)1024 * 1024 * 2;
constexpr size_t W_WTQ = W_WTOUT + (size_t)1024 * 1024 * 2;
constexpr size_t W_SK = W_WTQ + (size_t)2048 * 1024 * 2;
constexpr size_t W_RGA = W_SK + (size_t)16 * 128 * 128 * 2;
constexpr size_t W_RGX = W_RGA + (size_t)65536 * 2;
constexpr size_t W_EU = W_RGX + (size_t)65536 * 2;
constexpr size_t W_EV = W_EU + (size_t)16384 * 1024;
constexpr size_t W_ESC = W_EV + (size_t)16384 * 1024;
constexpr size_t W_XN = W_ESC + (size_t)32768 * 4;
constexpr size_t W_ZA = W_XN + (size_t)NTOK * 1024 * 2;
constexpr size_t W_ZB = W_ZA + (size_t)NTOK * 2048 * 2;
constexpr size_t W_AGG = W_ZB + (size_t)NTOK * 1536 * 2;
constexpr size_t W_SSQ = W_AGG + (size_t)128 * 1024 * 2 * 4;
constexpr size_t W_BAR = W_SSQ + (size_t)NTOK * 8 * 4;
constexpr size_t W_Q = W_BAR + (size_t)3456 * 4;
constexpr size_t W_ACT = W_Q + (size_t)8 * 256;
constexpr size_t W_END = W_ACT + (size_t)NTOK * 128 * 4;

constexpr int SMEM_BYTES = 81920;

struct Params {
  const float *x_prompt, *x_sample, *cache_conv, *state_lru, *cache_k, *cache_v, *norm1_g, *w_in, *conv_w,
      *conv_b, *rg_w_a, *rg_b_a, *rg_w_x, *rg_b_x, *rg_lambda, *q_norm_g, *k_norm_g, *attn_sinks,
      *w_branch_lru, *w_branch_attn, *w_out, *norm2_g, *peer_w_query, *peer_sub_keys, *expert_u, *expert_v;
  float* out;
  char* ws;
};

typedef const __attribute__((address_space(4))) Params KParams;
__device__ __forceinline__ KParams* fresh_params() {
  unsigned long long k = (unsigned long long)__builtin_amdgcn_kernarg_segment_ptr();
  asm volatile("" : "+s"(k));
  return (KParams*)k;
}
__device__ __forceinline__ u16 f2bf(float f) {
  uint32_t u = __float_as_uint(f);
  u += 0x7FFFu + ((u >> 16) & 1u);
  return (u16)(u >> 16);
}
__device__ __forceinline__ float bf2f(u16 h) { return __uint_as_float(((uint32_t)h) << 16); }
__device__ __forceinline__ uint32_t pack2(float a, float b) {
  uint32_t r;
  asm("v_cvt_pk_bf16_f32 %0, %1, %2" : "=v"(r) : "v"(a), "v"(b));
  return r;
}
__device__ __forceinline__ uint4 pack8(const float* v) {
  uint4 o;
  o.x = pack2(v[0], v[1]); o.y = pack2(v[2], v[3]); o.z = pack2(v[4], v[5]); o.w = pack2(v[6], v[7]);
  return o;
}
__device__ __forceinline__ void unpack8(uint4 u, float* v) {
  v[0] = __uint_as_float(u.x << 16); v[1] = __uint_as_float(u.x & 0xFFFF0000u);
  v[2] = __uint_as_float(u.y << 16); v[3] = __uint_as_float(u.y & 0xFFFF0000u);
  v[4] = __uint_as_float(u.z << 16); v[5] = __uint_as_float(u.z & 0xFFFF0000u);
  v[6] = __uint_as_float(u.w << 16); v[7] = __uint_as_float(u.w & 0xFFFF0000u);
}
__device__ __forceinline__ float sigmoidf_(float x) { return __builtin_amdgcn_rcpf(1.f + __expf(-x)); }
__device__ __forceinline__ float gelu_tanh(float x) {
  float y = 0.7978845608028654f * (x + 0.044715f * x * x * x);
  float t = 1.f - 2.f * __builtin_amdgcn_rcpf(__expf(2.f * y) + 1.f);
  return 0.5f * x * (1.f + t);
}
__device__ __forceinline__ uint32_t ordf(float f) {
  uint32_t u = __float_as_uint(f);
  return (u & 0x80000000u) ? ~u : (u | 0x80000000u);
}
__device__ __forceinline__ float unordf(uint32_t o) {
  uint32_t u = (o & 0x80000000u) ? (o ^ 0x80000000u) : ~o;
  return __uint_as_float(u);
}
__device__ __forceinline__ unsigned hw_xcc_id() { return (unsigned)__builtin_amdgcn_s_getreg((3 << 11) | 20) & 0xFu; }
__device__ __forceinline__ int opaque_tid() {
  int t = threadIdx.x;
  asm volatile("" : "+v"(t));
  return t;
}
__device__ __forceinline__ const float* xrow(KParams& p, int row) {
  return row < NP ? p.x_prompt + (size_t)row * D : p.x_sample + (size_t)(row - NP) * D;
}

#define INS16(T, V)                                  \
  {                                                  \
    uint32_t _v = (V);                               \
    _Pragma("unroll") for (int _q = 0; _q < 16; _q++) { \
      uint32_t _hi = max(T[_q], _v);                 \
      _v = min(T[_q], _v);                           \
      T[_q] = _hi;                                   \
    }                                                \
  }

#define CE_DESC(A_, B_) { const uint32_t _h = max(A_, B_), _l = min(A_, B_); A_ = _h; B_ = _l; }
__device__ __forceinline__ void sort16_desc(uint32_t (&t)[16]) {
#pragma unroll
  for (int k = 2; k <= 16; k <<= 1) {
#pragma unroll
    for (int j = k >> 1; j > 0; j >>= 1) {
#pragma unroll
      for (int i = 0; i < 16; i++) {
        const int l = i ^ j;
        if (l > i) {
          if ((i & k) == 0) { CE_DESC(t[i], t[l]); } else { CE_DESC(t[l], t[i]); }
        }
      }
    }
  }
}
__device__ __forceinline__ void merge16_desc(uint32_t (&T)[16], const uint32_t (&S)[16]) {
#pragma unroll
  for (int i = 0; i < 16; i++) T[i] = max(T[i], S[15 - i]);
#pragma unroll
  for (int j = 8; j > 0; j >>= 1) {
#pragma unroll
    for (int i = 0; i < 16; i++) {
      const int l = i ^ j;
      if (l > i) { CE_DESC(T[i], T[l]); }
    }
  }
}

__device__ __forceinline__ void transpose_cvt(const float* __restrict__ W, u16* __restrict__ Wt, int K, int N,
                                              size_t gtid, size_t gsz) {
  size_t total = (size_t)N * (K / 8);
  for (size_t c = gtid; c < total; c += gsz) {
    int n = (int)(c % N);
    int kg = (int)(c / N);
    float v[8];
#pragma unroll
    for (int i = 0; i < 8; i++) v[i] = W[(size_t)(kg * 8 + i) * N + n];
    *(uint4*)(Wt + (size_t)n * K + kg * 8) = pack8(v);
  }
}
__device__ __forceinline__ void plain_cvt(const float* __restrict__ S, u16* __restrict__ Dst, size_t n, size_t gtid,
                                          size_t gsz) {
  size_t total = n / 8;
  const float4* s4 = (const float4*)S;
  for (size_t c = gtid; c < total; c += gsz) {
    float4 a = s4[2 * c], b = s4[2 * c + 1];
    float v[8] = {a.x, a.y, a.z, a.w, b.x, b.y, b.z, b.w};
    *(uint4*)(Dst + c * 8) = pack8(v);
  }
}

__device__ __forceinline__ void phase0(KParams& p, char* smem) {
  const int tid = opaque_tid();
  const size_t gtid = (size_t)blockIdx.x * 256 + tid, gsz = (size_t)gridDim.x * 256;
  char* ws = p.ws;
  {
    const int lane = tid & 63;
    const int gw = (int)(gtid >> 6), nw = (int)(gsz >> 6);
    u16* XN = (u16*)(ws + W_XN);
    for (int row = gw; row < NTOK; row += nw) {
      const float4* xr = (const float4*)xrow(p, row);
      float4 v[4];
      float ss = 0.f;
#pragma unroll
      for (int i = 0; i < 4; i++) {
        v[i] = xr[lane + i * 64];
        ss += v[i].x * v[i].x + v[i].y * v[i].y + v[i].z * v[i].z + v[i].w * v[i].w;
      }
#pragma unroll
      for (int o = 32; o > 0; o >>= 1) ss += __shfl_xor(ss, o);
      float rstd = rsqrtf(ss * (1.f / 1024.f) + EPS);
      const float4* g4 = (const float4*)p.norm1_g;
#pragma unroll
      for (int i = 0; i < 4; i++) {
        float4 g = g4[lane + i * 64];
        uint2 o;
        o.x = pack2(v[i].x * rstd * g.x, v[i].y * rstd * g.y);
        o.y = pack2(v[i].z * rstd * g.z, v[i].w * rstd * g.w);
        *(uint2*)(XN + (size_t)row * D + (lane + i * 64) * 4) = o;
      }
    }
  }
  {
    float* T = (float*)smem;
    for (int tile = blockIdx.x; tile < 2688; tile += gridDim.x) {
      const float* W;
      u16* Wt;
      int N, tl;
      if (tile < 1408) { W = p.w_in; Wt = (u16*)(ws + W_WTIN); N = 5632; tl = tile; }
      else if (tile < 1664) { W = p.w_branch_lru; Wt = (u16*)(ws + W_WTLRU); N = 1024; tl = tile - 1408; }
      else if (tile < 1920) { W = p.w_branch_attn; Wt = (u16*)(ws + W_WTATTN); N = 1024; tl = tile - 1664; }
      else if (tile < 2176) { W = p.w_out; Wt = (u16*)(ws + W_WTOUT); N = 1024; tl = tile - 1920; }
      else { W = p.peer_w_query; Wt = (u16*)(ws + W_WTQ); N = 2048; tl = tile - 2176; }
      const int ntn = N >> 6;
      const int kt = tl / ntn, nt = tl - kt * ntn;
      __syncthreads();
      {
        const float* src = W + (size_t)(kt * 64 + (tid >> 2)) * N + nt * 64 + (tid & 3) * 16;
        const float4 a0 = *(const float4*)src, a1 = *(const float4*)(src + 4), a2 = *(const float4*)(src + 8),
                     a3 = *(const float4*)(src + 12);
        float* d = T + (tid >> 2) * 65 + (tid & 3) * 16;
        d[0] = a0.x; d[1] = a0.y; d[2] = a0.z; d[3] = a0.w; d[4] = a1.x; d[5] = a1.y; d[6] = a1.z; d[7] = a1.w;
        d[8] = a2.x; d[9] = a2.y; d[10] = a2.z; d[11] = a2.w; d[12] = a3.x; d[13] = a3.y; d[14] = a3.z; d[15] = a3.w;
      }
      __syncthreads();
      {
        const int n = tid >> 2, kc = (tid & 3) * 16;
        float v[16];
#pragma unroll
        for (int i = 0; i < 16; i++) v[i] = T[(kc + i) * 65 + n];
        u16* dst = Wt + (size_t)(nt * 64 + n) * 1024 + kt * 64 + kc;
        *(uint4*)dst = pack8(v);
        *(uint4*)(dst + 8) = pack8(v + 8);
      }
    }
  }
  {
    u16* RA = (u16*)(ws + W_RGA);
    u16* RX = (u16*)(ws + W_RGX);
    for (size_t e = gtid; e < 65536; e += gsz) {
      int n = (int)(e >> 12), k = (int)((e >> 6) & 63), j = (int)(e & 63);
      RA[e] = f2bf(p.rg_w_a[n * 4096 + j * 64 + k]);
      RX[e] = f2bf(p.rg_w_x[n * 4096 + j * 64 + k]);
    }
  }
  plain_cvt(p.peer_sub_keys, (u16*)(ws + W_SK), (size_t)16 * 128 * 128, gtid, gsz);
  {
    const int lane = tid & 63;
    const int gw = (int)(gtid >> 6), nw = (int)(gsz >> 6);
    unsigned char* E8 = (unsigned char*)(ws + W_EU);
    float* ESC = (float*)(ws + W_ESC);
    for (int r = gw; r < 32768; r += nw) {
      const float* src = (r < 16384 ? p.expert_u : p.expert_v) + (size_t)(r & 16383) * 1024 + lane * 16;
      const float4 a0 = *(const float4*)src, a1 = *(const float4*)(src + 4), a2 = *(const float4*)(src + 8),
                   a3 = *(const float4*)(src + 12);
      float am = fmaxf(fmaxf(fmaxf(fabsf(a0.x), fabsf(a0.y)), fmaxf(fabsf(a0.z), fabsf(a0.w))),
                       fmaxf(fmaxf(fabsf(a1.x), fabsf(a1.y)), fmaxf(fabsf(a1.z), fabsf(a1.w))));
      am = fmaxf(am, fmaxf(fmaxf(fmaxf(fabsf(a2.x), fabsf(a2.y)), fmaxf(fabsf(a2.z), fabsf(a2.w))),
                           fmaxf(fmaxf(fabsf(a3.x), fabsf(a3.y)), fmaxf(fabsf(a3.z), fabsf(a3.w)))));
#pragma unroll
      for (int o = 32; o > 0; o >>= 1) am = fmaxf(am, __shfl_xor(am, o));
      const float sc = am > 0.f ? 224.f / am : 1.f;
      uint4 o4;
      int wv;
      wv = __builtin_amdgcn_cvt_pk_fp8_f32(a0.x * sc, a0.y * sc, 0, false);
      wv = __builtin_amdgcn_cvt_pk_fp8_f32(a0.z * sc, a0.w * sc, wv, true);
      o4.x = (uint32_t)wv;
      wv = __builtin_amdgcn_cvt_pk_fp8_f32(a1.x * sc, a1.y * sc, 0, false);
      wv = __builtin_amdgcn_cvt_pk_fp8_f32(a1.z * sc, a1.w * sc, wv, true);
      o4.y = (uint32_t)wv;
      wv = __builtin_amdgcn_cvt_pk_fp8_f32(a2.x * sc, a2.y * sc, 0, false);
      wv = __builtin_amdgcn_cvt_pk_fp8_f32(a2.z * sc, a2.w * sc, wv, true);
      o4.z = (uint32_t)wv;
      wv = __builtin_amdgcn_cvt_pk_fp8_f32(a3.x * sc, a3.y * sc, 0, false);
      wv = __builtin_amdgcn_cvt_pk_fp8_f32(a3.z * sc, a3.w * sc, wv, true);
      o4.w = (uint32_t)wv;
      if (r < 16384) *(uint4*)(E8 + (size_t)r * 1024 + lane * 16) = o4;
      else *(uint4*)(E8 + (size_t)16384 * 1024 + (size_t)(lane >> 3) * (16384 * 128) + (size_t)(r - 16384) * 128 + (lane & 7) * 16) = o4;
      if (lane == 0) ESC[r] = am > 0.f ? am * (1.f / 224.f) : 1.f;
    }
  }
}

constexpr int LDT = 72;
constexpr int CS_LD = 132;

__device__ __forceinline__ void gemm_tile(const u16* __restrict__ A, int lda, const u16* __restrict__ Bt, int ldb,
                                          int K, f32x4 (&acc)[4][4], char* smem, int tid) {
  const int lane = tid & 63, w = tid >> 6;
  const int wm = w >> 1, wn = w & 1;
  const int l15 = lane & 15, quad = lane >> 4;
  const int lr = w * 8 + (lane >> 3);
  const int lc = ((lane & 7) ^ ((lane >> 3) & 7)) * 8;
  const char* Ab = (const char*)A;
  const char* Bb = (const char*)Bt;
  const uint32_t ao = (uint32_t)(lr * lda + lc) * 2u, bo = (uint32_t)(lr * ldb + lc) * 2u;
  const uint32_t sa2 = 64u * (uint32_t)lda, sb2 = 64u * (uint32_t)ldb;
  const uint32_t kmask = (uint32_t)K - 1u, kst = (((uint32_t)blockIdx.x >> 3) * 64u) & kmask;
  char* lw = smem + w * 1024 + lane * 16;
  const int swz = l15 & 7;
  const char* Ar = smem + (wm * 64 + l15) * 128 + ((quad ^ swz) * 16);
  const char* Br = smem + 16384 + (wn * 64 + l15) * 128 + ((quad ^ swz) * 16);
  const char* Ar1 = smem + (wm * 64 + l15) * 128 + (((4 + quad) ^ swz) * 16);
  const char* Br1 = smem + 16384 + (wn * 64 + l15) * 128 + (((4 + quad) ^ swz) * 16);
#define GT_ISSUE(st, off)                                                                                   \
  {                                                                                                         \
    const uint32_t _o = (((uint32_t)(off) + kst) & kmask) * 2u;                                             \
    char* _l = lw + (st) * 32768;                                                                           \
    _Pragma("unroll") for (int j = 0; j < 4; j++) {                                                         \
      __builtin_amdgcn_global_load_lds((const unsigned*)(Ab + (size_t)(ao + j * sa2 + _o)), (unsigned*)(_l + j * 4096), 16, 0, 0);          \
      __builtin_amdgcn_global_load_lds((const unsigned*)(Bb + (size_t)(bo + j * sb2 + _o)), (unsigned*)(_l + 16384 + j * 4096), 16, 0, 0);  \
    }                                                                                                       \
  }
#define GT_MMA(st)                                                                                          \
  {                                                                                                         \
    const char* _ar = Ar + (st) * 32768; const char* _br = Br + (st) * 32768;                               \
    const char* _ar1 = Ar1 + (st) * 32768; const char* _br1 = Br1 + (st) * 32768;                           \
    bf16x8 a0[4], b0[4], a1[4], b1[4];                                                                      \
    _Pragma("unroll") for (int i = 0; i < 4; i++) {                                                         \
      a0[i] = *(const bf16x8*)(_ar + i * 2048);                                                             \
      b0[i] = *(const bf16x8*)(_br + i * 2048);                                                             \
    }                                                                                                       \
    _Pragma("unroll") for (int i = 0; i < 4; i++) {                                                         \
      a1[i] = *(const bf16x8*)(_ar1 + i * 2048);                                                            \
      b1[i] = *(const bf16x8*)(_br1 + i * 2048);                                                            \
    }                                                                                                       \
    __builtin_amdgcn_s_setprio(1);                                                                          \
    _Pragma("unroll") for (int i = 0; i < 4; i++)                                                           \
      _Pragma("unroll") for (int j = 0; j < 4; j++)                                                         \
        acc[i][j] = __builtin_amdgcn_mfma_f32_16x16x32_bf16(a0[i], b0[j], acc[i][j], 0, 0, 0);              \
    _Pragma("unroll") for (int i = 0; i < 4; i++)                                                           \
      _Pragma("unroll") for (int j = 0; j < 4; j++)                                                         \
        acc[i][j] = __builtin_amdgcn_mfma_f32_16x16x32_bf16(a1[i], b1[j], acc[i][j], 0, 0, 0);              \
    __builtin_amdgcn_s_setprio(0);                                                                          \
  }
  __syncthreads();
  GT_ISSUE(0, 0);
  for (int k0 = 0; k0 < K; k0 += 128) {
    asm volatile("s_waitcnt vmcnt(0) lgkmcnt(0)" ::: "memory");
    __builtin_amdgcn_s_barrier();
    asm volatile("" ::: "memory");
    GT_ISSUE(1, k0 + 64);
    GT_MMA(0);
    asm volatile("s_waitcnt vmcnt(0) lgkmcnt(0)" ::: "memory");
    __builtin_amdgcn_s_barrier();
    asm volatile("" ::: "memory");
    if (k0 + 128 < K) GT_ISSUE(0, k0 + 128);
    GT_MMA(1);
  }
#undef GT_ISSUE
#undef GT_MMA
}

__device__ __forceinline__ void tile_map(int it, int total, int NT, int& mt, int& nt, int vb) {
  const int G = gridDim.x;
  int T = it;
  {
    const int round = it / G;
    if (round * G + G <= total) T = round * G + vb;
  }
  const int g = T / (8 * NT), r = T - g * (8 * NT);
  nt = r >> 3;
  mt = g * 8 + (r & 7);
}

__device__ __forceinline__ void zero_acc(f32x4 (&acc)[4][4]) {
#pragma unroll
  for (int i = 0; i < 4; i++)
#pragma unroll
    for (int j = 0; j < 4; j++) acc[i][j] = (f32x4){0.f, 0.f, 0.f, 0.f};
}

__device__ __forceinline__ void acc_to_cs(const f32x4 (&acc)[4][4], float* Cs, int tid) {
  const int lane = tid & 63, w = tid >> 6;
  const int wm = w >> 1, wn = w & 1;
  const int l15 = lane & 15, quad = lane >> 4;
#pragma unroll
  for (int i = 0; i < 4; i++)
#pragma unroll
    for (int j = 0; j < 4; j++)
#pragma unroll
      for (int e = 0; e < 4; e++)
        Cs[(wm * 64 + i * 16 + quad * 4 + e) * CS_LD + wn * 64 + j * 16 + l15] = acc[i][j][e];
}

__device__ __forceinline__ void phase_g1(KParams& p, char* smem, int vb) {
  const int tid = opaque_tid();
  u16* As = (u16*)smem;
  u16* Bs = As + 2 * 128 * LDT;
  float* Cs = (float*)smem;
  const u16* XN = (const u16*)(p.ws + W_XN);
  const u16* WT = (const u16*)(p.ws + W_WTIN);
  for (int t = blockIdx.x; t < MT * 44; t += gridDim.x) {
    int mt, nt;
    tile_map(t, MT * 44, 44, mt, nt, vb);
    f32x4 acc[4][4];
    zero_acc(acc);
    gemm_tile(XN + (size_t)mt * 128 * 1024, 1024, WT + (size_t)nt * 128 * 1024, 1024, 1024, acc, smem, tid);
    __syncthreads();
    acc_to_cs(acc, Cs, tid);
    __syncthreads();
    const int n0 = nt * 128;
    u16* dst;
    int ldd, col;
    if (n0 < 2048) { dst = (u16*)(p.ws + W_ZA); ldd = 2048; col = n0; }
    else if (n0 < 3584) { dst = (u16*)(p.ws + W_ZB); ldd = 1536; col = n0 - 2048; }
    else { dst = (u16*)p.out; ldd = 2048; col = n0 - 3584; }
    const int cc = (tid & 15) * 8;
#pragma unroll
    for (int i = 0; i < 8; i++) {
      const int r = (tid >> 4) + 16 * i;
      float4 a = *(const float4*)(Cs + r * CS_LD + cc), b = *(const float4*)(Cs + r * CS_LD + cc + 4);
      float v[8] = {a.x, a.y, a.z, a.w, b.x, b.y, b.z, b.w};
      *(uint4*)(dst + (size_t)(mt * 128 + r) * ldd + col + cc) = pack8(v);
    }
    __syncthreads();
  }
}

constexpr int KS_LD = 72, VT_LD = 200, PS_LD = 168;
__device__ __forceinline__ void attn_item(KParams& p, char* smem, int item) {
  const int tid = opaque_tid(), lane = tid & 63, w = tid >> 6, l15 = lane & 15, quad = lane >> 4;
  u16* Ks = (u16*)smem;
  u16* Vt = Ks + 192 * KS_LD;
  u16* Ps = Vt + 64 * VT_LD + w * 16 * PS_LD;
  const u16* ZB = (const u16*)(p.ws + W_ZB);
  u16* ATT = (u16*)(p.ws + W_XN);
  const bool sample = item >= 1024;
  int b, qb = 0, kv, rowbase, p0 = 0;
  if (!sample) {
    kv = item & 3; qb = (item >> 2) & 63; b = item >> 8;
    p0 = qb * 64;
    rowbase = b * SEQ + p0;
  } else {
    int it = item - 1024;
    kv = it & 3; b = it >> 2;
    rowbase = NP + b * 8;
  }
  __syncthreads();
  {
    const int ch = tid & 7;
    float kg[8];
#pragma unroll
    for (int i = 0; i < 8; i++) kg[i] = p.k_norm_g[ch * 8 + i];
    const int nrows = sample ? 160 : 192;
    for (int c = tid; c < nrows * 8; c += 256) {
      const int row = c >> 3;
      float kf[8], vf[8];
      bool valid, donorm;
      if (!sample) {
        const int pos = p0 - 128 + row;
        valid = pos >= 0;
        donorm = true;
        if (valid) {
          const u16* src = ZB + (size_t)(b * SEQ + pos) * 1536 + 1024 + kv * 64 + ch * 8;
          unpack8(*(const uint4*)src, kf);
          unpack8(*(const uint4*)(src + 256), vf);
        }
      } else {
        valid = row < 136;
        donorm = row >= 128;
        if (row < 128) {
          const float* sk = p.cache_k + ((size_t)(b * 128 + row) * 4 + kv) * 64 + ch * 8;
          const float* sv = p.cache_v + ((size_t)(b * 128 + row) * 4 + kv) * 64 + ch * 8;
          float4 a0 = *(const float4*)sk, a1 = *(const float4*)(sk + 4);
          float4 b0 = *(const float4*)sv, b1 = *(const float4*)(sv + 4);
          kf[0] = a0.x; kf[1] = a0.y; kf[2] = a0.z; kf[3] = a0.w; kf[4] = a1.x; kf[5] = a1.y; kf[6] = a1.z; kf[7] = a1.w;
          vf[0] = b0.x; vf[1] = b0.y; vf[2] = b0.z; vf[3] = b0.w; vf[4] = b1.x; vf[5] = b1.y; vf[6] = b1.z; vf[7] = b1.w;
        } else if (valid) {
          const u16* src = ZB + (size_t)(NP + b * 8 + (row - 128)) * 1536 + 1024 + kv * 64 + ch * 8;
          unpack8(*(const uint4*)src, kf);
          unpack8(*(const uint4*)(src + 256), vf);
        }
      }
      if (!valid) {
#pragma unroll
        for (int i = 0; i < 8; i++) { kf[i] = 0.f; vf[i] = 0.f; }
      }
      float ss = 0.f;
#pragma unroll
      for (int i = 0; i < 8; i++) ss += kf[i] * kf[i];
      ss += __shfl_xor(ss, 1);
      ss += __shfl_xor(ss, 2);
      ss += __shfl_xor(ss, 4);
      if (donorm) {
        const float rstd = rsqrtf(ss * (1.f / 64.f) + EPS);
#pragma unroll
        for (int i = 0; i < 8; i++) kf[i] = kf[i] * rstd * kg[i];
      }
      *(uint4*)(Ks + row * KS_LD + ch * 8) = pack8(kf);
#pragma unroll
      for (int i = 0; i < 8; i++) Vt[(ch * 8 + i) * VT_LD + row] = f2bf(vf[i]);
      if (!sample) {
        if (qb >= 62 && row >= 128) {
          const int wpos = p0 + (row - 128) - (SEQ - 128);
          float* ko = p.out + O_KP + ((size_t)(b * 128 + wpos) * 4 + kv) * 64 + ch * 8;
          float* vo = p.out + O_VP + ((size_t)(b * 128 + wpos) * 4 + kv) * 64 + ch * 8;
          *(float4*)ko = make_float4(kf[0], kf[1], kf[2], kf[3]);
          *(float4*)(ko + 4) = make_float4(kf[4], kf[5], kf[6], kf[7]);
          *(float4*)vo = make_float4(vf[0], vf[1], vf[2], vf[3]);
          *(float4*)(vo + 4) = make_float4(vf[4], vf[5], vf[6], vf[7]);
        }
      } else {
        if (row >= 8 && row < 136) {
          float* ko = p.out + O_KS + ((size_t)(b * 128 + (row - 8)) * 4 + kv) * 64 + ch * 8;
          float* vo = p.out + O_VS + ((size_t)(b * 128 + (row - 8)) * 4 + kv) * 64 + ch * 8;
          *(float4*)ko = make_float4(kf[0], kf[1], kf[2], kf[3]);
          *(float4*)(ko + 4) = make_float4(kf[4], kf[5], kf[6], kf[7]);
          *(float4*)vo = make_float4(vf[0], vf[1], vf[2], vf[3]);
          *(float4*)(vo + 4) = make_float4(vf[4], vf[5], vf[6], vf[7]);
        }
      }
    }
  }
  __syncthreads();
  const int hq = kv * 4 + w;
  const float slope = exp2f(-0.5f * (float)(hq + 1));
  const float sink = p.attn_sinks[hq];
  float qg[2][8];
#pragma unroll
  for (int ks = 0; ks < 2; ks++)
#pragma unroll
    for (int i = 0; i < 8; i++) qg[ks][i] = p.q_norm_g[ks * 32 + quad * 8 + i] * 0.125f;
  const int nsub = sample ? 1 : 4;
  for (int sb = 0; sb < nsub; sb++) {
    const int r0 = sb * 16;
    const int ws0 = r0 < 32 ? r0 : 32;
    bf16x8 qa[2];
    {
      const int qr = sample ? (l15 & 7) : (r0 + l15);
      const u16* src = ZB + (size_t)(rowbase + qr) * 1536 + hq * 64 + quad * 8;
      float q0[8], q1[8];
      unpack8(*(const uint4*)src, q0);
      unpack8(*(const uint4*)(src + 32), q1);
      float ss = 0.f;
#pragma unroll
      for (int i = 0; i < 8; i++) ss += q0[i] * q0[i] + q1[i] * q1[i];
      ss += __shfl_xor(ss, 16);
      ss += __shfl_xor(ss, 32);
      const float rstd = rsqrtf(ss * (1.f / 64.f) + EPS);
#pragma unroll
      for (int i = 0; i < 8; i++) { q0[i] *= rstd * qg[0][i]; q1[i] *= rstd * qg[1][i]; }
      uint4 u0 = pack8(q0), u1 = pack8(q1);
      qa[0] = __builtin_bit_cast(bf16x8, u0);
      qa[1] = __builtin_bit_cast(bf16x8, u1);
    }
    f32x4 s[10];
#pragma unroll
    for (int kt = 0; kt < 10; kt++) {
      const u16* kp = Ks + (ws0 + kt * 16 + l15) * KS_LD + quad * 8;
      bf16x8 b0 = *(const bf16x8*)kp, b1 = *(const bf16x8*)(kp + 32);
      f32x4 z = {0.f, 0.f, 0.f, 0.f};
      z = __builtin_amdgcn_mfma_f32_16x16x32_bf16(qa[0], b0, z, 0, 0, 0);
      s[kt] = __builtin_amdgcn_mfma_f32_16x16x32_bf16(qa[1], b1, z, 0, 0, 0);
    }
    float mx[4] = {-1e30f, -1e30f, -1e30f, -1e30f};
#pragma unroll
    for (int kt = 0; kt < 10; kt++) {
      const int jj = ws0 + kt * 16 + l15;
      const bool posok = sample ? (jj < 136) : (p0 - 128 + jj >= 0);
#pragma unroll
      for (int e = 0; e < 4; e++) {
        const int r = r0 + quad * 4 + e;
        const int dist = r + 128 - jj;
        const bool ok = posok && dist >= 0 && dist <= 128;
        float v = ok ? (s[kt][e] - slope * (float)dist) : -1e30f;
        s[kt][e] = v;
        mx[e] = fmaxf(mx[e], v);
      }
    }
    float sum[4];
#pragma unroll
    for (int e = 0; e < 4; e++) {
      float m = mx[e];
      m = fmaxf(m, __shfl_xor(m, 1));
      m = fmaxf(m, __shfl_xor(m, 2));
      m = fmaxf(m, __shfl_xor(m, 4));
      m = fmaxf(m, __shfl_xor(m, 8));
      m = fmaxf(m, sink);
      mx[e] = m;
      sum[e] = 0.f;
    }
#pragma unroll
    for (int kt = 0; kt < 10; kt++) {
#pragma unroll
      for (int e = 0; e < 4; e++) {
        float pv = __expf(s[kt][e] - mx[e]);
        sum[e] += pv;
        Ps[(quad * 4 + e) * PS_LD + kt * 16 + l15] = f2bf(pv);
      }
    }
#pragma unroll
    for (int e = 0; e < 4; e++) {
      float t = sum[e];
      t += __shfl_xor(t, 1);
      t += __shfl_xor(t, 2);
      t += __shfl_xor(t, 4);
      t += __shfl_xor(t, 8);
      sum[e] = 1.f / (t + __expf(sink - mx[e]));
    }
    __syncthreads();
    f32x4 o[4];
#pragma unroll
    for (int nt = 0; nt < 4; nt++) o[nt] = (f32x4){0.f, 0.f, 0.f, 0.f};
#pragma unroll
    for (int kk = 0; kk < 5; kk++) {
      bf16x8 pa = *(const bf16x8*)(Ps + l15 * PS_LD + kk * 32 + quad * 8);
#pragma unroll
      for (int nt = 0; nt < 4; nt++) {
        bf16x8 vb = *(const bf16x8*)(Vt + (nt * 16 + l15) * VT_LD + ws0 + kk * 32 + quad * 8);
        o[nt] = __builtin_amdgcn_mfma_f32_16x16x32_bf16(pa, vb, o[nt], 0, 0, 0);
      }
    }
#pragma unroll
    for (int e = 0; e < 4; e++) {
      const int r = quad * 4 + e;
      if (!sample || r < 8) {
        u16* dst = ATT + (size_t)(rowbase + r0 + r) * 1024 + hq * 64 + l15;
#pragma unroll
        for (int nt = 0; nt < 4; nt++) dst[nt * 16] = f2bf(o[nt][e] * sum[e]);
      }
    }
    __syncthreads();
  }
}

constexpr int XC_LD = 68;
__device__ __forceinline__ void lru_tile(KParams& p, char* smem, int mt, int nb, int mode) {
  const int tid = opaque_tid(), lane = tid & 63, w = tid >> 6, l15 = lane & 15, quad = lane >> 4;
  float* xcF = (float*)smem;
  float* aL = xcF + 128 * XC_LD;
  float* aggL = aL + 128 * XC_LD;
  const u16* ZA = (const u16*)(p.ws + W_ZA);
  const bool sample = mt >= 128;
  const int m0 = mt * 128;
  const int cb = nb * 64;
  __syncthreads();
  {
    const int ch = tid & 7;
    float cw[4][8], cbias[8];
#pragma unroll
    for (int j = 0; j < 4; j++)
#pragma unroll
      for (int i = 0; i < 8; i++) cw[j][i] = p.conv_w[j * 1024 + cb + ch * 8 + i];
#pragma unroll
    for (int i = 0; i < 8; i++) cbias[i] = p.conv_b[cb + ch * 8 + i];
#pragma unroll
    for (int it = 0; it < 4; it++) {
      const int r = (tid >> 3) + it * 32;
      const int grow = m0 + r;
      const int t = sample ? (r & 7) : ((mt & 31) * 128 + r);
      float y[8];
#pragma unroll
      for (int i = 0; i < 8; i++) y[i] = cbias[i];
#pragma unroll
      for (int d = 0; d < 4; d++) {
        float xv[8];
        if (t - d >= 0) {
          unpack8(*(const uint4*)(ZA + (size_t)(grow - d) * 2048 + cb + ch * 8), xv);
        } else if (sample) {
          const int bb = (m0 - NP + r) >> 3;
          const float* src = p.cache_conv + ((size_t)bb * 3 + (3 + t - d)) * 1024 + cb + ch * 8;
          float4 a = *(const float4*)src, b4 = *(const float4*)(src + 4);
          xv[0] = a.x; xv[1] = a.y; xv[2] = a.z; xv[3] = a.w; xv[4] = b4.x; xv[5] = b4.y; xv[6] = b4.z; xv[7] = b4.w;
        } else {
#pragma unroll
          for (int i = 0; i < 8; i++) xv[i] = 0.f;
        }
#pragma unroll
        for (int i = 0; i < 8; i++) y[i] += cw[3 - d][i] * xv[i];
        if (d == 0 && mode == 1) {
          if (!sample) {
            if ((mt & 31) == 31 && r >= 125) {
              float* dst = p.out + O_CONVP + ((size_t)(mt >> 5) * 3 + (r - 125)) * 1024 + cb + ch * 8;
              *(float4*)dst = make_float4(xv[0], xv[1], xv[2], xv[3]);
              *(float4*)(dst + 4) = make_float4(xv[4], xv[5], xv[6], xv[7]);
            }
          } else if (t >= 5) {
            const int bb = (m0 - NP + r) >> 3;
            float* dst = p.out + O_CONVS + ((size_t)bb * 3 + (t - 5)) * 1024 + cb + ch * 8;
            *(float4*)dst = make_float4(xv[0], xv[1], xv[2], xv[3]);
            *(float4*)(dst + 4) = make_float4(xv[4], xv[5], xv[6], xv[7]);
          }
        }
      }
      *(float4*)(xcF + r * XC_LD + ch * 8) = make_float4(y[0], y[1], y[2], y[3]);
      *(float4*)(xcF + r * XC_LD + ch * 8 + 4) = make_float4(y[4], y[5], y[6], y[7]);
    }
  }
  __syncthreads();
  {
    const u16* RA = (const u16*)(p.ws + W_RGA) + nb * 4096;
    const u16* RX = (const u16*)(p.ws + W_RGX) + nb * 4096;
    f32x4 aR[2][4], aI[2][4];
#pragma unroll
    for (int i = 0; i < 2; i++)
#pragma unroll
      for (int j = 0; j < 4; j++) { aR[i][j] = (f32x4){0.f, 0.f, 0.f, 0.f}; aI[i][j] = (f32x4){0.f, 0.f, 0.f, 0.f}; }
#pragma unroll
    for (int ks = 0; ks < 2; ks++) {
      bf16x8 a[2];
#pragma unroll
      for (int i = 0; i < 2; i++) {
        const float* src = xcF + (w * 32 + i * 16 + l15) * XC_LD + ks * 32 + quad * 8;
        float4 x0 = *(const float4*)src, x1 = *(const float4*)(src + 4);
        float v[8] = {x0.x, x0.y, x0.z, x0.w, x1.x, x1.y, x1.z, x1.w};
        uint4 u = pack8(v);
        a[i] = __builtin_bit_cast(bf16x8, u);
      }
#pragma unroll
      for (int j = 0; j < 4; j++) {
        bf16x8 ba = *(const bf16x8*)(RA + (j * 16 + l15) * 64 + ks * 32 + quad * 8);
        bf16x8 bx = *(const bf16x8*)(RX + (j * 16 + l15) * 64 + ks * 32 + quad * 8);
#pragma unroll
        for (int i = 0; i < 2; i++) {
          aR[i][j] = __builtin_amdgcn_mfma_f32_16x16x32_bf16(a[i], ba, aR[i][j], 0, 0, 0);
          aI[i][j] = __builtin_amdgcn_mfma_f32_16x16x32_bf16(a[i], bx, aI[i][j], 0, 0, 0);
        }
      }
    }
#pragma unroll
    for (int j = 0; j < 4; j++) {
      const int c = cb + j * 16 + l15;
      const float ba = p.rg_b_a[c], bx = p.rg_b_x[c];
      const float ls = -log1pf(__expf(-p.rg_lambda[c]));
#pragma unroll
      for (int i = 0; i < 2; i++)
#pragma unroll
        for (int e = 0; e < 4; e++) {
          const int row = w * 32 + i * 16 + quad * 4 + e;
          const float rg = sigmoidf_(aR[i][j][e] + ba);
          const float ig = sigmoidf_(aI[i][j][e] + bx);
          const float la = 8.f * rg * ls;
          const float av = __expf(la);
          const float x2 = 2.f * la;
          const float emt = -x2 * (1.f + x2 * (0.5f + x2 * (0.16666667f + x2 * (0.041666668f + x2 * 0.008333334f))));
          const float em = x2 > -0.25f ? emt : 1.f - __expf(x2);
          const float mult = __builtin_amdgcn_sqrtf(fmaxf(em, 0.f));
          const int idx = row * XC_LD + j * 16 + l15;
          const float xv = xcF[idx];
          aL[idx] = av;
          xcF[idx] = mult * ig * xv;
        }
    }
  }
  __syncthreads();
  const int c = cb + lane;
  float* carL = aggL + 512;
  if (!sample) {
    float* AGGP = (float*)(p.ws + W_AGG);
    float* AGGH = AGGP + 128 * 1024;
    const int chunk = mt & 31, base = mt - chunk;
    if (mode == 1) {
      float Pq[8], Hq[8];
#pragma unroll
      for (int k = 0; k < 8; k++) {
        const int q = w * 8 + k;
        const bool ok = q < chunk;
        Pq[k] = ok ? AGGP[(base + q) * 1024 + c] : 1.f;
        Hq[k] = ok ? AGGH[(base + q) * 1024 + c] : 0.f;
      }
      float Pc = 1.f, hc = 0.f;
#pragma unroll
      for (int k = 0; k < 8; k++) { hc = Pq[k] * hc + Hq[k]; Pc *= Pq[k]; }
      carL[(w * 64 + lane) * 2] = Pc;
      carL[(w * 64 + lane) * 2 + 1] = hc;
    }
    float P = 1.f, h = 0.f;
#pragma unroll 8
    for (int rr = 0; rr < 32; rr++) {
      const float av = aL[(w * 32 + rr) * XC_LD + lane], bv = xcF[(w * 32 + rr) * XC_LD + lane];
      h = av * h + bv;
      P *= av;
    }
    aggL[(w * 64 + lane) * 2] = P;
    aggL[(w * 64 + lane) * 2 + 1] = h;
    __syncthreads();
    if (mode == 0) {
      if (w == 0) {
        float Pt = 1.f, ht = 0.f;
#pragma unroll
        for (int q = 0; q < 4; q++) {
          const float Pq = aggL[(q * 64 + lane) * 2], hq = aggL[(q * 64 + lane) * 2 + 1];
          ht = Pq * ht + hq;
          Pt *= Pq;
        }
        AGGP[mt * 1024 + c] = Pt;
        AGGH[mt * 1024 + c] = ht;
      }
    } else {
      float hin = 0.f;
#pragma unroll
      for (int q = 0; q < 4; q++) hin = carL[(q * 64 + lane) * 2] * hin + carL[(q * 64 + lane) * 2 + 1];
      for (int q = 0; q < w; q++) hin = aggL[(q * 64 + lane) * 2] * hin + aggL[(q * 64 + lane) * 2 + 1];
      float hh = hin;
#pragma unroll 8
      for (int rr = 0; rr < 32; rr++) {
        const int row = w * 32 + rr;
        const float av = aL[row * XC_LD + lane], bv = xcF[row * XC_LD + lane];
        hh = av * hh + bv;
        xcF[row * XC_LD + lane] = hh;
      }
      if (chunk == 31 && w == 3) p.out[O_LRUP + (size_t)(mt >> 5) * 1024 + c] = hh;
    }
  } else {
    float hh = 0.f;
    float h0v[4];
#pragma unroll
    for (int k = 0; k < 4; k++) h0v[k] = p.state_lru[(size_t)(((m0 - NP + w * 32) >> 3) + k) * 1024 + c];
#pragma unroll
    for (int rr = 0; rr < 32; rr++) {
      const int row = w * 32 + rr;
      const int bb = (m0 - NP + row) >> 3;
      const int t = row & 7;
      if (t == 0) hh = h0v[rr >> 3];
      const float av = aL[row * XC_LD + lane], bv = xcF[row * XC_LD + lane];
      hh = av * hh + bv;
      xcF[row * XC_LD + lane] = hh;
      if (t == 7) p.out[O_LRUS + (size_t)bb * 1024 + c] = hh;
    }
  }
  if (mode == 1) {
    __syncthreads();
    u16* LO = (u16*)(p.ws + W_ZB);
    const int ch = tid & 7;
#pragma unroll
    for (int it = 0; it < 4; it++) {
      const int r = (tid >> 3) + it * 32;
      float g[8];
      unpack8(*(const uint4*)(ZA + (size_t)(m0 + r) * 2048 + 1024 + cb + ch * 8), g);
      const float4 h0 = *(const float4*)(xcF + r * XC_LD + ch * 8), h1 = *(const float4*)(xcF + r * XC_LD + ch * 8 + 4);
      float v[8] = {h0.x * gelu_tanh(g[0]), h0.y * gelu_tanh(g[1]), h0.z * gelu_tanh(g[2]), h0.w * gelu_tanh(g[3]),
                    h1.x * gelu_tanh(g[4]), h1.y * gelu_tanh(g[5]), h1.z * gelu_tanh(g[6]), h1.w * gelu_tanh(g[7])};
      *(uint4*)(LO + (size_t)(m0 + r) * 1024 + cb + ch * 8) = pack8(v);
    }
  }
}

__device__ __forceinline__ void phase_g3(KParams& p, char* smem, int vb) {
  const int tid = opaque_tid();
  u16* As = (u16*)smem;
  u16* Bs = As + 2 * 128 * LDT;
  float* Cs = (float*)smem;
  const u16* LO = (const u16*)(p.ws + W_ZB);
  const u16* ATT = (const u16*)(p.ws + W_XN);
  const u16* WL = (const u16*)(p.ws + W_WTLRU);
  const u16* WA = (const u16*)(p.ws + W_WTATTN);
  const u16* ZC = (const u16*)p.out;
  u16* MG = (u16*)(p.ws + W_ZA);
  for (int t = blockIdx.x; t < MT * 8; t += gridDim.x) {
    int mt, nt;
    tile_map(t, MT * 8, 8, mt, nt, vb);
    const int cc = (tid & 15) * 8;
#pragma unroll
    for (int pass = 0; pass < 2; pass++) {
      f32x4 acc[4][4];
      zero_acc(acc);
      gemm_tile((pass ? ATT : LO) + (size_t)mt * 128 * 1024, 1024, (pass ? WA : WL) + (size_t)nt * 128 * 1024, 1024, 1024,
                acc, smem, tid);
      __syncthreads();
      acc_to_cs(acc, Cs, tid);
      __syncthreads();
#pragma unroll
      for (int i = 0; i < 8; i++) {
        const int r = (tid >> 4) + 16 * i;
        const size_t row = (size_t)(mt * 128 + r);
        float4 a = *(const float4*)(Cs + r * CS_LD + cc), b = *(const float4*)(Cs + r * CS_LD + cc + 4);
        float v[8] = {a.x, a.y, a.z, a.w, b.x, b.y, b.z, b.w};
        float g[8];
        unpack8(*(const uint4*)(ZC + row * 2048 + pass * 1024 + nt * 128 + cc), g);
        u16* mp = MG + row * 1024 + nt * 128 + cc;
        if (pass == 0) {
#pragma unroll
          for (int q = 0; q < 8; q++) v[q] *= sigmoidf_(g[q]);
        } else {
          float pv[8];
          unpack8(*(const uint4*)mp, pv);
#pragma unroll
          for (int q = 0; q < 8; q++) v[q] = pv[q] + v[q] * sigmoidf_(g[q]);
        }
        *(uint4*)mp = pack8(v);
      }
      __syncthreads();
    }
  }
}

__device__ __forceinline__ void phase_g4(KParams& p, char* smem, int vb) {
  const int tid = opaque_tid();
  u16* As = (u16*)smem;
  u16* Bs = As + 2 * 128 * LDT;
  float* Cs = (float*)smem;
  const u16* MG = (const u16*)(p.ws + W_ZA);
  const u16* WO = (const u16*)(p.ws + W_WTOUT);
  u16* HG = (u16*)(p.ws + W_ZB);
  float* SSQ = (float*)(p.ws + W_SSQ);
  for (int t = blockIdx.x; t < MT * 8; t += gridDim.x) {
    int mt, nt;
    tile_map(t, MT * 8, 8, mt, nt, vb);
    f32x4 acc[4][4];
    zero_acc(acc);
    gemm_tile(MG + (size_t)mt * 128 * 1024, 1024, WO + (size_t)nt * 128 * 1024, 1024, 1024, acc, smem, tid);
    __syncthreads();
    acc_to_cs(acc, Cs, tid);
    __syncthreads();
    const int cc = (tid & 15) * 8;
    const float4 g0 = *(const float4*)(p.norm2_g + nt * 128 + cc), g1 = *(const float4*)(p.norm2_g + nt * 128 + cc + 4);
#pragma unroll
    for (int i = 0; i < 8; i++) {
      const int r = (tid >> 4) + 16 * i;
      const int row = mt * 128 + r;
      float4 a = *(const float4*)(Cs + r * CS_LD + cc), b = *(const float4*)(Cs + r * CS_LD + cc + 4);
      const float* xr = xrow(p, row) + nt * 128 + cc;
      float4 x0 = *(const float4*)xr, x1 = *(const float4*)(xr + 4);
      a.x += x0.x; a.y += x0.y; a.z += x0.z; a.w += x0.w;
      b.x += x1.x; b.y += x1.y; b.z += x1.z; b.w += x1.w;
      float* ho = p.out + O_Y + (size_t)row * 1024 + nt * 128 + cc;
      *(float4*)ho = a;
      *(float4*)(ho + 4) = b;
      float v[8] = {a.x * g0.x, a.y * g0.y, a.z * g0.z, a.w * g0.w, b.x * g1.x, b.y * g1.y, b.z * g1.z, b.w * g1.w};
      *(uint4*)(HG + (size_t)row * 1024 + nt * 128 + cc) = pack8(v);
      float ss = a.x * a.x + a.y * a.y + a.z * a.z + a.w * a.w + b.x * b.x + b.y * b.y + b.z * b.z + b.w * b.w;
      ss += __shfl_xor(ss, 1);
      ss += __shfl_xor(ss, 2);
      ss += __shfl_xor(ss, 4);
      ss += __shfl_xor(ss, 8);
      if ((tid & 15) == 0) SSQ[(size_t)row * 8 + nt] = ss;
    }
    __syncthreads();
  }
}

__device__ __forceinline__ float row_rstd(const float* SSQ, int row) {
  const float4 a = *(const float4*)(SSQ + (size_t)row * 8), b = *(const float4*)(SSQ + (size_t)row * 8 + 4);
  const float ss = ((a.x + a.y) + (a.z + a.w)) + ((b.x + b.y) + (b.z + b.w));
  return rsqrtf(ss * (1.f / 1024.f) + EPS);
}

__device__ __forceinline__ void phase_g5(KParams& p, char* smem, int vb) {
  const int tid = opaque_tid();
  u16* As = (u16*)smem;
  u16* Bs = As + 2 * 128 * LDT;
  float* Cs = (float*)smem;
  const u16* HG = (const u16*)(p.ws + W_ZB);
  const u16* WQ = (const u16*)(p.ws + W_WTQ);
  const float* SSQ = (const float*)(p.ws + W_SSQ);
  u16* QR = (u16*)(p.ws + W_ZA);
  for (int t = blockIdx.x; t < MT * 16; t += gridDim.x) {
    int mt, nt;
    tile_map(t, MT * 16, 16, mt, nt, vb);
    f32x4 acc[4][4];
    zero_acc(acc);
    gemm_tile(HG + (size_t)mt * 128 * 1024, 1024, WQ + (size_t)nt * 128 * 1024, 1024, 1024, acc, smem, tid);
    __syncthreads();
    acc_to_cs(acc, Cs, tid);
    __syncthreads();
    const int cc = (tid & 15) * 8;
#pragma unroll
    for (int i = 0; i < 8; i++) {
      const int r = (tid >> 4) + 16 * i;
      const int row = mt * 128 + r;
      const float rs = row_rstd(SSQ, row);
      float4 a = *(const float4*)(Cs + r * CS_LD + cc), b = *(const float4*)(Cs + r * CS_LD + cc + 4);
      float v[8] = {a.x * rs, a.y * rs, a.z * rs, a.w * rs, b.x * rs, b.y * rs, b.z * rs, b.w * rs};
      *(uint4*)(QR + (size_t)row * 2048 + nt * 128 + cc) = pack8(v);
    }
    __syncthreads();
  }
}

__device__ __forceinline__ void phase_g6(KParams& p, char* smem, int vb) {
  const int tid = opaque_tid();
  u16* As = (u16*)smem;
  u16* Bs = As + 2 * 128 * LDT;
  float* Cs = (float*)smem;
  uint32_t* Cu = (uint32_t*)smem;
  uint32_t* TK0 = (uint32_t*)(smem + 128 * CS_LD * 4);
  const u16* QR = (const u16*)(p.ws + W_ZA);
  const u16* SK = (const u16*)(p.ws + W_SK);
  int* IDX = (int*)(p.ws + W_XN);
  float* GW = (float*)(p.ws + W_XN + (size_t)NTOK * 128 * 4);
  const int row = tid >> 1, half = tid & 1;
  for (int t = blockIdx.x; t < MT * 8; t += gridDim.x) {
    int mt, h;
    tile_map(t, MT * 8, 8, mt, h, vb);
    uint32_t tk[16];
    for (int pp = 0; pp < 2; pp++) {
      f32x4 acc[4][4];
      zero_acc(acc);
      gemm_tile(QR + (size_t)mt * 128 * 2048 + h * 256 + pp * 128, 2048, SK + (size_t)(h * 2 + pp) * 16384, 128, 128, acc,
                smem, tid);
      __syncthreads();
      acc_to_cs(acc, Cs, tid);
      __syncthreads();
#pragma unroll
      for (int g = 0; g < 4; g++) {
        uint32_t sg[16];
#pragma unroll
        for (int q4 = 0; q4 < 4; q4++) {
          const int col = half * 64 + g * 16 + q4 * 4;
          const float4 v = *(const float4*)(Cs + row * CS_LD + col);
          sg[q4 * 4 + 0] = (ordf(v.x) & ~0x7Fu) | (uint32_t)(127 - col);
          sg[q4 * 4 + 1] = (ordf(v.y) & ~0x7Fu) | (uint32_t)(126 - col);
          sg[q4 * 4 + 2] = (ordf(v.z) & ~0x7Fu) | (uint32_t)(125 - col);
          sg[q4 * 4 + 3] = (ordf(v.w) & ~0x7Fu) | (uint32_t)(124 - col);
        }
        sort16_desc(sg);
        if (g == 0) {
#pragma unroll
          for (int q = 0; q < 16; q++) tk[q] = sg[q];
        } else {
          merge16_desc(tk, sg);
        }
      }
      __syncthreads();
      if (half == 1) {
#pragma unroll
        for (int q = 0; q < 16; q++) Cu[row * 16 + q] = tk[q];
      }
      __syncthreads();
      if (half == 0) {
        {
          uint32_t sg[16];
#pragma unroll
          for (int q4 = 0; q4 < 4; q4++) {
            const uint4 u = *(const uint4*)(Cu + row * 16 + q4 * 4);
            sg[q4 * 4] = u.x; sg[q4 * 4 + 1] = u.y; sg[q4 * 4 + 2] = u.z; sg[q4 * 4 + 3] = u.w;
          }
          merge16_desc(tk, sg);
        }
        if (pp == 0) {
#pragma unroll
          for (int q = 0; q < 16; q++) TK0[row * 16 + q] = tk[q];
        } else {
#pragma unroll
          for (int q = 0; q < 16; q++) Cu[2048 + row * 16 + q] = tk[q];
        }
      }
      __syncthreads();
    }
    if (half == 0) {
      float va[16], vb[16];
#pragma unroll
      for (int q = 0; q < 16; q++) {
        va[q] = unordf(TK0[row * 16 + q] & ~0x7Fu);
        vb[q] = unordf(tk[q] & ~0x7Fu);
      }
      uint32_t cd[16];
#pragma unroll
      for (int q = 0; q < 16; q++) cd[q] = (ordf(va[0] + vb[q]) & ~0xFFu) | (uint32_t)(255 - q);
#pragma unroll
      for (int i = 1; i < 16; i++) {
#pragma unroll
        for (int j = 0; j < 16; j++) {
          if ((i + 1) * (j + 1) <= 16) {
            const float sv = va[i] + vb[j];
            const uint32_t key = (ordf(sv) & ~0xFFu) | (uint32_t)(255 - (i * 16 + j));
            INS16(cd, key);
          }
        }
      }
      float ev[16];
      const float m0v = unordf(cd[0] & ~0xFFu);
      float esum = 0.f;
#pragma unroll
      for (int q = 0; q < 16; q++) {
        ev[q] = __expf(unordf(cd[q] & ~0xFFu) - m0v);
        esum += ev[q];
      }
      const float inv = 1.f / esum;
      const size_t ob = (size_t)(mt * 128 + row) * 128 + h * 16;
#pragma unroll
      for (int q = 0; q < 16; q++) {
        const int ij = 255 - (int)(cd[q] & 0xFFu);
        const int i0 = 127 - (int)(TK0[row * 16 + (ij >> 4)] & 0x7Fu);
        const int i1 = 127 - (int)(Cu[2048 + row * 16 + (ij & 15)] & 0x7Fu);
        IDX[ob + q] = i0 * 128 + i1;
        GW[ob + q] = ev[q] * inv;
      }
    }
    __syncthreads();
  }
}

typedef __attribute__((ext_vector_type(2))) float f32x2;
__device__ __forceinline__ void dec16(uint4 u, float* v) {
  f32x2 t;
  t = __builtin_amdgcn_cvt_pk_f32_fp8((int)u.x, false); v[0] = t.x; v[1] = t.y;
  t = __builtin_amdgcn_cvt_pk_f32_fp8((int)u.x, true); v[2] = t.x; v[3] = t.y;
  t = __builtin_amdgcn_cvt_pk_f32_fp8((int)u.y, false); v[4] = t.x; v[5] = t.y;
  t = __builtin_amdgcn_cvt_pk_f32_fp8((int)u.y, true); v[6] = t.x; v[7] = t.y;
  t = __builtin_amdgcn_cvt_pk_f32_fp8((int)u.z, false); v[8] = t.x; v[9] = t.y;
  t = __builtin_amdgcn_cvt_pk_f32_fp8((int)u.z, true); v[10] = t.x; v[11] = t.y;
  t = __builtin_amdgcn_cvt_pk_f32_fp8((int)u.w, false); v[12] = t.x; v[13] = t.y;
  t = __builtin_amdgcn_cvt_pk_f32_fp8((int)u.w, true); v[14] = t.x; v[15] = t.y;
}

__device__ __forceinline__ void phase7(KParams& p) {
  const int tid = opaque_tid(), lane = tid & 63, w = tid >> 6;
  const u16* HG = (const u16*)(p.ws + W_ZB);
  const float* SSQ = (const float*)(p.ws + W_SSQ);
  const int* IDX = (const int*)(p.ws + W_XN);
  const float* GW = (const float*)(p.ws + W_XN + (size_t)NTOK * 128 * 4);
  const unsigned char* EU = (const unsigned char*)(p.ws + W_EU);
  const unsigned char* EV = (const unsigned char*)(p.ws + W_EV);
  const float* ESC = (const float*)(p.ws + W_ESC);
  const int b0 = lane & 1, b1 = (lane >> 1) & 1, b2 = (lane >> 2) & 1;
  for (int tok = blockIdx.x * 4 + w; tok < NTOK; tok += gridDim.x * 4) {
    const float rs = row_rstd(SSQ, tok);
    float xh[16];
    {
      const uint4* hp = (const uint4*)(HG + (size_t)tok * 1024 + lane * 16);
      unpack8(hp[0], xh);
      unpack8(hp[1], xh + 8);
#pragma unroll
      for (int i = 0; i < 16; i++) xh[i] *= rs;
    }
    const int iA = IDX[(size_t)tok * 128 + lane], iB = IDX[(size_t)tok * 128 + 64 + lane];
    const float gA = GW[(size_t)tok * 128 + lane] * ESC[16384 + iA], gB = GW[(size_t)tok * 128 + 64 + lane] * ESC[16384 + iB];
    const float suA = ESC[iA], suB = ESC[iB];
    float dA = 0.f, dB = 0.f;
#pragma unroll 2
    for (int bb = 0; bb < 16; bb++) {
      const int isrc = bb < 8 ? iA : iB;
      float d[8];
      uint4 ur[8];
#pragma unroll
      for (int k = 0; k < 8; k++) {
        const int id = __builtin_amdgcn_readlane(isrc, (bb & 7) * 8 + k);
        ur[k] = *(const uint4*)(EU + (size_t)id * 1024 + lane * 16);
      }
#pragma unroll
      for (int k = 0; k < 8; k++) {
        float uv[16];
        dec16(ur[k], uv);
        float sacc = 0.f;
#pragma unroll
        for (int i = 0; i < 16; i++) sacc += xh[i] * uv[i];
        d[k] = sacc;
      }
      float e4[4], e2[2], e1;
#pragma unroll
      for (int i = 0; i < 4; i++) {
        const float keep = b0 ? d[2 * i + 1] : d[2 * i];
        const float send = b0 ? d[2 * i] : d[2 * i + 1];
        e4[i] = keep + __shfl_xor(send, 1);
      }
#pragma unroll
      for (int i = 0; i < 2; i++) {
        const float keep = b1 ? e4[2 * i + 1] : e4[2 * i];
        const float send = b1 ? e4[2 * i] : e4[2 * i + 1];
        e2[i] = keep + __shfl_xor(send, 2);
      }
      {
        const float keep = b2 ? e2[1] : e2[0];
        const float send = b2 ? e2[0] : e2[1];
        e1 = keep + __shfl_xor(send, 4);
      }
      e1 += __shfl_xor(e1, 8);
      e1 += __shfl_xor(e1, 16);
      e1 += __shfl_xor(e1, 32);
      const bool mine = (lane >> 3) == (bb & 7);
      if (bb < 8) dA = mine ? e1 : dA; else dB = mine ? e1 : dB;
    }
    const float actA = gelu_tanh(dA * suA) * gA, actB = gelu_tanh(dB * suB) * gB;
    float* ACT = (float*)(p.ws + W_ACT);
    ACT[(size_t)tok * 128 + lane] = actA;
    ACT[(size_t)tok * 128 + 64 + lane] = actB;
  }
}

__device__ __forceinline__ void phase7b(KParams& p) {
  const int tid = opaque_tid(), lane = tid & 63;
  const char* IDXb = (const char*)(p.ws + W_XN);
  const char* ACTb = (const char*)(p.ws + W_ACT);
  const char* EVb = (const char*)(p.ws + W_EV);
  char* Yb = (char*)(p.out + O_Y);
  unsigned* Q = (unsigned*)(p.ws + W_Q);
  const int esub = lane >> 3, c = lane & 7;
  const int pref = (int)(hw_xcc_id() & 7u);
  const int b3 = (lane >> 3) & 1, b4 = (lane >> 4) & 1, b5 = (lane >> 5) & 1;
  const uint32_t lane4 = (uint32_t)lane * 4u;
  const uint32_t yl = (uint32_t)(c * 16 + b3 * 8 + b4 * 4 + b5 * 2) * 4u;
  for (int k = 0; k < 8; k++) {
    const int sl = (pref + k) & 7;
    const char* Vs = EVb + (size_t)sl * (16384 * 128);
    const uint32_t vl = (uint32_t)c * 16u;
    for (;;) {
      unsigned it = 0;
      if (lane == 0) it = atomicAdd(Q + sl * 64, 1u);
      it = (unsigned)__builtin_amdgcn_readfirstlane((int)it);
      if (it >= (unsigned)(NTOK / 8)) break;
      const int tok0 = (int)it * 8;
      const char* ib = IDXb + (size_t)tok0 * 512;
      const char* ab = ACTb + (size_t)tok0 * 512;
      char* yb = Yb + (size_t)tok0 * 4096 + sl * 512;
      int nidA = *(const int*)(ib + lane4), nidB = *(const int*)(ib + 256 + lane4);
      float nacA = *(const float*)(ab + lane4), nacB = *(const float*)(ab + 256 + lane4);
      float2 nyv = *(const float2*)(yb + yl);
#pragma unroll 1
      for (int t = 0; t < 8; t++) {
        const int idA = nidA, idB = nidB;
        const float acA = nacA, acB = nacB;
        const float2 yv = nyv;
        char* ybt = yb;
        if (t < 7) {
          ib += 512; ab += 512; yb += 4096;
          nidA = *(const int*)(ib + lane4); nidB = *(const int*)(ib + 256 + lane4);
          nacA = *(const float*)(ab + lane4); nacB = *(const float*)(ab + 256 + lane4);
          nyv = *(const float2*)(yb + yl);
        }
        float o[16];
#pragma unroll
        for (int q = 0; q < 16; q++) o[q] = 0.f;
#pragma unroll
        for (int hf = 0; hf < 2; hf++) {
          uint4 vr[8];
#pragma unroll
          for (int i = 0; i < 8; i++) {
            const uint32_t id = (uint32_t)__shfl(hf ? idB : idA, i * 8 + esub);
            vr[i] = *(const uint4*)(Vs + (id * 128u + vl));
          }
#pragma unroll
          for (int i = 0; i < 8; i++) {
            float vv[16];
            dec16(vr[i], vv);
            const float a = __shfl(hf ? acB : acA, i * 8 + esub);
#pragma unroll
            for (int q = 0; q < 16; q++) o[q] += a * vv[q];
          }
        }
        float r8[8], r4[4], r2[2];
#pragma unroll
        for (int q = 0; q < 8; q++) {
          const float keep = b3 ? o[q + 8] : o[q];
          const float send = b3 ? o[q] : o[q + 8];
          r8[q] = keep + __shfl_xor(send, 8);
        }
#pragma unroll
        for (int q = 0; q < 4; q++) {
          const float keep = b4 ? r8[q + 4] : r8[q];
          const float send = b4 ? r8[q] : r8[q + 4];
          r4[q] = keep + __shfl_xor(send, 16);
        }
#pragma unroll
        for (int q = 0; q < 2; q++) {
          const float keep = b5 ? r4[q + 2] : r4[q];
          const float send = b5 ? r4[q] : r4[q + 2];
          r2[q] = keep + __shfl_xor(send, 32);
        }
        float2 h = yv;
        h.x += r2[0];
        h.y += r2[1];
        *(float2*)(ybt + yl) = h;
      }
    }
  }
}

#define XB_TMO      128
#define XB_XCNT(j)  (256  + 64 * (j))
#define XB_XSUB(j)  (1280 + 64 * (j))
#define XB_XGEN(j)  (2304 + 64 * (j))
#define XB_TOP      3328
#define XB_TOPGEN   3392
#define XCD_BAR_WORDS 3456
#define XB_SPIN_CAP (1u << 18)
#define LAS __attribute__((address_space(3)))
__device__ __forceinline__ unsigned xb_ld(unsigned* p) { return __hip_atomic_load(p, __ATOMIC_RELAXED, __HIP_MEMORY_SCOPE_AGENT); }
__device__ __forceinline__ unsigned xb_add(unsigned* p, unsigned v) { return __hip_atomic_fetch_add(p, v, __ATOMIC_RELAXED, __HIP_MEMORY_SCOPE_AGENT); }
__device__ __forceinline__ unsigned xb_xcc_id() { return (unsigned)__builtin_amdgcn_s_getreg((3 << 11) | 20) & 0xFu; }
#define XB_SPIN(cond, bar) do { unsigned _sp = 0; while (cond) { __builtin_amdgcn_s_sleep(1); \
    if ((++_sp & 255u) == 0u) { if (xb_ld(&(bar)[XB_TMO])) break; if (_sp > XB_SPIN_CAP) { atomicAdd(&(bar)[XB_TMO], 1u); break; } } } } while (0)
struct XcdBarrier { unsigned* bar; unsigned x; volatile LAS unsigned* st; };
__device__ __forceinline__ XcdBarrier xcd_barrier_post(unsigned* bar, volatile LAS unsigned* st) {
  XcdBarrier b; b.bar = bar; b.x = xb_xcc_id(); b.st = st;
  if (threadIdx.x == 0) st[2] = xb_add(&bar[XB_XCNT(b.x)], 1u);
  return b;
}
__device__ __forceinline__ void xcd_barrier_complete(unsigned* bar, unsigned x, unsigned& nloc, unsigned& nx) {
  const unsigned G = gridDim.x * gridDim.y * gridDim.z;
  unsigned sum, cnt, mine, sp = 0u;
  for (;;) {
    sum = 0u; cnt = 0u; mine = 0u;
#pragma unroll
    for (unsigned j = 0; j < 16; ++j) { const unsigned c = xb_ld(&bar[XB_XCNT(j)]); sum += c; cnt += (c > 0u) ? 1u : 0u; mine = (j == x) ? c : mine; }
    if (sum == G) break;
    __builtin_amdgcn_s_sleep(1);
    if ((++sp & 255u) == 0u) { if (xb_ld(&bar[XB_TMO])) break; if (sp > XB_SPIN_CAP) { atomicAdd(&bar[XB_TMO], 1u); break; } }
  }
  nloc = mine > 0u ? mine : 1u; nx = cnt > 0u ? cnt : 1u;
}
__device__ __forceinline__ void xcd_barrier(const XcdBarrier& b) {
  asm volatile("s_waitcnt vmcnt(0)" ::: "memory");
  __syncthreads();
  if (threadIdx.x == 0) {
    unsigned* bar = b.bar;
    __builtin_amdgcn_s_waitcnt(0);
    unsigned nloc = b.st[0], nx = b.st[1];
    if (nloc == 0u) { xcd_barrier_complete(bar, b.x, nloc, nx); b.st[0] = nloc; b.st[1] = nx; }
    const unsigned old = xb_add(&bar[XB_XSUB(b.x)], 1u);
    const unsigned gen = old / nloc;
    if (old + 1u == (gen + 1u) * nloc) {
      __builtin_amdgcn_fence(__ATOMIC_RELEASE, "agent");
      asm volatile("s_waitcnt vmcnt(0)" ::: "memory");
      const unsigned og = xb_add(&bar[XB_TOP], 1u);
      const unsigned tg = og / nx;
      if (og + 1u == (tg + 1u) * nx) xb_add(&bar[XB_TOPGEN], 1u);
      else XB_SPIN(xb_ld(&bar[XB_TOPGEN]) == tg, bar);
      __builtin_amdgcn_fence(__ATOMIC_ACQUIRE, "agent");
      xb_add(&bar[XB_XGEN(b.x)], 1u);
      asm volatile("s_waitcnt vmcnt(0)" ::: "memory");
    } else {
      XB_SPIN(xb_ld(&bar[XB_XGEN(b.x)]) == gen, bar);
      __builtin_amdgcn_fence(__ATOMIC_ACQUIRE, "agent");
      asm volatile("s_waitcnt vmcnt(0)" ::: "memory");
    }
  }
  __syncthreads();
}

#ifndef REP_MASK
#define REP_MASK 0
#endif
#define REPS(k) for (int _rep = 0; _rep < (((REP_MASK) >> (k)) & 1) + 1; _rep++)
__global__ void __launch_bounds__(256, 2) fwd_megakernel(Params p_) {
  extern __shared__ __attribute__((aligned(16))) char smem[];
  cg::grid_group grid = cg::this_grid();
  if (p_.ws == nullptr) grid.sync();
  volatile LAS unsigned* xst = (volatile LAS unsigned*)(smem + SMEM_BYTES - 16);
  if (threadIdx.x == 0) { xst[0] = 0u; xst[1] = 0u; xst[2] = 0u; xst[3] = 0u; }
  __syncthreads();
  const XcdBarrier xb = xcd_barrier_post((unsigned*)(p_.ws + W_BAR), xst);
  REPS(0) { phase0(*fresh_params(), smem); xcd_barrier(xb); }
  if (threadIdx.x == 0) {
    unsigned* bar = (unsigned*)(p_.ws + W_BAR);
    const unsigned per = gridDim.x >> 3;
    bool uni = (gridDim.x & 7u) == 0u;
    for (unsigned j = 0; j < 16; ++j) { const unsigned cnt = xb_ld(&bar[XB_XCNT(j)]); if (cnt != (j < 8 ? per : 0u)) uni = false; }
    xst[3] = uni ? (xb.x * per + xst[2]) : blockIdx.x;
  }
  __syncthreads();
  const int vb = (int)xst[3];
  REPS(1) { phase_g1(*fresh_params(), smem, vb); xcd_barrier(xb); }
  REPS(2) {
    for (int it = blockIdx.x; it < 1536 + 2048; it += gridDim.x) {
      if (it < 1536) attn_item(*fresh_params(), smem, it);
      else { const int q = it - 1536; lru_tile(*fresh_params(), smem, q >> 4, q & 15, 0); }
    }
    xcd_barrier(xb);
  }
  REPS(3) {
    for (int it = blockIdx.x; it < MT * 16; it += gridDim.x) lru_tile(*fresh_params(), smem, it >> 4, it & 15, 1);
    xcd_barrier(xb);
  }
  REPS(4) { phase_g3(*fresh_params(), smem, vb); xcd_barrier(xb); }
  REPS(5) { phase_g4(*fresh_params(), smem, vb); xcd_barrier(xb); }
  REPS(6) { phase_g5(*fresh_params(), smem, vb); xcd_barrier(xb); }
  REPS(7) { phase_g6(*fresh_params(), smem, vb); xcd_barrier(xb); }
  phase7(*fresh_params());
  xcd_barrier(xb);
  phase7b(*fresh_params());
}

extern "C" void kernel_launch(void* const* d_in, const int* in_sizes, int n_in, void* d_out, int out_size, void* d_ws,
                              size_t ws_size, hipStream_t stream) {
  static int grid_blocks = 0;
  if (!grid_blocks) {
    int dev = 0, cus = 0, per_cu = 0;
    hipGetDevice(&dev);
    hipDeviceGetAttribute(&cus, hipDeviceAttributeMultiprocessorCount, dev);
    hipFuncSetAttribute((const void*)fwd_megakernel, hipFuncAttributeMaxDynamicSharedMemorySize, SMEM_BYTES);
    hipOccupancyMaxActiveBlocksPerMultiprocessor(&per_cu, fwd_megakernel, 256, SMEM_BYTES);
    if (per_cu < 1) per_cu = 1;
    grid_blocks = cus * per_cu;
  }
  Params p{};
  const float** pp = (const float**)&p;
  for (int i = 0; i < 26; i++) pp[i] = (const float*)d_in[i];
  p.out = (float*)d_out;
  p.ws = (char*)d_ws;
  (void)hipMemsetAsync((char*)d_ws + W_BAR, 0, (size_t)3456 * 4 + 8 * 256, stream);
  void* args[] = {&p};
  hipError_t e = hipLaunchCooperativeKernel((void*)fwd_megakernel, dim3(grid_blocks), dim3(256), args, SMEM_BYTES, stream);
  if (e != hipSuccess) fprintf(stderr, "cooperative launch failed: %s (grid %d)\n", hipGetErrorString(e), grid_blocks);
}
```

```cpp
#include <hip/hip_runtime.h>
#include <hip/hip_cooperative_groups.h>
#include <stdint.h>
#include <cstdio>
namespace cg = cooperative_groups;

typedef unsigned short u16;
typedef __attribute__((ext_vector_type(8))) short bf16x8;
typedef __attribute__((ext_vector_type(4))) float f32x4;

constexpr int D = 1024;
constexpr int NP = 16384;
constexpr int NTOK = 17408;
constexpr int SEQ = 4096;
constexpr int MT = 136;
constexpr float EPS = 1e-6f;

constexpr size_t O_Y = 0;
constexpr size_t O_CONVP = 17825792;
constexpr size_t O_LRUP = O_CONVP + 12288;
constexpr size_t O_KP = O_LRUP + 4096;
constexpr size_t O_VP = O_KP + 131072;
constexpr size_t O_CONVS = O_VP + 131072;
constexpr size_t O_LRUS = O_CONVS + 393216;
constexpr size_t O_KS = O_LRUS + 131072;
constexpr size_t O_VS = O_KS + 4194304;

constexpr size_t W_WTIN = 0;
constexpr size_t W_WTLRU = W_WTIN + (size_t)5632 * 1024 * 2;
constexpr size_t W_WTATTN = W_WTLRU + (size_t)1024 * 1024 * 2;
constexpr size_t W_WTOUT = W_WTATTN + (size_t)1024 * 1024 * 2;
constexpr size_t W_WTQ = W_WTOUT + (size_t)1024 * 1024 * 2;
constexpr size_t W_SK = W_WTQ + (size_t)2048 * 1024 * 2;
constexpr size_t W_RGA = W_SK + (size_t)16 * 128 * 128 * 2;
constexpr size_t W_RGX = W_RGA + (size_t)65536 * 2;
constexpr size_t W_EU = W_RGX + (size_t)65536 * 2;
constexpr size_t W_EV = W_EU + (size_t)16384 * 1024;
constexpr size_t W_ESC = W_EV + (size_t)16384 * 1024;
constexpr size_t W_XN = W_ESC + (size_t)32768 * 4;
constexpr size_t W_ZA = W_XN + (size_t)NTOK * 1024 * 2;
constexpr size_t W_ZB = W_ZA + (size_t)NTOK * 2048 * 2;
constexpr size_t W_AGG = W_ZB + (size_t)NTOK * 1536 * 2;
constexpr size_t W_SSQ = W_AGG + (size_t)128 * 1024 * 2 * 4;
constexpr size_t W_BAR = W_SSQ + (size_t)NTOK * 16 * 4;
constexpr size_t W_Q = W_BAR + (size_t)3456 * 4;
constexpr size_t W_ACT = W_Q + (size_t)8 * 256;
constexpr size_t W_END = W_ACT + (size_t)NTOK * 128 * 4;

constexpr int SMEM_BYTES = 81920;

struct Params {
  const float *x_prompt, *x_sample, *cache_conv, *state_lru, *cache_k, *cache_v, *norm1_g, *w_in, *conv_w,
      *conv_b, *rg_w_a, *rg_b_a, *rg_w_x, *rg_b_x, *rg_lambda, *q_norm_g, *k_norm_g, *attn_sinks,
      *w_branch_lru, *w_branch_attn, *w_out, *norm2_g, *peer_w_query, *peer_sub_keys, *expert_u, *expert_v;
  float* out;
  char* ws;
};

typedef const __attribute__((address_space(4))) Params KParams;
__device__ __forceinline__ KParams* fresh_params() {
  unsigned long long k = (unsigned long long)__builtin_amdgcn_kernarg_segment_ptr();
  asm volatile("" : "+s"(k));
  return (KParams*)k;
}
__device__ __forceinline__ u16 f2bf(float f) {
  uint32_t u = __float_as_uint(f);
  u += 0x7FFFu + ((u >> 16) & 1u);
  return (u16)(u >> 16);
}
__device__ __forceinline__ float bf2f(u16 h) { return __uint_as_float(((uint32_t)h) << 16); }
__device__ __forceinline__ uint32_t pack2(float a, float b) {
  uint32_t r;
  asm("v_cvt_pk_bf16_f32 %0, %1, %2" : "=v"(r) : "v"(a), "v"(b));
  return r;
}
__device__ __forceinline__ uint4 pack8(const float* v) {
  uint4 o;
  o.x = pack2(v[0], v[1]); o.y = pack2(v[2], v[3]); o.z = pack2(v[4], v[5]); o.w = pack2(v[6], v[7]);
  return o;
}
__device__ __forceinline__ void unpack8(uint4 u, float* v) {
  v[0] = __uint_as_float(u.x << 16); v[1] = __uint_as_float(u.x & 0xFFFF0000u);
  v[2] = __uint_as_float(u.y << 16); v[3] = __uint_as_float(u.y & 0xFFFF0000u);
  v[4] = __uint_as_float(u.z << 16); v[5] = __uint_as_float(u.z & 0xFFFF0000u);
  v[6] = __uint_as_float(u.w << 16); v[7] = __uint_as_float(u.w & 0xFFFF0000u);
}
__device__ __forceinline__ float sigmoidf_(float x) { return __builtin_amdgcn_rcpf(1.f + __expf(-x)); }
__device__ __forceinline__ float gelu_tanh(float x) {
  float y = 0.7978845608028654f * (x + 0.044715f * x * x * x);
  float t = 1.f - 2.f * __builtin_amdgcn_rcpf(__expf(2.f * y) + 1.f);
  return 0.5f * x * (1.f + t);
}
__device__ __forceinline__ uint32_t ordf(float f) {
  uint32_t u = __float_as_uint(f);
  return (u & 0x80000000u) ? ~u : (u | 0x80000000u);
}
__device__ __forceinline__ float unordf(uint32_t o) {
  uint32_t u = (o & 0x80000000u) ? (o ^ 0x80000000u) : ~o;
  return __uint_as_float(u);
}
__device__ __forceinline__ unsigned hw_xcc_id() { return (unsigned)__builtin_amdgcn_s_getreg((3 << 11) | 20) & 0xFu; }
__device__ __forceinline__ int opaque_tid() {
  int t = threadIdx.x;
  asm volatile("" : "+v"(t));
  return t;
}
__device__ __forceinline__ const float* xrow(KParams& p, int row) {
  return row < NP ? p.x_prompt + (size_t)row * D : p.x_sample + (size_t)(row - NP) * D;
}

#define INS16(T, V)                                  \
  {                                                  \
    uint32_t _v = (V);                               \
    _Pragma("unroll") for (int _q = 0; _q < 16; _q++) { \
      uint32_t _hi = max(T[_q], _v);                 \
      _v = min(T[_q], _v);                           \
      T[_q] = _hi;                                   \
    }                                                \
  }

#define CE_DESC(A_, B_) { const uint32_t _h = max(A_, B_), _l = min(A_, B_); A_ = _h; B_ = _l; }
__device__ __forceinline__ void sort16_desc(uint32_t (&t)[16]) {
#pragma unroll
  for (int k = 2; k <= 16; k <<= 1) {
#pragma unroll
    for (int j = k >> 1; j > 0; j >>= 1) {
#pragma unroll
      for (int i = 0; i < 16; i++) {
        const int l = i ^ j;
        if (l > i) {
          if ((i & k) == 0) { CE_DESC(t[i], t[l]); } else { CE_DESC(t[l], t[i]); }
        }
      }
    }
  }
}
__device__ __forceinline__ void merge16_desc(uint32_t (&T)[16], const uint32_t (&S)[16]) {
#pragma unroll
  for (int i = 0; i < 16; i++) T[i] = max(T[i], S[15 - i]);
#pragma unroll
  for (int j = 8; j > 0; j >>= 1) {
#pragma unroll
    for (int i = 0; i < 16; i++) {
      const int l = i ^ j;
      if (l > i) { CE_DESC(T[i], T[l]); }
    }
  }
}

__device__ __forceinline__ void transpose_cvt(const float* __restrict__ W, u16* __restrict__ Wt, int K, int N,
                                              size_t gtid, size_t gsz) {
  size_t total = (size_t)N * (K / 8);
  for (size_t c = gtid; c < total; c += gsz) {
    int n = (int)(c % N);
    int kg = (int)(c / N);
    float v[8];
#pragma unroll
    for (int i = 0; i < 8; i++) v[i] = W[(size_t)(kg * 8 + i) * N + n];
    *(uint4*)(Wt + (size_t)n * K + kg * 8) = pack8(v);
  }
}
__device__ __forceinline__ void plain_cvt(const float* __restrict__ S, u16* __restrict__ Dst, size_t n, size_t gtid,
                                          size_t gsz) {
  size_t total = n / 8;
  const float4* s4 = (const float4*)S;
  for (size_t c = gtid; c < total; c += gsz) {
    float4 a = s4[2 * c], b = s4[2 * c + 1];
    float v[8] = {a.x, a.y, a.z, a.w, b.x, b.y, b.z, b.w};
    *(uint4*)(Dst + c * 8) = pack8(v);
  }
}

__device__ __forceinline__ void phase0(KParams& p, char* smem) {
  const int tid = opaque_tid();
  const size_t gtid = (size_t)blockIdx.x * 256 + tid, gsz = (size_t)gridDim.x * 256;
  char* ws = p.ws;
  {
    const int lane = tid & 63;
    const int gw = (int)(gtid >> 6), nw = (int)(gsz >> 6);
    u16* XN = (u16*)(ws + W_XN);
    for (int row = gw; row < NTOK; row += nw) {
      const float4* xr = (const float4*)xrow(p, row);
      float4 v[4];
      float ss = 0.f;
#pragma unroll
      for (int i = 0; i < 4; i++) {
        v[i] = xr[lane + i * 64];
        ss += v[i].x * v[i].x + v[i].y * v[i].y + v[i].z * v[i].z + v[i].w * v[i].w;
      }
#pragma unroll
      for (int o = 32; o > 0; o >>= 1) ss += __shfl_xor(ss, o);
      float rstd = rsqrtf(ss * (1.f / 1024.f) + EPS);
      const float4* g4 = (const float4*)p.norm1_g;
#pragma unroll
      for (int i = 0; i < 4; i++) {
        float4 g = g4[lane + i * 64];
        uint2 o;
        o.x = pack2(v[i].x * rstd * g.x, v[i].y * rstd * g.y);
        o.y = pack2(v[i].z * rstd * g.z, v[i].w * rstd * g.w);
        *(uint2*)(XN + (size_t)row * D + (lane + i * 64) * 4) = o;
      }
    }
  }
  {
    float* T = (float*)smem;
    for (int tile = blockIdx.x; tile < 2688; tile += gridDim.x) {
      const float* W;
      u16* Wt;
      int N, tl;
      if (tile < 1408) { W = p.w_in; Wt = (u16*)(ws + W_WTIN); N = 5632; tl = tile; }
      else if (tile < 1664) { W = p.w_branch_lru; Wt = (u16*)(ws + W_WTLRU); N = 1024; tl = tile - 1408; }
      else if (tile < 1920) { W = p.w_branch_attn; Wt = (u16*)(ws + W_WTATTN); N = 1024; tl = tile - 1664; }
      else if (tile < 2176) { W = p.w_out; Wt = (u16*)(ws + W_WTOUT); N = 1024; tl = tile - 1920; }
      else { W = p.peer_w_query; Wt = (u16*)(ws + W_WTQ); N = 2048; tl = tile - 2176; }
      const int ntn = N >> 6;
      const int kt = tl / ntn, nt = tl - kt * ntn;
      __syncthreads();
      {
        const float* src = W + (size_t)(kt * 64 + (tid >> 2)) * N + nt * 64 + (tid & 3) * 16;
        const float4 a0 = *(const float4*)src, a1 = *(const float4*)(src + 4), a2 = *(const float4*)(src + 8),
                     a3 = *(const float4*)(src + 12);
        float* d = T + (tid >> 2) * 65 + (tid & 3) * 16;
        d[0] = a0.x; d[1] = a0.y; d[2] = a0.z; d[3] = a0.w; d[4] = a1.x; d[5] = a1.y; d[6] = a1.z; d[7] = a1.w;
        d[8] = a2.x; d[9] = a2.y; d[10] = a2.z; d[11] = a2.w; d[12] = a3.x; d[13] = a3.y; d[14] = a3.z; d[15] = a3.w;
      }
      __syncthreads();
      {
        const int n = tid >> 2, kc = (tid & 3) * 16;
        float v[16];
#pragma unroll
        for (int i = 0; i < 16; i++) v[i] = T[(kc + i) * 65 + n];
        u16* dst = Wt + (size_t)(nt * 64 + n) * 1024 + kt * 64 + kc;
        *(uint4*)dst = pack8(v);
        *(uint4*)(dst + 8) = pack8(v + 8);
      }
    }
  }
  {
    u16* RA = (u16*)(ws + W_RGA);
    u16* RX = (u16*)(ws + W_RGX);
    for (size_t e = gtid; e < 65536; e += gsz) {
      int n = (int)(e >> 12), k = (int)((e >> 6) & 63), j = (int)(e & 63);
      RA[e] = f2bf(p.rg_w_a[n * 4096 + j * 64 + k]);
      RX[e] = f2bf(p.rg_w_x[n * 4096 + j * 64 + k]);
    }
  }
  plain_cvt(p.peer_sub_keys, (u16*)(ws + W_SK), (size_t)16 * 128 * 128, gtid, gsz);
  {
    const int lane = tid & 63;
    const int gw = (int)(gtid >> 6), nw = (int)(gsz >> 6);
    unsigned char* E8 = (unsigned char*)(ws + W_EU);
    float* ESC = (float*)(ws + W_ESC);
    for (int r = gw; r < 32768; r += nw) {
      const float* src = (r < 16384 ? p.expert_u : p.expert_v) + (size_t)(r & 16383) * 1024 + lane * 16;
      const float4 a0 = *(const float4*)src, a1 = *(const float4*)(src + 4), a2 = *(const float4*)(src + 8),
                   a3 = *(const float4*)(src + 12);
      float am = fmaxf(fmaxf(fmaxf(fabsf(a0.x), fabsf(a0.y)), fmaxf(fabsf(a0.z), fabsf(a0.w))),
                       fmaxf(fmaxf(fabsf(a1.x), fabsf(a1.y)), fmaxf(fabsf(a1.z), fabsf(a1.w))));
      am = fmaxf(am, fmaxf(fmaxf(fmaxf(fabsf(a2.x), fabsf(a2.y)), fmaxf(fabsf(a2.z), fabsf(a2.w))),
                           fmaxf(fmaxf(fabsf(a3.x), fabsf(a3.y)), fmaxf(fabsf(a3.z), fabsf(a3.w)))));
#pragma unroll
      for (int o = 32; o > 0; o >>= 1) am = fmaxf(am, __shfl_xor(am, o));
      const float sc = am > 0.f ? 224.f / am : 1.f;
      uint4 o4;
      int wv;
      wv = __builtin_amdgcn_cvt_pk_fp8_f32(a0.x * sc, a0.y * sc, 0, false);
      wv = __builtin_amdgcn_cvt_pk_fp8_f32(a0.z * sc, a0.w * sc, wv, true);
      o4.x = (uint32_t)wv;
      wv = __builtin_amdgcn_cvt_pk_fp8_f32(a1.x * sc, a1.y * sc, 0, false);
      wv = __builtin_amdgcn_cvt_pk_fp8_f32(a1.z * sc, a1.w * sc, wv, true);
      o4.y = (uint32_t)wv;
      wv = __builtin_amdgcn_cvt_pk_fp8_f32(a2.x * sc, a2.y * sc, 0, false);
      wv = __builtin_amdgcn_cvt_pk_fp8_f32(a2.z * sc, a2.w * sc, wv, true);
      o4.z = (uint32_t)wv;
      wv = __builtin_amdgcn_cvt_pk_fp8_f32(a3.x * sc, a3.y * sc, 0, false);
      wv = __builtin_amdgcn_cvt_pk_fp8_f32(a3.z * sc, a3.w * sc, wv, true);
      o4.w = (uint32_t)wv;
      if (r < 16384) *(uint4*)(E8 + (size_t)r * 1024 + lane * 16) = o4;
      else *(uint4*)(E8 + (size_t)16384 * 1024 + (size_t)(lane >> 3) * (16384 * 128) + (size_t)(r - 16384) * 128 + (lane & 7) * 16) = o4;
      if (lane == 0) ESC[r] = am > 0.f ? am * (1.f / 224.f) : 1.f;
    }
  }
}

constexpr int LDT = 72;
constexpr int CS_LD = 132;

template <int NW>
__device__ __forceinline__ void gemm_tile(const u16* __restrict__ A, int lda, const u16* __restrict__ Bt, int ldb,
                                          int K, f32x4 (&acc)[4][NW / 32], char* smem, int tid) {
  constexpr int NJ = NW / 32;
  const int lane = tid & 63, w = tid >> 6;
  const int wm = w >> 1, wn = w & 1;
  const int l15 = lane & 15, quad = lane >> 4;
  const int lr = w * 8 + (lane >> 3);
  const int lc = ((lane & 7) ^ ((lane >> 3) & 7)) * 8;
  const char* Ab = (const char*)A;
  const char* Bb = (const char*)Bt;
  const uint32_t ao = (uint32_t)(lr * lda + lc) * 2u, bo = (uint32_t)(lr * ldb + lc) * 2u;
  const uint32_t sa2 = 64u * (uint32_t)lda, sb2 = 64u * (uint32_t)ldb;
  const uint32_t kmask = (uint32_t)K - 1u, kst = (((uint32_t)blockIdx.x >> 3) * 64u) & kmask;
  char* lw = smem + w * 1024 + lane * 16;
  const int swz = l15 & 7;
  const char* Ar = smem + (wm * 64 + l15) * 128 + ((quad ^ swz) * 16);
  const char* Br = smem + 16384 + (wn * (NW / 2) + l15) * 128 + ((quad ^ swz) * 16);
  const char* Ar1 = smem + (wm * 64 + l15) * 128 + (((4 + quad) ^ swz) * 16);
  const char* Br1 = smem + 16384 + (wn * (NW / 2) + l15) * 128 + (((4 + quad) ^ swz) * 16);
#define GT_ISSUE(st, off)                                                                                   \
  {                                                                                                         \
    const uint32_t _o = (((uint32_t)(off) + kst) & kmask) * 2u;                                             \
    char* _l = lw + (st) * 32768;                                                                           \
    _Pragma("unroll") for (int j = 0; j < 4; j++) {                                                         \
      __builtin_amdgcn_global_load_lds((const unsigned*)(Ab + (size_t)(ao + j * sa2 + _o)), (unsigned*)(_l + j * 4096), 16, 0, 0);          \
      if (j < NJ) __builtin_amdgcn_global_load_lds((const unsigned*)(Bb + (size_t)(bo + j * sb2 + _o)), (unsigned*)(_l + 16384 + j * 4096), 16, 0, 0);  \
    }                                                                                                       \
  }
#define GT_MMA(st)                                                                                          \
  {                                                                                                         \
    const char* _ar = Ar + (st) * 32768; const char* _br = Br + (st) * 32768;                               \
    const char* _ar1 = Ar1 + (st) * 32768; const char* _br1 = Br1 + (st) * 32768;                           \
    bf16x8 a0[4], b0[NJ], a1[4], b1[NJ];                                                                      \
    _Pragma("unroll") for (int i = 0; i < 4; i++) {                                                         \
      a0[i] = *(const bf16x8*)(_ar + i * 2048);                                                             \
      if (i < NJ) b0[i] = *(const bf16x8*)(_br + i * 2048);                                                 \
    }                                                                                                       \
    _Pragma("unroll") for (int i = 0; i < 4; i++) {                                                         \
      a1[i] = *(const bf16x8*)(_ar1 + i * 2048);                                                            \
      if (i < NJ) b1[i] = *(const bf16x8*)(_br1 + i * 2048);                                                \
    }                                                                                                       \
    __builtin_amdgcn_s_setprio(1);                                                                          \
    _Pragma("unroll") for (int i = 0; i < 4; i++)                                                           \
      _Pragma("unroll") for (int j = 0; j < NJ; j++)                                                        \
        acc[i][j] = __builtin_amdgcn_mfma_f32_16x16x32_bf16(a0[i], b0[j], acc[i][j], 0, 0, 0);              \
    _Pragma("unroll") for (int i = 0; i < 4; i++)                                                           \
      _Pragma("unroll") for (int j = 0; j < NJ; j++)                                                        \
        acc[i][j] = __builtin_amdgcn_mfma_f32_16x16x32_bf16(a1[i], b1[j], acc[i][j], 0, 0, 0);              \
    __builtin_amdgcn_s_setprio(0);                                                                          \
  }
  __syncthreads();
  GT_ISSUE(0, 0);
  for (int k0 = 0; k0 < K; k0 += 128) {
    asm volatile("s_waitcnt vmcnt(0) lgkmcnt(0)" ::: "memory");
    __builtin_amdgcn_s_barrier();
    asm volatile("" ::: "memory");
    GT_ISSUE(1, k0 + 64);
    GT_MMA(0);
    asm volatile("s_waitcnt vmcnt(0) lgkmcnt(0)" ::: "memory");
    __builtin_amdgcn_s_barrier();
    asm volatile("" ::: "memory");
    if (k0 + 128 < K) GT_ISSUE(0, k0 + 128);
    GT_MMA(1);
  }
#undef GT_ISSUE
#undef GT_MMA
}

__device__ __forceinline__ void tile_map(int it, int total, int NT, int& mt, int& nt, int vb) {
  const int G = gridDim.x;
  int T = it;
  {
    const int round = it / G;
    if (round * G + G <= total) T = round * G + vb;
  }
  const int g = T / (8 * NT), r = T - g * (8 * NT);
  nt = r >> 3;
  mt = g * 8 + (r & 7);
}

template <int NJ>
__device__ __forceinline__ void zero_acc(f32x4 (&acc)[4][NJ]) {
#pragma unroll
  for (int i = 0; i < 4; i++)
#pragma unroll
    for (int j = 0; j < NJ; j++) acc[i][j] = (f32x4){0.f, 0.f, 0.f, 0.f};
}

template <int NJ>
__device__ __forceinline__ void acc_to_cs(const f32x4 (&acc)[4][NJ], float* Cs, int tid) {
  const int lane = tid & 63, w = tid >> 6;
  const int wm = w >> 1, wn = w & 1;
  const int l15 = lane & 15, quad = lane >> 4;
#pragma unroll
  for (int i = 0; i < 4; i++)
#pragma unroll
    for (int j = 0; j < NJ; j++)
#pragma unroll
      for (int e = 0; e < 4; e++)
        Cs[(wm * 64 + i * 16 + quad * 4 + e) * CS_LD + wn * (NJ * 16) + j * 16 + l15] = acc[i][j][e];
}

__device__ __forceinline__ void phase_g1(KParams& p, char* smem, int vb) {
  const int tid = opaque_tid();
  u16* As = (u16*)smem;
  u16* Bs = As + 2 * 128 * LDT;
  float* Cs = (float*)smem;
  const u16* XN = (const u16*)(p.ws + W_XN);
  const u16* WT = (const u16*)(p.ws + W_WTIN);
  for (int t = blockIdx.x; t < MT * 44; t += gridDim.x) {
    int mt, nt;
    tile_map(t, MT * 44, 44, mt, nt, vb);
    f32x4 acc[4][4];
    zero_acc(acc);
    gemm_tile<128>(XN + (size_t)mt * 128 * 1024, 1024, WT + (size_t)nt * 128 * 1024, 1024, 1024, acc, smem, tid);
    __syncthreads();
    acc_to_cs(acc, Cs, tid);
    __syncthreads();
    const int n0 = nt * 128;
    u16* dst;
    int ldd, col;
    if (n0 < 2048) { dst = (u16*)(p.ws + W_ZA); ldd = 2048; col = n0; }
    else if (n0 < 3584) { dst = (u16*)(p.ws + W_ZB); ldd = 1536; col = n0 - 2048; }
    else { dst = (u16*)p.out; ldd = 2048; col = n0 - 3584; }
    const int cc = (tid & 15) * 8;
#pragma unroll
    for (int i = 0; i < 8; i++) {
      const int r = (tid >> 4) + 16 * i;
      float4 a = *(const float4*)(Cs + r * CS_LD + cc), b = *(const float4*)(Cs + r * CS_LD + cc + 4);
      float v[8] = {a.x, a.y, a.z, a.w, b.x, b.y, b.z, b.w};
      *(uint4*)(dst + (size_t)(mt * 128 + r) * ldd + col + cc) = pack8(v);
    }
    __syncthreads();
  }
}

constexpr int KS_LD = 72, VT_LD = 200, PS_LD = 168;
__device__ __forceinline__ void attn_item(KParams& p, char* smem, int item) {
  const int tid = opaque_tid(), lane = tid & 63, w = tid >> 6, l15 = lane & 15, quad = lane >> 4;
  u16* Ks = (u16*)smem;
  u16* Vt = Ks + 192 * KS_LD;
  u16* Ps = Vt + 64 * VT_LD + w * 16 * PS_LD;
  const u16* ZB = (const u16*)(p.ws + W_ZB);
  u16* ATT = (u16*)(p.ws + W_XN);
  const bool sample = item >= 1024;
  int b, qb = 0, kv, rowbase, p0 = 0;
  if (!sample) {
    kv = item & 3; qb = (item >> 2) & 63; b = item >> 8;
    p0 = qb * 64;
    rowbase = b * SEQ + p0;
  } else {
    int it = item - 1024;
    kv = it & 3; b = it >> 2;
    rowbase = NP + b * 8;
  }
  __syncthreads();
  {
    const int ch = tid & 7;
    float kg[8];
#pragma unroll
    for (int i = 0; i < 8; i++) kg[i] = p.k_norm_g[ch * 8 + i];
    const int nrows = sample ? 160 : 192;
    for (int c = tid; c < nrows * 8; c += 256) {
      const int row = c >> 3;
      float kf[8], vf[8];
      bool valid, donorm;
      if (!sample) {
        const int pos = p0 - 128 + row;
        valid = pos >= 0;
        donorm = true;
        if (valid) {
          const u16* src = ZB + (size_t)(b * SEQ + pos) * 1536 + 1024 + kv * 64 + ch * 8;
          unpack8(*(const uint4*)src, kf);
          unpack8(*(const uint4*)(src + 256), vf);
        }
      } else {
        valid = row < 136;
        donorm = row >= 128;
        if (row < 128) {
          const float* sk = p.cache_k + ((size_t)(b * 128 + row) * 4 + kv) * 64 + ch * 8;
          const float* sv = p.cache_v + ((size_t)(b * 128 + row) * 4 + kv) * 64 + ch * 8;
          float4 a0 = *(const float4*)sk, a1 = *(const float4*)(sk + 4);
          float4 b0 = *(const float4*)sv, b1 = *(const float4*)(sv + 4);
          kf[0] = a0.x; kf[1] = a0.y; kf[2] = a0.z; kf[3] = a0.w; kf[4] = a1.x; kf[5] = a1.y; kf[6] = a1.z; kf[7] = a1.w;
          vf[0] = b0.x; vf[1] = b0.y; vf[2] = b0.z; vf[3] = b0.w; vf[4] = b1.x; vf[5] = b1.y; vf[6] = b1.z; vf[7] = b1.w;
        } else if (valid) {
          const u16* src = ZB + (size_t)(NP + b * 8 + (row - 128)) * 1536 + 1024 + kv * 64 + ch * 8;
          unpack8(*(const uint4*)src, kf);
          unpack8(*(const uint4*)(src + 256), vf);
        }
      }
      if (!valid) {
#pragma unroll
        for (int i = 0; i < 8; i++) { kf[i] = 0.f; vf[i] = 0.f; }
      }
      float ss = 0.f;
#pragma unroll
      for (int i = 0; i < 8; i++) ss += kf[i] * kf[i];
      ss += __shfl_xor(ss, 1);
      ss += __shfl_xor(ss, 2);
      ss += __shfl_xor(ss, 4);
      if (donorm) {
        const float rstd = rsqrtf(ss * (1.f / 64.f) + EPS);
#pragma unroll
        for (int i = 0; i < 8; i++) kf[i] = kf[i] * rstd * kg[i];
      }
      *(uint4*)(Ks + row * KS_LD + ch * 8) = pack8(kf);
#pragma unroll
      for (int i = 0; i < 8; i++) Vt[(ch * 8 + i) * VT_LD + row] = f2bf(vf[i]);
      if (!sample) {
        if (qb >= 62 && row >= 128) {
          const int wpos = p0 + (row - 128) - (SEQ - 128);
          float* ko = p.out + O_KP + ((size_t)(b * 128 + wpos) * 4 + kv) * 64 + ch * 8;
          float* vo = p.out + O_VP + ((size_t)(b * 128 + wpos) * 4 + kv) * 64 + ch * 8;
          *(float4*)ko = make_float4(kf[0], kf[1], kf[2], kf[3]);
          *(float4*)(ko + 4) = make_float4(kf[4], kf[5], kf[6], kf[7]);
          *(float4*)vo = make_float4(vf[0], vf[1], vf[2], vf[3]);
          *(float4*)(vo + 4) = make_float4(vf[4], vf[5], vf[6], vf[7]);
        }
      } else {
        if (row >= 8 && row < 136) {
          float* ko = p.out + O_KS + ((size_t)(b * 128 + (row - 8)) * 4 + kv) * 64 + ch * 8;
          float* vo = p.out + O_VS + ((size_t)(b * 128 + (row - 8)) * 4 + kv) * 64 + ch * 8;
          *(float4*)ko = make_float4(kf[0], kf[1], kf[2], kf[3]);
          *(float4*)(ko + 4) = make_float4(kf[4], kf[5], kf[6], kf[7]);
          *(float4*)vo = make_float4(vf[0], vf[1], vf[2], vf[3]);
          *(float4*)(vo + 4) = make_float4(vf[4], vf[5], vf[6], vf[7]);
        }
      }
    }
  }
  __syncthreads();
  const int hq = kv * 4 + w;
  const float slope = exp2f(-0.5f * (float)(hq + 1));
  const float sink = p.attn_sinks[hq];
  float qg[2][8];
#pragma unroll
  for (int ks = 0; ks < 2; ks++)
#pragma unroll
    for (int i = 0; i < 8; i++) qg[ks][i] = p.q_norm_g[ks * 32 + quad * 8 + i] * 0.125f;
  const int nsub = sample ? 1 : 4;
  for (int sb = 0; sb < nsub; sb++) {
    const int r0 = sb * 16;
    const int ws0 = r0 < 32 ? r0 : 32;
    bf16x8 qa[2];
    {
      const int qr = sample ? (l15 & 7) : (r0 + l15);
      const u16* src = ZB + (size_t)(rowbase + qr) * 1536 + hq * 64 + quad * 8;
      float q0[8], q1[8];
      unpack8(*(const uint4*)src, q0);
      unpack8(*(const uint4*)(src + 32), q1);
      float ss = 0.f;
#pragma unroll
      for (int i = 0; i < 8; i++) ss += q0[i] * q0[i] + q1[i] * q1[i];
      ss += __shfl_xor(ss, 16);
      ss += __shfl_xor(ss, 32);
      const float rstd = rsqrtf(ss * (1.f / 64.f) + EPS);
#pragma unroll
      for (int i = 0; i < 8; i++) { q0[i] *= rstd * qg[0][i]; q1[i] *= rstd * qg[1][i]; }
      uint4 u0 = pack8(q0), u1 = pack8(q1);
      qa[0] = __builtin_bit_cast(bf16x8, u0);
      qa[1] = __builtin_bit_cast(bf16x8, u1);
    }
    f32x4 s[10];
#pragma unroll
    for (int kt = 0; kt < 10; kt++) {
      const u16* kp = Ks + (ws0 + kt * 16 + l15) * KS_LD + quad * 8;
      bf16x8 b0 = *(const bf16x8*)kp, b1 = *(const bf16x8*)(kp + 32);
      f32x4 z = {0.f, 0.f, 0.f, 0.f};
      z = __builtin_amdgcn_mfma_f32_16x16x32_bf16(qa[0], b0, z, 0, 0, 0);
      s[kt] = __builtin_amdgcn_mfma_f32_16x16x32_bf16(qa[1], b1, z, 0, 0, 0);
    }
    float mx[4] = {-1e30f, -1e30f, -1e30f, -1e30f};
#pragma unroll
    for (int kt = 0; kt < 10; kt++) {
      const int jj = ws0 + kt * 16 + l15;
      const bool posok = sample ? (jj < 136) : (p0 - 128 + jj >= 0);
#pragma unroll
      for (int e = 0; e < 4; e++) {
        const int r = r0 + quad * 4 + e;
        const int dist = r + 128 - jj;
        const bool ok = posok && dist >= 0 && dist <= 128;
        float v = ok ? (s[kt][e] - slope * (float)dist) : -1e30f;
        s[kt][e] = v;
        mx[e] = fmaxf(mx[e], v);
      }
    }
    float sum[4];
#pragma unroll
    for (int e = 0; e < 4; e++) {
      float m = mx[e];
      m = fmaxf(m, __shfl_xor(m, 1));
      m = fmaxf(m, __shfl_xor(m, 2));
      m = fmaxf(m, __shfl_xor(m, 4));
      m = fmaxf(m, __shfl_xor(m, 8));
      m = fmaxf(m, sink);
      mx[e] = m;
      sum[e] = 0.f;
    }
#pragma unroll
    for (int kt = 0; kt < 10; kt++) {
#pragma unroll
      for (int e = 0; e < 4; e++) {
        float pv = __expf(s[kt][e] - mx[e]);
        sum[e] += pv;
        Ps[(quad * 4 + e) * PS_LD + kt * 16 + l15] = f2bf(pv);
      }
    }
#pragma unroll
    for (int e = 0; e < 4; e++) {
      float t = sum[e];
      t += __shfl_xor(t, 1);
      t += __shfl_xor(t, 2);
      t += __shfl_xor(t, 4);
      t += __shfl_xor(t, 8);
      sum[e] = 1.f / (t + __expf(sink - mx[e]));
    }
    __syncthreads();
    f32x4 o[4];
#pragma unroll
    for (int nt = 0; nt < 4; nt++) o[nt] = (f32x4){0.f, 0.f, 0.f, 0.f};
#pragma unroll
    for (int kk = 0; kk < 5; kk++) {
      bf16x8 pa = *(const bf16x8*)(Ps + l15 * PS_LD + kk * 32 + quad * 8);
#pragma unroll
      for (int nt = 0; nt < 4; nt++) {
        bf16x8 vb = *(const bf16x8*)(Vt + (nt * 16 + l15) * VT_LD + ws0 + kk * 32 + quad * 8);
        o[nt] = __builtin_amdgcn_mfma_f32_16x16x32_bf16(pa, vb, o[nt], 0, 0, 0);
      }
    }
#pragma unroll
    for (int e = 0; e < 4; e++) {
      const int r = quad * 4 + e;
      if (!sample || r < 8) {
        u16* dst = ATT + (size_t)(rowbase + r0 + r) * 1024 + hq * 64 + l15;
#pragma unroll
        for (int nt = 0; nt < 4; nt++) dst[nt * 16] = f2bf(o[nt][e] * sum[e]);
      }
    }
    __syncthreads();
  }
}

constexpr int XC_LD = 68;
__device__ __forceinline__ void lru_tile(KParams& p, char* smem, int mt, int nb, int mode) {
  const int tid = opaque_tid(), lane = tid & 63, w = tid >> 6, l15 = lane & 15, quad = lane >> 4;
  float* xcF = (float*)smem;
  float* aL = xcF + 128 * XC_LD;
  float* aggL = aL + 128 * XC_LD;
  const u16* ZA = (const u16*)(p.ws + W_ZA);
  const bool sample = mt >= 128;
  const int m0 = mt * 128;
  const int cb = nb * 64;
  __syncthreads();
  {
    const int ch = tid & 7;
    float cw[4][8], cbias[8];
#pragma unroll
    for (int j = 0; j < 4; j++)
#pragma unroll
      for (int i = 0; i < 8; i++) cw[j][i] = p.conv_w[j * 1024 + cb + ch * 8 + i];
#pragma unroll
    for (int i = 0; i < 8; i++) cbias[i] = p.conv_b[cb + ch * 8 + i];
#pragma unroll
    for (int it = 0; it < 4; it++) {
      const int r = (tid >> 3) + it * 32;
      const int grow = m0 + r;
      const int t = sample ? (r & 7) : ((mt & 31) * 128 + r);
      float y[8];
#pragma unroll
      for (int i = 0; i < 8; i++) y[i] = cbias[i];
#pragma unroll
      for (int d = 0; d < 4; d++) {
        float xv[8];
        if (t - d >= 0) {
          unpack8(*(const uint4*)(ZA + (size_t)(grow - d) * 2048 + cb + ch * 8), xv);
        } else if (sample) {
          const int bb = (m0 - NP + r) >> 3;
          const float* src = p.cache_conv + ((size_t)bb * 3 + (3 + t - d)) * 1024 + cb + ch * 8;
          float4 a = *(const float4*)src, b4 = *(const float4*)(src + 4);
          xv[0] = a.x; xv[1] = a.y; xv[2] = a.z; xv[3] = a.w; xv[4] = b4.x; xv[5] = b4.y; xv[6] = b4.z; xv[7] = b4.w;
        } else {
#pragma unroll
          for (int i = 0; i < 8; i++) xv[i] = 0.f;
        }
#pragma unroll
        for (int i = 0; i < 8; i++) y[i] += cw[3 - d][i] * xv[i];
        if (d == 0 && mode == 1) {
          if (!sample) {
            if ((mt & 31) == 31 && r >= 125) {
              float* dst = p.out + O_CONVP + ((size_t)(mt >> 5) * 3 + (r - 125)) * 1024 + cb + ch * 8;
              *(float4*)dst = make_float4(xv[0], xv[1], xv[2], xv[3]);
              *(float4*)(dst + 4) = make_float4(xv[4], xv[5], xv[6], xv[7]);
            }
          } else if (t >= 5) {
            const int bb = (m0 - NP + r) >> 3;
            float* dst = p.out + O_CONVS + ((size_t)bb * 3 + (t - 5)) * 1024 + cb + ch * 8;
            *(float4*)dst = make_float4(xv[0], xv[1], xv[2], xv[3]);
            *(float4*)(dst + 4) = make_float4(xv[4], xv[5], xv[6], xv[7]);
          }
        }
      }
      *(float4*)(xcF + r * XC_LD + ch * 8) = make_float4(y[0], y[1], y[2], y[3]);
      *(float4*)(xcF + r * XC_LD + ch * 8 + 4) = make_float4(y[4], y[5], y[6], y[7]);
    }
  }
  __syncthreads();
  {
    const u16* RA = (const u16*)(p.ws + W_RGA) + nb * 4096;
    const u16* RX = (const u16*)(p.ws + W_RGX) + nb * 4096;
    f32x4 aR[2][4], aI[2][4];
#pragma unroll
    for (int i = 0; i < 2; i++)
#pragma unroll
      for (int j = 0; j < 4; j++) { aR[i][j] = (f32x4){0.f, 0.f, 0.f, 0.f}; aI[i][j] = (f32x4){0.f, 0.f, 0.f, 0.f}; }
#pragma unroll
    for (int ks = 0; ks < 2; ks++) {
      bf16x8 a[2];
#pragma unroll
      for (int i = 0; i < 2; i++) {
        const float* src = xcF + (w * 32 + i * 16 + l15) * XC_LD + ks * 32 + quad * 8;
        float4 x0 = *(const float4*)src, x1 = *(const float4*)(src + 4);
        float v[8] = {x0.x, x0.y, x0.z, x0.w, x1.x, x1.y, x1.z, x1.w};
        uint4 u = pack8(v);
        a[i] = __builtin_bit_cast(bf16x8, u);
      }
#pragma unroll
      for (int j = 0; j < 4; j++) {
        bf16x8 ba = *(const bf16x8*)(RA + (j * 16 + l15) * 64 + ks * 32 + quad * 8);
        bf16x8 bx = *(const bf16x8*)(RX + (j * 16 + l15) * 64 + ks * 32 + quad * 8);
#pragma unroll
        for (int i = 0; i < 2; i++) {
          aR[i][j] = __builtin_amdgcn_mfma_f32_16x16x32_bf16(a[i], ba, aR[i][j], 0, 0, 0);
          aI[i][j] = __builtin_amdgcn_mfma_f32_16x16x32_bf16(a[i], bx, aI[i][j], 0, 0, 0);
        }
      }
    }
#pragma unroll
    for (int j = 0; j < 4; j++) {
      const int c = cb + j * 16 + l15;
      const float ba = p.rg_b_a[c], bx = p.rg_b_x[c];
      const float ls = -log1pf(__expf(-p.rg_lambda[c]));
#pragma unroll
      for (int i = 0; i < 2; i++)
#pragma unroll
        for (int e = 0; e < 4; e++) {
          const int row = w * 32 + i * 16 + quad * 4 + e;
          const float rg = sigmoidf_(aR[i][j][e] + ba);
          const float ig = sigmoidf_(aI[i][j][e] + bx);
          const float la = 8.f * rg * ls;
          const float av = __expf(la);
          const float x2 = 2.f * la;
          const float emt = -x2 * (1.f + x2 * (0.5f + x2 * (0.16666667f + x2 * (0.041666668f + x2 * 0.008333334f))));
          const float em = x2 > -0.25f ? emt : 1.f - __expf(x2);
          const float mult = __builtin_amdgcn_sqrtf(fmaxf(em, 0.f));
          const int idx = row * XC_LD + j * 16 + l15;
          const float xv = xcF[idx];
          aL[idx] = av;
          xcF[idx] = mult * ig * xv;
        }
    }
  }
  __syncthreads();
  const int c = cb + lane;
  float* carL = aggL + 512;
  if (!sample) {
    float* AGGP = (float*)(p.ws + W_AGG);
    float* AGGH = AGGP + 128 * 1024;
    const int chunk = mt & 31, base = mt - chunk;
    if (mode == 1) {
      float Pq[8], Hq[8];
#pragma unroll
      for (int k = 0; k < 8; k++) {
        const int q = w * 8 + k;
        const bool ok = q < chunk;
        Pq[k] = ok ? AGGP[(base + q) * 1024 + c] : 1.f;
        Hq[k] = ok ? AGGH[(base + q) * 1024 + c] : 0.f;
      }
      float Pc = 1.f, hc = 0.f;
#pragma unroll
      for (int k = 0; k < 8; k++) { hc = Pq[k] * hc + Hq[k]; Pc *= Pq[k]; }
      carL[(w * 64 + lane) * 2] = Pc;
      carL[(w * 64 + lane) * 2 + 1] = hc;
    }
    float P = 1.f, h = 0.f;
#pragma unroll 8
    for (int rr = 0; rr < 32; rr++) {
      const float av = aL[(w * 32 + rr) * XC_LD + lane], bv = xcF[(w * 32 + rr) * XC_LD + lane];
      h = av * h + bv;
      P *= av;
    }
    aggL[(w * 64 + lane) * 2] = P;
    aggL[(w * 64 + lane) * 2 + 1] = h;
    __syncthreads();
    if (mode == 0) {
      if (w == 0) {
        float Pt = 1.f, ht = 0.f;
#pragma unroll
        for (int q = 0; q < 4; q++) {
          const float Pq = aggL[(q * 64 + lane) * 2], hq = aggL[(q * 64 + lane) * 2 + 1];
          ht = Pq * ht + hq;
          Pt *= Pq;
        }
        AGGP[mt * 1024 + c] = Pt;
        AGGH[mt * 1024 + c] = ht;
      }
    } else {
      float hin = 0.f;
#pragma unroll
      for (int q = 0; q < 4; q++) hin = carL[(q * 64 + lane) * 2] * hin + carL[(q * 64 + lane) * 2 + 1];
      for (int q = 0; q < w; q++) hin = aggL[(q * 64 + lane) * 2] * hin + aggL[(q * 64 + lane) * 2 + 1];
      float hh = hin;
#pragma unroll 8
      for (int rr = 0; rr < 32; rr++) {
        const int row = w * 32 + rr;
        const float av = aL[row * XC_LD + lane], bv = xcF[row * XC_LD + lane];
        hh = av * hh + bv;
        xcF[row * XC_LD + lane] = hh;
      }
      if (chunk == 31 && w == 3) p.out[O_LRUP + (size_t)(mt >> 5) * 1024 + c] = hh;
    }
  } else {
    float hh = 0.f;
    float h0v[4];
#pragma unroll
    for (int k = 0; k < 4; k++) h0v[k] = p.state_lru[(size_t)(((m0 - NP + w * 32) >> 3) + k) * 1024 + c];
#pragma unroll
    for (int rr = 0; rr < 32; rr++) {
      const int row = w * 32 + rr;
      const int bb = (m0 - NP + row) >> 3;
      const int t = row & 7;
      if (t == 0) hh = h0v[rr >> 3];
      const float av = aL[row * XC_LD + lane], bv = xcF[row * XC_LD + lane];
      hh = av * hh + bv;
      xcF[row * XC_LD + lane] = hh;
      if (t == 7) p.out[O_LRUS + (size_t)bb * 1024 + c] = hh;
    }
  }
  if (mode == 1) {
    __syncthreads();
    u16* LO = (u16*)(p.ws + W_ZB);
    const int ch = tid & 7;
#pragma unroll
    for (int it = 0; it < 4; it++) {
      const int r = (tid >> 3) + it * 32;
      float g[8];
      unpack8(*(const uint4*)(ZA + (size_t)(m0 + r) * 2048 + 1024 + cb + ch * 8), g);
      const float4 h0 = *(const float4*)(xcF + r * XC_LD + ch * 8), h1 = *(const float4*)(xcF + r * XC_LD + ch * 8 + 4);
      float v[8] = {h0.x * gelu_tanh(g[0]), h0.y * gelu_tanh(g[1]), h0.z * gelu_tanh(g[2]), h0.w * gelu_tanh(g[3]),
                    h1.x * gelu_tanh(g[4]), h1.y * gelu_tanh(g[5]), h1.z * gelu_tanh(g[6]), h1.w * gelu_tanh(g[7])};
      *(uint4*)(LO + (size_t)(m0 + r) * 1024 + cb + ch * 8) = pack8(v);
    }
  }
}

template <int NW>
__device__ __forceinline__ void g3_tile(KParams& p, char* smem, int mt, int n0) {
  const int tid = opaque_tid();
  float* Cs = (float*)smem;
  const u16* LO = (const u16*)(p.ws + W_ZB);
  const u16* ATT = (const u16*)(p.ws + W_XN);
  const u16* WL = (const u16*)(p.ws + W_WTLRU);
  const u16* WA = (const u16*)(p.ws + W_WTATTN);
  const u16* ZC = (const u16*)p.out;
  u16* MG = (u16*)(p.ws + W_ZA);
  constexpr int TPR = NW / 8;
  constexpr int RPI = 256 / TPR;
  const int cc = (tid % TPR) * 8;
#pragma unroll
  for (int pass = 0; pass < 2; pass++) {
    f32x4 acc[4][NW / 32];
    zero_acc(acc);
    gemm_tile<NW>((pass ? ATT : LO) + (size_t)mt * 128 * 1024, 1024, (pass ? WA : WL) + (size_t)n0 * 1024, 1024, 1024, acc,
                  smem, tid);
    __syncthreads();
    acc_to_cs(acc, Cs, tid);
    __syncthreads();
#pragma unroll
    for (int i = 0; i < 128 / RPI; i++) {
      const int r = (tid / TPR) + RPI * i;
      const size_t row = (size_t)(mt * 128 + r);
      float4 a = *(const float4*)(Cs + r * CS_LD + cc), b = *(const float4*)(Cs + r * CS_LD + cc + 4);
      float v[8] = {a.x, a.y, a.z, a.w, b.x, b.y, b.z, b.w};
      float g[8];
      unpack8(*(const uint4*)(ZC + row * 2048 + pass * 1024 + n0 + cc), g);
      u16* mp = MG + row * 1024 + n0 + cc;
      if (pass == 0) {
#pragma unroll
        for (int q = 0; q < 8; q++) v[q] *= sigmoidf_(g[q]);
      } else {
        float pv[8];
        unpack8(*(const uint4*)mp, pv);
#pragma unroll
        for (int q = 0; q < 8; q++) v[q] = pv[q] + v[q] * sigmoidf_(g[q]);
      }
      *(uint4*)mp = pack8(v);
    }
    __syncthreads();
  }
}

__device__ __forceinline__ void phase_g3(KParams& p, char* smem, int vb) {
  for (int it = blockIdx.x; it < 1024 + 128; it += gridDim.x) {
    int mt, nt;
    if (it < 1024) {
      tile_map(it, MT * 8, 8, mt, nt, vb);
      g3_tile<128>(p, smem, mt, nt * 128);
    } else {
      tile_map(1024 + ((it - 1024) >> 1), MT * 8, 8, mt, nt, vb);
      g3_tile<64>(p, smem, mt, nt * 128 + ((it - 1024) & 1) * 64);
    }
  }
}

template <int NW>
__device__ __forceinline__ void g4_tile(KParams& p, char* smem, int mt, int n0) {
  const int tid = opaque_tid();
  float* Cs = (float*)smem;
  const u16* MG = (const u16*)(p.ws + W_ZA);
  const u16* WO = (const u16*)(p.ws + W_WTOUT);
  u16* HG = (u16*)(p.ws + W_ZB);
  float* SSQ = (float*)(p.ws + W_SSQ);
  constexpr int TPR = NW / 8;
  constexpr int RPI = 256 / TPR;
  f32x4 acc[4][NW / 32];
  zero_acc(acc);
  gemm_tile<NW>(MG + (size_t)mt * 128 * 1024, 1024, WO + (size_t)n0 * 1024, 1024, 1024, acc, smem, tid);
  __syncthreads();
  acc_to_cs(acc, Cs, tid);
  __syncthreads();
  const int cc = (tid % TPR) * 8;
  const float4 g0 = *(const float4*)(p.norm2_g + n0 + cc), g1 = *(const float4*)(p.norm2_g + n0 + cc + 4);
#pragma unroll
  for (int i = 0; i < 128 / RPI; i++) {
    const int r = (tid / TPR) + RPI * i;
    const int row = mt * 128 + r;
    float4 a = *(const float4*)(Cs + r * CS_LD + cc), b = *(const float4*)(Cs + r * CS_LD + cc + 4);
    const float* xr = xrow(p, row) + n0 + cc;
    float4 x0 = *(const float4*)xr, x1 = *(const float4*)(xr + 4);
    a.x += x0.x; a.y += x0.y; a.z += x0.z; a.w += x0.w;
    b.x += x1.x; b.y += x1.y; b.z += x1.z; b.w += x1.w;
    float* ho = p.out + O_Y + (size_t)row * 1024 + n0 + cc;
    *(float4*)ho = a;
    *(float4*)(ho + 4) = b;
    float v[8] = {a.x * g0.x, a.y * g0.y, a.z * g0.z, a.w * g0.w, b.x * g1.x, b.y * g1.y, b.z * g1.z, b.w * g1.w};
    *(uint4*)(HG + (size_t)row * 1024 + n0 + cc) = pack8(v);
    float ss = a.x * a.x + a.y * a.y + a.z * a.z + a.w * a.w + b.x * b.x + b.y * b.y + b.z * b.z + b.w * b.w;
    ss += __shfl_xor(ss, 1);
    ss += __shfl_xor(ss, 2);
    ss += __shfl_xor(ss, 4);
    if ((tid & 7) == 0) SSQ[(size_t)row * 16 + ((n0 + cc) >> 6)] = ss;
  }
  __syncthreads();
}

__device__ __forceinline__ void phase_g4(KParams& p, char* smem, int vb) {
  for (int it = blockIdx.x; it < 1024 + 128; it += gridDim.x) {
    int mt, nt;
    if (it < 1024) {
      tile_map(it, MT * 8, 8, mt, nt, vb);
      g4_tile<128>(p, smem, mt, nt * 128);
    } else {
      tile_map(1024 + ((it - 1024) >> 1), MT * 8, 8, mt, nt, vb);
      g4_tile<64>(p, smem, mt, nt * 128 + ((it - 1024) & 1) * 64);
    }
  }
}

__device__ __forceinline__ float row_rstd(const float* SSQ, int row) {
  const float4 a = *(const float4*)(SSQ + (size_t)row * 16), b = *(const float4*)(SSQ + (size_t)row * 16 + 4),
               c = *(const float4*)(SSQ + (size_t)row * 16 + 8), d = *(const float4*)(SSQ + (size_t)row * 16 + 12);
  const float ss = (((a.x + a.y) + (a.z + a.w)) + ((b.x + b.y) + (b.z + b.w))) +
                   (((c.x + c.y) + (c.z + c.w)) + ((d.x + d.y) + (d.z + d.w)));
  return rsqrtf(ss * (1.f / 1024.f) + EPS);
}

template <int NW>
__device__ __forceinline__ void g5_tile(KParams& p, char* smem, int mt, int n0) {
  const int tid = opaque_tid();
  float* Cs = (float*)smem;
  const u16* HG = (const u16*)(p.ws + W_ZB);
  const u16* WQ = (const u16*)(p.ws + W_WTQ);
  const float* SSQ = (const float*)(p.ws + W_SSQ);
  u16* QR = (u16*)(p.ws + W_ZA);
  constexpr int TPR = NW / 8;
  constexpr int RPI = 256 / TPR;
  f32x4 acc[4][NW / 32];
  zero_acc(acc);
  gemm_tile<NW>(HG + (size_t)mt * 128 * 1024, 1024, WQ + (size_t)n0 * 1024, 1024, 1024, acc, smem, tid);
  __syncthreads();
  acc_to_cs(acc, Cs, tid);
  __syncthreads();
  const int cc = (tid % TPR) * 8;
#pragma unroll
  for (int i = 0; i < 128 / RPI; i++) {
    const int r = (tid / TPR) + RPI * i;
    const int row = mt * 128 + r;
    const float rs = row_rstd(SSQ, row);
    float4 a = *(const float4*)(Cs + r * CS_LD + cc), b = *(const float4*)(Cs + r * CS_LD + cc + 4);
    float v[8] = {a.x * rs, a.y * rs, a.z * rs, a.w * rs, b.x * rs, b.y * rs, b.z * rs, b.w * rs};
    *(uint4*)(QR + (size_t)row * 2048 + n0 + cc) = pack8(v);
  }
  __syncthreads();
}

__device__ __forceinline__ void phase_g5(KParams& p, char* smem, int vb) {
  for (int it = blockIdx.x; it < 2048 + 256; it += gridDim.x) {
    int mt, nt;
    if (it < 2048) {
      tile_map(it, MT * 16, 16, mt, nt, vb);
      g5_tile<128>(p, smem, mt, nt * 128);
    } else {
      tile_map(2048 + ((it - 2048) >> 1), MT * 16, 16, mt, nt, vb);
      g5_tile<64>(p, smem, mt, nt * 128 + ((it - 2048) & 1) * 64);
    }
  }
}

__device__ __forceinline__ void phase_g6(KParams& p, char* smem, int vb) {
  const int tid = opaque_tid();
  u16* As = (u16*)smem;
  u16* Bs = As + 2 * 128 * LDT;
  float* Cs = (float*)smem;
  uint32_t* Cu = (uint32_t*)smem;
  uint32_t* TK0 = (uint32_t*)(smem + 128 * CS_LD * 4);
  const u16* QR = (const u16*)(p.ws + W_ZA);
  const u16* SK = (const u16*)(p.ws + W_SK);
  int* IDX = (int*)(p.ws + W_XN);
  float* GW = (float*)(p.ws + W_XN + (size_t)NTOK * 128 * 4);
  const int row = tid >> 1, half = tid & 1;
  for (int t = blockIdx.x; t < MT * 8; t += gridDim.x) {
    int mt, h;
    tile_map(t, MT * 8, 8, mt, h, vb);
    uint32_t tk[16];
    for (int pp = 0; pp < 2; pp++) {
      f32x4 acc[4][4];
      zero_acc(acc);
      gemm_tile<128>(QR + (size_t)mt * 128 * 2048 + h * 256 + pp * 128, 2048, SK + (size_t)(h * 2 + pp) * 16384, 128, 128, acc,
                smem, tid);
      __syncthreads();
      acc_to_cs(acc, Cs, tid);
      __syncthreads();
#pragma unroll
      for (int g = 0; g < 4; g++) {
        uint32_t sg[16];
#pragma unroll
        for (int q4 = 0; q4 < 4; q4++) {
          const int col = half * 64 + g * 16 + q4 * 4;
          const float4 v = *(const float4*)(Cs + row * CS_LD + col);
          sg[q4 * 4 + 0] = (ordf(v.x) & ~0x7Fu) | (uint32_t)(127 - col);
          sg[q4 * 4 + 1] = (ordf(v.y) & ~0x7Fu) | (uint32_t)(126 - col);
          sg[q4 * 4 + 2] = (ordf(v.z) & ~0x7Fu) | (uint32_t)(125 - col);
          sg[q4 * 4 + 3] = (ordf(v.w) & ~0x7Fu) | (uint32_t)(124 - col);
        }
        sort16_desc(sg);
        if (g == 0) {
#pragma unroll
          for (int q = 0; q < 16; q++) tk[q] = sg[q];
        } else {
          merge16_desc(tk, sg);
        }
      }
      __syncthreads();
      if (half == 1) {
#pragma unroll
        for (int q = 0; q < 16; q++) Cu[row * 16 + q] = tk[q];
      }
      __syncthreads();
      if (half == 0) {
        {
          uint32_t sg[16];
#pragma unroll
          for (int q4 = 0; q4 < 4; q4++) {
            const uint4 u = *(const uint4*)(Cu + row * 16 + q4 * 4);
            sg[q4 * 4] = u.x; sg[q4 * 4 + 1] = u.y; sg[q4 * 4 + 2] = u.z; sg[q4 * 4 + 3] = u.w;
          }
          merge16_desc(tk, sg);
        }
        if (pp == 0) {
#pragma unroll
          for (int q = 0; q < 16; q++) TK0[row * 16 + q] = tk[q];
        } else {
#pragma unroll
          for (int q = 0; q < 16; q++) Cu[2048 + row * 16 + q] = tk[q];
        }
      }
      __syncthreads();
    }
    if (half == 0) {
      float va[16], vb[16];
#pragma unroll
      for (int q = 0; q < 16; q++) {
        va[q] = unordf(TK0[row * 16 + q] & ~0x7Fu);
        vb[q] = unordf(tk[q] & ~0x7Fu);
      }
      uint32_t cd[16];
#pragma unroll
      for (int q = 0; q < 16; q++) cd[q] = (ordf(va[0] + vb[q]) & ~0xFFu) | (uint32_t)(255 - q);
#pragma unroll
      for (int i = 1; i < 16; i++) {
#pragma unroll
        for (int j = 0; j < 16; j++) {
          if ((i + 1) * (j + 1) <= 16) {
            const float sv = va[i] + vb[j];
            const uint32_t key = (ordf(sv) & ~0xFFu) | (uint32_t)(255 - (i * 16 + j));
            INS16(cd, key);
          }
        }
      }
      float ev[16];
      const float m0v = unordf(cd[0] & ~0xFFu);
      float esum = 0.f;
#pragma unroll
      for (int q = 0; q < 16; q++) {
        ev[q] = __expf(unordf(cd[q] & ~0xFFu) - m0v);
        esum += ev[q];
      }
      const float inv = 1.f / esum;
      const size_t ob = (size_t)(mt * 128 + row) * 128 + h * 16;
#pragma unroll
      for (int q = 0; q < 16; q++) {
        const int ij = 255 - (int)(cd[q] & 0xFFu);
        const int i0 = 127 - (int)(TK0[row * 16 + (ij >> 4)] & 0x7Fu);
        const int i1 = 127 - (int)(Cu[2048 + row * 16 + (ij & 15)] & 0x7Fu);
        IDX[ob + q] = i0 * 128 + i1;
        GW[ob + q] = ev[q] * inv;
      }
    }
    __syncthreads();
  }
}

typedef __attribute__((ext_vector_type(2))) float f32x2;
__device__ __forceinline__ void dec16(uint4 u, float* v) {
  f32x2 t;
  t = __builtin_amdgcn_cvt_pk_f32_fp8((int)u.x, false); v[0] = t.x; v[1] = t.y;
  t = __builtin_amdgcn_cvt_pk_f32_fp8((int)u.x, true); v[2] = t.x; v[3] = t.y;
  t = __builtin_amdgcn_cvt_pk_f32_fp8((int)u.y, false); v[4] = t.x; v[5] = t.y;
  t = __builtin_amdgcn_cvt_pk_f32_fp8((int)u.y, true); v[6] = t.x; v[7] = t.y;
  t = __builtin_amdgcn_cvt_pk_f32_fp8((int)u.z, false); v[8] = t.x; v[9] = t.y;
  t = __builtin_amdgcn_cvt_pk_f32_fp8((int)u.z, true); v[10] = t.x; v[11] = t.y;
  t = __builtin_amdgcn_cvt_pk_f32_fp8((int)u.w, false); v[12] = t.x; v[13] = t.y;
  t = __builtin_amdgcn_cvt_pk_f32_fp8((int)u.w, true); v[14] = t.x; v[15] = t.y;
}

__device__ __forceinline__ void phase7(KParams& p) {
  const int tid = opaque_tid(), lane = tid & 63, w = tid >> 6;
  const u16* HG = (const u16*)(p.ws + W_ZB);
  const float* SSQ = (const float*)(p.ws + W_SSQ);
  const int* IDX = (const int*)(p.ws + W_XN);
  const float* GW = (const float*)(p.ws + W_XN + (size_t)NTOK * 128 * 4);
  const unsigned char* EU = (const unsigned char*)(p.ws + W_EU);
  const unsigned char* EV = (const unsigned char*)(p.ws + W_EV);
  const float* ESC = (const float*)(p.ws + W_ESC);
  const int b0 = lane & 1, b1 = (lane >> 1) & 1, b2 = (lane >> 2) & 1;
  for (int tok = blockIdx.x * 4 + w; tok < NTOK; tok += gridDim.x * 4) {
    const float rs = row_rstd(SSQ, tok);
    float xh[16];
    {
      const uint4* hp = (const uint4*)(HG + (size_t)tok * 1024 + lane * 16);
      unpack8(hp[0], xh);
      unpack8(hp[1], xh + 8);
#pragma unroll
      for (int i = 0; i < 16; i++) xh[i] *= rs;
    }
    const int iA = IDX[(size_t)tok * 128 + lane], iB = IDX[(size_t)tok * 128 + 64 + lane];
    const float gA = GW[(size_t)tok * 128 + lane] * ESC[16384 + iA], gB = GW[(size_t)tok * 128 + 64 + lane] * ESC[16384 + iB];
    const float suA = ESC[iA], suB = ESC[iB];
    float dA = 0.f, dB = 0.f;
#pragma unroll 2
    for (int bb = 0; bb < 16; bb++) {
      const int isrc = bb < 8 ? iA : iB;
      float d[8];
      uint4 ur[8];
#pragma unroll
      for (int k = 0; k < 8; k++) {
        const int id = __builtin_amdgcn_readlane(isrc, (bb & 7) * 8 + k);
        ur[k] = *(const uint4*)(EU + (size_t)id * 1024 + lane * 16);
      }
#pragma unroll
      for (int k = 0; k < 8; k++) {
        float uv[16];
        dec16(ur[k], uv);
        float sacc = 0.f;
#pragma unroll
        for (int i = 0; i < 16; i++) sacc += xh[i] * uv[i];
        d[k] = sacc;
      }
      float e4[4], e2[2], e1;
#pragma unroll
      for (int i = 0; i < 4; i++) {
        const float keep = b0 ? d[2 * i + 1] : d[2 * i];
        const float send = b0 ? d[2 * i] : d[2 * i + 1];
        e4[i] = keep + __shfl_xor(send, 1);
      }
#pragma unroll
      for (int i = 0; i < 2; i++) {
        const float keep = b1 ? e4[2 * i + 1] : e4[2 * i];
        const float send = b1 ? e4[2 * i] : e4[2 * i + 1];
        e2[i] = keep + __shfl_xor(send, 2);
      }
      {
        const float keep = b2 ? e2[1] : e2[0];
        const float send = b2 ? e2[0] : e2[1];
        e1 = keep + __shfl_xor(send, 4);
      }
      e1 += __shfl_xor(e1, 8);
      e1 += __shfl_xor(e1, 16);
      e1 += __shfl_xor(e1, 32);
      const bool mine = (lane >> 3) == (bb & 7);
      if (bb < 8) dA = mine ? e1 : dA; else dB = mine ? e1 : dB;
    }
    const float actA = gelu_tanh(dA * suA) * gA, actB = gelu_tanh(dB * suB) * gB;
    float* ACT = (float*)(p.ws + W_ACT);
    ACT[(size_t)tok * 128 + lane] = actA;
    ACT[(size_t)tok * 128 + 64 + lane] = actB;
  }
}

__device__ __forceinline__ void phase7b(KParams& p) {
  const int tid = opaque_tid(), lane = tid & 63;
  const char* IDXb = (const char*)(p.ws + W_XN);
  const char* ACTb = (const char*)(p.ws + W_ACT);
  const char* EVb = (const char*)(p.ws + W_EV);
  char* Yb = (char*)(p.out + O_Y);
  unsigned* Q = (unsigned*)(p.ws + W_Q);
  const int esub = lane >> 3, c = lane & 7;
  const int pref = (int)(hw_xcc_id() & 7u);
  const int b3 = (lane >> 3) & 1, b4 = (lane >> 4) & 1, b5 = (lane >> 5) & 1;
  const uint32_t lane4 = (uint32_t)lane * 4u;
  const uint32_t yl = (uint32_t)(c * 16 + b3 * 8 + b4 * 4 + b5 * 2) * 4u;
  for (int k = 0; k < 8; k++) {
    const int sl = (pref + k) & 7;
    const char* Vs = EVb + (size_t)sl * (16384 * 128);
    const uint32_t vl = (uint32_t)c * 16u;
    for (;;) {
      unsigned it = 0;
      if (lane == 0) it = atomicAdd(Q + sl * 64, 1u);
      it = (unsigned)__builtin_amdgcn_readfirstlane((int)it);
      if (it >= (unsigned)(NTOK / 8)) break;
      const int tok0 = (int)it * 8;
      const char* ib = IDXb + (size_t)tok0 * 512;
      const char* ab = ACTb + (size_t)tok0 * 512;
      char* yb = Yb + (size_t)tok0 * 4096 + sl * 512;
      int nidA = *(const int*)(ib + lane4), nidB = *(const int*)(ib + 256 + lane4);
      float nacA = *(const float*)(ab + lane4), nacB = *(const float*)(ab + 256 + lane4);
      float2 nyv = *(const float2*)(yb + yl);
#pragma unroll 1
      for (int t = 0; t < 8; t++) {
        const int idA = nidA, idB = nidB;
        const float acA = nacA, acB = nacB;
        const float2 yv = nyv;
        char* ybt = yb;
        if (t < 7) {
          ib += 512; ab += 512; yb += 4096;
          nidA = *(const int*)(ib + lane4); nidB = *(const int*)(ib + 256 + lane4);
          nacA = *(const float*)(ab + lane4); nacB = *(const float*)(ab + 256 + lane4);
          nyv = *(const float2*)(yb + yl);
        }
        float o[16];
#pragma unroll
        for (int q = 0; q < 16; q++) o[q] = 0.f;
#pragma unroll
        for (int hf = 0; hf < 2; hf++) {
          uint4 vr[8];
#pragma unroll
          for (int i = 0; i < 8; i++) {
            const uint32_t id = (uint32_t)__shfl(hf ? idB : idA, i * 8 + esub);
            vr[i] = *(const uint4*)(Vs + (id * 128u + vl));
          }
#pragma unroll
          for (int i = 0; i < 8; i++) {
            float vv[16];
            dec16(vr[i], vv);
            const float a = __shfl(hf ? acB : acA, i * 8 + esub);
#pragma unroll
            for (int q = 0; q < 16; q++) o[q] += a * vv[q];
          }
        }
        float r8[8], r4[4], r2[2];
#pragma unroll
        for (int q = 0; q < 8; q++) {
          const float keep = b3 ? o[q + 8] : o[q];
          const float send = b3 ? o[q] : o[q + 8];
          r8[q] = keep + __shfl_xor(send, 8);
        }
#pragma unroll
        for (int q = 0; q < 4; q++) {
          const float keep = b4 ? r8[q + 4] : r8[q];
          const float send = b4 ? r8[q] : r8[q + 4];
          r4[q] = keep + __shfl_xor(send, 16);
        }
#pragma unroll
        for (int q = 0; q < 2; q++) {
          const float keep = b5 ? r4[q + 2] : r4[q];
          const float send = b5 ? r4[q] : r4[q + 2];
          r2[q] = keep + __shfl_xor(send, 32);
        }
        float2 h = yv;
        h.x += r2[0];
        h.y += r2[1];
        *(float2*)(ybt + yl) = h;
      }
    }
  }
}

#define XB_TMO      128
#define XB_XCNT(j)  (256  + 64 * (j))
#define XB_XSUB(j)  (1280 + 64 * (j))
#define XB_XGEN(j)  (2304 + 64 * (j))
#define XB_TOP      3328
#define XB_TOPGEN   3392
#define XCD_BAR_WORDS 3456
#define XB_SPIN_CAP (1u << 18)
#define LAS __attribute__((address_space(3)))
__device__ __forceinline__ unsigned xb_ld(unsigned* p) { return __hip_atomic_load(p, __ATOMIC_RELAXED, __HIP_MEMORY_SCOPE_AGENT); }
__device__ __forceinline__ unsigned xb_add(unsigned* p, unsigned v) { return __hip_atomic_fetch_add(p, v, __ATOMIC_RELAXED, __HIP_MEMORY_SCOPE_AGENT); }
__device__ __forceinline__ unsigned xb_xcc_id() { return (unsigned)__builtin_amdgcn_s_getreg((3 << 11) | 20) & 0xFu; }
#define XB_SPIN(cond, bar) do { unsigned _sp = 0; while (cond) { __builtin_amdgcn_s_sleep(1); \
    if ((++_sp & 255u) == 0u) { if (xb_ld(&(bar)[XB_TMO])) break; if (_sp > XB_SPIN_CAP) { atomicAdd(&(bar)[XB_TMO], 1u); break; } } } } while (0)
struct XcdBarrier { unsigned* bar; unsigned x; volatile LAS unsigned* st; };
__device__ __forceinline__ XcdBarrier xcd_barrier_post(unsigned* bar, volatile LAS unsigned* st) {
  XcdBarrier b; b.bar = bar; b.x = xb_xcc_id(); b.st = st;
  if (threadIdx.x == 0) st[2] = xb_add(&bar[XB_XCNT(b.x)], 1u);
  return b;
}
__device__ __forceinline__ void xcd_barrier_complete(unsigned* bar, unsigned x, unsigned& nloc, unsigned& nx) {
  const unsigned G = gridDim.x * gridDim.y * gridDim.z;
  unsigned sum, cnt, mine, sp = 0u;
  for (;;) {
    sum = 0u; cnt = 0u; mine = 0u;
#pragma unroll
    for (unsigned j = 0; j < 16; ++j) { const unsigned c = xb_ld(&bar[XB_XCNT(j)]); sum += c; cnt += (c > 0u) ? 1u : 0u; mine = (j == x) ? c : mine; }
    if (sum == G) break;
    __builtin_amdgcn_s_sleep(1);
    if ((++sp & 255u) == 0u) { if (xb_ld(&bar[XB_TMO])) break; if (sp > XB_SPIN_CAP) { atomicAdd(&bar[XB_TMO], 1u); break; } }
  }
  nloc = mine > 0u ? mine : 1u; nx = cnt > 0u ? cnt : 1u;
}
__device__ __forceinline__ void xcd_barrier(const XcdBarrier& b) {
  asm volatile("s_waitcnt vmcnt(0)" ::: "memory");
  __syncthreads();
  if (threadIdx.x == 0) {
    unsigned* bar = b.bar;
    __builtin_amdgcn_s_waitcnt(0);
    unsigned nloc = b.st[0], nx = b.st[1];
    if (nloc == 0u) { xcd_barrier_complete(bar, b.x, nloc, nx); b.st[0] = nloc; b.st[1] = nx; }
    const unsigned old = xb_add(&bar[XB_XSUB(b.x)], 1u);
    const unsigned gen = old / nloc;
    if (old + 1u == (gen + 1u) * nloc) {
      __builtin_amdgcn_fence(__ATOMIC_RELEASE, "agent");
      asm volatile("s_waitcnt vmcnt(0)" ::: "memory");
      const unsigned og = xb_add(&bar[XB_TOP], 1u);
      const unsigned tg = og / nx;
      if (og + 1u == (tg + 1u) * nx) xb_add(&bar[XB_TOPGEN], 1u);
      else XB_SPIN(xb_ld(&bar[XB_TOPGEN]) == tg, bar);
      __builtin_amdgcn_fence(__ATOMIC_ACQUIRE, "agent");
      xb_add(&bar[XB_XGEN(b.x)], 1u);
      asm volatile("s_waitcnt vmcnt(0)" ::: "memory");
    } else {
      XB_SPIN(xb_ld(&bar[XB_XGEN(b.x)]) == gen, bar);
      __builtin_amdgcn_fence(__ATOMIC_ACQUIRE, "agent");
      asm volatile("s_waitcnt vmcnt(0)" ::: "memory");
    }
  }
  __syncthreads();
}

#ifndef REP_MASK
#define REP_MASK 0
#endif
#define REPS(k) for (int _rep = 0; _rep < (((REP_MASK) >> (k)) & 1) + 1; _rep++)
__global__ void __launch_bounds__(256, 2) fwd_megakernel(Params p_) {
  extern __shared__ __attribute__((aligned(16))) char smem[];
  cg::grid_group grid = cg::this_grid();
  if (p_.ws == nullptr) grid.sync();
  volatile LAS unsigned* xst = (volatile LAS unsigned*)(smem + SMEM_BYTES - 16);
  if (threadIdx.x == 0) { xst[0] = 0u; xst[1] = 0u; xst[2] = 0u; xst[3] = 0u; }
  __syncthreads();
  const XcdBarrier xb = xcd_barrier_post((unsigned*)(p_.ws + W_BAR), xst);
  REPS(0) { phase0(*fresh_params(), smem); xcd_barrier(xb); }
  if (threadIdx.x == 0) {
    unsigned* bar = (unsigned*)(p_.ws + W_BAR);
    const unsigned per = gridDim.x >> 3;
    bool uni = (gridDim.x & 7u) == 0u;
    for (unsigned j = 0; j < 16; ++j) { const unsigned cnt = xb_ld(&bar[XB_XCNT(j)]); if (cnt != (j < 8 ? per : 0u)) uni = false; }
    xst[3] = uni ? (xb.x * per + xst[2]) : blockIdx.x;
  }
  __syncthreads();
  const int vb = (int)xst[3];
  REPS(1) { phase_g1(*fresh_params(), smem, vb); xcd_barrier(xb); }
  REPS(2) {
    for (int it = blockIdx.x; it < 1536 + 2048; it += gridDim.x) {
      if (it < 1536) attn_item(*fresh_params(), smem, it);
      else { const int q = it - 1536; lru_tile(*fresh_params(), smem, q >> 4, q & 15, 0); }
    }
    xcd_barrier(xb);
  }
  REPS(3) {
    for (int it = blockIdx.x; it < MT * 16; it += gridDim.x) lru_tile(*fresh_params(), smem, it >> 4, it & 15, 1);
    xcd_barrier(xb);
  }
  REPS(4) { phase_g3(*fresh_params(), smem, vb); xcd_barrier(xb); }
  REPS(5) { phase_g4(*fresh_params(), smem, vb); xcd_barrier(xb); }
  REPS(6) { phase_g5(*fresh_params(), smem, vb); xcd_barrier(xb); }
  REPS(7) { phase_g6(*fresh_params(), smem, vb); xcd_barrier(xb); }
  phase7(*fresh_params());
  xcd_barrier(xb);
  phase7b(*fresh_params());
}

extern "C" void kernel_launch(void* const* d_in, const int* in_sizes, int n_in, void* d_out, int out_size, void* d_ws,
                              size_t ws_size, hipStream_t stream) {
  static int grid_blocks = 0;
  if (!grid_blocks) {
    int dev = 0, cus = 0, per_cu = 0;
    hipGetDevice(&dev);
    hipDeviceGetAttribute(&cus, hipDeviceAttributeMultiprocessorCount, dev);
    hipFuncSetAttribute((const void*)fwd_megakernel, hipFuncAttributeMaxDynamicSharedMemorySize, SMEM_BYTES);
    hipOccupancyMaxActiveBlocksPerMultiprocessor(&per_cu, fwd_megakernel, 256, SMEM_BYTES);
    if (per_cu < 1) per_cu = 1;
    grid_blocks = cus * per_cu;
  }
  Params p{};
  const float** pp = (const float**)&p;
  for (int i = 0; i < 26; i++) pp[i] = (const float*)d_in[i];
  p.out = (float*)d_out;
  p.ws = (char*)d_ws;
  (void)hipMemsetAsync((char*)d_ws + W_BAR, 0, (size_t)3456 * 4 + 8 * 256, stream);
  void* args[] = {&p};
  hipError_t e = hipLaunchCooperativeKernel((void*)fwd_megakernel, dim3(grid_blocks), dim3(256), args, SMEM_BYTES, stream);
  if (e != hipSuccess) fprintf(stderr, "cooperative launch failed: %s (grid %d)\n", hipGetErrorString(e), grid_blocks);
}
```

```cpp
#include <hip/hip_runtime.h>
#include <hip/hip_cooperative_groups.h>
#include <stdint.h>
#include <cstdio>
namespace cg = cooperative_groups;

typedef unsigned short u16;
typedef __attribute__((ext_vector_type(8))) short bf16x8;
typedef __attribute__((ext_vector_type(4))) float f32x4;

constexpr int D = 1024;
constexpr int NP = 16384;
constexpr int NTOK = 17408;
constexpr int SEQ = 4096;
constexpr int MT = 136;
constexpr float EPS = 1e-6f;

constexpr size_t O_Y = 0;
constexpr size_t O_CONVP = 17825792;
constexpr size_t O_LRUP = O_CONVP + 12288;
constexpr size_t O_KP = O_LRUP + 4096;
constexpr size_t O_VP = O_KP + 131072;
constexpr size_t O_CONVS = O_VP + 131072;
constexpr size_t O_LRUS = O_CONVS + 393216;
constexpr size_t O_KS = O_LRUS + 131072;
constexpr size_t O_VS = O_KS + 4194304;

constexpr size_t W_WTIN = 0;
constexpr size_t W_WTLRU = W_WTIN + (size_t)5632 * 1024 * 2;
constexpr size_t W_WTATTN = W_WTLRU + (size_t)1024 * 1024 * 2;
constexpr size_t W_WTOUT = W_WTATTN + (size_t)1024 * 1024 * 2;
constexpr size_t W_WTQ = W_WTOUT + (size_t)1024 * 1024 * 2;
constexpr size_t W_SK = W_WTQ + (size_t)2048 * 1024 * 2;
constexpr size_t W_RGA = W_SK + (size_t)16 * 128 * 128 * 2;
constexpr size_t W_RGX = W_RGA + (size_t)65536 * 2;
constexpr size_t W_EU = W_RGX + (size_t)65536 * 2;
constexpr size_t W_EV = W_EU + (size_t)16384 * 1024;
constexpr size_t W_ESC = W_EV + (size_t)16384 * 1024;
constexpr size_t W_XN = W_ESC + (size_t)32768 * 4;
constexpr size_t W_ZA = W_XN + (size_t)NTOK * 1024 * 2;
constexpr size_t W_ZB = W_ZA + (size_t)NTOK * 2048 * 2;
constexpr size_t W_AGG = W_ZB + (size_t)NTOK * 1536 * 2;
constexpr size_t W_SSQ = W_AGG + (size_t)128 * 1024 * 2 * 4;
constexpr size_t W_BAR = W_SSQ + (size_t)NTOK * 16 * 4;
constexpr size_t W_Q = W_BAR + (size_t)3456 * 4;
constexpr size_t W_FLAG = W_Q + (size_t)8 * 256;
constexpr size_t W_ACT = W_FLAG + (size_t)2048 * 4;
constexpr size_t W_LO = W_ACT + (size_t)NTOK * 128 * 4;
constexpr size_t W_END = W_LO + (size_t)NTOK * 1024 * 2;

constexpr int SMEM_BYTES = 81920;

struct Params {
  const float *x_prompt, *x_sample, *cache_conv, *state_lru, *cache_k, *cache_v, *norm1_g, *w_in, *conv_w,
      *conv_b, *rg_w_a, *rg_b_a, *rg_w_x, *rg_b_x, *rg_lambda, *q_norm_g, *k_norm_g, *attn_sinks,
      *w_branch_lru, *w_branch_attn, *w_out, *norm2_g, *peer_w_query, *peer_sub_keys, *expert_u, *expert_v;
  float* out;
  char* ws;
};

typedef const __attribute__((address_space(4))) Params KParams;
__device__ __forceinline__ KParams* fresh_params() {
  unsigned long long k = (unsigned long long)__builtin_amdgcn_kernarg_segment_ptr();
  asm volatile("" : "+s"(k));
  return (KParams*)k;
}
__device__ __forceinline__ u16 f2bf(float f) {
  uint32_t u = __float_as_uint(f);
  u += 0x7FFFu + ((u >> 16) & 1u);
  return (u16)(u >> 16);
}
__device__ __forceinline__ float bf2f(u16 h) { return __uint_as_float(((uint32_t)h) << 16); }
__device__ __forceinline__ uint32_t pack2(float a, float b) {
  uint32_t r;
  asm("v_cvt_pk_bf16_f32 %0, %1, %2" : "=v"(r) : "v"(a), "v"(b));
  return r;
}
__device__ __forceinline__ uint4 pack8(const float* v) {
  uint4 o;
  o.x = pack2(v[0], v[1]); o.y = pack2(v[2], v[3]); o.z = pack2(v[4], v[5]); o.w = pack2(v[6], v[7]);
  return o;
}
__device__ __forceinline__ void unpack8(uint4 u, float* v) {
  v[0] = __uint_as_float(u.x << 16); v[1] = __uint_as_float(u.x & 0xFFFF0000u);
  v[2] = __uint_as_float(u.y << 16); v[3] = __uint_as_float(u.y & 0xFFFF0000u);
  v[4] = __uint_as_float(u.z << 16); v[5] = __uint_as_float(u.z & 0xFFFF0000u);
  v[6] = __uint_as_float(u.w << 16); v[7] = __uint_as_float(u.w & 0xFFFF0000u);
}
__device__ __forceinline__ float sigmoidf_(float x) { return __builtin_amdgcn_rcpf(1.f + __expf(-x)); }
__device__ __forceinline__ float gelu_tanh(float x) {
  float y = 0.7978845608028654f * (x + 0.044715f * x * x * x);
  float t = 1.f - 2.f * __builtin_amdgcn_rcpf(__expf(2.f * y) + 1.f);
  return 0.5f * x * (1.f + t);
}
__device__ __forceinline__ uint32_t ordf(float f) {
  uint32_t u = __float_as_uint(f);
  return (u & 0x80000000u) ? ~u : (u | 0x80000000u);
}
__device__ __forceinline__ float unordf(uint32_t o) {
  uint32_t u = (o & 0x80000000u) ? (o ^ 0x80000000u) : ~o;
  return __uint_as_float(u);
}
__device__ __forceinline__ unsigned hw_xcc_id() { return (unsigned)__builtin_amdgcn_s_getreg((3 << 11) | 20) & 0xFu; }
__device__ __forceinline__ int opaque_tid() {
  int t = threadIdx.x;
  asm volatile("" : "+v"(t));
  return t;
}
__device__ __forceinline__ const float* xrow(KParams& p, int row) {
  return row < NP ? p.x_prompt + (size_t)row * D : p.x_sample + (size_t)(row - NP) * D;
}

#define INS16(T, V)                                  \
  {                                                  \
    uint32_t _v = (V);                               \
    _Pragma("unroll") for (int _q = 0; _q < 16; _q++) { \
      uint32_t _hi = max(T[_q], _v);                 \
      _v = min(T[_q], _v);                           \
      T[_q] = _hi;                                   \
    }                                                \
  }

#define CE_DESC(A_, B_) { const uint32_t _h = max(A_, B_), _l = min(A_, B_); A_ = _h; B_ = _l; }
__device__ __forceinline__ void sort16_desc(uint32_t (&t)[16]) {
#pragma unroll
  for (int k = 2; k <= 16; k <<= 1) {
#pragma unroll
    for (int j = k >> 1; j > 0; j >>= 1) {
#pragma unroll
      for (int i = 0; i < 16; i++) {
        const int l = i ^ j;
        if (l > i) {
          if ((i & k) == 0) { CE_DESC(t[i], t[l]); } else { CE_DESC(t[l], t[i]); }
        }
      }
    }
  }
}
__device__ __forceinline__ void merge16_desc(uint32_t (&T)[16], const uint32_t (&S)[16]) {
#pragma unroll
  for (int i = 0; i < 16; i++) T[i] = max(T[i], S[15 - i]);
#pragma unroll
  for (int j = 8; j > 0; j >>= 1) {
#pragma unroll
    for (int i = 0; i < 16; i++) {
      const int l = i ^ j;
      if (l > i) { CE_DESC(T[i], T[l]); }
    }
  }
}

__device__ __forceinline__ void transpose_cvt(const float* __restrict__ W, u16* __restrict__ Wt, int K, int N,
                                              size_t gtid, size_t gsz) {
  size_t total = (size_t)N * (K / 8);
  for (size_t c = gtid; c < total; c += gsz) {
    int n = (int)(c % N);
    int kg = (int)(c / N);
    float v[8];
#pragma unroll
    for (int i = 0; i < 8; i++) v[i] = W[(size_t)(kg * 8 + i) * N + n];
    *(uint4*)(Wt + (size_t)n * K + kg * 8) = pack8(v);
  }
}
__device__ __forceinline__ void plain_cvt(const float* __restrict__ S, u16* __restrict__ Dst, size_t n, size_t gtid,
                                          size_t gsz) {
  size_t total = n / 8;
  const float4* s4 = (const float4*)S;
  for (size_t c = gtid; c < total; c += gsz) {
    float4 a = s4[2 * c], b = s4[2 * c + 1];
    float v[8] = {a.x, a.y, a.z, a.w, b.x, b.y, b.z, b.w};
    *(uint4*)(Dst + c * 8) = pack8(v);
  }
}

__device__ __forceinline__ void phase0(KParams& p, char* smem) {
  const int tid = opaque_tid();
  const size_t gtid = (size_t)blockIdx.x * 256 + tid, gsz = (size_t)gridDim.x * 256;
  char* ws = p.ws;
  {
    const int lane = tid & 63;
    const int gw = (int)(gtid >> 6), nw = (int)(gsz >> 6);
    u16* XN = (u16*)(ws + W_XN);
    for (int row = gw; row < NTOK; row += nw) {
      const float4* xr = (const float4*)xrow(p, row);
      float4 v[4];
      float ss = 0.f;
#pragma unroll
      for (int i = 0; i < 4; i++) {
        v[i] = xr[lane + i * 64];
        ss += v[i].x * v[i].x + v[i].y * v[i].y + v[i].z * v[i].z + v[i].w * v[i].w;
      }
#pragma unroll
      for (int o = 32; o > 0; o >>= 1) ss += __shfl_xor(ss, o);
      float rstd = rsqrtf(ss * (1.f / 1024.f) + EPS);
      const float4* g4 = (const float4*)p.norm1_g;
#pragma unroll
      for (int i = 0; i < 4; i++) {
        float4 g = g4[lane + i * 64];
        uint2 o;
        o.x = pack2(v[i].x * rstd * g.x, v[i].y * rstd * g.y);
        o.y = pack2(v[i].z * rstd * g.z, v[i].w * rstd * g.w);
        *(uint2*)(XN + (size_t)row * D + (lane + i * 64) * 4) = o;
      }
    }
  }
  {
    float* T = (float*)smem;
    for (int tile = blockIdx.x; tile < 2688; tile += gridDim.x) {
      const float* W;
      u16* Wt;
      int N, tl;
      if (tile < 1408) { W = p.w_in; Wt = (u16*)(ws + W_WTIN); N = 5632; tl = tile; }
      else if (tile < 1664) { W = p.w_branch_lru; Wt = (u16*)(ws + W_WTLRU); N = 1024; tl = tile - 1408; }
      else if (tile < 1920) { W = p.w_branch_attn; Wt = (u16*)(ws + W_WTATTN); N = 1024; tl = tile - 1664; }
      else if (tile < 2176) { W = p.w_out; Wt = (u16*)(ws + W_WTOUT); N = 1024; tl = tile - 1920; }
      else { W = p.peer_w_query; Wt = (u16*)(ws + W_WTQ); N = 2048; tl = tile - 2176; }
      const int ntn = N >> 6;
      const int kt = tl / ntn, nt = tl - kt * ntn;
      __syncthreads();
      {
        const float* src = W + (size_t)(kt * 64 + (tid >> 2)) * N + nt * 64 + (tid & 3) * 16;
        const float4 a0 = *(const float4*)src, a1 = *(const float4*)(src + 4), a2 = *(const float4*)(src + 8),
                     a3 = *(const float4*)(src + 12);
        float* d = T + (tid >> 2) * 65 + (tid & 3) * 16;
        d[0] = a0.x; d[1] = a0.y; d[2] = a0.z; d[3] = a0.w; d[4] = a1.x; d[5] = a1.y; d[6] = a1.z; d[7] = a1.w;
        d[8] = a2.x; d[9] = a2.y; d[10] = a2.z; d[11] = a2.w; d[12] = a3.x; d[13] = a3.y; d[14] = a3.z; d[15] = a3.w;
      }
      __syncthreads();
      {
        const int n = tid >> 2, kc = (tid & 3) * 16;
        float v[16];
#pragma unroll
        for (int i = 0; i < 16; i++) v[i] = T[(kc + i) * 65 + n];
        u16* dst = Wt + (size_t)(nt * 64 + n) * 1024 + kt * 64 + kc;
        *(uint4*)dst = pack8(v);
        *(uint4*)(dst + 8) = pack8(v + 8);
      }
    }
  }
  {
    u16* RA = (u16*)(ws + W_RGA);
    u16* RX = (u16*)(ws + W_RGX);
    for (size_t e = gtid; e < 65536; e += gsz) {
      int n = (int)(e >> 12), k = (int)((e >> 6) & 63), j = (int)(e & 63);
      RA[e] = f2bf(p.rg_w_a[n * 4096 + j * 64 + k]);
      RX[e] = f2bf(p.rg_w_x[n * 4096 + j * 64 + k]);
    }
  }
  plain_cvt(p.peer_sub_keys, (u16*)(ws + W_SK), (size_t)16 * 128 * 128, gtid, gsz);
  {
    const int lane = tid & 63;
    const int gw = (int)(gtid >> 6), nw = (int)(gsz >> 6);
    unsigned char* E8 = (unsigned char*)(ws + W_EU);
    float* ESC = (float*)(ws + W_ESC);
    for (int r = gw; r < 32768; r += nw) {
      const float* src = (r < 16384 ? p.expert_u : p.expert_v) + (size_t)(r & 16383) * 1024 + lane * 16;
      const float4 a0 = *(const float4*)src, a1 = *(const float4*)(src + 4), a2 = *(const float4*)(src + 8),
                   a3 = *(const float4*)(src + 12);
      float am = fmaxf(fmaxf(fmaxf(fabsf(a0.x), fabsf(a0.y)), fmaxf(fabsf(a0.z), fabsf(a0.w))),
                       fmaxf(fmaxf(fabsf(a1.x), fabsf(a1.y)), fmaxf(fabsf(a1.z), fabsf(a1.w))));
      am = fmaxf(am, fmaxf(fmaxf(fmaxf(fabsf(a2.x), fabsf(a2.y)), fmaxf(fabsf(a2.z), fabsf(a2.w))),
                           fmaxf(fmaxf(fabsf(a3.x), fabsf(a3.y)), fmaxf(fabsf(a3.z), fabsf(a3.w)))));
#pragma unroll
      for (int o = 32; o > 0; o >>= 1) am = fmaxf(am, __shfl_xor(am, o));
      const float sc = am > 0.f ? 224.f / am : 1.f;
      uint4 o4;
      int wv;
      wv = __builtin_amdgcn_cvt_pk_fp8_f32(a0.x * sc, a0.y * sc, 0, false);
      wv = __builtin_amdgcn_cvt_pk_fp8_f32(a0.z * sc, a0.w * sc, wv, true);
      o4.x = (uint32_t)wv;
      wv = __builtin_amdgcn_cvt_pk_fp8_f32(a1.x * sc, a1.y * sc, 0, false);
      wv = __builtin_amdgcn_cvt_pk_fp8_f32(a1.z * sc, a1.w * sc, wv, true);
      o4.y = (uint32_t)wv;
      wv = __builtin_amdgcn_cvt_pk_fp8_f32(a2.x * sc, a2.y * sc, 0, false);
      wv = __builtin_amdgcn_cvt_pk_fp8_f32(a2.z * sc, a2.w * sc, wv, true);
      o4.z = (uint32_t)wv;
      wv = __builtin_amdgcn_cvt_pk_fp8_f32(a3.x * sc, a3.y * sc, 0, false);
      wv = __builtin_amdgcn_cvt_pk_fp8_f32(a3.z * sc, a3.w * sc, wv, true);
      o4.w = (uint32_t)wv;
      if (r < 16384) *(uint4*)(E8 + (size_t)r * 1024 + lane * 16) = o4;
      else *(uint4*)(E8 + (size_t)16384 * 1024 + (size_t)(lane >> 3) * (16384 * 128) + (size_t)(r - 16384) * 128 + (lane & 7) * 16) = o4;
      if (lane == 0) ESC[r] = am > 0.f ? am * (1.f / 224.f) : 1.f;
    }
  }
}

constexpr int LDT = 72;
constexpr int CS_LD = 132;

template <int NW>
__device__ __forceinline__ void gemm_tile(const u16* __restrict__ A, int lda, const u16* __restrict__ Bt, int ldb,
                                          int K, f32x4 (&acc)[4][NW / 32], char* smem, int tid) {
  constexpr int NJ = NW / 32;
  const int lane = tid & 63, w = tid >> 6;
  const int wm = w >> 1, wn = w & 1;
  const int l15 = lane & 15, quad = lane >> 4;
  const int lr = w * 8 + (lane >> 3);
  const int lc = ((lane & 7) ^ ((lane >> 3) & 7)) * 8;
  const char* Ab = (const char*)A;
  const char* Bb = (const char*)Bt;
  const uint32_t ao = (uint32_t)(lr * lda + lc) * 2u, bo = (uint32_t)(lr * ldb + lc) * 2u;
  const uint32_t sa2 = 64u * (uint32_t)lda, sb2 = 64u * (uint32_t)ldb;
  const uint32_t kmask = (uint32_t)K - 1u, kst = (((uint32_t)blockIdx.x >> 3) * 64u) & kmask;
  char* lw = smem + w * 1024 + lane * 16;
  const int swz = l15 & 7;
  const char* Ar = smem + (wm * 64 + l15) * 128 + ((quad ^ swz) * 16);
  const char* Br = smem + 16384 + (wn * (NW / 2) + l15) * 128 + ((quad ^ swz) * 16);
  const char* Ar1 = smem + (wm * 64 + l15) * 128 + (((4 + quad) ^ swz) * 16);
  const char* Br1 = smem + 16384 + (wn * (NW / 2) + l15) * 128 + (((4 + quad) ^ swz) * 16);
#define GT_ISSUE(st, off)                                                                                   \
  {                                                                                                         \
    const uint32_t _o = (((uint32_t)(off) + kst) & kmask) * 2u;                                             \
    char* _l = lw + (st) * 32768;                                                                           \
    _Pragma("unroll") for (int j = 0; j < 4; j++) {                                                         \
      __builtin_amdgcn_global_load_lds((const unsigned*)(Ab + (size_t)(ao + j * sa2 + _o)), (unsigned*)(_l + j * 4096), 16, 0, 0);          \
      if (j < NJ) __builtin_amdgcn_global_load_lds((const unsigned*)(Bb + (size_t)(bo + j * sb2 + _o)), (unsigned*)(_l + 16384 + j * 4096), 16, 0, 0);  \
    }                                                                                                       \
  }
#define GT_MMA(st)                                                                                          \
  {                                                                                                         \
    const char* _ar = Ar + (st) * 32768; const char* _br = Br + (st) * 32768;                               \
    const char* _ar1 = Ar1 + (st) * 32768; const char* _br1 = Br1 + (st) * 32768;                           \
    bf16x8 a0[4], b0[NJ], a1[4], b1[NJ];                                                                      \
    _Pragma("unroll") for (int i = 0; i < 4; i++) {                                                         \
      a0[i] = *(const bf16x8*)(_ar + i * 2048);                                                             \
      if (i < NJ) b0[i] = *(const bf16x8*)(_br + i * 2048);                                                 \
    }                                                                                                       \
    _Pragma("unroll") for (int i = 0; i < 4; i++) {                                                         \
      a1[i] = *(const bf16x8*)(_ar1 + i * 2048);                                                            \
      if (i < NJ) b1[i] = *(const bf16x8*)(_br1 + i * 2048);                                                \
    }                                                                                                       \
    __builtin_amdgcn_s_setprio(1);                                                                          \
    _Pragma("unroll") for (int i = 0; i < 4; i++)                                                           \
      _Pragma("unroll") for (int j = 0; j < NJ; j++)                                                        \
        acc[i][j] = __builtin_amdgcn_mfma_f32_16x16x32_bf16(a0[i], b0[j], acc[i][j], 0, 0, 0);              \
    _Pragma("unroll") for (int i = 0; i < 4; i++)                                                           \
      _Pragma("unroll") for (int j = 0; j < NJ; j++)                                                        \
        acc[i][j] = __builtin_amdgcn_mfma_f32_16x16x32_bf16(a1[i], b1[j], acc[i][j], 0, 0, 0);              \
    __builtin_amdgcn_s_setprio(0);                                                                          \
  }
  __syncthreads();
  GT_ISSUE(0, 0);
  for (int k0 = 0; k0 < K; k0 += 128) {
    asm volatile("s_waitcnt vmcnt(0) lgkmcnt(0)" ::: "memory");
    __builtin_amdgcn_s_barrier();
    asm volatile("" ::: "memory");
    GT_ISSUE(1, k0 + 64);
    GT_MMA(0);
    asm volatile("s_waitcnt vmcnt(0) lgkmcnt(0)" ::: "memory");
    __builtin_amdgcn_s_barrier();
    asm volatile("" ::: "memory");
    if (k0 + 128 < K) GT_ISSUE(0, k0 + 128);
    GT_MMA(1);
  }
#undef GT_ISSUE
#undef GT_MMA
}

__device__ __forceinline__ void tile_map(int it, int total, int NT, int& mt, int& nt, int vb) {
  const int G = gridDim.x;
  int T = it;
  {
    const int round = it / G;
    if (round * G + G <= total) T = round * G + vb;
  }
  const int g = T / (8 * NT), r = T - g * (8 * NT);
  nt = r >> 3;
  mt = g * 8 + (r & 7);
}

template <int NJ>
__device__ __forceinline__ void zero_acc(f32x4 (&acc)[4][NJ]) {
#pragma unroll
  for (int i = 0; i < 4; i++)
#pragma unroll
    for (int j = 0; j < NJ; j++) acc[i][j] = (f32x4){0.f, 0.f, 0.f, 0.f};
}

template <int NJ>
__device__ __forceinline__ void acc_to_cs(const f32x4 (&acc)[4][NJ], float* Cs, int tid) {
  const int lane = tid & 63, w = tid >> 6;
  const int wm = w >> 1, wn = w & 1;
  const int l15 = lane & 15, quad = lane >> 4;
#pragma unroll
  for (int i = 0; i < 4; i++)
#pragma unroll
    for (int j = 0; j < NJ; j++)
#pragma unroll
      for (int e = 0; e < 4; e++)
        Cs[(wm * 64 + i * 16 + quad * 4 + e) * CS_LD + wn * (NJ * 16) + j * 16 + l15] = acc[i][j][e];
}

__device__ __forceinline__ void phase_g1(KParams& p, char* smem, int vb) {
  const int tid = opaque_tid();
  u16* As = (u16*)smem;
  u16* Bs = As + 2 * 128 * LDT;
  float* Cs = (float*)smem;
  const u16* XN = (const u16*)(p.ws + W_XN);
  const u16* WT = (const u16*)(p.ws + W_WTIN);
  for (int t = blockIdx.x; t < MT * 44; t += gridDim.x) {
    int mt, nt;
    tile_map(t, MT * 44, 44, mt, nt, vb);
    f32x4 acc[4][4];
    zero_acc(acc);
    gemm_tile<128>(XN + (size_t)mt * 128 * 1024, 1024, WT + (size_t)nt * 128 * 1024, 1024, 1024, acc, smem, tid);
    __syncthreads();
    acc_to_cs(acc, Cs, tid);
    __syncthreads();
    const int n0 = nt * 128;
    u16* dst;
    int ldd, col;
    if (n0 < 2048) { dst = (u16*)(p.ws + W_ZA); ldd = 2048; col = n0; }
    else if (n0 < 3584) { dst = (u16*)(p.ws + W_ZB); ldd = 1536; col = n0 - 2048; }
    else { dst = (u16*)p.out; ldd = 2048; col = n0 - 3584; }
    const int cc = (tid & 15) * 8;
#pragma unroll
    for (int i = 0; i < 8; i++) {
      const int r = (tid >> 4) + 16 * i;
      float4 a = *(const float4*)(Cs + r * CS_LD + cc), b = *(const float4*)(Cs + r * CS_LD + cc + 4);
      float v[8] = {a.x, a.y, a.z, a.w, b.x, b.y, b.z, b.w};
      *(uint4*)(dst + (size_t)(mt * 128 + r) * ldd + col + cc) = pack8(v);
    }
    __syncthreads();
  }
}

constexpr int KS_LD = 72, VT_LD = 200, PS_LD = 168;
__device__ __forceinline__ void attn_item(KParams& p, char* smem, int item) {
  const int tid = opaque_tid(), lane = tid & 63, w = tid >> 6, l15 = lane & 15, quad = lane >> 4;
  u16* Ks = (u16*)smem;
  u16* Vt = Ks + 192 * KS_LD;
  u16* Ps = Vt + 64 * VT_LD + w * 16 * PS_LD;
  const u16* ZB = (const u16*)(p.ws + W_ZB);
  u16* ATT = (u16*)(p.ws + W_XN);
  const bool sample = item >= 1024;
  int b, qb = 0, kv, rowbase, p0 = 0;
  if (!sample) {
    kv = item & 3; qb = (item >> 2) & 63; b = item >> 8;
    p0 = qb * 64;
    rowbase = b * SEQ + p0;
  } else {
    int it = item - 1024;
    kv = it & 3; b = it >> 2;
    rowbase = NP + b * 8;
  }
  __syncthreads();
  {
    const int ch = tid & 7;
    float kg[8];
#pragma unroll
    for (int i = 0; i < 8; i++) kg[i] = p.k_norm_g[ch * 8 + i];
    const int nrows = sample ? 160 : 192;
    for (int c = tid; c < nrows * 8; c += 256) {
      const int row = c >> 3;
      float kf[8], vf[8];
      bool valid, donorm;
      if (!sample) {
        const int pos = p0 - 128 + row;
        valid = pos >= 0;
        donorm = true;
        if (valid) {
          const u16* src = ZB + (size_t)(b * SEQ + pos) * 1536 + 1024 + kv * 64 + ch * 8;
          unpack8(*(const uint4*)src, kf);
          unpack8(*(const uint4*)(src + 256), vf);
        }
      } else {
        valid = row < 136;
        donorm = row >= 128;
        if (row < 128) {
          const float* sk = p.cache_k + ((size_t)(b * 128 + row) * 4 + kv) * 64 + ch * 8;
          const float* sv = p.cache_v + ((size_t)(b * 128 + row) * 4 + kv) * 64 + ch * 8;
          float4 a0 = *(const float4*)sk, a1 = *(const float4*)(sk + 4);
          float4 b0 = *(const float4*)sv, b1 = *(const float4*)(sv + 4);
          kf[0] = a0.x; kf[1] = a0.y; kf[2] = a0.z; kf[3] = a0.w; kf[4] = a1.x; kf[5] = a1.y; kf[6] = a1.z; kf[7] = a1.w;
          vf[0] = b0.x; vf[1] = b0.y; vf[2] = b0.z; vf[3] = b0.w; vf[4] = b1.x; vf[5] = b1.y; vf[6] = b1.z; vf[7] = b1.w;
        } else if (valid) {
          const u16* src = ZB + (size_t)(NP + b * 8 + (row - 128)) * 1536 + 1024 + kv * 64 + ch * 8;
          unpack8(*(const uint4*)src, kf);
          unpack8(*(const uint4*)(src + 256), vf);
        }
      }
      if (!valid) {
#pragma unroll
        for (int i = 0; i < 8; i++) { kf[i] = 0.f; vf[i] = 0.f; }
      }
      float ss = 0.f;
#pragma unroll
      for (int i = 0; i < 8; i++) ss += kf[i] * kf[i];
      ss += __shfl_xor(ss, 1);
      ss += __shfl_xor(ss, 2);
      ss += __shfl_xor(ss, 4);
      if (donorm) {
        const float rstd = rsqrtf(ss * (1.f / 64.f) + EPS);
#pragma unroll
        for (int i = 0; i < 8; i++) kf[i] = kf[i] * rstd * kg[i];
      }
      *(uint4*)(Ks + row * KS_LD + ch * 8) = pack8(kf);
#pragma unroll
      for (int i = 0; i < 8; i++) Vt[(ch * 8 + i) * VT_LD + row] = f2bf(vf[i]);
      if (!sample) {
        if (qb >= 62 && row >= 128) {
          const int wpos = p0 + (row - 128) - (SEQ - 128);
          float* ko = p.out + O_KP + ((size_t)(b * 128 + wpos) * 4 + kv) * 64 + ch * 8;
          float* vo = p.out + O_VP + ((size_t)(b * 128 + wpos) * 4 + kv) * 64 + ch * 8;
          *(float4*)ko = make_float4(kf[0], kf[1], kf[2], kf[3]);
          *(float4*)(ko + 4) = make_float4(kf[4], kf[5], kf[6], kf[7]);
          *(float4*)vo = make_float4(vf[0], vf[1], vf[2], vf[3]);
          *(float4*)(vo + 4) = make_float4(vf[4], vf[5], vf[6], vf[7]);
        }
      } else {
        if (row >= 8 && row < 136) {
          float* ko = p.out + O_KS + ((size_t)(b * 128 + (row - 8)) * 4 + kv) * 64 + ch * 8;
          float* vo = p.out + O_VS + ((size_t)(b * 128 + (row - 8)) * 4 + kv) * 64 + ch * 8;
          *(float4*)ko = make_float4(kf[0], kf[1], kf[2], kf[3]);
          *(float4*)(ko + 4) = make_float4(kf[4], kf[5], kf[6], kf[7]);
          *(float4*)vo = make_float4(vf[0], vf[1], vf[2], vf[3]);
          *(float4*)(vo + 4) = make_float4(vf[4], vf[5], vf[6], vf[7]);
        }
      }
    }
  }
  __syncthreads();
  const int hq = kv * 4 + w;
  const float slope = exp2f(-0.5f * (float)(hq + 1));
  const float sink = p.attn_sinks[hq];
  float qg[2][8];
#pragma unroll
  for (int ks = 0; ks < 2; ks++)
#pragma unroll
    for (int i = 0; i < 8; i++) qg[ks][i] = p.q_norm_g[ks * 32 + quad * 8 + i] * 0.125f;
  const int nsub = sample ? 1 : 4;
  for (int sb = 0; sb < nsub; sb++) {
    const int r0 = sb * 16;
    const int ws0 = r0 < 32 ? r0 : 32;
    bf16x8 qa[2];
    {
      const int qr = sample ? (l15 & 7) : (r0 + l15);
      const u16* src = ZB + (size_t)(rowbase + qr) * 1536 + hq * 64 + quad * 8;
      float q0[8], q1[8];
      unpack8(*(const uint4*)src, q0);
      unpack8(*(const uint4*)(src + 32), q1);
      float ss = 0.f;
#pragma unroll
      for (int i = 0; i < 8; i++) ss += q0[i] * q0[i] + q1[i] * q1[i];
      ss += __shfl_xor(ss, 16);
      ss += __shfl_xor(ss, 32);
      const float rstd = rsqrtf(ss * (1.f / 64.f) + EPS);
#pragma unroll
      for (int i = 0; i < 8; i++) { q0[i] *= rstd * qg[0][i]; q1[i] *= rstd * qg[1][i]; }
      uint4 u0 = pack8(q0), u1 = pack8(q1);
      qa[0] = __builtin_bit_cast(bf16x8, u0);
      qa[1] = __builtin_bit_cast(bf16x8, u1);
    }
    f32x4 s[10];
#pragma unroll
    for (int kt = 0; kt < 10; kt++) {
      const u16* kp = Ks + (ws0 + kt * 16 + l15) * KS_LD + quad * 8;
      bf16x8 b0 = *(const bf16x8*)kp, b1 = *(const bf16x8*)(kp + 32);
      f32x4 z = {0.f, 0.f, 0.f, 0.f};
      z = __builtin_amdgcn_mfma_f32_16x16x32_bf16(qa[0], b0, z, 0, 0, 0);
      s[kt] = __builtin_amdgcn_mfma_f32_16x16x32_bf16(qa[1], b1, z, 0, 0, 0);
    }
    float mx[4] = {-1e30f, -1e30f, -1e30f, -1e30f};
#pragma unroll
    for (int kt = 0; kt < 10; kt++) {
      const int jj = ws0 + kt * 16 + l15;
      const bool posok = sample ? (jj < 136) : (p0 - 128 + jj >= 0);
#pragma unroll
      for (int e = 0; e < 4; e++) {
        const int r = r0 + quad * 4 + e;
        const int dist = r + 128 - jj;
        const bool ok = posok && dist >= 0 && dist <= 128;
        float v = ok ? (s[kt][e] - slope * (float)dist) : -1e30f;
        s[kt][e] = v;
        mx[e] = fmaxf(mx[e], v);
      }
    }
    float sum[4];
#pragma unroll
    for (int e = 0; e < 4; e++) {
      float m = mx[e];
      m = fmaxf(m, __shfl_xor(m, 1));
      m = fmaxf(m, __shfl_xor(m, 2));
      m = fmaxf(m, __shfl_xor(m, 4));
      m = fmaxf(m, __shfl_xor(m, 8));
      m = fmaxf(m, sink);
      mx[e] = m;
      sum[e] = 0.f;
    }
#pragma unroll
    for (int kt = 0; kt < 10; kt++) {
#pragma unroll
      for (int e = 0; e < 4; e++) {
        float pv = __expf(s[kt][e] - mx[e]);
        sum[e] += pv;
        Ps[(quad * 4 + e) * PS_LD + kt * 16 + l15] = f2bf(pv);
      }
    }
#pragma unroll
    for (int e = 0; e < 4; e++) {
      float t = sum[e];
      t += __shfl_xor(t, 1);
      t += __shfl_xor(t, 2);
      t += __shfl_xor(t, 4);
      t += __shfl_xor(t, 8);
      sum[e] = 1.f / (t + __expf(sink - mx[e]));
    }
    __syncthreads();
    f32x4 o[4];
#pragma unroll
    for (int nt = 0; nt < 4; nt++) o[nt] = (f32x4){0.f, 0.f, 0.f, 0.f};
#pragma unroll
    for (int kk = 0; kk < 5; kk++) {
      bf16x8 pa = *(const bf16x8*)(Ps + l15 * PS_LD + kk * 32 + quad * 8);
#pragma unroll
      for (int nt = 0; nt < 4; nt++) {
        bf16x8 vb = *(const bf16x8*)(Vt + (nt * 16 + l15) * VT_LD + ws0 + kk * 32 + quad * 8);
        o[nt] = __builtin_amdgcn_mfma_f32_16x16x32_bf16(pa, vb, o[nt], 0, 0, 0);
      }
    }
#pragma unroll
    for (int e = 0; e < 4; e++) {
      const int r = quad * 4 + e;
      if (!sample || r < 8) {
        u16* dst = ATT + (size_t)(rowbase + r0 + r) * 1024 + hq * 64 + l15;
#pragma unroll
        for (int nt = 0; nt < 4; nt++) dst[nt * 16] = f2bf(o[nt][e] * sum[e]);
      }
    }
    __syncthreads();
  }
}

constexpr int XC_LD = 68;
__device__ __forceinline__ void lru_tile(KParams& p, char* smem, int mt, int nb, int mode) {
  const int tid = opaque_tid(), lane = tid & 63, w = tid >> 6, l15 = lane & 15, quad = lane >> 4;
  float* xcF = (float*)smem;
  float* aL = xcF + 128 * XC_LD;
  float* aggL = aL + 128 * XC_LD;
  const u16* ZA = (const u16*)(p.ws + W_ZA);
  const bool sample = mt >= 128;
  const int m0 = mt * 128;
  const int cb = nb * 64;
  __syncthreads();
  {
    const int ch = tid & 7;
    float cw[4][8], cbias[8];
#pragma unroll
    for (int j = 0; j < 4; j++)
#pragma unroll
      for (int i = 0; i < 8; i++) cw[j][i] = p.conv_w[j * 1024 + cb + ch * 8 + i];
#pragma unroll
    for (int i = 0; i < 8; i++) cbias[i] = p.conv_b[cb + ch * 8 + i];
#pragma unroll
    for (int it = 0; it < 4; it++) {
      const int r = (tid >> 3) + it * 32;
      const int grow = m0 + r;
      const int t = sample ? (r & 7) : ((mt & 31) * 128 + r);
      float y[8];
#pragma unroll
      for (int i = 0; i < 8; i++) y[i] = cbias[i];
#pragma unroll
      for (int d = 0; d < 4; d++) {
        float xv[8];
        if (t - d >= 0) {
          unpack8(*(const uint4*)(ZA + (size_t)(grow - d) * 2048 + cb + ch * 8), xv);
        } else if (sample) {
          const int bb = (m0 - NP + r) >> 3;
          const float* src = p.cache_conv + ((size_t)bb * 3 + (3 + t - d)) * 1024 + cb + ch * 8;
          float4 a = *(const float4*)src, b4 = *(const float4*)(src + 4);
          xv[0] = a.x; xv[1] = a.y; xv[2] = a.z; xv[3] = a.w; xv[4] = b4.x; xv[5] = b4.y; xv[6] = b4.z; xv[7] = b4.w;
        } else {
#pragma unroll
          for (int i = 0; i < 8; i++) xv[i] = 0.f;
        }
#pragma unroll
        for (int i = 0; i < 8; i++) y[i] += cw[3 - d][i] * xv[i];
        if (d == 0 && mode != 0) {
          if (!sample) {
            if ((mt & 31) == 31 && r >= 125) {
              float* dst = p.out + O_CONVP + ((size_t)(mt >> 5) * 3 + (r - 125)) * 1024 + cb + ch * 8;
              *(float4*)dst = make_float4(xv[0], xv[1], xv[2], xv[3]);
              *(float4*)(dst + 4) = make_float4(xv[4], xv[5], xv[6], xv[7]);
            }
          } else if (t >= 5) {
            const int bb = (m0 - NP + r) >> 3;
            float* dst = p.out + O_CONVS + ((size_t)bb * 3 + (t - 5)) * 1024 + cb + ch * 8;
            *(float4*)dst = make_float4(xv[0], xv[1], xv[2], xv[3]);
            *(float4*)(dst + 4) = make_float4(xv[4], xv[5], xv[6], xv[7]);
          }
        }
      }
      *(float4*)(xcF + r * XC_LD + ch * 8) = make_float4(y[0], y[1], y[2], y[3]);
      *(float4*)(xcF + r * XC_LD + ch * 8 + 4) = make_float4(y[4], y[5], y[6], y[7]);
    }
  }
  __syncthreads();
  {
    const u16* RA = (const u16*)(p.ws + W_RGA) + nb * 4096;
    const u16* RX = (const u16*)(p.ws + W_RGX) + nb * 4096;
    f32x4 aR[2][4], aI[2][4];
#pragma unroll
    for (int i = 0; i < 2; i++)
#pragma unroll
      for (int j = 0; j < 4; j++) { aR[i][j] = (f32x4){0.f, 0.f, 0.f, 0.f}; aI[i][j] = (f32x4){0.f, 0.f, 0.f, 0.f}; }
#pragma unroll
    for (int ks = 0; ks < 2; ks++) {
      bf16x8 a[2];
#pragma unroll
      for (int i = 0; i < 2; i++) {
        const float* src = xcF + (w * 32 + i * 16 + l15) * XC_LD + ks * 32 + quad * 8;
        float4 x0 = *(const float4*)src, x1 = *(const float4*)(src + 4);
        float v[8] = {x0.x, x0.y, x0.z, x0.w, x1.x, x1.y, x1.z, x1.w};
        uint4 u = pack8(v);
        a[i] = __builtin_bit_cast(bf16x8, u);
      }
#pragma unroll
      for (int j = 0; j < 4; j++) {
        bf16x8 ba = *(const bf16x8*)(RA + (j * 16 + l15) * 64 + ks * 32 + quad * 8);
        bf16x8 bx = *(const bf16x8*)(RX + (j * 16 + l15) * 64 + ks * 32 + quad * 8);
#pragma unroll
        for (int i = 0; i < 2; i++) {
          aR[i][j] = __builtin_amdgcn_mfma_f32_16x16x32_bf16(a[i], ba, aR[i][j], 0, 0, 0);
          aI[i][j] = __builtin_amdgcn_mfma_f32_16x16x32_bf16(a[i], bx, aI[i][j], 0, 0, 0);
        }
      }
    }
#pragma unroll
    for (int j = 0; j < 4; j++) {
      const int c = cb + j * 16 + l15;
      const float ba = p.rg_b_a[c], bx = p.rg_b_x[c];
      const float ls = -log1pf(__expf(-p.rg_lambda[c]));
#pragma unroll
      for (int i = 0; i < 2; i++)
#pragma unroll
        for (int e = 0; e < 4; e++) {
          const int row = w * 32 + i * 16 + quad * 4 + e;
          const float rg = sigmoidf_(aR[i][j][e] + ba);
          const float ig = sigmoidf_(aI[i][j][e] + bx);
          const float la = 8.f * rg * ls;
          const float av = __expf(la);
          const float x2 = 2.f * la;
          const float emt = -x2 * (1.f + x2 * (0.5f + x2 * (0.16666667f + x2 * (0.041666668f + x2 * 0.008333334f))));
          const float em = x2 > -0.25f ? emt : 1.f - __expf(x2);
          const float mult = __builtin_amdgcn_sqrtf(fmaxf(em, 0.f));
          const int idx = row * XC_LD + j * 16 + l15;
          const float xv = xcF[idx];
          aL[idx] = av;
          xcF[idx] = mult * ig * xv;
        }
    }
  }
  __syncthreads();
  const int c = cb + lane;
  float* carL = aggL + 512;
  if (!sample) {
    float* AGGP = (float*)(p.ws + W_AGG);
    float* AGGH = AGGP + 128 * 1024;
    const int chunk = mt & 31, base = mt - chunk;
    if (mode == 1) {
      float Pq[8], Hq[8];
#pragma unroll
      for (int k = 0; k < 8; k++) {
        const int q = w * 8 + k;
        const bool ok = q < chunk;
        Pq[k] = ok ? AGGP[(base + q) * 1024 + c] : 1.f;
        Hq[k] = ok ? AGGH[(base + q) * 1024 + c] : 0.f;
      }
      float Pc = 1.f, hc = 0.f;
#pragma unroll
      for (int k = 0; k < 8; k++) { hc = Pq[k] * hc + Hq[k]; Pc *= Pq[k]; }
      carL[(w * 64 + lane) * 2] = Pc;
      carL[(w * 64 + lane) * 2 + 1] = hc;
    }
    float P = 1.f, h = 0.f;
#pragma unroll 8
    for (int rr = 0; rr < 32; rr++) {
      const float av = aL[(w * 32 + rr) * XC_LD + lane], bv = xcF[(w * 32 + rr) * XC_LD + lane];
      h = av * h + bv;
      P *= av;
    }
    aggL[(w * 64 + lane) * 2] = P;
    aggL[(w * 64 + lane) * 2 + 1] = h;
    __syncthreads();
    if (mode == 0 || mode == 2) {
      if (w == 0) {
        float Pt = 1.f, ht = 0.f;
#pragma unroll
        for (int q = 0; q < 4; q++) {
          const float Pq = aggL[(q * 64 + lane) * 2], hq = aggL[(q * 64 + lane) * 2 + 1];
          ht = Pq * ht + hq;
          Pt *= Pq;
        }
        if (mode == 0) {
          AGGP[mt * 1024 + c] = Pt;
          AGGH[mt * 1024 + c] = ht;
        } else {
          __hip_atomic_store(&AGGP[mt * 1024 + c], Pt, __ATOMIC_RELAXED, __HIP_MEMORY_SCOPE_AGENT);
          __hip_atomic_store(&AGGH[mt * 1024 + c], ht, __ATOMIC_RELAXED, __HIP_MEMORY_SCOPE_AGENT);
          asm volatile("s_waitcnt vmcnt(0)" ::: "memory");
          if (lane == 0)
            __hip_atomic_store((unsigned*)(p.ws + W_FLAG) + mt * 16 + nb, 1u, __ATOMIC_RELAXED, __HIP_MEMORY_SCOPE_AGENT);
        }
      }
    }
    if (mode == 2) {
      {
        const int q = w * 8 + (lane & 7);
        const bool need = (lane < 8) && (q < chunk);
        unsigned* fp = (unsigned*)(p.ws + W_FLAG) + (base + (need ? q : 0)) * 16 + nb;
        unsigned spins = 0;
        for (;;) {
          const unsigned f = need ? __hip_atomic_load(fp, __ATOMIC_RELAXED, __HIP_MEMORY_SCOPE_AGENT) : 1u;
          if (__ballot(f == 0u) == 0ull) break;
          __builtin_amdgcn_s_sleep(2);
          if (++spins > (1u << 20)) break;
        }
      }
      float Pq[8], Hq[8];
#pragma unroll
      for (int k = 0; k < 8; k++) {
        const int q = w * 8 + k;
        const bool ok = q < chunk;
        Pq[k] = ok ? __hip_atomic_load(&AGGP[(base + q) * 1024 + c], __ATOMIC_RELAXED, __HIP_MEMORY_SCOPE_AGENT) : 1.f;
        Hq[k] = ok ? __hip_atomic_load(&AGGH[(base + q) * 1024 + c], __ATOMIC_RELAXED, __HIP_MEMORY_SCOPE_AGENT) : 0.f;
      }
      float Pc = 1.f, hc = 0.f;
#pragma unroll
      for (int k = 0; k < 8; k++) { hc = Pq[k] * hc + Hq[k]; Pc *= Pq[k]; }
      carL[(w * 64 + lane) * 2] = Pc;
      carL[(w * 64 + lane) * 2 + 1] = hc;
      __syncthreads();
    }
    if (mode == 0) {
    } else {
      float hin = 0.f;
#pragma unroll
      for (int q = 0; q < 4; q++) hin = carL[(q * 64 + lane) * 2] * hin + carL[(q * 64 + lane) * 2 + 1];
      for (int q = 0; q < w; q++) hin = aggL[(q * 64 + lane) * 2] * hin + aggL[(q * 64 + lane) * 2 + 1];
      float hh = hin;
#pragma unroll 8
      for (int rr = 0; rr < 32; rr++) {
        const int row = w * 32 + rr;
        const float av = aL[row * XC_LD + lane], bv = xcF[row * XC_LD + lane];
        hh = av * hh + bv;
        xcF[row * XC_LD + lane] = hh;
      }
      if (chunk == 31 && w == 3) p.out[O_LRUP + (size_t)(mt >> 5) * 1024 + c] = hh;
    }
  } else {
    float hh = 0.f;
    float h0v[4];
#pragma unroll
    for (int k = 0; k < 4; k++) h0v[k] = p.state_lru[(size_t)(((m0 - NP + w * 32) >> 3) + k) * 1024 + c];
#pragma unroll
    for (int rr = 0; rr < 32; rr++) {
      const int row = w * 32 + rr;
      const int bb = (m0 - NP + row) >> 3;
      const int t = row & 7;
      if (t == 0) hh = h0v[rr >> 3];
      const float av = aL[row * XC_LD + lane], bv = xcF[row * XC_LD + lane];
      hh = av * hh + bv;
      xcF[row * XC_LD + lane] = hh;
      if (t == 7) p.out[O_LRUS + (size_t)bb * 1024 + c] = hh;
    }
  }
  if (mode != 0) {
    __syncthreads();
    u16* LO = (u16*)(p.ws + W_LO);
    const int ch = tid & 7;
#pragma unroll
    for (int it = 0; it < 4; it++) {
      const int r = (tid >> 3) + it * 32;
      float g[8];
      unpack8(*(const uint4*)(ZA + (size_t)(m0 + r) * 2048 + 1024 + cb + ch * 8), g);
      const float4 h0 = *(const float4*)(xcF + r * XC_LD + ch * 8), h1 = *(const float4*)(xcF + r * XC_LD + ch * 8 + 4);
      float v[8] = {h0.x * gelu_tanh(g[0]), h0.y * gelu_tanh(g[1]), h0.z * gelu_tanh(g[2]), h0.w * gelu_tanh(g[3]),
                    h1.x * gelu_tanh(g[4]), h1.y * gelu_tanh(g[5]), h1.z * gelu_tanh(g[6]), h1.w * gelu_tanh(g[7])};
      *(uint4*)(LO + (size_t)(m0 + r) * 1024 + cb + ch * 8) = pack8(v);
    }
  }
}

template <int NW>
__device__ __forceinline__ void g3_tile(KParams& p, char* smem, int mt, int n0) {
  const int tid = opaque_tid();
  float* Cs = (float*)smem;
  const u16* LO = (const u16*)(p.ws + W_LO);
  const u16* ATT = (const u16*)(p.ws + W_XN);
  const u16* WL = (const u16*)(p.ws + W_WTLRU);
  const u16* WA = (const u16*)(p.ws + W_WTATTN);
  const u16* ZC = (const u16*)p.out;
  u16* MG = (u16*)(p.ws + W_ZA);
  constexpr int TPR = NW / 8;
  constexpr int RPI = 256 / TPR;
  const int cc = (tid % TPR) * 8;
#pragma unroll
  for (int pass = 0; pass < 2; pass++) {
    f32x4 acc[4][NW / 32];
    zero_acc(acc);
    gemm_tile<NW>((pass ? ATT : LO) + (size_t)mt * 128 * 1024, 1024, (pass ? WA : WL) + (size_t)n0 * 1024, 1024, 1024, acc,
                  smem, tid);
    __syncthreads();
    acc_to_cs(acc, Cs, tid);
    __syncthreads();
#pragma unroll
    for (int i = 0; i < 128 / RPI; i++) {
      const int r = (tid / TPR) + RPI * i;
      const size_t row = (size_t)(mt * 128 + r);
      float4 a = *(const float4*)(Cs + r * CS_LD + cc), b = *(const float4*)(Cs + r * CS_LD + cc + 4);
      float v[8] = {a.x, a.y, a.z, a.w, b.x, b.y, b.z, b.w};
      float g[8];
      unpack8(*(const uint4*)(ZC + row * 2048 + pass * 1024 + n0 + cc), g);
      u16* mp = MG + row * 1024 + n0 + cc;
      if (pass == 0) {
#pragma unroll
        for (int q = 0; q < 8; q++) v[q] *= sigmoidf_(g[q]);
      } else {
        float pv[8];
        unpack8(*(const uint4*)mp, pv);
#pragma unroll
        for (int q = 0; q < 8; q++) v[q] = pv[q] + v[q] * sigmoidf_(g[q]);
      }
      *(uint4*)mp = pack8(v);
    }
    __syncthreads();
  }
}

__device__ __forceinline__ void phase_g3(KParams& p, char* smem, int vb) {
  for (int it = blockIdx.x; it < 1024 + 128; it += gridDim.x) {
    int mt, nt;
    if (it < 1024) {
      tile_map(it, MT * 8, 8, mt, nt, vb);
      g3_tile<128>(p, smem, mt, nt * 128);
    } else {
      tile_map(1024 + ((it - 1024) >> 1), MT * 8, 8, mt, nt, vb);
      g3_tile<64>(p, smem, mt, nt * 128 + ((it - 1024) & 1) * 64);
    }
  }
}

template <int NW>
__device__ __forceinline__ void g4_tile(KParams& p, char* smem, int mt, int n0) {
  const int tid = opaque_tid();
  float* Cs = (float*)smem;
  const u16* MG = (const u16*)(p.ws + W_ZA);
  const u16* WO = (const u16*)(p.ws + W_WTOUT);
  u16* HG = (u16*)(p.ws + W_ZB);
  float* SSQ = (float*)(p.ws + W_SSQ);
  constexpr int TPR = NW / 8;
  constexpr int RPI = 256 / TPR;
  f32x4 acc[4][NW / 32];
  zero_acc(acc);
  gemm_tile<NW>(MG + (size_t)mt * 128 * 1024, 1024, WO + (size_t)n0 * 1024, 1024, 1024, acc, smem, tid);
  __syncthreads();
  acc_to_cs(acc, Cs, tid);
  __syncthreads();
  const int cc = (tid % TPR) * 8;
  const float4 g0 = *(const float4*)(p.norm2_g + n0 + cc), g1 = *(const float4*)(p.norm2_g + n0 + cc + 4);
#pragma unroll
  for (int i = 0; i < 128 / RPI; i++) {
    const int r = (tid / TPR) + RPI * i;
    const int row = mt * 128 + r;
    float4 a = *(const float4*)(Cs + r * CS_LD + cc), b = *(const float4*)(Cs + r * CS_LD + cc + 4);
    const float* xr = xrow(p, row) + n0 + cc;
    float4 x0 = *(const float4*)xr, x1 = *(const float4*)(xr + 4);
    a.x += x0.x; a.y += x0.y; a.z += x0.z; a.w += x0.w;
    b.x += x1.x; b.y += x1.y; b.z += x1.z; b.w += x1.w;
    float* ho = p.out + O_Y + (size_t)row * 1024 + n0 + cc;
    *(float4*)ho = a;
    *(float4*)(ho + 4) = b;
    float v[8] = {a.x * g0.x, a.y * g0.y, a.z * g0.z, a.w * g0.w, b.x * g1.x, b.y * g1.y, b.z * g1.z, b.w * g1.w};
    *(uint4*)(HG + (size_t)row * 1024 + n0 + cc) = pack8(v);
    float ss = a.x * a.x + a.y * a.y + a.z * a.z + a.w * a.w + b.x * b.x + b.y * b.y + b.z * b.z + b.w * b.w;
    ss += __shfl_xor(ss, 1);
    ss += __shfl_xor(ss, 2);
    ss += __shfl_xor(ss, 4);
    if ((tid & 7) == 0) SSQ[(size_t)row * 16 + ((n0 + cc) >> 6)] = ss;
  }
  __syncthreads();
}

__device__ __forceinline__ void phase_g4(KParams& p, char* smem, int vb) {
  for (int it = blockIdx.x; it < 1024 + 128; it += gridDim.x) {
    int mt, nt;
    if (it < 1024) {
      tile_map(it, MT * 8, 8, mt, nt, vb);
      g4_tile<128>(p, smem, mt, nt * 128);
    } else {
      tile_map(1024 + ((it - 1024) >> 1), MT * 8, 8, mt, nt, vb);
      g4_tile<64>(p, smem, mt, nt * 128 + ((it - 1024) & 1) * 64);
    }
  }
}

__device__ __forceinline__ float row_rstd(const float* SSQ, int row) {
  const float4 a = *(const float4*)(SSQ + (size_t)row * 16), b = *(const float4*)(SSQ + (size_t)row * 16 + 4),
               c = *(const float4*)(SSQ + (size_t)row * 16 + 8), d = *(const float4*)(SSQ + (size_t)row * 16 + 12);
  const float ss = (((a.x + a.y) + (a.z + a.w)) + ((b.x + b.y) + (b.z + b.w))) +
                   (((c.x + c.y) + (c.z + c.w)) + ((d.x + d.y) + (d.z + d.w)));
  return rsqrtf(ss * (1.f / 1024.f) + EPS);
}

template <int NW>
__device__ __forceinline__ void g5_tile(KParams& p, char* smem, int mt, int n0) {
  const int tid = opaque_tid();
  float* Cs = (float*)smem;
  const u16* HG = (const u16*)(p.ws + W_ZB);
  const u16* WQ = (const u16*)(p.ws + W_WTQ);
  const float* SSQ = (const float*)(p.ws + W_SSQ);
  u16* QR = (u16*)(p.ws + W_ZA);
  constexpr int TPR = NW / 8;
  constexpr int RPI = 256 / TPR;
  f32x4 acc[4][NW / 32];
  zero_acc(acc);
  gemm_tile<NW>(HG + (size_t)mt * 128 * 1024, 1024, WQ + (size_t)n0 * 1024, 1024, 1024, acc, smem, tid);
  __syncthreads();
  acc_to_cs(acc, Cs, tid);
  __syncthreads();
  const int cc = (tid % TPR) * 8;
#pragma unroll
  for (int i = 0; i < 128 / RPI; i++) {
    const int r = (tid / TPR) + RPI * i;
    const int row = mt * 128 + r;
    const float rs = row_rstd(SSQ, row);
    float4 a = *(const float4*)(Cs + r * CS_LD + cc), b = *(const float4*)(Cs + r * CS_LD + cc + 4);
    float v[8] = {a.x * rs, a.y * rs, a.z * rs, a.w * rs, b.x * rs, b.y * rs, b.z * rs, b.w * rs};
    *(uint4*)(QR + (size_t)row * 2048 + n0 + cc) = pack8(v);
  }
  __syncthreads();
}

__device__ __forceinline__ void phase_g5(KParams& p, char* smem, int vb) {
  for (int it = blockIdx.x; it < 2048 + 256; it += gridDim.x) {
    int mt, nt;
    if (it < 2048) {
      tile_map(it, MT * 16, 16, mt, nt, vb);
      g5_tile<128>(p, smem, mt, nt * 128);
    } else {
      tile_map(2048 + ((it - 2048) >> 1), MT * 16, 16, mt, nt, vb);
      g5_tile<64>(p, smem, mt, nt * 128 + ((it - 2048) & 1) * 64);
    }
  }
}

__device__ __forceinline__ void phase_g6(KParams& p, char* smem, int vb) {
  const int tid = opaque_tid();
  u16* As = (u16*)smem;
  u16* Bs = As + 2 * 128 * LDT;
  float* Cs = (float*)smem;
  uint32_t* Cu = (uint32_t*)smem;
  uint32_t* TK0 = (uint32_t*)(smem + 128 * CS_LD * 4);
  const u16* QR = (const u16*)(p.ws + W_ZA);
  const u16* SK = (const u16*)(p.ws + W_SK);
  int* IDX = (int*)(p.ws + W_XN);
  float* GW = (float*)(p.ws + W_XN + (size_t)NTOK * 128 * 4);
  const int row = tid >> 1, half = tid & 1;
  for (int t = blockIdx.x; t < MT * 8; t += gridDim.x) {
    int mt, h;
    tile_map(t, MT * 8, 8, mt, h, vb);
    uint32_t tk[16];
    for (int pp = 0; pp < 2; pp++) {
      f32x4 acc[4][4];
      zero_acc(acc);
      gemm_tile<128>(QR + (size_t)mt * 128 * 2048 + h * 256 + pp * 128, 2048, SK + (size_t)(h * 2 + pp) * 16384, 128, 128, acc,
                smem, tid);
      __syncthreads();
      acc_to_cs(acc, Cs, tid);
      __syncthreads();
#pragma unroll
      for (int g = 0; g < 4; g++) {
        uint32_t sg[16];
#pragma unroll
        for (int q4 = 0; q4 < 4; q4++) {
          const int col = half * 64 + g * 16 + q4 * 4;
          const float4 v = *(const float4*)(Cs + row * CS_LD + col);
          sg[q4 * 4 + 0] = (ordf(v.x) & ~0x7Fu) | (uint32_t)(127 - col);
          sg[q4 * 4 + 1] = (ordf(v.y) & ~0x7Fu) | (uint32_t)(126 - col);
          sg[q4 * 4 + 2] = (ordf(v.z) & ~0x7Fu) | (uint32_t)(125 - col);
          sg[q4 * 4 + 3] = (ordf(v.w) & ~0x7Fu) | (uint32_t)(124 - col);
        }
        sort16_desc(sg);
        if (g == 0) {
#pragma unroll
          for (int q = 0; q < 16; q++) tk[q] = sg[q];
        } else {
          merge16_desc(tk, sg);
        }
      }
      __syncthreads();
      if (half == 1) {
#pragma unroll
        for (int q = 0; q < 16; q++) Cu[row * 16 + q] = tk[q];
      }
      __syncthreads();
      if (half == 0) {
        {
          uint32_t sg[16];
#pragma unroll
          for (int q4 = 0; q4 < 4; q4++) {
            const uint4 u = *(const uint4*)(Cu + row * 16 + q4 * 4);
            sg[q4 * 4] = u.x; sg[q4 * 4 + 1] = u.y; sg[q4 * 4 + 2] = u.z; sg[q4 * 4 + 3] = u.w;
          }
          merge16_desc(tk, sg);
        }
        if (pp == 0) {
#pragma unroll
          for (int q = 0; q < 16; q++) TK0[row * 16 + q] = tk[q];
        } else {
#pragma unroll
          for (int q = 0; q < 16; q++) Cu[2048 + row * 16 + q] = tk[q];
        }
      }
      __syncthreads();
    }
    if (half == 0) {
      float va[16], vb[16];
#pragma unroll
      for (int q = 0; q < 16; q++) {
        va[q] = unordf(TK0[row * 16 + q] & ~0x7Fu);
        vb[q] = unordf(tk[q] & ~0x7Fu);
      }
      uint32_t cd[16];
#pragma unroll
      for (int q = 0; q < 16; q++) cd[q] = (ordf(va[0] + vb[q]) & ~0xFFu) | (uint32_t)(255 - q);
#pragma unroll
      for (int i = 1; i < 16; i++) {
#pragma unroll
        for (int j = 0; j < 16; j++) {
          if ((i + 1) * (j + 1) <= 16) {
            const float sv = va[i] + vb[j];
            const uint32_t key = (ordf(sv) & ~0xFFu) | (uint32_t)(255 - (i * 16 + j));
            INS16(cd, key);
          }
        }
      }
      float ev[16];
      const float m0v = unordf(cd[0] & ~0xFFu);
      float esum = 0.f;
#pragma unroll
      for (int q = 0; q < 16; q++) {
        ev[q] = __expf(unordf(cd[q] & ~0xFFu) - m0v);
        esum += ev[q];
      }
      const float inv = 1.f / esum;
      const size_t ob = (size_t)(mt * 128 + row) * 128 + h * 16;
#pragma unroll
      for (int q = 0; q < 16; q++) {
        const int ij = 255 - (int)(cd[q] & 0xFFu);
        const int i0 = 127 - (int)(TK0[row * 16 + (ij >> 4)] & 0x7Fu);
        const int i1 = 127 - (int)(Cu[2048 + row * 16 + (ij & 15)] & 0x7Fu);
        IDX[ob + q] = i0 * 128 + i1;
        GW[ob + q] = ev[q] * inv;
      }
    }
    __syncthreads();
  }
}

typedef __attribute__((ext_vector_type(2))) float f32x2;
__device__ __forceinline__ void dec16(uint4 u, float* v) {
  f32x2 t;
  t = __builtin_amdgcn_cvt_pk_f32_fp8((int)u.x, false); v[0] = t.x; v[1] = t.y;
  t = __builtin_amdgcn_cvt_pk_f32_fp8((int)u.x, true); v[2] = t.x; v[3] = t.y;
  t = __builtin_amdgcn_cvt_pk_f32_fp8((int)u.y, false); v[4] = t.x; v[5] = t.y;
  t = __builtin_amdgcn_cvt_pk_f32_fp8((int)u.y, true); v[6] = t.x; v[7] = t.y;
  t = __builtin_amdgcn_cvt_pk_f32_fp8((int)u.z, false); v[8] = t.x; v[9] = t.y;
  t = __builtin_amdgcn_cvt_pk_f32_fp8((int)u.z, true); v[10] = t.x; v[11] = t.y;
  t = __builtin_amdgcn_cvt_pk_f32_fp8((int)u.w, false); v[12] = t.x; v[13] = t.y;
  t = __builtin_amdgcn_cvt_pk_f32_fp8((int)u.w, true); v[14] = t.x; v[15] = t.y;
}

__device__ __forceinline__ void phase7(KParams& p) {
  const int tid = opaque_tid(), lane = tid & 63, w = tid >> 6;
  const u16* HG = (const u16*)(p.ws + W_ZB);
  const float* SSQ = (const float*)(p.ws + W_SSQ);
  const int* IDX = (const int*)(p.ws + W_XN);
  const float* GW = (const float*)(p.ws + W_XN + (size_t)NTOK * 128 * 4);
  const unsigned char* EU = (const unsigned char*)(p.ws + W_EU);
  const unsigned char* EV = (const unsigned char*)(p.ws + W_EV);
  const float* ESC = (const float*)(p.ws + W_ESC);
  const int b0 = lane & 1, b1 = (lane >> 1) & 1, b2 = (lane >> 2) & 1;
  for (int tok = blockIdx.x * 4 + w; tok < NTOK; tok += gridDim.x * 4) {
    const float rs = row_rstd(SSQ, tok);
    float xh[16];
    {
      const uint4* hp = (const uint4*)(HG + (size_t)tok * 1024 + lane * 16);
      unpack8(hp[0], xh);
      unpack8(hp[1], xh + 8);
#pragma unroll
      for (int i = 0; i < 16; i++) xh[i] *= rs;
    }
    const int iA = IDX[(size_t)tok * 128 + lane], iB = IDX[(size_t)tok * 128 + 64 + lane];
    const float gA = GW[(size_t)tok * 128 + lane] * ESC[16384 + iA], gB = GW[(size_t)tok * 128 + 64 + lane] * ESC[16384 + iB];
    const float suA = ESC[iA], suB = ESC[iB];
    float dA = 0.f, dB = 0.f;
#pragma unroll 2
    for (int bb = 0; bb < 16; bb++) {
      const int isrc = bb < 8 ? iA : iB;
      float d[8];
      uint4 ur[8];
#pragma unroll
      for (int k = 0; k < 8; k++) {
        const int id = __builtin_amdgcn_readlane(isrc, (bb & 7) * 8 + k);
        ur[k] = *(const uint4*)(EU + (size_t)id * 1024 + lane * 16);
      }
#pragma unroll
      for (int k = 0; k < 8; k++) {
        float uv[16];
        dec16(ur[k], uv);
        float sacc = 0.f;
#pragma unroll
        for (int i = 0; i < 16; i++) sacc += xh[i] * uv[i];
        d[k] = sacc;
      }
      float e4[4], e2[2], e1;
#pragma unroll
      for (int i = 0; i < 4; i++) {
        const float keep = b0 ? d[2 * i + 1] : d[2 * i];
        const float send = b0 ? d[2 * i] : d[2 * i + 1];
        e4[i] = keep + __shfl_xor(send, 1);
      }
#pragma unroll
      for (int i = 0; i < 2; i++) {
        const float keep = b1 ? e4[2 * i + 1] : e4[2 * i];
        const float send = b1 ? e4[2 * i] : e4[2 * i + 1];
        e2[i] = keep + __shfl_xor(send, 2);
      }
      {
        const float keep = b2 ? e2[1] : e2[0];
        const float send = b2 ? e2[0] : e2[1];
        e1 = keep + __shfl_xor(send, 4);
      }
      e1 += __shfl_xor(e1, 8);
      e1 += __shfl_xor(e1, 16);
      e1 += __shfl_xor(e1, 32);
      const bool mine = (lane >> 3) == (bb & 7);
      if (bb < 8) dA = mine ? e1 : dA; else dB = mine ? e1 : dB;
    }
    const float actA = gelu_tanh(dA * suA) * gA, actB = gelu_tanh(dB * suB) * gB;
    float* ACT = (float*)(p.ws + W_ACT);
    ACT[(size_t)tok * 128 + lane] = actA;
    ACT[(size_t)tok * 128 + 64 + lane] = actB;
  }
}

__device__ __forceinline__ void phase7b(KParams& p) {
  const int tid = opaque_tid(), lane = tid & 63;
  const char* IDXb = (const char*)(p.ws + W_XN);
  const char* ACTb = (const char*)(p.ws + W_ACT);
  const char* EVb = (const char*)(p.ws + W_EV);
  char* Yb = (char*)(p.out + O_Y);
  unsigned* Q = (unsigned*)(p.ws + W_Q);
  const int esub = lane >> 3, c = lane & 7;
  const int pref = (int)(hw_xcc_id() & 7u);
  const int b3 = (lane >> 3) & 1, b4 = (lane >> 4) & 1, b5 = (lane >> 5) & 1;
  const uint32_t lane4 = (uint32_t)lane * 4u;
  const uint32_t yl = (uint32_t)(c * 16 + b3 * 8 + b4 * 4 + b5 * 2) * 4u;
  for (int k = 0; k < 8; k++) {
    const int sl = (pref + k) & 7;
    const char* Vs = EVb + (size_t)sl * (16384 * 128);
    const uint32_t vl = (uint32_t)c * 16u;
    for (;;) {
      unsigned it = 0;
      if (lane == 0) it = atomicAdd(Q + sl * 64, 1u);
      it = (unsigned)__builtin_amdgcn_readfirstlane((int)it);
      if (it >= (unsigned)(NTOK / 8)) break;
      const int tok0 = (int)it * 8;
      const char* ib = IDXb + (size_t)tok0 * 512;
      const char* ab = ACTb + (size_t)tok0 * 512;
      char* yb = Yb + (size_t)tok0 * 4096 + sl * 512;
      int nidA = *(const int*)(ib + lane4), nidB = *(const int*)(ib + 256 + lane4);
      float nacA = *(const float*)(ab + lane4), nacB = *(const float*)(ab + 256 + lane4);
      float2 nyv = *(const float2*)(yb + yl);
#pragma unroll 1
      for (int t = 0; t < 8; t++) {
        const int idA = nidA, idB = nidB;
        const float acA = nacA, acB = nacB;
        const float2 yv = nyv;
        char* ybt = yb;
        if (t < 7) {
          ib += 512; ab += 512; yb += 4096;
          nidA = *(const int*)(ib + lane4); nidB = *(const int*)(ib + 256 + lane4);
          nacA = *(const float*)(ab + lane4); nacB = *(const float*)(ab + 256 + lane4);
          nyv = *(const float2*)(yb + yl);
        }
        float o[16];
#pragma unroll
        for (int q = 0; q < 16; q++) o[q] = 0.f;
#pragma unroll
        for (int hf = 0; hf < 2; hf++) {
          uint4 vr[8];
#pragma unroll
          for (int i = 0; i < 8; i++) {
            const uint32_t id = (uint32_t)__shfl(hf ? idB : idA, i * 8 + esub);
            vr[i] = *(const uint4*)(Vs + (id * 128u + vl));
          }
#pragma unroll
          for (int i = 0; i < 8; i++) {
            float vv[16];
            dec16(vr[i], vv);
            const float a = __shfl(hf ? acB : acA, i * 8 + esub);
#pragma unroll
            for (int q = 0; q < 16; q++) o[q] += a * vv[q];
          }
        }
        float r8[8], r4[4], r2[2];
#pragma unroll
        for (int q = 0; q < 8; q++) {
          const float keep = b3 ? o[q + 8] : o[q];
          const float send = b3 ? o[q] : o[q + 8];
          r8[q] = keep + __shfl_xor(send, 8);
        }
#pragma unroll
        for (int q = 0; q < 4; q++) {
          const float keep = b4 ? r8[q + 4] : r8[q];
          const float send = b4 ? r8[q] : r8[q + 4];
          r4[q] = keep + __shfl_xor(send, 16);
        }
#pragma unroll
        for (int q = 0; q < 2; q++) {
          const float keep = b5 ? r4[q + 2] : r4[q];
          const float send = b5 ? r4[q] : r4[q + 2];
          r2[q] = keep + __shfl_xor(send, 32);
        }
        float2 h = yv;
        h.x += r2[0];
        h.y += r2[1];
        *(float2*)(ybt + yl) = h;
      }
    }
  }
}

#define XB_TMO      128
#define XB_XCNT(j)  (256  + 64 * (j))
#define XB_XSUB(j)  (1280 + 64 * (j))
#define XB_XGEN(j)  (2304 + 64 * (j))
#define XB_TOP      3328
#define XB_TOPGEN   3392
#define XCD_BAR_WORDS 3456
#define XB_SPIN_CAP (1u << 18)
#define LAS __attribute__((address_space(3)))
__device__ __forceinline__ unsigned xb_ld(unsigned* p) { return __hip_atomic_load(p, __ATOMIC_RELAXED, __HIP_MEMORY_SCOPE_AGENT); }
__device__ __forceinline__ unsigned xb_add(unsigned* p, unsigned v) { return __hip_atomic_fetch_add(p, v, __ATOMIC_RELAXED, __HIP_MEMORY_SCOPE_AGENT); }
__device__ __forceinline__ unsigned xb_xcc_id() { return (unsigned)__builtin_amdgcn_s_getreg((3 << 11) | 20) & 0xFu; }
#define XB_SPIN(cond, bar) do { unsigned _sp = 0; while (cond) { __builtin_amdgcn_s_sleep(1); \
    if ((++_sp & 255u) == 0u) { if (xb_ld(&(bar)[XB_TMO])) break; if (_sp > XB_SPIN_CAP) { atomicAdd(&(bar)[XB_TMO], 1u); break; } } } } while (0)
struct XcdBarrier { unsigned* bar; unsigned x; volatile LAS unsigned* st; };
__device__ __forceinline__ XcdBarrier xcd_barrier_post(unsigned* bar, volatile LAS unsigned* st) {
  XcdBarrier b; b.bar = bar; b.x = xb_xcc_id(); b.st = st;
  if (threadIdx.x == 0) st[2] = xb_add(&bar[XB_XCNT(b.x)], 1u);
  return b;
}
__device__ __forceinline__ void xcd_barrier_complete(unsigned* bar, unsigned x, unsigned& nloc, unsigned& nx) {
  const unsigned G = gridDim.x * gridDim.y * gridDim.z;
  unsigned sum, cnt, mine, sp = 0u;
  for (;;) {
    sum = 0u; cnt = 0u; mine = 0u;
#pragma unroll
    for (unsigned j = 0; j < 16; ++j) { const unsigned c = xb_ld(&bar[XB_XCNT(j)]); sum += c; cnt += (c > 0u) ? 1u : 0u; mine = (j == x) ? c : mine; }
    if (sum == G) break;
    __builtin_amdgcn_s_sleep(1);
    if ((++sp & 255u) == 0u) { if (xb_ld(&bar[XB_TMO])) break; if (sp > XB_SPIN_CAP) { atomicAdd(&bar[XB_TMO], 1u); break; } }
  }
  nloc = mine > 0u ? mine : 1u; nx = cnt > 0u ? cnt : 1u;
}
__device__ __forceinline__ void xcd_barrier(const XcdBarrier& b) {
  asm volatile("s_waitcnt vmcnt(0)" ::: "memory");
  __syncthreads();
  if (threadIdx.x == 0) {
    unsigned* bar = b.bar;
    __builtin_amdgcn_s_waitcnt(0);
    unsigned nloc = b.st[0], nx = b.st[1];
    if (nloc == 0u) { xcd_barrier_complete(bar, b.x, nloc, nx); b.st[0] = nloc; b.st[1] = nx; }
    const unsigned old = xb_add(&bar[XB_XSUB(b.x)], 1u);
    const unsigned gen = old / nloc;
    if (old + 1u == (gen + 1u) * nloc) {
      __builtin_amdgcn_fence(__ATOMIC_RELEASE, "agent");
      asm volatile("s_waitcnt vmcnt(0)" ::: "memory");
      const unsigned og = xb_add(&bar[XB_TOP], 1u);
      const unsigned tg = og / nx;
      if (og + 1u == (tg + 1u) * nx) xb_add(&bar[XB_TOPGEN], 1u);
      else XB_SPIN(xb_ld(&bar[XB_TOPGEN]) == tg, bar);
      __builtin_amdgcn_fence(__ATOMIC_ACQUIRE, "agent");
      xb_add(&bar[XB_XGEN(b.x)], 1u);
      asm volatile("s_waitcnt vmcnt(0)" ::: "memory");
    } else {
      XB_SPIN(xb_ld(&bar[XB_XGEN(b.x)]) == gen, bar);
      __builtin_amdgcn_fence(__ATOMIC_ACQUIRE, "agent");
      asm volatile("s_waitcnt vmcnt(0)" ::: "memory");
    }
  }
  __syncthreads();
}

#ifndef REP_MASK
#define REP_MASK 0
#endif
#define REPS(k) for (int _rep = 0; _rep < (((REP_MASK) >> (k)) & 1) + 1; _rep++)
__global__ void __launch_bounds__(256, 2) fwd_megakernel(Params p_) {
  extern __shared__ __attribute__((aligned(16))) char smem[];
  cg::grid_group grid = cg::this_grid();
  if (p_.ws == nullptr) grid.sync();
  volatile LAS unsigned* xst = (volatile LAS unsigned*)(smem + SMEM_BYTES - 16);
  if (threadIdx.x == 0) { xst[0] = 0u; xst[1] = 0u; xst[2] = 0u; xst[3] = 0u; }
  __syncthreads();
  const XcdBarrier xb = xcd_barrier_post((unsigned*)(p_.ws + W_BAR), xst);
  REPS(0) { phase0(*fresh_params(), smem); xcd_barrier(xb); }
  if (threadIdx.x == 0) {
    unsigned* bar = (unsigned*)(p_.ws + W_BAR);
    const unsigned per = gridDim.x >> 3;
    bool uni = (gridDim.x & 7u) == 0u;
    for (unsigned j = 0; j < 16; ++j) { const unsigned cnt = xb_ld(&bar[XB_XCNT(j)]); if (cnt != (j < 8 ? per : 0u)) uni = false; }
    xst[3] = uni ? (xb.x * per + xst[2]) : blockIdx.x;
  }
  __syncthreads();
  const int vb = (int)xst[3];
  REPS(1) { phase_g1(*fresh_params(), smem, vb); xcd_barrier(xb); }
  REPS(2) {
    for (int it = blockIdx.x; it < MT * 16 + 1536; it += gridDim.x) {
      if (it < MT * 16) { const int mt = it >> 4; lru_tile(*fresh_params(), smem, mt, it & 15, mt < 128 ? 2 : 1); }
      else attn_item(*fresh_params(), smem, it - MT * 16);
    }
    xcd_barrier(xb);
  }
  REPS(4) { phase_g3(*fresh_params(), smem, vb); xcd_barrier(xb); }
  REPS(5) { phase_g4(*fresh_params(), smem, vb); xcd_barrier(xb); }
  REPS(6) { phase_g5(*fresh_params(), smem, vb); xcd_barrier(xb); }
  REPS(7) { phase_g6(*fresh_params(), smem, vb); xcd_barrier(xb); }
  phase7(*fresh_params());
  xcd_barrier(xb);
  phase7b(*fresh_params());
}

extern "C" void kernel_launch(void* const* d_in, const int* in_sizes, int n_in, void* d_out, int out_size, void* d_ws,
                              size_t ws_size, hipStream_t stream) {
  static int grid_blocks = 0;
  if (!grid_blocks) {
    int dev = 0, cus = 0, per_cu = 0;
    hipGetDevice(&dev);
    hipDeviceGetAttribute(&cus, hipDeviceAttributeMultiprocessorCount, dev);
    hipFuncSetAttribute((const void*)fwd_megakernel, hipFuncAttributeMaxDynamicSharedMemorySize, SMEM_BYTES);
    hipOccupancyMaxActiveBlocksPerMultiprocessor(&per_cu, fwd_megakernel, 256, SMEM_BYTES);
    if (per_cu < 1) per_cu = 1;
    grid_blocks = cus * per_cu;
  }
  Params p{};
  const float** pp = (const float**)&p;
  for (int i = 0; i < 26; i++) pp[i] = (const float*)d_in[i];
  p.out = (float*)d_out;
  p.ws = (char*)d_ws;
  (void)hipMemsetAsync((char*)d_ws + W_BAR, 0, (size_t)3456 * 4 + 8 * 256 + 2048 * 4, stream);
  void* args[] = {&p};
  hipError_t e = hipLaunchCooperativeKernel((void*)fwd_megakernel, dim3(grid_blocks), dim3(256), args, SMEM_BYTES, stream);
  if (e != hipSuccess) fprintf(stderr, "cooperative launch failed: %s (grid %d)\n", hipGetErrorString(e), grid_blocks);
}
```

```cpp
#include <hip/hip_runtime.h>
#include <hip/hip_cooperative_groups.h>
#include <stdint.h>
#include <cstdio>
namespace cg = cooperative_groups;

typedef unsigned short u16;
typedef __attribute__((ext_vector_type(8))) short bf16x8;
typedef __attribute__((ext_vector_type(4))) float f32x4;

constexpr int D = 1024;
constexpr int NP = 16384;
constexpr int NTOK = 17408;
constexpr int SEQ = 4096;
constexpr int MT = 136;
constexpr float EPS = 1e-6f;

constexpr size_t O_Y = 0;
constexpr size_t O_CONVP = 17825792;
constexpr size_t O_LRUP = O_CONVP + 12288;
constexpr size_t O_KP = O_LRUP + 4096;
constexpr size_t O_VP = O_KP + 131072;
constexpr size_t O_CONVS = O_VP + 131072;
constexpr size_t O_LRUS = O_CONVS + 393216;
constexpr size_t O_KS = O_LRUS + 131072;
constexpr size_t O_VS = O_KS + 4194304;

constexpr size_t W_WTIN = 0;
constexpr size_t W_WTLRU = W_WTIN + (size_t)5632 * 1024 * 2;
constexpr size_t W_WTATTN = W_WTLRU + (size_t)1024 * 1024 * 2;
constexpr size_t W_WTOUT = W_WTATTN + (size_t)1024 * 1024 * 2;
constexpr size_t W_WTQ = W_WTOUT + (size_t)1024 * 1024 * 2;
constexpr size_t W_SK = W_WTQ + (size_t)2048 * 1024 * 2;
constexpr size_t W_RGA = W_SK + (size_t)16 * 128 * 128 * 2;
constexpr size_t W_RGX = W_RGA + (size_t)65536 * 2;
constexpr size_t W_EU = W_RGX + (size_t)65536 * 2;
constexpr size_t W_EV = W_EU + (size_t)16384 * 1024;
constexpr size_t W_ESC = W_EV + (size_t)16384 * 1024;
constexpr size_t W_XN = W_ESC + (size_t)32768 * 4;
constexpr size_t W_ZA = W_XN + (size_t)NTOK * 1024 * 2;
constexpr size_t W_ZB = W_ZA + (size_t)NTOK * 2048 * 2;
constexpr size_t W_AGG = W_ZB + (size_t)NTOK * 1536 * 2;
constexpr size_t W_SSQ = W_AGG + (size_t)128 * 1024 * 2 * 4;
constexpr size_t W_BAR = W_SSQ + (size_t)NTOK * 16 * 4;
constexpr size_t W_Q = W_BAR + (size_t)3456 * 4;
constexpr size_t W_FLAG = W_Q + (size_t)8 * 256;
constexpr size_t W_CNT = W_FLAG + (size_t)2048 * 4;
constexpr size_t W_ACT = W_CNT + (size_t)2176 * 4;
constexpr size_t W_LO = W_ACT + (size_t)NTOK * 128 * 4;
constexpr size_t W_END = W_LO + (size_t)NTOK * 1024 * 2;

constexpr int SMEM_BYTES = 81920;

struct Params {
  const float *x_prompt, *x_sample, *cache_conv, *state_lru, *cache_k, *cache_v, *norm1_g, *w_in, *conv_w,
      *conv_b, *rg_w_a, *rg_b_a, *rg_w_x, *rg_b_x, *rg_lambda, *q_norm_g, *k_norm_g, *attn_sinks,
      *w_branch_lru, *w_branch_attn, *w_out, *norm2_g, *peer_w_query, *peer_sub_keys, *expert_u, *expert_v;
  float* out;
  char* ws;
};

typedef const __attribute__((address_space(4))) Params KParams;
__device__ __forceinline__ KParams* fresh_params() {
  unsigned long long k = (unsigned long long)__builtin_amdgcn_kernarg_segment_ptr();
  asm volatile("" : "+s"(k));
  return (KParams*)k;
}
__device__ __forceinline__ u16 f2bf(float f) {
  uint32_t u = __float_as_uint(f);
  u += 0x7FFFu + ((u >> 16) & 1u);
  return (u16)(u >> 16);
}
__device__ __forceinline__ float bf2f(u16 h) { return __uint_as_float(((uint32_t)h) << 16); }
__device__ __forceinline__ uint32_t pack2(float a, float b) {
  uint32_t r;
  asm("v_cvt_pk_bf16_f32 %0, %1, %2" : "=v"(r) : "v"(a), "v"(b));
  return r;
}
__device__ __forceinline__ uint4 pack8(const float* v) {
  uint4 o;
  o.x = pack2(v[0], v[1]); o.y = pack2(v[2], v[3]); o.z = pack2(v[4], v[5]); o.w = pack2(v[6], v[7]);
  return o;
}
__device__ __forceinline__ void unpack8(uint4 u, float* v) {
  v[0] = __uint_as_float(u.x << 16); v[1] = __uint_as_float(u.x & 0xFFFF0000u);
  v[2] = __uint_as_float(u.y << 16); v[3] = __uint_as_float(u.y & 0xFFFF0000u);
  v[4] = __uint_as_float(u.z << 16); v[5] = __uint_as_float(u.z & 0xFFFF0000u);
  v[6] = __uint_as_float(u.w << 16); v[7] = __uint_as_float(u.w & 0xFFFF0000u);
}
__device__ __forceinline__ float sigmoidf_(float x) { return __builtin_amdgcn_rcpf(1.f + __expf(-x)); }
__device__ __forceinline__ float gelu_tanh(float x) {
  float y = 0.7978845608028654f * (x + 0.044715f * x * x * x);
  float t = 1.f - 2.f * __builtin_amdgcn_rcpf(__expf(2.f * y) + 1.f);
  return 0.5f * x * (1.f + t);
}
__device__ __forceinline__ uint32_t ordf(float f) {
  uint32_t u = __float_as_uint(f);
  return (u & 0x80000000u) ? ~u : (u | 0x80000000u);
}
__device__ __forceinline__ float unordf(uint32_t o) {
  uint32_t u = (o & 0x80000000u) ? (o ^ 0x80000000u) : ~o;
  return __uint_as_float(u);
}
__device__ __forceinline__ unsigned hw_xcc_id() { return (unsigned)__builtin_amdgcn_s_getreg((3 << 11) | 20) & 0xFu; }
__device__ __forceinline__ int opaque_tid() {
  int t = threadIdx.x;
  asm volatile("" : "+v"(t));
  return t;
}
__device__ __forceinline__ const float* xrow(KParams& p, int row) {
  return row < NP ? p.x_prompt + (size_t)row * D : p.x_sample + (size_t)(row - NP) * D;
}

#define INS16(T, V)                                  \
  {                                                  \
    uint32_t _v = (V);                               \
    _Pragma("unroll") for (int _q = 0; _q < 16; _q++) { \
      uint32_t _hi = max(T[_q], _v);                 \
      _v = min(T[_q], _v);                           \
      T[_q] = _hi;                                   \
    }                                                \
  }

#define CE_DESC(A_, B_) { const uint32_t _h = max(A_, B_), _l = min(A_, B_); A_ = _h; B_ = _l; }
__device__ __forceinline__ void sort16_desc(uint32_t (&t)[16]) {
#pragma unroll
  for (int k = 2; k <= 16; k <<= 1) {
#pragma unroll
    for (int j = k >> 1; j > 0; j >>= 1) {
#pragma unroll
      for (int i = 0; i < 16; i++) {
        const int l = i ^ j;
        if (l > i) {
          if ((i & k) == 0) { CE_DESC(t[i], t[l]); } else { CE_DESC(t[l], t[i]); }
        }
      }
    }
  }
}
__device__ __forceinline__ void merge16_desc(uint32_t (&T)[16], const uint32_t (&S)[16]) {
#pragma unroll
  for (int i = 0; i < 16; i++) T[i] = max(T[i], S[15 - i]);
#pragma unroll
  for (int j = 8; j > 0; j >>= 1) {
#pragma unroll
    for (int i = 0; i < 16; i++) {
      const int l = i ^ j;
      if (l > i) { CE_DESC(T[i], T[l]); }
    }
  }
}

__device__ __forceinline__ void transpose_cvt(const float* __restrict__ W, u16* __restrict__ Wt, int K, int N,
                                              size_t gtid, size_t gsz) {
  size_t total = (size_t)N * (K / 8);
  for (size_t c = gtid; c < total; c += gsz) {
    int n = (int)(c % N);
    int kg = (int)(c / N);
    float v[8];
#pragma unroll
    for (int i = 0; i < 8; i++) v[i] = W[(size_t)(kg * 8 + i) * N + n];
    *(uint4*)(Wt + (size_t)n * K + kg * 8) = pack8(v);
  }
}
__device__ __forceinline__ void plain_cvt(const float* __restrict__ S, u16* __restrict__ Dst, size_t n, size_t gtid,
                                          size_t gsz) {
  size_t total = n / 8;
  const float4* s4 = (const float4*)S;
  for (size_t c = gtid; c < total; c += gsz) {
    float4 a = s4[2 * c], b = s4[2 * c + 1];
    float v[8] = {a.x, a.y, a.z, a.w, b.x, b.y, b.z, b.w};
    *(uint4*)(Dst + c * 8) = pack8(v);
  }
}

__device__ __forceinline__ void phase0(KParams& p, char* smem) {
  const int tid = opaque_tid();
  const size_t gtid = (size_t)blockIdx.x * 256 + tid, gsz = (size_t)gridDim.x * 256;
  char* ws = p.ws;
  {
    const int lane = tid & 63;
    const int gw = (int)(gtid >> 6), nw = (int)(gsz >> 6);
    u16* XN = (u16*)(ws + W_XN);
    for (int row = gw; row < NTOK; row += nw) {
      const float4* xr = (const float4*)xrow(p, row);
      float4 v[4];
      float ss = 0.f;
#pragma unroll
      for (int i = 0; i < 4; i++) {
        v[i] = xr[lane + i * 64];
        ss += v[i].x * v[i].x + v[i].y * v[i].y + v[i].z * v[i].z + v[i].w * v[i].w;
      }
#pragma unroll
      for (int o = 32; o > 0; o >>= 1) ss += __shfl_xor(ss, o);
      float rstd = rsqrtf(ss * (1.f / 1024.f) + EPS);
      const float4* g4 = (const float4*)p.norm1_g;
#pragma unroll
      for (int i = 0; i < 4; i++) {
        float4 g = g4[lane + i * 64];
        uint2 o;
        o.x = pack2(v[i].x * rstd * g.x, v[i].y * rstd * g.y);
        o.y = pack2(v[i].z * rstd * g.z, v[i].w * rstd * g.w);
        *(uint2*)(XN + (size_t)row * D + (lane + i * 64) * 4) = o;
      }
    }
  }
  {
    float* T = (float*)smem;
    for (int tile = blockIdx.x; tile < 2688; tile += gridDim.x) {
      const float* W;
      u16* Wt;
      int N, tl;
      if (tile < 1408) { W = p.w_in; Wt = (u16*)(ws + W_WTIN); N = 5632; tl = tile; }
      else if (tile < 1664) { W = p.w_branch_lru; Wt = (u16*)(ws + W_WTLRU); N = 1024; tl = tile - 1408; }
      else if (tile < 1920) { W = p.w_branch_attn; Wt = (u16*)(ws + W_WTATTN); N = 1024; tl = tile - 1664; }
      else if (tile < 2176) { W = p.w_out; Wt = (u16*)(ws + W_WTOUT); N = 1024; tl = tile - 1920; }
      else { W = p.peer_w_query; Wt = (u16*)(ws + W_WTQ); N = 2048; tl = tile - 2176; }
      const int ntn = N >> 6;
      const int kt = tl / ntn, nt = tl - kt * ntn;
      __syncthreads();
      {
        const float* src = W + (size_t)(kt * 64 + (tid >> 2)) * N + nt * 64 + (tid & 3) * 16;
        const float4 a0 = *(const float4*)src, a1 = *(const float4*)(src + 4), a2 = *(const float4*)(src + 8),
                     a3 = *(const float4*)(src + 12);
        float* d = T + (tid >> 2) * 65 + (tid & 3) * 16;
        d[0] = a0.x; d[1] = a0.y; d[2] = a0.z; d[3] = a0.w; d[4] = a1.x; d[5] = a1.y; d[6] = a1.z; d[7] = a1.w;
        d[8] = a2.x; d[9] = a2.y; d[10] = a2.z; d[11] = a2.w; d[12] = a3.x; d[13] = a3.y; d[14] = a3.z; d[15] = a3.w;
      }
      __syncthreads();
      {
        const int n = tid >> 2, kc = (tid & 3) * 16;
        float v[16];
#pragma unroll
        for (int i = 0; i < 16; i++) v[i] = T[(kc + i) * 65 + n];
        u16* dst = Wt + (size_t)(nt * 64 + n) * 1024 + kt * 64 + kc;
        *(uint4*)dst = pack8(v);
        *(uint4*)(dst + 8) = pack8(v + 8);
      }
    }
  }
  {
    u16* RA = (u16*)(ws + W_RGA);
    u16* RX = (u16*)(ws + W_RGX);
    for (size_t e = gtid; e < 65536; e += gsz) {
      int n = (int)(e >> 12), k = (int)((e >> 6) & 63), j = (int)(e & 63);
      RA[e] = f2bf(p.rg_w_a[n * 4096 + j * 64 + k]);
      RX[e] = f2bf(p.rg_w_x[n * 4096 + j * 64 + k]);
    }
  }
  plain_cvt(p.peer_sub_keys, (u16*)(ws + W_SK), (size_t)16 * 128 * 128, gtid, gsz);
  {
    const int lane = tid & 63;
    const int gw = (int)(gtid >> 6), nw = (int)(gsz >> 6);
    unsigned char* E8 = (unsigned char*)(ws + W_EU);
    float* ESC = (float*)(ws + W_ESC);
    for (int r = gw; r < 32768; r += nw) {
      const float* src = (r < 16384 ? p.expert_u : p.expert_v) + (size_t)(r & 16383) * 1024 + lane * 16;
      const float4 a0 = *(const float4*)src, a1 = *(const float4*)(src + 4), a2 = *(const float4*)(src + 8),
                   a3 = *(const float4*)(src + 12);
      float am = fmaxf(fmaxf(fmaxf(fabsf(a0.x), fabsf(a0.y)), fmaxf(fabsf(a0.z), fabsf(a0.w))),
                       fmaxf(fmaxf(fabsf(a1.x), fabsf(a1.y)), fmaxf(fabsf(a1.z), fabsf(a1.w))));
      am = fmaxf(am, fmaxf(fmaxf(fmaxf(fabsf(a2.x), fabsf(a2.y)), fmaxf(fabsf(a2.z), fabsf(a2.w))),
                           fmaxf(fmaxf(fabsf(a3.x), fabsf(a3.y)), fmaxf(fabsf(a3.z), fabsf(a3.w)))));
#pragma unroll
      for (int o = 32; o > 0; o >>= 1) am = fmaxf(am, __shfl_xor(am, o));
      const float sc = am > 0.f ? 224.f / am : 1.f;
      uint4 o4;
      int wv;
      wv = __builtin_amdgcn_cvt_pk_fp8_f32(a0.x * sc, a0.y * sc, 0, false);
      wv = __builtin_amdgcn_cvt_pk_fp8_f32(a0.z * sc, a0.w * sc, wv, true);
      o4.x = (uint32_t)wv;
      wv = __builtin_amdgcn_cvt_pk_fp8_f32(a1.x * sc, a1.y * sc, 0, false);
      wv = __builtin_amdgcn_cvt_pk_fp8_f32(a1.z * sc, a1.w * sc, wv, true);
      o4.y = (uint32_t)wv;
      wv = __builtin_amdgcn_cvt_pk_fp8_f32(a2.x * sc, a2.y * sc, 0, false);
      wv = __builtin_amdgcn_cvt_pk_fp8_f32(a2.z * sc, a2.w * sc, wv, true);
      o4.z = (uint32_t)wv;
      wv = __builtin_amdgcn_cvt_pk_fp8_f32(a3.x * sc, a3.y * sc, 0, false);
      wv = __builtin_amdgcn_cvt_pk_fp8_f32(a3.z * sc, a3.w * sc, wv, true);
      o4.w = (uint32_t)wv;
      if (r < 16384) *(uint4*)(E8 + (size_t)r * 1024 + lane * 16) = o4;
      else *(uint4*)(E8 + (size_t)16384 * 1024 + (size_t)(lane >> 3) * (16384 * 128) + (size_t)(r - 16384) * 128 + (lane & 7) * 16) = o4;
      if (lane == 0) ESC[r] = am > 0.f ? am * (1.f / 224.f) : 1.f;
    }
  }
}

constexpr int LDT = 72;
constexpr int CS_LD = 132;

template <int NW>
__device__ __forceinline__ void gemm_tile(const u16* __restrict__ A, int lda, const u16* __restrict__ Bt, int ldb,
                                          int K, f32x4 (&acc)[4][NW / 32], char* smem, int tid) {
  constexpr int NJ = NW / 32;
  const int lane = tid & 63, w = tid >> 6;
  const int wm = w >> 1, wn = w & 1;
  const int l15 = lane & 15, quad = lane >> 4;
  const int lr = w * 8 + (lane >> 3);
  const int lc = ((lane & 7) ^ ((lane >> 3) & 7)) * 8;
  const char* Ab = (const char*)A;
  const char* Bb = (const char*)Bt;
  const uint32_t ao = (uint32_t)(lr * lda + lc) * 2u, bo = (uint32_t)(lr * ldb + lc) * 2u;
  const uint32_t sa2 = 64u * (uint32_t)lda, sb2 = 64u * (uint32_t)ldb;
  const uint32_t kmask = (uint32_t)K - 1u, kst = (((uint32_t)blockIdx.x >> 3) * 64u) & kmask;
  char* lw = smem + w * 1024 + lane * 16;
  const int swz = l15 & 7;
  const char* Ar = smem + (wm * 64 + l15) * 128 + ((quad ^ swz) * 16);
  const char* Br = smem + 16384 + (wn * (NW / 2) + l15) * 128 + ((quad ^ swz) * 16);
  const char* Ar1 = smem + (wm * 64 + l15) * 128 + (((4 + quad) ^ swz) * 16);
  const char* Br1 = smem + 16384 + (wn * (NW / 2) + l15) * 128 + (((4 + quad) ^ swz) * 16);
#define GT_ISSUE(st, off)                                                                                   \
  {                                                                                                         \
    const uint32_t _o = (((uint32_t)(off) + kst) & kmask) * 2u;                                             \
    char* _l = lw + (st) * 32768;                                                                           \
    _Pragma("unroll") for (int j = 0; j < 4; j++) {                                                         \
      __builtin_amdgcn_global_load_lds((const unsigned*)(Ab + (size_t)(ao + j * sa2 + _o)), (unsigned*)(_l + j * 4096), 16, 0, 0);          \
      if (j < NJ) __builtin_amdgcn_global_load_lds((const unsigned*)(Bb + (size_t)(bo + j * sb2 + _o)), (unsigned*)(_l + 16384 + j * 4096), 16, 0, 0);  \
    }                                                                                                       \
  }
#define GT_MMA(st)                                                                                          \
  {                                                                                                         \
    const char* _ar = Ar + (st) * 32768; const char* _br = Br + (st) * 32768;                               \
    const char* _ar1 = Ar1 + (st) * 32768; const char* _br1 = Br1 + (st) * 32768;                           \
    bf16x8 a0[4], b0[NJ], a1[4], b1[NJ];                                                                      \
    _Pragma("unroll") for (int i = 0; i < 4; i++) {                                                         \
      a0[i] = *(const bf16x8*)(_ar + i * 2048);                                                             \
      if (i < NJ) b0[i] = *(const bf16x8*)(_br + i * 2048);                                                 \
    }                                                                                                       \
    _Pragma("unroll") for (int i = 0; i < 4; i++) {                                                         \
      a1[i] = *(const bf16x8*)(_ar1 + i * 2048);                                                            \
      if (i < NJ) b1[i] = *(const bf16x8*)(_br1 + i * 2048);                                                \
    }                                                                                                       \
    __builtin_amdgcn_s_setprio(1);                                                                          \
    _Pragma("unroll") for (int i = 0; i < 4; i++)                                                           \
      _Pragma("unroll") for (int j = 0; j < NJ; j++)                                                        \
        acc[i][j] = __builtin_amdgcn_mfma_f32_16x16x32_bf16(a0[i], b0[j], acc[i][j], 0, 0, 0);              \
    _Pragma("unroll") for (int i = 0; i < 4; i++)                                                           \
      _Pragma("unroll") for (int j = 0; j < NJ; j++)                                                        \
        acc[i][j] = __builtin_amdgcn_mfma_f32_16x16x32_bf16(a1[i], b1[j], acc[i][j], 0, 0, 0);              \
    __builtin_amdgcn_s_setprio(0);                                                                          \
  }
  __syncthreads();
  GT_ISSUE(0, 0);
  for (int k0 = 0; k0 < K; k0 += 128) {
    asm volatile("s_waitcnt vmcnt(0) lgkmcnt(0)" ::: "memory");
    __builtin_amdgcn_s_barrier();
    asm volatile("" ::: "memory");
    GT_ISSUE(1, k0 + 64);
    GT_MMA(0);
    asm volatile("s_waitcnt vmcnt(0) lgkmcnt(0)" ::: "memory");
    __builtin_amdgcn_s_barrier();
    asm volatile("" ::: "memory");
    if (k0 + 128 < K) GT_ISSUE(0, k0 + 128);
    GT_MMA(1);
  }
#undef GT_ISSUE
#undef GT_MMA
}

__device__ __forceinline__ void tile_map(int it, int total, int NT, int& mt, int& nt, int vb) {
  const int G = gridDim.x;
  int T = it;
  {
    const int round = it / G;
    if (round * G + G <= total) T = round * G + vb;
  }
  const int g = T / (8 * NT), r = T - g * (8 * NT);
  nt = r >> 3;
  mt = g * 8 + (r & 7);
}

template <int NJ>
__device__ __forceinline__ void zero_acc(f32x4 (&acc)[4][NJ]) {
#pragma unroll
  for (int i = 0; i < 4; i++)
#pragma unroll
    for (int j = 0; j < NJ; j++) acc[i][j] = (f32x4){0.f, 0.f, 0.f, 0.f};
}

template <int NJ>
__device__ __forceinline__ void acc_to_cs(const f32x4 (&acc)[4][NJ], float* Cs, int tid) {
  const int lane = tid & 63, w = tid >> 6;
  const int wm = w >> 1, wn = w & 1;
  const int l15 = lane & 15, quad = lane >> 4;
#pragma unroll
  for (int i = 0; i < 4; i++)
#pragma unroll
    for (int j = 0; j < NJ; j++)
#pragma unroll
      for (int e = 0; e < 4; e++)
        Cs[(wm * 64 + i * 16 + quad * 4 + e) * CS_LD + wn * (NJ * 16) + j * 16 + l15] = acc[i][j][e];
}

__device__ __forceinline__ void phase_g1(KParams& p, char* smem, int vb) {
  const int tid = opaque_tid();
  u16* As = (u16*)smem;
  u16* Bs = As + 2 * 128 * LDT;
  float* Cs = (float*)smem;
  const u16* XN = (const u16*)(p.ws + W_XN);
  const u16* WT = (const u16*)(p.ws + W_WTIN);
  for (int t = blockIdx.x; t < MT * 44; t += gridDim.x) {
    int mt, nt;
    tile_map(t, MT * 44, 44, mt, nt, vb);
    f32x4 acc[4][4];
    zero_acc(acc);
    gemm_tile<128>(XN + (size_t)mt * 128 * 1024, 1024, WT + (size_t)nt * 128 * 1024, 1024, 1024, acc, smem, tid);
    __syncthreads();
    acc_to_cs(acc, Cs, tid);
    __syncthreads();
    const int n0 = nt * 128;
    u16* dst;
    int ldd, col;
    if (n0 < 2048) { dst = (u16*)(p.ws + W_ZA); ldd = 2048; col = n0; }
    else if (n0 < 3584) { dst = (u16*)(p.ws + W_ZB); ldd = 1536; col = n0 - 2048; }
    else { dst = (u16*)p.out; ldd = 2048; col = n0 - 3584; }
    const int cc = (tid & 15) * 8;
#pragma unroll
    for (int i = 0; i < 8; i++) {
      const int r = (tid >> 4) + 16 * i;
      float4 a = *(const float4*)(Cs + r * CS_LD + cc), b = *(const float4*)(Cs + r * CS_LD + cc + 4);
      float v[8] = {a.x, a.y, a.z, a.w, b.x, b.y, b.z, b.w};
      *(uint4*)(dst + (size_t)(mt * 128 + r) * ldd + col + cc) = pack8(v);
    }
    __syncthreads();
  }
}

constexpr int KS_LD = 72, VT_LD = 200, PS_LD = 168;
__device__ __forceinline__ void attn_item(KParams& p, char* smem, int item) {
  const int tid = opaque_tid(), lane = tid & 63, w = tid >> 6, l15 = lane & 15, quad = lane >> 4;
  u16* Ks = (u16*)smem;
  u16* Vt = Ks + 192 * KS_LD;
  u16* Ps = Vt + 64 * VT_LD + w * 16 * PS_LD;
  const u16* ZB = (const u16*)(p.ws + W_ZB);
  u16* ATT = (u16*)(p.ws + W_XN);
  const bool sample = item >= 1024;
  int b, qb = 0, kv, rowbase, p0 = 0;
  if (!sample) {
    kv = item & 3; qb = (item >> 2) & 63; b = item >> 8;
    p0 = qb * 64;
    rowbase = b * SEQ + p0;
  } else {
    int it = item - 1024;
    kv = it & 3; b = it >> 2;
    rowbase = NP + b * 8;
  }
  __syncthreads();
  {
    const int ch = tid & 7;
    float kg[8];
#pragma unroll
    for (int i = 0; i < 8; i++) kg[i] = p.k_norm_g[ch * 8 + i];
    const int nrows = sample ? 160 : 192;
    for (int c = tid; c < nrows * 8; c += 256) {
      const int row = c >> 3;
      float kf[8], vf[8];
      bool valid, donorm;
      if (!sample) {
        const int pos = p0 - 128 + row;
        valid = pos >= 0;
        donorm = true;
        if (valid) {
          const u16* src = ZB + (size_t)(b * SEQ + pos) * 1536 + 1024 + kv * 64 + ch * 8;
          unpack8(*(const uint4*)src, kf);
          unpack8(*(const uint4*)(src + 256), vf);
        }
      } else {
        valid = row < 136;
        donorm = row >= 128;
        if (row < 128) {
          const float* sk = p.cache_k + ((size_t)(b * 128 + row) * 4 + kv) * 64 + ch * 8;
          const float* sv = p.cache_v + ((size_t)(b * 128 + row) * 4 + kv) * 64 + ch * 8;
          float4 a0 = *(const float4*)sk, a1 = *(const float4*)(sk + 4);
          float4 b0 = *(const float4*)sv, b1 = *(const float4*)(sv + 4);
          kf[0] = a0.x; kf[1] = a0.y; kf[2] = a0.z; kf[3] = a0.w; kf[4] = a1.x; kf[5] = a1.y; kf[6] = a1.z; kf[7] = a1.w;
          vf[0] = b0.x; vf[1] = b0.y; vf[2] = b0.z; vf[3] = b0.w; vf[4] = b1.x; vf[5] = b1.y; vf[6] = b1.z; vf[7] = b1.w;
        } else if (valid) {
          const u16* src = ZB + (size_t)(NP + b * 8 + (row - 128)) * 1536 + 1024 + kv * 64 + ch * 8;
          unpack8(*(const uint4*)src, kf);
          unpack8(*(const uint4*)(src + 256), vf);
        }
      }
      if (!valid) {
#pragma unroll
        for (int i = 0; i < 8; i++) { kf[i] = 0.f; vf[i] = 0.f; }
      }
      float ss = 0.f;
#pragma unroll
      for (int i = 0; i < 8; i++) ss += kf[i] * kf[i];
      ss += __shfl_xor(ss, 1);
      ss += __shfl_xor(ss, 2);
      ss += __shfl_xor(ss, 4);
      if (donorm) {
        const float rstd = rsqrtf(ss * (1.f / 64.f) + EPS);
#pragma unroll
        for (int i = 0; i < 8; i++) kf[i] = kf[i] * rstd * kg[i];
      }
      *(uint4*)(Ks + row * KS_LD + ch * 8) = pack8(kf);
#pragma unroll
      for (int i = 0; i < 8; i++) Vt[(ch * 8 + i) * VT_LD + row] = f2bf(vf[i]);
      if (!sample) {
        if (qb >= 62 && row >= 128) {
          const int wpos = p0 + (row - 128) - (SEQ - 128);
          float* ko = p.out + O_KP + ((size_t)(b * 128 + wpos) * 4 + kv) * 64 + ch * 8;
          float* vo = p.out + O_VP + ((size_t)(b * 128 + wpos) * 4 + kv) * 64 + ch * 8;
          *(float4*)ko = make_float4(kf[0], kf[1], kf[2], kf[3]);
          *(float4*)(ko + 4) = make_float4(kf[4], kf[5], kf[6], kf[7]);
          *(float4*)vo = make_float4(vf[0], vf[1], vf[2], vf[3]);
          *(float4*)(vo + 4) = make_float4(vf[4], vf[5], vf[6], vf[7]);
        }
      } else {
        if (row >= 8 && row < 136) {
          float* ko = p.out + O_KS + ((size_t)(b * 128 + (row - 8)) * 4 + kv) * 64 + ch * 8;
          float* vo = p.out + O_VS + ((size_t)(b * 128 + (row - 8)) * 4 + kv) * 64 + ch * 8;
          *(float4*)ko = make_float4(kf[0], kf[1], kf[2], kf[3]);
          *(float4*)(ko + 4) = make_float4(kf[4], kf[5], kf[6], kf[7]);
          *(float4*)vo = make_float4(vf[0], vf[1], vf[2], vf[3]);
          *(float4*)(vo + 4) = make_float4(vf[4], vf[5], vf[6], vf[7]);
        }
      }
    }
  }
  __syncthreads();
  const int hq = kv * 4 + w;
  const float slope = exp2f(-0.5f * (float)(hq + 1));
  const float sink = p.attn_sinks[hq];
  float qg[2][8];
#pragma unroll
  for (int ks = 0; ks < 2; ks++)
#pragma unroll
    for (int i = 0; i < 8; i++) qg[ks][i] = p.q_norm_g[ks * 32 + quad * 8 + i] * 0.125f;
  const int nsub = sample ? 1 : 4;
  for (int sb = 0; sb < nsub; sb++) {
    const int r0 = sb * 16;
    const int ws0 = r0 < 32 ? r0 : 32;
    bf16x8 qa[2];
    {
      const int qr = sample ? (l15 & 7) : (r0 + l15);
      const u16* src = ZB + (size_t)(rowbase + qr) * 1536 + hq * 64 + quad * 8;
      float q0[8], q1[8];
      unpack8(*(const uint4*)src, q0);
      unpack8(*(const uint4*)(src + 32), q1);
      float ss = 0.f;
#pragma unroll
      for (int i = 0; i < 8; i++) ss += q0[i] * q0[i] + q1[i] * q1[i];
      ss += __shfl_xor(ss, 16);
      ss += __shfl_xor(ss, 32);
      const float rstd = rsqrtf(ss * (1.f / 64.f) + EPS);
#pragma unroll
      for (int i = 0; i < 8; i++) { q0[i] *= rstd * qg[0][i]; q1[i] *= rstd * qg[1][i]; }
      uint4 u0 = pack8(q0), u1 = pack8(q1);
      qa[0] = __builtin_bit_cast(bf16x8, u0);
      qa[1] = __builtin_bit_cast(bf16x8, u1);
    }
    f32x4 s[10];
#pragma unroll
    for (int kt = 0; kt < 10; kt++) {
      const u16* kp = Ks + (ws0 + kt * 16 + l15) * KS_LD + quad * 8;
      bf16x8 b0 = *(const bf16x8*)kp, b1 = *(const bf16x8*)(kp + 32);
      f32x4 z = {0.f, 0.f, 0.f, 0.f};
      z = __builtin_amdgcn_mfma_f32_16x16x32_bf16(qa[0], b0, z, 0, 0, 0);
      s[kt] = __builtin_amdgcn_mfma_f32_16x16x32_bf16(qa[1], b1, z, 0, 0, 0);
    }
    float mx[4] = {-1e30f, -1e30f, -1e30f, -1e30f};
#pragma unroll
    for (int kt = 0; kt < 10; kt++) {
      const int jj = ws0 + kt * 16 + l15;
      const bool posok = sample ? (jj < 136) : (p0 - 128 + jj >= 0);
#pragma unroll
      for (int e = 0; e < 4; e++) {
        const int r = r0 + quad * 4 + e;
        const int dist = r + 128 - jj;
        const bool ok = posok && dist >= 0 && dist <= 128;
        float v = ok ? (s[kt][e] - slope * (float)dist) : -1e30f;
        s[kt][e] = v;
        mx[e] = fmaxf(mx[e], v);
      }
    }
    float sum[4];
#pragma unroll
    for (int e = 0; e < 4; e++) {
      float m = mx[e];
      m = fmaxf(m, __shfl_xor(m, 1));
      m = fmaxf(m, __shfl_xor(m, 2));
      m = fmaxf(m, __shfl_xor(m, 4));
      m = fmaxf(m, __shfl_xor(m, 8));
      m = fmaxf(m, sink);
      mx[e] = m;
      sum[e] = 0.f;
    }
#pragma unroll
    for (int kt = 0; kt < 10; kt++) {
#pragma unroll
      for (int e = 0; e < 4; e++) {
        float pv = __expf(s[kt][e] - mx[e]);
        sum[e] += pv;
        Ps[(quad * 4 + e) * PS_LD + kt * 16 + l15] = f2bf(pv);
      }
    }
#pragma unroll
    for (int e = 0; e < 4; e++) {
      float t = sum[e];
      t += __shfl_xor(t, 1);
      t += __shfl_xor(t, 2);
      t += __shfl_xor(t, 4);
      t += __shfl_xor(t, 8);
      sum[e] = 1.f / (t + __expf(sink - mx[e]));
    }
    __syncthreads();
    f32x4 o[4];
#pragma unroll
    for (int nt = 0; nt < 4; nt++) o[nt] = (f32x4){0.f, 0.f, 0.f, 0.f};
#pragma unroll
    for (int kk = 0; kk < 5; kk++) {
      bf16x8 pa = *(const bf16x8*)(Ps + l15 * PS_LD + kk * 32 + quad * 8);
#pragma unroll
      for (int nt = 0; nt < 4; nt++) {
        bf16x8 vb = *(const bf16x8*)(Vt + (nt * 16 + l15) * VT_LD + ws0 + kk * 32 + quad * 8);
        o[nt] = __builtin_amdgcn_mfma_f32_16x16x32_bf16(pa, vb, o[nt], 0, 0, 0);
      }
    }
#pragma unroll
    for (int e = 0; e < 4; e++) {
      const int r = quad * 4 + e;
      if (!sample || r < 8) {
        u16* dst = ATT + (size_t)(rowbase + r0 + r) * 1024 + hq * 64 + l15;
#pragma unroll
        for (int nt = 0; nt < 4; nt++) dst[nt * 16] = f2bf(o[nt][e] * sum[e]);
      }
    }
    __syncthreads();
  }
}

constexpr int XC_LD = 68;
__device__ __forceinline__ void lru_tile(KParams& p, char* smem, int mt, int nb, int mode) {
  const int tid = opaque_tid(), lane = tid & 63, w = tid >> 6, l15 = lane & 15, quad = lane >> 4;
  float* xcF = (float*)smem;
  float* aL = xcF + 128 * XC_LD;
  float* aggL = aL + 128 * XC_LD;
  const u16* ZA = (const u16*)(p.ws + W_ZA);
  const bool sample = mt >= 128;
  const int m0 = mt * 128;
  const int cb = nb * 64;
  __syncthreads();
  {
    const int ch = tid & 7;
    float cw[4][8], cbias[8];
#pragma unroll
    for (int j = 0; j < 4; j++)
#pragma unroll
      for (int i = 0; i < 8; i++) cw[j][i] = p.conv_w[j * 1024 + cb + ch * 8 + i];
#pragma unroll
    for (int i = 0; i < 8; i++) cbias[i] = p.conv_b[cb + ch * 8 + i];
#pragma unroll
    for (int it = 0; it < 4; it++) {
      const int r = (tid >> 3) + it * 32;
      const int grow = m0 + r;
      const int t = sample ? (r & 7) : ((mt & 31) * 128 + r);
      float y[8];
#pragma unroll
      for (int i = 0; i < 8; i++) y[i] = cbias[i];
#pragma unroll
      for (int d = 0; d < 4; d++) {
        float xv[8];
        if (t - d >= 0) {
          unpack8(*(const uint4*)(ZA + (size_t)(grow - d) * 2048 + cb + ch * 8), xv);
        } else if (sample) {
          const int bb = (m0 - NP + r) >> 3;
          const float* src = p.cache_conv + ((size_t)bb * 3 + (3 + t - d)) * 1024 + cb + ch * 8;
          float4 a = *(const float4*)src, b4 = *(const float4*)(src + 4);
          xv[0] = a.x; xv[1] = a.y; xv[2] = a.z; xv[3] = a.w; xv[4] = b4.x; xv[5] = b4.y; xv[6] = b4.z; xv[7] = b4.w;
        } else {
#pragma unroll
          for (int i = 0; i < 8; i++) xv[i] = 0.f;
        }
#pragma unroll
        for (int i = 0; i < 8; i++) y[i] += cw[3 - d][i] * xv[i];
        if (d == 0 && mode != 0) {
          if (!sample) {
            if ((mt & 31) == 31 && r >= 125) {
              float* dst = p.out + O_CONVP + ((size_t)(mt >> 5) * 3 + (r - 125)) * 1024 + cb + ch * 8;
              *(float4*)dst = make_float4(xv[0], xv[1], xv[2], xv[3]);
              *(float4*)(dst + 4) = make_float4(xv[4], xv[5], xv[6], xv[7]);
            }
          } else if (t >= 5) {
            const int bb = (m0 - NP + r) >> 3;
            float* dst = p.out + O_CONVS + ((size_t)bb * 3 + (t - 5)) * 1024 + cb + ch * 8;
            *(float4*)dst = make_float4(xv[0], xv[1], xv[2], xv[3]);
            *(float4*)(dst + 4) = make_float4(xv[4], xv[5], xv[6], xv[7]);
          }
        }
      }
      *(float4*)(xcF + r * XC_LD + ch * 8) = make_float4(y[0], y[1], y[2], y[3]);
      *(float4*)(xcF + r * XC_LD + ch * 8 + 4) = make_float4(y[4], y[5], y[6], y[7]);
    }
  }
  __syncthreads();
  {
    const u16* RA = (const u16*)(p.ws + W_RGA) + nb * 4096;
    const u16* RX = (const u16*)(p.ws + W_RGX) + nb * 4096;
    f32x4 aR[2][4], aI[2][4];
#pragma unroll
    for (int i = 0; i < 2; i++)
#pragma unroll
      for (int j = 0; j < 4; j++) { aR[i][j] = (f32x4){0.f, 0.f, 0.f, 0.f}; aI[i][j] = (f32x4){0.f, 0.f, 0.f, 0.f}; }
#pragma unroll
    for (int ks = 0; ks < 2; ks++) {
      bf16x8 a[2];
#pragma unroll
      for (int i = 0; i < 2; i++) {
        const float* src = xcF + (w * 32 + i * 16 + l15) * XC_LD + ks * 32 + quad * 8;
        float4 x0 = *(const float4*)src, x1 = *(const float4*)(src + 4);
        float v[8] = {x0.x, x0.y, x0.z, x0.w, x1.x, x1.y, x1.z, x1.w};
        uint4 u = pack8(v);
        a[i] = __builtin_bit_cast(bf16x8, u);
      }
#pragma unroll
      for (int j = 0; j < 4; j++) {
        bf16x8 ba = *(const bf16x8*)(RA + (j * 16 + l15) * 64 + ks * 32 + quad * 8);
        bf16x8 bx = *(const bf16x8*)(RX + (j * 16 + l15) * 64 + ks * 32 + quad * 8);
#pragma unroll
        for (int i = 0; i < 2; i++) {
          aR[i][j] = __builtin_amdgcn_mfma_f32_16x16x32_bf16(a[i], ba, aR[i][j], 0, 0, 0);
          aI[i][j] = __builtin_amdgcn_mfma_f32_16x16x32_bf16(a[i], bx, aI[i][j], 0, 0, 0);
        }
      }
    }
#pragma unroll
    for (int j = 0; j < 4; j++) {
      const int c = cb + j * 16 + l15;
      const float ba = p.rg_b_a[c], bx = p.rg_b_x[c];
      const float ls = -log1pf(__expf(-p.rg_lambda[c]));
#pragma unroll
      for (int i = 0; i < 2; i++)
#pragma unroll
        for (int e = 0; e < 4; e++) {
          const int row = w * 32 + i * 16 + quad * 4 + e;
          const float rg = sigmoidf_(aR[i][j][e] + ba);
          const float ig = sigmoidf_(aI[i][j][e] + bx);
          const float la = 8.f * rg * ls;
          const float av = __expf(la);
          const float x2 = 2.f * la;
          const float emt = -x2 * (1.f + x2 * (0.5f + x2 * (0.16666667f + x2 * (0.041666668f + x2 * 0.008333334f))));
          const float em = x2 > -0.25f ? emt : 1.f - __expf(x2);
          const float mult = __builtin_amdgcn_sqrtf(fmaxf(em, 0.f));
          const int idx = row * XC_LD + j * 16 + l15;
          const float xv = xcF[idx];
          aL[idx] = av;
          xcF[idx] = mult * ig * xv;
        }
    }
  }
  __syncthreads();
  const int c = cb + lane;
  float* carL = aggL + 512;
  if (!sample) {
    float* AGGP = (float*)(p.ws + W_AGG);
    float* AGGH = AGGP + 128 * 1024;
    const int chunk = mt & 31, base = mt - chunk;
    if (mode == 1) {
      float Pq[8], Hq[8];
#pragma unroll
      for (int k = 0; k < 8; k++) {
        const int q = w * 8 + k;
        const bool ok = q < chunk;
        Pq[k] = ok ? AGGP[(base + q) * 1024 + c] : 1.f;
        Hq[k] = ok ? AGGH[(base + q) * 1024 + c] : 0.f;
      }
      float Pc = 1.f, hc = 0.f;
#pragma unroll
      for (int k = 0; k < 8; k++) { hc = Pq[k] * hc + Hq[k]; Pc *= Pq[k]; }
      carL[(w * 64 + lane) * 2] = Pc;
      carL[(w * 64 + lane) * 2 + 1] = hc;
    }
    float P = 1.f, h = 0.f;
#pragma unroll 8
    for (int rr = 0; rr < 32; rr++) {
      const float av = aL[(w * 32 + rr) * XC_LD + lane], bv = xcF[(w * 32 + rr) * XC_LD + lane];
      h = av * h + bv;
      P *= av;
    }
    aggL[(w * 64 + lane) * 2] = P;
    aggL[(w * 64 + lane) * 2 + 1] = h;
    __syncthreads();
    if (mode == 0 || mode == 2) {
      if (w == 0) {
        float Pt = 1.f, ht = 0.f;
#pragma unroll
        for (int q = 0; q < 4; q++) {
          const float Pq = aggL[(q * 64 + lane) * 2], hq = aggL[(q * 64 + lane) * 2 + 1];
          ht = Pq * ht + hq;
          Pt *= Pq;
        }
        if (mode == 0) {
          AGGP[mt * 1024 + c] = Pt;
          AGGH[mt * 1024 + c] = ht;
        } else {
          __hip_atomic_store(&AGGP[mt * 1024 + c], Pt, __ATOMIC_RELAXED, __HIP_MEMORY_SCOPE_AGENT);
          __hip_atomic_store(&AGGH[mt * 1024 + c], ht, __ATOMIC_RELAXED, __HIP_MEMORY_SCOPE_AGENT);
          asm volatile("s_waitcnt vmcnt(0)" ::: "memory");
          if (lane == 0)
            __hip_atomic_store((unsigned*)(p.ws + W_FLAG) + mt * 16 + nb, 1u, __ATOMIC_RELAXED, __HIP_MEMORY_SCOPE_AGENT);
        }
      }
    }
    if (mode == 2) {
      {
        const int q = w * 8 + (lane & 7);
        const bool need = (lane < 8) && (q < chunk);
        unsigned* fp = (unsigned*)(p.ws + W_FLAG) + (base + (need ? q : 0)) * 16 + nb;
        unsigned spins = 0;
        for (;;) {
          const unsigned f = need ? __hip_atomic_load(fp, __ATOMIC_RELAXED, __HIP_MEMORY_SCOPE_AGENT) : 1u;
          if (__ballot(f == 0u) == 0ull) break;
          __builtin_amdgcn_s_sleep(2);
          if (++spins > (1u << 20)) break;
        }
      }
      float Pq[8], Hq[8];
#pragma unroll
      for (int k = 0; k < 8; k++) {
        const int q = w * 8 + k;
        const bool ok = q < chunk;
        Pq[k] = ok ? __hip_atomic_load(&AGGP[(base + q) * 1024 + c], __ATOMIC_RELAXED, __HIP_MEMORY_SCOPE_AGENT) : 1.f;
        Hq[k] = ok ? __hip_atomic_load(&AGGH[(base + q) * 1024 + c], __ATOMIC_RELAXED, __HIP_MEMORY_SCOPE_AGENT) : 0.f;
      }
      float Pc = 1.f, hc = 0.f;
#pragma unroll
      for (int k = 0; k < 8; k++) { hc = Pq[k] * hc + Hq[k]; Pc *= Pq[k]; }
      carL[(w * 64 + lane) * 2] = Pc;
      carL[(w * 64 + lane) * 2 + 1] = hc;
      __syncthreads();
    }
    if (mode == 0) {
    } else {
      float hin = 0.f;
#pragma unroll
      for (int q = 0; q < 4; q++) hin = carL[(q * 64 + lane) * 2] * hin + carL[(q * 64 + lane) * 2 + 1];
      for (int q = 0; q < w; q++) hin = aggL[(q * 64 + lane) * 2] * hin + aggL[(q * 64 + lane) * 2 + 1];
      float hh = hin;
#pragma unroll 8
      for (int rr = 0; rr < 32; rr++) {
        const int row = w * 32 + rr;
        const float av = aL[row * XC_LD + lane], bv = xcF[row * XC_LD + lane];
        hh = av * hh + bv;
        xcF[row * XC_LD + lane] = hh;
      }
      if (chunk == 31 && w == 3) p.out[O_LRUP + (size_t)(mt >> 5) * 1024 + c] = hh;
    }
  } else {
    float hh = 0.f;
    float h0v[4];
#pragma unroll
    for (int k = 0; k < 4; k++) h0v[k] = p.state_lru[(size_t)(((m0 - NP + w * 32) >> 3) + k) * 1024 + c];
#pragma unroll
    for (int rr = 0; rr < 32; rr++) {
      const int row = w * 32 + rr;
      const int bb = (m0 - NP + row) >> 3;
      const int t = row & 7;
      if (t == 0) hh = h0v[rr >> 3];
      const float av = aL[row * XC_LD + lane], bv = xcF[row * XC_LD + lane];
      hh = av * hh + bv;
      xcF[row * XC_LD + lane] = hh;
      if (t == 7) p.out[O_LRUS + (size_t)bb * 1024 + c] = hh;
    }
  }
  if (mode != 0) {
    __syncthreads();
    u16* LO = (u16*)(p.ws + W_LO);
    const int ch = tid & 7;
#pragma unroll
    for (int it = 0; it < 4; it++) {
      const int r = (tid >> 3) + it * 32;
      float g[8];
      unpack8(*(const uint4*)(ZA + (size_t)(m0 + r) * 2048 + 1024 + cb + ch * 8), g);
      const float4 h0 = *(const float4*)(xcF + r * XC_LD + ch * 8), h1 = *(const float4*)(xcF + r * XC_LD + ch * 8 + 4);
      float v[8] = {h0.x * gelu_tanh(g[0]), h0.y * gelu_tanh(g[1]), h0.z * gelu_tanh(g[2]), h0.w * gelu_tanh(g[3]),
                    h1.x * gelu_tanh(g[4]), h1.y * gelu_tanh(g[5]), h1.z * gelu_tanh(g[6]), h1.w * gelu_tanh(g[7])};
      *(uint4*)(LO + (size_t)(m0 + r) * 1024 + cb + ch * 8) = pack8(v);
    }
  }
}

template <int NW>
__device__ __forceinline__ void g3_tile(KParams& p, char* smem, int mt, int n0) {
  const int tid = opaque_tid();
  float* Cs = (float*)smem;
  const u16* LO = (const u16*)(p.ws + W_LO);
  const u16* ATT = (const u16*)(p.ws + W_XN);
  const u16* WL = (const u16*)(p.ws + W_WTLRU);
  const u16* WA = (const u16*)(p.ws + W_WTATTN);
  const u16* ZC = (const u16*)p.out;
  u16* MG = (u16*)(p.ws + W_ZA);
  constexpr int TPR = NW / 8;
  constexpr int RPI = 256 / TPR;
  const int cc = (tid % TPR) * 8;
#pragma unroll
  for (int pass = 0; pass < 2; pass++) {
    f32x4 acc[4][NW / 32];
    zero_acc(acc);
    gemm_tile<NW>((pass ? ATT : LO) + (size_t)mt * 128 * 1024, 1024, (pass ? WA : WL) + (size_t)n0 * 1024, 1024, 1024, acc,
                  smem, tid);
    __syncthreads();
    acc_to_cs(acc, Cs, tid);
    __syncthreads();
#pragma unroll
    for (int i = 0; i < 128 / RPI; i++) {
      const int r = (tid / TPR) + RPI * i;
      const size_t row = (size_t)(mt * 128 + r);
      float4 a = *(const float4*)(Cs + r * CS_LD + cc), b = *(const float4*)(Cs + r * CS_LD + cc + 4);
      float v[8] = {a.x, a.y, a.z, a.w, b.x, b.y, b.z, b.w};
      float g[8];
      unpack8(*(const uint4*)(ZC + row * 2048 + pass * 1024 + n0 + cc), g);
      u16* mp = MG + row * 1024 + n0 + cc;
      if (pass == 0) {
#pragma unroll
        for (int q = 0; q < 8; q++) v[q] *= sigmoidf_(g[q]);
      } else {
        float pv[8];
        unpack8(*(const uint4*)mp, pv);
#pragma unroll
        for (int q = 0; q < 8; q++) v[q] = pv[q] + v[q] * sigmoidf_(g[q]);
      }
      *(uint4*)mp = pack8(v);
    }
    __syncthreads();
  }
}

__device__ __forceinline__ void phase_g3(KParams& p, char* smem, int vb) {
  for (int it = blockIdx.x; it < 1024 + 128; it += gridDim.x) {
    int mt, nt;
    if (it < 1024) {
      tile_map(it, MT * 8, 8, mt, nt, vb);
      g3_tile<128>(p, smem, mt, nt * 128);
    } else {
      tile_map(1024 + ((it - 1024) >> 1), MT * 8, 8, mt, nt, vb);
      g3_tile<64>(p, smem, mt, nt * 128 + ((it - 1024) & 1) * 64);
    }
  }
}

template <int NW>
__device__ __forceinline__ void g4_tile(KParams& p, char* smem, int mt, int n0) {
  const int tid = opaque_tid();
  float* Cs = (float*)smem;
  const u16* MG = (const u16*)(p.ws + W_ZA);
  const u16* WO = (const u16*)(p.ws + W_WTOUT);
  u16* HG = (u16*)(p.ws + W_ZB);
  float* SSQ = (float*)(p.ws + W_SSQ);
  constexpr int TPR = NW / 8;
  constexpr int RPI = 256 / TPR;
  f32x4 acc[4][NW / 32];
  zero_acc(acc);
  gemm_tile<NW>(MG + (size_t)mt * 128 * 1024, 1024, WO + (size_t)n0 * 1024, 1024, 1024, acc, smem, tid);
  __syncthreads();
  acc_to_cs(acc, Cs, tid);
  __syncthreads();
  const int cc = (tid % TPR) * 8;
  const float4 g0 = *(const float4*)(p.norm2_g + n0 + cc), g1 = *(const float4*)(p.norm2_g + n0 + cc + 4);
#pragma unroll
  for (int i = 0; i < 128 / RPI; i++) {
    const int r = (tid / TPR) + RPI * i;
    const int row = mt * 128 + r;
    float4 a = *(const float4*)(Cs + r * CS_LD + cc), b = *(const float4*)(Cs + r * CS_LD + cc + 4);
    const float* xr = xrow(p, row) + n0 + cc;
    float4 x0 = *(const float4*)xr, x1 = *(const float4*)(xr + 4);
    a.x += x0.x; a.y += x0.y; a.z += x0.z; a.w += x0.w;
    b.x += x1.x; b.y += x1.y; b.z += x1.z; b.w += x1.w;
    float* ho = p.out + O_Y + (size_t)row * 1024 + n0 + cc;
    *(float4*)ho = a;
    *(float4*)(ho + 4) = b;
    float v[8] = {a.x * g0.x, a.y * g0.y, a.z * g0.z, a.w * g0.w, b.x * g1.x, b.y * g1.y, b.z * g1.z, b.w * g1.w};
    *(uint4*)(HG + (size_t)row * 1024 + n0 + cc) = pack8(v);
    float ss = a.x * a.x + a.y * a.y + a.z * a.z + a.w * a.w + b.x * b.x + b.y * b.y + b.z * b.z + b.w * b.w;
    ss += __shfl_xor(ss, 1);
    ss += __shfl_xor(ss, 2);
    ss += __shfl_xor(ss, 4);
    if ((tid & 7) == 0) SSQ[(size_t)row * 16 + ((n0 + cc) >> 6)] = ss;
  }
  __syncthreads();
}

__device__ __forceinline__ void phase_g4(KParams& p, char* smem, int vb) {
  for (int it = blockIdx.x; it < 1024 + 128; it += gridDim.x) {
    int mt, nt;
    if (it < 1024) {
      tile_map(it, MT * 8, 8, mt, nt, vb);
      g4_tile<128>(p, smem, mt, nt * 128);
    } else {
      tile_map(1024 + ((it - 1024) >> 1), MT * 8, 8, mt, nt, vb);
      g4_tile<64>(p, smem, mt, nt * 128 + ((it - 1024) & 1) * 64);
    }
  }
}

__device__ __forceinline__ float row_rstd(const float* SSQ, int row) {
  const float4 a = *(const float4*)(SSQ + (size_t)row * 16), b = *(const float4*)(SSQ + (size_t)row * 16 + 4),
               c = *(const float4*)(SSQ + (size_t)row * 16 + 8), d = *(const float4*)(SSQ + (size_t)row * 16 + 12);
  const float ss = (((a.x + a.y) + (a.z + a.w)) + ((b.x + b.y) + (b.z + b.w))) +
                   (((c.x + c.y) + (c.z + c.w)) + ((d.x + d.y) + (d.z + d.w)));
  return rsqrtf(ss * (1.f / 1024.f) + EPS);
}

template <int NW>
__device__ __forceinline__ void g5_tile(KParams& p, char* smem, int mt, int n0) {
  const int tid = opaque_tid();
  float* Cs = (float*)smem;
  const u16* HG = (const u16*)(p.ws + W_ZB);
  const u16* WQ = (const u16*)(p.ws + W_WTQ);
  const float* SSQ = (const float*)(p.ws + W_SSQ);
  u16* QR = (u16*)(p.ws + W_ZA);
  constexpr int TPR = NW / 8;
  constexpr int RPI = 256 / TPR;
  f32x4 acc[4][NW / 32];
  zero_acc(acc);
  gemm_tile<NW>(HG + (size_t)mt * 128 * 1024, 1024, WQ + (size_t)n0 * 1024, 1024, 1024, acc, smem, tid);
  __syncthreads();
  acc_to_cs(acc, Cs, tid);
  __syncthreads();
  const int cc = (tid % TPR) * 8;
#pragma unroll
  for (int i = 0; i < 128 / RPI; i++) {
    const int r = (tid / TPR) + RPI * i;
    const int row = mt * 128 + r;
    const float rs = row_rstd(SSQ, row);
    float4 a = *(const float4*)(Cs + r * CS_LD + cc), b = *(const float4*)(Cs + r * CS_LD + cc + 4);
    float v[8] = {a.x * rs, a.y * rs, a.z * rs, a.w * rs, b.x * rs, b.y * rs, b.z * rs, b.w * rs};
    *(uint4*)(QR + (size_t)row * 2048 + n0 + cc) = pack8(v);
  }
  __syncthreads();
}

__device__ __forceinline__ void phase_g5(KParams& p, char* smem, int vb) {
  for (int it = blockIdx.x; it < 2048 + 256; it += gridDim.x) {
    int mt, nt;
    if (it < 2048) {
      tile_map(it, MT * 16, 16, mt, nt, vb);
      g5_tile<128>(p, smem, mt, nt * 128);
    } else {
      tile_map(2048 + ((it - 2048) >> 1), MT * 16, 16, mt, nt, vb);
      g5_tile<64>(p, smem, mt, nt * 128 + ((it - 2048) & 1) * 64);
    }
  }
}

__device__ __forceinline__ void phase_g6(KParams& p, char* smem, int vb) {
  const int tid = opaque_tid();
  u16* As = (u16*)smem;
  u16* Bs = As + 2 * 128 * LDT;
  float* Cs = (float*)smem;
  uint32_t* Cu = (uint32_t*)smem;
  uint32_t* TK0 = (uint32_t*)(smem + 128 * CS_LD * 4);
  const u16* QR = (const u16*)(p.ws + W_ZA);
  const u16* SK = (const u16*)(p.ws + W_SK);
  int* IDX = (int*)(p.ws + W_XN);
  float* GW = (float*)(p.ws + W_XN + (size_t)NTOK * 128 * 4);
  const int row = tid >> 1, half = tid & 1;
  for (int t = blockIdx.x; t < MT * 8; t += gridDim.x) {
    int mt, h;
    tile_map(t, MT * 8, 8, mt, h, vb);
    uint32_t tk[16];
    for (int pp = 0; pp < 2; pp++) {
      f32x4 acc[4][4];
      zero_acc(acc);
      gemm_tile<128>(QR + (size_t)mt * 128 * 2048 + h * 256 + pp * 128, 2048, SK + (size_t)(h * 2 + pp) * 16384, 128, 128, acc,
                smem, tid);
      __syncthreads();
      acc_to_cs(acc, Cs, tid);
      __syncthreads();
#pragma unroll
      for (int g = 0; g < 4; g++) {
        uint32_t sg[16];
#pragma unroll
        for (int q4 = 0; q4 < 4; q4++) {
          const int col = half * 64 + g * 16 + q4 * 4;
          const float4 v = *(const float4*)(Cs + row * CS_LD + col);
          sg[q4 * 4 + 0] = (ordf(v.x) & ~0x7Fu) | (uint32_t)(127 - col);
          sg[q4 * 4 + 1] = (ordf(v.y) & ~0x7Fu) | (uint32_t)(126 - col);
          sg[q4 * 4 + 2] = (ordf(v.z) & ~0x7Fu) | (uint32_t)(125 - col);
          sg[q4 * 4 + 3] = (ordf(v.w) & ~0x7Fu) | (uint32_t)(124 - col);
        }
        sort16_desc(sg);
        if (g == 0) {
#pragma unroll
          for (int q = 0; q < 16; q++) tk[q] = sg[q];
        } else {
          merge16_desc(tk, sg);
        }
      }
      __syncthreads();
      if (half == 1) {
#pragma unroll
        for (int q = 0; q < 16; q++) Cu[row * 16 + q] = tk[q];
      }
      __syncthreads();
      if (half == 0) {
        {
          uint32_t sg[16];
#pragma unroll
          for (int q4 = 0; q4 < 4; q4++) {
            const uint4 u = *(const uint4*)(Cu + row * 16 + q4 * 4);
            sg[q4 * 4] = u.x; sg[q4 * 4 + 1] = u.y; sg[q4 * 4 + 2] = u.z; sg[q4 * 4 + 3] = u.w;
          }
          merge16_desc(tk, sg);
        }
        if (pp == 0) {
#pragma unroll
          for (int q = 0; q < 16; q++) TK0[row * 16 + q] = tk[q];
        } else {
#pragma unroll
          for (int q = 0; q < 16; q++) Cu[2048 + row * 16 + q] = tk[q];
        }
      }
      __syncthreads();
    }
    if (half == 0) {
      float va[16], vb[16];
#pragma unroll
      for (int q = 0; q < 16; q++) {
        va[q] = unordf(TK0[row * 16 + q] & ~0x7Fu);
        vb[q] = unordf(tk[q] & ~0x7Fu);
      }
      uint32_t cd[16];
#pragma unroll
      for (int q = 0; q < 16; q++) cd[q] = (ordf(va[0] + vb[q]) & ~0xFFu) | (uint32_t)(255 - q);
#pragma unroll
      for (int i = 1; i < 16; i++) {
#pragma unroll
        for (int j = 0; j < 16; j++) {
          if ((i + 1) * (j + 1) <= 16) {
            const float sv = va[i] + vb[j];
            const uint32_t key = (ordf(sv) & ~0xFFu) | (uint32_t)(255 - (i * 16 + j));
            INS16(cd, key);
          }
        }
      }
      float ev[16];
      const float m0v = unordf(cd[0] & ~0xFFu);
      float esum = 0.f;
#pragma unroll
      for (int q = 0; q < 16; q++) {
        ev[q] = __expf(unordf(cd[q] & ~0xFFu) - m0v);
        esum += ev[q];
      }
      const float inv = 1.f / esum;
      const size_t ob = (size_t)(mt * 128 + row) * 128 + h * 16;
#pragma unroll
      for (int q = 0; q < 16; q++) {
        const int ij = 255 - (int)(cd[q] & 0xFFu);
        const int i0 = 127 - (int)(TK0[row * 16 + (ij >> 4)] & 0x7Fu);
        const int i1 = 127 - (int)(Cu[2048 + row * 16 + (ij & 15)] & 0x7Fu);
        IDX[ob + q] = i0 * 128 + i1;
        GW[ob + q] = ev[q] * inv;
      }
    }
    __syncthreads();
  }
}

typedef __attribute__((ext_vector_type(2))) float f32x2;
__device__ __forceinline__ void dec16(uint4 u, float* v) {
  f32x2 t;
  t = __builtin_amdgcn_cvt_pk_f32_fp8((int)u.x, false); v[0] = t.x; v[1] = t.y;
  t = __builtin_amdgcn_cvt_pk_f32_fp8((int)u.x, true); v[2] = t.x; v[3] = t.y;
  t = __builtin_amdgcn_cvt_pk_f32_fp8((int)u.y, false); v[4] = t.x; v[5] = t.y;
  t = __builtin_amdgcn_cvt_pk_f32_fp8((int)u.y, true); v[6] = t.x; v[7] = t.y;
  t = __builtin_amdgcn_cvt_pk_f32_fp8((int)u.z, false); v[8] = t.x; v[9] = t.y;
  t = __builtin_amdgcn_cvt_pk_f32_fp8((int)u.z, true); v[10] = t.x; v[11] = t.y;
  t = __builtin_amdgcn_cvt_pk_f32_fp8((int)u.w, false); v[12] = t.x; v[13] = t.y;
  t = __builtin_amdgcn_cvt_pk_f32_fp8((int)u.w, true); v[14] = t.x; v[15] = t.y;
}

__device__ __forceinline__ void phase7(KParams& p) {
  const int tid = opaque_tid(), lane = tid & 63, w = tid >> 6;
  const u16* HG = (const u16*)(p.ws + W_ZB);
  const float* SSQ = (const float*)(p.ws + W_SSQ);
  const int* IDX = (const int*)(p.ws + W_XN);
  const float* GW = (const float*)(p.ws + W_XN + (size_t)NTOK * 128 * 4);
  const unsigned char* EU = (const unsigned char*)(p.ws + W_EU);
  const unsigned char* EV = (const unsigned char*)(p.ws + W_EV);
  const float* ESC = (const float*)(p.ws + W_ESC);
  const int b0 = lane & 1, b1 = (lane >> 1) & 1, b2 = (lane >> 2) & 1;
  for (int tok = blockIdx.x * 4 + w; tok < NTOK; tok += gridDim.x * 4) {
    const float rs = row_rstd(SSQ, tok);
    float xh[16];
    {
      const uint4* hp = (const uint4*)(HG + (size_t)tok * 1024 + lane * 16);
      unpack8(hp[0], xh);
      unpack8(hp[1], xh + 8);
#pragma unroll
      for (int i = 0; i < 16; i++) xh[i] *= rs;
    }
    const int iA = IDX[(size_t)tok * 128 + lane], iB = IDX[(size_t)tok * 128 + 64 + lane];
    const float gA = GW[(size_t)tok * 128 + lane] * ESC[16384 + iA], gB = GW[(size_t)tok * 128 + 64 + lane] * ESC[16384 + iB];
    const float suA = ESC[iA], suB = ESC[iB];
    float dA = 0.f, dB = 0.f;
#pragma unroll 2
    for (int bb = 0; bb < 16; bb++) {
      const int isrc = bb < 8 ? iA : iB;
      float d[8];
      uint4 ur[8];
#pragma unroll
      for (int k = 0; k < 8; k++) {
        const int id = __builtin_amdgcn_readlane(isrc, (bb & 7) * 8 + k);
        ur[k] = *(const uint4*)(EU + (size_t)id * 1024 + lane * 16);
      }
#pragma unroll
      for (int k = 0; k < 8; k++) {
        float uv[16];
        dec16(ur[k], uv);
        float sacc = 0.f;
#pragma unroll
        for (int i = 0; i < 16; i++) sacc += xh[i] * uv[i];
        d[k] = sacc;
      }
      float e4[4], e2[2], e1;
#pragma unroll
      for (int i = 0; i < 4; i++) {
        const float keep = b0 ? d[2 * i + 1] : d[2 * i];
        const float send = b0 ? d[2 * i] : d[2 * i + 1];
        e4[i] = keep + __shfl_xor(send, 1);
      }
#pragma unroll
      for (int i = 0; i < 2; i++) {
        const float keep = b1 ? e4[2 * i + 1] : e4[2 * i];
        const float send = b1 ? e4[2 * i] : e4[2 * i + 1];
        e2[i] = keep + __shfl_xor(send, 2);
      }
      {
        const float keep = b2 ? e2[1] : e2[0];
        const float send = b2 ? e2[0] : e2[1];
        e1 = keep + __shfl_xor(send, 4);
      }
      e1 += __shfl_xor(e1, 8);
      e1 += __shfl_xor(e1, 16);
      e1 += __shfl_xor(e1, 32);
      const bool mine = (lane >> 3) == (bb & 7);
      if (bb < 8) dA = mine ? e1 : dA; else dB = mine ? e1 : dB;
    }
    const float actA = gelu_tanh(dA * suA) * gA, actB = gelu_tanh(dB * suB) * gB;
    float* ACT = (float*)(p.ws + W_ACT);
    __hip_atomic_store(&ACT[(size_t)tok * 128 + lane], actA, __ATOMIC_RELAXED, __HIP_MEMORY_SCOPE_AGENT);
    __hip_atomic_store(&ACT[(size_t)tok * 128 + 64 + lane], actB, __ATOMIC_RELAXED, __HIP_MEMORY_SCOPE_AGENT);
    asm volatile("s_waitcnt vmcnt(0)" ::: "memory");
    if (lane == 0) __hip_atomic_fetch_add((unsigned*)(p.ws + W_CNT) + (tok >> 3), 1u, __ATOMIC_RELAXED, __HIP_MEMORY_SCOPE_AGENT);
  }
}

__device__ __forceinline__ void phase7b(KParams& p) {
  const int tid = opaque_tid(), lane = tid & 63;
  const char* IDXb = (const char*)(p.ws + W_XN);
  const char* ACTb = (const char*)(p.ws + W_ACT);
  const char* EVb = (const char*)(p.ws + W_EV);
  char* Yb = (char*)(p.out + O_Y);
  unsigned* Q = (unsigned*)(p.ws + W_Q);
  const int esub = lane >> 3, c = lane & 7;
  const int pref = (int)(hw_xcc_id() & 7u);
  const int b3 = (lane >> 3) & 1, b4 = (lane >> 4) & 1, b5 = (lane >> 5) & 1;
  const uint32_t lane4 = (uint32_t)lane * 4u;
  const uint32_t yl = (uint32_t)(c * 16 + b3 * 8 + b4 * 4 + b5 * 2) * 4u;
  for (int k = 0; k < 8; k++) {
    const int sl = (pref + k) & 7;
    const char* Vs = EVb + (size_t)sl * (16384 * 128);
    const uint32_t vl = (uint32_t)c * 16u;
    for (;;) {
      unsigned it = 0;
      if (lane == 0) it = atomicAdd(Q + sl * 64, 1u);
      it = (unsigned)__builtin_amdgcn_readfirstlane((int)it);
      if (it >= (unsigned)(NTOK / 8)) break;
      const int tok0 = (int)it * 8;
      {
        unsigned* cp = (unsigned*)(p.ws + W_CNT) + it;
        unsigned spins = 0;
        while ((unsigned)__builtin_amdgcn_readfirstlane((int)__hip_atomic_load(cp, __ATOMIC_RELAXED, __HIP_MEMORY_SCOPE_AGENT)) < 8u) {
          __builtin_amdgcn_s_sleep(2);
          if (++spins > (1u << 20)) break;
        }
      }
      const char* ib = IDXb + (size_t)tok0 * 512;
      const char* ab = ACTb + (size_t)tok0 * 512;
      char* yb = Yb + (size_t)tok0 * 4096 + sl * 512;
      int nidA = *(const int*)(ib + lane4), nidB = *(const int*)(ib + 256 + lane4);
      float nacA = __hip_atomic_load((const float*)(ab + lane4), __ATOMIC_RELAXED, __HIP_MEMORY_SCOPE_AGENT), nacB = __hip_atomic_load((const float*)(ab + 256 + lane4), __ATOMIC_RELAXED, __HIP_MEMORY_SCOPE_AGENT);
      float2 nyv = *(const float2*)(yb + yl);
#pragma unroll 1
      for (int t = 0; t < 8; t++) {
        const int idA = nidA, idB = nidB;
        const float acA = nacA, acB = nacB;
        const float2 yv = nyv;
        char* ybt = yb;
        if (t < 7) {
          ib += 512; ab += 512; yb += 4096;
          nidA = *(const int*)(ib + lane4); nidB = *(const int*)(ib + 256 + lane4);
          nacA = __hip_atomic_load((const float*)(ab + lane4), __ATOMIC_RELAXED, __HIP_MEMORY_SCOPE_AGENT); nacB = __hip_atomic_load((const float*)(ab + 256 + lane4), __ATOMIC_RELAXED, __HIP_MEMORY_SCOPE_AGENT);
          nyv = *(const float2*)(yb + yl);
        }
        float o[16];
#pragma unroll
        for (int q = 0; q < 16; q++) o[q] = 0.f;
#pragma unroll
        for (int hf = 0; hf < 2; hf++) {
          uint4 vr[8];
#pragma unroll
          for (int i = 0; i < 8; i++) {
            const uint32_t id = (uint32_t)__shfl(hf ? idB : idA, i * 8 + esub);
            vr[i] = *(const uint4*)(Vs + (id * 128u + vl));
          }
#pragma unroll
          for (int i = 0; i < 8; i++) {
            float vv[16];
            dec16(vr[i], vv);
            const float a = __shfl(hf ? acB : acA, i * 8 + esub);
#pragma unroll
            for (int q = 0; q < 16; q++) o[q] += a * vv[q];
          }
        }
        float r8[8], r4[4], r2[2];
#pragma unroll
        for (int q = 0; q < 8; q++) {
          const float keep = b3 ? o[q + 8] : o[q];
          const float send = b3 ? o[q] : o[q + 8];
          r8[q] = keep + __shfl_xor(send, 8);
        }
#pragma unroll
        for (int q = 0; q < 4; q++) {
          const float keep = b4 ? r8[q + 4] : r8[q];
          const float send = b4 ? r8[q] : r8[q + 4];
          r4[q] = keep + __shfl_xor(send, 16);
        }
#pragma unroll
        for (int q = 0; q < 2; q++) {
          const float keep = b5 ? r4[q + 2] : r4[q];
          const float send = b5 ? r4[q] : r4[q + 2];
          r2[q] = keep + __shfl_xor(send, 32);
        }
        float2 h = yv;
        h.x += r2[0];
        h.y += r2[1];
        *(float2*)(ybt + yl) = h;
      }
    }
  }
}

#define XB_TMO      128
#define XB_XCNT(j)  (256  + 64 * (j))
#define XB_XSUB(j)  (1280 + 64 * (j))
#define XB_XGEN(j)  (2304 + 64 * (j))
#define XB_TOP      3328
#define XB_TOPGEN   3392
#define XCD_BAR_WORDS 3456
#define XB_SPIN_CAP (1u << 18)
#define LAS __attribute__((address_space(3)))
__device__ __forceinline__ unsigned xb_ld(unsigned* p) { return __hip_atomic_load(p, __ATOMIC_RELAXED, __HIP_MEMORY_SCOPE_AGENT); }
__device__ __forceinline__ unsigned xb_add(unsigned* p, unsigned v) { return __hip_atomic_fetch_add(p, v, __ATOMIC_RELAXED, __HIP_MEMORY_SCOPE_AGENT); }
__device__ __forceinline__ unsigned xb_xcc_id() { return (unsigned)__builtin_amdgcn_s_getreg((3 << 11) | 20) & 0xFu; }
#define XB_SPIN(cond, bar) do { unsigned _sp = 0; while (cond) { __builtin_amdgcn_s_sleep(1); \
    if ((++_sp & 255u) == 0u) { if (xb_ld(&(bar)[XB_TMO])) break; if (_sp > XB_SPIN_CAP) { atomicAdd(&(bar)[XB_TMO], 1u); break; } } } } while (0)
struct XcdBarrier { unsigned* bar; unsigned x; volatile LAS unsigned* st; };
__device__ __forceinline__ XcdBarrier xcd_barrier_post(unsigned* bar, volatile LAS unsigned* st) {
  XcdBarrier b; b.bar = bar; b.x = xb_xcc_id(); b.st = st;
  if (threadIdx.x == 0) st[2] = xb_add(&bar[XB_XCNT(b.x)], 1u);
  return b;
}
__device__ __forceinline__ void xcd_barrier_complete(unsigned* bar, unsigned x, unsigned& nloc, unsigned& nx) {
  const unsigned G = gridDim.x * gridDim.y * gridDim.z;
  unsigned sum, cnt, mine, sp = 0u;
  for (;;) {
    sum = 0u; cnt = 0u; mine = 0u;
#pragma unroll
    for (unsigned j = 0; j < 16; ++j) { const unsigned c = xb_ld(&bar[XB_XCNT(j)]); sum += c; cnt += (c > 0u) ? 1u : 0u; mine = (j == x) ? c : mine; }
    if (sum == G) break;
    __builtin_amdgcn_s_sleep(1);
    if ((++sp & 255u) == 0u) { if (xb_ld(&bar[XB_TMO])) break; if (sp > XB_SPIN_CAP) { atomicAdd(&bar[XB_TMO], 1u); break; } }
  }
  nloc = mine > 0u ? mine : 1u; nx = cnt > 0u ? cnt : 1u;
}
__device__ __forceinline__ void xcd_barrier(const XcdBarrier& b) {
  asm volatile("s_waitcnt vmcnt(0)" ::: "memory");
  __syncthreads();
  if (threadIdx.x == 0) {
    unsigned* bar = b.bar;
    __builtin_amdgcn_s_waitcnt(0);
    unsigned nloc = b.st[0], nx = b.st[1];
    if (nloc == 0u) { xcd_barrier_complete(bar, b.x, nloc, nx); b.st[0] = nloc; b.st[1] = nx; }
    const unsigned old = xb_add(&bar[XB_XSUB(b.x)], 1u);
    const unsigned gen = old / nloc;
    if (old + 1u == (gen + 1u) * nloc) {
      __builtin_amdgcn_fence(__ATOMIC_RELEASE, "agent");
      asm volatile("s_waitcnt vmcnt(0)" ::: "memory");
      const unsigned og = xb_add(&bar[XB_TOP], 1u);
      const unsigned tg = og / nx;
      if (og + 1u == (tg + 1u) * nx) xb_add(&bar[XB_TOPGEN], 1u);
      else XB_SPIN(xb_ld(&bar[XB_TOPGEN]) == tg, bar);
      __builtin_amdgcn_fence(__ATOMIC_ACQUIRE, "agent");
      xb_add(&bar[XB_XGEN(b.x)], 1u);
      asm volatile("s_waitcnt vmcnt(0)" ::: "memory");
    } else {
      XB_SPIN(xb_ld(&bar[XB_XGEN(b.x)]) == gen, bar);
      __builtin_amdgcn_fence(__ATOMIC_ACQUIRE, "agent");
      asm volatile("s_waitcnt vmcnt(0)" ::: "memory");
    }
  }
  __syncthreads();
}

#ifndef REP_MASK
#define REP_MASK 0
#endif
#define REPS(k) for (int _rep = 0; _rep < (((REP_MASK) >> (k)) & 1) + 1; _rep++)
__global__ void __launch_bounds__(256, 2) fwd_megakernel(Params p_) {
  extern __shared__ __attribute__((aligned(16))) char smem[];
  cg::grid_group grid = cg::this_grid();
  if (p_.ws == nullptr) grid.sync();
  volatile LAS unsigned* xst = (volatile LAS unsigned*)(smem + SMEM_BYTES - 16);
  if (threadIdx.x == 0) { xst[0] = 0u; xst[1] = 0u; xst[2] = 0u; xst[3] = 0u; }
  __syncthreads();
  const XcdBarrier xb = xcd_barrier_post((unsigned*)(p_.ws + W_BAR), xst);
  REPS(0) { phase0(*fresh_params(), smem); xcd_barrier(xb); }
  if (threadIdx.x == 0) {
    unsigned* bar = (unsigned*)(p_.ws + W_BAR);
    const unsigned per = gridDim.x >> 3;
    bool uni = (gridDim.x & 7u) == 0u;
    for (unsigned j = 0; j < 16; ++j) { const unsigned cnt = xb_ld(&bar[XB_XCNT(j)]); if (cnt != (j < 8 ? per : 0u)) uni = false; }
    xst[3] = uni ? (xb.x * per + xst[2]) : blockIdx.x;
  }
  __syncthreads();
  const int vb = (int)xst[3];
  REPS(1) { phase_g1(*fresh_params(), smem, vb); xcd_barrier(xb); }
  REPS(2) {
    for (int it = blockIdx.x; it < MT * 16 + 1536; it += gridDim.x) {
      if (it < MT * 16) { const int mt = it >> 4; lru_tile(*fresh_params(), smem, mt, it & 15, mt < 128 ? 2 : 1); }
      else attn_item(*fresh_params(), smem, it - MT * 16);
    }
    xcd_barrier(xb);
  }
  REPS(4) { phase_g3(*fresh_params(), smem, vb); xcd_barrier(xb); }
  REPS(5) { phase_g4(*fresh_params(), smem, vb); xcd_barrier(xb); }
  REPS(6) { phase_g5(*fresh_params(), smem, vb); xcd_barrier(xb); }
  REPS(7) { phase_g6(*fresh_params(), smem, vb); xcd_barrier(xb); }
  phase7(*fresh_params());
  phase7b(*fresh_params());
}

extern "C" void kernel_launch(void* const* d_in, const int* in_sizes, int n_in, void* d_out, int out_size, void* d_ws,
                              size_t ws_size, hipStream_t stream) {
  static int grid_blocks = 0;
  if (!grid_blocks) {
    int dev = 0, cus = 0, per_cu = 0;
    hipGetDevice(&dev);
    hipDeviceGetAttribute(&cus, hipDeviceAttributeMultiprocessorCount, dev);
    hipFuncSetAttribute((const void*)fwd_megakernel, hipFuncAttributeMaxDynamicSharedMemorySize, SMEM_BYTES);
    hipOccupancyMaxActiveBlocksPerMultiprocessor(&per_cu, fwd_megakernel, 256, SMEM_BYTES);
    if (per_cu < 1) per_cu = 1;
    grid_blocks = cus * per_cu;
  }
  Params p{};
  const float** pp = (const float**)&p;
  for (int i = 0; i < 26; i++) pp[i] = (const float*)d_in[i];
  p.out = (float*)d_out;
  p.ws = (char*)d_ws;
  (void)hipMemsetAsync((char*)d_ws + W_BAR, 0, (size_t)3456 * 4 + 8 * 256 + 2048 * 4 + 2176 * 4, stream);
  void* args[] = {&p};
  hipError_t e = hipLaunchCooperativeKernel((void*)fwd_megakernel, dim3(grid_blocks), dim3(256), args, SMEM_BYTES, stream);
  if (e != hipSuccess) fprintf(stderr, "cooperative launch failed: %s (grid %d)\n", hipGetErrorString(e), grid_blocks);
}
```

```cpp
#include <hip/hip_runtime.h>
#include <hip/hip_cooperative_groups.h>
#include <stdint.h>
#include <cstdio>
namespace cg = cooperative_groups;

typedef unsigned short u16;
typedef __attribute__((ext_vector_type(8))) short bf16x8;
typedef __attribute__((ext_vector_type(4))) float f32x4;

constexpr int D = 1024;
constexpr int NP = 16384;
constexpr int NTOK = 17408;
constexpr int SEQ = 4096;
constexpr int MT = 136;
constexpr float EPS = 1e-6f;

constexpr size_t O_Y = 0;
constexpr size_t O_CONVP = 17825792;
constexpr size_t O_LRUP = O_CONVP + 12288;
constexpr size_t O_KP = O_LRUP + 4096;
constexpr size_t O_VP = O_KP + 131072;
constexpr size_t O_CONVS = O_VP + 131072;
constexpr size_t O_LRUS = O_CONVS + 393216;
constexpr size_t O_KS = O_LRUS + 131072;
constexpr size_t O_VS = O_KS + 4194304;

constexpr size_t W_WTIN = 0;
constexpr size_t W_WTLRU = W_WTIN + (size_t)5632 * 1024 * 2;
constexpr size_t W_WTATTN = W_WTLRU + (size_t)1024 * 1024 * 2;
constexpr size_t W_WTOUT = W_WTATTN + (size_t)1024 * 1024 * 2;
constexpr size_t W_WTQ = W_WTOUT + (size_t)1024 * 1024 * 2;
constexpr size_t W_SK = W_WTQ + (size_t)2048 * 1024 * 2;
constexpr size_t W_RGA = W_SK + (size_t)16 * 128 * 128 * 2;
constexpr size_t W_RGX = W_RGA + (size_t)65536 * 2;
constexpr size_t W_EU = W_RGX + (size_t)65536 * 2;
constexpr size_t W_EV = W_EU + (size_t)16384 * 1024;
constexpr size_t W_ESC = W_EV + (size_t)16384 * 1024;
constexpr size_t W_XN = W_ESC + (size_t)32768 * 4;
constexpr size_t W_ZA = W_XN + (size_t)NTOK * 1024 * 2;
constexpr size_t W_ZB = W_ZA + (size_t)NTOK * 2048 * 2;
constexpr size_t W_AGG = W_ZB + (size_t)NTOK * 1536 * 2;
constexpr size_t W_SSQ = W_AGG + (size_t)128 * 1024 * 2 * 4;
constexpr size_t W_BAR = W_SSQ + (size_t)NTOK * 16 * 4;
constexpr size_t W_Q = W_BAR + (size_t)3456 * 4;
constexpr size_t W_FLAG = W_Q + (size_t)8 * 256;
constexpr size_t W_CNT = W_FLAG + (size_t)2048 * 4;
constexpr size_t W_ACT = W_CNT + (size_t)2176 * 4;
constexpr size_t W_LO = W_ACT + (size_t)NTOK * 128 * 4;
constexpr size_t W_END = W_LO + (size_t)NTOK * 1024 * 2;

constexpr int SMEM_BYTES = 81920;

struct Params {
  const float *x_prompt, *x_sample, *cache_conv, *state_lru, *cache_k, *cache_v, *norm1_g, *w_in, *conv_w,
      *conv_b, *rg_w_a, *rg_b_a, *rg_w_x, *rg_b_x, *rg_lambda, *q_norm_g, *k_norm_g, *attn_sinks,
      *w_branch_lru, *w_branch_attn, *w_out, *norm2_g, *peer_w_query, *peer_sub_keys, *expert_u, *expert_v;
  float* out;
  char* ws;
};

typedef const __attribute__((address_space(4))) Params KParams;
__device__ __forceinline__ KParams* fresh_params() {
  unsigned long long k = (unsigned long long)__builtin_amdgcn_kernarg_segment_ptr();
  asm volatile("" : "+s"(k));
  return (KParams*)k;
}
__device__ __forceinline__ u16 f2bf(float f) {
  uint32_t u = __float_as_uint(f);
  u += 0x7FFFu + ((u >> 16) & 1u);
  return (u16)(u >> 16);
}
__device__ __forceinline__ float bf2f(u16 h) { return __uint_as_float(((uint32_t)h) << 16); }
__device__ __forceinline__ uint32_t pack2(float a, float b) {
  uint32_t r;
  asm("v_cvt_pk_bf16_f32 %0, %1, %2" : "=v"(r) : "v"(a), "v"(b));
  return r;
}
__device__ __forceinline__ uint4 pack8(const float* v) {
  uint4 o;
  o.x = pack2(v[0], v[1]); o.y = pack2(v[2], v[3]); o.z = pack2(v[4], v[5]); o.w = pack2(v[6], v[7]);
  return o;
}
__device__ __forceinline__ void unpack8(uint4 u, float* v) {
  v[0] = __uint_as_float(u.x << 16); v[1] = __uint_as_float(u.x & 0xFFFF0000u);
  v[2] = __uint_as_float(u.y << 16); v[3] = __uint_as_float(u.y & 0xFFFF0000u);
  v[4] = __uint_as_float(u.z << 16); v[5] = __uint_as_float(u.z & 0xFFFF0000u);
  v[6] = __uint_as_float(u.w << 16); v[7] = __uint_as_float(u.w & 0xFFFF0000u);
}
__device__ __forceinline__ float sigmoidf_(float x) { return __builtin_amdgcn_rcpf(1.f + __expf(-x)); }
__device__ __forceinline__ float gelu_tanh(float x) {
  float y = 0.7978845608028654f * (x + 0.044715f * x * x * x);
  float t = 1.f - 2.f * __builtin_amdgcn_rcpf(__expf(2.f * y) + 1.f);
  return 0.5f * x * (1.f + t);
}
__device__ __forceinline__ uint32_t ordf(float f) {
  uint32_t u = __float_as_uint(f);
  return (u & 0x80000000u) ? ~u : (u | 0x80000000u);
}
__device__ __forceinline__ float unordf(uint32_t o) {
  uint32_t u = (o & 0x80000000u) ? (o ^ 0x80000000u) : ~o;
  return __uint_as_float(u);
}
__device__ __forceinline__ unsigned hw_xcc_id() { return (unsigned)__builtin_amdgcn_s_getreg((3 << 11) | 20) & 0xFu; }
__device__ __forceinline__ int opaque_tid() {
  int t = threadIdx.x;
  asm volatile("" : "+v"(t));
  return t;
}
__device__ __forceinline__ const float* xrow(KParams& p, int row) {
  return row < NP ? p.x_prompt + (size_t)row * D : p.x_sample + (size_t)(row - NP) * D;
}

#define INS16(T, V)                                  \
  {                                                  \
    uint32_t _v = (V);                               \
    _Pragma("unroll") for (int _q = 0; _q < 16; _q++) { \
      uint32_t _hi = max(T[_q], _v);                 \
      _v = min(T[_q], _v);                           \
      T[_q] = _hi;                                   \
    }                                                \
  }

#define CE_DESC(A_, B_) { const uint32_t _h = max(A_, B_), _l = min(A_, B_); A_ = _h; B_ = _l; }
__device__ __forceinline__ void sort16_desc(uint32_t (&t)[16]) {
#pragma unroll
  for (int k = 2; k <= 16; k <<= 1) {
#pragma unroll
    for (int j = k >> 1; j > 0; j >>= 1) {
#pragma unroll
      for (int i = 0; i < 16; i++) {
        const int l = i ^ j;
        if (l > i) {
          if ((i & k) == 0) { CE_DESC(t[i], t[l]); } else { CE_DESC(t[l], t[i]); }
        }
      }
    }
  }
}
__device__ __forceinline__ void merge16_desc(uint32_t (&T)[16], const uint32_t (&S)[16]) {
#pragma unroll
  for (int i = 0; i < 16; i++) T[i] = max(T[i], S[15 - i]);
#pragma unroll
  for (int j = 8; j > 0; j >>= 1) {
#pragma unroll
    for (int i = 0; i < 16; i++) {
      const int l = i ^ j;
      if (l > i) { CE_DESC(T[i], T[l]); }
    }
  }
}

__device__ __forceinline__ void transpose_cvt(const float* __restrict__ W, u16* __restrict__ Wt, int K, int N,
                                              size_t gtid, size_t gsz) {
  size_t total = (size_t)N * (K / 8);
  for (size_t c = gtid; c < total; c += gsz) {
    int n = (int)(c % N);
    int kg = (int)(c / N);
    float v[8];
#pragma unroll
    for (int i = 0; i < 8; i++) v[i] = W[(size_t)(kg * 8 + i) * N + n];
    *(uint4*)(Wt + (size_t)n * K + kg * 8) = pack8(v);
  }
}
__device__ __forceinline__ void plain_cvt(const float* __restrict__ S, u16* __restrict__ Dst, size_t n, size_t gtid,
                                          size_t gsz) {
  size_t total = n / 8;
  const float4* s4 = (const float4*)S;
  for (size_t c = gtid; c < total; c += gsz) {
    float4 a = s4[2 * c], b = s4[2 * c + 1];
    float v[8] = {a.x, a.y, a.z, a.w, b.x, b.y, b.z, b.w};
    *(uint4*)(Dst + c * 8) = pack8(v);
  }
}

__device__ __forceinline__ void phase0(KParams& p, char* smem) {
  const int tid = opaque_tid();
  const size_t gtid = (size_t)blockIdx.x * 256 + tid, gsz = (size_t)gridDim.x * 256;
  char* ws = p.ws;
  {
    const int lane = tid & 63;
    const int gw = (int)(gtid >> 6), nw = (int)(gsz >> 6);
    u16* XN = (u16*)(ws + W_XN);
    for (int row = gw; row < NTOK; row += nw) {
      const float4* xr = (const float4*)xrow(p, row);
      float4 v[4];
      float ss = 0.f;
#pragma unroll
      for (int i = 0; i < 4; i++) {
        v[i] = xr[lane + i * 64];
        ss += v[i].x * v[i].x + v[i].y * v[i].y + v[i].z * v[i].z + v[i].w * v[i].w;
      }
#pragma unroll
      for (int o = 32; o > 0; o >>= 1) ss += __shfl_xor(ss, o);
      float rstd = rsqrtf(ss * (1.f / 1024.f) + EPS);
      const float4* g4 = (const float4*)p.norm1_g;
#pragma unroll
      for (int i = 0; i < 4; i++) {
        float4 g = g4[lane + i * 64];
        uint2 o;
        o.x = pack2(v[i].x * rstd * g.x, v[i].y * rstd * g.y);
        o.y = pack2(v[i].z * rstd * g.z, v[i].w * rstd * g.w);
        *(uint2*)(XN + (size_t)row * D + (lane + i * 64) * 4) = o;
      }
    }
  }
  {
    float* T = (float*)smem;
    for (int tile = blockIdx.x; tile < 2688; tile += gridDim.x) {
      const float* W;
      u16* Wt;
      int N, tl;
      if (tile < 1408) { W = p.w_in; Wt = (u16*)(ws + W_WTIN); N = 5632; tl = tile; }
      else if (tile < 1664) { W = p.w_branch_lru; Wt = (u16*)(ws + W_WTLRU); N = 1024; tl = tile - 1408; }
      else if (tile < 1920) { W = p.w_branch_attn; Wt = (u16*)(ws + W_WTATTN); N = 1024; tl = tile - 1664; }
      else if (tile < 2176) { W = p.w_out; Wt = (u16*)(ws + W_WTOUT); N = 1024; tl = tile - 1920; }
      else { W = p.peer_w_query; Wt = (u16*)(ws + W_WTQ); N = 2048; tl = tile - 2176; }
      const int ntn = N >> 6;
      const int kt = tl / ntn, nt = tl - kt * ntn;
      __syncthreads();
      {
        const float* src = W + (size_t)(kt * 64 + (tid >> 2)) * N + nt * 64 + (tid & 3) * 16;
        const float4 a0 = *(const float4*)src, a1 = *(const float4*)(src + 4), a2 = *(const float4*)(src + 8),
                     a3 = *(const float4*)(src + 12);
        float* d = T + (tid >> 2) * 65 + (tid & 3) * 16;
        d[0] = a0.x; d[1] = a0.y; d[2] = a0.z; d[3] = a0.w; d[4] = a1.x; d[5] = a1.y; d[6] = a1.z; d[7] = a1.w;
        d[8] = a2.x; d[9] = a2.y; d[10] = a2.z; d[11] = a2.w; d[12] = a3.x; d[13] = a3.y; d[14] = a3.z; d[15] = a3.w;
      }
      __syncthreads();
      {
        const int n = tid >> 2, kc = (tid & 3) * 16;
        float v[16];
#pragma unroll
        for (int i = 0; i < 16; i++) v[i] = T[(kc + i) * 65 + n];
        u16* dst = Wt + (size_t)(nt * 64 + n) * 1024 + kt * 64 + kc;
        *(uint4*)dst = pack8(v);
        *(uint4*)(dst + 8) = pack8(v + 8);
      }
    }
  }
  {
    u16* RA = (u16*)(ws + W_RGA);
    u16* RX = (u16*)(ws + W_RGX);
    for (size_t e = gtid; e < 65536; e += gsz) {
      int n = (int)(e >> 12), k = (int)((e >> 6) & 63), j = (int)(e & 63);
      RA[e] = f2bf(p.rg_w_a[n * 4096 + j * 64 + k]);
      RX[e] = f2bf(p.rg_w_x[n * 4096 + j * 64 + k]);
    }
  }
  plain_cvt(p.peer_sub_keys, (u16*)(ws + W_SK), (size_t)16 * 128 * 128, gtid, gsz);
  {
    const int lane = tid & 63;
    const int gw = (int)(gtid >> 6), nw = (int)(gsz >> 6);
    unsigned char* E8 = (unsigned char*)(ws + W_EU);
    float* ESC = (float*)(ws + W_ESC);
    for (int r = gw; r < 32768; r += nw) {
      const float* src = (r < 16384 ? p.expert_u : p.expert_v) + (size_t)(r & 16383) * 1024 + lane * 16;
      const float4 a0 = *(const float4*)src, a1 = *(const float4*)(src + 4), a2 = *(const float4*)(src + 8),
                   a3 = *(const float4*)(src + 12);
      float am = fmaxf(fmaxf(fmaxf(fabsf(a0.x), fabsf(a0.y)), fmaxf(fabsf(a0.z), fabsf(a0.w))),
                       fmaxf(fmaxf(fabsf(a1.x), fabsf(a1.y)), fmaxf(fabsf(a1.z), fabsf(a1.w))));
      am = fmaxf(am, fmaxf(fmaxf(fmaxf(fabsf(a2.x), fabsf(a2.y)), fmaxf(fabsf(a2.z), fabsf(a2.w))),
                           fmaxf(fmaxf(fabsf(a3.x), fabsf(a3.y)), fmaxf(fabsf(a3.z), fabsf(a3.w)))));
#pragma unroll
      for (int o = 32; o > 0; o >>= 1) am = fmaxf(am, __shfl_xor(am, o));
      const float sc = am > 0.f ? 224.f / am : 1.f;
      uint4 o4;
      int wv;
      wv = __builtin_amdgcn_cvt_pk_fp8_f32(a0.x * sc, a0.y * sc, 0, false);
      wv = __builtin_amdgcn_cvt_pk_fp8_f32(a0.z * sc, a0.w * sc, wv, true);
      o4.x = (uint32_t)wv;
      wv = __builtin_amdgcn_cvt_pk_fp8_f32(a1.x * sc, a1.y * sc, 0, false);
      wv = __builtin_amdgcn_cvt_pk_fp8_f32(a1.z * sc, a1.w * sc, wv, true);
      o4.y = (uint32_t)wv;
      wv = __builtin_amdgcn_cvt_pk_fp8_f32(a2.x * sc, a2.y * sc, 0, false);
      wv = __builtin_amdgcn_cvt_pk_fp8_f32(a2.z * sc, a2.w * sc, wv, true);
      o4.z = (uint32_t)wv;
      wv = __builtin_amdgcn_cvt_pk_fp8_f32(a3.x * sc, a3.y * sc, 0, false);
      wv = __builtin_amdgcn_cvt_pk_fp8_f32(a3.z * sc, a3.w * sc, wv, true);
      o4.w = (uint32_t)wv;
      if (r < 16384) *(uint4*)(E8 + (size_t)r * 1024 + lane * 16) = o4;
      else *(uint4*)(E8 + (size_t)16384 * 1024 + (size_t)(lane >> 3) * (16384 * 128) + (size_t)(r - 16384) * 128 + (lane & 7) * 16) = o4;
      if (lane == 0) ESC[r] = am > 0.f ? am * (1.f / 224.f) : 1.f;
    }
  }
}

constexpr int LDT = 72;
constexpr int CS_LD = 132;

template <int NW>
__device__ __forceinline__ void gemm_tile(const u16* __restrict__ A, int lda, const u16* __restrict__ Bt, int ldb,
                                          int K, f32x4 (&acc)[4][NW / 32], char* smem, int tid) {
  constexpr int NJ = NW / 32;
  const int lane = tid & 63, w = tid >> 6;
  const int wm = w >> 1, wn = w & 1;
  const int l15 = lane & 15, quad = lane >> 4;
  const int lr = w * 8 + (lane >> 3);
  const int lc = ((lane & 7) ^ ((lane >> 3) & 7)) * 8;
  const char* Ab = (const char*)A;
  const char* Bb = (const char*)Bt;
  const uint32_t ao = (uint32_t)(lr * lda + lc) * 2u, bo = (uint32_t)(lr * ldb + lc) * 2u;
  const uint32_t sa2 = 64u * (uint32_t)lda, sb2 = 64u * (uint32_t)ldb;
  const uint32_t kmask = (uint32_t)K - 1u, kst = (((uint32_t)blockIdx.x >> 3) * 64u) & kmask;
  char* lw = smem + w * 1024 + lane * 16;
  const int swz = l15 & 7;
  const char* Ar = smem + (wm * 64 + l15) * 128 + ((quad ^ swz) * 16);
  const char* Br = smem + 16384 + (wn * (NW / 2) + l15) * 128 + ((quad ^ swz) * 16);
  const char* Ar1 = smem + (wm * 64 + l15) * 128 + (((4 + quad) ^ swz) * 16);
  const char* Br1 = smem + 16384 + (wn * (NW / 2) + l15) * 128 + (((4 + quad) ^ swz) * 16);
#define GT_ISSUE(st, off)                                                                                   \
  {                                                                                                         \
    const uint32_t _o = (((uint32_t)(off) + kst) & kmask) * 2u;                                             \
    char* _l = lw + (st) * 32768;                                                                           \
    _Pragma("unroll") for (int j = 0; j < 4; j++) {                                                         \
      __builtin_amdgcn_global_load_lds((const unsigned*)(Ab + (size_t)(ao + j * sa2 + _o)), (unsigned*)(_l + j * 4096), 16, 0, 0);          \
      if (j < NJ) __builtin_amdgcn_global_load_lds((const unsigned*)(Bb + (size_t)(bo + j * sb2 + _o)), (unsigned*)(_l + 16384 + j * 4096), 16, 0, 0);  \
    }                                                                                                       \
  }
#define GT_MMA(st)                                                                                          \
  {                                                                                                         \
    const char* _ar = Ar + (st) * 32768; const char* _br = Br + (st) * 32768;                               \
    const char* _ar1 = Ar1 + (st) * 32768; const char* _br1 = Br1 + (st) * 32768;                           \
    bf16x8 a0[4], b0[NJ], a1[4], b1[NJ];                                                                      \
    _Pragma("unroll") for (int i = 0; i < 4; i++) {                                                         \
      a0[i] = *(const bf16x8*)(_ar + i * 2048);                                                             \
      if (i < NJ) b0[i] = *(const bf16x8*)(_br + i * 2048);                                                 \
    }                                                                                                       \
    _Pragma("unroll") for (int i = 0; i < 4; i++) {                                                         \
      a1[i] = *(const bf16x8*)(_ar1 + i * 2048);                                                            \
      if (i < NJ) b1[i] = *(const bf16x8*)(_br1 + i * 2048);                                                \
    }                                                                                                       \
    __builtin_amdgcn_s_setprio(1);                                                                          \
    _Pragma("unroll") for (int i = 0; i < 4; i++)                                                           \
      _Pragma("unroll") for (int j = 0; j < NJ; j++)                                                        \
        acc[i][j] = __builtin_amdgcn_mfma_f32_16x16x32_bf16(a0[i], b0[j], acc[i][j], 0, 0, 0);              \
    _Pragma("unroll") for (int i = 0; i < 4; i++)                                                           \
      _Pragma("unroll") for (int j = 0; j < NJ; j++)                                                        \
        acc[i][j] = __builtin_amdgcn_mfma_f32_16x16x32_bf16(a1[i], b1[j], acc[i][j], 0, 0, 0);              \
    __builtin_amdgcn_s_setprio(0);                                                                          \
  }
  __syncthreads();
  GT_ISSUE(0, 0);
  for (int k0 = 0; k0 < K; k0 += 128) {
    asm volatile("s_waitcnt vmcnt(0) lgkmcnt(0)" ::: "memory");
    __builtin_amdgcn_s_barrier();
    asm volatile("" ::: "memory");
    GT_ISSUE(1, k0 + 64);
    GT_MMA(0);
    asm volatile("s_waitcnt vmcnt(0) lgkmcnt(0)" ::: "memory");
    __builtin_amdgcn_s_barrier();
    asm volatile("" ::: "memory");
    if (k0 + 128 < K) GT_ISSUE(0, k0 + 128);
    GT_MMA(1);
  }
#undef GT_ISSUE
#undef GT_MMA
}

__device__ __forceinline__ void tile_map(int it, int total, int NT, int& mt, int& nt, int vb) {
  const int G = gridDim.x;
  int T = it;
  {
    const int round = it / G;
    if (round * G + G <= total) T = round * G + vb;
  }
  const int g = T / (8 * NT), r = T - g * (8 * NT);
  nt = r >> 3;
  mt = g * 8 + (r & 7);
}

template <int NJ>
__device__ __forceinline__ void zero_acc(f32x4 (&acc)[4][NJ]) {
#pragma unroll
  for (int i = 0; i < 4; i++)
#pragma unroll
    for (int j = 0; j < NJ; j++) acc[i][j] = (f32x4){0.f, 0.f, 0.f, 0.f};
}

template <int NJ>
__device__ __forceinline__ void acc_to_cs(const f32x4 (&acc)[4][NJ], float* Cs, int tid) {
  const int lane = tid & 63, w = tid >> 6;
  const int wm = w >> 1, wn = w & 1;
  const int l15 = lane & 15, quad = lane >> 4;
#pragma unroll
  for (int i = 0; i < 4; i++)
#pragma unroll
    for (int j = 0; j < NJ; j++)
#pragma unroll
      for (int e = 0; e < 4; e++)
        Cs[(wm * 64 + i * 16 + quad * 4 + e) * CS_LD + wn * (NJ * 16) + j * 16 + l15] = acc[i][j][e];
}

__device__ __forceinline__ void phase_g1(KParams& p, char* smem, int vb) {
  const int tid = opaque_tid();
  u16* As = (u16*)smem;
  u16* Bs = As + 2 * 128 * LDT;
  float* Cs = (float*)smem;
  const u16* XN = (const u16*)(p.ws + W_XN);
  const u16* WT = (const u16*)(p.ws + W_WTIN);
  for (int t = blockIdx.x; t < MT * 44; t += gridDim.x) {
    int mt, nt;
    tile_map(t, MT * 44, 44, mt, nt, vb);
    f32x4 acc[4][4];
    zero_acc(acc);
    gemm_tile<128>(XN + (size_t)mt * 128 * 1024, 1024, WT + (size_t)nt * 128 * 1024, 1024, 1024, acc, smem, tid);
    __syncthreads();
    acc_to_cs(acc, Cs, tid);
    __syncthreads();
    const int n0 = nt * 128;
    u16* dst;
    int ldd, col;
    if (n0 < 2048) { dst = (u16*)(p.ws + W_ZA); ldd = 2048; col = n0; }
    else if (n0 < 3584) { dst = (u16*)(p.ws + W_ZB); ldd = 1536; col = n0 - 2048; }
    else { dst = (u16*)p.out; ldd = 2048; col = n0 - 3584; }
    const int cc = (tid & 15) * 8;
#pragma unroll
    for (int i = 0; i < 8; i++) {
      const int r = (tid >> 4) + 16 * i;
      float4 a = *(const float4*)(Cs + r * CS_LD + cc), b = *(const float4*)(Cs + r * CS_LD + cc + 4);
      float v[8] = {a.x, a.y, a.z, a.w, b.x, b.y, b.z, b.w};
      *(uint4*)(dst + (size_t)(mt * 128 + r) * ldd + col + cc) = pack8(v);
    }
    __syncthreads();
  }
}

constexpr int KS_LD = 72, VT_LD = 200, PS_LD = 168;
__device__ __forceinline__ void attn_item(KParams& p, char* smem, int item) {
  const int tid = opaque_tid(), lane = tid & 63, w = tid >> 6, l15 = lane & 15, quad = lane >> 4;
  u16* Ks = (u16*)smem;
  u16* Vt = Ks + 192 * KS_LD;
  u16* Ps = Vt + 64 * VT_LD + w * 16 * PS_LD;
  const u16* ZB = (const u16*)(p.ws + W_ZB);
  u16* ATT = (u16*)(p.ws + W_XN);
  const bool sample = item >= 1024;
  int b, qb = 0, kv, rowbase, p0 = 0;
  if (!sample) {
    kv = item & 3; qb = (item >> 2) & 63; b = item >> 8;
    p0 = qb * 64;
    rowbase = b * SEQ + p0;
  } else {
    int it = item - 1024;
    kv = it & 3; b = it >> 2;
    rowbase = NP + b * 8;
  }
  __syncthreads();
  {
    const int ch = tid & 7;
    float kg[8];
#pragma unroll
    for (int i = 0; i < 8; i++) kg[i] = p.k_norm_g[ch * 8 + i];
    const int nrows = sample ? 160 : 192;
    for (int c = tid; c < nrows * 8; c += 256) {
      const int row = c >> 3;
      float kf[8], vf[8];
      bool valid, donorm;
      if (!sample) {
        const int pos = p0 - 128 + row;
        valid = pos >= 0;
        donorm = true;
        if (valid) {
          const u16* src = ZB + (size_t)(b * SEQ + pos) * 1536 + 1024 + kv * 64 + ch * 8;
          unpack8(*(const uint4*)src, kf);
          unpack8(*(const uint4*)(src + 256), vf);
        }
      } else {
        valid = row < 136;
        donorm = row >= 128;
        if (row < 128) {
          const float* sk = p.cache_k + ((size_t)(b * 128 + row) * 4 + kv) * 64 + ch * 8;
          const float* sv = p.cache_v + ((size_t)(b * 128 + row) * 4 + kv) * 64 + ch * 8;
          float4 a0 = *(const float4*)sk, a1 = *(const float4*)(sk + 4);
          float4 b0 = *(const float4*)sv, b1 = *(const float4*)(sv + 4);
          kf[0] = a0.x; kf[1] = a0.y; kf[2] = a0.z; kf[3] = a0.w; kf[4] = a1.x; kf[5] = a1.y; kf[6] = a1.z; kf[7] = a1.w;
          vf[0] = b0.x; vf[1] = b0.y; vf[2] = b0.z; vf[3] = b0.w; vf[4] = b1.x; vf[5] = b1.y; vf[6] = b1.z; vf[7] = b1.w;
        } else if (valid) {
          const u16* src = ZB + (size_t)(NP + b * 8 + (row - 128)) * 1536 + 1024 + kv * 64 + ch * 8;
          unpack8(*(const uint4*)src, kf);
          unpack8(*(const uint4*)(src + 256), vf);
        }
      }
      if (!valid) {
#pragma unroll
        for (int i = 0; i < 8; i++) { kf[i] = 0.f; vf[i] = 0.f; }
      }
      float ss = 0.f;
#pragma unroll
      for (int i = 0; i < 8; i++) ss += kf[i] * kf[i];
      ss += __shfl_xor(ss, 1);
      ss += __shfl_xor(ss, 2);
      ss += __shfl_xor(ss, 4);
      if (donorm) {
        const float rstd = rsqrtf(ss * (1.f / 64.f) + EPS);
#pragma unroll
        for (int i = 0; i < 8; i++) kf[i] = kf[i] * rstd * kg[i];
      }
      *(uint4*)(Ks + row * KS_LD + ch * 8) = pack8(kf);
#pragma unroll
      for (int i = 0; i < 8; i++) Vt[(ch * 8 + i) * VT_LD + row] = f2bf(vf[i]);
      if (!sample) {
        if (qb >= 62 && row >= 128) {
          const int wpos = p0 + (row - 128) - (SEQ - 128);
          float* ko = p.out + O_KP + ((size_t)(b * 128 + wpos) * 4 + kv) * 64 + ch * 8;
          float* vo = p.out + O_VP + ((size_t)(b * 128 + wpos) * 4 + kv) * 64 + ch * 8;
          *(float4*)ko = make_float4(kf[0], kf[1], kf[2], kf[3]);
          *(float4*)(ko + 4) = make_float4(kf[4], kf[5], kf[6], kf[7]);
          *(float4*)vo = make_float4(vf[0], vf[1], vf[2], vf[3]);
          *(float4*)(vo + 4) = make_float4(vf[4], vf[5], vf[6], vf[7]);
        }
      } else {
        if (row >= 8 && row < 136) {
          float* ko = p.out + O_KS + ((size_t)(b * 128 + (row - 8)) * 4 + kv) * 64 + ch * 8;
          float* vo = p.out + O_VS + ((size_t)(b * 128 + (row - 8)) * 4 + kv) * 64 + ch * 8;
          *(float4*)ko = make_float4(kf[0], kf[1], kf[2], kf[3]);
          *(float4*)(ko + 4) = make_float4(kf[4], kf[5], kf[6], kf[7]);
          *(float4*)vo = make_float4(vf[0], vf[1], vf[2], vf[3]);
          *(float4*)(vo + 4) = make_float4(vf[4], vf[5], vf[6], vf[7]);
        }
      }
    }
  }
  __syncthreads();
  const int hq = kv * 4 + w;
  const float slope = exp2f(-0.5f * (float)(hq + 1));
  const float sink = p.attn_sinks[hq];
  float qg[2][8];
#pragma unroll
  for (int ks = 0; ks < 2; ks++)
#pragma unroll
    for (int i = 0; i < 8; i++) qg[ks][i] = p.q_norm_g[ks * 32 + quad * 8 + i] * 0.125f;
  const int nsub = sample ? 1 : 4;
  for (int sb = 0; sb < nsub; sb++) {
    const int r0 = sb * 16;
    const int ws0 = r0 < 32 ? r0 : 32;
    bf16x8 qa[2];
    {
      const int qr = sample ? (l15 & 7) : (r0 + l15);
      const u16* src = ZB + (size_t)(rowbase + qr) * 1536 + hq * 64 + quad * 8;
      float q0[8], q1[8];
      unpack8(*(const uint4*)src, q0);
      unpack8(*(const uint4*)(src + 32), q1);
      float ss = 0.f;
#pragma unroll
      for (int i = 0; i < 8; i++) ss += q0[i] * q0[i] + q1[i] * q1[i];
      ss += __shfl_xor(ss, 16);
      ss += __shfl_xor(ss, 32);
      const float rstd = rsqrtf(ss * (1.f / 64.f) + EPS);
#pragma unroll
      for (int i = 0; i < 8; i++) { q0[i] *= rstd * qg[0][i]; q1[i] *= rstd * qg[1][i]; }
      uint4 u0 = pack8(q0), u1 = pack8(q1);
      qa[0] = __builtin_bit_cast(bf16x8, u0);
      qa[1] = __builtin_bit_cast(bf16x8, u1);
    }
    f32x4 s[10];
#pragma unroll
    for (int kt = 0; kt < 10; kt++) {
      const u16* kp = Ks + (ws0 + kt * 16 + l15) * KS_LD + quad * 8;
      bf16x8 b0 = *(const bf16x8*)kp, b1 = *(const bf16x8*)(kp + 32);
      f32x4 z = {0.f, 0.f, 0.f, 0.f};
      z = __builtin_amdgcn_mfma_f32_16x16x32_bf16(qa[0], b0, z, 0, 0, 0);
      s[kt] = __builtin_amdgcn_mfma_f32_16x16x32_bf16(qa[1], b1, z, 0, 0, 0);
    }
    float mx[4] = {-1e30f, -1e30f, -1e30f, -1e30f};
#pragma unroll
    for (int kt = 0; kt < 10; kt++) {
      const int jj = ws0 + kt * 16 + l15;
      const bool posok = sample ? (jj < 136) : (p0 - 128 + jj >= 0);
#pragma unroll
      for (int e = 0; e < 4; e++) {
        const int r = r0 + quad * 4 + e;
        const int dist = r + 128 - jj;
        const bool ok = posok && dist >= 0 && dist <= 128;
        float v = ok ? (s[kt][e] - slope * (float)dist) : -1e30f;
        s[kt][e] = v;
        mx[e] = fmaxf(mx[e], v);
      }
    }
    float sum[4];
#pragma unroll
    for (int e = 0; e < 4; e++) {
      float m = mx[e];
      m = fmaxf(m, __shfl_xor(m, 1));
      m = fmaxf(m, __shfl_xor(m, 2));
      m = fmaxf(m, __shfl_xor(m, 4));
      m = fmaxf(m, __shfl_xor(m, 8));
      m = fmaxf(m, sink);
      mx[e] = m;
      sum[e] = 0.f;
    }
#pragma unroll
    for (int kt = 0; kt < 10; kt++) {
#pragma unroll
      for (int e = 0; e < 4; e++) {
        float pv = __expf(s[kt][e] - mx[e]);
        sum[e] += pv;
        Ps[(quad * 4 + e) * PS_LD + kt * 16 + l15] = f2bf(pv);
      }
    }
#pragma unroll
    for (int e = 0; e < 4; e++) {
      float t = sum[e];
      t += __shfl_xor(t, 1);
      t += __shfl_xor(t, 2);
      t += __shfl_xor(t, 4);
      t += __shfl_xor(t, 8);
      sum[e] = 1.f / (t + __expf(sink - mx[e]));
    }
    __syncthreads();
    f32x4 o[4];
#pragma unroll
    for (int nt = 0; nt < 4; nt++) o[nt] = (f32x4){0.f, 0.f, 0.f, 0.f};
#pragma unroll
    for (int kk = 0; kk < 5; kk++) {
      bf16x8 pa = *(const bf16x8*)(Ps + l15 * PS_LD + kk * 32 + quad * 8);
#pragma unroll
      for (int nt = 0; nt < 4; nt++) {
        bf16x8 vb = *(const bf16x8*)(Vt + (nt * 16 + l15) * VT_LD + ws0 + kk * 32 + quad * 8);
        o[nt] = __builtin_amdgcn_mfma_f32_16x16x32_bf16(pa, vb, o[nt], 0, 0, 0);
      }
    }
#pragma unroll
    for (int e = 0; e < 4; e++) {
      const int r = quad * 4 + e;
      if (!sample || r < 8) {
        u16* dst = ATT + (size_t)(rowbase + r0 + r) * 1024 + hq * 64 + l15;
#pragma unroll
        for (int nt = 0; nt < 4; nt++) dst[nt * 16] = f2bf(o[nt][e] * sum[e]);
      }
    }
    __syncthreads();
  }
}

constexpr int XC_LD = 68;
__device__ __forceinline__ void lru_tile(KParams& p, char* smem, int mt, int nb, int mode) {
  const int tid = opaque_tid(), lane = tid & 63, w = tid >> 6, l15 = lane & 15, quad = lane >> 4;
  float* xcF = (float*)smem;
  float* aL = xcF + 128 * XC_LD;
  float* aggL = aL + 128 * XC_LD;
  const u16* ZA = (const u16*)(p.ws + W_ZA);
  const bool sample = mt >= 128;
  const int m0 = mt * 128;
  const int cb = nb * 64;
  __syncthreads();
  {
    const int ch = tid & 7;
    float cw[4][8], cbias[8];
#pragma unroll
    for (int j = 0; j < 4; j++)
#pragma unroll
      for (int i = 0; i < 8; i++) cw[j][i] = p.conv_w[j * 1024 + cb + ch * 8 + i];
#pragma unroll
    for (int i = 0; i < 8; i++) cbias[i] = p.conv_b[cb + ch * 8 + i];
#pragma unroll
    for (int it = 0; it < 4; it++) {
      const int r = (tid >> 3) + it * 32;
      const int grow = m0 + r;
      const int t = sample ? (r & 7) : ((mt & 31) * 128 + r);
      float y[8];
#pragma unroll
      for (int i = 0; i < 8; i++) y[i] = cbias[i];
#pragma unroll
      for (int d = 0; d < 4; d++) {
        float xv[8];
        if (t - d >= 0) {
          unpack8(*(const uint4*)(ZA + (size_t)(grow - d) * 2048 + cb + ch * 8), xv);
        } else if (sample) {
          const int bb = (m0 - NP + r) >> 3;
          const float* src = p.cache_conv + ((size_t)bb * 3 + (3 + t - d)) * 1024 + cb + ch * 8;
          float4 a = *(const float4*)src, b4 = *(const float4*)(src + 4);
          xv[0] = a.x; xv[1] = a.y; xv[2] = a.z; xv[3] = a.w; xv[4] = b4.x; xv[5] = b4.y; xv[6] = b4.z; xv[7] = b4.w;
        } else {
#pragma unroll
          for (int i = 0; i < 8; i++) xv[i] = 0.f;
        }
#pragma unroll
        for (int i = 0; i < 8; i++) y[i] += cw[3 - d][i] * xv[i];
        if (d == 0 && mode != 0) {
          if (!sample) {
            if ((mt & 31) == 31 && r >= 125) {
              float* dst = p.out + O_CONVP + ((size_t)(mt >> 5) * 3 + (r - 125)) * 1024 + cb + ch * 8;
              *(float4*)dst = make_float4(xv[0], xv[1], xv[2], xv[3]);
              *(float4*)(dst + 4) = make_float4(xv[4], xv[5], xv[6], xv[7]);
            }
          } else if (t >= 5) {
            const int bb = (m0 - NP + r) >> 3;
            float* dst = p.out + O_CONVS + ((size_t)bb * 3 + (t - 5)) * 1024 + cb + ch * 8;
            *(float4*)dst = make_float4(xv[0], xv[1], xv[2], xv[3]);
            *(float4*)(dst + 4) = make_float4(xv[4], xv[5], xv[6], xv[7]);
          }
        }
      }
      *(float4*)(xcF + r * XC_LD + ch * 8) = make_float4(y[0], y[1], y[2], y[3]);
      *(float4*)(xcF + r * XC_LD + ch * 8 + 4) = make_float4(y[4], y[5], y[6], y[7]);
    }
  }
  __syncthreads();
  {
    const u16* RA = (const u16*)(p.ws + W_RGA) + nb * 4096;
    const u16* RX = (const u16*)(p.ws + W_RGX) + nb * 4096;
    f32x4 aR[2][4], aI[2][4];
#pragma unroll
    for (int i = 0; i < 2; i++)
#pragma unroll
      for (int j = 0; j < 4; j++) { aR[i][j] = (f32x4){0.f, 0.f, 0.f, 0.f}; aI[i][j] = (f32x4){0.f, 0.f, 0.f, 0.f}; }
#pragma unroll
    for (int ks = 0; ks < 2; ks++) {
      bf16x8 a[2];
#pragma unroll
      for (int i = 0; i < 2; i++) {
        const float* src = xcF + (w * 32 + i * 16 + l15) * XC_LD + ks * 32 + quad * 8;
        float4 x0 = *(const float4*)src, x1 = *(const float4*)(src + 4);
        float v[8] = {x0.x, x0.y, x0.z, x0.w, x1.x, x1.y, x1.z, x1.w};
        uint4 u = pack8(v);
        a[i] = __builtin_bit_cast(bf16x8, u);
      }
#pragma unroll
      for (int j = 0; j < 4; j++) {
        bf16x8 ba = *(const bf16x8*)(RA + (j * 16 + l15) * 64 + ks * 32 + quad * 8);
        bf16x8 bx = *(const bf16x8*)(RX + (j * 16 + l15) * 64 + ks * 32 + quad * 8);
#pragma unroll
        for (int i = 0; i < 2; i++) {
          aR[i][j] = __builtin_amdgcn_mfma_f32_16x16x32_bf16(a[i], ba, aR[i][j], 0, 0, 0);
          aI[i][j] = __builtin_amdgcn_mfma_f32_16x16x32_bf16(a[i], bx, aI[i][j], 0, 0, 0);
        }
      }
    }
#pragma unroll
    for (int j = 0; j < 4; j++) {
      const int c = cb + j * 16 + l15;
      const float ba = p.rg_b_a[c], bx = p.rg_b_x[c];
      const float ls = -log1pf(__expf(-p.rg_lambda[c]));
#pragma unroll
      for (int i = 0; i < 2; i++)
#pragma unroll
        for (int e = 0; e < 4; e++) {
          const int row = w * 32 + i * 16 + quad * 4 + e;
          const float rg = sigmoidf_(aR[i][j][e] + ba);
          const float ig = sigmoidf_(aI[i][j][e] + bx);
          const float la = 8.f * rg * ls;
          const float av = __expf(la);
          const float x2 = 2.f * la;
          const float emt = -x2 * (1.f + x2 * (0.5f + x2 * (0.16666667f + x2 * (0.041666668f + x2 * 0.008333334f))));
          const float em = x2 > -0.25f ? emt : 1.f - __expf(x2);
          const float mult = __builtin_amdgcn_sqrtf(fmaxf(em, 0.f));
          const int idx = row * XC_LD + j * 16 + l15;
          const float xv = xcF[idx];
          aL[idx] = av;
          xcF[idx] = mult * ig * xv;
        }
    }
  }
  __syncthreads();
  const int c = cb + lane;
  float* carL = aggL + 512;
  if (!sample) {
    float* AGGP = (float*)(p.ws + W_AGG);
    float* AGGH = AGGP + 128 * 1024;
    const int chunk = mt & 31, base = mt - chunk;
    if (mode == 1) {
      float Pq[8], Hq[8];
#pragma unroll
      for (int k = 0; k < 8; k++) {
        const int q = w * 8 + k;
        const bool ok = q < chunk;
        Pq[k] = ok ? AGGP[(base + q) * 1024 + c] : 1.f;
        Hq[k] = ok ? AGGH[(base + q) * 1024 + c] : 0.f;
      }
      float Pc = 1.f, hc = 0.f;
#pragma unroll
      for (int k = 0; k < 8; k++) { hc = Pq[k] * hc + Hq[k]; Pc *= Pq[k]; }
      carL[(w * 64 + lane) * 2] = Pc;
      carL[(w * 64 + lane) * 2 + 1] = hc;
    }
    float P = 1.f, h = 0.f;
#pragma unroll 8
    for (int rr = 0; rr < 32; rr++) {
      const float av = aL[(w * 32 + rr) * XC_LD + lane], bv = xcF[(w * 32 + rr) * XC_LD + lane];
      h = av * h + bv;
      P *= av;
    }
    aggL[(w * 64 + lane) * 2] = P;
    aggL[(w * 64 + lane) * 2 + 1] = h;
    __syncthreads();
    if (mode == 0 || mode == 2) {
      if (w == 0) {
        float Pt = 1.f, ht = 0.f;
#pragma unroll
        for (int q = 0; q < 4; q++) {
          const float Pq = aggL[(q * 64 + lane) * 2], hq = aggL[(q * 64 + lane) * 2 + 1];
          ht = Pq * ht + hq;
          Pt *= Pq;
        }
        if (mode == 0) {
          AGGP[mt * 1024 + c] = Pt;
          AGGH[mt * 1024 + c] = ht;
        } else {
          __hip_atomic_store(&AGGP[mt * 1024 + c], Pt, __ATOMIC_RELAXED, __HIP_MEMORY_SCOPE_AGENT);
          __hip_atomic_store(&AGGH[mt * 1024 + c], ht, __ATOMIC_RELAXED, __HIP_MEMORY_SCOPE_AGENT);
          asm volatile("s_waitcnt vmcnt(0)" ::: "memory");
          if (lane == 0)
            __hip_atomic_store((unsigned*)(p.ws + W_FLAG) + mt * 16 + nb, 1u, __ATOMIC_RELAXED, __HIP_MEMORY_SCOPE_AGENT);
        }
      }
    }
    if (mode == 2) {
      {
        const int q = w * 8 + (lane & 7);
        const bool need = (lane < 8) && (q < chunk);
        unsigned* fp = (unsigned*)(p.ws + W_FLAG) + (base + (need ? q : 0)) * 16 + nb;
        unsigned spins = 0;
        for (;;) {
          const unsigned f = need ? __hip_atomic_load(fp, __ATOMIC_RELAXED, __HIP_MEMORY_SCOPE_AGENT) : 1u;
          if (__ballot(f == 0u) == 0ull) break;
          __builtin_amdgcn_s_sleep(2);
          if (++spins > (1u << 20)) break;
        }
      }
      float Pq[8], Hq[8];
#pragma unroll
      for (int k = 0; k < 8; k++) {
        const int q = w * 8 + k;
        const bool ok = q < chunk;
        Pq[k] = ok ? __hip_atomic_load(&AGGP[(base + q) * 1024 + c], __ATOMIC_RELAXED, __HIP_MEMORY_SCOPE_AGENT) : 1.f;
        Hq[k] = ok ? __hip_atomic_load(&AGGH[(base + q) * 1024 + c], __ATOMIC_RELAXED, __HIP_MEMORY_SCOPE_AGENT) : 0.f;
      }
      float Pc = 1.f, hc = 0.f;
#pragma unroll
      for (int k = 0; k < 8; k++) { hc = Pq[k] * hc + Hq[k]; Pc *= Pq[k]; }
      carL[(w * 64 + lane) * 2] = Pc;
      carL[(w * 64 + lane) * 2 + 1] = hc;
      __syncthreads();
    }
    if (mode == 0) {
    } else {
      float hin = 0.f;
#pragma unroll
      for (int q = 0; q < 4; q++) hin = carL[(q * 64 + lane) * 2] * hin + carL[(q * 64 + lane) * 2 + 1];
      for (int q = 0; q < w; q++) hin = aggL[(q * 64 + lane) * 2] * hin + aggL[(q * 64 + lane) * 2 + 1];
      float hh = hin;
#pragma unroll 8
      for (int rr = 0; rr < 32; rr++) {
        const int row = w * 32 + rr;
        const float av = aL[row * XC_LD + lane], bv = xcF[row * XC_LD + lane];
        hh = av * hh + bv;
        xcF[row * XC_LD + lane] = hh;
      }
      if (chunk == 31 && w == 3) p.out[O_LRUP + (size_t)(mt >> 5) * 1024 + c] = hh;
    }
  } else {
    float hh = 0.f;
    float h0v[4];
#pragma unroll
    for (int k = 0; k < 4; k++) h0v[k] = p.state_lru[(size_t)(((m0 - NP + w * 32) >> 3) + k) * 1024 + c];
#pragma unroll
    for (int rr = 0; rr < 32; rr++) {
      const int row = w * 32 + rr;
      const int bb = (m0 - NP + row) >> 3;
      const int t = row & 7;
      if (t == 0) hh = h0v[rr >> 3];
      const float av = aL[row * XC_LD + lane], bv = xcF[row * XC_LD + lane];
      hh = av * hh + bv;
      xcF[row * XC_LD + lane] = hh;
      if (t == 7) p.out[O_LRUS + (size_t)bb * 1024 + c] = hh;
    }
  }
  if (mode != 0) {
    __syncthreads();
    u16* LO = (u16*)(p.ws + W_LO);
    const int ch = tid & 7;
#pragma unroll
    for (int it = 0; it < 4; it++) {
      const int r = (tid >> 3) + it * 32;
      float g[8];
      unpack8(*(const uint4*)(ZA + (size_t)(m0 + r) * 2048 + 1024 + cb + ch * 8), g);
      const float4 h0 = *(const float4*)(xcF + r * XC_LD + ch * 8), h1 = *(const float4*)(xcF + r * XC_LD + ch * 8 + 4);
      float v[8] = {h0.x * gelu_tanh(g[0]), h0.y * gelu_tanh(g[1]), h0.z * gelu_tanh(g[2]), h0.w * gelu_tanh(g[3]),
                    h1.x * gelu_tanh(g[4]), h1.y * gelu_tanh(g[5]), h1.z * gelu_tanh(g[6]), h1.w * gelu_tanh(g[7])};
      *(uint4*)(LO + (size_t)(m0 + r) * 1024 + cb + ch * 8) = pack8(v);
    }
  }
}

template <int NW>
__device__ __forceinline__ void g3_tile(KParams& p, char* smem, int mt, int n0) {
  const int tid = opaque_tid();
  float* Cs = (float*)smem;
  const u16* LO = (const u16*)(p.ws + W_LO);
  const u16* ATT = (const u16*)(p.ws + W_XN);
  const u16* WL = (const u16*)(p.ws + W_WTLRU);
  const u16* WA = (const u16*)(p.ws + W_WTATTN);
  const u16* ZC = (const u16*)p.out;
  u16* MG = (u16*)(p.ws + W_ZA);
  constexpr int TPR = NW / 8;
  constexpr int RPI = 256 / TPR;
  const int cc = (tid % TPR) * 8;
#pragma unroll
  for (int pass = 0; pass < 2; pass++) {
    f32x4 acc[4][NW / 32];
    zero_acc(acc);
    gemm_tile<NW>((pass ? ATT : LO) + (size_t)mt * 128 * 1024, 1024, (pass ? WA : WL) + (size_t)n0 * 1024, 1024, 1024, acc,
                  smem, tid);
    __syncthreads();
    acc_to_cs(acc, Cs, tid);
    __syncthreads();
#pragma unroll
    for (int i = 0; i < 128 / RPI; i++) {
      const int r = (tid / TPR) + RPI * i;
      const size_t row = (size_t)(mt * 128 + r);
      float4 a = *(const float4*)(Cs + r * CS_LD + cc), b = *(const float4*)(Cs + r * CS_LD + cc + 4);
      float v[8] = {a.x, a.y, a.z, a.w, b.x, b.y, b.z, b.w};
      float g[8];
      unpack8(*(const uint4*)(ZC + row * 2048 + pass * 1024 + n0 + cc), g);
      u16* mp = MG + row * 1024 + n0 + cc;
      if (pass == 0) {
#pragma unroll
        for (int q = 0; q < 8; q++) v[q] *= sigmoidf_(g[q]);
      } else {
        float pv[8];
        unpack8(*(const uint4*)mp, pv);
#pragma unroll
        for (int q = 0; q < 8; q++) v[q] = pv[q] + v[q] * sigmoidf_(g[q]);
      }
      *(uint4*)mp = pack8(v);
    }
    __syncthreads();
  }
}

__device__ __forceinline__ void phase_g3(KParams& p, char* smem, int vb) {
  for (int it = blockIdx.x; it < 1024 + 128; it += gridDim.x) {
    int mt, nt;
    if (it < 1024) {
      tile_map(it, MT * 8, 8, mt, nt, vb);
      g3_tile<128>(p, smem, mt, nt * 128);
    } else {
      tile_map(1024 + ((it - 1024) >> 1), MT * 8, 8, mt, nt, vb);
      g3_tile<64>(p, smem, mt, nt * 128 + ((it - 1024) & 1) * 64);
    }
  }
}

template <int NW>
__device__ __forceinline__ void g4_tile(KParams& p, char* smem, int mt, int n0) {
  const int tid = opaque_tid();
  float* Cs = (float*)smem;
  const u16* MG = (const u16*)(p.ws + W_ZA);
  const u16* WO = (const u16*)(p.ws + W_WTOUT);
  u16* HG = (u16*)(p.ws + W_ZB);
  float* SSQ = (float*)(p.ws + W_SSQ);
  constexpr int TPR = NW / 8;
  constexpr int RPI = 256 / TPR;
  f32x4 acc[4][NW / 32];
  zero_acc(acc);
  gemm_tile<NW>(MG + (size_t)mt * 128 * 1024, 1024, WO + (size_t)n0 * 1024, 1024, 1024, acc, smem, tid);
  __syncthreads();
  acc_to_cs(acc, Cs, tid);
  __syncthreads();
  const int cc = (tid % TPR) * 8;
  const float4 g0 = *(const float4*)(p.norm2_g + n0 + cc), g1 = *(const float4*)(p.norm2_g + n0 + cc + 4);
#pragma unroll
  for (int i = 0; i < 128 / RPI; i++) {
    const int r = (tid / TPR) + RPI * i;
    const int row = mt * 128 + r;
    float4 a = *(const float4*)(Cs + r * CS_LD + cc), b = *(const float4*)(Cs + r * CS_LD + cc + 4);
    const float* xr = xrow(p, row) + n0 + cc;
    float4 x0 = *(const float4*)xr, x1 = *(const float4*)(xr + 4);
    a.x += x0.x; a.y += x0.y; a.z += x0.z; a.w += x0.w;
    b.x += x1.x; b.y += x1.y; b.z += x1.z; b.w += x1.w;
    float* ho = p.out + O_Y + (size_t)row * 1024 + n0 + cc;
    *(float4*)ho = a;
    *(float4*)(ho + 4) = b;
    float v[8] = {a.x * g0.x, a.y * g0.y, a.z * g0.z, a.w * g0.w, b.x * g1.x, b.y * g1.y, b.z * g1.z, b.w * g1.w};
    *(uint4*)(HG + (size_t)row * 1024 + n0 + cc) = pack8(v);
    float ss = a.x * a.x + a.y * a.y + a.z * a.z + a.w * a.w + b.x * b.x + b.y * b.y + b.z * b.z + b.w * b.w;
    ss += __shfl_xor(ss, 1);
    ss += __shfl_xor(ss, 2);
    ss += __shfl_xor(ss, 4);
    if ((tid & 7) == 0) SSQ[(size_t)row * 16 + ((n0 + cc) >> 6)] = ss;
  }
  __syncthreads();
}

__device__ __forceinline__ void phase_g4(KParams& p, char* smem, int vb) {
  for (int it = blockIdx.x; it < 1024 + 128; it += gridDim.x) {
    int mt, nt;
    if (it < 1024) {
      tile_map(it, MT * 8, 8, mt, nt, vb);
      g4_tile<128>(p, smem, mt, nt * 128);
    } else {
      tile_map(1024 + ((it - 1024) >> 1), MT * 8, 8, mt, nt, vb);
      g4_tile<64>(p, smem, mt, nt * 128 + ((it - 1024) & 1) * 64);
    }
  }
}

__device__ __forceinline__ float row_rstd(const float* SSQ, int row) {
  const float4 a = *(const float4*)(SSQ + (size_t)row * 16), b = *(const float4*)(SSQ + (size_t)row * 16 + 4),
               c = *(const float4*)(SSQ + (size_t)row * 16 + 8), d = *(const float4*)(SSQ + (size_t)row * 16 + 12);
  const float ss = (((a.x + a.y) + (a.z + a.w)) + ((b.x + b.y) + (b.z + b.w))) +
                   (((c.x + c.y) + (c.z + c.w)) + ((d.x + d.y) + (d.z + d.w)));
  return rsqrtf(ss * (1.f / 1024.f) + EPS);
}

template <int NW>
__device__ __forceinline__ void g5_tile(KParams& p, char* smem, int mt, int n0) {
  const int tid = opaque_tid();
  float* Cs = (float*)smem;
  const u16* HG = (const u16*)(p.ws + W_ZB);
  const u16* WQ = (const u16*)(p.ws + W_WTQ);
  const float* SSQ = (const float*)(p.ws + W_SSQ);
  u16* QR = (u16*)(p.ws + W_ZA);
  constexpr int TPR = NW / 8;
  constexpr int RPI = 256 / TPR;
  f32x4 acc[4][NW / 32];
  zero_acc(acc);
  gemm_tile<NW>(HG + (size_t)mt * 128 * 1024, 1024, WQ + (size_t)n0 * 1024, 1024, 1024, acc, smem, tid);
  __syncthreads();
  acc_to_cs(acc, Cs, tid);
  __syncthreads();
  const int cc = (tid % TPR) * 8;
#pragma unroll
  for (int i = 0; i < 128 / RPI; i++) {
    const int r = (tid / TPR) + RPI * i;
    const int row = mt * 128 + r;
    const float rs = row_rstd(SSQ, row);
    float4 a = *(const float4*)(Cs + r * CS_LD + cc), b = *(const float4*)(Cs + r * CS_LD + cc + 4);
    float v[8] = {a.x * rs, a.y * rs, a.z * rs, a.w * rs, b.x * rs, b.y * rs, b.z * rs, b.w * rs};
    *(uint4*)(QR + (size_t)row * 2048 + n0 + cc) = pack8(v);
  }
  __syncthreads();
}

__device__ __forceinline__ void phase_g5(KParams& p, char* smem, int vb) {
  for (int it = blockIdx.x; it < 2048 + 256; it += gridDim.x) {
    int mt, nt;
    if (it < 2048) {
      tile_map(it, MT * 16, 16, mt, nt, vb);
      g5_tile<128>(p, smem, mt, nt * 128);
    } else {
      tile_map(2048 + ((it - 2048) >> 1), MT * 16, 16, mt, nt, vb);
      g5_tile<64>(p, smem, mt, nt * 128 + ((it - 2048) & 1) * 64);
    }
  }
}

__device__ __forceinline__ void phase_g6(KParams& p, char* smem, int vb) {
  const int tid = opaque_tid();
  u16* As = (u16*)smem;
  u16* Bs = As + 2 * 128 * LDT;
  float* Cs = (float*)smem;
  uint32_t* Cu = (uint32_t*)smem;
  uint32_t* TK0 = (uint32_t*)(smem + 128 * CS_LD * 4);
  const u16* QR = (const u16*)(p.ws + W_ZA);
  const u16* SK = (const u16*)(p.ws + W_SK);
  int* IDX = (int*)(p.ws + W_XN);
  float* GW = (float*)(p.ws + W_XN + (size_t)NTOK * 128 * 4);
  const int row = tid >> 1, half = tid & 1;
  for (int t = blockIdx.x; t < MT * 8; t += gridDim.x) {
    int mt, h;
    tile_map(t, MT * 8, 8, mt, h, vb);
    uint32_t tk[16];
    for (int pp = 0; pp < 2; pp++) {
      f32x4 acc[4][4];
      zero_acc(acc);
      gemm_tile<128>(QR + (size_t)mt * 128 * 2048 + h * 256 + pp * 128, 2048, SK + (size_t)(h * 2 + pp) * 16384, 128, 128, acc,
                smem, tid);
      __syncthreads();
      acc_to_cs(acc, Cs, tid);
      __syncthreads();
#pragma unroll
      for (int g = 0; g < 4; g++) {
        uint32_t sg[16];
#pragma unroll
        for (int q4 = 0; q4 < 4; q4++) {
          const int col = half * 64 + g * 16 + q4 * 4;
          const float4 v = *(const float4*)(Cs + row * CS_LD + col);
          sg[q4 * 4 + 0] = (ordf(v.x) & ~0x7Fu) | (uint32_t)(127 - col);
          sg[q4 * 4 + 1] = (ordf(v.y) & ~0x7Fu) | (uint32_t)(126 - col);
          sg[q4 * 4 + 2] = (ordf(v.z) & ~0x7Fu) | (uint32_t)(125 - col);
          sg[q4 * 4 + 3] = (ordf(v.w) & ~0x7Fu) | (uint32_t)(124 - col);
        }
        sort16_desc(sg);
        if (g == 0) {
#pragma unroll
          for (int q = 0; q < 16; q++) tk[q] = sg[q];
        } else {
          merge16_desc(tk, sg);
        }
      }
      __syncthreads();
      if (half == 1) {
#pragma unroll
        for (int q = 0; q < 16; q++) Cu[row * 16 + q] = tk[q];
      }
      __syncthreads();
      if (half == 0) {
        {
          uint32_t sg[16];
#pragma unroll
          for (int q4 = 0; q4 < 4; q4++) {
            const uint4 u = *(const uint4*)(Cu + row * 16 + q4 * 4);
            sg[q4 * 4] = u.x; sg[q4 * 4 + 1] = u.y; sg[q4 * 4 + 2] = u.z; sg[q4 * 4 + 3] = u.w;
          }
          merge16_desc(tk, sg);
        }
        if (pp == 0) {
#pragma unroll
          for (int q = 0; q < 16; q++) TK0[row * 16 + q] = tk[q];
        } else {
#pragma unroll
          for (int q = 0; q < 16; q++) Cu[2048 + row * 16 + q] = tk[q];
        }
      }
      __syncthreads();
    }
    if (half == 0) {
      float va[16], vb[16];
#pragma unroll
      for (int q = 0; q < 16; q++) {
        va[q] = unordf(TK0[row * 16 + q] & ~0x7Fu);
        vb[q] = unordf(tk[q] & ~0x7Fu);
      }
      uint32_t cd[16];
#pragma unroll
      for (int q = 0; q < 16; q++) cd[q] = (ordf(va[0] + vb[q]) & ~0xFFu) | (uint32_t)(255 - q);
#pragma unroll
      for (int i = 1; i < 16; i++) {
#pragma unroll
        for (int j = 0; j < 16; j++) {
          if ((i + 1) * (j + 1) <= 16) {
            const float sv = va[i] + vb[j];
            const uint32_t key = (ordf(sv) & ~0xFFu) | (uint32_t)(255 - (i * 16 + j));
            INS16(cd, key);
          }
        }
      }
      float ev[16];
      const float m0v = unordf(cd[0] & ~0xFFu);
      float esum = 0.f;
#pragma unroll
      for (int q = 0; q < 16; q++) {
        ev[q] = __expf(unordf(cd[q] & ~0xFFu) - m0v);
        esum += ev[q];
      }
      const float inv = 1.f / esum;
      const size_t ob = (size_t)(mt * 128 + row) * 128 + h * 16;
#pragma unroll
      for (int q = 0; q < 16; q++) {
        const int ij = 255 - (int)(cd[q] & 0xFFu);
        const int i0 = 127 - (int)(TK0[row * 16 + (ij >> 4)] & 0x7Fu);
        const int i1 = 127 - (int)(Cu[2048 + row * 16 + (ij & 15)] & 0x7Fu);
        IDX[ob + q] = i0 * 128 + i1;
        GW[ob + q] = ev[q] * inv;
      }
    }
    __syncthreads();
  }
}

typedef __attribute__((ext_vector_type(2))) float f32x2;
__device__ __forceinline__ void dec16(uint4 u, float* v) {
  f32x2 t;
  t = __builtin_amdgcn_cvt_pk_f32_fp8((int)u.x, false); v[0] = t.x; v[1] = t.y;
  t = __builtin_amdgcn_cvt_pk_f32_fp8((int)u.x, true); v[2] = t.x; v[3] = t.y;
  t = __builtin_amdgcn_cvt_pk_f32_fp8((int)u.y, false); v[4] = t.x; v[5] = t.y;
  t = __builtin_amdgcn_cvt_pk_f32_fp8((int)u.y, true); v[6] = t.x; v[7] = t.y;
  t = __builtin_amdgcn_cvt_pk_f32_fp8((int)u.z, false); v[8] = t.x; v[9] = t.y;
  t = __builtin_amdgcn_cvt_pk_f32_fp8((int)u.z, true); v[10] = t.x; v[11] = t.y;
  t = __builtin_amdgcn_cvt_pk_f32_fp8((int)u.w, false); v[12] = t.x; v[13] = t.y;
  t = __builtin_amdgcn_cvt_pk_f32_fp8((int)u.w, true); v[14] = t.x; v[15] = t.y;
}

__device__ __forceinline__ void phase7(KParams& p) {
  const int tid = opaque_tid(), lane = tid & 63, w = tid >> 6;
  const u16* HG = (const u16*)(p.ws + W_ZB);
  const float* SSQ = (const float*)(p.ws + W_SSQ);
  const int* IDX = (const int*)(p.ws + W_XN);
  const float* GW = (const float*)(p.ws + W_XN + (size_t)NTOK * 128 * 4);
  const unsigned char* EU = (const unsigned char*)(p.ws + W_EU);
  const unsigned char* EV = (const unsigned char*)(p.ws + W_EV);
  const float* ESC = (const float*)(p.ws + W_ESC);
  const int b0 = lane & 1, b1 = (lane >> 1) & 1, b2 = (lane >> 2) & 1;
  const int nwv = gridDim.x * 4;
  int tok = blockIdx.x * 4 + w;
  uint4 nh0 = make_uint4(0u, 0u, 0u, 0u), nh1 = nh0;
  float nrs = 0.f, ngwA = 0.f, ngwB = 0.f;
  int niA = 0, niB = 0;
  if (tok < NTOK) {
    const uint4* hp = (const uint4*)(HG + (size_t)tok * 1024 + lane * 16);
    nh0 = hp[0]; nh1 = hp[1];
    nrs = row_rstd(SSQ, tok);
    niA = IDX[(size_t)tok * 128 + lane]; niB = IDX[(size_t)tok * 128 + 64 + lane];
    ngwA = GW[(size_t)tok * 128 + lane]; ngwB = GW[(size_t)tok * 128 + 64 + lane];
  }
#pragma unroll 1
  for (; tok < NTOK; tok += nwv) {
    const float rs = nrs;
    const int iA = niA, iB = niB;
    const float gwA = ngwA, gwB = ngwB;
    float xh[16];
    unpack8(nh0, xh);
    unpack8(nh1, xh + 8);
#pragma unroll
    for (int i = 0; i < 16; i++) xh[i] *= rs;
    {
      const int nt2 = tok + nwv;
      if (nt2 < NTOK) {
        const uint4* hp = (const uint4*)(HG + (size_t)nt2 * 1024 + lane * 16);
        nh0 = hp[0]; nh1 = hp[1];
        nrs = row_rstd(SSQ, nt2);
        niA = IDX[(size_t)nt2 * 128 + lane]; niB = IDX[(size_t)nt2 * 128 + 64 + lane];
        ngwA = GW[(size_t)nt2 * 128 + lane]; ngwB = GW[(size_t)nt2 * 128 + 64 + lane];
      }
    }
    const float gA = gwA * ESC[16384 + iA], gB = gwB * ESC[16384 + iB];
    const float suA = ESC[iA], suB = ESC[iB];
    float dA = 0.f, dB = 0.f;
#pragma unroll 2
    for (int bb = 0; bb < 16; bb++) {
      const int isrc = bb < 8 ? iA : iB;
      float d[8];
      uint4 ur[8];
#pragma unroll
      for (int k = 0; k < 8; k++) {
        const int id = __builtin_amdgcn_readlane(isrc, (bb & 7) * 8 + k);
        ur[k] = *(const uint4*)(EU + (size_t)id * 1024 + lane * 16);
      }
#pragma unroll
      for (int k = 0; k < 8; k++) {
        float uv[16];
        dec16(ur[k], uv);
        float sacc = 0.f;
#pragma unroll
        for (int i = 0; i < 16; i++) sacc += xh[i] * uv[i];
        d[k] = sacc;
      }
      float e4[4], e2[2], e1;
#pragma unroll
      for (int i = 0; i < 4; i++) {
        const float keep = b0 ? d[2 * i + 1] : d[2 * i];
        const float send = b0 ? d[2 * i] : d[2 * i + 1];
        e4[i] = keep + __shfl_xor(send, 1);
      }
#pragma unroll
      for (int i = 0; i < 2; i++) {
        const float keep = b1 ? e4[2 * i + 1] : e4[2 * i];
        const float send = b1 ? e4[2 * i] : e4[2 * i + 1];
        e2[i] = keep + __shfl_xor(send, 2);
      }
      {
        const float keep = b2 ? e2[1] : e2[0];
        const float send = b2 ? e2[0] : e2[1];
        e1 = keep + __shfl_xor(send, 4);
      }
      e1 += __shfl_xor(e1, 8);
      e1 += __shfl_xor(e1, 16);
      e1 += __shfl_xor(e1, 32);
      const bool mine = (lane >> 3) == (bb & 7);
      if (bb < 8) dA = mine ? e1 : dA; else dB = mine ? e1 : dB;
    }
    const float actA = gelu_tanh(dA * suA) * gA, actB = gelu_tanh(dB * suB) * gB;
    float* ACT = (float*)(p.ws + W_ACT);
    __hip_atomic_store(&ACT[(size_t)tok * 128 + lane], actA, __ATOMIC_RELAXED, __HIP_MEMORY_SCOPE_AGENT);
    __hip_atomic_store(&ACT[(size_t)tok * 128 + 64 + lane], actB, __ATOMIC_RELAXED, __HIP_MEMORY_SCOPE_AGENT);
    asm volatile("s_waitcnt vmcnt(0)" ::: "memory");
    if (lane == 0) __hip_atomic_fetch_add((unsigned*)(p.ws + W_CNT) + (tok >> 3), 1u, __ATOMIC_RELAXED, __HIP_MEMORY_SCOPE_AGENT);
  }
}

__device__ __forceinline__ void phase7b(KParams& p) {
  const int tid = opaque_tid(), lane = tid & 63;
  const char* IDXb = (const char*)(p.ws + W_XN);
  const char* ACTb = (const char*)(p.ws + W_ACT);
  const char* EVb = (const char*)(p.ws + W_EV);
  char* Yb = (char*)(p.out + O_Y);
  unsigned* Q = (unsigned*)(p.ws + W_Q);
  const int esub = lane >> 3, c = lane & 7;
  const int pref = (int)(hw_xcc_id() & 7u);
  const int b3 = (lane >> 3) & 1, b4 = (lane >> 4) & 1, b5 = (lane >> 5) & 1;
  const uint32_t lane4 = (uint32_t)lane * 4u;
  const uint32_t yl = (uint32_t)(c * 16 + b3 * 8 + b4 * 4 + b5 * 2) * 4u;
  for (int k = 0; k < 8; k++) {
    const int sl = (pref + k) & 7;
    const char* Vs = EVb + (size_t)sl * (16384 * 128);
    const uint32_t vl = (uint32_t)c * 16u;
    for (;;) {
      unsigned it = 0;
      if (lane == 0) it = atomicAdd(Q + sl * 64, 1u);
      it = (unsigned)__builtin_amdgcn_readfirstlane((int)it);
      if (it >= (unsigned)(NTOK / 8)) break;
      const int tok0 = (int)it * 8;
      {
        unsigned* cp = (unsigned*)(p.ws + W_CNT) + it;
        unsigned spins = 0;
        while ((unsigned)__builtin_amdgcn_readfirstlane((int)__hip_atomic_load(cp, __ATOMIC_RELAXED, __HIP_MEMORY_SCOPE_AGENT)) < 8u) {
          __builtin_amdgcn_s_sleep(2);
          if (++spins > (1u << 20)) break;
        }
      }
      const char* ib = IDXb + (size_t)tok0 * 512;
      const char* ab = ACTb + (size_t)tok0 * 512;
      char* yb = Yb + (size_t)tok0 * 4096 + sl * 512;
      int nidA = *(const int*)(ib + lane4), nidB = *(const int*)(ib + 256 + lane4);
      float nacA = __hip_atomic_load((const float*)(ab + lane4), __ATOMIC_RELAXED, __HIP_MEMORY_SCOPE_AGENT), nacB = __hip_atomic_load((const float*)(ab + 256 + lane4), __ATOMIC_RELAXED, __HIP_MEMORY_SCOPE_AGENT);
      float2 nyv = *(const float2*)(yb + yl);
#pragma unroll 1
      for (int t = 0; t < 8; t++) {
        const int idA = nidA, idB = nidB;
        const float acA = nacA, acB = nacB;
        const float2 yv = nyv;
        char* ybt = yb;
        if (t < 7) {
          ib += 512; ab += 512; yb += 4096;
          nidA = *(const int*)(ib + lane4); nidB = *(const int*)(ib + 256 + lane4);
          nacA = __hip_atomic_load((const float*)(ab + lane4), __ATOMIC_RELAXED, __HIP_MEMORY_SCOPE_AGENT); nacB = __hip_atomic_load((const float*)(ab + 256 + lane4), __ATOMIC_RELAXED, __HIP_MEMORY_SCOPE_AGENT);
          nyv = *(const float2*)(yb + yl);
        }
        float o[16];
#pragma unroll
        for (int q = 0; q < 16; q++) o[q] = 0.f;
#pragma unroll
        for (int hf = 0; hf < 2; hf++) {
          uint4 vr[8];
#pragma unroll
          for (int i = 0; i < 8; i++) {
            const uint32_t id = (uint32_t)__shfl(hf ? idB : idA, i * 8 + esub);
            vr[i] = *(const uint4*)(Vs + (id * 128u + vl));
          }
#pragma unroll
          for (int i = 0; i < 8; i++) {
            float vv[16];
            dec16(vr[i], vv);
            const float a = __shfl(hf ? acB : acA, i * 8 + esub);
#pragma unroll
            for (int q = 0; q < 16; q++) o[q] += a * vv[q];
          }
        }
        float r8[8], r4[4], r2[2];
#pragma unroll
        for (int q = 0; q < 8; q++) {
          const float keep = b3 ? o[q + 8] : o[q];
          const float send = b3 ? o[q] : o[q + 8];
          r8[q] = keep + __shfl_xor(send, 8);
        }
#pragma unroll
        for (int q = 0; q < 4; q++) {
          const float keep = b4 ? r8[q + 4] : r8[q];
          const float send = b4 ? r8[q] : r8[q + 4];
          r4[q] = keep + __shfl_xor(send, 16);
        }
#pragma unroll
        for (int q = 0; q < 2; q++) {
          const float keep = b5 ? r4[q + 2] : r4[q];
          const float send = b5 ? r4[q] : r4[q + 2];
          r2[q] = keep + __shfl_xor(send, 32);
        }
        float2 h = yv;
        h.x += r2[0];
        h.y += r2[1];
        *(float2*)(ybt + yl) = h;
      }
    }
  }
}

#define XB_TMO      128
#define XB_XCNT(j)  (256  + 64 * (j))
#define XB_XSUB(j)  (1280 + 64 * (j))
#define XB_XGEN(j)  (2304 + 64 * (j))
#define XB_TOP      3328
#define XB_TOPGEN   3392
#define XCD_BAR_WORDS 3456
#define XB_SPIN_CAP (1u << 18)
#define LAS __attribute__((address_space(3)))
__device__ __forceinline__ unsigned xb_ld(unsigned* p) { return __hip_atomic_load(p, __ATOMIC_RELAXED, __HIP_MEMORY_SCOPE_AGENT); }
__device__ __forceinline__ unsigned xb_add(unsigned* p, unsigned v) { return __hip_atomic_fetch_add(p, v, __ATOMIC_RELAXED, __HIP_MEMORY_SCOPE_AGENT); }
__device__ __forceinline__ unsigned xb_xcc_id() { return (unsigned)__builtin_amdgcn_s_getreg((3 << 11) | 20) & 0xFu; }
#define XB_SPIN(cond, bar) do { unsigned _sp = 0; while (cond) { __builtin_amdgcn_s_sleep(1); \
    if ((++_sp & 255u) == 0u) { if (xb_ld(&(bar)[XB_TMO])) break; if (_sp > XB_SPIN_CAP) { atomicAdd(&(bar)[XB_TMO], 1u); break; } } } } while (0)
struct XcdBarrier { unsigned* bar; unsigned x; volatile LAS unsigned* st; };
__device__ __forceinline__ XcdBarrier xcd_barrier_post(unsigned* bar, volatile LAS unsigned* st) {
  XcdBarrier b; b.bar = bar; b.x = xb_xcc_id(); b.st = st;
  if (threadIdx.x == 0) st[2] = xb_add(&bar[XB_XCNT(b.x)], 1u);
  return b;
}
__device__ __forceinline__ void xcd_barrier_complete(unsigned* bar, unsigned x, unsigned& nloc, unsigned& nx) {
  const unsigned G = gridDim.x * gridDim.y * gridDim.z;
  unsigned sum, cnt, mine, sp = 0u;
  for (;;) {
    sum = 0u; cnt = 0u; mine = 0u;
#pragma unroll
    for (unsigned j = 0; j < 16; ++j) { const unsigned c = xb_ld(&bar[XB_XCNT(j)]); sum += c; cnt += (c > 0u) ? 1u : 0u; mine = (j == x) ? c : mine; }
    if (sum == G) break;
    __builtin_amdgcn_s_sleep(1);
    if ((++sp & 255u) == 0u) { if (xb_ld(&bar[XB_TMO])) break; if (sp > XB_SPIN_CAP) { atomicAdd(&bar[XB_TMO], 1u); break; } }
  }
  nloc = mine > 0u ? mine : 1u; nx = cnt > 0u ? cnt : 1u;
}
__device__ __forceinline__ void xcd_barrier(const XcdBarrier& b) {
  asm volatile("s_waitcnt vmcnt(0)" ::: "memory");
  __syncthreads();
  if (threadIdx.x == 0) {
    unsigned* bar = b.bar;
    __builtin_amdgcn_s_waitcnt(0);
    unsigned nloc = b.st[0], nx = b.st[1];
    if (nloc == 0u) { xcd_barrier_complete(bar, b.x, nloc, nx); b.st[0] = nloc; b.st[1] = nx; }
    const unsigned old = xb_add(&bar[XB_XSUB(b.x)], 1u);
    const unsigned gen = old / nloc;
    if (old + 1u == (gen + 1u) * nloc) {
      __builtin_amdgcn_fence(__ATOMIC_RELEASE, "agent");
      asm volatile("s_waitcnt vmcnt(0)" ::: "memory");
      const unsigned og = xb_add(&bar[XB_TOP], 1u);
      const unsigned tg = og / nx;
      if (og + 1u == (tg + 1u) * nx) xb_add(&bar[XB_TOPGEN], 1u);
      else XB_SPIN(xb_ld(&bar[XB_TOPGEN]) == tg, bar);
      __builtin_amdgcn_fence(__ATOMIC_ACQUIRE, "agent");
      xb_add(&bar[XB_XGEN(b.x)], 1u);
      asm volatile("s_waitcnt vmcnt(0)" ::: "memory");
    } else {
      XB_SPIN(xb_ld(&bar[XB_XGEN(b.x)]) == gen, bar);
      __builtin_amdgcn_fence(__ATOMIC_ACQUIRE, "agent");
      asm volatile("s_waitcnt vmcnt(0)" ::: "memory");
    }
  }
  __syncthreads();
}

#ifndef REP_MASK
#define REP_MASK 0
#endif
#define REPS(k) for (int _rep = 0; _rep < (((REP_MASK) >> (k)) & 1) + 1; _rep++)
__global__ void __launch_bounds__(256, 2) fwd_megakernel(Params p_) {
  extern __shared__ __attribute__((aligned(16))) char smem[];
  cg::grid_group grid = cg::this_grid();
  if (p_.ws == nullptr) grid.sync();
  volatile LAS unsigned* xst = (volatile LAS unsigned*)(smem + SMEM_BYTES - 16);
  if (threadIdx.x == 0) { xst[0] = 0u; xst[1] = 0u; xst[2] = 0u; xst[3] = 0u; }
  __syncthreads();
  const XcdBarrier xb = xcd_barrier_post((unsigned*)(p_.ws + W_BAR), xst);
  REPS(0) { phase0(*fresh_params(), smem); xcd_barrier(xb); }
  if (threadIdx.x == 0) {
    unsigned* bar = (unsigned*)(p_.ws + W_BAR);
    const unsigned per = gridDim.x >> 3;
    bool uni = (gridDim.x & 7u) == 0u;
    for (unsigned j = 0; j < 16; ++j) { const unsigned cnt = xb_ld(&bar[XB_XCNT(j)]); if (cnt != (j < 8 ? per : 0u)) uni = false; }
    xst[3] = uni ? (xb.x * per + xst[2]) : blockIdx.x;
  }
  __syncthreads();
  const int vb = (int)xst[3];
  REPS(1) { phase_g1(*fresh_params(), smem, vb); xcd_barrier(xb); }
  REPS(2) {
    for (int it = blockIdx.x; it < MT * 16 + 1536; it += gridDim.x) {
      if (it < MT * 16) { const int mt = it >> 4; lru_tile(*fresh_params(), smem, mt, it & 15, mt < 128 ? 2 : 1); }
      else attn_item(*fresh_params(), smem, it - MT * 16);
    }
    xcd_barrier(xb);
  }
  REPS(4) { phase_g3(*fresh_params(), smem, vb); xcd_barrier(xb); }
  REPS(5) { phase_g4(*fresh_params(), smem, vb); xcd_barrier(xb); }
  REPS(6) { phase_g5(*fresh_params(), smem, vb); xcd_barrier(xb); }
  REPS(7) { phase_g6(*fresh_params(), smem, vb); xcd_barrier(xb); }
  phase7(*fresh_params());
  phase7b(*fresh_params());
}

extern "C" void kernel_launch(void* const* d_in, const int* in_sizes, int n_in, void* d_out, int out_size, void* d_ws,
                              size_t ws_size, hipStream_t stream) {
  static int grid_blocks = 0;
  if (!grid_blocks) {
    int dev = 0, cus = 0, per_cu = 0;
    hipGetDevice(&dev);
    hipDeviceGetAttribute(&cus, hipDeviceAttributeMultiprocessorCount, dev);
    hipFuncSetAttribute((const void*)fwd_megakernel, hipFuncAttributeMaxDynamicSharedMemorySize, SMEM_BYTES);
    hipOccupancyMaxActiveBlocksPerMultiprocessor(&per_cu, fwd_megakernel, 256, SMEM_BYTES);
    if (per_cu < 1) per_cu = 1;
    grid_blocks = cus * per_cu;
  }
  Params p{};
  const float** pp = (const float**)&p;
  for (int i = 0; i < 26; i++) pp[i] = (const float*)d_in[i];
  p.out = (float*)d_out;
  p.ws = (char*)d_ws;
  (void)hipMemsetAsync((char*)d_ws + W_BAR, 0, (size_t)3456 * 4 + 8 * 256 + 2048 * 4 + 2176 * 4, stream);
  void* args[] = {&p};
  hipError_t e = hipLaunchCooperativeKernel((void*)fwd_megakernel, dim3(grid_blocks), dim3(256), args, SMEM_BYTES, stream);
  if (e != hipSuccess) fprintf(stderr, "cooperative launch failed: %s (grid %d)\n", hipGetErrorString(e), grid_blocks);
}
```

```cpp
#include <hip/hip_runtime.h>
#include <hip/hip_cooperative_groups.h>
#include <stdint.h>
#include <cstdio>
namespace cg = cooperative_groups;

typedef unsigned short u16;
typedef __attribute__((ext_vector_type(8))) short bf16x8;
typedef __attribute__((ext_vector_type(4))) float f32x4;

constexpr int D = 1024;
constexpr int NP = 16384;
constexpr int NTOK = 17408;
constexpr int SEQ = 4096;
constexpr int MT = 136;
constexpr float EPS = 1e-6f;

constexpr size_t O_Y = 0;
constexpr size_t O_CONVP = 17825792;
constexpr size_t O_LRUP = O_CONVP + 12288;
constexpr size_t O_KP = O_LRUP + 4096;
constexpr size_t O_VP = O_KP + 131072;
constexpr size_t O_CONVS = O_VP + 131072;
constexpr size_t O_LRUS = O_CONVS + 393216;
constexpr size_t O_KS = O_LRUS + 131072;
constexpr size_t O_VS = O_KS + 4194304;

constexpr size_t W_WTIN = 0;
constexpr size_t W_WTLRU = W_WTIN + (size_t)5632 * 1024 * 2;
constexpr size_t W_WTATTN = W_WTLRU + (size_t)1024 * 1024 * 2;
constexpr size_t W_WTOUT = W_WTATTN + (size_t)1024 * 1024 * 2;
constexpr size_t W_WTQ = W_WTOUT + (size_t)1024 * 1024 * 2;
constexpr size_t W_SK = W_WTQ + (size_t)2048 * 1024 * 2;
constexpr size_t W_RGA = W_SK + (size_t)16 * 128 * 128 * 2;
constexpr size_t W_RGX = W_RGA + (size_t)65536 * 2;
constexpr size_t W_EU = W_RGX + (size_t)65536 * 2;
constexpr size_t W_EV = W_EU + (size_t)16384 * 1024;
constexpr size_t W_ESC = W_EV + (size_t)16384 * 1024;
constexpr size_t W_XN = W_ESC + (size_t)32768 * 4;
constexpr size_t W_ZA = W_XN + (size_t)NTOK * 1024 * 2;
constexpr size_t W_ZB = W_ZA + (size_t)NTOK * 2048 * 2;
constexpr size_t W_AGG = W_ZB + (size_t)NTOK * 1536 * 2;
constexpr size_t W_SSQ = W_AGG + (size_t)128 * 1024 * 2 * 4;
constexpr size_t W_BAR = W_SSQ + (size_t)NTOK * 16 * 4;
constexpr size_t W_Q = W_BAR + (size_t)3456 * 4;
constexpr size_t W_FLAG = W_Q + (size_t)8 * 256;
constexpr size_t W_CNT = W_FLAG + (size_t)2048 * 4;
constexpr size_t W_ACT = W_CNT + (size_t)2176 * 4;
constexpr size_t W_LO = W_ACT + (size_t)NTOK * 128 * 4;
constexpr size_t W_END = W_LO + (size_t)NTOK * 1024 * 2;

constexpr int SMEM_BYTES = 81920;

struct Params {
  const float *x_prompt, *x_sample, *cache_conv, *state_lru, *cache_k, *cache_v, *norm1_g, *w_in, *conv_w,
      *conv_b, *rg_w_a, *rg_b_a, *rg_w_x, *rg_b_x, *rg_lambda, *q_norm_g, *k_norm_g, *attn_sinks,
      *w_branch_lru, *w_branch_attn, *w_out, *norm2_g, *peer_w_query, *peer_sub_keys, *expert_u, *expert_v;
  float* out;
  char* ws;
};

typedef const __attribute__((address_space(4))) Params KParams;
__device__ __forceinline__ KParams* fresh_params() {
  unsigned long long k = (unsigned long long)__builtin_amdgcn_kernarg_segment_ptr();
  asm volatile("" : "+s"(k));
  return (KParams*)k;
}
__device__ __forceinline__ u16 f2bf(float f) {
  uint32_t u = __float_as_uint(f);
  u += 0x7FFFu + ((u >> 16) & 1u);
  return (u16)(u >> 16);
}
__device__ __forceinline__ float bf2f(u16 h) { return __uint_as_float(((uint32_t)h) << 16); }
__device__ __forceinline__ uint32_t pack2(float a, float b) {
  uint32_t r;
  asm("v_cvt_pk_bf16_f32 %0, %1, %2" : "=v"(r) : "v"(a), "v"(b));
  return r;
}
__device__ __forceinline__ uint4 pack8(const float* v) {
  uint4 o;
  o.x = pack2(v[0], v[1]); o.y = pack2(v[2], v[3]); o.z = pack2(v[4], v[5]); o.w = pack2(v[6], v[7]);
  return o;
}
__device__ __forceinline__ void unpack8(uint4 u, float* v) {
  v[0] = __uint_as_float(u.x << 16); v[1] = __uint_as_float(u.x & 0xFFFF0000u);
  v[2] = __uint_as_float(u.y << 16); v[3] = __uint_as_float(u.y & 0xFFFF0000u);
  v[4] = __uint_as_float(u.z << 16); v[5] = __uint_as_float(u.z & 0xFFFF0000u);
  v[6] = __uint_as_float(u.w << 16); v[7] = __uint_as_float(u.w & 0xFFFF0000u);
}
__device__ __forceinline__ float sigmoidf_(float x) { return __builtin_amdgcn_rcpf(1.f + __expf(-x)); }
__device__ __forceinline__ float gelu_tanh(float x) {
  float y = 0.7978845608028654f * (x + 0.044715f * x * x * x);
  float t = 1.f - 2.f * __builtin_amdgcn_rcpf(__expf(2.f * y) + 1.f);
  return 0.5f * x * (1.f + t);
}
__device__ __forceinline__ uint32_t ordf(float f) {
  uint32_t u = __float_as_uint(f);
  return (u & 0x80000000u) ? ~u : (u | 0x80000000u);
}
__device__ __forceinline__ float unordf(uint32_t o) {
  uint32_t u = (o & 0x80000000u) ? (o ^ 0x80000000u) : ~o;
  return __uint_as_float(u);
}
__device__ __forceinline__ unsigned hw_xcc_id() { return (unsigned)__builtin_amdgcn_s_getreg((3 << 11) | 20) & 0xFu; }
__device__ __forceinline__ int opaque_tid() {
  int t = threadIdx.x;
  asm volatile("" : "+v"(t));
  return t;
}
__device__ __forceinline__ const float* xrow(KParams& p, int row) {
  return row < NP ? p.x_prompt + (size_t)row * D : p.x_sample + (size_t)(row - NP) * D;
}

#define INS16(T, V)                                  \
  {                                                  \
    uint32_t _v = (V);                               \
    _Pragma("unroll") for (int _q = 0; _q < 16; _q++) { \
      uint32_t _hi = max(T[_q], _v);                 \
      _v = min(T[_q], _v);                           \
      T[_q] = _hi;                                   \
    }                                                \
  }

#define CE_DESC(A_, B_) { const uint32_t _h = max(A_, B_), _l = min(A_, B_); A_ = _h; B_ = _l; }
__device__ __forceinline__ void sort16_desc(uint32_t (&t)[16]) {
#pragma unroll
  for (int k = 2; k <= 16; k <<= 1) {
#pragma unroll
    for (int j = k >> 1; j > 0; j >>= 1) {
#pragma unroll
      for (int i = 0; i < 16; i++) {
        const int l = i ^ j;
        if (l > i) {
          if ((i & k) == 0) { CE_DESC(t[i], t[l]); } else { CE_DESC(t[l], t[i]); }
        }
      }
    }
  }
}
__device__ __forceinline__ void merge16_desc(uint32_t (&T)[16], const uint32_t (&S)[16]) {
#pragma unroll
  for (int i = 0; i < 16; i++) T[i] = max(T[i], S[15 - i]);
#pragma unroll
  for (int j = 8; j > 0; j >>= 1) {
#pragma unroll
    for (int i = 0; i < 16; i++) {
      const int l = i ^ j;
      if (l > i) { CE_DESC(T[i], T[l]); }
    }
  }
}

__device__ __forceinline__ void transpose_cvt(const float* __restrict__ W, u16* __restrict__ Wt, int K, int N,
                                              size_t gtid, size_t gsz) {
  size_t total = (size_t)N * (K / 8);
  for (size_t c = gtid; c < total; c += gsz) {
    int n = (int)(c % N);
    int kg = (int)(c / N);
    float v[8];
#pragma unroll
    for (int i = 0; i < 8; i++) v[i] = W[(size_t)(kg * 8 + i) * N + n];
    *(uint4*)(Wt + (size_t)n * K + kg * 8) = pack8(v);
  }
}
__device__ __forceinline__ void plain_cvt(const float* __restrict__ S, u16* __restrict__ Dst, size_t n, size_t gtid,
                                          size_t gsz) {
  size_t total = n / 8;
  const float4* s4 = (const float4*)S;
  for (size_t c = gtid; c < total; c += gsz) {
    float4 a = s4[2 * c], b = s4[2 * c + 1];
    float v[8] = {a.x, a.y, a.z, a.w, b.x, b.y, b.z, b.w};
    *(uint4*)(Dst + c * 8) = pack8(v);
  }
}

__device__ __forceinline__ void phase0(KParams& p, char* smem) {
  const int tid = opaque_tid();
  const size_t gtid = (size_t)blockIdx.x * 256 + tid, gsz = (size_t)gridDim.x * 256;
  char* ws = p.ws;
  {
    const int lane = tid & 63;
    const int gw = (int)(gtid >> 6), nw = (int)(gsz >> 6);
    u16* XN = (u16*)(ws + W_XN);
    for (int row = gw; row < NTOK; row += nw) {
      const float4* xr = (const float4*)xrow(p, row);
      float4 v[4];
      float ss = 0.f;
#pragma unroll
      for (int i = 0; i < 4; i++) {
        v[i] = xr[lane + i * 64];
        ss += v[i].x * v[i].x + v[i].y * v[i].y + v[i].z * v[i].z + v[i].w * v[i].w;
      }
#pragma unroll
      for (int o = 32; o > 0; o >>= 1) ss += __shfl_xor(ss, o);
      float rstd = rsqrtf(ss * (1.f / 1024.f) + EPS);
      const float4* g4 = (const float4*)p.norm1_g;
#pragma unroll
      for (int i = 0; i < 4; i++) {
        float4 g = g4[lane + i * 64];
        uint2 o;
        o.x = pack2(v[i].x * rstd * g.x, v[i].y * rstd * g.y);
        o.y = pack2(v[i].z * rstd * g.z, v[i].w * rstd * g.w);
        *(uint2*)(XN + (size_t)row * D + (lane + i * 64) * 4) = o;
      }
    }
  }
  {
    float* T = (float*)smem;
    for (int tile = blockIdx.x; tile < 2688; tile += gridDim.x) {
      const float* W;
      u16* Wt;
      int N, tl;
      if (tile < 1408) { W = p.w_in; Wt = (u16*)(ws + W_WTIN); N = 5632; tl = tile; }
      else if (tile < 1664) { W = p.w_branch_lru; Wt = (u16*)(ws + W_WTLRU); N = 1024; tl = tile - 1408; }
      else if (tile < 1920) { W = p.w_branch_attn; Wt = (u16*)(ws + W_WTATTN); N = 1024; tl = tile - 1664; }
      else if (tile < 2176) { W = p.w_out; Wt = (u16*)(ws + W_WTOUT); N = 1024; tl = tile - 1920; }
      else { W = p.peer_w_query; Wt = (u16*)(ws + W_WTQ); N = 2048; tl = tile - 2176; }
      const int ntn = N >> 6;
      const int kt = tl / ntn, nt = tl - kt * ntn;
      __syncthreads();
      {
        const float* src = W + (size_t)(kt * 64 + (tid >> 2)) * N + nt * 64 + (tid & 3) * 16;
        const float4 a0 = *(const float4*)src, a1 = *(const float4*)(src + 4), a2 = *(const float4*)(src + 8),
                     a3 = *(const float4*)(src + 12);
        float* d = T + (tid >> 2) * 65 + (tid & 3) * 16;
        d[0] = a0.x; d[1] = a0.y; d[2] = a0.z; d[3] = a0.w; d[4] = a1.x; d[5] = a1.y; d[6] = a1.z; d[7] = a1.w;
        d[8] = a2.x; d[9] = a2.y; d[10] = a2.z; d[11] = a2.w; d[12] = a3.x; d[13] = a3.y; d[14] = a3.z; d[15] = a3.w;
      }
      __syncthreads();
      {
        const int n = tid >> 2, kc = (tid & 3) * 16;
        float v[16];
#pragma unroll
        for (int i = 0; i < 16; i++) v[i] = T[(kc + i) * 65 + n];
        u16* dst = Wt + (size_t)(nt * 64 + n) * 1024 + kt * 64 + kc;
        *(uint4*)dst = pack8(v);
        *(uint4*)(dst + 8) = pack8(v + 8);
      }
    }
  }
  {
    u16* RA = (u16*)(ws + W_RGA);
    u16* RX = (u16*)(ws + W_RGX);
    for (size_t e = gtid; e < 65536; e += gsz) {
      int n = (int)(e >> 12), k = (int)((e >> 6) & 63), j = (int)(e & 63);
      RA[e] = f2bf(p.rg_w_a[n * 4096 + j * 64 + k]);
      RX[e] = f2bf(p.rg_w_x[n * 4096 + j * 64 + k]);
    }
  }
  plain_cvt(p.peer_sub_keys, (u16*)(ws + W_SK), (size_t)16 * 128 * 128, gtid, gsz);
  {
    const int lane = tid & 63;
    const int gw = (int)(gtid >> 6), nw = (int)(gsz >> 6);
    unsigned char* E8 = (unsigned char*)(ws + W_EU);
    float* ESC = (float*)(ws + W_ESC);
    for (int r = gw; r < 32768; r += nw) {
      const float* src = (r < 16384 ? p.expert_u : p.expert_v) + (size_t)(r & 16383) * 1024 + lane * 16;
      const float4 a0 = *(const float4*)src, a1 = *(const float4*)(src + 4), a2 = *(const float4*)(src + 8),
                   a3 = *(const float4*)(src + 12);
      float am = fmaxf(fmaxf(fmaxf(fabsf(a0.x), fabsf(a0.y)), fmaxf(fabsf(a0.z), fabsf(a0.w))),
                       fmaxf(fmaxf(fabsf(a1.x), fabsf(a1.y)), fmaxf(fabsf(a1.z), fabsf(a1.w))));
      am = fmaxf(am, fmaxf(fmaxf(fmaxf(fabsf(a2.x), fabsf(a2.y)), fmaxf(fabsf(a2.z), fabsf(a2.w))),
                           fmaxf(fmaxf(fabsf(a3.x), fabsf(a3.y)), fmaxf(fabsf(a3.z), fabsf(a3.w)))));
#pragma unroll
      for (int o = 32; o > 0; o >>= 1) am = fmaxf(am, __shfl_xor(am, o));
      const float sc = am > 0.f ? 224.f / am : 1.f;
      uint4 o4;
      int wv;
      wv = __builtin_amdgcn_cvt_pk_fp8_f32(a0.x * sc, a0.y * sc, 0, false);
      wv = __builtin_amdgcn_cvt_pk_fp8_f32(a0.z * sc, a0.w * sc, wv, true);
      o4.x = (uint32_t)wv;
      wv = __builtin_amdgcn_cvt_pk_fp8_f32(a1.x * sc, a1.y * sc, 0, false);
      wv = __builtin_amdgcn_cvt_pk_fp8_f32(a1.z * sc, a1.w * sc, wv, true);
      o4.y = (uint32_t)wv;
      wv = __builtin_amdgcn_cvt_pk_fp8_f32(a2.x * sc, a2.y * sc, 0, false);
      wv = __builtin_amdgcn_cvt_pk_fp8_f32(a2.z * sc, a2.w * sc, wv, true);
      o4.z = (uint32_t)wv;
      wv = __builtin_amdgcn_cvt_pk_fp8_f32(a3.x * sc, a3.y * sc, 0, false);
      wv = __builtin_amdgcn_cvt_pk_fp8_f32(a3.z * sc, a3.w * sc, wv, true);
      o4.w = (uint32_t)wv;
      if (r < 16384) *(uint4*)(E8 + (size_t)r * 1024 + lane * 16) = o4;
      else *(uint4*)(E8 + (size_t)16384 * 1024 + (size_t)(lane >> 3) * (16384 * 128) + (size_t)(r - 16384) * 128 + (lane & 7) * 16) = o4;
      if (lane == 0) ESC[r] = am > 0.f ? am * (1.f / 224.f) : 1.f;
    }
  }
}

constexpr int LDT = 72;
constexpr int CS_LD = 132;

template <int NW>
__device__ __forceinline__ void gemm_tile(const u16* __restrict__ A, int lda, const u16* __restrict__ Bt, int ldb,
                                          int K, f32x4 (&acc)[4][NW / 32], char* smem, int tid) {
  constexpr int NJ = NW / 32;
  const int lane = tid & 63, w = tid >> 6;
  const int wm = w >> 1, wn = w & 1;
  const int l15 = lane & 15, quad = lane >> 4;
  const int lr = w * 8 + (lane >> 3);
  const int lc = ((lane & 7) ^ ((lane >> 3) & 7)) * 8;
  const char* Ab = (const char*)A;
  const char* Bb = (const char*)Bt;
  const uint32_t ao = (uint32_t)(lr * lda + lc) * 2u, bo = (uint32_t)(lr * ldb + lc) * 2u;
  const uint32_t sa2 = 64u * (uint32_t)lda, sb2 = 64u * (uint32_t)ldb;
  const uint32_t kmask = (uint32_t)K - 1u, kst = (((uint32_t)blockIdx.x >> 3) * 64u) & kmask;
  char* lw = smem + w * 1024 + lane * 16;
  const int swz = l15 & 7;
  const char* Ar = smem + (wm * 64 + l15) * 128 + ((quad ^ swz) * 16);
  const char* Br = smem + 16384 + (wn * (NW / 2) + l15) * 128 + ((quad ^ swz) * 16);
  const char* Ar1 = smem + (wm * 64 + l15) * 128 + (((4 + quad) ^ swz) * 16);
  const char* Br1 = smem + 16384 + (wn * (NW / 2) + l15) * 128 + (((4 + quad) ^ swz) * 16);
#define GT_ISSUE(st, off)                                                                                   \
  {                                                                                                         \
    const uint32_t _o = (((uint32_t)(off) + kst) & kmask) * 2u;                                             \
    char* _l = lw + (st) * 32768;                                                                           \
    _Pragma("unroll") for (int j = 0; j < 4; j++) {                                                         \
      __builtin_amdgcn_global_load_lds((const unsigned*)(Ab + (size_t)(ao + j * sa2 + _o)), (unsigned*)(_l + j * 4096), 16, 0, 0);          \
      if (j < NJ) __builtin_amdgcn_global_load_lds((const unsigned*)(Bb + (size_t)(bo + j * sb2 + _o)), (unsigned*)(_l + 16384 + j * 4096), 16, 0, 0);  \
    }                                                                                                       \
  }
#define GT_MMA(st)                                                                                          \
  {                                                                                                         \
    const char* _ar = Ar + (st) * 32768; const char* _br = Br + (st) * 32768;                               \
    const char* _ar1 = Ar1 + (st) * 32768; const char* _br1 = Br1 + (st) * 32768;                           \
    bf16x8 a0[4], b0[NJ], a1[4], b1[NJ];                                                                      \
    _Pragma("unroll") for (int i = 0; i < 4; i++) {                                                         \
      a0[i] = *(const bf16x8*)(_ar + i * 2048);                                                             \
      if (i < NJ) b0[i] = *(const bf16x8*)(_br + i * 2048);                                                 \
    }                                                                                                       \
    _Pragma("unroll") for (int i = 0; i < 4; i++) {                                                         \
      a1[i] = *(const bf16x8*)(_ar1 + i * 2048);                                                            \
      if (i < NJ) b1[i] = *(const bf16x8*)(_br1 + i * 2048);                                                \
    }                                                                                                       \
    __builtin_amdgcn_s_setprio(1);                                                                          \
    _Pragma("unroll") for (int i = 0; i < 4; i++)                                                           \
      _Pragma("unroll") for (int j = 0; j < NJ; j++)                                                        \
        acc[i][j] = __builtin_amdgcn_mfma_f32_16x16x32_bf16(a0[i], b0[j], acc[i][j], 0, 0, 0);              \
    _Pragma("unroll") for (int i = 0; i < 4; i++)                                                           \
      _Pragma("unroll") for (int j = 0; j < NJ; j++)                                                        \
        acc[i][j] = __builtin_amdgcn_mfma_f32_16x16x32_bf16(a1[i], b1[j], acc[i][j], 0, 0, 0);              \
    __builtin_amdgcn_s_setprio(0);                                                                          \
  }
  __syncthreads();
  GT_ISSUE(0, 0);
  for (int k0 = 0; k0 < K; k0 += 128) {
    asm volatile("s_waitcnt vmcnt(0) lgkmcnt(0)" ::: "memory");
    __builtin_amdgcn_s_barrier();
    asm volatile("" ::: "memory");
    GT_ISSUE(1, k0 + 64);
    GT_MMA(0);
    asm volatile("s_waitcnt vmcnt(0) lgkmcnt(0)" ::: "memory");
    __builtin_amdgcn_s_barrier();
    asm volatile("" ::: "memory");
    if (k0 + 128 < K) GT_ISSUE(0, k0 + 128);
    GT_MMA(1);
  }
#undef GT_ISSUE
#undef GT_MMA
}

__device__ __forceinline__ void tile_map(int it, int total, int NT, int& mt, int& nt, int vb) {
  const int G = gridDim.x;
  int T = it;
  {
    const int round = it / G;
    if (round * G + G <= total) T = round * G + vb;
  }
  const int g = T / (8 * NT), r = T - g * (8 * NT);
  nt = r >> 3;
  mt = g * 8 + (r & 7);
}

template <int NJ>
__device__ __forceinline__ void zero_acc(f32x4 (&acc)[4][NJ]) {
#pragma unroll
  for (int i = 0; i < 4; i++)
#pragma unroll
    for (int j = 0; j < NJ; j++) acc[i][j] = (f32x4){0.f, 0.f, 0.f, 0.f};
}

template <int NJ>
__device__ __forceinline__ void acc_to_cs(const f32x4 (&acc)[4][NJ], float* Cs, int tid) {
  const int lane = tid & 63, w = tid >> 6;
  const int wm = w >> 1, wn = w & 1;
  const int l15 = lane & 15, quad = lane >> 4;
#pragma unroll
  for (int i = 0; i < 4; i++)
#pragma unroll
    for (int j = 0; j < NJ; j++)
#pragma unroll
      for (int e = 0; e < 4; e++)
        Cs[(wm * 64 + i * 16 + quad * 4 + e) * CS_LD + wn * (NJ * 16) + j * 16 + l15] = acc[i][j][e];
}

__device__ __forceinline__ void phase_g1(KParams& p, char* smem, int vb) {
  const int tid = opaque_tid();
  u16* As = (u16*)smem;
  u16* Bs = As + 2 * 128 * LDT;
  float* Cs = (float*)smem;
  const u16* XN = (const u16*)(p.ws + W_XN);
  const u16* WT = (const u16*)(p.ws + W_WTIN);
  for (int t = blockIdx.x; t < MT * 44; t += gridDim.x) {
    int mt, nt;
    tile_map(t, MT * 44, 44, mt, nt, vb);
    f32x4 acc[4][4];
    zero_acc(acc);
    gemm_tile<128>(XN + (size_t)mt * 128 * 1024, 1024, WT + (size_t)nt * 128 * 1024, 1024, 1024, acc, smem, tid);
    __syncthreads();
    acc_to_cs(acc, Cs, tid);
    __syncthreads();
    const int n0 = nt * 128;
    u16* dst;
    int ldd, col;
    if (n0 < 2048) { dst = (u16*)(p.ws + W_ZA); ldd = 2048; col = n0; }
    else if (n0 < 3584) { dst = (u16*)(p.ws + W_ZB); ldd = 1536; col = n0 - 2048; }
    else { dst = (u16*)p.out; ldd = 2048; col = n0 - 3584; }
    const int cc = (tid & 15) * 8;
#pragma unroll
    for (int i = 0; i < 8; i++) {
      const int r = (tid >> 4) + 16 * i;
      float4 a = *(const float4*)(Cs + r * CS_LD + cc), b = *(const float4*)(Cs + r * CS_LD + cc + 4);
      float v[8] = {a.x, a.y, a.z, a.w, b.x, b.y, b.z, b.w};
      *(uint4*)(dst + (size_t)(mt * 128 + r) * ldd + col + cc) = pack8(v);
    }
    __syncthreads();
  }
}

constexpr int KS_LD = 72, VT_LD = 200, PS_LD = 168;
__device__ __forceinline__ void attn_item(KParams& p, char* smem, int item) {
  const int tid = opaque_tid(), lane = tid & 63, w = tid >> 6, l15 = lane & 15, quad = lane >> 4;
  u16* Ks = (u16*)smem;
  u16* Vt = Ks + 192 * KS_LD;
  u16* Ps = Vt + 64 * VT_LD + w * 16 * PS_LD;
  const u16* ZB = (const u16*)(p.ws + W_ZB);
  u16* ATT = (u16*)(p.ws + W_XN);
  const bool sample = item >= 1024;
  int b, qb = 0, kv, rowbase, p0 = 0;
  if (!sample) {
    kv = item & 3; qb = (item >> 2) & 63; b = item >> 8;
    p0 = qb * 64;
    rowbase = b * SEQ + p0;
  } else {
    int it = item - 1024;
    kv = it & 3; b = it >> 2;
    rowbase = NP + b * 8;
  }
  __syncthreads();
  {
    const int ch = tid & 7;
    float kg[8];
#pragma unroll
    for (int i = 0; i < 8; i++) kg[i] = p.k_norm_g[ch * 8 + i];
    const int nrows = sample ? 160 : 192;
    for (int c = tid; c < nrows * 8; c += 256) {
      const int row = c >> 3;
      float kf[8], vf[8];
      bool valid, donorm;
      if (!sample) {
        const int pos = p0 - 128 + row;
        valid = pos >= 0;
        donorm = true;
        if (valid) {
          const u16* src = ZB + (size_t)(b * SEQ + pos) * 1536 + 1024 + kv * 64 + ch * 8;
          unpack8(*(const uint4*)src, kf);
          unpack8(*(const uint4*)(src + 256), vf);
        }
      } else {
        valid = row < 136;
        donorm = row >= 128;
        if (row < 128) {
          const float* sk = p.cache_k + ((size_t)(b * 128 + row) * 4 + kv) * 64 + ch * 8;
          const float* sv = p.cache_v + ((size_t)(b * 128 + row) * 4 + kv) * 64 + ch * 8;
          float4 a0 = *(const float4*)sk, a1 = *(const float4*)(sk + 4);
          float4 b0 = *(const float4*)sv, b1 = *(const float4*)(sv + 4);
          kf[0] = a0.x; kf[1] = a0.y; kf[2] = a0.z; kf[3] = a0.w; kf[4] = a1.x; kf[5] = a1.y; kf[6] = a1.z; kf[7] = a1.w;
          vf[0] = b0.x; vf[1] = b0.y; vf[2] = b0.z; vf[3] = b0.w; vf[4] = b1.x; vf[5] = b1.y; vf[6] = b1.z; vf[7] = b1.w;
        } else if (valid) {
          const u16* src = ZB + (size_t)(NP + b * 8 + (row - 128)) * 1536 + 1024 + kv * 64 + ch * 8;
          unpack8(*(const uint4*)src, kf);
          unpack8(*(const uint4*)(src + 256), vf);
        }
      }
      if (!valid) {
#pragma unroll
        for (int i = 0; i < 8; i++) { kf[i] = 0.f; vf[i] = 0.f; }
      }
      float ss = 0.f;
#pragma unroll
      for (int i = 0; i < 8; i++) ss += kf[i] * kf[i];
      ss += __shfl_xor(ss, 1);
      ss += __shfl_xor(ss, 2);
      ss += __shfl_xor(ss, 4);
      if (donorm) {
        const float rstd = rsqrtf(ss * (1.f / 64.f) + EPS);
#pragma unroll
        for (int i = 0; i < 8; i++) kf[i] = kf[i] * rstd * kg[i];
      }
      *(uint4*)(Ks + row * KS_LD + ch * 8) = pack8(kf);
#pragma unroll
      for (int i = 0; i < 8; i++) Vt[(ch * 8 + i) * VT_LD + row] = f2bf(vf[i]);
      if (!sample) {
        if (qb >= 62 && row >= 128) {
          const int wpos = p0 + (row - 128) - (SEQ - 128);
          float* ko = p.out + O_KP + ((size_t)(b * 128 + wpos) * 4 + kv) * 64 + ch * 8;
          float* vo = p.out + O_VP + ((size_t)(b * 128 + wpos) * 4 + kv) * 64 + ch * 8;
          *(float4*)ko = make_float4(kf[0], kf[1], kf[2], kf[3]);
          *(float4*)(ko + 4) = make_float4(kf[4], kf[5], kf[6], kf[7]);
          *(float4*)vo = make_float4(vf[0], vf[1], vf[2], vf[3]);
          *(float4*)(vo + 4) = make_float4(vf[4], vf[5], vf[6], vf[7]);
        }
      } else {
        if (row >= 8 && row < 136) {
          float* ko = p.out + O_KS + ((size_t)(b * 128 + (row - 8)) * 4 + kv) * 64 + ch * 8;
          float* vo = p.out + O_VS + ((size_t)(b * 128 + (row - 8)) * 4 + kv) * 64 + ch * 8;
          *(float4*)ko = make_float4(kf[0], kf[1], kf[2], kf[3]);
          *(float4*)(ko + 4) = make_float4(kf[4], kf[5], kf[6], kf[7]);
          *(float4*)vo = make_float4(vf[0], vf[1], vf[2], vf[3]);
          *(float4*)(vo + 4) = make_float4(vf[4], vf[5], vf[6], vf[7]);
        }
      }
    }
  }
  __syncthreads();
  const int hq = kv * 4 + w;
  const float slope = exp2f(-0.5f * (float)(hq + 1));
  const float sink = p.attn_sinks[hq];
  float qg[2][8];
#pragma unroll
  for (int ks = 0; ks < 2; ks++)
#pragma unroll
    for (int i = 0; i < 8; i++) qg[ks][i] = p.q_norm_g[ks * 32 + quad * 8 + i] * 0.125f;
  const int nsub = sample ? 1 : 4;
  for (int sb = 0; sb < nsub; sb++) {
    const int r0 = sb * 16;
    const int ws0 = r0 < 32 ? r0 : 32;
    bf16x8 qa[2];
    {
      const int qr = sample ? (l15 & 7) : (r0 + l15);
      const u16* src = ZB + (size_t)(rowbase + qr) * 1536 + hq * 64 + quad * 8;
      float q0[8], q1[8];
      unpack8(*(const uint4*)src, q0);
      unpack8(*(const uint4*)(src + 32), q1);
      float ss = 0.f;
#pragma unroll
      for (int i = 0; i < 8; i++) ss += q0[i] * q0[i] + q1[i] * q1[i];
      ss += __shfl_xor(ss, 16);
      ss += __shfl_xor(ss, 32);
      const float rstd = rsqrtf(ss * (1.f / 64.f) + EPS);
#pragma unroll
      for (int i = 0; i < 8; i++) { q0[i] *= rstd * qg[0][i]; q1[i] *= rstd * qg[1][i]; }
      uint4 u0 = pack8(q0), u1 = pack8(q1);
      qa[0] = __builtin_bit_cast(bf16x8, u0);
      qa[1] = __builtin_bit_cast(bf16x8, u1);
    }
    f32x4 s[10];
#pragma unroll
    for (int kt = 0; kt < 10; kt++) {
      const u16* kp = Ks + (ws0 + kt * 16 + l15) * KS_LD + quad * 8;
      bf16x8 b0 = *(const bf16x8*)kp, b1 = *(const bf16x8*)(kp + 32);
      f32x4 z = {0.f, 0.f, 0.f, 0.f};
      z = __builtin_amdgcn_mfma_f32_16x16x32_bf16(qa[0], b0, z, 0, 0, 0);
      s[kt] = __builtin_amdgcn_mfma_f32_16x16x32_bf16(qa[1], b1, z, 0, 0, 0);
    }
    float mx[4] = {-1e30f, -1e30f, -1e30f, -1e30f};
#pragma unroll
    for (int kt = 0; kt < 10; kt++) {
      const int jj = ws0 + kt * 16 + l15;
      const bool posok = sample ? (jj < 136) : (p0 - 128 + jj >= 0);
#pragma unroll
      for (int e = 0; e < 4; e++) {
        const int r = r0 + quad * 4 + e;
        const int dist = r + 128 - jj;
        const bool ok = posok && dist >= 0 && dist <= 128;
        float v = ok ? (s[kt][e] - slope * (float)dist) : -1e30f;
        s[kt][e] = v;
        mx[e] = fmaxf(mx[e], v);
      }
    }
    float sum[4];
#pragma unroll
    for (int e = 0; e < 4; e++) {
      float m = mx[e];
      m = fmaxf(m, __shfl_xor(m, 1));
      m = fmaxf(m, __shfl_xor(m, 2));
      m = fmaxf(m, __shfl_xor(m, 4));
      m = fmaxf(m, __shfl_xor(m, 8));
      m = fmaxf(m, sink);
      mx[e] = m;
      sum[e] = 0.f;
    }
#pragma unroll
    for (int kt = 0; kt < 10; kt++) {
#pragma unroll
      for (int e = 0; e < 4; e++) {
        float pv = __expf(s[kt][e] - mx[e]);
        sum[e] += pv;
        Ps[(quad * 4 + e) * PS_LD + kt * 16 + l15] = f2bf(pv);
      }
    }
#pragma unroll
    for (int e = 0; e < 4; e++) {
      float t = sum[e];
      t += __shfl_xor(t, 1);
      t += __shfl_xor(t, 2);
      t += __shfl_xor(t, 4);
      t += __shfl_xor(t, 8);
      sum[e] = 1.f / (t + __expf(sink - mx[e]));
    }
    __syncthreads();
    f32x4 o[4];
#pragma unroll
    for (int nt = 0; nt < 4; nt++) o[nt] = (f32x4){0.f, 0.f, 0.f, 0.f};
#pragma unroll
    for (int kk = 0; kk < 5; kk++) {
      bf16x8 pa = *(const bf16x8*)(Ps + l15 * PS_LD + kk * 32 + quad * 8);
#pragma unroll
      for (int nt = 0; nt < 4; nt++) {
        bf16x8 vb = *(const bf16x8*)(Vt + (nt * 16 + l15) * VT_LD + ws0 + kk * 32 + quad * 8);
        o[nt] = __builtin_amdgcn_mfma_f32_16x16x32_bf16(pa, vb, o[nt], 0, 0, 0);
      }
    }
#pragma unroll
    for (int e = 0; e < 4; e++) {
      const int r = quad * 4 + e;
      if (!sample || r < 8) {
        u16* dst = ATT + (size_t)(rowbase + r0 + r) * 1024 + hq * 64 + l15;
#pragma unroll
        for (int nt = 0; nt < 4; nt++) dst[nt * 16] = f2bf(o[nt][e] * sum[e]);
      }
    }
    __syncthreads();
  }
}

constexpr int XC_LD = 68;
__device__ __forceinline__ void lru_tile(KParams& p, char* smem, int mt, int nb, int mode) {
  const int tid = opaque_tid(), lane = tid & 63, w = tid >> 6, l15 = lane & 15, quad = lane >> 4;
  float* xcF = (float*)smem;
  float* aL = xcF + 128 * XC_LD;
  float* aggL = aL + 128 * XC_LD;
  const u16* ZA = (const u16*)(p.ws + W_ZA);
  const bool sample = mt >= 128;
  const int m0 = mt * 128;
  const int cb = nb * 64;
  __syncthreads();
  {
    const int ch = tid & 7;
    float cw[4][8], cbias[8];
#pragma unroll
    for (int j = 0; j < 4; j++)
#pragma unroll
      for (int i = 0; i < 8; i++) cw[j][i] = p.conv_w[j * 1024 + cb + ch * 8 + i];
#pragma unroll
    for (int i = 0; i < 8; i++) cbias[i] = p.conv_b[cb + ch * 8 + i];
#pragma unroll
    for (int it = 0; it < 4; it++) {
      const int r = (tid >> 3) + it * 32;
      const int grow = m0 + r;
      const int t = sample ? (r & 7) : ((mt & 31) * 128 + r);
      float y[8];
#pragma unroll
      for (int i = 0; i < 8; i++) y[i] = cbias[i];
#pragma unroll
      for (int d = 0; d < 4; d++) {
        float xv[8];
        if (t - d >= 0) {
          unpack8(*(const uint4*)(ZA + (size_t)(grow - d) * 2048 + cb + ch * 8), xv);
        } else if (sample) {
          const int bb = (m0 - NP + r) >> 3;
          const float* src = p.cache_conv + ((size_t)bb * 3 + (3 + t - d)) * 1024 + cb + ch * 8;
          float4 a = *(const float4*)src, b4 = *(const float4*)(src + 4);
          xv[0] = a.x; xv[1] = a.y; xv[2] = a.z; xv[3] = a.w; xv[4] = b4.x; xv[5] = b4.y; xv[6] = b4.z; xv[7] = b4.w;
        } else {
#pragma unroll
          for (int i = 0; i < 8; i++) xv[i] = 0.f;
        }
#pragma unroll
        for (int i = 0; i < 8; i++) y[i] += cw[3 - d][i] * xv[i];
        if (d == 0 && mode != 0) {
          if (!sample) {
            if ((mt & 31) == 31 && r >= 125) {
              float* dst = p.out + O_CONVP + ((size_t)(mt >> 5) * 3 + (r - 125)) * 1024 + cb + ch * 8;
              *(float4*)dst = make_float4(xv[0], xv[1], xv[2], xv[3]);
              *(float4*)(dst + 4) = make_float4(xv[4], xv[5], xv[6], xv[7]);
            }
          } else if (t >= 5) {
            const int bb = (m0 - NP + r) >> 3;
            float* dst = p.out + O_CONVS + ((size_t)bb * 3 + (t - 5)) * 1024 + cb + ch * 8;
            *(float4*)dst = make_float4(xv[0], xv[1], xv[2], xv[3]);
            *(float4*)(dst + 4) = make_float4(xv[4], xv[5], xv[6], xv[7]);
          }
        }
      }
      *(float4*)(xcF + r * XC_LD + ch * 8) = make_float4(y[0], y[1], y[2], y[3]);
      *(float4*)(xcF + r * XC_LD + ch * 8 + 4) = make_float4(y[4], y[5], y[6], y[7]);
    }
  }
  __syncthreads();
  {
    const u16* RA = (const u16*)(p.ws + W_RGA) + nb * 4096;
    const u16* RX = (const u16*)(p.ws + W_RGX) + nb * 4096;
    f32x4 aR[2][4], aI[2][4];
#pragma unroll
    for (int i = 0; i < 2; i++)
#pragma unroll
      for (int j = 0; j < 4; j++) { aR[i][j] = (f32x4){0.f, 0.f, 0.f, 0.f}; aI[i][j] = (f32x4){0.f, 0.f, 0.f, 0.f}; }
#pragma unroll
    for (int ks = 0; ks < 2; ks++) {
      bf16x8 a[2];
#pragma unroll
      for (int i = 0; i < 2; i++) {
        const float* src = xcF + (w * 32 + i * 16 + l15) * XC_LD + ks * 32 + quad * 8;
        float4 x0 = *(const float4*)src, x1 = *(const float4*)(src + 4);
        float v[8] = {x0.x, x0.y, x0.z, x0.w, x1.x, x1.y, x1.z, x1.w};
        uint4 u = pack8(v);
        a[i] = __builtin_bit_cast(bf16x8, u);
      }
#pragma unroll
      for (int j = 0; j < 4; j++) {
        bf16x8 ba = *(const bf16x8*)(RA + (j * 16 + l15) * 64 + ks * 32 + quad * 8);
        bf16x8 bx = *(const bf16x8*)(RX + (j * 16 + l15) * 64 + ks * 32 + quad * 8);
#pragma unroll
        for (int i = 0; i < 2; i++) {
          aR[i][j] = __builtin_amdgcn_mfma_f32_16x16x32_bf16(a[i], ba, aR[i][j], 0, 0, 0);
          aI[i][j] = __builtin_amdgcn_mfma_f32_16x16x32_bf16(a[i], bx, aI[i][j], 0, 0, 0);
        }
      }
    }
#pragma unroll
    for (int j = 0; j < 4; j++) {
      const int c = cb + j * 16 + l15;
      const float ba = p.rg_b_a[c], bx = p.rg_b_x[c];
      const float ls = -log1pf(__expf(-p.rg_lambda[c]));
#pragma unroll
      for (int i = 0; i < 2; i++)
#pragma unroll
        for (int e = 0; e < 4; e++) {
          const int row = w * 32 + i * 16 + quad * 4 + e;
          const float rg = sigmoidf_(aR[i][j][e] + ba);
          const float ig = sigmoidf_(aI[i][j][e] + bx);
          const float la = 8.f * rg * ls;
          const float av = __expf(la);
          const float x2 = 2.f * la;
          const float emt = -x2 * (1.f + x2 * (0.5f + x2 * (0.16666667f + x2 * (0.041666668f + x2 * 0.008333334f))));
          const float em = x2 > -0.25f ? emt : 1.f - __expf(x2);
          const float mult = __builtin_amdgcn_sqrtf(fmaxf(em, 0.f));
          const int idx = row * XC_LD + j * 16 + l15;
          const float xv = xcF[idx];
          aL[idx] = av;
          xcF[idx] = mult * ig * xv;
        }
    }
  }
  __syncthreads();
  const int c = cb + lane;
  float* carL = aggL + 512;
  if (!sample) {
    float* AGGP = (float*)(p.ws + W_AGG);
    float* AGGH = AGGP + 128 * 1024;
    const int chunk = mt & 31, base = mt - chunk;
    if (mode == 1) {
      float Pq[8], Hq[8];
#pragma unroll
      for (int k = 0; k < 8; k++) {
        const int q = w * 8 + k;
        const bool ok = q < chunk;
        Pq[k] = ok ? AGGP[(base + q) * 1024 + c] : 1.f;
        Hq[k] = ok ? AGGH[(base + q) * 1024 + c] : 0.f;
      }
      float Pc = 1.f, hc = 0.f;
#pragma unroll
      for (int k = 0; k < 8; k++) { hc = Pq[k] * hc + Hq[k]; Pc *= Pq[k]; }
      carL[(w * 64 + lane) * 2] = Pc;
      carL[(w * 64 + lane) * 2 + 1] = hc;
    }
    float P = 1.f, h = 0.f;
#pragma unroll 8
    for (int rr = 0; rr < 32; rr++) {
      const float av = aL[(w * 32 + rr) * XC_LD + lane], bv = xcF[(w * 32 + rr) * XC_LD + lane];
      h = av * h + bv;
      P *= av;
    }
    aggL[(w * 64 + lane) * 2] = P;
    aggL[(w * 64 + lane) * 2 + 1] = h;
    __syncthreads();
    if (mode == 0 || mode == 2) {
      if (w == 0) {
        float Pt = 1.f, ht = 0.f;
#pragma unroll
        for (int q = 0; q < 4; q++) {
          const float Pq = aggL[(q * 64 + lane) * 2], hq = aggL[(q * 64 + lane) * 2 + 1];
          ht = Pq * ht + hq;
          Pt *= Pq;
        }
        if (mode == 0) {
          AGGP[mt * 1024 + c] = Pt;
          AGGH[mt * 1024 + c] = ht;
        } else {
          __hip_atomic_store(&AGGP[mt * 1024 + c], Pt, __ATOMIC_RELAXED, __HIP_MEMORY_SCOPE_AGENT);
          __hip_atomic_store(&AGGH[mt * 1024 + c], ht, __ATOMIC_RELAXED, __HIP_MEMORY_SCOPE_AGENT);
          asm volatile("s_waitcnt vmcnt(0)" ::: "memory");
          if (lane == 0)
            __hip_atomic_store((unsigned*)(p.ws + W_FLAG) + mt * 16 + nb, 1u, __ATOMIC_RELAXED, __HIP_MEMORY_SCOPE_AGENT);
        }
      }
    }
    if (mode == 2) {
      {
        const int q = w * 8 + (lane & 7);
        const bool need = (lane < 8) && (q < chunk);
        unsigned* fp = (unsigned*)(p.ws + W_FLAG) + (base + (need ? q : 0)) * 16 + nb;
        unsigned spins = 0;
        for (;;) {
          const unsigned f = need ? __hip_atomic_load(fp, __ATOMIC_RELAXED, __HIP_MEMORY_SCOPE_AGENT) : 1u;
          if (__ballot(f == 0u) == 0ull) break;
          __builtin_amdgcn_s_sleep(2);
          if (++spins > (1u << 20)) break;
        }
      }
      float Pq[8], Hq[8];
#pragma unroll
      for (int k = 0; k < 8; k++) {
        const int q = w * 8 + k;
        const bool ok = q < chunk;
        Pq[k] = ok ? __hip_atomic_load(&AGGP[(base + q) * 1024 + c], __ATOMIC_RELAXED, __HIP_MEMORY_SCOPE_AGENT) : 1.f;
        Hq[k] = ok ? __hip_atomic_load(&AGGH[(base + q) * 1024 + c], __ATOMIC_RELAXED, __HIP_MEMORY_SCOPE_AGENT) : 0.f;
      }
      float Pc = 1.f, hc = 0.f;
#pragma unroll
      for (int k = 0; k < 8; k++) { hc = Pq[k] * hc + Hq[k]; Pc *= Pq[k]; }
      carL[(w * 64 + lane) * 2] = Pc;
      carL[(w * 64 + lane) * 2 + 1] = hc;
      __syncthreads();
    }
    if (mode == 0) {
    } else {
      float hin = 0.f;
#pragma unroll
      for (int q = 0; q < 4; q++) hin = carL[(q * 64 + lane) * 2] * hin + carL[(q * 64 + lane) * 2 + 1];
      for (int q = 0; q < w; q++) hin = aggL[(q * 64 + lane) * 2] * hin + aggL[(q * 64 + lane) * 2 + 1];
      float hh = hin;
#pragma unroll 8
      for (int rr = 0; rr < 32; rr++) {
        const int row = w * 32 + rr;
        const float av = aL[row * XC_LD + lane], bv = xcF[row * XC_LD + lane];
        hh = av * hh + bv;
        xcF[row * XC_LD + lane] = hh;
      }
      if (chunk == 31 && w == 3) p.out[O_LRUP + (size_t)(mt >> 5) * 1024 + c] = hh;
    }
  } else {
    float hh = 0.f;
    float h0v[4];
#pragma unroll
    for (int k = 0; k < 4; k++) h0v[k] = p.state_lru[(size_t)(((m0 - NP + w * 32) >> 3) + k) * 1024 + c];
#pragma unroll
    for (int rr = 0; rr < 32; rr++) {
      const int row = w * 32 + rr;
      const int bb = (m0 - NP + row) >> 3;
      const int t = row & 7;
      if (t == 0) hh = h0v[rr >> 3];
      const float av = aL[row * XC_LD + lane], bv = xcF[row * XC_LD + lane];
      hh = av * hh + bv;
      xcF[row * XC_LD + lane] = hh;
      if (t == 7) p.out[O_LRUS + (size_t)bb * 1024 + c] = hh;
    }
  }
  if (mode != 0) {
    __syncthreads();
    u16* LO = (u16*)(p.ws + W_LO);
    const int ch = tid & 7;
#pragma unroll
    for (int it = 0; it < 4; it++) {
      const int r = (tid >> 3) + it * 32;
      float g[8];
      unpack8(*(const uint4*)(ZA + (size_t)(m0 + r) * 2048 + 1024 + cb + ch * 8), g);
      const float4 h0 = *(const float4*)(xcF + r * XC_LD + ch * 8), h1 = *(const float4*)(xcF + r * XC_LD + ch * 8 + 4);
      float v[8] = {h0.x * gelu_tanh(g[0]), h0.y * gelu_tanh(g[1]), h0.z * gelu_tanh(g[2]), h0.w * gelu_tanh(g[3]),
                    h1.x * gelu_tanh(g[4]), h1.y * gelu_tanh(g[5]), h1.z * gelu_tanh(g[6]), h1.w * gelu_tanh(g[7])};
      *(uint4*)(LO + (size_t)(m0 + r) * 1024 + cb + ch * 8) = pack8(v);
    }
  }
}

template <int NW>
__device__ __forceinline__ void g3_tile(KParams& p, char* smem, int mt, int n0) {
  const int tid = opaque_tid();
  float* Cs = (float*)smem;
  const u16* LO = (const u16*)(p.ws + W_LO);
  const u16* ATT = (const u16*)(p.ws + W_XN);
  const u16* WL = (const u16*)(p.ws + W_WTLRU);
  const u16* WA = (const u16*)(p.ws + W_WTATTN);
  const u16* ZC = (const u16*)p.out;
  u16* MG = (u16*)(p.ws + W_ZA);
  constexpr int TPR = NW / 8;
  constexpr int RPI = 256 / TPR;
  const int cc = (tid % TPR) * 8;
  uint4 part[128 / RPI];
#pragma unroll
  for (int pass = 0; pass < 2; pass++) {
    f32x4 acc[4][NW / 32];
    zero_acc(acc);
    gemm_tile<NW>((pass ? ATT : LO) + (size_t)mt * 128 * 1024, 1024, (pass ? WA : WL) + (size_t)n0 * 1024, 1024, 1024, acc,
                  smem, tid);
    __syncthreads();
    acc_to_cs(acc, Cs, tid);
    __syncthreads();
#pragma unroll
    for (int i = 0; i < 128 / RPI; i++) {
      const int r = (tid / TPR) + RPI * i;
      const size_t row = (size_t)(mt * 128 + r);
      float4 a = *(const float4*)(Cs + r * CS_LD + cc), b = *(const float4*)(Cs + r * CS_LD + cc + 4);
      float v[8] = {a.x, a.y, a.z, a.w, b.x, b.y, b.z, b.w};
      float g[8];
      unpack8(*(const uint4*)(ZC + row * 2048 + pass * 1024 + n0 + cc), g);
      u16* mp = MG + row * 1024 + n0 + cc;
      if (pass == 0) {
#pragma unroll
        for (int q = 0; q < 8; q++) v[q] *= sigmoidf_(g[q]);
        part[i] = pack8(v);
      } else {
        float pv[8];
        unpack8(part[i], pv);
#pragma unroll
        for (int q = 0; q < 8; q++) v[q] = pv[q] + v[q] * sigmoidf_(g[q]);
        *(uint4*)mp = pack8(v);
      }
    }
    __syncthreads();
  }
}

__device__ __forceinline__ void phase_g3(KParams& p, char* smem, int vb) {
  for (int it = blockIdx.x; it < 1024 + 128; it += gridDim.x) {
    int mt, nt;
    if (it < 1024) {
      tile_map(it, MT * 8, 8, mt, nt, vb);
      g3_tile<128>(p, smem, mt, nt * 128);
    } else {
      tile_map(1024 + ((it - 1024) >> 1), MT * 8, 8, mt, nt, vb);
      g3_tile<64>(p, smem, mt, nt * 128 + ((it - 1024) & 1) * 64);
    }
  }
}

template <int NW>
__device__ __forceinline__ void g4_tile(KParams& p, char* smem, int mt, int n0) {
  const int tid = opaque_tid();
  float* Cs = (float*)smem;
  const u16* MG = (const u16*)(p.ws + W_ZA);
  const u16* WO = (const u16*)(p.ws + W_WTOUT);
  u16* HG = (u16*)(p.ws + W_ZB);
  float* SSQ = (float*)(p.ws + W_SSQ);
  constexpr int TPR = NW / 8;
  constexpr int RPI = 256 / TPR;
  f32x4 acc[4][NW / 32];
  zero_acc(acc);
  gemm_tile<NW>(MG + (size_t)mt * 128 * 1024, 1024, WO + (size_t)n0 * 1024, 1024, 1024, acc, smem, tid);
  __syncthreads();
  acc_to_cs(acc, Cs, tid);
  __syncthreads();
  const int cc = (tid % TPR) * 8;
  const float4 g0 = *(const float4*)(p.norm2_g + n0 + cc), g1 = *(const float4*)(p.norm2_g + n0 + cc + 4);
#pragma unroll
  for (int i = 0; i < 128 / RPI; i++) {
    const int r = (tid / TPR) + RPI * i;
    const int row = mt * 128 + r;
    float4 a = *(const float4*)(Cs + r * CS_LD + cc), b = *(const float4*)(Cs + r * CS_LD + cc + 4);
    const float* xr = xrow(p, row) + n0 + cc;
    float4 x0 = *(const float4*)xr, x1 = *(const float4*)(xr + 4);
    a.x += x0.x; a.y += x0.y; a.z += x0.z; a.w += x0.w;
    b.x += x1.x; b.y += x1.y; b.z += x1.z; b.w += x1.w;
    float* ho = p.out + O_Y + (size_t)row * 1024 + n0 + cc;
    *(float4*)ho = a;
    *(float4*)(ho + 4) = b;
    float v[8] = {a.x * g0.x, a.y * g0.y, a.z * g0.z, a.w * g0.w, b.x * g1.x, b.y * g1.y, b.z * g1.z, b.w * g1.w};
    *(uint4*)(HG + (size_t)row * 1024 + n0 + cc) = pack8(v);
    float ss = a.x * a.x + a.y * a.y + a.z * a.z + a.w * a.w + b.x * b.x + b.y * b.y + b.z * b.z + b.w * b.w;
    ss += __shfl_xor(ss, 1);
    ss += __shfl_xor(ss, 2);
    ss += __shfl_xor(ss, 4);
    if ((tid & 7) == 0) SSQ[(size_t)row * 16 + ((n0 + cc) >> 6)] = ss;
  }
  __syncthreads();
}

__device__ __forceinline__ void phase_g4(KParams& p, char* smem, int vb) {
  for (int it = blockIdx.x; it < 1024 + 128; it += gridDim.x) {
    int mt, nt;
    if (it < 1024) {
      tile_map(it, MT * 8, 8, mt, nt, vb);
      g4_tile<128>(p, smem, mt, nt * 128);
    } else {
      tile_map(1024 + ((it - 1024) >> 1), MT * 8, 8, mt, nt, vb);
      g4_tile<64>(p, smem, mt, nt * 128 + ((it - 1024) & 1) * 64);
    }
  }
}

__device__ __forceinline__ float row_rstd(const float* SSQ, int row) {
  const float4 a = *(const float4*)(SSQ + (size_t)row * 16), b = *(const float4*)(SSQ + (size_t)row * 16 + 4),
               c = *(const float4*)(SSQ + (size_t)row * 16 + 8), d = *(const float4*)(SSQ + (size_t)row * 16 + 12);
  const float ss = (((a.x + a.y) + (a.z + a.w)) + ((b.x + b.y) + (b.z + b.w))) +
                   (((c.x + c.y) + (c.z + c.w)) + ((d.x + d.y) + (d.z + d.w)));
  return rsqrtf(ss * (1.f / 1024.f) + EPS);
}

template <int NW>
__device__ __forceinline__ void g5_tile(KParams& p, char* smem, int mt, int n0) {
  const int tid = opaque_tid();
  float* Cs = (float*)smem;
  const u16* HG = (const u16*)(p.ws + W_ZB);
  const u16* WQ = (const u16*)(p.ws + W_WTQ);
  const float* SSQ = (const float*)(p.ws + W_SSQ);
  u16* QR = (u16*)(p.ws + W_ZA);
  constexpr int TPR = NW / 8;
  constexpr int RPI = 256 / TPR;
  f32x4 acc[4][NW / 32];
  zero_acc(acc);
  gemm_tile<NW>(HG + (size_t)mt * 128 * 1024, 1024, WQ + (size_t)n0 * 1024, 1024, 1024, acc, smem, tid);
  __syncthreads();
  acc_to_cs(acc, Cs, tid);
  __syncthreads();
  const int cc = (tid % TPR) * 8;
#pragma unroll
  for (int i = 0; i < 128 / RPI; i++) {
    const int r = (tid / TPR) + RPI * i;
    const int row = mt * 128 + r;
    const float rs = row_rstd(SSQ, row);
    float4 a = *(const float4*)(Cs + r * CS_LD + cc), b = *(const float4*)(Cs + r * CS_LD + cc + 4);
    float v[8] = {a.x * rs, a.y * rs, a.z * rs, a.w * rs, b.x * rs, b.y * rs, b.z * rs, b.w * rs};
    *(uint4*)(QR + (size_t)row * 2048 + n0 + cc) = pack8(v);
  }
  __syncthreads();
}

__device__ __forceinline__ void phase_g5(KParams& p, char* smem, int vb) {
  for (int it = blockIdx.x; it < 2048 + 256; it += gridDim.x) {
    int mt, nt;
    if (it < 2048) {
      tile_map(it, MT * 16, 16, mt, nt, vb);
      g5_tile<128>(p, smem, mt, nt * 128);
    } else {
      tile_map(2048 + ((it - 2048) >> 1), MT * 16, 16, mt, nt, vb);
      g5_tile<64>(p, smem, mt, nt * 128 + ((it - 2048) & 1) * 64);
    }
  }
}

__device__ __forceinline__ void phase_g6(KParams& p, char* smem, int vb) {
  const int tid = opaque_tid();
  u16* As = (u16*)smem;
  u16* Bs = As + 2 * 128 * LDT;
  float* Cs = (float*)smem;
  uint32_t* Cu = (uint32_t*)smem;
  uint32_t* TK0 = (uint32_t*)(smem + 128 * CS_LD * 4);
  const u16* QR = (const u16*)(p.ws + W_ZA);
  const u16* SK = (const u16*)(p.ws + W_SK);
  int* IDX = (int*)(p.ws + W_XN);
  float* GW = (float*)(p.ws + W_XN + (size_t)NTOK * 128 * 4);
  const int row = tid >> 1, half = tid & 1;
  for (int t = blockIdx.x; t < MT * 8; t += gridDim.x) {
    int mt, h;
    tile_map(t, MT * 8, 8, mt, h, vb);
    uint32_t tk[16];
    for (int pp = 0; pp < 2; pp++) {
      f32x4 acc[4][4];
      zero_acc(acc);
      gemm_tile<128>(QR + (size_t)mt * 128 * 2048 + h * 256 + pp * 128, 2048, SK + (size_t)(h * 2 + pp) * 16384, 128, 128, acc,
                smem, tid);
      __syncthreads();
      acc_to_cs(acc, Cs, tid);
      __syncthreads();
#pragma unroll
      for (int g = 0; g < 4; g++) {
        uint32_t sg[16];
#pragma unroll
        for (int q4 = 0; q4 < 4; q4++) {
          const int col = half * 64 + g * 16 + q4 * 4;
          const float4 v = *(const float4*)(Cs + row * CS_LD + col);
          sg[q4 * 4 + 0] = (ordf(v.x) & ~0x7Fu) | (uint32_t)(127 - col);
          sg[q4 * 4 + 1] = (ordf(v.y) & ~0x7Fu) | (uint32_t)(126 - col);
          sg[q4 * 4 + 2] = (ordf(v.z) & ~0x7Fu) | (uint32_t)(125 - col);
          sg[q4 * 4 + 3] = (ordf(v.w) & ~0x7Fu) | (uint32_t)(124 - col);
        }
        sort16_desc(sg);
        if (g == 0) {
#pragma unroll
          for (int q = 0; q < 16; q++) tk[q] = sg[q];
        } else {
          merge16_desc(tk, sg);
        }
      }
      __syncthreads();
      if (half == 1) {
#pragma unroll
        for (int q = 0; q < 16; q++) Cu[row * 16 + q] = tk[q];
      }
      __syncthreads();
      if (half == 0) {
        {
          uint32_t sg[16];
#pragma unroll
          for (int q4 = 0; q4 < 4; q4++) {
            const uint4 u = *(const uint4*)(Cu + row * 16 + q4 * 4);
            sg[q4 * 4] = u.x; sg[q4 * 4 + 1] = u.y; sg[q4 * 4 + 2] = u.z; sg[q4 * 4 + 3] = u.w;
          }
          merge16_desc(tk, sg);
        }
        if (pp == 0) {
#pragma unroll
          for (int q = 0; q < 16; q++) TK0[row * 16 + q] = tk[q];
        } else {
#pragma unroll
          for (int q = 0; q < 16; q++) Cu[2048 + row * 16 + q] = tk[q];
        }
      }
      __syncthreads();
    }
    if (half == 0) {
      float va[16], vb[16];
#pragma unroll
      for (int q = 0; q < 16; q++) {
        va[q] = unordf(TK0[row * 16 + q] & ~0x7Fu);
        vb[q] = unordf(tk[q] & ~0x7Fu);
      }
      uint32_t cd[16];
#pragma unroll
      for (int q = 0; q < 16; q++) cd[q] = (ordf(va[0] + vb[q]) & ~0xFFu) | (uint32_t)(255 - q);
#pragma unroll
      for (int i = 1; i < 16; i++) {
#pragma unroll
        for (int j = 0; j < 16; j++) {
          if ((i + 1) * (j + 1) <= 16) {
            const float sv = va[i] + vb[j];
            const uint32_t key = (ordf(sv) & ~0xFFu) | (uint32_t)(255 - (i * 16 + j));
            INS16(cd, key);
          }
        }
      }
      float ev[16];
      const float m0v = unordf(cd[0] & ~0xFFu);
      float esum = 0.f;
#pragma unroll
      for (int q = 0; q < 16; q++) {
        ev[q] = __expf(unordf(cd[q] & ~0xFFu) - m0v);
        esum += ev[q];
      }
      const float inv = 1.f / esum;
      const size_t ob = (size_t)(mt * 128 + row) * 128 + h * 16;
#pragma unroll
      for (int q = 0; q < 16; q++) {
        const int ij = 255 - (int)(cd[q] & 0xFFu);
        const int i0 = 127 - (int)(TK0[row * 16 + (ij >> 4)] & 0x7Fu);
        const int i1 = 127 - (int)(Cu[2048 + row * 16 + (ij & 15)] & 0x7Fu);
        IDX[ob + q] = i0 * 128 + i1;
        GW[ob + q] = ev[q] * inv;
      }
    }
    __syncthreads();
  }
}

typedef __attribute__((ext_vector_type(2))) float f32x2;
__device__ __forceinline__ void dec16(uint4 u, float* v) {
  f32x2 t;
  t = __builtin_amdgcn_cvt_pk_f32_fp8((int)u.x, false); v[0] = t.x; v[1] = t.y;
  t = __builtin_amdgcn_cvt_pk_f32_fp8((int)u.x, true); v[2] = t.x; v[3] = t.y;
  t = __builtin_amdgcn_cvt_pk_f32_fp8((int)u.y, false); v[4] = t.x; v[5] = t.y;
  t = __builtin_amdgcn_cvt_pk_f32_fp8((int)u.y, true); v[6] = t.x; v[7] = t.y;
  t = __builtin_amdgcn_cvt_pk_f32_fp8((int)u.z, false); v[8] = t.x; v[9] = t.y;
  t = __builtin_amdgcn_cvt_pk_f32_fp8((int)u.z, true); v[10] = t.x; v[11] = t.y;
  t = __builtin_amdgcn_cvt_pk_f32_fp8((int)u.w, false); v[12] = t.x; v[13] = t.y;
  t = __builtin_amdgcn_cvt_pk_f32_fp8((int)u.w, true); v[14] = t.x; v[15] = t.y;
}

__device__ __forceinline__ void phase7(KParams& p) {
  const int tid = opaque_tid(), lane = tid & 63, w = tid >> 6;
  const u16* HG = (const u16*)(p.ws + W_ZB);
  const float* SSQ = (const float*)(p.ws + W_SSQ);
  const int* IDX = (const int*)(p.ws + W_XN);
  const float* GW = (const float*)(p.ws + W_XN + (size_t)NTOK * 128 * 4);
  const unsigned char* EU = (const unsigned char*)(p.ws + W_EU);
  const unsigned char* EV = (const unsigned char*)(p.ws + W_EV);
  const float* ESC = (const float*)(p.ws + W_ESC);
  const int b0 = lane & 1, b1 = (lane >> 1) & 1, b2 = (lane >> 2) & 1;
  const int nwv = gridDim.x * 4;
  int tok = blockIdx.x * 4 + w;
  uint4 nh0 = make_uint4(0u, 0u, 0u, 0u), nh1 = nh0;
  float nrs = 0.f, ngwA = 0.f, ngwB = 0.f;
  int niA = 0, niB = 0;
  if (tok < NTOK) {
    const uint4* hp = (const uint4*)(HG + (size_t)tok * 1024 + lane * 16);
    nh0 = hp[0]; nh1 = hp[1];
    nrs = row_rstd(SSQ, tok);
    niA = IDX[(size_t)tok * 128 + lane]; niB = IDX[(size_t)tok * 128 + 64 + lane];
    ngwA = GW[(size_t)tok * 128 + lane]; ngwB = GW[(size_t)tok * 128 + 64 + lane];
  }
#pragma unroll 1
  for (; tok < NTOK; tok += nwv) {
    const float rs = nrs;
    const int iA = niA, iB = niB;
    const float gwA = ngwA, gwB = ngwB;
    float xh[16];
    unpack8(nh0, xh);
    unpack8(nh1, xh + 8);
#pragma unroll
    for (int i = 0; i < 16; i++) xh[i] *= rs;
    {
      const int nt2 = tok + nwv;
      if (nt2 < NTOK) {
        const uint4* hp = (const uint4*)(HG + (size_t)nt2 * 1024 + lane * 16);
        nh0 = hp[0]; nh1 = hp[1];
        nrs = row_rstd(SSQ, nt2);
        niA = IDX[(size_t)nt2 * 128 + lane]; niB = IDX[(size_t)nt2 * 128 + 64 + lane];
        ngwA = GW[(size_t)nt2 * 128 + lane]; ngwB = GW[(size_t)nt2 * 128 + 64 + lane];
      }
    }
    const float gA = gwA * ESC[16384 + iA], gB = gwB * ESC[16384 + iB];
    const float suA = ESC[iA], suB = ESC[iB];
    float dA = 0.f, dB = 0.f;
#pragma unroll 2
    for (int bb = 0; bb < 16; bb++) {
      const int isrc = bb < 8 ? iA : iB;
      float d[8];
      uint4 ur[8];
#pragma unroll
      for (int k = 0; k < 8; k++) {
        const int id = __builtin_amdgcn_readlane(isrc, (bb & 7) * 8 + k);
        ur[k] = *(const uint4*)(EU + (size_t)id * 1024 + lane * 16);
      }
#pragma unroll
      for (int k = 0; k < 8; k++) {
        float uv[16];
        dec16(ur[k], uv);
        float sacc = 0.f;
#pragma unroll
        for (int i = 0; i < 16; i++) sacc += xh[i] * uv[i];
        d[k] = sacc;
      }
      float e4[4], e2[2], e1;
#pragma unroll
      for (int i = 0; i < 4; i++) {
        const float keep = b0 ? d[2 * i + 1] : d[2 * i];
        const float send = b0 ? d[2 * i] : d[2 * i + 1];
        e4[i] = keep + __shfl_xor(send, 1);
      }
#pragma unroll
      for (int i = 0; i < 2; i++) {
        const float keep = b1 ? e4[2 * i + 1] : e4[2 * i];
        const float send = b1 ? e4[2 * i] : e4[2 * i + 1];
        e2[i] = keep + __shfl_xor(send, 2);
      }
      {
        const float keep = b2 ? e2[1] : e2[0];
        const float send = b2 ? e2[0] : e2[1];
        e1 = keep + __shfl_xor(send, 4);
      }
      e1 += __shfl_xor(e1, 8);
      e1 += __shfl_xor(e1, 16);
      e1 += __shfl_xor(e1, 32);
      const bool mine = (lane >> 3) == (bb & 7);
      if (bb < 8) dA = mine ? e1 : dA; else dB = mine ? e1 : dB;
    }
    const float actA = gelu_tanh(dA * suA) * gA, actB = gelu_tanh(dB * suB) * gB;
    float* ACT = (float*)(p.ws + W_ACT);
    __hip_atomic_store(&ACT[(size_t)tok * 128 + lane], actA, __ATOMIC_RELAXED, __HIP_MEMORY_SCOPE_AGENT);
    __hip_atomic_store(&ACT[(size_t)tok * 128 + 64 + lane], actB, __ATOMIC_RELAXED, __HIP_MEMORY_SCOPE_AGENT);
    asm volatile("s_waitcnt vmcnt(0)" ::: "memory");
    if (lane == 0) __hip_atomic_fetch_add((unsigned*)(p.ws + W_CNT) + (tok >> 3), 1u, __ATOMIC_RELAXED, __HIP_MEMORY_SCOPE_AGENT);
  }
}

__device__ __forceinline__ void phase7b(KParams& p) {
  const int tid = opaque_tid(), lane = tid & 63;
  const char* IDXb = (const char*)(p.ws + W_XN);
  const char* ACTb = (const char*)(p.ws + W_ACT);
  const char* EVb = (const char*)(p.ws + W_EV);
  char* Yb = (char*)(p.out + O_Y);
  unsigned* Q = (unsigned*)(p.ws + W_Q);
  const int esub = lane >> 3, c = lane & 7;
  const int pref = (int)(hw_xcc_id() & 7u);
  const int b3 = (lane >> 3) & 1, b4 = (lane >> 4) & 1, b5 = (lane >> 5) & 1;
  const uint32_t lane4 = (uint32_t)lane * 4u;
  const uint32_t yl = (uint32_t)(c * 16 + b3 * 8 + b4 * 4 + b5 * 2) * 4u;
  for (int k = 0; k < 8; k++) {
    const int sl = (pref + k) & 7;
    const char* Vs = EVb + (size_t)sl * (16384 * 128);
    const uint32_t vl = (uint32_t)c * 16u;
    for (;;) {
      unsigned it = 0;
      if (lane == 0) it = atomicAdd(Q + sl * 64, 1u);
      it = (unsigned)__builtin_amdgcn_readfirstlane((int)it);
      if (it >= (unsigned)(NTOK / 8)) break;
      const int tok0 = (int)it * 8;
      {
        unsigned* cp = (unsigned*)(p.ws + W_CNT) + it;
        unsigned spins = 0;
        while ((unsigned)__builtin_amdgcn_readfirstlane((int)__hip_atomic_load(cp, __ATOMIC_RELAXED, __HIP_MEMORY_SCOPE_AGENT)) < 8u) {
          __builtin_amdgcn_s_sleep(2);
          if (++spins > (1u << 20)) break;
        }
      }
      const char* ib = IDXb + (size_t)tok0 * 512;
      const char* ab = ACTb + (size_t)tok0 * 512;
      char* yb = Yb + (size_t)tok0 * 4096 + sl * 512;
      int nidA = *(const int*)(ib + lane4), nidB = *(const int*)(ib + 256 + lane4);
      float nacA = __hip_atomic_load((const float*)(ab + lane4), __ATOMIC_RELAXED, __HIP_MEMORY_SCOPE_AGENT), nacB = __hip_atomic_load((const float*)(ab + 256 + lane4), __ATOMIC_RELAXED, __HIP_MEMORY_SCOPE_AGENT);
      float2 nyv = *(const float2*)(yb + yl);
#pragma unroll 1
      for (int t = 0; t < 8; t++) {
        const int idA = nidA, idB = nidB;
        const float acA = nacA, acB = nacB;
        const float2 yv = nyv;
        char* ybt = yb;
        if (t < 7) {
          ib += 512; ab += 512; yb += 4096;
          nidA = *(const int*)(ib + lane4); nidB = *(const int*)(ib + 256 + lane4);
          nacA = __hip_atomic_load((const float*)(ab + lane4), __ATOMIC_RELAXED, __HIP_MEMORY_SCOPE_AGENT); nacB = __hip_atomic_load((const float*)(ab + 256 + lane4), __ATOMIC_RELAXED, __HIP_MEMORY_SCOPE_AGENT);
          nyv = *(const float2*)(yb + yl);
        }
        float o[16];
#pragma unroll
        for (int q = 0; q < 16; q++) o[q] = 0.f;
#pragma unroll
        for (int hf = 0; hf < 2; hf++) {
          uint4 vr[8];
#pragma unroll
          for (int i = 0; i < 8; i++) {
            const uint32_t id = (uint32_t)__shfl(hf ? idB : idA, i * 8 + esub);
            vr[i] = *(const uint4*)(Vs + (id * 128u + vl));
          }
#pragma unroll
          for (int i = 0; i < 8; i++) {
            float vv[16];
            dec16(vr[i], vv);
            const float a = __shfl(hf ? acB : acA, i * 8 + esub);
#pragma unroll
            for (int q = 0; q < 16; q++) o[q] += a * vv[q];
          }
        }
        float r8[8], r4[4], r2[2];
#pragma unroll
        for (int q = 0; q < 8; q++) {
          const float keep = b3 ? o[q + 8] : o[q];
          const float send = b3 ? o[q] : o[q + 8];
          r8[q] = keep + __shfl_xor(send, 8);
        }
#pragma unroll
        for (int q = 0; q < 4; q++) {
          const float keep = b4 ? r8[q + 4] : r8[q];
          const float send = b4 ? r8[q] : r8[q + 4];
          r4[q] = keep + __shfl_xor(send, 16);
        }
#pragma unroll
        for (int q = 0; q < 2; q++) {
          const float keep = b5 ? r4[q + 2] : r4[q];
          const float send = b5 ? r4[q] : r4[q + 2];
          r2[q] = keep + __shfl_xor(send, 32);
        }
        float2 h = yv;
        h.x += r2[0];
        h.y += r2[1];
        *(float2*)(ybt + yl) = h;
      }
    }
  }
}

#define XB_TMO      128
#define XB_XCNT(j)  (256  + 64 * (j))
#define XB_XSUB(j)  (1280 + 64 * (j))
#define XB_XGEN(j)  (2304 + 64 * (j))
#define XB_TOP      3328
#define XB_TOPGEN   3392
#define XCD_BAR_WORDS 3456
#define XB_SPIN_CAP (1u << 18)
#define LAS __attribute__((address_space(3)))
__device__ __forceinline__ unsigned xb_ld(unsigned* p) { return __hip_atomic_load(p, __ATOMIC_RELAXED, __HIP_MEMORY_SCOPE_AGENT); }
__device__ __forceinline__ unsigned xb_add(unsigned* p, unsigned v) { return __hip_atomic_fetch_add(p, v, __ATOMIC_RELAXED, __HIP_MEMORY_SCOPE_AGENT); }
__device__ __forceinline__ unsigned xb_xcc_id() { return (unsigned)__builtin_amdgcn_s_getreg((3 << 11) | 20) & 0xFu; }
#define XB_SPIN(cond, bar) do { unsigned _sp = 0; while (cond) { __builtin_amdgcn_s_sleep(1); \
    if ((++_sp & 255u) == 0u) { if (xb_ld(&(bar)[XB_TMO])) break; if (_sp > XB_SPIN_CAP) { atomicAdd(&(bar)[XB_TMO], 1u); break; } } } } while (0)
struct XcdBarrier { unsigned* bar; unsigned x; volatile LAS unsigned* st; };
__device__ __forceinline__ XcdBarrier xcd_barrier_post(unsigned* bar, volatile LAS unsigned* st) {
  XcdBarrier b; b.bar = bar; b.x = xb_xcc_id(); b.st = st;
  if (threadIdx.x == 0) st[2] = xb_add(&bar[XB_XCNT(b.x)], 1u);
  return b;
}
__device__ __forceinline__ void xcd_barrier_complete(unsigned* bar, unsigned x, unsigned& nloc, unsigned& nx) {
  const unsigned G = gridDim.x * gridDim.y * gridDim.z;
  unsigned sum, cnt, mine, sp = 0u;
  for (;;) {
    sum = 0u; cnt = 0u; mine = 0u;
#pragma unroll
    for (unsigned j = 0; j < 16; ++j) { const unsigned c = xb_ld(&bar[XB_XCNT(j)]); sum += c; cnt += (c > 0u) ? 1u : 0u; mine = (j == x) ? c : mine; }
    if (sum == G) break;
    __builtin_amdgcn_s_sleep(1);
    if ((++sp & 255u) == 0u) { if (xb_ld(&bar[XB_TMO])) break; if (sp > XB_SPIN_CAP) { atomicAdd(&bar[XB_TMO], 1u); break; } }
  }
  nloc = mine > 0u ? mine : 1u; nx = cnt > 0u ? cnt : 1u;
}
__device__ __forceinline__ void xcd_barrier(const XcdBarrier& b) {
  asm volatile("s_waitcnt vmcnt(0)" ::: "memory");
  __syncthreads();
  if (threadIdx.x == 0) {
    unsigned* bar = b.bar;
    __builtin_amdgcn_s_waitcnt(0);
    unsigned nloc = b.st[0], nx = b.st[1];
    if (nloc == 0u) { xcd_barrier_complete(bar, b.x, nloc, nx); b.st[0] = nloc; b.st[1] = nx; }
    const unsigned old = xb_add(&bar[XB_XSUB(b.x)], 1u);
    const unsigned gen = old / nloc;
    if (old + 1u == (gen + 1u) * nloc) {
      __builtin_amdgcn_fence(__ATOMIC_RELEASE, "agent");
      asm volatile("s_waitcnt vmcnt(0)" ::: "memory");
      const unsigned og = xb_add(&bar[XB_TOP], 1u);
      const unsigned tg = og / nx;
      if (og + 1u == (tg + 1u) * nx) xb_add(&bar[XB_TOPGEN], 1u);
      else XB_SPIN(xb_ld(&bar[XB_TOPGEN]) == tg, bar);
      __builtin_amdgcn_fence(__ATOMIC_ACQUIRE, "agent");
      xb_add(&bar[XB_XGEN(b.x)], 1u);
      asm volatile("s_waitcnt vmcnt(0)" ::: "memory");
    } else {
      XB_SPIN(xb_ld(&bar[XB_XGEN(b.x)]) == gen, bar);
      __builtin_amdgcn_fence(__ATOMIC_ACQUIRE, "agent");
      asm volatile("s_waitcnt vmcnt(0)" ::: "memory");
    }
  }
  __syncthreads();
}

#ifndef REP_MASK
#define REP_MASK 0
#endif
#define REPS(k) for (int _rep = 0; _rep < (((REP_MASK) >> (k)) & 1) + 1; _rep++)
__global__ void __launch_bounds__(256, 2) fwd_megakernel(Params p_) {
  extern __shared__ __attribute__((aligned(16))) char smem[];
  cg::grid_group grid = cg::this_grid();
  if (p_.ws == nullptr) grid.sync();
  volatile LAS unsigned* xst = (volatile LAS unsigned*)(smem + SMEM_BYTES - 16);
  if (threadIdx.x == 0) { xst[0] = 0u; xst[1] = 0u; xst[2] = 0u; xst[3] = 0u; }
  __syncthreads();
  const XcdBarrier xb = xcd_barrier_post((unsigned*)(p_.ws + W_BAR), xst);
  REPS(0) { phase0(*fresh_params(), smem); xcd_barrier(xb); }
  if (threadIdx.x == 0) {
    unsigned* bar = (unsigned*)(p_.ws + W_BAR);
    const unsigned per = gridDim.x >> 3;
    bool uni = (gridDim.x & 7u) == 0u;
    for (unsigned j = 0; j < 16; ++j) { const unsigned cnt = xb_ld(&bar[XB_XCNT(j)]); if (cnt != (j < 8 ? per : 0u)) uni = false; }
    xst[3] = uni ? (xb.x * per + xst[2]) : blockIdx.x;
  }
  __syncthreads();
  const int vb = (int)xst[3];
  REPS(1) { phase_g1(*fresh_params(), smem, vb); xcd_barrier(xb); }
  REPS(2) {
    for (int it = blockIdx.x; it < MT * 16 + 1536; it += gridDim.x) {
      if (it < MT * 16) { const int mt = it >> 4; lru_tile(*fresh_params(), smem, mt, it & 15, mt < 128 ? 2 : 1); }
      else attn_item(*fresh_params(), smem, it - MT * 16);
    }
    xcd_barrier(xb);
  }
  REPS(4) { phase_g3(*fresh_params(), smem, vb); xcd_barrier(xb); }
  REPS(5) { phase_g4(*fresh_params(), smem, vb); xcd_barrier(xb); }
  REPS(6) { phase_g5(*fresh_params(), smem, vb); xcd_barrier(xb); }
  REPS(7) { phase_g6(*fresh_params(), smem, vb); xcd_barrier(xb); }
  phase7(*fresh_params());
  phase7b(*fresh_params());
}

extern "C" void kernel_launch(void* const* d_in, const int* in_sizes, int n_in, void* d_out, int out_size, void* d_ws,
                              size_t ws_size, hipStream_t stream) {
  static int grid_blocks = 0;
  if (!grid_blocks) {
    int dev = 0, cus = 0, per_cu = 0;
    hipGetDevice(&dev);
    hipDeviceGetAttribute(&cus, hipDeviceAttributeMultiprocessorCount, dev);
    hipFuncSetAttribute((const void*)fwd_megakernel, hipFuncAttributeMaxDynamicSharedMemorySize, SMEM_BYTES);
    hipOccupancyMaxActiveBlocksPerMultiprocessor(&per_cu, fwd_megakernel, 256, SMEM_BYTES);
    if (per_cu < 1) per_cu = 1;
    grid_blocks = cus * per_cu;
  }
  Params p{};
  const float** pp = (const float**)&p;
  for (int i = 0; i < 26; i++) pp[i] = (const float*)d_in[i];
  p.out = (float*)d_out;
  p.ws = (char*)d_ws;
  (void)hipMemsetAsync((char*)d_ws + W_BAR, 0, (size_t)3456 * 4 + 8 * 256 + 2048 * 4 + 2176 * 4, stream);
  void* args[] = {&p};
  hipError_t e = hipLaunchCooperativeKernel((void*)fwd_megakernel, dim3(grid_blocks), dim3(256), args, SMEM_BYTES, stream);
  if (e != hipSuccess) fprintf(stderr, "cooperative launch failed: %s (grid %d)\n", hipGetErrorString(e), grid_blocks);
}
```

```cpp
#include <hip/hip_runtime.h>
#include <hip/hip_cooperative_groups.h>
#include <stdint.h>
#include <cstdio>
namespace cg = cooperative_groups;

typedef unsigned short u16;
typedef __attribute__((ext_vector_type(8))) short bf16x8;
typedef __attribute__((ext_vector_type(4))) float f32x4;

constexpr int D = 1024;
constexpr int NP = 16384;
constexpr int NTOK = 17408;
constexpr int SEQ = 4096;
constexpr int MT = 136;
constexpr float EPS = 1e-6f;

constexpr size_t O_Y = 0;
constexpr size_t O_CONVP = 17825792;
constexpr size_t O_LRUP = O_CONVP + 12288;
constexpr size_t O_KP = O_LRUP + 4096;
constexpr size_t O_VP = O_KP + 131072;
constexpr size_t O_CONVS = O_VP + 131072;
constexpr size_t O_LRUS = O_CONVS + 393216;
constexpr size_t O_KS = O_LRUS + 131072;
constexpr size_t O_VS = O_KS + 4194304;

constexpr size_t W_WTIN = 0;
constexpr size_t W_WTLRU = W_WTIN + (size_t)5632 * 1024 * 2;
constexpr size_t W_WTATTN = W_WTLRU + (size_t)1024 * 1024 * 2;
constexpr size_t W_WTOUT = W_WTATTN + (size_t)1024 * 1024 * 2;
constexpr size_t W_WTQ = W_WTOUT + (size_t)1024 * 1024 * 2;
constexpr size_t W_SK = W_WTQ + (size_t)2048 * 1024 * 2;
constexpr size_t W_RGA = W_SK + (size_t)16 * 128 * 128 * 2;
constexpr size_t W_RGX = W_RGA + (size_t)65536 * 2;
constexpr size_t W_EU = W_RGX + (size_t)65536 * 2;
constexpr size_t W_EV = W_EU + (size_t)16384 * 1024;
constexpr size_t W_ESC = W_EV + (size_t)16384 * 1024;
constexpr size_t W_XN = W_ESC + (size_t)32768 * 4;
constexpr size_t W_ZA = W_XN + (size_t)NTOK * 1024 * 2;
constexpr size_t W_ZB = W_ZA + (size_t)NTOK * 2048 * 2;
constexpr size_t W_AGG = W_ZB + (size_t)NTOK * 1536 * 2;
constexpr size_t W_SSQ = W_AGG + (size_t)128 * 1024 * 2 * 4;
constexpr size_t W_BAR = W_SSQ + (size_t)NTOK * 16 * 4;
constexpr size_t W_Q = W_BAR + (size_t)3456 * 4;
constexpr size_t W_FLAG = W_Q + (size_t)8 * 256;
constexpr size_t W_CNT = W_FLAG + (size_t)2048 * 4;
constexpr size_t W_ACT = W_CNT + (size_t)2176 * 4;
constexpr size_t W_LO = W_ACT + (size_t)NTOK * 128 * 4;
constexpr size_t W_END = W_LO + (size_t)NTOK * 1024 * 2;

constexpr int SMEM_BYTES = 81920;

struct Params {
  const float *x_prompt, *x_sample, *cache_conv, *state_lru, *cache_k, *cache_v, *norm1_g, *w_in, *conv_w,
      *conv_b, *rg_w_a, *rg_b_a, *rg_w_x, *rg_b_x, *rg_lambda, *q_norm_g, *k_norm_g, *attn_sinks,
      *w_branch_lru, *w_branch_attn, *w_out, *norm2_g, *peer_w_query, *peer_sub_keys, *expert_u, *expert_v;
  float* out;
  char* ws;
};

typedef const __attribute__((address_space(4))) Params KParams;
__device__ __forceinline__ KParams* fresh_params() {
  unsigned long long k = (unsigned long long)__builtin_amdgcn_kernarg_segment_ptr();
  asm volatile("" : "+s"(k));
  return (KParams*)k;
}
__device__ __forceinline__ u16 f2bf(float f) {
  uint32_t u = __float_as_uint(f);
  u += 0x7FFFu + ((u >> 16) & 1u);
  return (u16)(u >> 16);
}
__device__ __forceinline__ float bf2f(u16 h) { return __uint_as_float(((uint32_t)h) << 16); }
__device__ __forceinline__ uint32_t pack2(float a, float b) {
  uint32_t r;
  asm("v_cvt_pk_bf16_f32 %0, %1, %2" : "=v"(r) : "v"(a), "v"(b));
  return r;
}
__device__ __forceinline__ uint4 pack8(const float* v) {
  uint4 o;
  o.x = pack2(v[0], v[1]); o.y = pack2(v[2], v[3]); o.z = pack2(v[4], v[5]); o.w = pack2(v[6], v[7]);
  return o;
}
__device__ __forceinline__ void unpack8(uint4 u, float* v) {
  v[0] = __uint_as_float(u.x << 16); v[1] = __uint_as_float(u.x & 0xFFFF0000u);
  v[2] = __uint_as_float(u.y << 16); v[3] = __uint_as_float(u.y & 0xFFFF0000u);
  v[4] = __uint_as_float(u.z << 16); v[5] = __uint_as_float(u.z & 0xFFFF0000u);
  v[6] = __uint_as_float(u.w << 16); v[7] = __uint_as_float(u.w & 0xFFFF0000u);
}
__device__ __forceinline__ float sigmoidf_(float x) { return __builtin_amdgcn_rcpf(1.f + __expf(-x)); }
__device__ __forceinline__ float gelu_tanh(float x) {
  float y = 0.7978845608028654f * (x + 0.044715f * x * x * x);
  float t = 1.f - 2.f * __builtin_amdgcn_rcpf(__expf(2.f * y) + 1.f);
  return 0.5f * x * (1.f + t);
}
__device__ __forceinline__ uint32_t ordf(float f) {
  uint32_t u = __float_as_uint(f);
  return (u & 0x80000000u) ? ~u : (u | 0x80000000u);
}
__device__ __forceinline__ float unordf(uint32_t o) {
  uint32_t u = (o & 0x80000000u) ? (o ^ 0x80000000u) : ~o;
  return __uint_as_float(u);
}
__device__ __forceinline__ unsigned hw_xcc_id() { return (unsigned)__builtin_amdgcn_s_getreg((3 << 11) | 20) & 0xFu; }
__device__ __forceinline__ int opaque_tid() {
  int t = threadIdx.x;
  asm volatile("" : "+v"(t));
  return t;
}
__device__ __forceinline__ const float* xrow(KParams& p, int row) {
  return row < NP ? p.x_prompt + (size_t)row * D : p.x_sample + (size_t)(row - NP) * D;
}

#define INS16(T, V)                                  \
  {                                                  \
    uint32_t _v = (V);                               \
    _Pragma("unroll") for (int _q = 0; _q < 16; _q++) { \
      uint32_t _hi = max(T[_q], _v);                 \
      _v = min(T[_q], _v);                           \
      T[_q] = _hi;                                   \
    }                                                \
  }

#define CE_DESC(A_, B_) { const uint32_t _h = max(A_, B_), _l = min(A_, B_); A_ = _h; B_ = _l; }
__device__ __forceinline__ void sort16_desc(uint32_t (&t)[16]) {
#pragma unroll
  for (int k = 2; k <= 16; k <<= 1) {
#pragma unroll
    for (int j = k >> 1; j > 0; j >>= 1) {
#pragma unroll
      for (int i = 0; i < 16; i++) {
        const int l = i ^ j;
        if (l > i) {
          if ((i & k) == 0) { CE_DESC(t[i], t[l]); } else { CE_DESC(t[l], t[i]); }
        }
      }
    }
  }
}
__device__ __forceinline__ void merge16_desc(uint32_t (&T)[16], const uint32_t (&S)[16]) {
#pragma unroll
  for (int i = 0; i < 16; i++) T[i] = max(T[i], S[15 - i]);
#pragma unroll
  for (int j = 8; j > 0; j >>= 1) {
#pragma unroll
    for (int i = 0; i < 16; i++) {
      const int l = i ^ j;
      if (l > i) { CE_DESC(T[i], T[l]); }
    }
  }
}

__device__ __forceinline__ void transpose_cvt(const float* __restrict__ W, u16* __restrict__ Wt, int K, int N,
                                              size_t gtid, size_t gsz) {
  size_t total = (size_t)N * (K / 8);
  for (size_t c = gtid; c < total; c += gsz) {
    int n = (int)(c % N);
    int kg = (int)(c / N);
    float v[8];
#pragma unroll
    for (int i = 0; i < 8; i++) v[i] = W[(size_t)(kg * 8 + i) * N + n];
    *(uint4*)(Wt + (size_t)n * K + kg * 8) = pack8(v);
  }
}
__device__ __forceinline__ void plain_cvt(const float* __restrict__ S, u16* __restrict__ Dst, size_t n, size_t gtid,
                                          size_t gsz) {
  size_t total = n / 8;
  const float4* s4 = (const float4*)S;
  for (size_t c = gtid; c < total; c += gsz) {
    float4 a = s4[2 * c], b = s4[2 * c + 1];
    float v[8] = {a.x, a.y, a.z, a.w, b.x, b.y, b.z, b.w};
    *(uint4*)(Dst + c * 8) = pack8(v);
  }
}

__device__ __forceinline__ void phase0(KParams& p, char* smem) {
  const int tid = opaque_tid();
  const size_t gtid = (size_t)blockIdx.x * 256 + tid, gsz = (size_t)gridDim.x * 256;
  char* ws = p.ws;
  {
    const int lane = tid & 63;
    const int gw = (int)(gtid >> 6), nw = (int)(gsz >> 6);
    u16* XN = (u16*)(ws + W_XN);
    for (int row = gw; row < NTOK; row += nw) {
      const float4* xr = (const float4*)xrow(p, row);
      float4 v[4];
      float ss = 0.f;
#pragma unroll
      for (int i = 0; i < 4; i++) {
        v[i] = xr[lane + i * 64];
        ss += v[i].x * v[i].x + v[i].y * v[i].y + v[i].z * v[i].z + v[i].w * v[i].w;
      }
#pragma unroll
      for (int o = 32; o > 0; o >>= 1) ss += __shfl_xor(ss, o);
      float rstd = rsqrtf(ss * (1.f / 1024.f) + EPS);
      const float4* g4 = (const float4*)p.norm1_g;
#pragma unroll
      for (int i = 0; i < 4; i++) {
        float4 g = g4[lane + i * 64];
        uint2 o;
        o.x = pack2(v[i].x * rstd * g.x, v[i].y * rstd * g.y);
        o.y = pack2(v[i].z * rstd * g.z, v[i].w * rstd * g.w);
        *(uint2*)(XN + (size_t)row * D + (lane + i * 64) * 4) = o;
      }
    }
  }
  {
    float* T = (float*)smem;
    for (int tile = blockIdx.x; tile < 2688; tile += gridDim.x) {
      const float* W;
      u16* Wt;
      int N, tl;
      if (tile < 1408) { W = p.w_in; Wt = (u16*)(ws + W_WTIN); N = 5632; tl = tile; }
      else if (tile < 1664) { W = p.w_branch_lru; Wt = (u16*)(ws + W_WTLRU); N = 1024; tl = tile - 1408; }
      else if (tile < 1920) { W = p.w_branch_attn; Wt = (u16*)(ws + W_WTATTN); N = 1024; tl = tile - 1664; }
      else if (tile < 2176) { W = p.w_out; Wt = (u16*)(ws + W_WTOUT); N = 1024; tl = tile - 1920; }
      else { W = p.peer_w_query; Wt = (u16*)(ws + W_WTQ); N = 2048; tl = tile - 2176; }
      const int ntn = N >> 6;
      const int kt = tl / ntn, nt = tl - kt * ntn;
      __syncthreads();
      {
        const float* src = W + (size_t)(kt * 64 + (tid >> 2)) * N + nt * 64 + (tid & 3) * 16;
        const float4 a0 = *(const float4*)src, a1 = *(const float4*)(src + 4), a2 = *(const float4*)(src + 8),
                     a3 = *(const float4*)(src + 12);
        float* d = T + (tid >> 2) * 65 + (tid & 3) * 16;
        d[0] = a0.x; d[1] = a0.y; d[2] = a0.z; d[3] = a0.w; d[4] = a1.x; d[5] = a1.y; d[6] = a1.z; d[7] = a1.w;
        d[8] = a2.x; d[9] = a2.y; d[10] = a2.z; d[11] = a2.w; d[12] = a3.x; d[13] = a3.y; d[14] = a3.z; d[15] = a3.w;
      }
      __syncthreads();
      {
        const int n = tid >> 2, kc = (tid & 3) * 16;
        float v[16];
#pragma unroll
        for (int i = 0; i < 16; i++) v[i] = T[(kc + i) * 65 + n];
        u16* dst = Wt + (size_t)(nt * 64 + n) * 1024 + kt * 64 + kc;
        *(uint4*)dst = pack8(v);
        *(uint4*)(dst + 8) = pack8(v + 8);
      }
    }
  }
  {
    u16* RA = (u16*)(ws + W_RGA);
    u16* RX = (u16*)(ws + W_RGX);
    for (size_t e = gtid; e < 65536; e += gsz) {
      int n = (int)(e >> 12), k = (int)((e >> 6) & 63), j = (int)(e & 63);
      RA[e] = f2bf(p.rg_w_a[n * 4096 + j * 64 + k]);
      RX[e] = f2bf(p.rg_w_x[n * 4096 + j * 64 + k]);
    }
  }
  plain_cvt(p.peer_sub_keys, (u16*)(ws + W_SK), (size_t)16 * 128 * 128, gtid, gsz);
  {
    const int lane = tid & 63;
    const int gw = (int)(gtid >> 6), nw = (int)(gsz >> 6);
    unsigned char* E8 = (unsigned char*)(ws + W_EU);
    float* ESC = (float*)(ws + W_ESC);
    for (int r = gw; r < 32768; r += nw) {
      const float* src = (r < 16384 ? p.expert_u : p.expert_v) + (size_t)(r & 16383) * 1024 + lane * 16;
      const float4 a0 = *(const float4*)src, a1 = *(const float4*)(src + 4), a2 = *(const float4*)(src + 8),
                   a3 = *(const float4*)(src + 12);
      float am = fmaxf(fmaxf(fmaxf(fabsf(a0.x), fabsf(a0.y)), fmaxf(fabsf(a0.z), fabsf(a0.w))),
                       fmaxf(fmaxf(fabsf(a1.x), fabsf(a1.y)), fmaxf(fabsf(a1.z), fabsf(a1.w))));
      am = fmaxf(am, fmaxf(fmaxf(fmaxf(fabsf(a2.x), fabsf(a2.y)), fmaxf(fabsf(a2.z), fabsf(a2.w))),
                           fmaxf(fmaxf(fabsf(a3.x), fabsf(a3.y)), fmaxf(fabsf(a3.z), fabsf(a3.w)))));
#pragma unroll
      for (int o = 32; o > 0; o >>= 1) am = fmaxf(am, __shfl_xor(am, o));
      const float sc = am > 0.f ? 224.f / am : 1.f;
      uint4 o4;
      int wv;
      wv = __builtin_amdgcn_cvt_pk_fp8_f32(a0.x * sc, a0.y * sc, 0, false);
      wv = __builtin_amdgcn_cvt_pk_fp8_f32(a0.z * sc, a0.w * sc, wv, true);
      o4.x = (uint32_t)wv;
      wv = __builtin_amdgcn_cvt_pk_fp8_f32(a1.x * sc, a1.y * sc, 0, false);
      wv = __builtin_amdgcn_cvt_pk_fp8_f32(a1.z * sc, a1.w * sc, wv, true);
      o4.y = (uint32_t)wv;
      wv = __builtin_amdgcn_cvt_pk_fp8_f32(a2.x * sc, a2.y * sc, 0, false);
      wv = __builtin_amdgcn_cvt_pk_fp8_f32(a2.z * sc, a2.w * sc, wv, true);
      o4.z = (uint32_t)wv;
      wv = __builtin_amdgcn_cvt_pk_fp8_f32(a3.x * sc, a3.y * sc, 0, false);
      wv = __builtin_amdgcn_cvt_pk_fp8_f32(a3.z * sc, a3.w * sc, wv, true);
      o4.w = (uint32_t)wv;
      if (r < 16384) *(uint4*)(E8 + (size_t)r * 1024 + lane * 16) = o4;
      else *(uint4*)(E8 + (size_t)16384 * 1024 + (size_t)(lane >> 3) * (16384 * 128) + (size_t)(r - 16384) * 128 + (lane & 7) * 16) = o4;
      if (lane == 0) ESC[r] = am > 0.f ? am * (1.f / 224.f) : 1.f;
    }
  }
}

constexpr int LDT = 72;
constexpr int CS_LD = 132;

template <int NW>
__device__ __forceinline__ void gemm_tile(const u16* __restrict__ A, int lda, const u16* __restrict__ Bt, int ldb,
                                          int K, f32x4 (&acc)[4][NW / 32], char* smem, int tid) {
  constexpr int NJ = NW / 32;
  const int lane = tid & 63, w = tid >> 6;
  const int wm = w >> 1, wn = w & 1;
  const int l15 = lane & 15, quad = lane >> 4;
  const int lr = w * 8 + (lane >> 3);
  const int lc = ((lane & 7) ^ ((lane >> 3) & 7)) * 8;
  const char* Ab = (const char*)A;
  const char* Bb = (const char*)Bt;
  const uint32_t ao = (uint32_t)(lr * lda + lc) * 2u, bo = (uint32_t)(lr * ldb + lc) * 2u;
  const uint32_t sa2 = 64u * (uint32_t)lda, sb2 = 64u * (uint32_t)ldb;
  const uint32_t kmask = (uint32_t)K - 1u, kst = (((uint32_t)blockIdx.x >> 3) * 64u) & kmask;
  char* lw = smem + w * 1024 + lane * 16;
  const int swz = l15 & 7;
  const char* Ar = smem + (wm * 64 + l15) * 128 + ((quad ^ swz) * 16);
  const char* Br = smem + 16384 + (wn * (NW / 2) + l15) * 128 + ((quad ^ swz) * 16);
  const char* Ar1 = smem + (wm * 64 + l15) * 128 + (((4 + quad) ^ swz) * 16);
  const char* Br1 = smem + 16384 + (wn * (NW / 2) + l15) * 128 + (((4 + quad) ^ swz) * 16);
#define GT_ISSUE(st, off)                                                                                   \
  {                                                                                                         \
    const uint32_t _o = (((uint32_t)(off) + kst) & kmask) * 2u;                                             \
    char* _l = lw + (st) * 32768;                                                                           \
    _Pragma("unroll") for (int j = 0; j < 4; j++) {                                                         \
      __builtin_amdgcn_global_load_lds((const unsigned*)(Ab + (size_t)(ao + j * sa2 + _o)), (unsigned*)(_l + j * 4096), 16, 0, 0);          \
      if (j < NJ) __builtin_amdgcn_global_load_lds((const unsigned*)(Bb + (size_t)(bo + j * sb2 + _o)), (unsigned*)(_l + 16384 + j * 4096), 16, 0, 0);  \
    }                                                                                                       \
  }
#define GT_MMA(st)                                                                                          \
  {                                                                                                         \
    const char* _ar = Ar + (st) * 32768; const char* _br = Br + (st) * 32768;                               \
    const char* _ar1 = Ar1 + (st) * 32768; const char* _br1 = Br1 + (st) * 32768;                           \
    bf16x8 a0[4], b0[NJ], a1[4], b1[NJ];                                                                      \
    _Pragma("unroll") for (int i = 0; i < 4; i++) {                                                         \
      a0[i] = *(const bf16x8*)(_ar + i * 2048);                                                             \
      if (i < NJ) b0[i] = *(const bf16x8*)(_br + i * 2048);                                                 \
    }                                                                                                       \
    _Pragma("unroll") for (int i = 0; i < 4; i++) {                                                         \
      a1[i] = *(const bf16x8*)(_ar1 + i * 2048);                                                            \
      if (i < NJ) b1[i] = *(const bf16x8*)(_br1 + i * 2048);                                                \
    }                                                                                                       \
    __builtin_amdgcn_s_setprio(1);                                                                          \
    _Pragma("unroll") for (int i = 0; i < 4; i++)                                                           \
      _Pragma("unroll") for (int j = 0; j < NJ; j++)                                                        \
        acc[i][j] = __builtin_amdgcn_mfma_f32_16x16x32_bf16(a0[i], b0[j], acc[i][j], 0, 0, 0);              \
    _Pragma("unroll") for (int i = 0; i < 4; i++)                                                           \
      _Pragma("unroll") for (int j = 0; j < NJ; j++)                                                        \
        acc[i][j] = __builtin_amdgcn_mfma_f32_16x16x32_bf16(a1[i], b1[j], acc[i][j], 0, 0, 0);              \
    __builtin_amdgcn_s_setprio(0);                                                                          \
  }
  __syncthreads();
  GT_ISSUE(0, 0);
  for (int k0 = 0; k0 < K; k0 += 128) {
    asm volatile("s_waitcnt vmcnt(0) lgkmcnt(0)" ::: "memory");
    __builtin_amdgcn_s_barrier();
    asm volatile("" ::: "memory");
    GT_ISSUE(1, k0 + 64);
    GT_MMA(0);
    asm volatile("s_waitcnt vmcnt(0) lgkmcnt(0)" ::: "memory");
    __builtin_amdgcn_s_barrier();
    asm volatile("" ::: "memory");
    if (k0 + 128 < K) GT_ISSUE(0, k0 + 128);
    GT_MMA(1);
  }
#undef GT_ISSUE
#undef GT_MMA
}

__device__ __forceinline__ void tile_map(int it, int total, int NT, int& mt, int& nt, int vb) {
  const int G = gridDim.x;
  int T = it;
  {
    const int round = it / G;
    if (round * G + G <= total) T = round * G + vb;
  }
  const int g = T / (8 * NT), r = T - g * (8 * NT);
  nt = r >> 3;
  mt = g * 8 + (r & 7);
}

template <int NJ>
__device__ __forceinline__ void zero_acc(f32x4 (&acc)[4][NJ]) {
#pragma unroll
  for (int i = 0; i < 4; i++)
#pragma unroll
    for (int j = 0; j < NJ; j++) acc[i][j] = (f32x4){0.f, 0.f, 0.f, 0.f};
}

template <int NJ>
__device__ __forceinline__ void acc_to_cs(const f32x4 (&acc)[4][NJ], float* Cs, int tid) {
  const int lane = tid & 63, w = tid >> 6;
  const int wm = w >> 1, wn = w & 1;
  const int l15 = lane & 15, quad = lane >> 4;
#pragma unroll
  for (int i = 0; i < 4; i++)
#pragma unroll
    for (int j = 0; j < NJ; j++)
#pragma unroll
      for (int e = 0; e < 4; e++)
        Cs[(wm * 64 + i * 16 + quad * 4 + e) * CS_LD + wn * (NJ * 16) + j * 16 + l15] = acc[i][j][e];
}

__device__ __forceinline__ void phase_g1(KParams& p, char* smem, int vb) {
  const int tid = opaque_tid();
  u16* As = (u16*)smem;
  u16* Bs = As + 2 * 128 * LDT;
  float* Cs = (float*)smem;
  const u16* XN = (const u16*)(p.ws + W_XN);
  const u16* WT = (const u16*)(p.ws + W_WTIN);
  for (int t = blockIdx.x; t < MT * 44; t += gridDim.x) {
    int mt, nt;
    tile_map(t, MT * 44, 44, mt, nt, vb);
    f32x4 acc[4][4];
    zero_acc(acc);
    gemm_tile<128>(XN + (size_t)mt * 128 * 1024, 1024, WT + (size_t)nt * 128 * 1024, 1024, 1024, acc, smem, tid);
    __syncthreads();
    acc_to_cs(acc, Cs, tid);
    __syncthreads();
    const int n0 = nt * 128;
    u16* dst;
    int ldd, col;
    if (n0 < 2048) { dst = (u16*)(p.ws + W_ZA); ldd = 2048; col = n0; }
    else if (n0 < 3584) { dst = (u16*)(p.ws + W_ZB); ldd = 1536; col = n0 - 2048; }
    else { dst = (u16*)p.out; ldd = 2048; col = n0 - 3584; }
    const int cc = (tid & 15) * 8;
#pragma unroll
    for (int i = 0; i < 8; i++) {
      const int r = (tid >> 4) + 16 * i;
      float4 a = *(const float4*)(Cs + r * CS_LD + cc), b = *(const float4*)(Cs + r * CS_LD + cc + 4);
      float v[8] = {a.x, a.y, a.z, a.w, b.x, b.y, b.z, b.w};
      *(uint4*)(dst + (size_t)(mt * 128 + r) * ldd + col + cc) = pack8(v);
    }
    __syncthreads();
  }
}

constexpr int KS_LD = 72, VT_LD = 200, PS_LD = 168;
__device__ __forceinline__ void attn_item(KParams& p, char* smem, int item) {
  const int tid = opaque_tid(), lane = tid & 63, w = tid >> 6, l15 = lane & 15, quad = lane >> 4;
  u16* Ks = (u16*)smem;
  u16* Vt = Ks + 192 * KS_LD;
  u16* Ps = Vt + 64 * VT_LD + w * 16 * PS_LD;
  const u16* ZB = (const u16*)(p.ws + W_ZB);
  u16* ATT = (u16*)(p.ws + W_XN);
  const bool sample = item >= 1024;
  int b, qb = 0, kv, rowbase, p0 = 0;
  if (!sample) {
    kv = item & 3; qb = (item >> 2) & 63; b = item >> 8;
    p0 = qb * 64;
    rowbase = b * SEQ + p0;
  } else {
    int it = item - 1024;
    kv = it & 3; b = it >> 2;
    rowbase = NP + b * 8;
  }
  __syncthreads();
  {
    const int ch = tid & 7;
    float kg[8];
#pragma unroll
    for (int i = 0; i < 8; i++) kg[i] = p.k_norm_g[ch * 8 + i];
    const int nrows = sample ? 160 : 192;
    for (int c = tid; c < nrows * 8; c += 256) {
      const int row = c >> 3;
      float kf[8], vf[8];
      bool valid, donorm;
      if (!sample) {
        const int pos = p0 - 128 + row;
        valid = pos >= 0;
        donorm = true;
        if (valid) {
          const u16* src = ZB + (size_t)(b * SEQ + pos) * 1536 + 1024 + kv * 64 + ch * 8;
          unpack8(*(const uint4*)src, kf);
          unpack8(*(const uint4*)(src + 256), vf);
        }
      } else {
        valid = row < 136;
        donorm = row >= 128;
        if (row < 128) {
          const float* sk = p.cache_k + ((size_t)(b * 128 + row) * 4 + kv) * 64 + ch * 8;
          const float* sv = p.cache_v + ((size_t)(b * 128 + row) * 4 + kv) * 64 + ch * 8;
          float4 a0 = *(const float4*)sk, a1 = *(const float4*)(sk + 4);
          float4 b0 = *(const float4*)sv, b1 = *(const float4*)(sv + 4);
          kf[0] = a0.x; kf[1] = a0.y; kf[2] = a0.z; kf[3] = a0.w; kf[4] = a1.x; kf[5] = a1.y; kf[6] = a1.z; kf[7] = a1.w;
          vf[0] = b0.x; vf[1] = b0.y; vf[2] = b0.z; vf[3] = b0.w; vf[4] = b1.x; vf[5] = b1.y; vf[6] = b1.z; vf[7] = b1.w;
        } else if (valid) {
          const u16* src = ZB + (size_t)(NP + b * 8 + (row - 128)) * 1536 + 1024 + kv * 64 + ch * 8;
          unpack8(*(const uint4*)src, kf);
          unpack8(*(const uint4*)(src + 256), vf);
        }
      }
      if (!valid) {
#pragma unroll
        for (int i = 0; i < 8; i++) { kf[i] = 0.f; vf[i] = 0.f; }
      }
      float ss = 0.f;
#pragma unroll
      for (int i = 0; i < 8; i++) ss += kf[i] * kf[i];
      ss += __shfl_xor(ss, 1);
      ss += __shfl_xor(ss, 2);
      ss += __shfl_xor(ss, 4);
      if (donorm) {
        const float rstd = rsqrtf(ss * (1.f / 64.f) + EPS);
#pragma unroll
        for (int i = 0; i < 8; i++) kf[i] = kf[i] * rstd * kg[i];
      }
      *(uint4*)(Ks + row * KS_LD + ch * 8) = pack8(kf);
#pragma unroll
      for (int i = 0; i < 8; i++) Vt[(ch * 8 + i) * VT_LD + row] = f2bf(vf[i]);
      if (!sample) {
        if (qb >= 62 && row >= 128) {
          const int wpos = p0 + (row - 128) - (SEQ - 128);
          float* ko = p.out + O_KP + ((size_t)(b * 128 + wpos) * 4 + kv) * 64 + ch * 8;
          float* vo = p.out + O_VP + ((size_t)(b * 128 + wpos) * 4 + kv) * 64 + ch * 8;
          *(float4*)ko = make_float4(kf[0], kf[1], kf[2], kf[3]);
          *(float4*)(ko + 4) = make_float4(kf[4], kf[5], kf[6], kf[7]);
          *(float4*)vo = make_float4(vf[0], vf[1], vf[2], vf[3]);
          *(float4*)(vo + 4) = make_float4(vf[4], vf[5], vf[6], vf[7]);
        }
      } else {
        if (row >= 8 && row < 136) {
          float* ko = p.out + O_KS + ((size_t)(b * 128 + (row - 8)) * 4 + kv) * 64 + ch * 8;
          float* vo = p.out + O_VS + ((size_t)(b * 128 + (row - 8)) * 4 + kv) * 64 + ch * 8;
          *(float4*)ko = make_float4(kf[0], kf[1], kf[2], kf[3]);
          *(float4*)(ko + 4) = make_float4(kf[4], kf[5], kf[6], kf[7]);
          *(float4*)vo = make_float4(vf[0], vf[1], vf[2], vf[3]);
          *(float4*)(vo + 4) = make_float4(vf[4], vf[5], vf[6], vf[7]);
        }
      }
    }
  }
  __syncthreads();
  const int hq = kv * 4 + w;
  const float slope = exp2f(-0.5f * (float)(hq + 1));
  const float sink = p.attn_sinks[hq];
  float qg[2][8];
#pragma unroll
  for (int ks = 0; ks < 2; ks++)
#pragma unroll
    for (int i = 0; i < 8; i++) qg[ks][i] = p.q_norm_g[ks * 32 + quad * 8 + i] * 0.125f;
  const int nsub = sample ? 1 : 4;
  for (int sb = 0; sb < nsub; sb++) {
    const int r0 = sb * 16;
    const int ws0 = r0 < 32 ? r0 : 32;
    bf16x8 qa[2];
    {
      const int qr = sample ? (l15 & 7) : (r0 + l15);
      const u16* src = ZB + (size_t)(rowbase + qr) * 1536 + hq * 64 + quad * 8;
      float q0[8], q1[8];
      unpack8(*(const uint4*)src, q0);
      unpack8(*(const uint4*)(src + 32), q1);
      float ss = 0.f;
#pragma unroll
      for (int i = 0; i < 8; i++) ss += q0[i] * q0[i] + q1[i] * q1[i];
      ss += __shfl_xor(ss, 16);
      ss += __shfl_xor(ss, 32);
      const float rstd = rsqrtf(ss * (1.f / 64.f) + EPS);
#pragma unroll
      for (int i = 0; i < 8; i++) { q0[i] *= rstd * qg[0][i]; q1[i] *= rstd * qg[1][i]; }
      uint4 u0 = pack8(q0), u1 = pack8(q1);
      qa[0] = __builtin_bit_cast(bf16x8, u0);
      qa[1] = __builtin_bit_cast(bf16x8, u1);
    }
    f32x4 s[10];
#pragma unroll
    for (int kt = 0; kt < 10; kt++) {
      const u16* kp = Ks + (ws0 + kt * 16 + l15) * KS_LD + quad * 8;
      bf16x8 b0 = *(const bf16x8*)kp, b1 = *(const bf16x8*)(kp + 32);
      f32x4 z = {0.f, 0.f, 0.f, 0.f};
      z = __builtin_amdgcn_mfma_f32_16x16x32_bf16(qa[0], b0, z, 0, 0, 0);
      s[kt] = __builtin_amdgcn_mfma_f32_16x16x32_bf16(qa[1], b1, z, 0, 0, 0);
    }
    float mx[4] = {-1e30f, -1e30f, -1e30f, -1e30f};
#pragma unroll
    for (int kt = 0; kt < 10; kt++) {
      const int jj = ws0 + kt * 16 + l15;
      const bool posok = sample ? (jj < 136) : (p0 - 128 + jj >= 0);
#pragma unroll
      for (int e = 0; e < 4; e++) {
        const int r = r0 + quad * 4 + e;
        const int dist = r + 128 - jj;
        const bool ok = posok && dist >= 0 && dist <= 128;
        float v = ok ? (s[kt][e] - slope * (float)dist) : -1e30f;
        s[kt][e] = v;
        mx[e] = fmaxf(mx[e], v);
      }
    }
    float sum[4];
#pragma unroll
    for (int e = 0; e < 4; e++) {
      float m = mx[e];
      m = fmaxf(m, __shfl_xor(m, 1));
      m = fmaxf(m, __shfl_xor(m, 2));
      m = fmaxf(m, __shfl_xor(m, 4));
      m = fmaxf(m, __shfl_xor(m, 8));
      m = fmaxf(m, sink);
      mx[e] = m;
      sum[e] = 0.f;
    }
#pragma unroll
    for (int kt = 0; kt < 10; kt++) {
#pragma unroll
      for (int e = 0; e < 4; e++) {
        float pv = __expf(s[kt][e] - mx[e]);
        sum[e] += pv;
        Ps[(quad * 4 + e) * PS_LD + kt * 16 + l15] = f2bf(pv);
      }
    }
#pragma unroll
    for (int e = 0; e < 4; e++) {
      float t = sum[e];
      t += __shfl_xor(t, 1);
      t += __shfl_xor(t, 2);
      t += __shfl_xor(t, 4);
      t += __shfl_xor(t, 8);
      sum[e] = 1.f / (t + __expf(sink - mx[e]));
    }
    __syncthreads();
    f32x4 o[4];
#pragma unroll
    for (int nt = 0; nt < 4; nt++) o[nt] = (f32x4){0.f, 0.f, 0.f, 0.f};
#pragma unroll
    for (int kk = 0; kk < 5; kk++) {
      bf16x8 pa = *(const bf16x8*)(Ps + l15 * PS_LD + kk * 32 + quad * 8);
#pragma unroll
      for (int nt = 0; nt < 4; nt++) {
        bf16x8 vb = *(const bf16x8*)(Vt + (nt * 16 + l15) * VT_LD + ws0 + kk * 32 + quad * 8);
        o[nt] = __builtin_amdgcn_mfma_f32_16x16x32_bf16(pa, vb, o[nt], 0, 0, 0);
      }
    }
#pragma unroll
    for (int e = 0; e < 4; e++) {
      const int r = quad * 4 + e;
      if (!sample || r < 8) {
        u16* dst = ATT + (size_t)(rowbase + r0 + r) * 1024 + hq * 64 + l15;
#pragma unroll
        for (int nt = 0; nt < 4; nt++) dst[nt * 16] = f2bf(o[nt][e] * sum[e]);
      }
    }
    __syncthreads();
  }
}

constexpr int XC_LD = 68;
__device__ __forceinline__ void lru_tile(KParams& p, char* smem, int mt, int nb, int mode) {
  const int tid = opaque_tid(), lane = tid & 63, w = tid >> 6, l15 = lane & 15, quad = lane >> 4;
  float* xcF = (float*)smem;
  float* aL = xcF + 128 * XC_LD;
  float* aggL = aL + 128 * XC_LD;
  const u16* ZA = (const u16*)(p.ws + W_ZA);
  const bool sample = mt >= 128;
  const int m0 = mt * 128;
  const int cb = nb * 64;
  __syncthreads();
  {
    const int ch = tid & 7;
    float cw[4][8], cbias[8];
#pragma unroll
    for (int j = 0; j < 4; j++)
#pragma unroll
      for (int i = 0; i < 8; i++) cw[j][i] = p.conv_w[j * 1024 + cb + ch * 8 + i];
#pragma unroll
    for (int i = 0; i < 8; i++) cbias[i] = p.conv_b[cb + ch * 8 + i];
#pragma unroll
    for (int it = 0; it < 4; it++) {
      const int r = (tid >> 3) + it * 32;
      const int grow = m0 + r;
      const int t = sample ? (r & 7) : ((mt & 31) * 128 + r);
      float y[8];
#pragma unroll
      for (int i = 0; i < 8; i++) y[i] = cbias[i];
#pragma unroll
      for (int d = 0; d < 4; d++) {
        float xv[8];
        if (t - d >= 0) {
          unpack8(*(const uint4*)(ZA + (size_t)(grow - d) * 2048 + cb + ch * 8), xv);
        } else if (sample) {
          const int bb = (m0 - NP + r) >> 3;
          const float* src = p.cache_conv + ((size_t)bb * 3 + (3 + t - d)) * 1024 + cb + ch * 8;
          float4 a = *(const float4*)src, b4 = *(const float4*)(src + 4);
          xv[0] = a.x; xv[1] = a.y; xv[2] = a.z; xv[3] = a.w; xv[4] = b4.x; xv[5] = b4.y; xv[6] = b4.z; xv[7] = b4.w;
        } else {
#pragma unroll
          for (int i = 0; i < 8; i++) xv[i] = 0.f;
        }
#pragma unroll
        for (int i = 0; i < 8; i++) y[i] += cw[3 - d][i] * xv[i];
        if (d == 0 && mode != 0) {
          if (!sample) {
            if ((mt & 31) == 31 && r >= 125) {
              float* dst = p.out + O_CONVP + ((size_t)(mt >> 5) * 3 + (r - 125)) * 1024 + cb + ch * 8;
              *(float4*)dst = make_float4(xv[0], xv[1], xv[2], xv[3]);
              *(float4*)(dst + 4) = make_float4(xv[4], xv[5], xv[6], xv[7]);
            }
          } else if (t >= 5) {
            const int bb = (m0 - NP + r) >> 3;
            float* dst = p.out + O_CONVS + ((size_t)bb * 3 + (t - 5)) * 1024 + cb + ch * 8;
            *(float4*)dst = make_float4(xv[0], xv[1], xv[2], xv[3]);
            *(float4*)(dst + 4) = make_float4(xv[4], xv[5], xv[6], xv[7]);
          }
        }
      }
      *(float4*)(xcF + r * XC_LD + ch * 8) = make_float4(y[0], y[1], y[2], y[3]);
      *(float4*)(xcF + r * XC_LD + ch * 8 + 4) = make_float4(y[4], y[5], y[6], y[7]);
    }
  }
  __syncthreads();
  {
    const u16* RA = (const u16*)(p.ws + W_RGA) + nb * 4096;
    const u16* RX = (const u16*)(p.ws + W_RGX) + nb * 4096;
    f32x4 aR[2][4], aI[2][4];
#pragma unroll
    for (int i = 0; i < 2; i++)
#pragma unroll
      for (int j = 0; j < 4; j++) { aR[i][j] = (f32x4){0.f, 0.f, 0.f, 0.f}; aI[i][j] = (f32x4){0.f, 0.f, 0.f, 0.f}; }
#pragma unroll
    for (int ks = 0; ks < 2; ks++) {
      bf16x8 a[2];
#pragma unroll
      for (int i = 0; i < 2; i++) {
        const float* src = xcF + (w * 32 + i * 16 + l15) * XC_LD + ks * 32 + quad * 8;
        float4 x0 = *(const float4*)src, x1 = *(const float4*)(src + 4);
        float v[8] = {x0.x, x0.y, x0.z, x0.w, x1.x, x1.y, x1.z, x1.w};
        uint4 u = pack8(v);
        a[i] = __builtin_bit_cast(bf16x8, u);
      }
#pragma unroll
      for (int j = 0; j < 4; j++) {
        bf16x8 ba = *(const bf16x8*)(RA + (j * 16 + l15) * 64 + ks * 32 + quad * 8);
        bf16x8 bx = *(const bf16x8*)(RX + (j * 16 + l15) * 64 + ks * 32 + quad * 8);
#pragma unroll
        for (int i = 0; i < 2; i++) {
          aR[i][j] = __builtin_amdgcn_mfma_f32_16x16x32_bf16(a[i], ba, aR[i][j], 0, 0, 0);
          aI[i][j] = __builtin_amdgcn_mfma_f32_16x16x32_bf16(a[i], bx, aI[i][j], 0, 0, 0);
        }
      }
    }
#pragma unroll
    for (int j = 0; j < 4; j++) {
      const int c = cb + j * 16 + l15;
      const float ba = p.rg_b_a[c], bx = p.rg_b_x[c];
      const float ls = -log1pf(__expf(-p.rg_lambda[c]));
#pragma unroll
      for (int i = 0; i < 2; i++)
#pragma unroll
        for (int e = 0; e < 4; e++) {
          const int row = w * 32 + i * 16 + quad * 4 + e;
          const float rg = sigmoidf_(aR[i][j][e] + ba);
          const float ig = sigmoidf_(aI[i][j][e] + bx);
          const float la = 8.f * rg * ls;
          const float av = __expf(la);
          const float x2 = 2.f * la;
          const float emt = -x2 * (1.f + x2 * (0.5f + x2 * (0.16666667f + x2 * (0.041666668f + x2 * 0.008333334f))));
          const float em = x2 > -0.25f ? emt : 1.f - __expf(x2);
          const float mult = __builtin_amdgcn_sqrtf(fmaxf(em, 0.f));
          const int idx = row * XC_LD + j * 16 + l15;
          const float xv = xcF[idx];
          aL[idx] = av;
          xcF[idx] = mult * ig * xv;
        }
    }
  }
  __syncthreads();
  const int c = cb + lane;
  float* carL = aggL + 512;
  if (!sample) {
    float* AGGP = (float*)(p.ws + W_AGG);
    float* AGGH = AGGP + 128 * 1024;
    const int chunk = mt & 31, base = mt - chunk;
    if (mode == 1) {
      float Pq[8], Hq[8];
#pragma unroll
      for (int k = 0; k < 8; k++) {
        const int q = w * 8 + k;
        const bool ok = q < chunk;
        Pq[k] = ok ? AGGP[(base + q) * 1024 + c] : 1.f;
        Hq[k] = ok ? AGGH[(base + q) * 1024 + c] : 0.f;
      }
      float Pc = 1.f, hc = 0.f;
#pragma unroll
      for (int k = 0; k < 8; k++) { hc = Pq[k] * hc + Hq[k]; Pc *= Pq[k]; }
      carL[(w * 64 + lane) * 2] = Pc;
      carL[(w * 64 + lane) * 2 + 1] = hc;
    }
    float P = 1.f, h = 0.f;
#pragma unroll 8
    for (int rr = 0; rr < 32; rr++) {
      const float av = aL[(w * 32 + rr) * XC_LD + lane], bv = xcF[(w * 32 + rr) * XC_LD + lane];
      h = av * h + bv;
      P *= av;
    }
    aggL[(w * 64 + lane) * 2] = P;
    aggL[(w * 64 + lane) * 2 + 1] = h;
    __syncthreads();
    if (mode == 0 || mode == 2) {
      if (w == 0) {
        float Pt = 1.f, ht = 0.f;
#pragma unroll
        for (int q = 0; q < 4; q++) {
          const float Pq = aggL[(q * 64 + lane) * 2], hq = aggL[(q * 64 + lane) * 2 + 1];
          ht = Pq * ht + hq;
          Pt *= Pq;
        }
        if (mode == 0) {
          AGGP[mt * 1024 + c] = Pt;
          AGGH[mt * 1024 + c] = ht;
        } else {
          __hip_atomic_store(&AGGP[mt * 1024 + c], Pt, __ATOMIC_RELAXED, __HIP_MEMORY_SCOPE_AGENT);
          __hip_atomic_store(&AGGH[mt * 1024 + c], ht, __ATOMIC_RELAXED, __HIP_MEMORY_SCOPE_AGENT);
          asm volatile("s_waitcnt vmcnt(0)" ::: "memory");
          if (lane == 0)
            __hip_atomic_store((unsigned*)(p.ws + W_FLAG) + mt * 16 + nb, 1u, __ATOMIC_RELAXED, __HIP_MEMORY_SCOPE_AGENT);
        }
      }
    }
    if (mode == 2) {
      {
        const int q = w * 8 + (lane & 7);
        const bool need = (lane < 8) && (q < chunk);
        unsigned* fp = (unsigned*)(p.ws + W_FLAG) + (base + (need ? q : 0)) * 16 + nb;
        unsigned spins = 0;
        for (;;) {
          const unsigned f = need ? __hip_atomic_load(fp, __ATOMIC_RELAXED, __HIP_MEMORY_SCOPE_AGENT) : 1u;
          if (__ballot(f == 0u) == 0ull) break;
          __builtin_amdgcn_s_sleep(2);
          if (++spins > (1u << 20)) break;
        }
      }
      float Pq[8], Hq[8];
#pragma unroll
      for (int k = 0; k < 8; k++) {
        const int q = w * 8 + k;
        const bool ok = q < chunk;
        Pq[k] = ok ? __hip_atomic_load(&AGGP[(base + q) * 1024 + c], __ATOMIC_RELAXED, __HIP_MEMORY_SCOPE_AGENT) : 1.f;
        Hq[k] = ok ? __hip_atomic_load(&AGGH[(base + q) * 1024 + c], __ATOMIC_RELAXED, __HIP_MEMORY_SCOPE_AGENT) : 0.f;
      }
      float Pc = 1.f, hc = 0.f;
#pragma unroll
      for (int k = 0; k < 8; k++) { hc = Pq[k] * hc + Hq[k]; Pc *= Pq[k]; }
      carL[(w * 64 + lane) * 2] = Pc;
      carL[(w * 64 + lane) * 2 + 1] = hc;
      __syncthreads();
    }
    if (mode == 0) {
    } else {
      float hin = 0.f;
#pragma unroll
      for (int q = 0; q < 4; q++) hin = carL[(q * 64 + lane) * 2] * hin + carL[(q * 64 + lane) * 2 + 1];
      for (int q = 0; q < w; q++) hin = aggL[(q * 64 + lane) * 2] * hin + aggL[(q * 64 + lane) * 2 + 1];
      float hh = hin;
#pragma unroll 8
      for (int rr = 0; rr < 32; rr++) {
        const int row = w * 32 + rr;
        const float av = aL[row * XC_LD + lane], bv = xcF[row * XC_LD + lane];
        hh = av * hh + bv;
        xcF[row * XC_LD + lane] = hh;
      }
      if (chunk == 31 && w == 3) p.out[O_LRUP + (size_t)(mt >> 5) * 1024 + c] = hh;
    }
  } else {
    float hh = 0.f;
    float h0v[4];
#pragma unroll
    for (int k = 0; k < 4; k++) h0v[k] = p.state_lru[(size_t)(((m0 - NP + w * 32) >> 3) + k) * 1024 + c];
#pragma unroll
    for (int rr = 0; rr < 32; rr++) {
      const int row = w * 32 + rr;
      const int bb = (m0 - NP + row) >> 3;
      const int t = row & 7;
      if (t == 0) hh = h0v[rr >> 3];
      const float av = aL[row * XC_LD + lane], bv = xcF[row * XC_LD + lane];
      hh = av * hh + bv;
      xcF[row * XC_LD + lane] = hh;
      if (t == 7) p.out[O_LRUS + (size_t)bb * 1024 + c] = hh;
    }
  }
  if (mode != 0) {
    __syncthreads();
    u16* LO = (u16*)(p.ws + W_LO);
    const int ch = tid & 7;
#pragma unroll
    for (int it = 0; it < 4; it++) {
      const int r = (tid >> 3) + it * 32;
      float g[8];
      unpack8(*(const uint4*)(ZA + (size_t)(m0 + r) * 2048 + 1024 + cb + ch * 8), g);
      const float4 h0 = *(const float4*)(xcF + r * XC_LD + ch * 8), h1 = *(const float4*)(xcF + r * XC_LD + ch * 8 + 4);
      float v[8] = {h0.x * gelu_tanh(g[0]), h0.y * gelu_tanh(g[1]), h0.z * gelu_tanh(g[2]), h0.w * gelu_tanh(g[3]),
                    h1.x * gelu_tanh(g[4]), h1.y * gelu_tanh(g[5]), h1.z * gelu_tanh(g[6]), h1.w * gelu_tanh(g[7])};
      *(uint4*)(LO + (size_t)(m0 + r) * 1024 + cb + ch * 8) = pack8(v);
    }
  }
}

template <int NW>
__device__ __forceinline__ void g3_tile(KParams& p, char* smem, int mt, int n0) {
  const int tid = opaque_tid();
  float* Cs = (float*)smem;
  const u16* LO = (const u16*)(p.ws + W_LO);
  const u16* ATT = (const u16*)(p.ws + W_XN);
  const u16* WL = (const u16*)(p.ws + W_WTLRU);
  const u16* WA = (const u16*)(p.ws + W_WTATTN);
  const u16* ZC = (const u16*)p.out;
  u16* MG = (u16*)(p.ws + W_ZA);
  constexpr int TPR = NW / 8;
  constexpr int RPI = 256 / TPR;
  const int cc = (tid % TPR) * 8;
  uint4 part[128 / RPI];
#pragma unroll
  for (int pass = 0; pass < 2; pass++) {
    f32x4 acc[4][NW / 32];
    zero_acc(acc);
    gemm_tile<NW>((pass ? ATT : LO) + (size_t)mt * 128 * 1024, 1024, (pass ? WA : WL) + (size_t)n0 * 1024, 1024, 1024, acc,
                  smem, tid);
    uint4 graw[128 / RPI];
#pragma unroll
    for (int i = 0; i < 128 / RPI; i++)
      graw[i] = *(const uint4*)(ZC + (size_t)(mt * 128 + (tid / TPR) + RPI * i) * 2048 + pass * 1024 + n0 + cc);
    __syncthreads();
    acc_to_cs(acc, Cs, tid);
    __syncthreads();
#pragma unroll
    for (int i = 0; i < 128 / RPI; i++) {
      const int r = (tid / TPR) + RPI * i;
      const size_t row = (size_t)(mt * 128 + r);
      float4 a = *(const float4*)(Cs + r * CS_LD + cc), b = *(const float4*)(Cs + r * CS_LD + cc + 4);
      float v[8] = {a.x, a.y, a.z, a.w, b.x, b.y, b.z, b.w};
      float g[8];
      unpack8(graw[i], g);
      u16* mp = MG + row * 1024 + n0 + cc;
      if (pass == 0) {
#pragma unroll
        for (int q = 0; q < 8; q++) v[q] *= sigmoidf_(g[q]);
        part[i] = pack8(v);
      } else {
        float pv[8];
        unpack8(part[i], pv);
#pragma unroll
        for (int q = 0; q < 8; q++) v[q] = pv[q] + v[q] * sigmoidf_(g[q]);
        *(uint4*)mp = pack8(v);
      }
    }
    __syncthreads();
  }
}

__device__ __forceinline__ void phase_g3(KParams& p, char* smem, int vb) {
  for (int it = blockIdx.x; it < 1024 + 128; it += gridDim.x) {
    int mt, nt;
    if (it < 1024) {
      tile_map(it, MT * 8, 8, mt, nt, vb);
      g3_tile<128>(p, smem, mt, nt * 128);
    } else {
      tile_map(1024 + ((it - 1024) >> 1), MT * 8, 8, mt, nt, vb);
      g3_tile<64>(p, smem, mt, nt * 128 + ((it - 1024) & 1) * 64);
    }
  }
}

template <int NW>
__device__ __forceinline__ void g4_tile(KParams& p, char* smem, int mt, int n0) {
  const int tid = opaque_tid();
  float* Cs = (float*)smem;
  const u16* MG = (const u16*)(p.ws + W_ZA);
  const u16* WO = (const u16*)(p.ws + W_WTOUT);
  u16* HG = (u16*)(p.ws + W_ZB);
  float* SSQ = (float*)(p.ws + W_SSQ);
  constexpr int TPR = NW / 8;
  constexpr int RPI = 256 / TPR;
  f32x4 acc[4][NW / 32];
  zero_acc(acc);
  gemm_tile<NW>(MG + (size_t)mt * 128 * 1024, 1024, WO + (size_t)n0 * 1024, 1024, 1024, acc, smem, tid);
  const int cc = (tid % TPR) * 8;
  float4 xr0[128 / RPI], xr1[128 / RPI];
#pragma unroll
  for (int i = 0; i < 128 / RPI; i++) {
    const float* xr = xrow(p, mt * 128 + (tid / TPR) + RPI * i) + n0 + cc;
    xr0[i] = *(const float4*)xr;
    xr1[i] = *(const float4*)(xr + 4);
  }
  __syncthreads();
  acc_to_cs(acc, Cs, tid);
  __syncthreads();
  const float4 g0 = *(const float4*)(p.norm2_g + n0 + cc), g1 = *(const float4*)(p.norm2_g + n0 + cc + 4);
#pragma unroll
  for (int i = 0; i < 128 / RPI; i++) {
    const int r = (tid / TPR) + RPI * i;
    const int row = mt * 128 + r;
    float4 a = *(const float4*)(Cs + r * CS_LD + cc), b = *(const float4*)(Cs + r * CS_LD + cc + 4);
    const float4 x0 = xr0[i], x1 = xr1[i];
    a.x += x0.x; a.y += x0.y; a.z += x0.z; a.w += x0.w;
    b.x += x1.x; b.y += x1.y; b.z += x1.z; b.w += x1.w;
    float* ho = p.out + O_Y + (size_t)row * 1024 + n0 + cc;
    *(float4*)ho = a;
    *(float4*)(ho + 4) = b;
    float v[8] = {a.x * g0.x, a.y * g0.y, a.z * g0.z, a.w * g0.w, b.x * g1.x, b.y * g1.y, b.z * g1.z, b.w * g1.w};
    *(uint4*)(HG + (size_t)row * 1024 + n0 + cc) = pack8(v);
    float ss = a.x * a.x + a.y * a.y + a.z * a.z + a.w * a.w + b.x * b.x + b.y * b.y + b.z * b.z + b.w * b.w;
    ss += __shfl_xor(ss, 1);
    ss += __shfl_xor(ss, 2);
    ss += __shfl_xor(ss, 4);
    if ((tid & 7) == 0) SSQ[(size_t)row * 16 + ((n0 + cc) >> 6)] = ss;
  }
  __syncthreads();
}

__device__ __forceinline__ void phase_g4(KParams& p, char* smem, int vb) {
  for (int it = blockIdx.x; it < 1024 + 128; it += gridDim.x) {
    int mt, nt;
    if (it < 1024) {
      tile_map(it, MT * 8, 8, mt, nt, vb);
      g4_tile<128>(p, smem, mt, nt * 128);
    } else {
      tile_map(1024 + ((it - 1024) >> 1), MT * 8, 8, mt, nt, vb);
      g4_tile<64>(p, smem, mt, nt * 128 + ((it - 1024) & 1) * 64);
    }
  }
}

__device__ __forceinline__ float row_rstd(const float* SSQ, int row) {
  const float4 a = *(const float4*)(SSQ + (size_t)row * 16), b = *(const float4*)(SSQ + (size_t)row * 16 + 4),
               c = *(const float4*)(SSQ + (size_t)row * 16 + 8), d = *(const float4*)(SSQ + (size_t)row * 16 + 12);
  const float ss = (((a.x + a.y) + (a.z + a.w)) + ((b.x + b.y) + (b.z + b.w))) +
                   (((c.x + c.y) + (c.z + c.w)) + ((d.x + d.y) + (d.z + d.w)));
  return rsqrtf(ss * (1.f / 1024.f) + EPS);
}

template <int NW>
__device__ __forceinline__ void g5_tile(KParams& p, char* smem, int mt, int n0) {
  const int tid = opaque_tid();
  float* Cs = (float*)smem;
  const u16* HG = (const u16*)(p.ws + W_ZB);
  const u16* WQ = (const u16*)(p.ws + W_WTQ);
  const float* SSQ = (const float*)(p.ws + W_SSQ);
  u16* QR = (u16*)(p.ws + W_ZA);
  constexpr int TPR = NW / 8;
  constexpr int RPI = 256 / TPR;
  f32x4 acc[4][NW / 32];
  zero_acc(acc);
  gemm_tile<NW>(HG + (size_t)mt * 128 * 1024, 1024, WQ + (size_t)n0 * 1024, 1024, 1024, acc, smem, tid);
  __syncthreads();
  acc_to_cs(acc, Cs, tid);
  __syncthreads();
  const int cc = (tid % TPR) * 8;
#pragma unroll
  for (int i = 0; i < 128 / RPI; i++) {
    const int r = (tid / TPR) + RPI * i;
    const int row = mt * 128 + r;
    const float rs = row_rstd(SSQ, row);
    float4 a = *(const float4*)(Cs + r * CS_LD + cc), b = *(const float4*)(Cs + r * CS_LD + cc + 4);
    float v[8] = {a.x * rs, a.y * rs, a.z * rs, a.w * rs, b.x * rs, b.y * rs, b.z * rs, b.w * rs};
    *(uint4*)(QR + (size_t)row * 2048 + n0 + cc) = pack8(v);
  }
  __syncthreads();
}

__device__ __forceinline__ void phase_g5(KParams& p, char* smem, int vb) {
  for (int it = blockIdx.x; it < 2048 + 256; it += gridDim.x) {
    int mt, nt;
    if (it < 2048) {
      tile_map(it, MT * 16, 16, mt, nt, vb);
      g5_tile<128>(p, smem, mt, nt * 128);
    } else {
      tile_map(2048 + ((it - 2048) >> 1), MT * 16, 16, mt, nt, vb);
      g5_tile<64>(p, smem, mt, nt * 128 + ((it - 2048) & 1) * 64);
    }
  }
}

__device__ __forceinline__ void phase_g6(KParams& p, char* smem, int vb) {
  const int tid = opaque_tid();
  u16* As = (u16*)smem;
  u16* Bs = As + 2 * 128 * LDT;
  float* Cs = (float*)smem;
  uint32_t* Cu = (uint32_t*)smem;
  uint32_t* TK0 = (uint32_t*)(smem + 128 * CS_LD * 4);
  const u16* QR = (const u16*)(p.ws + W_ZA);
  const u16* SK = (const u16*)(p.ws + W_SK);
  int* IDX = (int*)(p.ws + W_XN);
  float* GW = (float*)(p.ws + W_XN + (size_t)NTOK * 128 * 4);
  const int row = tid >> 1, half = tid & 1;
  for (int t = blockIdx.x; t < MT * 8; t += gridDim.x) {
    int mt, h;
    tile_map(t, MT * 8, 8, mt, h, vb);
    uint32_t tk[16];
    for (int pp = 0; pp < 2; pp++) {
      f32x4 acc[4][4];
      zero_acc(acc);
      gemm_tile<128>(QR + (size_t)mt * 128 * 2048 + h * 256 + pp * 128, 2048, SK + (size_t)(h * 2 + pp) * 16384, 128, 128, acc,
                smem, tid);
      __syncthreads();
      acc_to_cs(acc, Cs, tid);
      __syncthreads();
#pragma unroll
      for (int g = 0; g < 4; g++) {
        uint32_t sg[16];
#pragma unroll
        for (int q4 = 0; q4 < 4; q4++) {
          const int col = half * 64 + g * 16 + q4 * 4;
          const float4 v = *(const float4*)(Cs + row * CS_LD + col);
          sg[q4 * 4 + 0] = (ordf(v.x) & ~0x7Fu) | (uint32_t)(127 - col);
          sg[q4 * 4 + 1] = (ordf(v.y) & ~0x7Fu) | (uint32_t)(126 - col);
          sg[q4 * 4 + 2] = (ordf(v.z) & ~0x7Fu) | (uint32_t)(125 - col);
          sg[q4 * 4 + 3] = (ordf(v.w) & ~0x7Fu) | (uint32_t)(124 - col);
        }
        sort16_desc(sg);
        if (g == 0) {
#pragma unroll
          for (int q = 0; q < 16; q++) tk[q] = sg[q];
        } else {
          merge16_desc(tk, sg);
        }
      }
      __syncthreads();
      if (half == 1) {
#pragma unroll
        for (int q = 0; q < 16; q++) Cu[row * 16 + q] = tk[q];
      }
      __syncthreads();
      if (half == 0) {
        {
          uint32_t sg[16];
#pragma unroll
          for (int q4 = 0; q4 < 4; q4++) {
            const uint4 u = *(const uint4*)(Cu + row * 16 + q4 * 4);
            sg[q4 * 4] = u.x; sg[q4 * 4 + 1] = u.y; sg[q4 * 4 + 2] = u.z; sg[q4 * 4 + 3] = u.w;
          }
          merge16_desc(tk, sg);
        }
        if (pp == 0) {
#pragma unroll
          for (int q = 0; q < 16; q++) TK0[row * 16 + q] = tk[q];
        } else {
#pragma unroll
          for (int q = 0; q < 16; q++) Cu[2048 + row * 16 + q] = tk[q];
        }
      }
      __syncthreads();
    }
    if (half == 0) {
      float va[16], vb[16];
#pragma unroll
      for (int q = 0; q < 16; q++) {
        va[q] = unordf(TK0[row * 16 + q] & ~0x7Fu);
        vb[q] = unordf(tk[q] & ~0x7Fu);
      }
      uint32_t cd[16];
#pragma unroll
      for (int q = 0; q < 16; q++) cd[q] = (ordf(va[0] + vb[q]) & ~0xFFu) | (uint32_t)(255 - q);
#pragma unroll
      for (int i = 1; i < 16; i++) {
#pragma unroll
        for (int j = 0; j < 16; j++) {
          if ((i + 1) * (j + 1) <= 16) {
            const float sv = va[i] + vb[j];
            const uint32_t key = (ordf(sv) & ~0xFFu) | (uint32_t)(255 - (i * 16 + j));
            INS16(cd, key);
          }
        }
      }
      float ev[16];
      const float m0v = unordf(cd[0] & ~0xFFu);
      float esum = 0.f;
#pragma unroll
      for (int q = 0; q < 16; q++) {
        ev[q] = __expf(unordf(cd[q] & ~0xFFu) - m0v);
        esum += ev[q];
      }
      const float inv = 1.f / esum;
      const size_t ob = (size_t)(mt * 128 + row) * 128 + h * 16;
#pragma unroll
      for (int q = 0; q < 16; q++) {
        const int ij = 255 - (int)(cd[q] & 0xFFu);
        const int i0 = 127 - (int)(TK0[row * 16 + (ij >> 4)] & 0x7Fu);
        const int i1 = 127 - (int)(Cu[2048 + row * 16 + (ij & 15)] & 0x7Fu);
        IDX[ob + q] = i0 * 128 + i1;
        GW[ob + q] = ev[q] * inv;
      }
    }
    __syncthreads();
  }
}

typedef __attribute__((ext_vector_type(2))) float f32x2;
__device__ __forceinline__ void dec16(uint4 u, float* v) {
  f32x2 t;
  t = __builtin_amdgcn_cvt_pk_f32_fp8((int)u.x, false); v[0] = t.x; v[1] = t.y;
  t = __builtin_amdgcn_cvt_pk_f32_fp8((int)u.x, true); v[2] = t.x; v[3] = t.y;
  t = __builtin_amdgcn_cvt_pk_f32_fp8((int)u.y, false); v[4] = t.x; v[5] = t.y;
  t = __builtin_amdgcn_cvt_pk_f32_fp8((int)u.y, true); v[6] = t.x; v[7] = t.y;
  t = __builtin_amdgcn_cvt_pk_f32_fp8((int)u.z, false); v[8] = t.x; v[9] = t.y;
  t = __builtin_amdgcn_cvt_pk_f32_fp8((int)u.z, true); v[10] = t.x; v[11] = t.y;
  t = __builtin_amdgcn_cvt_pk_f32_fp8((int)u.w, false); v[12] = t.x; v[13] = t.y;
  t = __builtin_amdgcn_cvt_pk_f32_fp8((int)u.w, true); v[14] = t.x; v[15] = t.y;
}

__device__ __forceinline__ void phase7(KParams& p) {
  const int tid = opaque_tid(), lane = tid & 63, w = tid >> 6;
  const u16* HG = (const u16*)(p.ws + W_ZB);
  const float* SSQ = (const float*)(p.ws + W_SSQ);
  const int* IDX = (const int*)(p.ws + W_XN);
  const float* GW = (const float*)(p.ws + W_XN + (size_t)NTOK * 128 * 4);
  const unsigned char* EU = (const unsigned char*)(p.ws + W_EU);
  const unsigned char* EV = (const unsigned char*)(p.ws + W_EV);
  const float* ESC = (const float*)(p.ws + W_ESC);
  const int b0 = lane & 1, b1 = (lane >> 1) & 1, b2 = (lane >> 2) & 1;
  const int nwv = gridDim.x * 4;
  int tok = blockIdx.x * 4 + w;
  uint4 nh0 = make_uint4(0u, 0u, 0u, 0u), nh1 = nh0;
  float nrs = 0.f, ngwA = 0.f, ngwB = 0.f;
  int niA = 0, niB = 0;
  if (tok < NTOK) {
    const uint4* hp = (const uint4*)(HG + (size_t)tok * 1024 + lane * 16);
    nh0 = hp[0]; nh1 = hp[1];
    nrs = row_rstd(SSQ, tok);
    niA = IDX[(size_t)tok * 128 + lane]; niB = IDX[(size_t)tok * 128 + 64 + lane];
    ngwA = GW[(size_t)tok * 128 + lane]; ngwB = GW[(size_t)tok * 128 + 64 + lane];
  }
#pragma unroll 1
  for (; tok < NTOK; tok += nwv) {
    const float rs = nrs;
    const int iA = niA, iB = niB;
    const float gwA = ngwA, gwB = ngwB;
    float xh[16];
    unpack8(nh0, xh);
    unpack8(nh1, xh + 8);
#pragma unroll
    for (int i = 0; i < 16; i++) xh[i] *= rs;
    {
      const int nt2 = tok + nwv;
      if (nt2 < NTOK) {
        const uint4* hp = (const uint4*)(HG + (size_t)nt2 * 1024 + lane * 16);
        nh0 = hp[0]; nh1 = hp[1];
        nrs = row_rstd(SSQ, nt2);
        niA = IDX[(size_t)nt2 * 128 + lane]; niB = IDX[(size_t)nt2 * 128 + 64 + lane];
        ngwA = GW[(size_t)nt2 * 128 + lane]; ngwB = GW[(size_t)nt2 * 128 + 64 + lane];
      }
    }
    const float gA = gwA * ESC[16384 + iA], gB = gwB * ESC[16384 + iB];
    const float suA = ESC[iA], suB = ESC[iB];
    float dA = 0.f, dB = 0.f;
#pragma unroll 2
    for (int bb = 0; bb < 16; bb++) {
      const int isrc = bb < 8 ? iA : iB;
      float d[8];
      uint4 ur[8];
#pragma unroll
      for (int k = 0; k < 8; k++) {
        const int id = __builtin_amdgcn_readlane(isrc, (bb & 7) * 8 + k);
        ur[k] = *(const uint4*)(EU + (size_t)id * 1024 + lane * 16);
      }
#pragma unroll
      for (int k = 0; k < 8; k++) {
        float uv[16];
        dec16(ur[k], uv);
        float sacc = 0.f;
#pragma unroll
        for (int i = 0; i < 16; i++) sacc += xh[i] * uv[i];
        d[k] = sacc;
      }
      float e4[4], e2[2], e1;
#pragma unroll
      for (int i = 0; i < 4; i++) {
        const float keep = b0 ? d[2 * i + 1] : d[2 * i];
        const float send = b0 ? d[2 * i] : d[2 * i + 1];
        e4[i] = keep + __shfl_xor(send, 1);
      }
#pragma unroll
      for (int i = 0; i < 2; i++) {
        const float keep = b1 ? e4[2 * i + 1] : e4[2 * i];
        const float send = b1 ? e4[2 * i] : e4[2 * i + 1];
        e2[i] = keep + __shfl_xor(send, 2);
      }
      {
        const float keep = b2 ? e2[1] : e2[0];
        const float send = b2 ? e2[0] : e2[1];
        e1 = keep + __shfl_xor(send, 4);
      }
      e1 += __shfl_xor(e1, 8);
      e1 += __shfl_xor(e1, 16);
      e1 += __shfl_xor(e1, 32);
      const bool mine = (lane >> 3) == (bb & 7);
      if (bb < 8) dA = mine ? e1 : dA; else dB = mine ? e1 : dB;
    }
    const float actA = gelu_tanh(dA * suA) * gA, actB = gelu_tanh(dB * suB) * gB;
    float* ACT = (float*)(p.ws + W_ACT);
    __hip_atomic_store(&ACT[(size_t)tok * 128 + lane], actA, __ATOMIC_RELAXED, __HIP_MEMORY_SCOPE_AGENT);
    __hip_atomic_store(&ACT[(size_t)tok * 128 + 64 + lane], actB, __ATOMIC_RELAXED, __HIP_MEMORY_SCOPE_AGENT);
    asm volatile("s_waitcnt vmcnt(0)" ::: "memory");
    if (lane == 0) __hip_atomic_fetch_add((unsigned*)(p.ws + W_CNT) + (tok >> 3), 1u, __ATOMIC_RELAXED, __HIP_MEMORY_SCOPE_AGENT);
  }
}

__device__ __forceinline__ void phase7b(KParams& p) {
  const int tid = opaque_tid(), lane = tid & 63;
  const char* IDXb = (const char*)(p.ws + W_XN);
  const char* ACTb = (const char*)(p.ws + W_ACT);
  const char* EVb = (const char*)(p.ws + W_EV);
  char* Yb = (char*)(p.out + O_Y);
  unsigned* Q = (unsigned*)(p.ws + W_Q);
  const int esub = lane >> 3, c = lane & 7;
  const int pref = (int)(hw_xcc_id() & 7u);
  const int b3 = (lane >> 3) & 1, b4 = (lane >> 4) & 1, b5 = (lane >> 5) & 1;
  const uint32_t lane4 = (uint32_t)lane * 4u;
  const uint32_t yl = (uint32_t)(c * 16 + b3 * 8 + b4 * 4 + b5 * 2) * 4u;
  for (int k = 0; k < 8; k++) {
    const int sl = (pref + k) & 7;
    const char* Vs = EVb + (size_t)sl * (16384 * 128);
    const uint32_t vl = (uint32_t)c * 16u;
    for (;;) {
      unsigned it = 0;
      if (lane == 0) it = atomicAdd(Q + sl * 64, 1u);
      it = (unsigned)__builtin_amdgcn_readfirstlane((int)it);
      if (it >= (unsigned)(NTOK / 8)) break;
      const int tok0 = (int)it * 8;
      {
        unsigned* cp = (unsigned*)(p.ws + W_CNT) + it;
        unsigned spins = 0;
        while ((unsigned)__builtin_amdgcn_readfirstlane((int)__hip_atomic_load(cp, __ATOMIC_RELAXED, __HIP_MEMORY_SCOPE_AGENT)) < 8u) {
          __builtin_amdgcn_s_sleep(2);
          if (++spins > (1u << 20)) break;
        }
      }
      const char* ib = IDXb + (size_t)tok0 * 512;
      const char* ab = ACTb + (size_t)tok0 * 512;
      char* yb = Yb + (size_t)tok0 * 4096 + sl * 512;
      int nidA = *(const int*)(ib + lane4), nidB = *(const int*)(ib + 256 + lane4);
      float nacA = __hip_atomic_load((const float*)(ab + lane4), __ATOMIC_RELAXED, __HIP_MEMORY_SCOPE_AGENT), nacB = __hip_atomic_load((const float*)(ab + 256 + lane4), __ATOMIC_RELAXED, __HIP_MEMORY_SCOPE_AGENT);
      float2 nyv = *(const float2*)(yb + yl);
#pragma unroll 1
      for (int t = 0; t < 8; t++) {
        const int idA = nidA, idB = nidB;
        const float acA = nacA, acB = nacB;
        const float2 yv = nyv;
        char* ybt = yb;
        if (t < 7) {
          ib += 512; ab += 512; yb += 4096;
          nidA = *(const int*)(ib + lane4); nidB = *(const int*)(ib + 256 + lane4);
          nacA = __hip_atomic_load((const float*)(ab + lane4), __ATOMIC_RELAXED, __HIP_MEMORY_SCOPE_AGENT); nacB = __hip_atomic_load((const float*)(ab + 256 + lane4), __ATOMIC_RELAXED, __HIP_MEMORY_SCOPE_AGENT);
          nyv = *(const float2*)(yb + yl);
        }
        float o[16];
#pragma unroll
        for (int q = 0; q < 16; q++) o[q] = 0.f;
#pragma unroll
        for (int hf = 0; hf < 2; hf++) {
          uint4 vr[8];
#pragma unroll
          for (int i = 0; i < 8; i++) {
            const uint32_t id = (uint32_t)__shfl(hf ? idB : idA, i * 8 + esub);
            vr[i] = *(const uint4*)(Vs + (id * 128u + vl));
          }
#pragma unroll
          for (int i = 0; i < 8; i++) {
            float vv[16];
            dec16(vr[i], vv);
            const float a = __shfl(hf ? acB : acA, i * 8 + esub);
#pragma unroll
            for (int q = 0; q < 16; q++) o[q] += a * vv[q];
          }
        }
        float r8[8], r4[4], r2[2];
#pragma unroll
        for (int q = 0; q < 8; q++) {
          const float keep = b3 ? o[q + 8] : o[q];
          const float send = b3 ? o[q] : o[q + 8];
          r8[q] = keep + __shfl_xor(send, 8);
        }
#pragma unroll
        for (int q = 0; q < 4; q++) {
          const float keep = b4 ? r8[q + 4] : r8[q];
          const float send = b4 ? r8[q] : r8[q + 4];
          r4[q] = keep + __shfl_xor(send, 16);
        }
#pragma unroll
        for (int q = 0; q < 2; q++) {
          const float keep = b5 ? r4[q + 2] : r4[q];
          const float send = b5 ? r4[q] : r4[q + 2];
          r2[q] = keep + __shfl_xor(send, 32);
        }
        float2 h = yv;
        h.x += r2[0];
        h.y += r2[1];
        *(float2*)(ybt + yl) = h;
      }
    }
  }
}

#define XB_TMO      128
#define XB_XCNT(j)  (256  + 64 * (j))
#define XB_XSUB(j)  (1280 + 64 * (j))
#define XB_XGEN(j)  (2304 + 64 * (j))
#define XB_TOP      3328
#define XB_TOPGEN   3392
#define XCD_BAR_WORDS 3456
#define XB_SPIN_CAP (1u << 18)
#define LAS __attribute__((address_space(3)))
__device__ __forceinline__ unsigned xb_ld(unsigned* p) { return __hip_atomic_load(p, __ATOMIC_RELAXED, __HIP_MEMORY_SCOPE_AGENT); }
__device__ __forceinline__ unsigned xb_add(unsigned* p, unsigned v) { return __hip_atomic_fetch_add(p, v, __ATOMIC_RELAXED, __HIP_MEMORY_SCOPE_AGENT); }
__device__ __forceinline__ unsigned xb_xcc_id() { return (unsigned)__builtin_amdgcn_s_getreg((3 << 11) | 20) & 0xFu; }
#define XB_SPIN(cond, bar) do { unsigned _sp = 0; while (cond) { __builtin_amdgcn_s_sleep(1); \
    if ((++_sp & 255u) == 0u) { if (xb_ld(&(bar)[XB_TMO])) break; if (_sp > XB_SPIN_CAP) { atomicAdd(&(bar)[XB_TMO], 1u); break; } } } } while (0)
struct XcdBarrier { unsigned* bar; unsigned x; volatile LAS unsigned* st; };
__device__ __forceinline__ XcdBarrier xcd_barrier_post(unsigned* bar, volatile LAS unsigned* st) {
  XcdBarrier b; b.bar = bar; b.x = xb_xcc_id(); b.st = st;
  if (threadIdx.x == 0) st[2] = xb_add(&bar[XB_XCNT(b.x)], 1u);
  return b;
}
__device__ __forceinline__ void xcd_barrier_complete(unsigned* bar, unsigned x, unsigned& nloc, unsigned& nx) {
  const unsigned G = gridDim.x * gridDim.y * gridDim.z;
  unsigned sum, cnt, mine, sp = 0u;
  for (;;) {
    sum = 0u; cnt = 0u; mine = 0u;
#pragma unroll
    for (unsigned j = 0; j < 16; ++j) { const unsigned c = xb_ld(&bar[XB_XCNT(j)]); sum += c; cnt += (c > 0u) ? 1u : 0u; mine = (j == x) ? c : mine; }
    if (sum == G) break;
    __builtin_amdgcn_s_sleep(1);
    if ((++sp & 255u) == 0u) { if (xb_ld(&bar[XB_TMO])) break; if (sp > XB_SPIN_CAP) { atomicAdd(&bar[XB_TMO], 1u); break; } }
  }
  nloc = mine > 0u ? mine : 1u; nx = cnt > 0u ? cnt : 1u;
}
__device__ __forceinline__ void xcd_barrier(const XcdBarrier& b) {
  asm volatile("s_waitcnt vmcnt(0)" ::: "memory");
  __syncthreads();
  if (threadIdx.x == 0) {
    unsigned* bar = b.bar;
    __builtin_amdgcn_s_waitcnt(0);
    unsigned nloc = b.st[0], nx = b.st[1];
    if (nloc == 0u) { xcd_barrier_complete(bar, b.x, nloc, nx); b.st[0] = nloc; b.st[1] = nx; }
    const unsigned old = xb_add(&bar[XB_XSUB(b.x)], 1u);
    const unsigned gen = old / nloc;
    if (old + 1u == (gen + 1u) * nloc) {
      __builtin_amdgcn_fence(__ATOMIC_RELEASE, "agent");
      asm volatile("s_waitcnt vmcnt(0)" ::: "memory");
      const unsigned og = xb_add(&bar[XB_TOP], 1u);
      const unsigned tg = og / nx;
      if (og + 1u == (tg + 1u) * nx) xb_add(&bar[XB_TOPGEN], 1u);
      else XB_SPIN(xb_ld(&bar[XB_TOPGEN]) == tg, bar);
      __builtin_amdgcn_fence(__ATOMIC_ACQUIRE, "agent");
      xb_add(&bar[XB_XGEN(b.x)], 1u);
      asm volatile("s_waitcnt vmcnt(0)" ::: "memory");
    } else {
      XB_SPIN(xb_ld(&bar[XB_XGEN(b.x)]) == gen, bar);
      __builtin_amdgcn_fence(__ATOMIC_ACQUIRE, "agent");
      asm volatile("s_waitcnt vmcnt(0)" ::: "memory");
    }
  }
  __syncthreads();
}

#ifndef REP_MASK
#define REP_MASK 0
#endif
#define REPS(k) for (int _rep = 0; _rep < (((REP_MASK) >> (k)) & 1) + 1; _rep++)
__global__ void __launch_bounds__(256, 2) fwd_megakernel(Params p_) {
  extern __shared__ __attribute__((aligned(16))) char smem[];
  cg::grid_group grid = cg::this_grid();
  if (p_.ws == nullptr) grid.sync();
  volatile LAS unsigned* xst = (volatile LAS unsigned*)(smem + SMEM_BYTES - 16);
  if (threadIdx.x == 0) { xst[0] = 0u; xst[1] = 0u; xst[2] = 0u; xst[3] = 0u; }
  __syncthreads();
  const XcdBarrier xb = xcd_barrier_post((unsigned*)(p_.ws + W_BAR), xst);
  REPS(0) { phase0(*fresh_params(), smem); xcd_barrier(xb); }
  if (threadIdx.x == 0) {
    unsigned* bar = (unsigned*)(p_.ws + W_BAR);
    const unsigned per = gridDim.x >> 3;
    bool uni = (gridDim.x & 7u) == 0u;
    for (unsigned j = 0; j < 16; ++j) { const unsigned cnt = xb_ld(&bar[XB_XCNT(j)]); if (cnt != (j < 8 ? per : 0u)) uni = false; }
    xst[3] = uni ? (xb.x * per + xst[2]) : blockIdx.x;
  }
  __syncthreads();
  const int vb = (int)xst[3];
  REPS(1) { phase_g1(*fresh_params(), smem, vb); xcd_barrier(xb); }
  REPS(2) {
    for (int it = blockIdx.x; it < MT * 16 + 1536; it += gridDim.x) {
      if (it < MT * 16) { const int mt = it >> 4; lru_tile(*fresh_params(), smem, mt, it & 15, mt < 128 ? 2 : 1); }
      else attn_item(*fresh_params(), smem, it - MT * 16);
    }
    xcd_barrier(xb);
  }
  REPS(4) { phase_g3(*fresh_params(), smem, vb); xcd_barrier(xb); }
  REPS(5) { phase_g4(*fresh_params(), smem, vb); xcd_barrier(xb); }
  REPS(6) { phase_g5(*fresh_params(), smem, vb); xcd_barrier(xb); }
  REPS(7) { phase_g6(*fresh_params(), smem, vb); xcd_barrier(xb); }
  phase7(*fresh_params());
  phase7b(*fresh_params());
}

extern "C" void kernel_launch(void* const* d_in, const int* in_sizes, int n_in, void* d_out, int out_size, void* d_ws,
                              size_t ws_size, hipStream_t stream) {
  static int grid_blocks = 0;
  if (!grid_blocks) {
    int dev = 0, cus = 0, per_cu = 0;
    hipGetDevice(&dev);
    hipDeviceGetAttribute(&cus, hipDeviceAttributeMultiprocessorCount, dev);
    hipFuncSetAttribute((const void*)fwd_megakernel, hipFuncAttributeMaxDynamicSharedMemorySize, SMEM_BYTES);
    hipOccupancyMaxActiveBlocksPerMultiprocessor(&per_cu, fwd_megakernel, 256, SMEM_BYTES);
    if (per_cu < 1) per_cu = 1;
    grid_blocks = cus * per_cu;
  }
  Params p{};
  const float** pp = (const float**)&p;
  for (int i = 0; i < 26; i++) pp[i] = (const float*)d_in[i];
  p.out = (float*)d_out;
  p.ws = (char*)d_ws;
  (void)hipMemsetAsync((char*)d_ws + W_BAR, 0, (size_t)3456 * 4 + 8 * 256 + 2048 * 4 + 2176 * 4, stream);
  void* args[] = {&p};
  hipError_t e = hipLaunchCooperativeKernel((void*)fwd_megakernel, dim3(grid_blocks), dim3(256), args, SMEM_BYTES, stream);
  if (e != hipSuccess) fprintf(stderr, "cooperative launch failed: %s (grid %d)\n", hipGetErrorString(e), grid_blocks);
}
```

```cpp
#include <hip/hip_runtime.h>
#include <hip/hip_cooperative_groups.h>
#include <stdint.h>
#include <cstdio>
namespace cg = cooperative_groups;

typedef unsigned short u16;
typedef __attribute__((ext_vector_type(8))) short bf16x8;
typedef __attribute__((ext_vector_type(4))) float f32x4;

constexpr int D = 1024;
constexpr int NP = 16384;
constexpr int NTOK = 17408;
constexpr int SEQ = 4096;
constexpr int MT = 136;
constexpr float EPS = 1e-6f;

constexpr size_t O_Y = 0;
constexpr size_t O_CONVP = 17825792;
constexpr size_t O_LRUP = O_CONVP + 12288;
constexpr size_t O_KP = O_LRUP + 4096;
constexpr size_t O_VP = O_KP + 131072;
constexpr size_t O_CONVS = O_VP + 131072;
constexpr size_t O_LRUS = O_CONVS + 393216;
constexpr size_t O_KS = O_LRUS + 131072;
constexpr size_t O_VS = O_KS + 4194304;

constexpr size_t W_WTIN = 0;
constexpr size_t W_WTLRU = W_WTIN + (size_t)5632 * 1024 * 2;
constexpr size_t W_WTATTN = W_WTLRU + (size_t)1024 * 1024 * 2;
constexpr size_t W_WTOUT = W_WTATTN + (size_t)1024 * 1024 * 2;
constexpr size_t W_WTQ = W_WTOUT + (size_t)1024 * 1024 * 2;
constexpr size_t W_SK = W_WTQ + (size_t)2048 * 1024 * 2;
constexpr size_t W_RGA = W_SK + (size_t)16 * 128 * 128 * 2;
constexpr size_t W_RGX = W_RGA + (size_t)65536 * 2;
constexpr size_t W_EU = W_RGX + (size_t)65536 * 2;
constexpr size_t W_EV = W_EU + (size_t)16384 * 1024;
constexpr size_t W_ESC = W_EV + (size_t)16384 * 1024;
constexpr size_t W_XN = W_ESC + (size_t)32768 * 4;
constexpr size_t W_ZA = W_XN + (size_t)NTOK * 1024 * 2;
constexpr size_t W_ZB = W_ZA + (size_t)NTOK * 2048 * 2;
constexpr size_t W_AGG = W_ZB + (size_t)NTOK * 1536 * 2;
constexpr size_t W_SSQ = W_AGG + (size_t)128 * 1024 * 2 * 4;
constexpr size_t W_BAR = W_SSQ + (size_t)NTOK * 16 * 4;
constexpr size_t W_Q = W_BAR + (size_t)3456 * 4;
constexpr size_t W_FLAG = W_Q + (size_t)8 * 256;
constexpr size_t W_CNT = W_FLAG + (size_t)2048 * 4;
constexpr size_t W_ACT = W_CNT + (size_t)2176 * 4;
constexpr size_t W_LO = W_ACT + (size_t)NTOK * 128 * 4;
constexpr size_t W_END = W_LO + (size_t)NTOK * 1024 * 2;

constexpr int SMEM_BYTES = 81920;

struct Params {
  const float *x_prompt, *x_sample, *cache_conv, *state_lru, *cache_k, *cache_v, *norm1_g, *w_in, *conv_w,
      *conv_b, *rg_w_a, *rg_b_a, *rg_w_x, *rg_b_x, *rg_lambda, *q_norm_g, *k_norm_g, *attn_sinks,
      *w_branch_lru, *w_branch_attn, *w_out, *norm2_g, *peer_w_query, *peer_sub_keys, *expert_u, *expert_v;
  float* out;
  char* ws;
};

typedef const __attribute__((address_space(4))) Params KParams;
__device__ __forceinline__ KParams* fresh_params() {
  unsigned long long k = (unsigned long long)__builtin_amdgcn_kernarg_segment_ptr();
  asm volatile("" : "+s"(k));
  return (KParams*)k;
}
__device__ __forceinline__ u16 f2bf(float f) {
  uint32_t u = __float_as_uint(f);
  u += 0x7FFFu + ((u >> 16) & 1u);
  return (u16)(u >> 16);
}
__device__ __forceinline__ float bf2f(u16 h) { return __uint_as_float(((uint32_t)h) << 16); }
__device__ __forceinline__ uint32_t pack2(float a, float b) {
  uint32_t r;
  asm("v_cvt_pk_bf16_f32 %0, %1, %2" : "=v"(r) : "v"(a), "v"(b));
  return r;
}
__device__ __forceinline__ uint4 pack8(const float* v) {
  uint4 o;
  o.x = pack2(v[0], v[1]); o.y = pack2(v[2], v[3]); o.z = pack2(v[4], v[5]); o.w = pack2(v[6], v[7]);
  return o;
}
__device__ __forceinline__ void unpack8(uint4 u, float* v) {
  v[0] = __uint_as_float(u.x << 16); v[1] = __uint_as_float(u.x & 0xFFFF0000u);
  v[2] = __uint_as_float(u.y << 16); v[3] = __uint_as_float(u.y & 0xFFFF0000u);
  v[4] = __uint_as_float(u.z << 16); v[5] = __uint_as_float(u.z & 0xFFFF0000u);
  v[6] = __uint_as_float(u.w << 16); v[7] = __uint_as_float(u.w & 0xFFFF0000u);
}
__device__ __forceinline__ float sigmoidf_(float x) { return __builtin_amdgcn_rcpf(1.f + __expf(-x)); }
__device__ __forceinline__ float gelu_tanh(float x) {
  float y = 0.7978845608028654f * (x + 0.044715f * x * x * x);
  float t = 1.f - 2.f * __builtin_amdgcn_rcpf(__expf(2.f * y) + 1.f);
  return 0.5f * x * (1.f + t);
}
__device__ __forceinline__ uint32_t ordf(float f) {
  uint32_t u = __float_as_uint(f);
  return (u & 0x80000000u) ? ~u : (u | 0x80000000u);
}
__device__ __forceinline__ float unordf(uint32_t o) {
  uint32_t u = (o & 0x80000000u) ? (o ^ 0x80000000u) : ~o;
  return __uint_as_float(u);
}
__device__ __forceinline__ unsigned hw_xcc_id() { return (unsigned)__builtin_amdgcn_s_getreg((3 << 11) | 20) & 0xFu; }
__device__ __forceinline__ int opaque_tid() {
  int t = threadIdx.x;
  asm volatile("" : "+v"(t));
  return t;
}
__device__ __forceinline__ const float* xrow(KParams& p, int row) {
  return row < NP ? p.x_prompt + (size_t)row * D : p.x_sample + (size_t)(row - NP) * D;
}

#define INS16(T, V)                                  \
  {                                                  \
    uint32_t _v = (V);                               \
    _Pragma("unroll") for (int _q = 0; _q < 16; _q++) { \
      uint32_t _hi = max(T[_q], _v);                 \
      _v = min(T[_q], _v);                           \
      T[_q] = _hi;                                   \
    }                                                \
  }

#define CE_DESC(A_, B_) { const uint32_t _h = max(A_, B_), _l = min(A_, B_); A_ = _h; B_ = _l; }
__device__ __forceinline__ void sort16_desc(uint32_t (&t)[16]) {
#pragma unroll
  for (int k = 2; k <= 16; k <<= 1) {
#pragma unroll
    for (int j = k >> 1; j > 0; j >>= 1) {
#pragma unroll
      for (int i = 0; i < 16; i++) {
        const int l = i ^ j;
        if (l > i) {
          if ((i & k) == 0) { CE_DESC(t[i], t[l]); } else { CE_DESC(t[l], t[i]); }
        }
      }
    }
  }
}
__device__ __forceinline__ void merge16_desc(uint32_t (&T)[16], const uint32_t (&S)[16]) {
#pragma unroll
  for (int i = 0; i < 16; i++) T[i] = max(T[i], S[15 - i]);
#pragma unroll
  for (int j = 8; j > 0; j >>= 1) {
#pragma unroll
    for (int i = 0; i < 16; i++) {
      const int l = i ^ j;
      if (l > i) { CE_DESC(T[i], T[l]); }
    }
  }
}

__device__ __forceinline__ void transpose_cvt(const float* __restrict__ W, u16* __restrict__ Wt, int K, int N,
                                              size_t gtid, size_t gsz) {
  size_t total = (size_t)N * (K / 8);
  for (size_t c = gtid; c < total; c += gsz) {
    int n = (int)(c % N);
    int kg = (int)(c / N);
    float v[8];
#pragma unroll
    for (int i = 0; i < 8; i++) v[i] = W[(size_t)(kg * 8 + i) * N + n];
    *(uint4*)(Wt + (size_t)n * K + kg * 8) = pack8(v);
  }
}
__device__ __forceinline__ void plain_cvt(const float* __restrict__ S, u16* __restrict__ Dst, size_t n, size_t gtid,
                                          size_t gsz) {
  size_t total = n / 8;
  const float4* s4 = (const float4*)S;
  for (size_t c = gtid; c < total; c += gsz) {
    float4 a = s4[2 * c], b = s4[2 * c + 1];
    float v[8] = {a.x, a.y, a.z, a.w, b.x, b.y, b.z, b.w};
    *(uint4*)(Dst + c * 8) = pack8(v);
  }
}

__device__ __forceinline__ void phase0(KParams& p, char* smem) {
  const int tid = opaque_tid();
  const size_t gtid = (size_t)blockIdx.x * 256 + tid, gsz = (size_t)gridDim.x * 256;
  char* ws = p.ws;
  {
    const int lane = tid & 63;
    const int gw = (int)(gtid >> 6), nw = (int)(gsz >> 6);
    u16* XN = (u16*)(ws + W_XN);
    for (int row = gw; row < NTOK; row += nw) {
      const float4* xr = (const float4*)xrow(p, row);
      float4 v[4];
      float ss = 0.f;
#pragma unroll
      for (int i = 0; i < 4; i++) {
        v[i] = xr[lane + i * 64];
        ss += v[i].x * v[i].x + v[i].y * v[i].y + v[i].z * v[i].z + v[i].w * v[i].w;
      }
#pragma unroll
      for (int o = 32; o > 0; o >>= 1) ss += __shfl_xor(ss, o);
      float rstd = rsqrtf(ss * (1.f / 1024.f) + EPS);
      const float4* g4 = (const float4*)p.norm1_g;
#pragma unroll
      for (int i = 0; i < 4; i++) {
        float4 g = g4[lane + i * 64];
        uint2 o;
        o.x = pack2(v[i].x * rstd * g.x, v[i].y * rstd * g.y);
        o.y = pack2(v[i].z * rstd * g.z, v[i].w * rstd * g.w);
        *(uint2*)(XN + (size_t)row * D + (lane + i * 64) * 4) = o;
      }
    }
  }
  {
    float* T = (float*)smem;
    for (int tile = blockIdx.x; tile < 2688; tile += gridDim.x) {
      const float* W;
      u16* Wt;
      int N, tl;
      if (tile < 1408) { W = p.w_in; Wt = (u16*)(ws + W_WTIN); N = 5632; tl = tile; }
      else if (tile < 1664) { W = p.w_branch_lru; Wt = (u16*)(ws + W_WTLRU); N = 1024; tl = tile - 1408; }
      else if (tile < 1920) { W = p.w_branch_attn; Wt = (u16*)(ws + W_WTATTN); N = 1024; tl = tile - 1664; }
      else if (tile < 2176) { W = p.w_out; Wt = (u16*)(ws + W_WTOUT); N = 1024; tl = tile - 1920; }
      else { W = p.peer_w_query; Wt = (u16*)(ws + W_WTQ); N = 2048; tl = tile - 2176; }
      const int ntn = N >> 6;
      const int kt = tl / ntn, nt = tl - kt * ntn;
      __syncthreads();
      {
        const float* src = W + (size_t)(kt * 64 + (tid >> 2)) * N + nt * 64 + (tid & 3) * 16;
        const float4 a0 = *(const float4*)src, a1 = *(const float4*)(src + 4), a2 = *(const float4*)(src + 8),
                     a3 = *(const float4*)(src + 12);
        float* d = T + (tid >> 2) * 65 + (tid & 3) * 16;
        d[0] = a0.x; d[1] = a0.y; d[2] = a0.z; d[3] = a0.w; d[4] = a1.x; d[5] = a1.y; d[6] = a1.z; d[7] = a1.w;
        d[8] = a2.x; d[9] = a2.y; d[10] = a2.z; d[11] = a2.w; d[12] = a3.x; d[13] = a3.y; d[14] = a3.z; d[15] = a3.w;
      }
      __syncthreads();
      {
        const int n = tid >> 2, kc = (tid & 3) * 16;
        float v[16];
#pragma unroll
        for (int i = 0; i < 16; i++) v[i] = T[(kc + i) * 65 + n];
        u16* dst = Wt + (size_t)(nt * 64 + n) * 1024 + kt * 64 + kc;
        *(uint4*)dst = pack8(v);
        *(uint4*)(dst + 8) = pack8(v + 8);
      }
    }
  }
  {
    u16* RA = (u16*)(ws + W_RGA);
    u16* RX = (u16*)(ws + W_RGX);
    for (size_t e = gtid; e < 65536; e += gsz) {
      int n = (int)(e >> 12), k = (int)((e >> 6) & 63), j = (int)(e & 63);
      RA[e] = f2bf(p.rg_w_a[n * 4096 + j * 64 + k]);
      RX[e] = f2bf(p.rg_w_x[n * 4096 + j * 64 + k]);
    }
  }
  plain_cvt(p.peer_sub_keys, (u16*)(ws + W_SK), (size_t)16 * 128 * 128, gtid, gsz);
  {
    const int lane = tid & 63;
    const int gw = (int)(gtid >> 6), nw = (int)(gsz >> 6);
    unsigned char* E8 = (unsigned char*)(ws + W_EU);
    float* ESC = (float*)(ws + W_ESC);
    for (int r = gw; r < 32768; r += nw) {
      const float* src = (r < 16384 ? p.expert_u : p.expert_v) + (size_t)(r & 16383) * 1024 + lane * 16;
      const float4 a0 = *(const float4*)src, a1 = *(const float4*)(src + 4), a2 = *(const float4*)(src + 8),
                   a3 = *(const float4*)(src + 12);
      float am = fmaxf(fmaxf(fmaxf(fabsf(a0.x), fabsf(a0.y)), fmaxf(fabsf(a0.z), fabsf(a0.w))),
                       fmaxf(fmaxf(fabsf(a1.x), fabsf(a1.y)), fmaxf(fabsf(a1.z), fabsf(a1.w))));
      am = fmaxf(am, fmaxf(fmaxf(fmaxf(fabsf(a2.x), fabsf(a2.y)), fmaxf(fabsf(a2.z), fabsf(a2.w))),
                           fmaxf(fmaxf(fabsf(a3.x), fabsf(a3.y)), fmaxf(fabsf(a3.z), fabsf(a3.w)))));
#pragma unroll
      for (int o = 32; o > 0; o >>= 1) am = fmaxf(am, __shfl_xor(am, o));
      const float sc = am > 0.f ? 224.f / am : 1.f;
      uint4 o4;
      int wv;
      wv = __builtin_amdgcn_cvt_pk_fp8_f32(a0.x * sc, a0.y * sc, 0, false);
      wv = __builtin_amdgcn_cvt_pk_fp8_f32(a0.z * sc, a0.w * sc, wv, true);
      o4.x = (uint32_t)wv;
      wv = __builtin_amdgcn_cvt_pk_fp8_f32(a1.x * sc, a1.y * sc, 0, false);
      wv = __builtin_amdgcn_cvt_pk_fp8_f32(a1.z * sc, a1.w * sc, wv, true);
      o4.y = (uint32_t)wv;
      wv = __builtin_amdgcn_cvt_pk_fp8_f32(a2.x * sc, a2.y * sc, 0, false);
      wv = __builtin_amdgcn_cvt_pk_fp8_f32(a2.z * sc, a2.w * sc, wv, true);
      o4.z = (uint32_t)wv;
      wv = __builtin_amdgcn_cvt_pk_fp8_f32(a3.x * sc, a3.y * sc, 0, false);
      wv = __builtin_amdgcn_cvt_pk_fp8_f32(a3.z * sc, a3.w * sc, wv, true);
      o4.w = (uint32_t)wv;
      if (r < 16384) *(uint4*)(E8 + (size_t)r * 1024 + lane * 16) = o4;
      else *(uint4*)(E8 + (size_t)16384 * 1024 + (size_t)(lane >> 3) * (16384 * 128) + (size_t)(r - 16384) * 128 + (lane & 7) * 16) = o4;
      if (lane == 0) ESC[r] = am > 0.f ? am * (1.f / 224.f) : 1.f;
    }
  }
}

constexpr int LDT = 72;
constexpr int CS_LD = 132;

template <int NW>
__device__ __forceinline__ void gemm_tile(const u16* __restrict__ A, int lda, const u16* __restrict__ Bt, int ldb,
                                          int K, f32x4 (&acc)[4][NW / 32], char* smem, int tid) {
  constexpr int NJ = NW / 32;
  const int lane = tid & 63, w = tid >> 6;
  const int wm = w >> 1, wn = w & 1;
  const int l15 = lane & 15, quad = lane >> 4;
  const int lr = w * 8 + (lane >> 3);
  const int lc = ((lane & 7) ^ ((lane >> 3) & 7)) * 8;
  const char* Ab = (const char*)A;
  const char* Bb = (const char*)Bt;
  const uint32_t ao = (uint32_t)(lr * lda + lc) * 2u, bo = (uint32_t)(lr * ldb + lc) * 2u;
  const uint32_t sa2 = 64u * (uint32_t)lda, sb2 = 64u * (uint32_t)ldb;
  const uint32_t kmask = (uint32_t)K - 1u, kst = (((uint32_t)blockIdx.x >> 3) * 64u) & kmask;
  char* lw = smem + w * 1024 + lane * 16;
  const int swz = l15 & 7;
  const char* Ar = smem + (wm * 64 + l15) * 128 + ((quad ^ swz) * 16);
  const char* Br = smem + 16384 + (wn * (NW / 2) + l15) * 128 + ((quad ^ swz) * 16);
  const char* Ar1 = smem + (wm * 64 + l15) * 128 + (((4 + quad) ^ swz) * 16);
  const char* Br1 = smem + 16384 + (wn * (NW / 2) + l15) * 128 + (((4 + quad) ^ swz) * 16);
#define GT_ISSUE(st, off)                                                                                   \
  {                                                                                                         \
    const uint32_t _o = (((uint32_t)(off) + kst) & kmask) * 2u;                                             \
    char* _l = lw + (st) * 32768;                                                                           \
    _Pragma("unroll") for (int j = 0; j < 4; j++) {                                                         \
      __builtin_amdgcn_global_load_lds((const unsigned*)(Ab + (size_t)(ao + j * sa2 + _o)), (unsigned*)(_l + j * 4096), 16, 0, 0);          \
      if (j < NJ) __builtin_amdgcn_global_load_lds((const unsigned*)(Bb + (size_t)(bo + j * sb2 + _o)), (unsigned*)(_l + 16384 + j * 4096), 16, 0, 0);  \
    }                                                                                                       \
  }
#define GT_MMA(st)                                                                                          \
  {                                                                                                         \
    const char* _ar = Ar + (st) * 32768; const char* _br = Br + (st) * 32768;                               \
    const char* _ar1 = Ar1 + (st) * 32768; const char* _br1 = Br1 + (st) * 32768;                           \
    bf16x8 a0[4], b0[NJ], a1[4], b1[NJ];                                                                      \
    _Pragma("unroll") for (int i = 0; i < 4; i++) {                                                         \
      a0[i] = *(const bf16x8*)(_ar + i * 2048);                                                             \
      if (i < NJ) b0[i] = *(const bf16x8*)(_br + i * 2048);                                                 \
    }                                                                                                       \
    _Pragma("unroll") for (int i = 0; i < 4; i++) {                                                         \
      a1[i] = *(const bf16x8*)(_ar1 + i * 2048);                                                            \
      if (i < NJ) b1[i] = *(const bf16x8*)(_br1 + i * 2048);                                                \
    }                                                                                                       \
    __builtin_amdgcn_s_setprio(1);                                                                          \
    _Pragma("unroll") for (int i = 0; i < 4; i++)                                                           \
      _Pragma("unroll") for (int j = 0; j < NJ; j++)                                                        \
        acc[i][j] = __builtin_amdgcn_mfma_f32_16x16x32_bf16(a0[i], b0[j], acc[i][j], 0, 0, 0);              \
    _Pragma("unroll") for (int i = 0; i < 4; i++)                                                           \
      _Pragma("unroll") for (int j = 0; j < NJ; j++)                                                        \
        acc[i][j] = __builtin_amdgcn_mfma_f32_16x16x32_bf16(a1[i], b1[j], acc[i][j], 0, 0, 0);              \
    __builtin_amdgcn_s_setprio(0);                                                                          \
  }
  __syncthreads();
  GT_ISSUE(0, 0);
  for (int k0 = 0; k0 < K; k0 += 128) {
    asm volatile("s_waitcnt vmcnt(0) lgkmcnt(0)" ::: "memory");
    __builtin_amdgcn_s_barrier();
    asm volatile("" ::: "memory");
    GT_ISSUE(1, k0 + 64);
    GT_MMA(0);
    asm volatile("s_waitcnt vmcnt(0) lgkmcnt(0)" ::: "memory");
    __builtin_amdgcn_s_barrier();
    asm volatile("" ::: "memory");
    if (k0 + 128 < K) GT_ISSUE(0, k0 + 128);
    GT_MMA(1);
  }
#undef GT_ISSUE
#undef GT_MMA
}

__device__ __forceinline__ void tile_map(int it, int total, int NT, int& mt, int& nt, int vb) {
  const int G = gridDim.x;
  int T = it;
  {
    const int round = it / G;
    if (round * G + G <= total) T = round * G + vb;
  }
  const int g = T / (8 * NT), r = T - g * (8 * NT);
  nt = r >> 3;
  mt = g * 8 + (r & 7);
}

template <int NJ>
__device__ __forceinline__ void zero_acc(f32x4 (&acc)[4][NJ]) {
#pragma unroll
  for (int i = 0; i < 4; i++)
#pragma unroll
    for (int j = 0; j < NJ; j++) acc[i][j] = (f32x4){0.f, 0.f, 0.f, 0.f};
}

template <int NJ>
__device__ __forceinline__ void acc_to_cs(const f32x4 (&acc)[4][NJ], float* Cs, int tid) {
  const int lane = tid & 63, w = tid >> 6;
  const int wm = w >> 1, wn = w & 1;
  const int l15 = lane & 15, quad = lane >> 4;
#pragma unroll
  for (int i = 0; i < 4; i++)
#pragma unroll
    for (int j = 0; j < NJ; j++)
#pragma unroll
      for (int e = 0; e < 4; e++)
        Cs[(wm * 64 + i * 16 + quad * 4 + e) * CS_LD + wn * (NJ * 16) + j * 16 + l15] = acc[i][j][e];
}

__device__ __forceinline__ void phase_g1(KParams& p, char* smem, int vb) {
  const int tid = opaque_tid();
  u16* As = (u16*)smem;
  u16* Bs = As + 2 * 128 * LDT;
  float* Cs = (float*)smem;
  const u16* XN = (const u16*)(p.ws + W_XN);
  const u16* WT = (const u16*)(p.ws + W_WTIN);
  for (int t = blockIdx.x; t < MT * 44; t += gridDim.x) {
    int mt, nt;
    tile_map(t, MT * 44, 44, mt, nt, vb);
    f32x4 acc[4][4];
    zero_acc(acc);
    gemm_tile<128>(XN + (size_t)mt * 128 * 1024, 1024, WT + (size_t)nt * 128 * 1024, 1024, 1024, acc, smem, tid);
    __syncthreads();
    acc_to_cs(acc, Cs, tid);
    __syncthreads();
    const int n0 = nt * 128;
    u16* dst;
    int ldd, col;
    if (n0 < 2048) { dst = (u16*)(p.ws + W_ZA); ldd = 2048; col = n0; }
    else if (n0 < 3584) { dst = (u16*)(p.ws + W_ZB); ldd = 1536; col = n0 - 2048; }
    else { dst = (u16*)p.out; ldd = 2048; col = n0 - 3584; }
    const int cc = (tid & 15) * 8;
#pragma unroll
    for (int i = 0; i < 8; i++) {
      const int r = (tid >> 4) + 16 * i;
      float4 a = *(const float4*)(Cs + r * CS_LD + cc), b = *(const float4*)(Cs + r * CS_LD + cc + 4);
      float v[8] = {a.x, a.y, a.z, a.w, b.x, b.y, b.z, b.w};
      *(uint4*)(dst + (size_t)(mt * 128 + r) * ldd + col + cc) = pack8(v);
    }
    __syncthreads();
  }
}

constexpr int KS_LD = 72, VT_LD = 200, PS_LD = 168;
__device__ __forceinline__ void attn_item(KParams& p, char* smem, int item) {
  const int tid = opaque_tid(), lane = tid & 63, w = tid >> 6, l15 = lane & 15, quad = lane >> 4;
  u16* Ks = (u16*)smem;
  u16* Vt = Ks + 192 * KS_LD;
  u16* Ps = Vt + 64 * VT_LD + w * 16 * PS_LD;
  const u16* ZB = (const u16*)(p.ws + W_ZB);
  u16* ATT = (u16*)(p.ws + W_XN);
  const bool sample = item >= 1024;
  int b, qb = 0, kv, rowbase, p0 = 0;
  if (!sample) {
    kv = item & 3; qb = (item >> 2) & 63; b = item >> 8;
    p0 = qb * 64;
    rowbase = b * SEQ + p0;
  } else {
    int it = item - 1024;
    kv = it & 3; b = it >> 2;
    rowbase = NP + b * 8;
  }
  __syncthreads();
  {
    const int ch = tid & 7;
    float kg[8];
#pragma unroll
    for (int i = 0; i < 8; i++) kg[i] = p.k_norm_g[ch * 8 + i];
    const int nrows = sample ? 160 : 192;
    for (int c = tid; c < nrows * 8; c += 256) {
      const int row = c >> 3;
      float kf[8], vf[8];
      bool valid, donorm;
      if (!sample) {
        const int pos = p0 - 128 + row;
        valid = pos >= 0;
        donorm = true;
        if (valid) {
          const u16* src = ZB + (size_t)(b * SEQ + pos) * 1536 + 1024 + kv * 64 + ch * 8;
          unpack8(*(const uint4*)src, kf);
          unpack8(*(const uint4*)(src + 256), vf);
        }
      } else {
        valid = row < 136;
        donorm = row >= 128;
        if (row < 128) {
          const float* sk = p.cache_k + ((size_t)(b * 128 + row) * 4 + kv) * 64 + ch * 8;
          const float* sv = p.cache_v + ((size_t)(b * 128 + row) * 4 + kv) * 64 + ch * 8;
          float4 a0 = *(const float4*)sk, a1 = *(const float4*)(sk + 4);
          float4 b0 = *(const float4*)sv, b1 = *(const float4*)(sv + 4);
          kf[0] = a0.x; kf[1] = a0.y; kf[2] = a0.z; kf[3] = a0.w; kf[4] = a1.x; kf[5] = a1.y; kf[6] = a1.z; kf[7] = a1.w;
          vf[0] = b0.x; vf[1] = b0.y; vf[2] = b0.z; vf[3] = b0.w; vf[4] = b1.x; vf[5] = b1.y; vf[6] = b1.z; vf[7] = b1.w;
        } else if (valid) {
          const u16* src = ZB + (size_t)(NP + b * 8 + (row - 128)) * 1536 + 1024 + kv * 64 + ch * 8;
          unpack8(*(const uint4*)src, kf);
          unpack8(*(const uint4*)(src + 256), vf);
        }
      }
      if (!valid) {
#pragma unroll
        for (int i = 0; i < 8; i++) { kf[i] = 0.f; vf[i] = 0.f; }
      }
      float ss = 0.f;
#pragma unroll
      for (int i = 0; i < 8; i++) ss += kf[i] * kf[i];
      ss += __shfl_xor(ss, 1);
      ss += __shfl_xor(ss, 2);
      ss += __shfl_xor(ss, 4);
      if (donorm) {
        const float rstd = rsqrtf(ss * (1.f / 64.f) + EPS);
#pragma unroll
        for (int i = 0; i < 8; i++) kf[i] = kf[i] * rstd * kg[i];
      }
      *(uint4*)(Ks + row * KS_LD + ch * 8) = pack8(kf);
#pragma unroll
      for (int i = 0; i < 8; i++) Vt[(ch * 8 + i) * VT_LD + row] = f2bf(vf[i]);
      if (!sample) {
        if (qb >= 62 && row >= 128) {
          const int wpos = p0 + (row - 128) - (SEQ - 128);
          float* ko = p.out + O_KP + ((size_t)(b * 128 + wpos) * 4 + kv) * 64 + ch * 8;
          float* vo = p.out + O_VP + ((size_t)(b * 128 + wpos) * 4 + kv) * 64 + ch * 8;
          *(float4*)ko = make_float4(kf[0], kf[1], kf[2], kf[3]);
          *(float4*)(ko + 4) = make_float4(kf[4], kf[5], kf[6], kf[7]);
          *(float4*)vo = make_float4(vf[0], vf[1], vf[2], vf[3]);
          *(float4*)(vo + 4) = make_float4(vf[4], vf[5], vf[6], vf[7]);
        }
      } else {
        if (row >= 8 && row < 136) {
          float* ko = p.out + O_KS + ((size_t)(b * 128 + (row - 8)) * 4 + kv) * 64 + ch * 8;
          float* vo = p.out + O_VS + ((size_t)(b * 128 + (row - 8)) * 4 + kv) * 64 + ch * 8;
          *(float4*)ko = make_float4(kf[0], kf[1], kf[2], kf[3]);
          *(float4*)(ko + 4) = make_float4(kf[4], kf[5], kf[6], kf[7]);
          *(float4*)vo = make_float4(vf[0], vf[1], vf[2], vf[3]);
          *(float4*)(vo + 4) = make_float4(vf[4], vf[5], vf[6], vf[7]);
        }
      }
    }
  }
  __syncthreads();
  const int hq = kv * 4 + w;
  const float slope = exp2f(-0.5f * (float)(hq + 1));
  const float sink = p.attn_sinks[hq];
  float qg[2][8];
#pragma unroll
  for (int ks = 0; ks < 2; ks++)
#pragma unroll
    for (int i = 0; i < 8; i++) qg[ks][i] = p.q_norm_g[ks * 32 + quad * 8 + i] * 0.125f;
  const int nsub = sample ? 1 : 4;
  for (int sb = 0; sb < nsub; sb++) {
    const int r0 = sb * 16;
    const int ws0 = r0 < 32 ? r0 : 32;
    bf16x8 qa[2];
    {
      const int qr = sample ? (l15 & 7) : (r0 + l15);
      const u16* src = ZB + (size_t)(rowbase + qr) * 1536 + hq * 64 + quad * 8;
      float q0[8], q1[8];
      unpack8(*(const uint4*)src, q0);
      unpack8(*(const uint4*)(src + 32), q1);
      float ss = 0.f;
#pragma unroll
      for (int i = 0; i < 8; i++) ss += q0[i] * q0[i] + q1[i] * q1[i];
      ss += __shfl_xor(ss, 16);
      ss += __shfl_xor(ss, 32);
      const float rstd = rsqrtf(ss * (1.f / 64.f) + EPS);
#pragma unroll
      for (int i = 0; i < 8; i++) { q0[i] *= rstd * qg[0][i]; q1[i] *= rstd * qg[1][i]; }
      uint4 u0 = pack8(q0), u1 = pack8(q1);
      qa[0] = __builtin_bit_cast(bf16x8, u0);
      qa[1] = __builtin_bit_cast(bf16x8, u1);
    }
    f32x4 s[10];
#pragma unroll
    for (int kt = 0; kt < 10; kt++) {
      const u16* kp = Ks + (ws0 + kt * 16 + l15) * KS_LD + quad * 8;
      bf16x8 b0 = *(const bf16x8*)kp, b1 = *(const bf16x8*)(kp + 32);
      f32x4 z = {0.f, 0.f, 0.f, 0.f};
      z = __builtin_amdgcn_mfma_f32_16x16x32_bf16(qa[0], b0, z, 0, 0, 0);
      s[kt] = __builtin_amdgcn_mfma_f32_16x16x32_bf16(qa[1], b1, z, 0, 0, 0);
    }
    float mx[4] = {-1e30f, -1e30f, -1e30f, -1e30f};
#pragma unroll
    for (int kt = 0; kt < 10; kt++) {
      const int jj = ws0 + kt * 16 + l15;
      const bool posok = sample ? (jj < 136) : (p0 - 128 + jj >= 0);
#pragma unroll
      for (int e = 0; e < 4; e++) {
        const int r = r0 + quad * 4 + e;
        const int dist = r + 128 - jj;
        const bool ok = posok && dist >= 0 && dist <= 128;
        float v = ok ? (s[kt][e] - slope * (float)dist) : -1e30f;
        s[kt][e] = v;
        mx[e] = fmaxf(mx[e], v);
      }
    }
    float sum[4];
#pragma unroll
    for (int e = 0; e < 4; e++) {
      float m = mx[e];
      m = fmaxf(m, __shfl_xor(m, 1));
      m = fmaxf(m, __shfl_xor(m, 2));
      m = fmaxf(m, __shfl_xor(m, 4));
      m = fmaxf(m, __shfl_xor(m, 8));
      m = fmaxf(m, sink);
      mx[e] = m;
      sum[e] = 0.f;
    }
#pragma unroll
    for (int kt = 0; kt < 10; kt++) {
#pragma unroll
      for (int e = 0; e < 4; e++) {
        float pv = __expf(s[kt][e] - mx[e]);
        sum[e] += pv;
        Ps[(quad * 4 + e) * PS_LD + kt * 16 + l15] = f2bf(pv);
      }
    }
#pragma unroll
    for (int e = 0; e < 4; e++) {
      float t = sum[e];
      t += __shfl_xor(t, 1);
      t += __shfl_xor(t, 2);
      t += __shfl_xor(t, 4);
      t += __shfl_xor(t, 8);
      sum[e] = 1.f / (t + __expf(sink - mx[e]));
    }
    __syncthreads();
    f32x4 o[4];
#pragma unroll
    for (int nt = 0; nt < 4; nt++) o[nt] = (f32x4){0.f, 0.f, 0.f, 0.f};
#pragma unroll
    for (int kk = 0; kk < 5; kk++) {
      bf16x8 pa = *(const bf16x8*)(Ps + l15 * PS_LD + kk * 32 + quad * 8);
#pragma unroll
      for (int nt = 0; nt < 4; nt++) {
        bf16x8 vb = *(const bf16x8*)(Vt + (nt * 16 + l15) * VT_LD + ws0 + kk * 32 + quad * 8);
        o[nt] = __builtin_amdgcn_mfma_f32_16x16x32_bf16(pa, vb, o[nt], 0, 0, 0);
      }
    }
#pragma unroll
    for (int e = 0; e < 4; e++) {
      const int r = quad * 4 + e;
      if (!sample || r < 8) {
        u16* dst = ATT + (size_t)(rowbase + r0 + r) * 1024 + hq * 64 + l15;
#pragma unroll
        for (int nt = 0; nt < 4; nt++) dst[nt * 16] = f2bf(o[nt][e] * sum[e]);
      }
    }
    __syncthreads();
  }
}

constexpr int XC_LD = 68;
__device__ __forceinline__ void lru_tile(KParams& p, char* smem, int mt, int nb, int mode) {
  const int tid = opaque_tid(), lane = tid & 63, w = tid >> 6, l15 = lane & 15, quad = lane >> 4;
  float* xcF = (float*)smem;
  float* aL = xcF + 128 * XC_LD;
  float* aggL = aL + 128 * XC_LD;
  const u16* ZA = (const u16*)(p.ws + W_ZA);
  const bool sample = mt >= 128;
  const int m0 = mt * 128;
  const int cb = nb * 64;
  __syncthreads();
  {
    const int ch = tid & 7;
    float cw[4][8], cbias[8];
#pragma unroll
    for (int j = 0; j < 4; j++)
#pragma unroll
      for (int i = 0; i < 8; i++) cw[j][i] = p.conv_w[j * 1024 + cb + ch * 8 + i];
#pragma unroll
    for (int i = 0; i < 8; i++) cbias[i] = p.conv_b[cb + ch * 8 + i];
#pragma unroll
    for (int it = 0; it < 4; it++) {
      const int r = (tid >> 3) + it * 32;
      const int grow = m0 + r;
      const int t = sample ? (r & 7) : ((mt & 31) * 128 + r);
      float y[8];
#pragma unroll
      for (int i = 0; i < 8; i++) y[i] = cbias[i];
#pragma unroll
      for (int d = 0; d < 4; d++) {
        float xv[8];
        if (t - d >= 0) {
          unpack8(*(const uint4*)(ZA + (size_t)(grow - d) * 2048 + cb + ch * 8), xv);
        } else if (sample) {
          const int bb = (m0 - NP + r) >> 3;
          const float* src = p.cache_conv + ((size_t)bb * 3 + (3 + t - d)) * 1024 + cb + ch * 8;
          float4 a = *(const float4*)src, b4 = *(const float4*)(src + 4);
          xv[0] = a.x; xv[1] = a.y; xv[2] = a.z; xv[3] = a.w; xv[4] = b4.x; xv[5] = b4.y; xv[6] = b4.z; xv[7] = b4.w;
        } else {
#pragma unroll
          for (int i = 0; i < 8; i++) xv[i] = 0.f;
        }
#pragma unroll
        for (int i = 0; i < 8; i++) y[i] += cw[3 - d][i] * xv[i];
        if (d == 0 && mode != 0) {
          if (!sample) {
            if ((mt & 31) == 31 && r >= 125) {
              float* dst = p.out + O_CONVP + ((size_t)(mt >> 5) * 3 + (r - 125)) * 1024 + cb + ch * 8;
              *(float4*)dst = make_float4(xv[0], xv[1], xv[2], xv[3]);
              *(float4*)(dst + 4) = make_float4(xv[4], xv[5], xv[6], xv[7]);
            }
          } else if (t >= 5) {
            const int bb = (m0 - NP + r) >> 3;
            float* dst = p.out + O_CONVS + ((size_t)bb * 3 + (t - 5)) * 1024 + cb + ch * 8;
            *(float4*)dst = make_float4(xv[0], xv[1], xv[2], xv[3]);
            *(float4*)(dst + 4) = make_float4(xv[4], xv[5], xv[6], xv[7]);
          }
        }
      }
      *(float4*)(xcF + r * XC_LD + ch * 8) = make_float4(y[0], y[1], y[2], y[3]);
      *(float4*)(xcF + r * XC_LD + ch * 8 + 4) = make_float4(y[4], y[5], y[6], y[7]);
    }
  }
  __syncthreads();
  {
    const u16* RA = (const u16*)(p.ws + W_RGA) + nb * 4096;
    const u16* RX = (const u16*)(p.ws + W_RGX) + nb * 4096;
    f32x4 aR[2][4], aI[2][4];
#pragma unroll
    for (int i = 0; i < 2; i++)
#pragma unroll
      for (int j = 0; j < 4; j++) { aR[i][j] = (f32x4){0.f, 0.f, 0.f, 0.f}; aI[i][j] = (f32x4){0.f, 0.f, 0.f, 0.f}; }
#pragma unroll
    for (int ks = 0; ks < 2; ks++) {
      bf16x8 a[2];
#pragma unroll
      for (int i = 0; i < 2; i++) {
        const float* src = xcF + (w * 32 + i * 16 + l15) * XC_LD + ks * 32 + quad * 8;
        float4 x0 = *(const float4*)src, x1 = *(const float4*)(src + 4);
        float v[8] = {x0.x, x0.y, x0.z, x0.w, x1.x, x1.y, x1.z, x1.w};
        uint4 u = pack8(v);
        a[i] = __builtin_bit_cast(bf16x8, u);
      }
#pragma unroll
      for (int j = 0; j < 4; j++) {
        bf16x8 ba = *(const bf16x8*)(RA + (j * 16 + l15) * 64 + ks * 32 + quad * 8);
        bf16x8 bx = *(const bf16x8*)(RX + (j * 16 + l15) * 64 + ks * 32 + quad * 8);
#pragma unroll
        for (int i = 0; i < 2; i++) {
          aR[i][j] = __builtin_amdgcn_mfma_f32_16x16x32_bf16(a[i], ba, aR[i][j], 0, 0, 0);
          aI[i][j] = __builtin_amdgcn_mfma_f32_16x16x32_bf16(a[i], bx, aI[i][j], 0, 0, 0);
        }
      }
    }
#pragma unroll
    for (int j = 0; j < 4; j++) {
      const int c = cb + j * 16 + l15;
      const float ba = p.rg_b_a[c], bx = p.rg_b_x[c];
      const float ls = -log1pf(__expf(-p.rg_lambda[c]));
#pragma unroll
      for (int i = 0; i < 2; i++)
#pragma unroll
        for (int e = 0; e < 4; e++) {
          const int row = w * 32 + i * 16 + quad * 4 + e;
          const float rg = sigmoidf_(aR[i][j][e] + ba);
          const float ig = sigmoidf_(aI[i][j][e] + bx);
          const float la = 8.f * rg * ls;
          const float av = __expf(la);
          const float x2 = 2.f * la;
          const float emt = -x2 * (1.f + x2 * (0.5f + x2 * (0.16666667f + x2 * (0.041666668f + x2 * 0.008333334f))));
          const float em = x2 > -0.25f ? emt : 1.f - __expf(x2);
          const float mult = __builtin_amdgcn_sqrtf(fmaxf(em, 0.f));
          const int idx = row * XC_LD + j * 16 + l15;
          const float xv = xcF[idx];
          aL[idx] = av;
          xcF[idx] = mult * ig * xv;
        }
    }
  }
  __syncthreads();
  const int c = cb + lane;
  float* carL = aggL + 512;
  if (!sample) {
    float* AGGP = (float*)(p.ws + W_AGG);
    float* AGGH = AGGP + 128 * 1024;
    const int chunk = mt & 31, base = mt - chunk;
    if (mode == 1) {
      float Pq[8], Hq[8];
#pragma unroll
      for (int k = 0; k < 8; k++) {
        const int q = w * 8 + k;
        const bool ok = q < chunk;
        Pq[k] = ok ? AGGP[(base + q) * 1024 + c] : 1.f;
        Hq[k] = ok ? AGGH[(base + q) * 1024 + c] : 0.f;
      }
      float Pc = 1.f, hc = 0.f;
#pragma unroll
      for (int k = 0; k < 8; k++) { hc = Pq[k] * hc + Hq[k]; Pc *= Pq[k]; }
      carL[(w * 64 + lane) * 2] = Pc;
      carL[(w * 64 + lane) * 2 + 1] = hc;
    }
    float P = 1.f, h = 0.f;
#pragma unroll 8
    for (int rr = 0; rr < 32; rr++) {
      const float av = aL[(w * 32 + rr) * XC_LD + lane], bv = xcF[(w * 32 + rr) * XC_LD + lane];
      h = av * h + bv;
      P *= av;
    }
    aggL[(w * 64 + lane) * 2] = P;
    aggL[(w * 64 + lane) * 2 + 1] = h;
    __syncthreads();
    if (mode == 0 || mode == 2) {
      if (w == 0) {
        float Pt = 1.f, ht = 0.f;
#pragma unroll
        for (int q = 0; q < 4; q++) {
          const float Pq = aggL[(q * 64 + lane) * 2], hq = aggL[(q * 64 + lane) * 2 + 1];
          ht = Pq * ht + hq;
          Pt *= Pq;
        }
        if (mode == 0) {
          AGGP[mt * 1024 + c] = Pt;
          AGGH[mt * 1024 + c] = ht;
        } else {
          __hip_atomic_store(&AGGP[mt * 1024 + c], Pt, __ATOMIC_RELAXED, __HIP_MEMORY_SCOPE_AGENT);
          __hip_atomic_store(&AGGH[mt * 1024 + c], ht, __ATOMIC_RELAXED, __HIP_MEMORY_SCOPE_AGENT);
          asm volatile("s_waitcnt vmcnt(0)" ::: "memory");
          if (lane == 0)
            __hip_atomic_store((unsigned*)(p.ws + W_FLAG) + mt * 16 + nb, 1u, __ATOMIC_RELAXED, __HIP_MEMORY_SCOPE_AGENT);
        }
      }
    }
    if (mode == 2) {
      {
        const int q = w * 8 + (lane & 7);
        const bool need = (lane < 8) && (q < chunk);
        unsigned* fp = (unsigned*)(p.ws + W_FLAG) + (base + (need ? q : 0)) * 16 + nb;
        unsigned spins = 0;
        for (;;) {
          const unsigned f = need ? __hip_atomic_load(fp, __ATOMIC_RELAXED, __HIP_MEMORY_SCOPE_AGENT) : 1u;
          if (__ballot(f == 0u) == 0ull) break;
          __builtin_amdgcn_s_sleep(2);
          if (++spins > (1u << 20)) break;
        }
      }
      float Pq[8], Hq[8];
#pragma unroll
      for (int k = 0; k < 8; k++) {
        const int q = w * 8 + k;
        const bool ok = q < chunk;
        Pq[k] = ok ? __hip_atomic_load(&AGGP[(base + q) * 1024 + c], __ATOMIC_RELAXED, __HIP_MEMORY_SCOPE_AGENT) : 1.f;
        Hq[k] = ok ? __hip_atomic_load(&AGGH[(base + q) * 1024 + c], __ATOMIC_RELAXED, __HIP_MEMORY_SCOPE_AGENT) : 0.f;
      }
      float Pc = 1.f, hc = 0.f;
#pragma unroll
      for (int k = 0; k < 8; k++) { hc = Pq[k] * hc + Hq[k]; Pc *= Pq[k]; }
      carL[(w * 64 + lane) * 2] = Pc;
      carL[(w * 64 + lane) * 2 + 1] = hc;
      __syncthreads();
    }
    if (mode == 0) {
    } else {
      float hin = 0.f;
#pragma unroll
      for (int q = 0; q < 4; q++) hin = carL[(q * 64 + lane) * 2] * hin + carL[(q * 64 + lane) * 2 + 1];
      for (int q = 0; q < w; q++) hin = aggL[(q * 64 + lane) * 2] * hin + aggL[(q * 64 + lane) * 2 + 1];
      float hh = hin;
#pragma unroll 8
      for (int rr = 0; rr < 32; rr++) {
        const int row = w * 32 + rr;
        const float av = aL[row * XC_LD + lane], bv = xcF[row * XC_LD + lane];
        hh = av * hh + bv;
        xcF[row * XC_LD + lane] = hh;
      }
      if (chunk == 31 && w == 3) p.out[O_LRUP + (size_t)(mt >> 5) * 1024 + c] = hh;
    }
  } else {
    float hh = 0.f;
    float h0v[4];
#pragma unroll
    for (int k = 0; k < 4; k++) h0v[k] = p.state_lru[(size_t)(((m0 - NP + w * 32) >> 3) + k) * 1024 + c];
#pragma unroll
    for (int rr = 0; rr < 32; rr++) {
      const int row = w * 32 + rr;
      const int bb = (m0 - NP + row) >> 3;
      const int t = row & 7;
      if (t == 0) hh = h0v[rr >> 3];
      const float av = aL[row * XC_LD + lane], bv = xcF[row * XC_LD + lane];
      hh = av * hh + bv;
      xcF[row * XC_LD + lane] = hh;
      if (t == 7) p.out[O_LRUS + (size_t)bb * 1024 + c] = hh;
    }
  }
  if (mode != 0) {
    __syncthreads();
    u16* LO = (u16*)(p.ws + W_LO);
    const int ch = tid & 7;
#pragma unroll
    for (int it = 0; it < 4; it++) {
      const int r = (tid >> 3) + it * 32;
      float g[8];
      unpack8(*(const uint4*)(ZA + (size_t)(m0 + r) * 2048 + 1024 + cb + ch * 8), g);
      const float4 h0 = *(const float4*)(xcF + r * XC_LD + ch * 8), h1 = *(const float4*)(xcF + r * XC_LD + ch * 8 + 4);
      float v[8] = {h0.x * gelu_tanh(g[0]), h0.y * gelu_tanh(g[1]), h0.z * gelu_tanh(g[2]), h0.w * gelu_tanh(g[3]),
                    h1.x * gelu_tanh(g[4]), h1.y * gelu_tanh(g[5]), h1.z * gelu_tanh(g[6]), h1.w * gelu_tanh(g[7])};
      *(uint4*)(LO + (size_t)(m0 + r) * 1024 + cb + ch * 8) = pack8(v);
    }
  }
}

template <int NW>
__device__ __forceinline__ void g3_tile(KParams& p, char* smem, int mt, int n0) {
  const int tid = opaque_tid();
  float* Cs = (float*)smem;
  const u16* LO = (const u16*)(p.ws + W_LO);
  const u16* ATT = (const u16*)(p.ws + W_XN);
  const u16* WL = (const u16*)(p.ws + W_WTLRU);
  const u16* WA = (const u16*)(p.ws + W_WTATTN);
  const u16* ZC = (const u16*)p.out;
  u16* MG = (u16*)(p.ws + W_ZA);
  constexpr int TPR = NW / 8;
  constexpr int RPI = 256 / TPR;
  const int cc = (tid % TPR) * 8;
  uint4 part[128 / RPI];
#pragma unroll
  for (int pass = 0; pass < 2; pass++) {
    f32x4 acc[4][NW / 32];
    zero_acc(acc);
    gemm_tile<NW>((pass ? ATT : LO) + (size_t)mt * 128 * 1024, 1024, (pass ? WA : WL) + (size_t)n0 * 1024, 1024, 1024, acc,
                  smem, tid);
    uint4 graw[128 / RPI];
#pragma unroll
    for (int i = 0; i < 128 / RPI; i++)
      graw[i] = *(const uint4*)(ZC + (size_t)(mt * 128 + (tid / TPR) + RPI * i) * 2048 + pass * 1024 + n0 + cc);
    __syncthreads();
    acc_to_cs(acc, Cs, tid);
    __syncthreads();
#pragma unroll
    for (int i = 0; i < 128 / RPI; i++) {
      const int r = (tid / TPR) + RPI * i;
      const size_t row = (size_t)(mt * 128 + r);
      float4 a = *(const float4*)(Cs + r * CS_LD + cc), b = *(const float4*)(Cs + r * CS_LD + cc + 4);
      float v[8] = {a.x, a.y, a.z, a.w, b.x, b.y, b.z, b.w};
      float g[8];
      unpack8(graw[i], g);
      u16* mp = MG + row * 1024 + n0 + cc;
      if (pass == 0) {
#pragma unroll
        for (int q = 0; q < 8; q++) v[q] *= sigmoidf_(g[q]);
        part[i] = pack8(v);
      } else {
        float pv[8];
        unpack8(part[i], pv);
#pragma unroll
        for (int q = 0; q < 8; q++) v[q] = pv[q] + v[q] * sigmoidf_(g[q]);
        *(uint4*)mp = pack8(v);
      }
    }
    __syncthreads();
  }
}

__device__ __forceinline__ void phase_g3(KParams& p, char* smem, int vb) {
  for (int it = blockIdx.x; it < 1024 + 128; it += gridDim.x) {
    int mt, nt;
    if (it < 1024) {
      tile_map(it, MT * 8, 8, mt, nt, vb);
      g3_tile<128>(p, smem, mt, nt * 128);
    } else {
      tile_map(1024 + ((it - 1024) >> 1), MT * 8, 8, mt, nt, vb);
      g3_tile<64>(p, smem, mt, nt * 128 + ((it - 1024) & 1) * 64);
    }
  }
}

template <int NW>
__device__ __forceinline__ void g4_tile(KParams& p, char* smem, int mt, int n0) {
  const int tid = opaque_tid();
  float* Cs = (float*)smem;
  const u16* MG = (const u16*)(p.ws + W_ZA);
  const u16* WO = (const u16*)(p.ws + W_WTOUT);
  u16* HG = (u16*)(p.ws + W_ZB);
  float* SSQ = (float*)(p.ws + W_SSQ);
  constexpr int TPR = NW / 8;
  constexpr int RPI = 256 / TPR;
  f32x4 acc[4][NW / 32];
  zero_acc(acc);
  gemm_tile<NW>(MG + (size_t)mt * 128 * 1024, 1024, WO + (size_t)n0 * 1024, 1024, 1024, acc, smem, tid);
  const int cc = (tid % TPR) * 8;
  float4 xr0[128 / RPI], xr1[128 / RPI];
#pragma unroll
  for (int i = 0; i < 128 / RPI; i++) {
    const float* xr = xrow(p, mt * 128 + (tid / TPR) + RPI * i) + n0 + cc;
    xr0[i] = *(const float4*)xr;
    xr1[i] = *(const float4*)(xr + 4);
  }
  __syncthreads();
  acc_to_cs(acc, Cs, tid);
  __syncthreads();
  const float4 g0 = *(const float4*)(p.norm2_g + n0 + cc), g1 = *(const float4*)(p.norm2_g + n0 + cc + 4);
#pragma unroll
  for (int i = 0; i < 128 / RPI; i++) {
    const int r = (tid / TPR) + RPI * i;
    const int row = mt * 128 + r;
    float4 a = *(const float4*)(Cs + r * CS_LD + cc), b = *(const float4*)(Cs + r * CS_LD + cc + 4);
    const float4 x0 = xr0[i], x1 = xr1[i];
    a.x += x0.x; a.y += x0.y; a.z += x0.z; a.w += x0.w;
    b.x += x1.x; b.y += x1.y; b.z += x1.z; b.w += x1.w;
    float* ho = p.out + O_Y + (size_t)row * 1024 + n0 + cc;
    *(float4*)ho = a;
    *(float4*)(ho + 4) = b;
    float v[8] = {a.x * g0.x, a.y * g0.y, a.z * g0.z, a.w * g0.w, b.x * g1.x, b.y * g1.y, b.z * g1.z, b.w * g1.w};
    *(uint4*)(HG + (size_t)row * 1024 + n0 + cc) = pack8(v);
    float ss = a.x * a.x + a.y * a.y + a.z * a.z + a.w * a.w + b.x * b.x + b.y * b.y + b.z * b.z + b.w * b.w;
    ss += __shfl_xor(ss, 1);
    ss += __shfl_xor(ss, 2);
    ss += __shfl_xor(ss, 4);
    if ((tid & 7) == 0) SSQ[(size_t)row * 16 + ((n0 + cc) >> 6)] = ss;
  }
  __syncthreads();
}

__device__ __forceinline__ void phase_g4(KParams& p, char* smem, int vb) {
  for (int it = blockIdx.x; it < 1024 + 128; it += gridDim.x) {
    int mt, nt;
    if (it < 1024) {
      tile_map(it, MT * 8, 8, mt, nt, vb);
      g4_tile<128>(p, smem, mt, nt * 128);
    } else {
      tile_map(1024 + ((it - 1024) >> 1), MT * 8, 8, mt, nt, vb);
      g4_tile<64>(p, smem, mt, nt * 128 + ((it - 1024) & 1) * 64);
    }
  }
}

__device__ __forceinline__ float row_rstd(const float* SSQ, int row) {
  const float4 a = *(const float4*)(SSQ + (size_t)row * 16), b = *(const float4*)(SSQ + (size_t)row * 16 + 4),
               c = *(const float4*)(SSQ + (size_t)row * 16 + 8), d = *(const float4*)(SSQ + (size_t)row * 16 + 12);
  const float ss = (((a.x + a.y) + (a.z + a.w)) + ((b.x + b.y) + (b.z + b.w))) +
                   (((c.x + c.y) + (c.z + c.w)) + ((d.x + d.y) + (d.z + d.w)));
  return rsqrtf(ss * (1.f / 1024.f) + EPS);
}

template <int NW>
__device__ __forceinline__ void g5_tile(KParams& p, char* smem, int mt, int n0) {
  const int tid = opaque_tid();
  float* Cs = (float*)smem;
  const u16* HG = (const u16*)(p.ws + W_ZB);
  const u16* WQ = (const u16*)(p.ws + W_WTQ);
  const float* SSQ = (const float*)(p.ws + W_SSQ);
  u16* QR = (u16*)(p.ws + W_ZA);
  constexpr int TPR = NW / 8;
  constexpr int RPI = 256 / TPR;
  float* RS = (float*)(smem + 128 * CS_LD * 4);
  if (tid < 128) RS[tid] = row_rstd(SSQ, mt * 128 + tid);
  f32x4 acc[4][NW / 32];
  zero_acc(acc);
  gemm_tile<NW>(HG + (size_t)mt * 128 * 1024, 1024, WQ + (size_t)n0 * 1024, 1024, 1024, acc, smem, tid);
  __syncthreads();
  acc_to_cs(acc, Cs, tid);
  __syncthreads();
  const int cc = (tid % TPR) * 8;
#pragma unroll
  for (int i = 0; i < 128 / RPI; i++) {
    const int r = (tid / TPR) + RPI * i;
    const int row = mt * 128 + r;
    const float rs = RS[r];
    float4 a = *(const float4*)(Cs + r * CS_LD + cc), b = *(const float4*)(Cs + r * CS_LD + cc + 4);
    float v[8] = {a.x * rs, a.y * rs, a.z * rs, a.w * rs, b.x * rs, b.y * rs, b.z * rs, b.w * rs};
    *(uint4*)(QR + (size_t)row * 2048 + n0 + cc) = pack8(v);
  }
  __syncthreads();
}

__device__ __forceinline__ void phase_g5(KParams& p, char* smem, int vb) {
  for (int it = blockIdx.x; it < 2048 + 256; it += gridDim.x) {
    int mt, nt;
    if (it < 2048) {
      tile_map(it, MT * 16, 16, mt, nt, vb);
      g5_tile<128>(p, smem, mt, nt * 128);
    } else {
      tile_map(2048 + ((it - 2048) >> 1), MT * 16, 16, mt, nt, vb);
      g5_tile<64>(p, smem, mt, nt * 128 + ((it - 2048) & 1) * 64);
    }
  }
}

__device__ __forceinline__ void phase_g6(KParams& p, char* smem, int vb) {
  const int tid = opaque_tid();
  u16* As = (u16*)smem;
  u16* Bs = As + 2 * 128 * LDT;
  float* Cs = (float*)smem;
  uint32_t* Cu = (uint32_t*)smem;
  uint32_t* TK0 = (uint32_t*)(smem + 128 * CS_LD * 4);
  const u16* QR = (const u16*)(p.ws + W_ZA);
  const u16* SK = (const u16*)(p.ws + W_SK);
  int* IDX = (int*)(p.ws + W_XN);
  float* GW = (float*)(p.ws + W_XN + (size_t)NTOK * 128 * 4);
  const int row = tid >> 1, half = tid & 1;
  for (int t = blockIdx.x; t < MT * 8; t += gridDim.x) {
    int mt, h;
    tile_map(t, MT * 8, 8, mt, h, vb);
    uint32_t tk[16];
    for (int pp = 0; pp < 2; pp++) {
      f32x4 acc[4][4];
      zero_acc(acc);
      gemm_tile<128>(QR + (size_t)mt * 128 * 2048 + h * 256 + pp * 128, 2048, SK + (size_t)(h * 2 + pp) * 16384, 128, 128, acc,
                smem, tid);
      __syncthreads();
      acc_to_cs(acc, Cs, tid);
      __syncthreads();
#pragma unroll
      for (int g = 0; g < 4; g++) {
        uint32_t sg[16];
#pragma unroll
        for (int q4 = 0; q4 < 4; q4++) {
          const int col = half * 64 + g * 16 + q4 * 4;
          const float4 v = *(const float4*)(Cs + row * CS_LD + col);
          sg[q4 * 4 + 0] = (ordf(v.x) & ~0x7Fu) | (uint32_t)(127 - col);
          sg[q4 * 4 + 1] = (ordf(v.y) & ~0x7Fu) | (uint32_t)(126 - col);
          sg[q4 * 4 + 2] = (ordf(v.z) & ~0x7Fu) | (uint32_t)(125 - col);
          sg[q4 * 4 + 3] = (ordf(v.w) & ~0x7Fu) | (uint32_t)(124 - col);
        }
        sort16_desc(sg);
        if (g == 0) {
#pragma unroll
          for (int q = 0; q < 16; q++) tk[q] = sg[q];
        } else {
          merge16_desc(tk, sg);
        }
      }
      __syncthreads();
      if (half == 1) {
#pragma unroll
        for (int q = 0; q < 16; q++) Cu[row * 16 + q] = tk[q];
      }
      __syncthreads();
      if (half == 0) {
        {
          uint32_t sg[16];
#pragma unroll
          for (int q4 = 0; q4 < 4; q4++) {
            const uint4 u = *(const uint4*)(Cu + row * 16 + q4 * 4);
            sg[q4 * 4] = u.x; sg[q4 * 4 + 1] = u.y; sg[q4 * 4 + 2] = u.z; sg[q4 * 4 + 3] = u.w;
          }
          merge16_desc(tk, sg);
        }
        if (pp == 0) {
#pragma unroll
          for (int q = 0; q < 16; q++) TK0[row * 16 + q] = tk[q];
        } else {
#pragma unroll
          for (int q = 0; q < 16; q++) Cu[2048 + row * 16 + q] = tk[q];
        }
      }
      __syncthreads();
    }
    if (half == 0) {
      float va[16], vb[16];
#pragma unroll
      for (int q = 0; q < 16; q++) {
        va[q] = unordf(TK0[row * 16 + q] & ~0x7Fu);
        vb[q] = unordf(tk[q] & ~0x7Fu);
      }
      uint32_t cd[16];
#pragma unroll
      for (int q = 0; q < 16; q++) cd[q] = (ordf(va[0] + vb[q]) & ~0xFFu) | (uint32_t)(255 - q);
#pragma unroll
      for (int i = 1; i < 16; i++) {
#pragma unroll
        for (int j = 0; j < 16; j++) {
          if ((i + 1) * (j + 1) <= 16) {
            const float sv = va[i] + vb[j];
            const uint32_t key = (ordf(sv) & ~0xFFu) | (uint32_t)(255 - (i * 16 + j));
            INS16(cd, key);
          }
        }
      }
      float ev[16];
      const float m0v = unordf(cd[0] & ~0xFFu);
      float esum = 0.f;
#pragma unroll
      for (int q = 0; q < 16; q++) {
        ev[q] = __expf(unordf(cd[q] & ~0xFFu) - m0v);
        esum += ev[q];
      }
      const float inv = 1.f / esum;
      const size_t ob = (size_t)(mt * 128 + row) * 128 + h * 16;
#pragma unroll
      for (int q = 0; q < 16; q++) {
        const int ij = 255 - (int)(cd[q] & 0xFFu);
        const int i0 = 127 - (int)(TK0[row * 16 + (ij >> 4)] & 0x7Fu);
        const int i1 = 127 - (int)(Cu[2048 + row * 16 + (ij & 15)] & 0x7Fu);
        IDX[ob + q] = i0 * 128 + i1;
        GW[ob + q] = ev[q] * inv;
      }
    }
    __syncthreads();
  }
}

typedef __attribute__((ext_vector_type(2))) float f32x2;
__device__ __forceinline__ void dec16(uint4 u, float* v) {
  f32x2 t;
  t = __builtin_amdgcn_cvt_pk_f32_fp8((int)u.x, false); v[0] = t.x; v[1] = t.y;
  t = __builtin_amdgcn_cvt_pk_f32_fp8((int)u.x, true); v[2] = t.x; v[3] = t.y;
  t = __builtin_amdgcn_cvt_pk_f32_fp8((int)u.y, false); v[4] = t.x; v[5] = t.y;
  t = __builtin_amdgcn_cvt_pk_f32_fp8((int)u.y, true); v[6] = t.x; v[7] = t.y;
  t = __builtin_amdgcn_cvt_pk_f32_fp8((int)u.z, false); v[8] = t.x; v[9] = t.y;
  t = __builtin_amdgcn_cvt_pk_f32_fp8((int)u.z, true); v[10] = t.x; v[11] = t.y;
  t = __builtin_amdgcn_cvt_pk_f32_fp8((int)u.w, false); v[12] = t.x; v[13] = t.y;
  t = __builtin_amdgcn_cvt_pk_f32_fp8((int)u.w, true); v[14] = t.x; v[15] = t.y;
}

__device__ __forceinline__ void phase7(KParams& p) {
  const int tid = opaque_tid(), lane = tid & 63, w = tid >> 6;
  const u16* HG = (const u16*)(p.ws + W_ZB);
  const float* SSQ = (const float*)(p.ws + W_SSQ);
  const int* IDX = (const int*)(p.ws + W_XN);
  const float* GW = (const float*)(p.ws + W_XN + (size_t)NTOK * 128 * 4);
  const unsigned char* EU = (const unsigned char*)(p.ws + W_EU);
  const unsigned char* EV = (const unsigned char*)(p.ws + W_EV);
  const float* ESC = (const float*)(p.ws + W_ESC);
  const int b0 = lane & 1, b1 = (lane >> 1) & 1, b2 = (lane >> 2) & 1;
  const int nwv = gridDim.x * 4;
  int tok = blockIdx.x * 4 + w;
  uint4 nh0 = make_uint4(0u, 0u, 0u, 0u), nh1 = nh0;
  float nrs = 0.f, ngwA = 0.f, ngwB = 0.f;
  int niA = 0, niB = 0;
  if (tok < NTOK) {
    const uint4* hp = (const uint4*)(HG + (size_t)tok * 1024 + lane * 16);
    nh0 = hp[0]; nh1 = hp[1];
    nrs = row_rstd(SSQ, tok);
    niA = IDX[(size_t)tok * 128 + lane]; niB = IDX[(size_t)tok * 128 + 64 + lane];
    ngwA = GW[(size_t)tok * 128 + lane]; ngwB = GW[(size_t)tok * 128 + 64 + lane];
  }
#pragma unroll 1
  for (; tok < NTOK; tok += nwv) {
    const float rs = nrs;
    const int iA = niA, iB = niB;
    const float gwA = ngwA, gwB = ngwB;
    float xh[16];
    unpack8(nh0, xh);
    unpack8(nh1, xh + 8);
#pragma unroll
    for (int i = 0; i < 16; i++) xh[i] *= rs;
    {
      const int nt2 = tok + nwv;
      if (nt2 < NTOK) {
        const uint4* hp = (const uint4*)(HG + (size_t)nt2 * 1024 + lane * 16);
        nh0 = hp[0]; nh1 = hp[1];
        nrs = row_rstd(SSQ, nt2);
        niA = IDX[(size_t)nt2 * 128 + lane]; niB = IDX[(size_t)nt2 * 128 + 64 + lane];
        ngwA = GW[(size_t)nt2 * 128 + lane]; ngwB = GW[(size_t)nt2 * 128 + 64 + lane];
      }
    }
    const float gA = gwA * ESC[16384 + iA], gB = gwB * ESC[16384 + iB];
    const float suA = ESC[iA], suB = ESC[iB];
    float dA = 0.f, dB = 0.f;
#pragma unroll 2
    for (int bb = 0; bb < 16; bb++) {
      const int isrc = bb < 8 ? iA : iB;
      float d[8];
      uint4 ur[8];
#pragma unroll
      for (int k = 0; k < 8; k++) {
        const int id = __builtin_amdgcn_readlane(isrc, (bb & 7) * 8 + k);
        ur[k] = *(const uint4*)(EU + (size_t)id * 1024 + lane * 16);
      }
#pragma unroll
      for (int k = 0; k < 8; k++) {
        float uv[16];
        dec16(ur[k], uv);
        float sacc = 0.f;
#pragma unroll
        for (int i = 0; i < 16; i++) sacc += xh[i] * uv[i];
        d[k] = sacc;
      }
      float e4[4], e2[2], e1;
#pragma unroll
      for (int i = 0; i < 4; i++) {
        const float keep = b0 ? d[2 * i + 1] : d[2 * i];
        const float send = b0 ? d[2 * i] : d[2 * i + 1];
        e4[i] = keep + __shfl_xor(send, 1);
      }
#pragma unroll
      for (int i = 0; i < 2; i++) {
        const float keep = b1 ? e4[2 * i + 1] : e4[2 * i];
        const float send = b1 ? e4[2 * i] : e4[2 * i + 1];
        e2[i] = keep + __shfl_xor(send, 2);
      }
      {
        const float keep = b2 ? e2[1] : e2[0];
        const float send = b2 ? e2[0] : e2[1];
        e1 = keep + __shfl_xor(send, 4);
      }
      e1 += __shfl_xor(e1, 8);
      e1 += __shfl_xor(e1, 16);
      e1 += __shfl_xor(e1, 32);
      const bool mine = (lane >> 3) == (bb & 7);
      if (bb < 8) dA = mine ? e1 : dA; else dB = mine ? e1 : dB;
    }
    const float actA = gelu_tanh(dA * suA) * gA, actB = gelu_tanh(dB * suB) * gB;
    float* ACT = (float*)(p.ws + W_ACT);
    __hip_atomic_store(&ACT[(size_t)tok * 128 + lane], actA, __ATOMIC_RELAXED, __HIP_MEMORY_SCOPE_AGENT);
    __hip_atomic_store(&ACT[(size_t)tok * 128 + 64 + lane], actB, __ATOMIC_RELAXED, __HIP_MEMORY_SCOPE_AGENT);
    asm volatile("s_waitcnt vmcnt(0)" ::: "memory");
    if (lane == 0) __hip_atomic_fetch_add((unsigned*)(p.ws + W_CNT) + (tok >> 3), 1u, __ATOMIC_RELAXED, __HIP_MEMORY_SCOPE_AGENT);
  }
}

__device__ __forceinline__ void phase7b(KParams& p) {
  const int tid = opaque_tid(), lane = tid & 63;
  const char* IDXb = (const char*)(p.ws + W_XN);
  const char* ACTb = (const char*)(p.ws + W_ACT);
  const char* EVb = (const char*)(p.ws + W_EV);
  char* Yb = (char*)(p.out + O_Y);
  unsigned* Q = (unsigned*)(p.ws + W_Q);
  const int esub = lane >> 3, c = lane & 7;
  const int pref = (int)(hw_xcc_id() & 7u);
  const int b3 = (lane >> 3) & 1, b4 = (lane >> 4) & 1, b5 = (lane >> 5) & 1;
  const uint32_t lane4 = (uint32_t)lane * 4u;
  const uint32_t yl = (uint32_t)(c * 16 + b3 * 8 + b4 * 4 + b5 * 2) * 4u;
  for (int k = 0; k < 8; k++) {
    const int sl = (pref + k) & 7;
    const char* Vs = EVb + (size_t)sl * (16384 * 128);
    const uint32_t vl = (uint32_t)c * 16u;
    for (;;) {
      unsigned it = 0;
      if (lane == 0) it = atomicAdd(Q + sl * 64, 1u);
      it = (unsigned)__builtin_amdgcn_readfirstlane((int)it);
      if (it >= (unsigned)(NTOK / 8)) break;
      const int tok0 = (int)it * 8;
      {
        unsigned* cp = (unsigned*)(p.ws + W_CNT) + it;
        unsigned spins = 0;
        while ((unsigned)__builtin_amdgcn_readfirstlane((int)__hip_atomic_load(cp, __ATOMIC_RELAXED, __HIP_MEMORY_SCOPE_AGENT)) < 8u) {
          __builtin_amdgcn_s_sleep(2);
          if (++spins > (1u << 20)) break;
        }
      }
      const char* ib = IDXb + (size_t)tok0 * 512;
      const char* ab = ACTb + (size_t)tok0 * 512;
      char* yb = Yb + (size_t)tok0 * 4096 + sl * 512;
      int nidA = *(const int*)(ib + lane4), nidB = *(const int*)(ib + 256 + lane4);
      float nacA = __hip_atomic_load((const float*)(ab + lane4), __ATOMIC_RELAXED, __HIP_MEMORY_SCOPE_AGENT), nacB = __hip_atomic_load((const float*)(ab + 256 + lane4), __ATOMIC_RELAXED, __HIP_MEMORY_SCOPE_AGENT);
      float2 nyv = *(const float2*)(yb + yl);
#pragma unroll 1
      for (int t = 0; t < 8; t++) {
        const int idA = nidA, idB = nidB;
        const float acA = nacA, acB = nacB;
        const float2 yv = nyv;
        char* ybt = yb;
        if (t < 7) {
          ib += 512; ab += 512; yb += 4096;
          nidA = *(const int*)(ib + lane4); nidB = *(const int*)(ib + 256 + lane4);
          nacA = __hip_atomic_load((const float*)(ab + lane4), __ATOMIC_RELAXED, __HIP_MEMORY_SCOPE_AGENT); nacB = __hip_atomic_load((const float*)(ab + 256 + lane4), __ATOMIC_RELAXED, __HIP_MEMORY_SCOPE_AGENT);
          nyv = *(const float2*)(yb + yl);
        }
        float o[16];
#pragma unroll
        for (int q = 0; q < 16; q++) o[q] = 0.f;
#pragma unroll
        for (int hf = 0; hf < 2; hf++) {
          uint4 vr[8];
#pragma unroll
          for (int i = 0; i < 8; i++) {
            const uint32_t id = (uint32_t)__shfl(hf ? idB : idA, i * 8 + esub);
            vr[i] = *(const uint4*)(Vs + (id * 128u + vl));
          }
#pragma unroll
          for (int i = 0; i < 8; i++) {
            float vv[16];
            dec16(vr[i], vv);
            const float a = __shfl(hf ? acB : acA, i * 8 + esub);
#pragma unroll
            for (int q = 0; q < 16; q++) o[q] += a * vv[q];
          }
        }
        float r8[8], r4[4], r2[2];
#pragma unroll
        for (int q = 0; q < 8; q++) {
          const float keep = b3 ? o[q + 8] : o[q];
          const float send = b3 ? o[q] : o[q + 8];
          r8[q] = keep + __shfl_xor(send, 8);
        }
#pragma unroll
        for (int q = 0; q < 4; q++) {
          const float keep = b4 ? r8[q + 4] : r8[q];
          const float send = b4 ? r8[q] : r8[q + 4];
          r4[q] = keep + __shfl_xor(send, 16);
        }
#pragma unroll
        for (int q = 0; q < 2; q++) {
          const float keep = b5 ? r4[q + 2] : r4[q];
          const float send = b5 ? r4[q] : r4[q + 2];
          r2[q] = keep + __shfl_xor(send, 32);
        }
        float2 h = yv;
        h.x += r2[0];
        h.y += r2[1];
        *(float2*)(ybt + yl) = h;
      }
    }
  }
}

#define XB_TMO      128
#define XB_XCNT(j)  (256  + 64 * (j))
#define XB_XSUB(j)  (1280 + 64 * (j))
#define XB_XGEN(j)  (2304 + 64 * (j))
#define XB_TOP      3328
#define XB_TOPGEN   3392
#define XCD_BAR_WORDS 3456
#define XB_SPIN_CAP (1u << 18)
#define LAS __attribute__((address_space(3)))
__device__ __forceinline__ unsigned xb_ld(unsigned* p) { return __hip_atomic_load(p, __ATOMIC_RELAXED, __HIP_MEMORY_SCOPE_AGENT); }
__device__ __forceinline__ unsigned xb_add(unsigned* p, unsigned v) { return __hip_atomic_fetch_add(p, v, __ATOMIC_RELAXED, __HIP_MEMORY_SCOPE_AGENT); }
__device__ __forceinline__ unsigned xb_xcc_id() { return (unsigned)__builtin_amdgcn_s_getreg((3 << 11) | 20) & 0xFu; }
#define XB_SPIN(cond, bar) do { unsigned _sp = 0; while (cond) { __builtin_amdgcn_s_sleep(1); \
    if ((++_sp & 255u) == 0u) { if (xb_ld(&(bar)[XB_TMO])) break; if (_sp > XB_SPIN_CAP) { atomicAdd(&(bar)[XB_TMO], 1u); break; } } } } while (0)
struct XcdBarrier { unsigned* bar; unsigned x; volatile LAS unsigned* st; };
__device__ __forceinline__ XcdBarrier xcd_barrier_post(unsigned* bar, volatile LAS unsigned* st) {
  XcdBarrier b; b.bar = bar; b.x = xb_xcc_id(); b.st = st;
  if (threadIdx.x == 0) st[2] = xb_add(&bar[XB_XCNT(b.x)], 1u);
  return b;
}
__device__ __forceinline__ void xcd_barrier_complete(unsigned* bar, unsigned x, unsigned& nloc, unsigned& nx) {
  const unsigned G = gridDim.x * gridDim.y * gridDim.z;
  unsigned sum, cnt, mine, sp = 0u;
  for (;;) {
    sum = 0u; cnt = 0u; mine = 0u;
#pragma unroll
    for (unsigned j = 0; j < 16; ++j) { const unsigned c = xb_ld(&bar[XB_XCNT(j)]); sum += c; cnt += (c > 0u) ? 1u : 0u; mine = (j == x) ? c : mine; }
    if (sum == G) break;
    __builtin_amdgcn_s_sleep(1);
    if ((++sp & 255u) == 0u) { if (xb_ld(&bar[XB_TMO])) break; if (sp > XB_SPIN_CAP) { atomicAdd(&bar[XB_TMO], 1u); break; } }
  }
  nloc = mine > 0u ? mine : 1u; nx = cnt > 0u ? cnt : 1u;
}
__device__ __forceinline__ void xcd_barrier(const XcdBarrier& b) {
  asm volatile("s_waitcnt vmcnt(0)" ::: "memory");
  __syncthreads();
  if (threadIdx.x == 0) {
    unsigned* bar = b.bar;
    __builtin_amdgcn_s_waitcnt(0);
    unsigned nloc = b.st[0], nx = b.st[1];
    if (nloc == 0u) { xcd_barrier_complete(bar, b.x, nloc, nx); b.st[0] = nloc; b.st[1] = nx; }
    const unsigned old = xb_add(&bar[XB_XSUB(b.x)], 1u);
    const unsigned gen = old / nloc;
    if (old + 1u == (gen + 1u) * nloc) {
      __builtin_amdgcn_fence(__ATOMIC_RELEASE, "agent");
      asm volatile("s_waitcnt vmcnt(0)" ::: "memory");
      const unsigned og = xb_add(&bar[XB_TOP], 1u);
      const unsigned tg = og / nx;
      if (og + 1u == (tg + 1u) * nx) xb_add(&bar[XB_TOPGEN], 1u);
      else XB_SPIN(xb_ld(&bar[XB_TOPGEN]) == tg, bar);
      __builtin_amdgcn_fence(__ATOMIC_ACQUIRE, "agent");
      xb_add(&bar[XB_XGEN(b.x)], 1u);
      asm volatile("s_waitcnt vmcnt(0)" ::: "memory");
    } else {
      XB_SPIN(xb_ld(&bar[XB_XGEN(b.x)]) == gen, bar);
      __builtin_amdgcn_fence(__ATOMIC_ACQUIRE, "agent");
      asm volatile("s_waitcnt vmcnt(0)" ::: "memory");
    }
  }
  __syncthreads();
}

#ifndef REP_MASK
#define REP_MASK 0
#endif
#define REPS(k) for (int _rep = 0; _rep < (((REP_MASK) >> (k)) & 1) + 1; _rep++)
__global__ void __launch_bounds__(256, 2) fwd_megakernel(Params p_) {
  extern __shared__ __attribute__((aligned(16))) char smem[];
  cg::grid_group grid = cg::this_grid();
  if (p_.ws == nullptr) grid.sync();
  volatile LAS unsigned* xst = (volatile LAS unsigned*)(smem + SMEM_BYTES - 16);
  if (threadIdx.x == 0) { xst[0] = 0u; xst[1] = 0u; xst[2] = 0u; xst[3] = 0u; }
  __syncthreads();
  const XcdBarrier xb = xcd_barrier_post((unsigned*)(p_.ws + W_BAR), xst);
  REPS(0) { phase0(*fresh_params(), smem); xcd_barrier(xb); }
  if (threadIdx.x == 0) {
    unsigned* bar = (unsigned*)(p_.ws + W_BAR);
    const unsigned per = gridDim.x >> 3;
    bool uni = (gridDim.x & 7u) == 0u;
    for (unsigned j = 0; j < 16; ++j) { const unsigned cnt = xb_ld(&bar[XB_XCNT(j)]); if (cnt != (j < 8 ? per : 0u)) uni = false; }
    xst[3] = uni ? (xb.x * per + xst[2]) : blockIdx.x;
  }
  __syncthreads();
  const int vb = (int)xst[3];
  REPS(1) { phase_g1(*fresh_params(), smem, vb); xcd_barrier(xb); }
  REPS(2) {
    for (int it = blockIdx.x; it < MT * 16 + 1536; it += gridDim.x) {
      if (it < MT * 16) { const int mt = it >> 4; lru_tile(*fresh_params(), smem, mt, it & 15, mt < 128 ? 2 : 1); }
      else attn_item(*fresh_params(), smem, it - MT * 16);
    }
    xcd_barrier(xb);
  }
  REPS(4) { phase_g3(*fresh_params(), smem, vb); xcd_barrier(xb); }
  REPS(5) { phase_g4(*fresh_params(), smem, vb); xcd_barrier(xb); }
  REPS(6) { phase_g5(*fresh_params(), smem, vb); xcd_barrier(xb); }
  REPS(7) { phase_g6(*fresh_params(), smem, vb); xcd_barrier(xb); }
  phase7(*fresh_params());
  phase7b(*fresh_params());
}

extern "C" void kernel_launch(void* const* d_in, const int* in_sizes, int n_in, void* d_out, int out_size, void* d_ws,
                              size_t ws_size, hipStream_t stream) {
  static int grid_blocks = 0;
  if (!grid_blocks) {
    int dev = 0, cus = 0, per_cu = 0;
    hipGetDevice(&dev);
    hipDeviceGetAttribute(&cus, hipDeviceAttributeMultiprocessorCount, dev);
    hipFuncSetAttribute((const void*)fwd_megakernel, hipFuncAttributeMaxDynamicSharedMemorySize, SMEM_BYTES);
    hipOccupancyMaxActiveBlocksPerMultiprocessor(&per_cu, fwd_megakernel, 256, SMEM_BYTES);
    if (per_cu < 1) per_cu = 1;
    grid_blocks = cus * per_cu;
  }
  Params p{};
  const float** pp = (const float**)&p;
  for (int i = 0; i < 26; i++) pp[i] = (const float*)d_in[i];
  p.out = (float*)d_out;
  p.ws = (char*)d_ws;
  (void)hipMemsetAsync((char*)d_ws + W_BAR, 0, (size_t)3456 * 4 + 8 * 256 + 2048 * 4 + 2176 * 4, stream);
  void* args[] = {&p};
  hipError_t e = hipLaunchCooperativeKernel((void*)fwd_megakernel, dim3(grid_blocks), dim3(256), args, SMEM_BYTES, stream);
  if (e != hipSuccess) fprintf(stderr, "cooperative launch failed: %s (grid %d)\n", hipGetErrorString(e), grid_blocks);
}
```

```cpp
#include <hip/hip_runtime.h>
#include <hip/hip_cooperative_groups.h>
#include <stdint.h>
#include <cstdio>
namespace cg = cooperative_groups;

typedef unsigned short u16;
typedef __attribute__((ext_vector_type(8))) short bf16x8;
typedef __attribute__((ext_vector_type(4))) float f32x4;

constexpr int D = 1024;
constexpr int NP = 16384;
constexpr int NTOK = 17408;
constexpr int SEQ = 4096;
constexpr int MT = 136;
constexpr float EPS = 1e-6f;

constexpr size_t O_Y = 0;
constexpr size_t O_CONVP = 17825792;
constexpr size_t O_LRUP = O_CONVP + 12288;
constexpr size_t O_KP = O_LRUP + 4096;
constexpr size_t O_VP = O_KP + 131072;
constexpr size_t O_CONVS = O_VP + 131072;
constexpr size_t O_LRUS = O_CONVS + 393216;
constexpr size_t O_KS = O_LRUS + 131072;
constexpr size_t O_VS = O_KS + 4194304;

constexpr size_t W_WTIN = 0;
constexpr size_t W_WTLRU = W_WTIN + (size_t)5632 * 1024 * 2;
constexpr size_t W_WTATTN = W_WTLRU + (size_t)1024 * 1024 * 2;
constexpr size_t W_WTOUT = W_WTATTN + (size_t)1024 * 1024 * 2;
constexpr size_t W_WTQ = W_WTOUT + (size_t)1024 * 1024 * 2;
constexpr size_t W_SK = W_WTQ + (size_t)2048 * 1024 * 2;
constexpr size_t W_RGA = W_SK + (size_t)16 * 128 * 128 * 2;
constexpr size_t W_RGX = W_RGA + (size_t)65536 * 2;
constexpr size_t W_EU = W_RGX + (size_t)65536 * 2;
constexpr size_t W_EV = W_EU + (size_t)16384 * 1024;
constexpr size_t W_ESC = W_EV + (size_t)16384 * 1024;
constexpr size_t W_XN = W_ESC + (size_t)32768 * 4;
constexpr size_t W_ZA = W_XN + (size_t)NTOK * 1024 * 2;
constexpr size_t W_ZB = W_ZA + (size_t)NTOK * 2048 * 2;
constexpr size_t W_AGG = W_ZB + (size_t)NTOK * 1536 * 2;
constexpr size_t W_SSQ = W_AGG + (size_t)128 * 1024 * 2 * 4;
constexpr size_t W_BAR = W_SSQ + (size_t)NTOK * 16 * 4;
constexpr size_t W_Q = W_BAR + (size_t)3456 * 4;
constexpr size_t W_FLAG = W_Q + (size_t)8 * 256;
constexpr size_t W_CNT = W_FLAG + (size_t)2048 * 4;
constexpr size_t W_ACT = W_CNT + (size_t)2176 * 4;
constexpr size_t W_LO = W_ACT + (size_t)NTOK * 128 * 4;
constexpr size_t W_END = W_LO + (size_t)NTOK * 1024 * 2;

constexpr int SMEM_BYTES = 81920;

struct Params {
  const float *x_prompt, *x_sample, *cache_conv, *state_lru, *cache_k, *cache_v, *norm1_g, *w_in, *conv_w,
      *conv_b, *rg_w_a, *rg_b_a, *rg_w_x, *rg_b_x, *rg_lambda, *q_norm_g, *k_norm_g, *attn_sinks,
      *w_branch_lru, *w_branch_attn, *w_out, *norm2_g, *peer_w_query, *peer_sub_keys, *expert_u, *expert_v;
  float* out;
  char* ws;
};

typedef const __attribute__((address_space(4))) Params KParams;
__device__ __forceinline__ KParams* fresh_params() {
  unsigned long long k = (unsigned long long)__builtin_amdgcn_kernarg_segment_ptr();
  asm volatile("" : "+s"(k));
  return (KParams*)k;
}
__device__ __forceinline__ u16 f2bf(float f) {
  uint32_t u = __float_as_uint(f);
  u += 0x7FFFu + ((u >> 16) & 1u);
  return (u16)(u >> 16);
}
__device__ __forceinline__ float bf2f(u16 h) { return __uint_as_float(((uint32_t)h) << 16); }
__device__ __forceinline__ uint32_t pack2(float a, float b) {
  uint32_t r;
  asm("v_cvt_pk_bf16_f32 %0, %1, %2" : "=v"(r) : "v"(a), "v"(b));
  return r;
}
__device__ __forceinline__ uint4 pack8(const float* v) {
  uint4 o;
  o.x = pack2(v[0], v[1]); o.y = pack2(v[2], v[3]); o.z = pack2(v[4], v[5]); o.w = pack2(v[6], v[7]);
  return o;
}
__device__ __forceinline__ void unpack8(uint4 u, float* v) {
  v[0] = __uint_as_float(u.x << 16); v[1] = __uint_as_float(u.x & 0xFFFF0000u);
  v[2] = __uint_as_float(u.y << 16); v[3] = __uint_as_float(u.y & 0xFFFF0000u);
  v[4] = __uint_as_float(u.z << 16); v[5] = __uint_as_float(u.z & 0xFFFF0000u);
  v[6] = __uint_as_float(u.w << 16); v[7] = __uint_as_float(u.w & 0xFFFF0000u);
}
__device__ __forceinline__ float sigmoidf_(float x) { return __builtin_amdgcn_rcpf(1.f + __expf(-x)); }
__device__ __forceinline__ float gelu_tanh(float x) {
  float y = 0.7978845608028654f * (x + 0.044715f * x * x * x);
  float t = 1.f - 2.f * __builtin_amdgcn_rcpf(__expf(2.f * y) + 1.f);
  return 0.5f * x * (1.f + t);
}
__device__ __forceinline__ uint32_t ordf(float f) {
  uint32_t u = __float_as_uint(f);
  return (u & 0x80000000u) ? ~u : (u | 0x80000000u);
}
__device__ __forceinline__ float unordf(uint32_t o) {
  uint32_t u = (o & 0x80000000u) ? (o ^ 0x80000000u) : ~o;
  return __uint_as_float(u);
}
__device__ __forceinline__ unsigned hw_xcc_id() { return (unsigned)__builtin_amdgcn_s_getreg((3 << 11) | 20) & 0xFu; }
__device__ __forceinline__ int opaque_tid() {
  int t = threadIdx.x;
  asm volatile("" : "+v"(t));
  return t;
}
__device__ __forceinline__ const float* xrow(KParams& p, int row) {
  return row < NP ? p.x_prompt + (size_t)row * D : p.x_sample + (size_t)(row - NP) * D;
}

#define INS16(T, V)                                  \
  {                                                  \
    uint32_t _v = (V);                               \
    _Pragma("unroll") for (int _q = 0; _q < 16; _q++) { \
      uint32_t _hi = max(T[_q], _v);                 \
      _v = min(T[_q], _v);                           \
      T[_q] = _hi;                                   \
    }                                                \
  }

#define CE_DESC(A_, B_) { const uint32_t _h = max(A_, B_), _l = min(A_, B_); A_ = _h; B_ = _l; }
__device__ __forceinline__ void sort16_desc(uint32_t (&t)[16]) {
#pragma unroll
  for (int k = 2; k <= 16; k <<= 1) {
#pragma unroll
    for (int j = k >> 1; j > 0; j >>= 1) {
#pragma unroll
      for (int i = 0; i < 16; i++) {
        const int l = i ^ j;
        if (l > i) {
          if ((i & k) == 0) { CE_DESC(t[i], t[l]); } else { CE_DESC(t[l], t[i]); }
        }
      }
    }
  }
}
__device__ __forceinline__ void merge16_desc(uint32_t (&T)[16], const uint32_t (&S)[16]) {
#pragma unroll
  for (int i = 0; i < 16; i++) T[i] = max(T[i], S[15 - i]);
#pragma unroll
  for (int j = 8; j > 0; j >>= 1) {
#pragma unroll
    for (int i = 0; i < 16; i++) {
      const int l = i ^ j;
      if (l > i) { CE_DESC(T[i], T[l]); }
    }
  }
}

__device__ __forceinline__ void transpose_cvt(const float* __restrict__ W, u16* __restrict__ Wt, int K, int N,
                                              size_t gtid, size_t gsz) {
  size_t total = (size_t)N * (K / 8);
  for (size_t c = gtid; c < total; c += gsz) {
    int n = (int)(c % N);
    int kg = (int)(c / N);
    float v[8];
#pragma unroll
    for (int i = 0; i < 8; i++) v[i] = W[(size_t)(kg * 8 + i) * N + n];
    *(uint4*)(Wt + (size_t)n * K + kg * 8) = pack8(v);
  }
}
__device__ __forceinline__ void plain_cvt(const float* __restrict__ S, u16* __restrict__ Dst, size_t n, size_t gtid,
                                          size_t gsz) {
  size_t total = n / 8;
  const float4* s4 = (const float4*)S;
  for (size_t c = gtid; c < total; c += gsz) {
    float4 a = s4[2 * c], b = s4[2 * c + 1];
    float v[8] = {a.x, a.y, a.z, a.w, b.x, b.y, b.z, b.w};
    *(uint4*)(Dst + c * 8) = pack8(v);
  }
}

__device__ __forceinline__ void phase0(KParams& p, char* smem) {
  const int tid = opaque_tid();
  const size_t gtid = (size_t)blockIdx.x * 256 + tid, gsz = (size_t)gridDim.x * 256;
  char* ws = p.ws;
  {
    const int lane = tid & 63;
    const int gw = (int)(gtid >> 6), nw = (int)(gsz >> 6);
    u16* XN = (u16*)(ws + W_XN);
    for (int row = gw; row < NTOK; row += nw) {
      const float4* xr = (const float4*)xrow(p, row);
      float4 v[4];
      float ss = 0.f;
#pragma unroll
      for (int i = 0; i < 4; i++) {
        v[i] = xr[lane + i * 64];
        ss += v[i].x * v[i].x + v[i].y * v[i].y + v[i].z * v[i].z + v[i].w * v[i].w;
      }
#pragma unroll
      for (int o = 32; o > 0; o >>= 1) ss += __shfl_xor(ss, o);
      float rstd = rsqrtf(ss * (1.f / 1024.f) + EPS);
      const float4* g4 = (const float4*)p.norm1_g;
#pragma unroll
      for (int i = 0; i < 4; i++) {
        float4 g = g4[lane + i * 64];
        uint2 o;
        o.x = pack2(v[i].x * rstd * g.x, v[i].y * rstd * g.y);
        o.y = pack2(v[i].z * rstd * g.z, v[i].w * rstd * g.w);
        *(uint2*)(XN + (size_t)row * D + (lane + i * 64) * 4) = o;
      }
    }
  }
  {
    float* T = (float*)smem;
    for (int tile = blockIdx.x; tile < 2688; tile += gridDim.x) {
      const float* W;
      u16* Wt;
      int N, tl;
      if (tile < 1408) { W = p.w_in; Wt = (u16*)(ws + W_WTIN); N = 5632; tl = tile; }
      else if (tile < 1664) { W = p.w_branch_lru; Wt = (u16*)(ws + W_WTLRU); N = 1024; tl = tile - 1408; }
      else if (tile < 1920) { W = p.w_branch_attn; Wt = (u16*)(ws + W_WTATTN); N = 1024; tl = tile - 1664; }
      else if (tile < 2176) { W = p.w_out; Wt = (u16*)(ws + W_WTOUT); N = 1024; tl = tile - 1920; }
      else { W = p.peer_w_query; Wt = (u16*)(ws + W_WTQ); N = 2048; tl = tile - 2176; }
      const int ntn = N >> 6;
      const int kt = tl / ntn, nt = tl - kt * ntn;
      __syncthreads();
      {
        const float* src = W + (size_t)(kt * 64 + (tid >> 2)) * N + nt * 64 + (tid & 3) * 16;
        const float4 a0 = *(const float4*)src, a1 = *(const float4*)(src + 4), a2 = *(const float4*)(src + 8),
                     a3 = *(const float4*)(src + 12);
        float* d = T + (tid >> 2) * 65 + (tid & 3) * 16;
        d[0] = a0.x; d[1] = a0.y; d[2] = a0.z; d[3] = a0.w; d[4] = a1.x; d[5] = a1.y; d[6] = a1.z; d[7] = a1.w;
        d[8] = a2.x; d[9] = a2.y; d[10] = a2.z; d[11] = a2.w; d[12] = a3.x; d[13] = a3.y; d[14] = a3.z; d[15] = a3.w;
      }
      __syncthreads();
      {
        const int n = tid >> 2, kc = (tid & 3) * 16;
        float v[16];
#pragma unroll
        for (int i = 0; i < 16; i++) v[i] = T[(kc + i) * 65 + n];
        u16* dst = Wt + (size_t)(nt * 64 + n) * 1024 + kt * 64 + kc;
        *(uint4*)dst = pack8(v);
        *(uint4*)(dst + 8) = pack8(v + 8);
      }
    }
  }
  {
    u16* RA = (u16*)(ws + W_RGA);
    u16* RX = (u16*)(ws + W_RGX);
    for (size_t e = gtid; e < 65536; e += gsz) {
      int n = (int)(e >> 12), k = (int)((e >> 6) & 63), j = (int)(e & 63);
      RA[e] = f2bf(p.rg_w_a[n * 4096 + j * 64 + k]);
      RX[e] = f2bf(p.rg_w_x[n * 4096 + j * 64 + k]);
    }
  }
  plain_cvt(p.peer_sub_keys, (u16*)(ws + W_SK), (size_t)16 * 128 * 128, gtid, gsz);
  {
    const int lane = tid & 63;
    const int gw = (int)(gtid >> 6), nw = (int)(gsz >> 6);
    unsigned char* E8 = (unsigned char*)(ws + W_EU);
    float* ESC = (float*)(ws + W_ESC);
    for (int r = gw; r < 32768; r += nw) {
      const float* src = (r < 16384 ? p.expert_u : p.expert_v) + (size_t)(r & 16383) * 1024 + lane * 16;
      const float4 a0 = *(const float4*)src, a1 = *(const float4*)(src + 4), a2 = *(const float4*)(src + 8),
                   a3 = *(const float4*)(src + 12);
      float am = fmaxf(fmaxf(fmaxf(fabsf(a0.x), fabsf(a0.y)), fmaxf(fabsf(a0.z), fabsf(a0.w))),
                       fmaxf(fmaxf(fabsf(a1.x), fabsf(a1.y)), fmaxf(fabsf(a1.z), fabsf(a1.w))));
      am = fmaxf(am, fmaxf(fmaxf(fmaxf(fabsf(a2.x), fabsf(a2.y)), fmaxf(fabsf(a2.z), fabsf(a2.w))),
                           fmaxf(fmaxf(fabsf(a3.x), fabsf(a3.y)), fmaxf(fabsf(a3.z), fabsf(a3.w)))));
#pragma unroll
      for (int o = 32; o > 0; o >>= 1) am = fmaxf(am, __shfl_xor(am, o));
      const float sc = am > 0.f ? 224.f / am : 1.f;
      uint4 o4;
      int wv;
      wv = __builtin_amdgcn_cvt_pk_fp8_f32(a0.x * sc, a0.y * sc, 0, false);
      wv = __builtin_amdgcn_cvt_pk_fp8_f32(a0.z * sc, a0.w * sc, wv, true);
      o4.x = (uint32_t)wv;
      wv = __builtin_amdgcn_cvt_pk_fp8_f32(a1.x * sc, a1.y * sc, 0, false);
      wv = __builtin_amdgcn_cvt_pk_fp8_f32(a1.z * sc, a1.w * sc, wv, true);
      o4.y = (uint32_t)wv;
      wv = __builtin_amdgcn_cvt_pk_fp8_f32(a2.x * sc, a2.y * sc, 0, false);
      wv = __builtin_amdgcn_cvt_pk_fp8_f32(a2.z * sc, a2.w * sc, wv, true);
      o4.z = (uint32_t)wv;
      wv = __builtin_amdgcn_cvt_pk_fp8_f32(a3.x * sc, a3.y * sc, 0, false);
      wv = __builtin_amdgcn_cvt_pk_fp8_f32(a3.z * sc, a3.w * sc, wv, true);
      o4.w = (uint32_t)wv;
      if (r < 16384) *(uint4*)(E8 + (size_t)r * 1024 + lane * 16) = o4;
      else *(uint4*)(E8 + (size_t)16384 * 1024 + (size_t)(lane >> 3) * (16384 * 128) + (size_t)(r - 16384) * 128 + (lane & 7) * 16) = o4;
      if (lane == 0) ESC[r] = am > 0.f ? am * (1.f / 224.f) : 1.f;
    }
  }
}

constexpr int LDT = 72;
constexpr int CS_LD = 132;

template <int NW>
__device__ __forceinline__ void gemm_tile(const u16* __restrict__ A, int lda, const u16* __restrict__ Bt, int ldb,
                                          int K, f32x4 (&acc)[4][NW / 32], char* smem, int tid) {
  constexpr int NJ = NW / 32;
  const int lane = tid & 63, w = tid >> 6;
  const int wm = w >> 1, wn = w & 1;
  const int l15 = lane & 15, quad = lane >> 4;
  const int lr = w * 8 + (lane >> 3);
  const int lc = ((lane & 7) ^ ((lane >> 3) & 7)) * 8;
  const char* Ab = (const char*)A;
  const char* Bb = (const char*)Bt;
  const uint32_t ao = (uint32_t)(lr * lda + lc) * 2u, bo = (uint32_t)(lr * ldb + lc) * 2u;
  const uint32_t sa2 = 64u * (uint32_t)lda, sb2 = 64u * (uint32_t)ldb;
  const uint32_t kmask = (uint32_t)K - 1u, kst = (((uint32_t)blockIdx.x >> 3) * 64u) & kmask;
  char* lw = smem + w * 1024 + lane * 16;
  const int swz = l15 & 7;
  const char* Ar = smem + (wm * 64 + l15) * 128 + ((quad ^ swz) * 16);
  const char* Br = smem + 16384 + (wn * (NW / 2) + l15) * 128 + ((quad ^ swz) * 16);
  const char* Ar1 = smem + (wm * 64 + l15) * 128 + (((4 + quad) ^ swz) * 16);
  const char* Br1 = smem + 16384 + (wn * (NW / 2) + l15) * 128 + (((4 + quad) ^ swz) * 16);
#define GT_ISSUE(st, off)                                                                                   \
  {                                                                                                         \
    const uint32_t _o = (((uint32_t)(off) + kst) & kmask) * 2u;                                             \
    char* _l = lw + (st) * 32768;                                                                           \
    _Pragma("unroll") for (int j = 0; j < 4; j++) {                                                         \
      __builtin_amdgcn_global_load_lds((const unsigned*)(Ab + (size_t)(ao + j * sa2 + _o)), (unsigned*)(_l + j * 4096), 16, 0, 0);          \
      if (j < NJ) __builtin_amdgcn_global_load_lds((const unsigned*)(Bb + (size_t)(bo + j * sb2 + _o)), (unsigned*)(_l + 16384 + j * 4096), 16, 0, 0);  \
    }                                                                                                       \
  }
#define GT_MMA(st)                                                                                          \
  {                                                                                                         \
    const char* _ar = Ar + (st) * 32768; const char* _br = Br + (st) * 32768;                               \
    const char* _ar1 = Ar1 + (st) * 32768; const char* _br1 = Br1 + (st) * 32768;                           \
    bf16x8 a0[4], b0[NJ], a1[4], b1[NJ];                                                                      \
    _Pragma("unroll") for (int i = 0; i < 4; i++) {                                                         \
      a0[i] = *(const bf16x8*)(_ar + i * 2048);                                                             \
      if (i < NJ) b0[i] = *(const bf16x8*)(_br + i * 2048);                                                 \
    }                                                                                                       \
    _Pragma("unroll") for (int i = 0; i < 4; i++) {                                                         \
      a1[i] = *(const bf16x8*)(_ar1 + i * 2048);                                                            \
      if (i < NJ) b1[i] = *(const bf16x8*)(_br1 + i * 2048);                                                \
    }                                                                                                       \
    __builtin_amdgcn_s_setprio(1);                                                                          \
    _Pragma("unroll") for (int i = 0; i < 4; i++)                                                           \
      _Pragma("unroll") for (int j = 0; j < NJ; j++)                                                        \
        acc[i][j] = __builtin_amdgcn_mfma_f32_16x16x32_bf16(a0[i], b0[j], acc[i][j], 0, 0, 0);              \
    _Pragma("unroll") for (int i = 0; i < 4; i++)                                                           \
      _Pragma("unroll") for (int j = 0; j < NJ; j++)                                                        \
        acc[i][j] = __builtin_amdgcn_mfma_f32_16x16x32_bf16(a1[i], b1[j], acc[i][j], 0, 0, 0);              \
    __builtin_amdgcn_s_setprio(0);                                                                          \
  }
  __syncthreads();
  GT_ISSUE(0, 0);
  for (int k0 = 0; k0 < K; k0 += 128) {
    asm volatile("s_waitcnt vmcnt(0) lgkmcnt(0)" ::: "memory");
    __builtin_amdgcn_s_barrier();
    asm volatile("" ::: "memory");
    GT_ISSUE(1, k0 + 64);
    GT_MMA(0);
    asm volatile("s_waitcnt vmcnt(0) lgkmcnt(0)" ::: "memory");
    __builtin_amdgcn_s_barrier();
    asm volatile("" ::: "memory");
    if (k0 + 128 < K) GT_ISSUE(0, k0 + 128);
    GT_MMA(1);
  }
#undef GT_ISSUE
#undef GT_MMA
}

__device__ __forceinline__ void tile_map(int it, int total, int NT, int& mt, int& nt, int vb) {
  const int G = gridDim.x;
  int T = it;
  {
    const int round = it / G;
    if (round * G + G <= total) T = round * G + vb;
  }
  const int g = T / (8 * NT), r = T - g * (8 * NT);
  nt = r >> 3;
  mt = g * 8 + (r & 7);
}

template <int NJ>
__device__ __forceinline__ void zero_acc(f32x4 (&acc)[4][NJ]) {
#pragma unroll
  for (int i = 0; i < 4; i++)
#pragma unroll
    for (int j = 0; j < NJ; j++) acc[i][j] = (f32x4){0.f, 0.f, 0.f, 0.f};
}

template <int NJ>
__device__ __forceinline__ void acc_to_cs(const f32x4 (&acc)[4][NJ], float* Cs, int tid) {
  const int lane = tid & 63, w = tid >> 6;
  const int wm = w >> 1, wn = w & 1;
  const int l15 = lane & 15, quad = lane >> 4;
#pragma unroll
  for (int i = 0; i < 4; i++)
#pragma unroll
    for (int j = 0; j < NJ; j++)
#pragma unroll
      for (int e = 0; e < 4; e++)
        Cs[(wm * 64 + i * 16 + quad * 4 + e) * CS_LD + wn * (NJ * 16) + j * 16 + l15] = acc[i][j][e];
}

__device__ __forceinline__ void phase_g1(KParams& p, char* smem, int vb) {
  const int tid = opaque_tid();
  u16* As = (u16*)smem;
  u16* Bs = As + 2 * 128 * LDT;
  float* Cs = (float*)smem;
  const u16* XN = (const u16*)(p.ws + W_XN);
  const u16* WT = (const u16*)(p.ws + W_WTIN);
  for (int t = blockIdx.x; t < MT * 44; t += gridDim.x) {
    int mt, nt;
    tile_map(t, MT * 44, 44, mt, nt, vb);
    f32x4 acc[4][4];
    zero_acc(acc);
    gemm_tile<128>(XN + (size_t)mt * 128 * 1024, 1024, WT + (size_t)nt * 128 * 1024, 1024, 1024, acc, smem, tid);
    __syncthreads();
    acc_to_cs(acc, Cs, tid);
    __syncthreads();
    const int n0 = nt * 128;
    u16* dst;
    int ldd, col;
    if (n0 < 2048) { dst = (u16*)(p.ws + W_ZA); ldd = 2048; col = n0; }
    else if (n0 < 3584) { dst = (u16*)(p.ws + W_ZB); ldd = 1536; col = n0 - 2048; }
    else { dst = (u16*)p.out; ldd = 2048; col = n0 - 3584; }
    const int cc = (tid & 15) * 8;
#pragma unroll
    for (int i = 0; i < 8; i++) {
      const int r = (tid >> 4) + 16 * i;
      float4 a = *(const float4*)(Cs + r * CS_LD + cc), b = *(const float4*)(Cs + r * CS_LD + cc + 4);
      float v[8] = {a.x, a.y, a.z, a.w, b.x, b.y, b.z, b.w};
      *(uint4*)(dst + (size_t)(mt * 128 + r) * ldd + col + cc) = pack8(v);
    }
    __syncthreads();
  }
}

constexpr int KS_LD = 72, VT_LD = 200, PS_LD = 168;
__device__ __forceinline__ void attn_item(KParams& p, char* smem, int item) {
  const int tid = opaque_tid(), lane = tid & 63, w = tid >> 6, l15 = lane & 15, quad = lane >> 4;
  u16* Ks = (u16*)smem;
  u16* Vt = Ks + 192 * KS_LD;
  u16* Ps = Vt + 64 * VT_LD + w * 16 * PS_LD;
  const u16* ZB = (const u16*)(p.ws + W_ZB);
  u16* ATT = (u16*)(p.ws + W_XN);
  const bool sample = item >= 1024;
  int b, qb = 0, kv, rowbase, p0 = 0;
  if (!sample) {
    kv = item & 3; qb = (item >> 2) & 63; b = item >> 8;
    p0 = qb * 64;
    rowbase = b * SEQ + p0;
  } else {
    int it = item - 1024;
    kv = it & 3; b = it >> 2;
    rowbase = NP + b * 8;
  }
  __syncthreads();
  {
    const int ch = tid & 7;
    float kg[8];
#pragma unroll
    for (int i = 0; i < 8; i++) kg[i] = p.k_norm_g[ch * 8 + i];
    const int nrows = sample ? 160 : 192;
    for (int c = tid; c < nrows * 8; c += 256) {
      const int row = c >> 3;
      float kf[8], vf[8];
      bool valid, donorm;
      if (!sample) {
        const int pos = p0 - 128 + row;
        valid = pos >= 0;
        donorm = true;
        if (valid) {
          const u16* src = ZB + (size_t)(b * SEQ + pos) * 1536 + 1024 + kv * 64 + ch * 8;
          unpack8(*(const uint4*)src, kf);
          unpack8(*(const uint4*)(src + 256), vf);
        }
      } else {
        valid = row < 136;
        donorm = row >= 128;
        if (row < 128) {
          const float* sk = p.cache_k + ((size_t)(b * 128 + row) * 4 + kv) * 64 + ch * 8;
          const float* sv = p.cache_v + ((size_t)(b * 128 + row) * 4 + kv) * 64 + ch * 8;
          float4 a0 = *(const float4*)sk, a1 = *(const float4*)(sk + 4);
          float4 b0 = *(const float4*)sv, b1 = *(const float4*)(sv + 4);
          kf[0] = a0.x; kf[1] = a0.y; kf[2] = a0.z; kf[3] = a0.w; kf[4] = a1.x; kf[5] = a1.y; kf[6] = a1.z; kf[7] = a1.w;
          vf[0] = b0.x; vf[1] = b0.y; vf[2] = b0.z; vf[3] = b0.w; vf[4] = b1.x; vf[5] = b1.y; vf[6] = b1.z; vf[7] = b1.w;
        } else if (valid) {
          const u16* src = ZB + (size_t)(NP + b * 8 + (row - 128)) * 1536 + 1024 + kv * 64 + ch * 8;
          unpack8(*(const uint4*)src, kf);
          unpack8(*(const uint4*)(src + 256), vf);
        }
      }
      if (!valid) {
#pragma unroll
        for (int i = 0; i < 8; i++) { kf[i] = 0.f; vf[i] = 0.f; }
      }
      float ss = 0.f;
#pragma unroll
      for (int i = 0; i < 8; i++) ss += kf[i] * kf[i];
      ss += __shfl_xor(ss, 1);
      ss += __shfl_xor(ss, 2);
      ss += __shfl_xor(ss, 4);
      if (donorm) {
        const float rstd = rsqrtf(ss * (1.f / 64.f) + EPS);
#pragma unroll
        for (int i = 0; i < 8; i++) kf[i] = kf[i] * rstd * kg[i];
      }
      *(uint4*)(Ks + row * KS_LD + ch * 8) = pack8(kf);
#pragma unroll
      for (int i = 0; i < 8; i++) Vt[(ch * 8 + i) * VT_LD + row] = f2bf(vf[i]);
      if (!sample) {
        if (qb >= 62 && row >= 128) {
          const int wpos = p0 + (row - 128) - (SEQ - 128);
          float* ko = p.out + O_KP + ((size_t)(b * 128 + wpos) * 4 + kv) * 64 + ch * 8;
          float* vo = p.out + O_VP + ((size_t)(b * 128 + wpos) * 4 + kv) * 64 + ch * 8;
          *(float4*)ko = make_float4(kf[0], kf[1], kf[2], kf[3]);
          *(float4*)(ko + 4) = make_float4(kf[4], kf[5], kf[6], kf[7]);
          *(float4*)vo = make_float4(vf[0], vf[1], vf[2], vf[3]);
          *(float4*)(vo + 4) = make_float4(vf[4], vf[5], vf[6], vf[7]);
        }
      } else {
        if (row >= 8 && row < 136) {
          float* ko = p.out + O_KS + ((size_t)(b * 128 + (row - 8)) * 4 + kv) * 64 + ch * 8;
          float* vo = p.out + O_VS + ((size_t)(b * 128 + (row - 8)) * 4 + kv) * 64 + ch * 8;
          *(float4*)ko = make_float4(kf[0], kf[1], kf[2], kf[3]);
          *(float4*)(ko + 4) = make_float4(kf[4], kf[5], kf[6], kf[7]);
          *(float4*)vo = make_float4(vf[0], vf[1], vf[2], vf[3]);
          *(float4*)(vo + 4) = make_float4(vf[4], vf[5], vf[6], vf[7]);
        }
      }
    }
  }
  __syncthreads();
  const int hq = kv * 4 + w;
  const float slope = exp2f(-0.5f * (float)(hq + 1));
  const float sink = p.attn_sinks[hq];
  float qg[2][8];
#pragma unroll
  for (int ks = 0; ks < 2; ks++)
#pragma unroll
    for (int i = 0; i < 8; i++) qg[ks][i] = p.q_norm_g[ks * 32 + quad * 8 + i] * 0.125f;
  const int nsub = sample ? 1 : 4;
  for (int sb = 0; sb < nsub; sb++) {
    const int r0 = sb * 16;
    const int ws0 = r0 < 32 ? r0 : 32;
    bf16x8 qa[2];
    {
      const int qr = sample ? (l15 & 7) : (r0 + l15);
      const u16* src = ZB + (size_t)(rowbase + qr) * 1536 + hq * 64 + quad * 8;
      float q0[8], q1[8];
      unpack8(*(const uint4*)src, q0);
      unpack8(*(const uint4*)(src + 32), q1);
      float ss = 0.f;
#pragma unroll
      for (int i = 0; i < 8; i++) ss += q0[i] * q0[i] + q1[i] * q1[i];
      ss += __shfl_xor(ss, 16);
      ss += __shfl_xor(ss, 32);
      const float rstd = rsqrtf(ss * (1.f / 64.f) + EPS);
#pragma unroll
      for (int i = 0; i < 8; i++) { q0[i] *= rstd * qg[0][i]; q1[i] *= rstd * qg[1][i]; }
      uint4 u0 = pack8(q0), u1 = pack8(q1);
      qa[0] = __builtin_bit_cast(bf16x8, u0);
      qa[1] = __builtin_bit_cast(bf16x8, u1);
    }
    f32x4 s[10];
#pragma unroll
    for (int kt = 0; kt < 10; kt++) {
      const u16* kp = Ks + (ws0 + kt * 16 + l15) * KS_LD + quad * 8;
      bf16x8 b0 = *(const bf16x8*)kp, b1 = *(const bf16x8*)(kp + 32);
      f32x4 z = {0.f, 0.f, 0.f, 0.f};
      z = __builtin_amdgcn_mfma_f32_16x16x32_bf16(qa[0], b0, z, 0, 0, 0);
      s[kt] = __builtin_amdgcn_mfma_f32_16x16x32_bf16(qa[1], b1, z, 0, 0, 0);
    }
    float mx[4] = {-1e30f, -1e30f, -1e30f, -1e30f};
#pragma unroll
    for (int kt = 0; kt < 10; kt++) {
      const int jj = ws0 + kt * 16 + l15;
      const bool posok = sample ? (jj < 136) : (p0 - 128 + jj >= 0);
#pragma unroll
      for (int e = 0; e < 4; e++) {
        const int r = r0 + quad * 4 + e;
        const int dist = r + 128 - jj;
        const bool ok = posok && dist >= 0 && dist <= 128;
        float v = ok ? (s[kt][e] - slope * (float)dist) : -1e30f;
        s[kt][e] = v;
        mx[e] = fmaxf(mx[e], v);
      }
    }
    float sum[4];
#pragma unroll
    for (int e = 0; e < 4; e++) {
      float m = mx[e];
      m = fmaxf(m, __shfl_xor(m, 1));
      m = fmaxf(m, __shfl_xor(m, 2));
      m = fmaxf(m, __shfl_xor(m, 4));
      m = fmaxf(m, __shfl_xor(m, 8));
      m = fmaxf(m, sink);
      mx[e] = m;
      sum[e] = 0.f;
    }
#pragma unroll
    for (int kt = 0; kt < 10; kt++) {
#pragma unroll
      for (int e = 0; e < 4; e++) {
        float pv = __expf(s[kt][e] - mx[e]);
        sum[e] += pv;
        Ps[(quad * 4 + e) * PS_LD + kt * 16 + l15] = f2bf(pv);
      }
    }
#pragma unroll
    for (int e = 0; e < 4; e++) {
      float t = sum[e];
      t += __shfl_xor(t, 1);
      t += __shfl_xor(t, 2);
      t += __shfl_xor(t, 4);
      t += __shfl_xor(t, 8);
      sum[e] = 1.f / (t + __expf(sink - mx[e]));
    }
    __syncthreads();
    f32x4 o[4];
#pragma unroll
    for (int nt = 0; nt < 4; nt++) o[nt] = (f32x4){0.f, 0.f, 0.f, 0.f};
#pragma unroll
    for (int kk = 0; kk < 5; kk++) {
      bf16x8 pa = *(const bf16x8*)(Ps + l15 * PS_LD + kk * 32 + quad * 8);
#pragma unroll
      for (int nt = 0; nt < 4; nt++) {
        bf16x8 vb = *(const bf16x8*)(Vt + (nt * 16 + l15) * VT_LD + ws0 + kk * 32 + quad * 8);
        o[nt] = __builtin_amdgcn_mfma_f32_16x16x32_bf16(pa, vb, o[nt], 0, 0, 0);
      }
    }
#pragma unroll
    for (int e = 0; e < 4; e++) {
      const int r = quad * 4 + e;
      if (!sample || r < 8) {
        u16* dst = ATT + (size_t)(rowbase + r0 + r) * 1024 + hq * 64 + l15;
#pragma unroll
        for (int nt = 0; nt < 4; nt++) dst[nt * 16] = f2bf(o[nt][e] * sum[e]);
      }
    }
    __syncthreads();
  }
}

constexpr int XC_LD = 68;
__device__ __forceinline__ void lru_tile(KParams& p, char* smem, int mt, int nb, int mode) {
  const int tid = opaque_tid(), lane = tid & 63, w = tid >> 6, l15 = lane & 15, quad = lane >> 4;
  float* xcF = (float*)smem;
  float* aL = xcF + 128 * XC_LD;
  float* aggL = aL + 128 * XC_LD;
  const u16* ZA = (const u16*)(p.ws + W_ZA);
  const bool sample = mt >= 128;
  const int m0 = mt * 128;
  const int cb = nb * 64;
  __syncthreads();
  {
    const int ch = tid & 7;
    float cw[4][8], cbias[8];
#pragma unroll
    for (int j = 0; j < 4; j++)
#pragma unroll
      for (int i = 0; i < 8; i++) cw[j][i] = p.conv_w[j * 1024 + cb + ch * 8 + i];
#pragma unroll
    for (int i = 0; i < 8; i++) cbias[i] = p.conv_b[cb + ch * 8 + i];
#pragma unroll
    for (int it = 0; it < 4; it++) {
      const int r = (tid >> 3) + it * 32;
      const int grow = m0 + r;
      const int t = sample ? (r & 7) : ((mt & 31) * 128 + r);
      float y[8];
#pragma unroll
      for (int i = 0; i < 8; i++) y[i] = cbias[i];
#pragma unroll
      for (int d = 0; d < 4; d++) {
        float xv[8];
        if (t - d >= 0) {
          unpack8(*(const uint4*)(ZA + (size_t)(grow - d) * 2048 + cb + ch * 8), xv);
        } else if (sample) {
          const int bb = (m0 - NP + r) >> 3;
          const float* src = p.cache_conv + ((size_t)bb * 3 + (3 + t - d)) * 1024 + cb + ch * 8;
          float4 a = *(const float4*)src, b4 = *(const float4*)(src + 4);
          xv[0] = a.x; xv[1] = a.y; xv[2] = a.z; xv[3] = a.w; xv[4] = b4.x; xv[5] = b4.y; xv[6] = b4.z; xv[7] = b4.w;
        } else {
#pragma unroll
          for (int i = 0; i < 8; i++) xv[i] = 0.f;
        }
#pragma unroll
        for (int i = 0; i < 8; i++) y[i] += cw[3 - d][i] * xv[i];
        if (d == 0 && mode != 0) {
          if (!sample) {
            if ((mt & 31) == 31 && r >= 125) {
              float* dst = p.out + O_CONVP + ((size_t)(mt >> 5) * 3 + (r - 125)) * 1024 + cb + ch * 8;
              *(float4*)dst = make_float4(xv[0], xv[1], xv[2], xv[3]);
              *(float4*)(dst + 4) = make_float4(xv[4], xv[5], xv[6], xv[7]);
            }
          } else if (t >= 5) {
            const int bb = (m0 - NP + r) >> 3;
            float* dst = p.out + O_CONVS + ((size_t)bb * 3 + (t - 5)) * 1024 + cb + ch * 8;
            *(float4*)dst = make_float4(xv[0], xv[1], xv[2], xv[3]);
            *(float4*)(dst + 4) = make_float4(xv[4], xv[5], xv[6], xv[7]);
          }
        }
      }
      *(float4*)(xcF + r * XC_LD + ch * 8) = make_float4(y[0], y[1], y[2], y[3]);
      *(float4*)(xcF + r * XC_LD + ch * 8 + 4) = make_float4(y[4], y[5], y[6], y[7]);
    }
  }
  __syncthreads();
  {
    const u16* RA = (const u16*)(p.ws + W_RGA) + nb * 4096;
    const u16* RX = (const u16*)(p.ws + W_RGX) + nb * 4096;
    f32x4 aR[2][4], aI[2][4];
#pragma unroll
    for (int i = 0; i < 2; i++)
#pragma unroll
      for (int j = 0; j < 4; j++) { aR[i][j] = (f32x4){0.f, 0.f, 0.f, 0.f}; aI[i][j] = (f32x4){0.f, 0.f, 0.f, 0.f}; }
#pragma unroll
    for (int ks = 0; ks < 2; ks++) {
      bf16x8 a[2];
#pragma unroll
      for (int i = 0; i < 2; i++) {
        const float* src = xcF + (w * 32 + i * 16 + l15) * XC_LD + ks * 32 + quad * 8;
        float4 x0 = *(const float4*)src, x1 = *(const float4*)(src + 4);
        float v[8] = {x0.x, x0.y, x0.z, x0.w, x1.x, x1.y, x1.z, x1.w};
        uint4 u = pack8(v);
        a[i] = __builtin_bit_cast(bf16x8, u);
      }
#pragma unroll
      for (int j = 0; j < 4; j++) {
        bf16x8 ba = *(const bf16x8*)(RA + (j * 16 + l15) * 64 + ks * 32 + quad * 8);
        bf16x8 bx = *(const bf16x8*)(RX + (j * 16 + l15) * 64 + ks * 32 + quad * 8);
#pragma unroll
        for (int i = 0; i < 2; i++) {
          aR[i][j] = __builtin_amdgcn_mfma_f32_16x16x32_bf16(a[i], ba, aR[i][j], 0, 0, 0);
          aI[i][j] = __builtin_amdgcn_mfma_f32_16x16x32_bf16(a[i], bx, aI[i][j], 0, 0, 0);
        }
      }
    }
#pragma unroll
    for (int j = 0; j < 4; j++) {
      const int c = cb + j * 16 + l15;
      const float ba = p.rg_b_a[c], bx = p.rg_b_x[c];
      const float ls = -log1pf(__expf(-p.rg_lambda[c]));
#pragma unroll
      for (int i = 0; i < 2; i++)
#pragma unroll
        for (int e = 0; e < 4; e++) {
          const int row = w * 32 + i * 16 + quad * 4 + e;
          const float rg = sigmoidf_(aR[i][j][e] + ba);
          const float ig = sigmoidf_(aI[i][j][e] + bx);
          const float la = 8.f * rg * ls;
          const float av = __expf(la);
          const float x2 = 2.f * la;
          const float emt = -x2 * (1.f + x2 * (0.5f + x2 * (0.16666667f + x2 * (0.041666668f + x2 * 0.008333334f))));
          const float em = x2 > -0.25f ? emt : 1.f - __expf(x2);
          const float mult = __builtin_amdgcn_sqrtf(fmaxf(em, 0.f));
          const int idx = row * XC_LD + j * 16 + l15;
          const float xv = xcF[idx];
          aL[idx] = av;
          xcF[idx] = mult * ig * xv;
        }
    }
  }
  __syncthreads();
  uint4 grw[4];
  if (mode != 0) {
#pragma unroll
    for (int it = 0; it < 4; it++)
      grw[it] = *(const uint4*)(ZA + (size_t)(m0 + (tid >> 3) + it * 32) * 2048 + 1024 + cb + (tid & 7) * 8);
  }
  const int c = cb + lane;
  float* carL = aggL + 512;
  if (!sample) {
    float* AGGP = (float*)(p.ws + W_AGG);
    float* AGGH = AGGP + 128 * 1024;
    const int chunk = mt & 31, base = mt - chunk;
    if (mode == 1) {
      float Pq[8], Hq[8];
#pragma unroll
      for (int k = 0; k < 8; k++) {
        const int q = w * 8 + k;
        const bool ok = q < chunk;
        Pq[k] = ok ? AGGP[(base + q) * 1024 + c] : 1.f;
        Hq[k] = ok ? AGGH[(base + q) * 1024 + c] : 0.f;
      }
      float Pc = 1.f, hc = 0.f;
#pragma unroll
      for (int k = 0; k < 8; k++) { hc = Pq[k] * hc + Hq[k]; Pc *= Pq[k]; }
      carL[(w * 64 + lane) * 2] = Pc;
      carL[(w * 64 + lane) * 2 + 1] = hc;
    }
    float P = 1.f, h = 0.f;
#pragma unroll 8
    for (int rr = 0; rr < 32; rr++) {
      const float av = aL[(w * 32 + rr) * XC_LD + lane], bv = xcF[(w * 32 + rr) * XC_LD + lane];
      h = av * h + bv;
      P *= av;
    }
    aggL[(w * 64 + lane) * 2] = P;
    aggL[(w * 64 + lane) * 2 + 1] = h;
    __syncthreads();
    if (mode == 0 || mode == 2) {
      if (w == 0) {
        float Pt = 1.f, ht = 0.f;
#pragma unroll
        for (int q = 0; q < 4; q++) {
          const float Pq = aggL[(q * 64 + lane) * 2], hq = aggL[(q * 64 + lane) * 2 + 1];
          ht = Pq * ht + hq;
          Pt *= Pq;
        }
        if (mode == 0) {
          AGGP[mt * 1024 + c] = Pt;
          AGGH[mt * 1024 + c] = ht;
        } else {
          __hip_atomic_store(&AGGP[mt * 1024 + c], Pt, __ATOMIC_RELAXED, __HIP_MEMORY_SCOPE_AGENT);
          __hip_atomic_store(&AGGH[mt * 1024 + c], ht, __ATOMIC_RELAXED, __HIP_MEMORY_SCOPE_AGENT);
          asm volatile("s_waitcnt vmcnt(0)" ::: "memory");
          if (lane == 0)
            __hip_atomic_store((unsigned*)(p.ws + W_FLAG) + mt * 16 + nb, 1u, __ATOMIC_RELAXED, __HIP_MEMORY_SCOPE_AGENT);
        }
      }
    }
    if (mode == 2) {
      {
        const int q = w * 8 + (lane & 7);
        const bool need = (lane < 8) && (q < chunk);
        unsigned* fp = (unsigned*)(p.ws + W_FLAG) + (base + (need ? q : 0)) * 16 + nb;
        unsigned spins = 0;
        for (;;) {
          const unsigned f = need ? __hip_atomic_load(fp, __ATOMIC_RELAXED, __HIP_MEMORY_SCOPE_AGENT) : 1u;
          if (__ballot(f == 0u) == 0ull) break;
          __builtin_amdgcn_s_sleep(2);
          if (++spins > (1u << 20)) break;
        }
      }
      float Pq[8], Hq[8];
#pragma unroll
      for (int k = 0; k < 8; k++) {
        const int q = w * 8 + k;
        const bool ok = q < chunk;
        Pq[k] = ok ? __hip_atomic_load(&AGGP[(base + q) * 1024 + c], __ATOMIC_RELAXED, __HIP_MEMORY_SCOPE_AGENT) : 1.f;
        Hq[k] = ok ? __hip_atomic_load(&AGGH[(base + q) * 1024 + c], __ATOMIC_RELAXED, __HIP_MEMORY_SCOPE_AGENT) : 0.f;
      }
      float Pc = 1.f, hc = 0.f;
#pragma unroll
      for (int k = 0; k < 8; k++) { hc = Pq[k] * hc + Hq[k]; Pc *= Pq[k]; }
      carL[(w * 64 + lane) * 2] = Pc;
      carL[(w * 64 + lane) * 2 + 1] = hc;
      __syncthreads();
    }
    if (mode == 0) {
    } else {
      float hin = 0.f;
#pragma unroll
      for (int q = 0; q < 4; q++) hin = carL[(q * 64 + lane) * 2] * hin + carL[(q * 64 + lane) * 2 + 1];
      for (int q = 0; q < w; q++) hin = aggL[(q * 64 + lane) * 2] * hin + aggL[(q * 64 + lane) * 2 + 1];
      float hh = hin;
#pragma unroll 8
      for (int rr = 0; rr < 32; rr++) {
        const int row = w * 32 + rr;
        const float av = aL[row * XC_LD + lane], bv = xcF[row * XC_LD + lane];
        hh = av * hh + bv;
        xcF[row * XC_LD + lane] = hh;
      }
      if (chunk == 31 && w == 3) p.out[O_LRUP + (size_t)(mt >> 5) * 1024 + c] = hh;
    }
  } else {
    float hh = 0.f;
    float h0v[4];
#pragma unroll
    for (int k = 0; k < 4; k++) h0v[k] = p.state_lru[(size_t)(((m0 - NP + w * 32) >> 3) + k) * 1024 + c];
#pragma unroll
    for (int rr = 0; rr < 32; rr++) {
      const int row = w * 32 + rr;
      const int bb = (m0 - NP + row) >> 3;
      const int t = row & 7;
      if (t == 0) hh = h0v[rr >> 3];
      const float av = aL[row * XC_LD + lane], bv = xcF[row * XC_LD + lane];
      hh = av * hh + bv;
      xcF[row * XC_LD + lane] = hh;
      if (t == 7) p.out[O_LRUS + (size_t)bb * 1024 + c] = hh;
    }
  }
  if (mode != 0) {
    __syncthreads();
    u16* LO = (u16*)(p.ws + W_LO);
    const int ch = tid & 7;
#pragma unroll
    for (int it = 0; it < 4; it++) {
      const int r = (tid >> 3) + it * 32;
      float g[8];
      unpack8(grw[it], g);
      const float4 h0 = *(const float4*)(xcF + r * XC_LD + ch * 8), h1 = *(const float4*)(xcF + r * XC_LD + ch * 8 + 4);
      float v[8] = {h0.x * gelu_tanh(g[0]), h0.y * gelu_tanh(g[1]), h0.z * gelu_tanh(g[2]), h0.w * gelu_tanh(g[3]),
                    h1.x * gelu_tanh(g[4]), h1.y * gelu_tanh(g[5]), h1.z * gelu_tanh(g[6]), h1.w * gelu_tanh(g[7])};
      *(uint4*)(LO + (size_t)(m0 + r) * 1024 + cb + ch * 8) = pack8(v);
    }
  }
}

template <int NW>
__device__ __forceinline__ void g3_tile(KParams& p, char* smem, int mt, int n0) {
  const int tid = opaque_tid();
  float* Cs = (float*)smem;
  const u16* LO = (const u16*)(p.ws + W_LO);
  const u16* ATT = (const u16*)(p.ws + W_XN);
  const u16* WL = (const u16*)(p.ws + W_WTLRU);
  const u16* WA = (const u16*)(p.ws + W_WTATTN);
  const u16* ZC = (const u16*)p.out;
  u16* MG = (u16*)(p.ws + W_ZA);
  constexpr int TPR = NW / 8;
  constexpr int RPI = 256 / TPR;
  const int cc = (tid % TPR) * 8;
  uint4 part[128 / RPI];
#pragma unroll
  for (int pass = 0; pass < 2; pass++) {
    f32x4 acc[4][NW / 32];
    zero_acc(acc);
    gemm_tile<NW>((pass ? ATT : LO) + (size_t)mt * 128 * 1024, 1024, (pass ? WA : WL) + (size_t)n0 * 1024, 1024, 1024, acc,
                  smem, tid);
    uint4 graw[128 / RPI];
#pragma unroll
    for (int i = 0; i < 128 / RPI; i++)
      graw[i] = *(const uint4*)(ZC + (size_t)(mt * 128 + (tid / TPR) + RPI * i) * 2048 + pass * 1024 + n0 + cc);
    __syncthreads();
    acc_to_cs(acc, Cs, tid);
    __syncthreads();
#pragma unroll
    for (int i = 0; i < 128 / RPI; i++) {
      const int r = (tid / TPR) + RPI * i;
      const size_t row = (size_t)(mt * 128 + r);
      float4 a = *(const float4*)(Cs + r * CS_LD + cc), b = *(const float4*)(Cs + r * CS_LD + cc + 4);
      float v[8] = {a.x, a.y, a.z, a.w, b.x, b.y, b.z, b.w};
      float g[8];
      unpack8(graw[i], g);
      u16* mp = MG + row * 1024 + n0 + cc;
      if (pass == 0) {
#pragma unroll
        for (int q = 0; q < 8; q++) v[q] *= sigmoidf_(g[q]);
        part[i] = pack8(v);
      } else {
        float pv[8];
        unpack8(part[i], pv);
#pragma unroll
        for (int q = 0; q < 8; q++) v[q] = pv[q] + v[q] * sigmoidf_(g[q]);
        *(uint4*)mp = pack8(v);
      }
    }
    __syncthreads();
  }
}

__device__ __forceinline__ void phase_g3(KParams& p, char* smem, int vb) {
  for (int it = blockIdx.x; it < 1024 + 128; it += gridDim.x) {
    int mt, nt;
    if (it < 1024) {
      tile_map(it, MT * 8, 8, mt, nt, vb);
      g3_tile<128>(p, smem, mt, nt * 128);
    } else {
      tile_map(1024 + ((it - 1024) >> 1), MT * 8, 8, mt, nt, vb);
      g3_tile<64>(p, smem, mt, nt * 128 + ((it - 1024) & 1) * 64);
    }
  }
}

template <int NW>
__device__ __forceinline__ void g4_tile(KParams& p, char* smem, int mt, int n0) {
  const int tid = opaque_tid();
  float* Cs = (float*)smem;
  const u16* MG = (const u16*)(p.ws + W_ZA);
  const u16* WO = (const u16*)(p.ws + W_WTOUT);
  u16* HG = (u16*)(p.ws + W_ZB);
  float* SSQ = (float*)(p.ws + W_SSQ);
  constexpr int TPR = NW / 8;
  constexpr int RPI = 256 / TPR;
  f32x4 acc[4][NW / 32];
  zero_acc(acc);
  gemm_tile<NW>(MG + (size_t)mt * 128 * 1024, 1024, WO + (size_t)n0 * 1024, 1024, 1024, acc, smem, tid);
  const int cc = (tid % TPR) * 8;
  float4 xr0[128 / RPI], xr1[128 / RPI];
#pragma unroll
  for (int i = 0; i < 128 / RPI; i++) {
    const float* xr = xrow(p, mt * 128 + (tid / TPR) + RPI * i) + n0 + cc;
    xr0[i] = *(const float4*)xr;
    xr1[i] = *(const float4*)(xr + 4);
  }
  __syncthreads();
  acc_to_cs(acc, Cs, tid);
  __syncthreads();
  const float4 g0 = *(const float4*)(p.norm2_g + n0 + cc), g1 = *(const float4*)(p.norm2_g + n0 + cc + 4);
#pragma unroll
  for (int i = 0; i < 128 / RPI; i++) {
    const int r = (tid / TPR) + RPI * i;
    const int row = mt * 128 + r;
    float4 a = *(const float4*)(Cs + r * CS_LD + cc), b = *(const float4*)(Cs + r * CS_LD + cc + 4);
    const float4 x0 = xr0[i], x1 = xr1[i];
    a.x += x0.x; a.y += x0.y; a.z += x0.z; a.w += x0.w;
    b.x += x1.x; b.y += x1.y; b.z += x1.z; b.w += x1.w;
    float* ho = p.out + O_Y + (size_t)row * 1024 + n0 + cc;
    *(float4*)ho = a;
    *(float4*)(ho + 4) = b;
    float v[8] = {a.x * g0.x, a.y * g0.y, a.z * g0.z, a.w * g0.w, b.x * g1.x, b.y * g1.y, b.z * g1.z, b.w * g1.w};
    *(uint4*)(HG + (size_t)row * 1024 + n0 + cc) = pack8(v);
    float ss = a.x * a.x + a.y * a.y + a.z * a.z + a.w * a.w + b.x * b.x + b.y * b.y + b.z * b.z + b.w * b.w;
    ss += __shfl_xor(ss, 1);
    ss += __shfl_xor(ss, 2);
    ss += __shfl_xor(ss, 4);
    if ((tid & 7) == 0) SSQ[(size_t)row * 16 + ((n0 + cc) >> 6)] = ss;
  }
  __syncthreads();
}

__device__ __forceinline__ void phase_g4(KParams& p, char* smem, int vb) {
  for (int it = blockIdx.x; it < 1024 + 128; it += gridDim.x) {
    int mt, nt;
    if (it < 1024) {
      tile_map(it, MT * 8, 8, mt, nt, vb);
      g4_tile<128>(p, smem, mt, nt * 128);
    } else {
      tile_map(1024 + ((it - 1024) >> 1), MT * 8, 8, mt, nt, vb);
      g4_tile<64>(p, smem, mt, nt * 128 + ((it - 1024) & 1) * 64);
    }
  }
}

__device__ __forceinline__ float row_rstd(const float* SSQ, int row) {
  const float4 a = *(const float4*)(SSQ + (size_t)row * 16), b = *(const float4*)(SSQ + (size_t)row * 16 + 4),
               c = *(const float4*)(SSQ + (size_t)row * 16 + 8), d = *(const float4*)(SSQ + (size_t)row * 16 + 12);
  const float ss = (((a.x + a.y) + (a.z + a.w)) + ((b.x + b.y) + (b.z + b.w))) +
                   (((c.x + c.y) + (c.z + c.w)) + ((d.x + d.y) + (d.z + d.w)));
  return rsqrtf(ss * (1.f / 1024.f) + EPS);
}

template <int NW>
__device__ __forceinline__ void g5_tile(KParams& p, char* smem, int mt, int n0) {
  const int tid = opaque_tid();
  float* Cs = (float*)smem;
  const u16* HG = (const u16*)(p.ws + W_ZB);
  const u16* WQ = (const u16*)(p.ws + W_WTQ);
  const float* SSQ = (const float*)(p.ws + W_SSQ);
  u16* QR = (u16*)(p.ws + W_ZA);
  constexpr int TPR = NW / 8;
  constexpr int RPI = 256 / TPR;
  float* RS = (float*)(smem + 128 * CS_LD * 4);
  if (tid < 128) RS[tid] = row_rstd(SSQ, mt * 128 + tid);
  f32x4 acc[4][NW / 32];
  zero_acc(acc);
  gemm_tile<NW>(HG + (size_t)mt * 128 * 1024, 1024, WQ + (size_t)n0 * 1024, 1024, 1024, acc, smem, tid);
  __syncthreads();
  acc_to_cs(acc, Cs, tid);
  __syncthreads();
  const int cc = (tid % TPR) * 8;
#pragma unroll
  for (int i = 0; i < 128 / RPI; i++) {
    const int r = (tid / TPR) + RPI * i;
    const int row = mt * 128 + r;
    const float rs = RS[r];
    float4 a = *(const float4*)(Cs + r * CS_LD + cc), b = *(const float4*)(Cs + r * CS_LD + cc + 4);
    float v[8] = {a.x * rs, a.y * rs, a.z * rs, a.w * rs, b.x * rs, b.y * rs, b.z * rs, b.w * rs};
    *(uint4*)(QR + (size_t)row * 2048 + n0 + cc) = pack8(v);
  }
  __syncthreads();
}

__device__ __forceinline__ void phase_g5(KParams& p, char* smem, int vb) {
  for (int it = blockIdx.x; it < 2048 + 256; it += gridDim.x) {
    int mt, nt;
    if (it < 2048) {
      tile_map(it, MT * 16, 16, mt, nt, vb);
      g5_tile<128>(p, smem, mt, nt * 128);
    } else {
      tile_map(2048 + ((it - 2048) >> 1), MT * 16, 16, mt, nt, vb);
      g5_tile<64>(p, smem, mt, nt * 128 + ((it - 2048) & 1) * 64);
    }
  }
}

__device__ __forceinline__ void phase_g6(KParams& p, char* smem, int vb) {
  const int tid = opaque_tid();
  u16* As = (u16*)smem;
  u16* Bs = As + 2 * 128 * LDT;
  float* Cs = (float*)smem;
  uint32_t* Cu = (uint32_t*)smem;
  uint32_t* TK0 = (uint32_t*)(smem + 128 * CS_LD * 4);
  const u16* QR = (const u16*)(p.ws + W_ZA);
  const u16* SK = (const u16*)(p.ws + W_SK);
  int* IDX = (int*)(p.ws + W_XN);
  float* GW = (float*)(p.ws + W_XN + (size_t)NTOK * 128 * 4);
  const int row = tid >> 1, half = tid & 1;
  for (int t = blockIdx.x; t < MT * 8; t += gridDim.x) {
    int mt, h;
    tile_map(t, MT * 8, 8, mt, h, vb);
    uint32_t tk[16];
    for (int pp = 0; pp < 2; pp++) {
      f32x4 acc[4][4];
      zero_acc(acc);
      gemm_tile<128>(QR + (size_t)mt * 128 * 2048 + h * 256 + pp * 128, 2048, SK + (size_t)(h * 2 + pp) * 16384, 128, 128, acc,
                smem, tid);
      __syncthreads();
      acc_to_cs(acc, Cs, tid);
      __syncthreads();
#pragma unroll
      for (int g = 0; g < 4; g++) {
        uint32_t sg[16];
#pragma unroll
        for (int q4 = 0; q4 < 4; q4++) {
          const int col = half * 64 + g * 16 + q4 * 4;
          const float4 v = *(const float4*)(Cs + row * CS_LD + col);
          sg[q4 * 4 + 0] = (ordf(v.x) & ~0x7Fu) | (uint32_t)(127 - col);
          sg[q4 * 4 + 1] = (ordf(v.y) & ~0x7Fu) | (uint32_t)(126 - col);
          sg[q4 * 4 + 2] = (ordf(v.z) & ~0x7Fu) | (uint32_t)(125 - col);
          sg[q4 * 4 + 3] = (ordf(v.w) & ~0x7Fu) | (uint32_t)(124 - col);
        }
        sort16_desc(sg);
        if (g == 0) {
#pragma unroll
          for (int q = 0; q < 16; q++) tk[q] = sg[q];
        } else {
          merge16_desc(tk, sg);
        }
      }
      __syncthreads();
      if (half == 1) {
#pragma unroll
        for (int q = 0; q < 16; q++) Cu[row * 16 + q] = tk[q];
      }
      __syncthreads();
      if (half == 0) {
        {
          uint32_t sg[16];
#pragma unroll
          for (int q4 = 0; q4 < 4; q4++) {
            const uint4 u = *(const uint4*)(Cu + row * 16 + q4 * 4);
            sg[q4 * 4] = u.x; sg[q4 * 4 + 1] = u.y; sg[q4 * 4 + 2] = u.z; sg[q4 * 4 + 3] = u.w;
          }
          merge16_desc(tk, sg);
        }
        if (pp == 0) {
#pragma unroll
          for (int q = 0; q < 16; q++) TK0[row * 16 + q] = tk[q];
        } else {
#pragma unroll
          for (int q = 0; q < 16; q++) Cu[2048 + row * 16 + q] = tk[q];
        }
      }
      __syncthreads();
    }
    if (half == 0) {
      float va[16], vb[16];
#pragma unroll
      for (int q = 0; q < 16; q++) {
        va[q] = unordf(TK0[row * 16 + q] & ~0x7Fu);
        vb[q] = unordf(tk[q] & ~0x7Fu);
      }
      uint32_t cd[16];
#pragma unroll
      for (int q = 0; q < 16; q++) cd[q] = (ordf(va[0] + vb[q]) & ~0xFFu) | (uint32_t)(255 - q);
#pragma unroll
      for (int i = 1; i < 16; i++) {
#pragma unroll
        for (int j = 0; j < 16; j++) {
          if ((i + 1) * (j + 1) <= 16) {
            const float sv = va[i] + vb[j];
            const uint32_t key = (ordf(sv) & ~0xFFu) | (uint32_t)(255 - (i * 16 + j));
            INS16(cd, key);
          }
        }
      }
      float ev[16];
      const float m0v = unordf(cd[0] & ~0xFFu);
      float esum = 0.f;
#pragma unroll
      for (int q = 0; q < 16; q++) {
        ev[q] = __expf(unordf(cd[q] & ~0xFFu) - m0v);
        esum += ev[q];
      }
      const float inv = 1.f / esum;
      const size_t ob = (size_t)(mt * 128 + row) * 128 + h * 16;
#pragma unroll
      for (int q = 0; q < 16; q++) {
        const int ij = 255 - (int)(cd[q] & 0xFFu);
        const int i0 = 127 - (int)(TK0[row * 16 + (ij >> 4)] & 0x7Fu);
        const int i1 = 127 - (int)(Cu[2048 + row * 16 + (ij & 15)] & 0x7Fu);
        IDX[ob + q] = i0 * 128 + i1;
        GW[ob + q] = ev[q] * inv;
      }
    }
    __syncthreads();
  }
}

typedef __attribute__((ext_vector_type(2))) float f32x2;
__device__ __forceinline__ void dec16(uint4 u, float* v) {
  f32x2 t;
  t = __builtin_amdgcn_cvt_pk_f32_fp8((int)u.x, false); v[0] = t.x; v[1] = t.y;
  t = __builtin_amdgcn_cvt_pk_f32_fp8((int)u.x, true); v[2] = t.x; v[3] = t.y;
  t = __builtin_amdgcn_cvt_pk_f32_fp8((int)u.y, false); v[4] = t.x; v[5] = t.y;
  t = __builtin_amdgcn_cvt_pk_f32_fp8((int)u.y, true); v[6] = t.x; v[7] = t.y;
  t = __builtin_amdgcn_cvt_pk_f32_fp8((int)u.z, false); v[8] = t.x; v[9] = t.y;
  t = __builtin_amdgcn_cvt_pk_f32_fp8((int)u.z, true); v[10] = t.x; v[11] = t.y;
  t = __builtin_amdgcn_cvt_pk_f32_fp8((int)u.w, false); v[12] = t.x; v[13] = t.y;
  t = __builtin_amdgcn_cvt_pk_f32_fp8((int)u.w, true); v[14] = t.x; v[15] = t.y;
}

__device__ __forceinline__ void phase7(KParams& p) {
  const int tid = opaque_tid(), lane = tid & 63, w = tid >> 6;
  const u16* HG = (const u16*)(p.ws + W_ZB);
  const float* SSQ = (const float*)(p.ws + W_SSQ);
  const int* IDX = (const int*)(p.ws + W_XN);
  const float* GW = (const float*)(p.ws + W_XN + (size_t)NTOK * 128 * 4);
  const unsigned char* EU = (const unsigned char*)(p.ws + W_EU);
  const unsigned char* EV = (const unsigned char*)(p.ws + W_EV);
  const float* ESC = (const float*)(p.ws + W_ESC);
  const int b0 = lane & 1, b1 = (lane >> 1) & 1, b2 = (lane >> 2) & 1;
  const int nwv = gridDim.x * 4;
  int tok = blockIdx.x * 4 + w;
  uint4 nh0 = make_uint4(0u, 0u, 0u, 0u), nh1 = nh0;
  float nrs = 0.f, ngwA = 0.f, ngwB = 0.f;
  int niA = 0, niB = 0;
  if (tok < NTOK) {
    const uint4* hp = (const uint4*)(HG + (size_t)tok * 1024 + lane * 16);
    nh0 = hp[0]; nh1 = hp[1];
    nrs = row_rstd(SSQ, tok);
    niA = IDX[(size_t)tok * 128 + lane]; niB = IDX[(size_t)tok * 128 + 64 + lane];
    ngwA = GW[(size_t)tok * 128 + lane]; ngwB = GW[(size_t)tok * 128 + 64 + lane];
  }
#pragma unroll 1
  for (; tok < NTOK; tok += nwv) {
    const float rs = nrs;
    const int iA = niA, iB = niB;
    const float gwA = ngwA, gwB = ngwB;
    float xh[16];
    unpack8(nh0, xh);
    unpack8(nh1, xh + 8);
#pragma unroll
    for (int i = 0; i < 16; i++) xh[i] *= rs;
    {
      const int nt2 = tok + nwv;
      if (nt2 < NTOK) {
        const uint4* hp = (const uint4*)(HG + (size_t)nt2 * 1024 + lane * 16);
        nh0 = hp[0]; nh1 = hp[1];
        nrs = row_rstd(SSQ, nt2);
        niA = IDX[(size_t)nt2 * 128 + lane]; niB = IDX[(size_t)nt2 * 128 + 64 + lane];
        ngwA = GW[(size_t)nt2 * 128 + lane]; ngwB = GW[(size_t)nt2 * 128 + 64 + lane];
      }
    }
    const float gA = gwA * ESC[16384 + iA], gB = gwB * ESC[16384 + iB];
    const float suA = ESC[iA], suB = ESC[iB];
    float dA = 0.f, dB = 0.f;
#pragma unroll 2
    for (int bb = 0; bb < 16; bb++) {
      const int isrc = bb < 8 ? iA : iB;
      float d[8];
      uint4 ur[8];
#pragma unroll
      for (int k = 0; k < 8; k++) {
        const int id = __builtin_amdgcn_readlane(isrc, (bb & 7) * 8 + k);
        ur[k] = *(const uint4*)(EU + (size_t)id * 1024 + lane * 16);
      }
#pragma unroll
      for (int k = 0; k < 8; k++) {
        float uv[16];
        dec16(ur[k], uv);
        float sacc = 0.f;
#pragma unroll
        for (int i = 0; i < 16; i++) sacc += xh[i] * uv[i];
        d[k] = sacc;
      }
      float e4[4], e2[2], e1;
#pragma unroll
      for (int i = 0; i < 4; i++) {
        const float keep = b0 ? d[2 * i + 1] : d[2 * i];
        const float send = b0 ? d[2 * i] : d[2 * i + 1];
        e4[i] = keep + __shfl_xor(send, 1);
      }
#pragma unroll
      for (int i = 0; i < 2; i++) {
        const float keep = b1 ? e4[2 * i + 1] : e4[2 * i];
        const float send = b1 ? e4[2 * i] : e4[2 * i + 1];
        e2[i] = keep + __shfl_xor(send, 2);
      }
      {
        const float keep = b2 ? e2[1] : e2[0];
        const float send = b2 ? e2[0] : e2[1];
        e1 = keep + __shfl_xor(send, 4);
      }
      e1 += __shfl_xor(e1, 8);
      e1 += __shfl_xor(e1, 16);
      e1 += __shfl_xor(e1, 32);
      const bool mine = (lane >> 3) == (bb & 7);
      if (bb < 8) dA = mine ? e1 : dA; else dB = mine ? e1 : dB;
    }
    const float actA = gelu_tanh(dA * suA) * gA, actB = gelu_tanh(dB * suB) * gB;
    float* ACT = (float*)(p.ws + W_ACT);
    __hip_atomic_store(&ACT[(size_t)tok * 128 + lane], actA, __ATOMIC_RELAXED, __HIP_MEMORY_SCOPE_AGENT);
    __hip_atomic_store(&ACT[(size_t)tok * 128 + 64 + lane], actB, __ATOMIC_RELAXED, __HIP_MEMORY_SCOPE_AGENT);
    asm volatile("s_waitcnt vmcnt(0)" ::: "memory");
    if (lane == 0) __hip_atomic_fetch_add((unsigned*)(p.ws + W_CNT) + (tok >> 3), 1u, __ATOMIC_RELAXED, __HIP_MEMORY_SCOPE_AGENT);
  }
}

__device__ __forceinline__ void phase7b(KParams& p) {
  const int tid = opaque_tid(), lane = tid & 63;
  const char* IDXb = (const char*)(p.ws + W_XN);
  const char* ACTb = (const char*)(p.ws + W_ACT);
  const char* EVb = (const char*)(p.ws + W_EV);
  char* Yb = (char*)(p.out + O_Y);
  unsigned* Q = (unsigned*)(p.ws + W_Q);
  const int esub = lane >> 3, c = lane & 7;
  const int pref = (int)(hw_xcc_id() & 7u);
  const int b3 = (lane >> 3) & 1, b4 = (lane >> 4) & 1, b5 = (lane >> 5) & 1;
  const uint32_t lane4 = (uint32_t)lane * 4u;
  const uint32_t yl = (uint32_t)(c * 16 + b3 * 8 + b4 * 4 + b5 * 2) * 4u;
  for (int k = 0; k < 8; k++) {
    const int sl = (pref + k) & 7;
    const char* Vs = EVb + (size_t)sl * (16384 * 128);
    const uint32_t vl = (uint32_t)c * 16u;
    for (;;) {
      unsigned it = 0;
      if (lane == 0) it = atomicAdd(Q + sl * 64, 1u);
      it = (unsigned)__builtin_amdgcn_readfirstlane((int)it);
      if (it >= (unsigned)(NTOK / 8)) break;
      const int tok0 = (int)it * 8;
      {
        unsigned* cp = (unsigned*)(p.ws + W_CNT) + it;
        unsigned spins = 0;
        while ((unsigned)__builtin_amdgcn_readfirstlane((int)__hip_atomic_load(cp, __ATOMIC_RELAXED, __HIP_MEMORY_SCOPE_AGENT)) < 8u) {
          __builtin_amdgcn_s_sleep(2);
          if (++spins > (1u << 20)) break;
        }
      }
      const char* ib = IDXb + (size_t)tok0 * 512;
      const char* ab = ACTb + (size_t)tok0 * 512;
      char* yb = Yb + (size_t)tok0 * 4096 + sl * 512;
      int nidA = *(const int*)(ib + lane4), nidB = *(const int*)(ib + 256 + lane4);
      float nacA = __hip_atomic_load((const float*)(ab + lane4), __ATOMIC_RELAXED, __HIP_MEMORY_SCOPE_AGENT), nacB = __hip_atomic_load((const float*)(ab + 256 + lane4), __ATOMIC_RELAXED, __HIP_MEMORY_SCOPE_AGENT);
      float2 nyv = *(const float2*)(yb + yl);
#pragma unroll 1
      for (int t = 0; t < 8; t++) {
        const int idA = nidA, idB = nidB;
        const float acA = nacA, acB = nacB;
        const float2 yv = nyv;
        char* ybt = yb;
        if (t < 7) {
          ib += 512; ab += 512; yb += 4096;
          nidA = *(const int*)(ib + lane4); nidB = *(const int*)(ib + 256 + lane4);
          nacA = __hip_atomic_load((const float*)(ab + lane4), __ATOMIC_RELAXED, __HIP_MEMORY_SCOPE_AGENT); nacB = __hip_atomic_load((const float*)(ab + 256 + lane4), __ATOMIC_RELAXED, __HIP_MEMORY_SCOPE_AGENT);
          nyv = *(const float2*)(yb + yl);
        }
        float o[16];
#pragma unroll
        for (int q = 0; q < 16; q++) o[q] = 0.f;
#pragma unroll
        for (int hf = 0; hf < 2; hf++) {
          uint4 vr[8];
#pragma unroll
          for (int i = 0; i < 8; i++) {
            const uint32_t id = (uint32_t)__shfl(hf ? idB : idA, i * 8 + esub);
            vr[i] = *(const uint4*)(Vs + (id * 128u + vl));
          }
#pragma unroll
          for (int i = 0; i < 8; i++) {
            float vv[16];
            dec16(vr[i], vv);
            const float a = __shfl(hf ? acB : acA, i * 8 + esub);
#pragma unroll
            for (int q = 0; q < 16; q++) o[q] += a * vv[q];
          }
        }
        float r8[8], r4[4], r2[2];
#pragma unroll
        for (int q = 0; q < 8; q++) {
          const float keep = b3 ? o[q + 8] : o[q];
          const float send = b3 ? o[q] : o[q + 8];
          r8[q] = keep + __shfl_xor(send, 8);
        }
#pragma unroll
        for (int q = 0; q < 4; q++) {
          const float keep = b4 ? r8[q + 4] : r8[q];
          const float send = b4 ? r8[q] : r8[q + 4];
          r4[q] = keep + __shfl_xor(send, 16);
        }
#pragma unroll
        for (int q = 0; q < 2; q++) {
          const float keep = b5 ? r4[q + 2] : r4[q];
          const float send = b5 ? r4[q] : r4[q + 2];
          r2[q] = keep + __shfl_xor(send, 32);
        }
        float2 h = yv;
        h.x += r2[0];
        h.y += r2[1];
        *(float2*)(ybt + yl) = h;
      }
    }
  }
}

#define XB_TMO      128
#define XB_XCNT(j)  (256  + 64 * (j))
#define XB_XSUB(j)  (1280 + 64 * (j))
#define XB_XGEN(j)  (2304 + 64 * (j))
#define XB_TOP      3328
#define XB_TOPGEN   3392
#define XCD_BAR_WORDS 3456
#define XB_SPIN_CAP (1u << 18)
#define LAS __attribute__((address_space(3)))
__device__ __forceinline__ unsigned xb_ld(unsigned* p) { return __hip_atomic_load(p, __ATOMIC_RELAXED, __HIP_MEMORY_SCOPE_AGENT); }
__device__ __forceinline__ unsigned xb_add(unsigned* p, unsigned v) { return __hip_atomic_fetch_add(p, v, __ATOMIC_RELAXED, __HIP_MEMORY_SCOPE_AGENT); }
__device__ __forceinline__ unsigned xb_xcc_id() { return (unsigned)__builtin_amdgcn_s_getreg((3 << 11) | 20) & 0xFu; }
#define XB_SPIN(cond, bar) do { unsigned _sp = 0; while (cond) { __builtin_amdgcn_s_sleep(1); \
    if ((++_sp & 255u) == 0u) { if (xb_ld(&(bar)[XB_TMO])) break; if (_sp > XB_SPIN_CAP) { atomicAdd(&(bar)[XB_TMO], 1u); break; } } } } while (0)
struct XcdBarrier { unsigned* bar; unsigned x; volatile LAS unsigned* st; };
__device__ __forceinline__ XcdBarrier xcd_barrier_post(unsigned* bar, volatile LAS unsigned* st) {
  XcdBarrier b; b.bar = bar; b.x = xb_xcc_id(); b.st = st;
  if (threadIdx.x == 0) st[2] = xb_add(&bar[XB_XCNT(b.x)], 1u);
  return b;
}
__device__ __forceinline__ void xcd_barrier_complete(unsigned* bar, unsigned x, unsigned& nloc, unsigned& nx) {
  const unsigned G = gridDim.x * gridDim.y * gridDim.z;
  unsigned sum, cnt, mine, sp = 0u;
  for (;;) {
    sum = 0u; cnt = 0u; mine = 0u;
#pragma unroll
    for (unsigned j = 0; j < 16; ++j) { const unsigned c = xb_ld(&bar[XB_XCNT(j)]); sum += c; cnt += (c > 0u) ? 1u : 0u; mine = (j == x) ? c : mine; }
    if (sum == G) break;
    __builtin_amdgcn_s_sleep(1);
    if ((++sp & 255u) == 0u) { if (xb_ld(&bar[XB_TMO])) break; if (sp > XB_SPIN_CAP) { atomicAdd(&bar[XB_TMO], 1u); break; } }
  }
  nloc = mine > 0u ? mine : 1u; nx = cnt > 0u ? cnt : 1u;
}
__device__ __forceinline__ void xcd_barrier(const XcdBarrier& b) {
  asm volatile("s_waitcnt vmcnt(0)" ::: "memory");
  __syncthreads();
  if (threadIdx.x == 0) {
    unsigned* bar = b.bar;
    __builtin_amdgcn_s_waitcnt(0);
    unsigned nloc = b.st[0], nx = b.st[1];
    if (nloc == 0u) { xcd_barrier_complete(bar, b.x, nloc, nx); b.st[0] = nloc; b.st[1] = nx; }
    const unsigned old = xb_add(&bar[XB_XSUB(b.x)], 1u);
    const unsigned gen = old / nloc;
    if (old + 1u == (gen + 1u) * nloc) {
      __builtin_amdgcn_fence(__ATOMIC_RELEASE, "agent");
      asm volatile("s_waitcnt vmcnt(0)" ::: "memory");
      const unsigned og = xb_add(&bar[XB_TOP], 1u);
      const unsigned tg = og / nx;
      if (og + 1u == (tg + 1u) * nx) xb_add(&bar[XB_TOPGEN], 1u);
      else XB_SPIN(xb_ld(&bar[XB_TOPGEN]) == tg, bar);
      __builtin_amdgcn_fence(__ATOMIC_ACQUIRE, "agent");
      xb_add(&bar[XB_XGEN(b.x)], 1u);
      asm volatile("s_waitcnt vmcnt(0)" ::: "memory");
    } else {
      XB_SPIN(xb_ld(&bar[XB_XGEN(b.x)]) == gen, bar);
      __builtin_amdgcn_fence(__ATOMIC_ACQUIRE, "agent");
      asm volatile("s_waitcnt vmcnt(0)" ::: "memory");
    }
  }
  __syncthreads();
}

#ifndef REP_MASK
#define REP_MASK 0
#endif
#define REPS(k) for (int _rep = 0; _rep < (((REP_MASK) >> (k)) & 1) + 1; _rep++)
__global__ void __launch_bounds__(256, 2) fwd_megakernel(Params p_) {
  extern __shared__ __attribute__((aligned(16))) char smem[];
  cg::grid_group grid = cg::this_grid();
  if (p_.ws == nullptr) grid.sync();
  volatile LAS unsigned* xst = (volatile LAS unsigned*)(smem + SMEM_BYTES - 16);
  if (threadIdx.x == 0) { xst[0] = 0u; xst[1] = 0u; xst[2] = 0u; xst[3] = 0u; }
  __syncthreads();
  const XcdBarrier xb = xcd_barrier_post((unsigned*)(p_.ws + W_BAR), xst);
  REPS(0) { phase0(*fresh_params(), smem); xcd_barrier(xb); }
  if (threadIdx.x == 0) {
    unsigned* bar = (unsigned*)(p_.ws + W_BAR);
    const unsigned per = gridDim.x >> 3;
    bool uni = (gridDim.x & 7u) == 0u;
    for (unsigned j = 0; j < 16; ++j) { const unsigned cnt = xb_ld(&bar[XB_XCNT(j)]); if (cnt != (j < 8 ? per : 0u)) uni = false; }
    xst[3] = uni ? (xb.x * per + xst[2]) : blockIdx.x;
  }
  __syncthreads();
  const int vb = (int)xst[3];
  REPS(1) { phase_g1(*fresh_params(), smem, vb); xcd_barrier(xb); }
  REPS(2) {
    for (int it = blockIdx.x; it < MT * 16 + 1536; it += gridDim.x) {
      if (it < MT * 16) { const int mt = it >> 4; lru_tile(*fresh_params(), smem, mt, it & 15, mt < 128 ? 2 : 1); }
      else attn_item(*fresh_params(), smem, it - MT * 16);
    }
    xcd_barrier(xb);
  }
  REPS(4) { phase_g3(*fresh_params(), smem, vb); xcd_barrier(xb); }
  REPS(5) { phase_g4(*fresh_params(), smem, vb); xcd_barrier(xb); }
  REPS(6) { phase_g5(*fresh_params(), smem, vb); xcd_barrier(xb); }
  REPS(7) { phase_g6(*fresh_params(), smem, vb); xcd_barrier(xb); }
  phase7(*fresh_params());
  phase7b(*fresh_params());
}

extern "C" void kernel_launch(void* const* d_in, const int* in_sizes, int n_in, void* d_out, int out_size, void* d_ws,
                              size_t ws_size, hipStream_t stream) {
  static int grid_blocks = 0;
  if (!grid_blocks) {
    int dev = 0, cus = 0, per_cu = 0;
    hipGetDevice(&dev);
    hipDeviceGetAttribute(&cus, hipDeviceAttributeMultiprocessorCount, dev);
    hipFuncSetAttribute((const void*)fwd_megakernel, hipFuncAttributeMaxDynamicSharedMemorySize, SMEM_BYTES);
    hipOccupancyMaxActiveBlocksPerMultiprocessor(&per_cu, fwd_megakernel, 256, SMEM_BYTES);
    if (per_cu < 1) per_cu = 1;
    grid_blocks = cus * per_cu;
  }
  Params p{};
  const float** pp = (const float**)&p;
  for (int i = 0; i < 26; i++) pp[i] = (const float*)d_in[i];
  p.out = (float*)d_out;
  p.ws = (char*)d_ws;
  (void)hipMemsetAsync((char*)d_ws + W_BAR, 0, (size_t)3456 * 4 + 8 * 256 + 2048 * 4 + 2176 * 4, stream);
  void* args[] = {&p};
  hipError_t e = hipLaunchCooperativeKernel((void*)fwd_megakernel, dim3(grid_blocks), dim3(256), args, SMEM_BYTES, stream);
  if (e != hipSuccess) fprintf(stderr, "cooperative launch failed: %s (grid %d)\n", hipGetErrorString(e), grid_blocks);
}
```

```cpp
#include <hip/hip_runtime.h>
#include <hip/hip_cooperative_groups.h>
#include <stdint.h>
#include <cstdio>
namespace cg = cooperative_groups;

typedef unsigned short u16;
typedef __attribute__((ext_vector_type(8))) short bf16x8;
typedef __attribute__((ext_vector_type(4))) float f32x4;

constexpr int D = 1024;
constexpr int NP = 16384;
constexpr int NTOK = 17408;
constexpr int SEQ = 4096;
constexpr int MT = 136;
constexpr float EPS = 1e-6f;

constexpr size_t O_Y = 0;
constexpr size_t O_CONVP = 17825792;
constexpr size_t O_LRUP = O_CONVP + 12288;
constexpr size_t O_KP = O_LRUP + 4096;
constexpr size_t O_VP = O_KP + 131072;
constexpr size_t O_CONVS = O_VP + 131072;
constexpr size_t O_LRUS = O_CONVS + 393216;
constexpr size_t O_KS = O_LRUS + 131072;
constexpr size_t O_VS = O_KS + 4194304;

constexpr size_t W_WTIN = 0;
constexpr size_t W_WTLRU = W_WTIN + (size_t)5632 * 1024 * 2;
constexpr size_t W_WTATTN = W_WTLRU + (size_t)1024 * 1024 * 2;
constexpr size_t W_WTOUT = W_WTATTN + (size_t)1024 * 1024 * 2;
constexpr size_t W_WTQ = W_WTOUT + (size_t)1024 * 1024 * 2;
constexpr size_t W_SK = W_WTQ + (size_t)2048 * 1024 * 2;
constexpr size_t W_RGA = W_SK + (size_t)16 * 128 * 128 * 2;
constexpr size_t W_RGX = W_RGA + (size_t)65536 * 2;
constexpr size_t W_EU = W_RGX + (size_t)65536 * 2;
constexpr size_t W_EV = W_EU + (size_t)16384 * 1024;
constexpr size_t W_ESC = W_EV + (size_t)16384 * 1024;
constexpr size_t W_XN = W_ESC + (size_t)32768 * 4;
constexpr size_t W_ZA = W_XN + (size_t)NTOK * 1024 * 2;
constexpr size_t W_ZB = W_ZA + (size_t)NTOK * 2048 * 2;
constexpr size_t W_AGG = W_ZB + (size_t)NTOK * 1536 * 2;
constexpr size_t W_SSQ = W_AGG + (size_t)128 * 1024 * 2 * 4;
constexpr size_t W_BAR = W_SSQ + (size_t)NTOK * 16 * 4;
constexpr size_t W_Q = W_BAR + (size_t)3456 * 4;
constexpr size_t W_FLAG = W_Q + (size_t)8 * 256;
constexpr size_t W_CNT = W_FLAG + (size_t)2048 * 4;
constexpr size_t W_ACT = W_CNT + (size_t)2176 * 4;
constexpr size_t W_LO = W_ACT + (size_t)NTOK * 128 * 4;
constexpr size_t W_END = W_LO + (size_t)NTOK * 1024 * 2;

constexpr int SMEM_BYTES = 81920;

struct Params {
  const float *x_prompt, *x_sample, *cache_conv, *state_lru, *cache_k, *cache_v, *norm1_g, *w_in, *conv_w,
      *conv_b, *rg_w_a, *rg_b_a, *rg_w_x, *rg_b_x, *rg_lambda, *q_norm_g, *k_norm_g, *attn_sinks,
      *w_branch_lru, *w_branch_attn, *w_out, *norm2_g, *peer_w_query, *peer_sub_keys, *expert_u, *expert_v;
  float* out;
  char* ws;
};

typedef const __attribute__((address_space(4))) Params KParams;
__device__ __forceinline__ KParams* fresh_params() {
  unsigned long long k = (unsigned long long)__builtin_amdgcn_kernarg_segment_ptr();
  asm volatile("" : "+s"(k));
  return (KParams*)k;
}
__device__ __forceinline__ u16 f2bf(float f) {
  uint32_t u = __float_as_uint(f);
  u += 0x7FFFu + ((u >> 16) & 1u);
  return (u16)(u >> 16);
}
__device__ __forceinline__ float bf2f(u16 h) { return __uint_as_float(((uint32_t)h) << 16); }
__device__ __forceinline__ uint32_t pack2(float a, float b) {
  uint32_t r;
  asm("v_cvt_pk_bf16_f32 %0, %1, %2" : "=v"(r) : "v"(a), "v"(b));
  return r;
}
__device__ __forceinline__ uint4 pack8(const float* v) {
  uint4 o;
  o.x = pack2(v[0], v[1]); o.y = pack2(v[2], v[3]); o.z = pack2(v[4], v[5]); o.w = pack2(v[6], v[7]);
  return o;
}
__device__ __forceinline__ void unpack8(uint4 u, float* v) {
  v[0] = __uint_as_float(u.x << 16); v[1] = __uint_as_float(u.x & 0xFFFF0000u);
  v[2] = __uint_as_float(u.y << 16); v[3] = __uint_as_float(u.y & 0xFFFF0000u);
  v[4] = __uint_as_float(u.z << 16); v[5] = __uint_as_float(u.z & 0xFFFF0000u);
  v[6] = __uint_as_float(u.w << 16); v[7] = __uint_as_float(u.w & 0xFFFF0000u);
}
__device__ __forceinline__ float sigmoidf_(float x) { return __builtin_amdgcn_rcpf(1.f + __expf(-x)); }
__device__ __forceinline__ float gelu_tanh(float x) {
  float y = 0.7978845608028654f * (x + 0.044715f * x * x * x);
  float t = 1.f - 2.f * __builtin_amdgcn_rcpf(__expf(2.f * y) + 1.f);
  return 0.5f * x * (1.f + t);
}
__device__ __forceinline__ uint32_t ordf(float f) {
  uint32_t u = __float_as_uint(f);
  return (u & 0x80000000u) ? ~u : (u | 0x80000000u);
}
__device__ __forceinline__ float unordf(uint32_t o) {
  uint32_t u = (o & 0x80000000u) ? (o ^ 0x80000000u) : ~o;
  return __uint_as_float(u);
}
__device__ __forceinline__ unsigned hw_xcc_id() { return (unsigned)__builtin_amdgcn_s_getreg((3 << 11) | 20) & 0xFu; }
__device__ __forceinline__ int opaque_tid() {
  int t = threadIdx.x;
  asm volatile("" : "+v"(t));
  return t;
}
__device__ __forceinline__ const float* xrow(KParams& p, int row) {
  return row < NP ? p.x_prompt + (size_t)row * D : p.x_sample + (size_t)(row - NP) * D;
}

#define INS16(T, V)                                  \
  {                                                  \
    uint32_t _v = (V);                               \
    _Pragma("unroll") for (int _q = 0; _q < 16; _q++) { \
      uint32_t _hi = max(T[_q], _v);                 \
      _v = min(T[_q], _v);                           \
      T[_q] = _hi;                                   \
    }                                                \
  }

#define CE_DESC(A_, B_) { const uint32_t _h = max(A_, B_), _l = min(A_, B_); A_ = _h; B_ = _l; }
__device__ __forceinline__ void sort16_desc(uint32_t (&t)[16]) {
#pragma unroll
  for (int k = 2; k <= 16; k <<= 1) {
#pragma unroll
    for (int j = k >> 1; j > 0; j >>= 1) {
#pragma unroll
      for (int i = 0; i < 16; i++) {
        const int l = i ^ j;
        if (l > i) {
          if ((i & k) == 0) { CE_DESC(t[i], t[l]); } else { CE_DESC(t[l], t[i]); }
        }
      }
    }
  }
}
__device__ __forceinline__ void merge16_desc(uint32_t (&T)[16], const uint32_t (&S)[16]) {
#pragma unroll
  for (int i = 0; i < 16; i++) T[i] = max(T[i], S[15 - i]);
#pragma unroll
  for (int j = 8; j > 0; j >>= 1) {
#pragma unroll
    for (int i = 0; i < 16; i++) {
      const int l = i ^ j;
      if (l > i) { CE_DESC(T[i], T[l]); }
    }
  }
}

__device__ __forceinline__ void transpose_cvt(const float* __restrict__ W, u16* __restrict__ Wt, int K, int N,
                                              size_t gtid, size_t gsz) {
  size_t total = (size_t)N * (K / 8);
  for (size_t c = gtid; c < total; c += gsz) {
    int n = (int)(c % N);
    int kg = (int)(c / N);
    float v[8];
#pragma unroll
    for (int i = 0; i < 8; i++) v[i] = W[(size_t)(kg * 8 + i) * N + n];
    *(uint4*)(Wt + (size_t)n * K + kg * 8) = pack8(v);
  }
}
__device__ __forceinline__ void plain_cvt(const float* __restrict__ S, u16* __restrict__ Dst, size_t n, size_t gtid,
                                          size_t gsz) {
  size_t total = n / 8;
  const float4* s4 = (const float4*)S;
  for (size_t c = gtid; c < total; c += gsz) {
    float4 a = s4[2 * c], b = s4[2 * c + 1];
    float v[8] = {a.x, a.y, a.z, a.w, b.x, b.y, b.z, b.w};
    *(uint4*)(Dst + c * 8) = pack8(v);
  }
}

__device__ __forceinline__ void phase0(KParams& p, char* smem) {
  const int tid = opaque_tid();
  const size_t gtid = (size_t)blockIdx.x * 256 + tid, gsz = (size_t)gridDim.x * 256;
  char* ws = p.ws;
  {
    const int lane = tid & 63;
    const int gw = (int)(gtid >> 6), nw = (int)(gsz >> 6);
    u16* XN = (u16*)(ws + W_XN);
    for (int row = gw; row < NTOK; row += nw) {
      const float4* xr = (const float4*)xrow(p, row);
      float4 v[4];
      float ss = 0.f;
#pragma unroll
      for (int i = 0; i < 4; i++) {
        v[i] = xr[lane + i * 64];
        ss += v[i].x * v[i].x + v[i].y * v[i].y + v[i].z * v[i].z + v[i].w * v[i].w;
      }
#pragma unroll
      for (int o = 32; o > 0; o >>= 1) ss += __shfl_xor(ss, o);
      float rstd = rsqrtf(ss * (1.f / 1024.f) + EPS);
      const float4* g4 = (const float4*)p.norm1_g;
#pragma unroll
      for (int i = 0; i < 4; i++) {
        float4 g = g4[lane + i * 64];
        uint2 o;
        o.x = pack2(v[i].x * rstd * g.x, v[i].y * rstd * g.y);
        o.y = pack2(v[i].z * rstd * g.z, v[i].w * rstd * g.w);
        *(uint2*)(XN + (size_t)row * D + (lane + i * 64) * 4) = o;
      }
    }
  }
  {
    float* T = (float*)smem;
    for (int tile = blockIdx.x; tile < 2688; tile += gridDim.x) {
      const float* W;
      u16* Wt;
      int N, tl;
      if (tile < 1408) { W = p.w_in; Wt = (u16*)(ws + W_WTIN); N = 5632; tl = tile; }
      else if (tile < 1664) { W = p.w_branch_lru; Wt = (u16*)(ws + W_WTLRU); N = 1024; tl = tile - 1408; }
      else if (tile < 1920) { W = p.w_branch_attn; Wt = (u16*)(ws + W_WTATTN); N = 1024; tl = tile - 1664; }
      else if (tile < 2176) { W = p.w_out; Wt = (u16*)(ws + W_WTOUT); N = 1024; tl = tile - 1920; }
      else { W = p.peer_w_query; Wt = (u16*)(ws + W_WTQ); N = 2048; tl = tile - 2176; }
      const int ntn = N >> 6;
      const int kt = tl / ntn, nt = tl - kt * ntn;
      __syncthreads();
      {
        const float* src = W + (size_t)(kt * 64 + (tid >> 2)) * N + nt * 64 + (tid & 3) * 16;
        const float4 a0 = *(const float4*)src, a1 = *(const float4*)(src + 4), a2 = *(const float4*)(src + 8),
                     a3 = *(const float4*)(src + 12);
        float* d = T + (tid >> 2) * 65 + (tid & 3) * 16;
        d[0] = a0.x; d[1] = a0.y; d[2] = a0.z; d[3] = a0.w; d[4] = a1.x; d[5] = a1.y; d[6] = a1.z; d[7] = a1.w;
        d[8] = a2.x; d[9] = a2.y; d[10] = a2.z; d[11] = a2.w; d[12] = a3.x; d[13] = a3.y; d[14] = a3.z; d[15] = a3.w;
      }
      __syncthreads();
      {
        const int n = tid >> 2, kc = (tid & 3) * 16;
        float v[16];
#pragma unroll
        for (int i = 0; i < 16; i++) v[i] = T[(kc + i) * 65 + n];
        u16* dst = Wt + (size_t)(nt * 64 + n) * 1024 + kt * 64 + kc;
        *(uint4*)dst = pack8(v);
        *(uint4*)(dst + 8) = pack8(v + 8);
      }
    }
  }
  {
    u16* RA = (u16*)(ws + W_RGA);
    u16* RX = (u16*)(ws + W_RGX);
    for (size_t e = gtid; e < 65536; e += gsz) {
      int n = (int)(e >> 12), k = (int)((e >> 6) & 63), j = (int)(e & 63);
      RA[e] = f2bf(p.rg_w_a[n * 4096 + j * 64 + k]);
      RX[e] = f2bf(p.rg_w_x[n * 4096 + j * 64 + k]);
    }
  }
  plain_cvt(p.peer_sub_keys, (u16*)(ws + W_SK), (size_t)16 * 128 * 128, gtid, gsz);
  {
    const int lane = tid & 63;
    const int gw = (int)(gtid >> 6), nw = (int)(gsz >> 6);
    unsigned char* E8 = (unsigned char*)(ws + W_EU);
    float* ESC = (float*)(ws + W_ESC);
    for (int r = gw; r < 32768; r += nw) {
      const float* src = (r < 16384 ? p.expert_u : p.expert_v) + (size_t)(r & 16383) * 1024 + lane * 16;
      const float4 a0 = *(const float4*)src, a1 = *(const float4*)(src + 4), a2 = *(const float4*)(src + 8),
                   a3 = *(const float4*)(src + 12);
      float am = fmaxf(fmaxf(fmaxf(fabsf(a0.x), fabsf(a0.y)), fmaxf(fabsf(a0.z), fabsf(a0.w))),
                       fmaxf(fmaxf(fabsf(a1.x), fabsf(a1.y)), fmaxf(fabsf(a1.z), fabsf(a1.w))));
      am = fmaxf(am, fmaxf(fmaxf(fmaxf(fabsf(a2.x), fabsf(a2.y)), fmaxf(fabsf(a2.z), fabsf(a2.w))),
                           fmaxf(fmaxf(fabsf(a3.x), fabsf(a3.y)), fmaxf(fabsf(a3.z), fabsf(a3.w)))));
#pragma unroll
      for (int o = 32; o > 0; o >>= 1) am = fmaxf(am, __shfl_xor(am, o));
      const float sc = am > 0.f ? 224.f / am : 1.f;
      uint4 o4;
      int wv;
      wv = __builtin_amdgcn_cvt_pk_fp8_f32(a0.x * sc, a0.y * sc, 0, false);
      wv = __builtin_amdgcn_cvt_pk_fp8_f32(a0.z * sc, a0.w * sc, wv, true);
      o4.x = (uint32_t)wv;
      wv = __builtin_amdgcn_cvt_pk_fp8_f32(a1.x * sc, a1.y * sc, 0, false);
      wv = __builtin_amdgcn_cvt_pk_fp8_f32(a1.z * sc, a1.w * sc, wv, true);
      o4.y = (uint32_t)wv;
      wv = __builtin_amdgcn_cvt_pk_fp8_f32(a2.x * sc, a2.y * sc, 0, false);
      wv = __builtin_amdgcn_cvt_pk_fp8_f32(a2.z * sc, a2.w * sc, wv, true);
      o4.z = (uint32_t)wv;
      wv = __builtin_amdgcn_cvt_pk_fp8_f32(a3.x * sc, a3.y * sc, 0, false);
      wv = __builtin_amdgcn_cvt_pk_fp8_f32(a3.z * sc, a3.w * sc, wv, true);
      o4.w = (uint32_t)wv;
      if (r < 16384) *(uint4*)(E8 + (size_t)r * 1024 + lane * 16) = o4;
      else *(uint4*)(E8 + (size_t)16384 * 1024 + (size_t)(lane >> 3) * (16384 * 128) + (size_t)(r - 16384) * 128 + (lane & 7) * 16) = o4;
      if (lane == 0) ESC[r] = am > 0.f ? am * (1.f / 224.f) : 1.f;
    }
  }
}

constexpr int LDT = 72;
constexpr int CS_LD = 132;

template <int NW>
__device__ __forceinline__ void gemm_tile(const u16* __restrict__ A, int lda, const u16* __restrict__ Bt, int ldb,
                                          int K, f32x4 (&acc)[4][NW / 32], char* smem, int tid) {
  constexpr int NJ = NW / 32;
  const int lane = tid & 63, w = tid >> 6;
  const int wm = w >> 1, wn = w & 1;
  const int l15 = lane & 15, quad = lane >> 4;
  const int lr = w * 8 + (lane >> 3);
  const int lc = ((lane & 7) ^ ((lane >> 3) & 7)) * 8;
  const char* Ab = (const char*)A;
  const char* Bb = (const char*)Bt;
  const uint32_t ao = (uint32_t)(lr * lda + lc) * 2u, bo = (uint32_t)(lr * ldb + lc) * 2u;
  const uint32_t sa2 = 64u * (uint32_t)lda, sb2 = 64u * (uint32_t)ldb;
  const uint32_t kmask = (uint32_t)K - 1u, kst = (((uint32_t)blockIdx.x >> 3) * 64u) & kmask;
  char* lw = smem + w * 1024 + lane * 16;
  const int swz = l15 & 7;
  const char* Ar = smem + (wm * 64 + l15) * 128 + ((quad ^ swz) * 16);
  const char* Br = smem + 16384 + (wn * (NW / 2) + l15) * 128 + ((quad ^ swz) * 16);
  const char* Ar1 = smem + (wm * 64 + l15) * 128 + (((4 + quad) ^ swz) * 16);
  const char* Br1 = smem + 16384 + (wn * (NW / 2) + l15) * 128 + (((4 + quad) ^ swz) * 16);
#define GT_ISSUE(st, off)                                                                                   \
  {                                                                                                         \
    const uint32_t _o = (((uint32_t)(off) + kst) & kmask) * 2u;                                             \
    char* _l = lw + (st) * 32768;                                                                           \
    _Pragma("unroll") for (int j = 0; j < 4; j++) {                                                         \
      __builtin_amdgcn_global_load_lds((const unsigned*)(Ab + (size_t)(ao + j * sa2 + _o)), (unsigned*)(_l + j * 4096), 16, 0, 0);          \
      if (j < NJ) __builtin_amdgcn_global_load_lds((const unsigned*)(Bb + (size_t)(bo + j * sb2 + _o)), (unsigned*)(_l + 16384 + j * 4096), 16, 0, 0);  \
    }                                                                                                       \
  }
#define GT_MMA(st)                                                                                          \
  {                                                                                                         \
    const char* _ar = Ar + (st) * 32768; const char* _br = Br + (st) * 32768;                               \
    const char* _ar1 = Ar1 + (st) * 32768; const char* _br1 = Br1 + (st) * 32768;                           \
    bf16x8 a0[4], b0[NJ], a1[4], b1[NJ];                                                                      \
    _Pragma("unroll") for (int i = 0; i < 4; i++) {                                                         \
      a0[i] = *(const bf16x8*)(_ar + i * 2048);                                                             \
      if (i < NJ) b0[i] = *(const bf16x8*)(_br + i * 2048);                                                 \
    }                                                                                                       \
    _Pragma("unroll") for (int i = 0; i < 4; i++) {                                                         \
      a1[i] = *(const bf16x8*)(_ar1 + i * 2048);                                                            \
      if (i < NJ) b1[i] = *(const bf16x8*)(_br1 + i * 2048);                                                \
    }                                                                                                       \
    __builtin_amdgcn_s_setprio(1);                                                                          \
    _Pragma("unroll") for (int i = 0; i < 4; i++)                                                           \
      _Pragma("unroll") for (int j = 0; j < NJ; j++)                                                        \
        acc[i][j] = __builtin_amdgcn_mfma_f32_16x16x32_bf16(a0[i], b0[j], acc[i][j], 0, 0, 0);              \
    _Pragma("unroll") for (int i = 0; i < 4; i++)                                                           \
      _Pragma("unroll") for (int j = 0; j < NJ; j++)                                                        \
        acc[i][j] = __builtin_amdgcn_mfma_f32_16x16x32_bf16(a1[i], b1[j], acc[i][j], 0, 0, 0);              \
    __builtin_amdgcn_s_setprio(0);                                                                          \
  }
  __syncthreads();
  GT_ISSUE(0, 0);
  for (int k0 = 0; k0 < K; k0 += 128) {
    asm volatile("s_waitcnt vmcnt(0) lgkmcnt(0)" ::: "memory");
    __builtin_amdgcn_s_barrier();
    asm volatile("" ::: "memory");
    GT_ISSUE(1, k0 + 64);
    GT_MMA(0);
    asm volatile("s_waitcnt vmcnt(0) lgkmcnt(0)" ::: "memory");
    __builtin_amdgcn_s_barrier();
    asm volatile("" ::: "memory");
    if (k0 + 128 < K) GT_ISSUE(0, k0 + 128);
    GT_MMA(1);
  }
#undef GT_ISSUE
#undef GT_MMA
}

__device__ __forceinline__ void tile_map(int it, int total, int NT, int& mt, int& nt, int vb) {
  const int G = gridDim.x;
  int T = it;
  {
    const int round = it / G;
    if (round * G + G <= total) T = round * G + vb;
  }
  const int g = T / (8 * NT), r = T - g * (8 * NT);
  nt = r >> 3;
  mt = g * 8 + (r & 7);
}

template <int NJ>
__device__ __forceinline__ void zero_acc(f32x4 (&acc)[4][NJ]) {
#pragma unroll
  for (int i = 0; i < 4; i++)
#pragma unroll
    for (int j = 0; j < NJ; j++) acc[i][j] = (f32x4){0.f, 0.f, 0.f, 0.f};
}

template <int NJ>
__device__ __forceinline__ void acc_to_cs(const f32x4 (&acc)[4][NJ], float* Cs, int tid) {
  const int lane = tid & 63, w = tid >> 6;
  const int wm = w >> 1, wn = w & 1;
  const int l15 = lane & 15, quad = lane >> 4;
#pragma unroll
  for (int i = 0; i < 4; i++)
#pragma unroll
    for (int j = 0; j < NJ; j++)
#pragma unroll
      for (int e = 0; e < 4; e++)
        Cs[(wm * 64 + i * 16 + quad * 4 + e) * CS_LD + wn * (NJ * 16) + j * 16 + l15] = acc[i][j][e];
}

__device__ __forceinline__ void phase_g1(KParams& p, char* smem, int vb) {
  const int tid = opaque_tid();
  u16* As = (u16*)smem;
  u16* Bs = As + 2 * 128 * LDT;
  float* Cs = (float*)smem;
  const u16* XN = (const u16*)(p.ws + W_XN);
  const u16* WT = (const u16*)(p.ws + W_WTIN);
  for (int t = blockIdx.x; t < MT * 44; t += gridDim.x) {
    int mt, nt;
    tile_map(t, MT * 44, 44, mt, nt, vb);
    f32x4 acc[4][4];
    zero_acc(acc);
    gemm_tile<128>(XN + (size_t)mt * 128 * 1024, 1024, WT + (size_t)nt * 128 * 1024, 1024, 1024, acc, smem, tid);
    __syncthreads();
    acc_to_cs(acc, Cs, tid);
    __syncthreads();
    const int n0 = nt * 128;
    u16* dst;
    int ldd, col;
    if (n0 < 2048) { dst = (u16*)(p.ws + W_ZA); ldd = 2048; col = n0; }
    else if (n0 < 3584) { dst = (u16*)(p.ws + W_ZB); ldd = 1536; col = n0 - 2048; }
    else { dst = (u16*)p.out; ldd = 2048; col = n0 - 3584; }
    const int cc = (tid & 15) * 8;
#pragma unroll
    for (int i = 0; i < 8; i++) {
      const int r = (tid >> 4) + 16 * i;
      float4 a = *(const float4*)(Cs + r * CS_LD + cc), b = *(const float4*)(Cs + r * CS_LD + cc + 4);
      float v[8] = {a.x, a.y, a.z, a.w, b.x, b.y, b.z, b.w};
      *(uint4*)(dst + (size_t)(mt * 128 + r) * ldd + col + cc) = pack8(v);
    }
    __syncthreads();
  }
}

constexpr int KS_LD = 72, VT_LD = 200, PS_LD = 168;
__device__ __forceinline__ void attn_item(KParams& p, char* smem, int item) {
  const int tid = opaque_tid(), lane = tid & 63, w = tid >> 6, l15 = lane & 15, quad = lane >> 4;
  u16* Ks = (u16*)smem;
  u16* Vt = Ks + 192 * KS_LD;
  u16* Ps = Vt + 64 * VT_LD + w * 16 * PS_LD;
  const u16* ZB = (const u16*)(p.ws + W_ZB);
  u16* ATT = (u16*)(p.ws + W_XN);
  const bool sample = item >= 1024;
  int b, qb = 0, kv, rowbase, p0 = 0;
  if (!sample) {
    kv = item & 3; qb = (item >> 2) & 63; b = item >> 8;
    p0 = qb * 64;
    rowbase = b * SEQ + p0;
  } else {
    int it = item - 1024;
    kv = it & 3; b = it >> 2;
    rowbase = NP + b * 8;
  }
  const int hq = kv * 4 + w;
  const float slope = exp2f(-0.5f * (float)(hq + 1));
  const float sink = p.attn_sinks[hq];
  float qg[2][8];
#pragma unroll
  for (int ks = 0; ks < 2; ks++)
#pragma unroll
    for (int i = 0; i < 8; i++) qg[ks][i] = p.q_norm_g[ks * 32 + quad * 8 + i] * 0.125f;
  __syncthreads();
  {
    const int ch = tid & 7;
    float kg[8];
#pragma unroll
    for (int i = 0; i < 8; i++) kg[i] = p.k_norm_g[ch * 8 + i];
    const int nrows = sample ? 160 : 192;
    for (int c = tid; c < nrows * 8; c += 256) {
      const int row = c >> 3;
      float kf[8], vf[8];
      bool valid, donorm;
      if (!sample) {
        const int pos = p0 - 128 + row;
        valid = pos >= 0;
        donorm = true;
        if (valid) {
          const u16* src = ZB + (size_t)(b * SEQ + pos) * 1536 + 1024 + kv * 64 + ch * 8;
          unpack8(*(const uint4*)src, kf);
          unpack8(*(const uint4*)(src + 256), vf);
        }
      } else {
        valid = row < 136;
        donorm = row >= 128;
        if (row < 128) {
          const float* sk = p.cache_k + ((size_t)(b * 128 + row) * 4 + kv) * 64 + ch * 8;
          const float* sv = p.cache_v + ((size_t)(b * 128 + row) * 4 + kv) * 64 + ch * 8;
          float4 a0 = *(const float4*)sk, a1 = *(const float4*)(sk + 4);
          float4 b0 = *(const float4*)sv, b1 = *(const float4*)(sv + 4);
          kf[0] = a0.x; kf[1] = a0.y; kf[2] = a0.z; kf[3] = a0.w; kf[4] = a1.x; kf[5] = a1.y; kf[6] = a1.z; kf[7] = a1.w;
          vf[0] = b0.x; vf[1] = b0.y; vf[2] = b0.z; vf[3] = b0.w; vf[4] = b1.x; vf[5] = b1.y; vf[6] = b1.z; vf[7] = b1.w;
        } else if (valid) {
          const u16* src = ZB + (size_t)(NP + b * 8 + (row - 128)) * 1536 + 1024 + kv * 64 + ch * 8;
          unpack8(*(const uint4*)src, kf);
          unpack8(*(const uint4*)(src + 256), vf);
        }
      }
      if (!valid) {
#pragma unroll
        for (int i = 0; i < 8; i++) { kf[i] = 0.f; vf[i] = 0.f; }
      }
      float ss = 0.f;
#pragma unroll
      for (int i = 0; i < 8; i++) ss += kf[i] * kf[i];
      ss += __shfl_xor(ss, 1);
      ss += __shfl_xor(ss, 2);
      ss += __shfl_xor(ss, 4);
      if (donorm) {
        const float rstd = rsqrtf(ss * (1.f / 64.f) + EPS);
#pragma unroll
        for (int i = 0; i < 8; i++) kf[i] = kf[i] * rstd * kg[i];
      }
      *(uint4*)(Ks + row * KS_LD + ch * 8) = pack8(kf);
#pragma unroll
      for (int i = 0; i < 8; i++) Vt[(ch * 8 + i) * VT_LD + row] = f2bf(vf[i]);
      if (!sample) {
        if (qb >= 62 && row >= 128) {
          const int wpos = p0 + (row - 128) - (SEQ - 128);
          float* ko = p.out + O_KP + ((size_t)(b * 128 + wpos) * 4 + kv) * 64 + ch * 8;
          float* vo = p.out + O_VP + ((size_t)(b * 128 + wpos) * 4 + kv) * 64 + ch * 8;
          *(float4*)ko = make_float4(kf[0], kf[1], kf[2], kf[3]);
          *(float4*)(ko + 4) = make_float4(kf[4], kf[5], kf[6], kf[7]);
          *(float4*)vo = make_float4(vf[0], vf[1], vf[2], vf[3]);
          *(float4*)(vo + 4) = make_float4(vf[4], vf[5], vf[6], vf[7]);
        }
      } else {
        if (row >= 8 && row < 136) {
          float* ko = p.out + O_KS + ((size_t)(b * 128 + (row - 8)) * 4 + kv) * 64 + ch * 8;
          float* vo = p.out + O_VS + ((size_t)(b * 128 + (row - 8)) * 4 + kv) * 64 + ch * 8;
          *(float4*)ko = make_float4(kf[0], kf[1], kf[2], kf[3]);
          *(float4*)(ko + 4) = make_float4(kf[4], kf[5], kf[6], kf[7]);
          *(float4*)vo = make_float4(vf[0], vf[1], vf[2], vf[3]);
          *(float4*)(vo + 4) = make_float4(vf[4], vf[5], vf[6], vf[7]);
        }
      }
    }
  }
  __syncthreads();
  const int nsub = sample ? 1 : 4;
  for (int sb = 0; sb < nsub; sb++) {
    const int r0 = sb * 16;
    const int ws0 = r0 < 32 ? r0 : 32;
    bf16x8 qa[2];
    {
      const int qr = sample ? (l15 & 7) : (r0 + l15);
      const u16* src = ZB + (size_t)(rowbase + qr) * 1536 + hq * 64 + quad * 8;
      float q0[8], q1[8];
      unpack8(*(const uint4*)src, q0);
      unpack8(*(const uint4*)(src + 32), q1);
      float ss = 0.f;
#pragma unroll
      for (int i = 0; i < 8; i++) ss += q0[i] * q0[i] + q1[i] * q1[i];
      ss += __shfl_xor(ss, 16);
      ss += __shfl_xor(ss, 32);
      const float rstd = rsqrtf(ss * (1.f / 64.f) + EPS);
#pragma unroll
      for (int i = 0; i < 8; i++) { q0[i] *= rstd * qg[0][i]; q1[i] *= rstd * qg[1][i]; }
      uint4 u0 = pack8(q0), u1 = pack8(q1);
      qa[0] = __builtin_bit_cast(bf16x8, u0);
      qa[1] = __builtin_bit_cast(bf16x8, u1);
    }
    f32x4 s[10];
#pragma unroll
    for (int kt = 0; kt < 10; kt++) {
      const u16* kp = Ks + (ws0 + kt * 16 + l15) * KS_LD + quad * 8;
      bf16x8 b0 = *(const bf16x8*)kp, b1 = *(const bf16x8*)(kp + 32);
      f32x4 z = {0.f, 0.f, 0.f, 0.f};
      z = __builtin_amdgcn_mfma_f32_16x16x32_bf16(qa[0], b0, z, 0, 0, 0);
      s[kt] = __builtin_amdgcn_mfma_f32_16x16x32_bf16(qa[1], b1, z, 0, 0, 0);
    }
    float mx[4] = {-1e30f, -1e30f, -1e30f, -1e30f};
#pragma unroll
    for (int kt = 0; kt < 10; kt++) {
      const int jj = ws0 + kt * 16 + l15;
      const bool posok = sample ? (jj < 136) : (p0 - 128 + jj >= 0);
#pragma unroll
      for (int e = 0; e < 4; e++) {
        const int r = r0 + quad * 4 + e;
        const int dist = r + 128 - jj;
        const bool ok = posok && dist >= 0 && dist <= 128;
        float v = ok ? (s[kt][e] - slope * (float)dist) : -1e30f;
        s[kt][e] = v;
        mx[e] = fmaxf(mx[e], v);
      }
    }
    float sum[4];
#pragma unroll
    for (int e = 0; e < 4; e++) {
      float m = mx[e];
      m = fmaxf(m, __shfl_xor(m, 1));
      m = fmaxf(m, __shfl_xor(m, 2));
      m = fmaxf(m, __shfl_xor(m, 4));
      m = fmaxf(m, __shfl_xor(m, 8));
      m = fmaxf(m, sink);
      mx[e] = m;
      sum[e] = 0.f;
    }
#pragma unroll
    for (int kt = 0; kt < 10; kt++) {
#pragma unroll
      for (int e = 0; e < 4; e++) {
        float pv = __expf(s[kt][e] - mx[e]);
        sum[e] += pv;
        Ps[(quad * 4 + e) * PS_LD + kt * 16 + l15] = f2bf(pv);
      }
    }
#pragma unroll
    for (int e = 0; e < 4; e++) {
      float t = sum[e];
      t += __shfl_xor(t, 1);
      t += __shfl_xor(t, 2);
      t += __shfl_xor(t, 4);
      t += __shfl_xor(t, 8);
      sum[e] = 1.f / (t + __expf(sink - mx[e]));
    }
    __syncthreads();
    f32x4 o[4];
#pragma unroll
    for (int nt = 0; nt < 4; nt++) o[nt] = (f32x4){0.f, 0.f, 0.f, 0.f};
#pragma unroll
    for (int kk = 0; kk < 5; kk++) {
      bf16x8 pa = *(const bf16x8*)(Ps + l15 * PS_LD + kk * 32 + quad * 8);
#pragma unroll
      for (int nt = 0; nt < 4; nt++) {
        bf16x8 vb = *(const bf16x8*)(Vt + (nt * 16 + l15) * VT_LD + ws0 + kk * 32 + quad * 8);
        o[nt] = __builtin_amdgcn_mfma_f32_16x16x32_bf16(pa, vb, o[nt], 0, 0, 0);
      }
    }
#pragma unroll
    for (int e = 0; e < 4; e++) {
      const int r = quad * 4 + e;
      if (!sample || r < 8) {
        u16* dst = ATT + (size_t)(rowbase + r0 + r) * 1024 + hq * 64 + l15;
#pragma unroll
        for (int nt = 0; nt < 4; nt++) dst[nt * 16] = f2bf(o[nt][e] * sum[e]);
      }
    }
    __syncthreads();
  }
}

constexpr int XC_LD = 68;
__device__ __forceinline__ void lru_tile(KParams& p, char* smem, int mt, int nb, int mode) {
  const int tid = opaque_tid(), lane = tid & 63, w = tid >> 6, l15 = lane & 15, quad = lane >> 4;
  float* xcF = (float*)smem;
  float* aL = xcF + 128 * XC_LD;
  float* aggL = aL + 128 * XC_LD;
  const u16* ZA = (const u16*)(p.ws + W_ZA);
  const bool sample = mt >= 128;
  const int m0 = mt * 128;
  const int cb = nb * 64;
  __syncthreads();
  {
    const int ch = tid & 7;
    float cw[4][8], cbias[8];
#pragma unroll
    for (int j = 0; j < 4; j++)
#pragma unroll
      for (int i = 0; i < 8; i++) cw[j][i] = p.conv_w[j * 1024 + cb + ch * 8 + i];
#pragma unroll
    for (int i = 0; i < 8; i++) cbias[i] = p.conv_b[cb + ch * 8 + i];
#pragma unroll
    for (int it = 0; it < 4; it++) {
      const int r = (tid >> 3) + it * 32;
      const int grow = m0 + r;
      const int t = sample ? (r & 7) : ((mt & 31) * 128 + r);
      float y[8];
#pragma unroll
      for (int i = 0; i < 8; i++) y[i] = cbias[i];
#pragma unroll
      for (int d = 0; d < 4; d++) {
        float xv[8];
        if (t - d >= 0) {
          unpack8(*(const uint4*)(ZA + (size_t)(grow - d) * 2048 + cb + ch * 8), xv);
        } else if (sample) {
          const int bb = (m0 - NP + r) >> 3;
          const float* src = p.cache_conv + ((size_t)bb * 3 + (3 + t - d)) * 1024 + cb + ch * 8;
          float4 a = *(const float4*)src, b4 = *(const float4*)(src + 4);
          xv[0] = a.x; xv[1] = a.y; xv[2] = a.z; xv[3] = a.w; xv[4] = b4.x; xv[5] = b4.y; xv[6] = b4.z; xv[7] = b4.w;
        } else {
#pragma unroll
          for (int i = 0; i < 8; i++) xv[i] = 0.f;
        }
#pragma unroll
        for (int i = 0; i < 8; i++) y[i] += cw[3 - d][i] * xv[i];
        if (d == 0 && mode != 0) {
          if (!sample) {
            if ((mt & 31) == 31 && r >= 125) {
              float* dst = p.out + O_CONVP + ((size_t)(mt >> 5) * 3 + (r - 125)) * 1024 + cb + ch * 8;
              *(float4*)dst = make_float4(xv[0], xv[1], xv[2], xv[3]);
              *(float4*)(dst + 4) = make_float4(xv[4], xv[5], xv[6], xv[7]);
            }
          } else if (t >= 5) {
            const int bb = (m0 - NP + r) >> 3;
            float* dst = p.out + O_CONVS + ((size_t)bb * 3 + (t - 5)) * 1024 + cb + ch * 8;
            *(float4*)dst = make_float4(xv[0], xv[1], xv[2], xv[3]);
            *(float4*)(dst + 4) = make_float4(xv[4], xv[5], xv[6], xv[7]);
          }
        }
      }
      *(float4*)(xcF + r * XC_LD + ch * 8) = make_float4(y[0], y[1], y[2], y[3]);
      *(float4*)(xcF + r * XC_LD + ch * 8 + 4) = make_float4(y[4], y[5], y[6], y[7]);
    }
  }
  __syncthreads();
  {
    const u16* RA = (const u16*)(p.ws + W_RGA) + nb * 4096;
    const u16* RX = (const u16*)(p.ws + W_RGX) + nb * 4096;
    f32x4 aR[2][4], aI[2][4];
#pragma unroll
    for (int i = 0; i < 2; i++)
#pragma unroll
      for (int j = 0; j < 4; j++) { aR[i][j] = (f32x4){0.f, 0.f, 0.f, 0.f}; aI[i][j] = (f32x4){0.f, 0.f, 0.f, 0.f}; }
#pragma unroll
    for (int ks = 0; ks < 2; ks++) {
      bf16x8 a[2];
#pragma unroll
      for (int i = 0; i < 2; i++) {
        const float* src = xcF + (w * 32 + i * 16 + l15) * XC_LD + ks * 32 + quad * 8;
        float4 x0 = *(const float4*)src, x1 = *(const float4*)(src + 4);
        float v[8] = {x0.x, x0.y, x0.z, x0.w, x1.x, x1.y, x1.z, x1.w};
        uint4 u = pack8(v);
        a[i] = __builtin_bit_cast(bf16x8, u);
      }
#pragma unroll
      for (int j = 0; j < 4; j++) {
        bf16x8 ba = *(const bf16x8*)(RA + (j * 16 + l15) * 64 + ks * 32 + quad * 8);
        bf16x8 bx = *(const bf16x8*)(RX + (j * 16 + l15) * 64 + ks * 32 + quad * 8);
#pragma unroll
        for (int i = 0; i < 2; i++) {
          aR[i][j] = __builtin_amdgcn_mfma_f32_16x16x32_bf16(a[i], ba, aR[i][j], 0, 0, 0);
          aI[i][j] = __builtin_amdgcn_mfma_f32_16x16x32_bf16(a[i], bx, aI[i][j], 0, 0, 0);
        }
      }
    }
#pragma unroll
    for (int j = 0; j < 4; j++) {
      const int c = cb + j * 16 + l15;
      const float ba = p.rg_b_a[c], bx = p.rg_b_x[c];
      const float ls = -log1pf(__expf(-p.rg_lambda[c]));
#pragma unroll
      for (int i = 0; i < 2; i++)
#pragma unroll
        for (int e = 0; e < 4; e++) {
          const int row = w * 32 + i * 16 + quad * 4 + e;
          const float rg = sigmoidf_(aR[i][j][e] + ba);
          const float ig = sigmoidf_(aI[i][j][e] + bx);
          const float la = 8.f * rg * ls;
          const float av = __expf(la);
          const float x2 = 2.f * la;
          const float emt = -x2 * (1.f + x2 * (0.5f + x2 * (0.16666667f + x2 * (0.041666668f + x2 * 0.008333334f))));
          const float em = x2 > -0.25f ? emt : 1.f - __expf(x2);
          const float mult = __builtin_amdgcn_sqrtf(fmaxf(em, 0.f));
          const int idx = row * XC_LD + j * 16 + l15;
          const float xv = xcF[idx];
          aL[idx] = av;
          xcF[idx] = mult * ig * xv;
        }
    }
  }
  __syncthreads();
  uint4 grw[4];
  if (mode != 0) {
#pragma unroll
    for (int it = 0; it < 4; it++)
      grw[it] = *(const uint4*)(ZA + (size_t)(m0 + (tid >> 3) + it * 32) * 2048 + 1024 + cb + (tid & 7) * 8);
  }
  const int c = cb + lane;
  float* carL = aggL + 512;
  if (!sample) {
    float* AGGP = (float*)(p.ws + W_AGG);
    float* AGGH = AGGP + 128 * 1024;
    const int chunk = mt & 31, base = mt - chunk;
    if (mode == 1) {
      float Pq[8], Hq[8];
#pragma unroll
      for (int k = 0; k < 8; k++) {
        const int q = w * 8 + k;
        const bool ok = q < chunk;
        Pq[k] = ok ? AGGP[(base + q) * 1024 + c] : 1.f;
        Hq[k] = ok ? AGGH[(base + q) * 1024 + c] : 0.f;
      }
      float Pc = 1.f, hc = 0.f;
#pragma unroll
      for (int k = 0; k < 8; k++) { hc = Pq[k] * hc + Hq[k]; Pc *= Pq[k]; }
      carL[(w * 64 + lane) * 2] = Pc;
      carL[(w * 64 + lane) * 2 + 1] = hc;
    }
    float P = 1.f, h = 0.f;
#pragma unroll 8
    for (int rr = 0; rr < 32; rr++) {
      const float av = aL[(w * 32 + rr) * XC_LD + lane], bv = xcF[(w * 32 + rr) * XC_LD + lane];
      h = av * h + bv;
      P *= av;
    }
    aggL[(w * 64 + lane) * 2] = P;
    aggL[(w * 64 + lane) * 2 + 1] = h;
    __syncthreads();
    if (mode == 0 || mode == 2) {
      if (w == 0) {
        float Pt = 1.f, ht = 0.f;
#pragma unroll
        for (int q = 0; q < 4; q++) {
          const float Pq = aggL[(q * 64 + lane) * 2], hq = aggL[(q * 64 + lane) * 2 + 1];
          ht = Pq * ht + hq;
          Pt *= Pq;
        }
        if (mode == 0) {
          AGGP[mt * 1024 + c] = Pt;
          AGGH[mt * 1024 + c] = ht;
        } else {
          __hip_atomic_store(&AGGP[mt * 1024 + c], Pt, __ATOMIC_RELAXED, __HIP_MEMORY_SCOPE_AGENT);
          __hip_atomic_store(&AGGH[mt * 1024 + c], ht, __ATOMIC_RELAXED, __HIP_MEMORY_SCOPE_AGENT);
          asm volatile("s_waitcnt vmcnt(0)" ::: "memory");
          if (lane == 0)
            __hip_atomic_store((unsigned*)(p.ws + W_FLAG) + mt * 16 + nb, 1u, __ATOMIC_RELAXED, __HIP_MEMORY_SCOPE_AGENT);
        }
      }
    }
    if (mode == 2) {
      {
        const int q = w * 8 + (lane & 7);
        const bool need = (lane < 8) && (q < chunk);
        unsigned* fp = (unsigned*)(p.ws + W_FLAG) + (base + (need ? q : 0)) * 16 + nb;
        unsigned spins = 0;
        for (;;) {
          const unsigned f = need ? __hip_atomic_load(fp, __ATOMIC_RELAXED, __HIP_MEMORY_SCOPE_AGENT) : 1u;
          if (__ballot(f == 0u) == 0ull) break;
          __builtin_amdgcn_s_sleep(2);
          if (++spins > (1u << 20)) break;
        }
      }
      float Pq[8], Hq[8];
#pragma unroll
      for (int k = 0; k < 8; k++) {
        const int q = w * 8 + k;
        const bool ok = q < chunk;
        Pq[k] = ok ? __hip_atomic_load(&AGGP[(base + q) * 1024 + c], __ATOMIC_RELAXED, __HIP_MEMORY_SCOPE_AGENT) : 1.f;
        Hq[k] = ok ? __hip_atomic_load(&AGGH[(base + q) * 1024 + c], __ATOMIC_RELAXED, __HIP_MEMORY_SCOPE_AGENT) : 0.f;
      }
      float Pc = 1.f, hc = 0.f;
#pragma unroll
      for (int k = 0; k < 8; k++) { hc = Pq[k] * hc + Hq[k]; Pc *= Pq[k]; }
      carL[(w * 64 + lane) * 2] = Pc;
      carL[(w * 64 + lane) * 2 + 1] = hc;
      __syncthreads();
    }
    if (mode == 0) {
    } else {
      float hin = 0.f;
#pragma unroll
      for (int q = 0; q < 4; q++) hin = carL[(q * 64 + lane) * 2] * hin + carL[(q * 64 + lane) * 2 + 1];
      for (int q = 0; q < w; q++) hin = aggL[(q * 64 + lane) * 2] * hin + aggL[(q * 64 + lane) * 2 + 1];
      float hh = hin;
#pragma unroll 8
      for (int rr = 0; rr < 32; rr++) {
        const int row = w * 32 + rr;
        const float av = aL[row * XC_LD + lane], bv = xcF[row * XC_LD + lane];
        hh = av * hh + bv;
        xcF[row * XC_LD + lane] = hh;
      }
      if (chunk == 31 && w == 3) p.out[O_LRUP + (size_t)(mt >> 5) * 1024 + c] = hh;
    }
  } else {
    float hh = 0.f;
    float h0v[4];
#pragma unroll
    for (int k = 0; k < 4; k++) h0v[k] = p.state_lru[(size_t)(((m0 - NP + w * 32) >> 3) + k) * 1024 + c];
#pragma unroll
    for (int rr = 0; rr < 32; rr++) {
      const int row = w * 32 + rr;
      const int bb = (m0 - NP + row) >> 3;
      const int t = row & 7;
      if (t == 0) hh = h0v[rr >> 3];
      const float av = aL[row * XC_LD + lane], bv = xcF[row * XC_LD + lane];
      hh = av * hh + bv;
      xcF[row * XC_LD + lane] = hh;
      if (t == 7) p.out[O_LRUS + (size_t)bb * 1024 + c] = hh;
    }
  }
  if (mode != 0) {
    __syncthreads();
    u16* LO = (u16*)(p.ws + W_LO);
    const int ch = tid & 7;
#pragma unroll
    for (int it = 0; it < 4; it++) {
      const int r = (tid >> 3) + it * 32;
      float g[8];
      unpack8(grw[it], g);
      const float4 h0 = *(const float4*)(xcF + r * XC_LD + ch * 8), h1 = *(const float4*)(xcF + r * XC_LD + ch * 8 + 4);
      float v[8] = {h0.x * gelu_tanh(g[0]), h0.y * gelu_tanh(g[1]), h0.z * gelu_tanh(g[2]), h0.w * gelu_tanh(g[3]),
                    h1.x * gelu_tanh(g[4]), h1.y * gelu_tanh(g[5]), h1.z * gelu_tanh(g[6]), h1.w * gelu_tanh(g[7])};
      *(uint4*)(LO + (size_t)(m0 + r) * 1024 + cb + ch * 8) = pack8(v);
    }
  }
}

template <int NW>
__device__ __forceinline__ void g3_tile(KParams& p, char* smem, int mt, int n0) {
  const int tid = opaque_tid();
  float* Cs = (float*)smem;
  const u16* LO = (const u16*)(p.ws + W_LO);
  const u16* ATT = (const u16*)(p.ws + W_XN);
  const u16* WL = (const u16*)(p.ws + W_WTLRU);
  const u16* WA = (const u16*)(p.ws + W_WTATTN);
  const u16* ZC = (const u16*)p.out;
  u16* MG = (u16*)(p.ws + W_ZA);
  constexpr int TPR = NW / 8;
  constexpr int RPI = 256 / TPR;
  const int cc = (tid % TPR) * 8;
  uint4 part[128 / RPI];
#pragma unroll
  for (int pass = 0; pass < 2; pass++) {
    f32x4 acc[4][NW / 32];
    zero_acc(acc);
    gemm_tile<NW>((pass ? ATT : LO) + (size_t)mt * 128 * 1024, 1024, (pass ? WA : WL) + (size_t)n0 * 1024, 1024, 1024, acc,
                  smem, tid);
    uint4 graw[128 / RPI];
#pragma unroll
    for (int i = 0; i < 128 / RPI; i++)
      graw[i] = *(const uint4*)(ZC + (size_t)(mt * 128 + (tid / TPR) + RPI * i) * 2048 + pass * 1024 + n0 + cc);
    __syncthreads();
    acc_to_cs(acc, Cs, tid);
    __syncthreads();
#pragma unroll
    for (int i = 0; i < 128 / RPI; i++) {
      const int r = (tid / TPR) + RPI * i;
      const size_t row = (size_t)(mt * 128 + r);
      float4 a = *(const float4*)(Cs + r * CS_LD + cc), b = *(const float4*)(Cs + r * CS_LD + cc + 4);
      float v[8] = {a.x, a.y, a.z, a.w, b.x, b.y, b.z, b.w};
      float g[8];
      unpack8(graw[i], g);
      u16* mp = MG + row * 1024 + n0 + cc;
      if (pass == 0) {
#pragma unroll
        for (int q = 0; q < 8; q++) v[q] *= sigmoidf_(g[q]);
        part[i] = pack8(v);
      } else {
        float pv[8];
        unpack8(part[i], pv);
#pragma unroll
        for (int q = 0; q < 8; q++) v[q] = pv[q] + v[q] * sigmoidf_(g[q]);
        *(uint4*)mp = pack8(v);
      }
    }
    __syncthreads();
  }
}

__device__ __forceinline__ void phase_g3(KParams& p, char* smem, int vb) {
  for (int it = blockIdx.x; it < 1024 + 128; it += gridDim.x) {
    int mt, nt;
    if (it < 1024) {
      tile_map(it, MT * 8, 8, mt, nt, vb);
      g3_tile<128>(p, smem, mt, nt * 128);
    } else {
      tile_map(1024 + ((it - 1024) >> 1), MT * 8, 8, mt, nt, vb);
      g3_tile<64>(p, smem, mt, nt * 128 + ((it - 1024) & 1) * 64);
    }
  }
}

template <int NW>
__device__ __forceinline__ void g4_tile(KParams& p, char* smem, int mt, int n0) {
  const int tid = opaque_tid();
  float* Cs = (float*)smem;
  const u16* MG = (const u16*)(p.ws + W_ZA);
  const u16* WO = (const u16*)(p.ws + W_WTOUT);
  u16* HG = (u16*)(p.ws + W_ZB);
  float* SSQ = (float*)(p.ws + W_SSQ);
  constexpr int TPR = NW / 8;
  constexpr int RPI = 256 / TPR;
  f32x4 acc[4][NW / 32];
  zero_acc(acc);
  gemm_tile<NW>(MG + (size_t)mt * 128 * 1024, 1024, WO + (size_t)n0 * 1024, 1024, 1024, acc, smem, tid);
  const int cc = (tid % TPR) * 8;
  const float4 g0 = *(const float4*)(p.norm2_g + n0 + cc), g1 = *(const float4*)(p.norm2_g + n0 + cc + 4);
  float4 xr0[128 / RPI], xr1[128 / RPI];
#pragma unroll
  for (int i = 0; i < 128 / RPI; i++) {
    const float* xr = xrow(p, mt * 128 + (tid / TPR) + RPI * i) + n0 + cc;
    xr0[i] = *(const float4*)xr;
    xr1[i] = *(const float4*)(xr + 4);
  }
  __syncthreads();
  acc_to_cs(acc, Cs, tid);
  __syncthreads();
#pragma unroll
  for (int i = 0; i < 128 / RPI; i++) {
    const int r = (tid / TPR) + RPI * i;
    const int row = mt * 128 + r;
    float4 a = *(const float4*)(Cs + r * CS_LD + cc), b = *(const float4*)(Cs + r * CS_LD + cc + 4);
    const float4 x0 = xr0[i], x1 = xr1[i];
    a.x += x0.x; a.y += x0.y; a.z += x0.z; a.w += x0.w;
    b.x += x1.x; b.y += x1.y; b.z += x1.z; b.w += x1.w;
    float* ho = p.out + O_Y + (size_t)row * 1024 + n0 + cc;
    *(float4*)ho = a;
    *(float4*)(ho + 4) = b;
    float v[8] = {a.x * g0.x, a.y * g0.y, a.z * g0.z, a.w * g0.w, b.x * g1.x, b.y * g1.y, b.z * g1.z, b.w * g1.w};
    *(uint4*)(HG + (size_t)row * 1024 + n0 + cc) = pack8(v);
    float ss = a.x * a.x + a.y * a.y + a.z * a.z + a.w * a.w + b.x * b.x + b.y * b.y + b.z * b.z + b.w * b.w;
    ss += __shfl_xor(ss, 1);
    ss += __shfl_xor(ss, 2);
    ss += __shfl_xor(ss, 4);
    if ((tid & 7) == 0) SSQ[(size_t)row * 16 + ((n0 + cc) >> 6)] = ss;
  }
  __syncthreads();
}

__device__ __forceinline__ void phase_g4(KParams& p, char* smem, int vb) {
  for (int it = blockIdx.x; it < 1024 + 128; it += gridDim.x) {
    int mt, nt;
    if (it < 1024) {
      tile_map(it, MT * 8, 8, mt, nt, vb);
      g4_tile<128>(p, smem, mt, nt * 128);
    } else {
      tile_map(1024 + ((it - 1024) >> 1), MT * 8, 8, mt, nt, vb);
      g4_tile<64>(p, smem, mt, nt * 128 + ((it - 1024) & 1) * 64);
    }
  }
}

__device__ __forceinline__ float row_rstd(const float* SSQ, int row) {
  const float4 a = *(const float4*)(SSQ + (size_t)row * 16), b = *(const float4*)(SSQ + (size_t)row * 16 + 4),
               c = *(const float4*)(SSQ + (size_t)row * 16 + 8), d = *(const float4*)(SSQ + (size_t)row * 16 + 12);
  const float ss = (((a.x + a.y) + (a.z + a.w)) + ((b.x + b.y) + (b.z + b.w))) +
                   (((c.x + c.y) + (c.z + c.w)) + ((d.x + d.y) + (d.z + d.w)));
  return rsqrtf(ss * (1.f / 1024.f) + EPS);
}

template <int NW>
__device__ __forceinline__ void g5_tile(KParams& p, char* smem, int mt, int n0) {
  const int tid = opaque_tid();
  float* Cs = (float*)smem;
  const u16* HG = (const u16*)(p.ws + W_ZB);
  const u16* WQ = (const u16*)(p.ws + W_WTQ);
  const float* SSQ = (const float*)(p.ws + W_SSQ);
  u16* QR = (u16*)(p.ws + W_ZA);
  constexpr int TPR = NW / 8;
  constexpr int RPI = 256 / TPR;
  float* RS = (float*)(smem + 128 * CS_LD * 4);
  if (tid < 128) RS[tid] = row_rstd(SSQ, mt * 128 + tid);
  f32x4 acc[4][NW / 32];
  zero_acc(acc);
  gemm_tile<NW>(HG + (size_t)mt * 128 * 1024, 1024, WQ + (size_t)n0 * 1024, 1024, 1024, acc, smem, tid);
  __syncthreads();
  acc_to_cs(acc, Cs, tid);
  __syncthreads();
  const int cc = (tid % TPR) * 8;
#pragma unroll
  for (int i = 0; i < 128 / RPI; i++) {
    const int r = (tid / TPR) + RPI * i;
    const int row = mt * 128 + r;
    const float rs = RS[r];
    float4 a = *(const float4*)(Cs + r * CS_LD + cc), b = *(const float4*)(Cs + r * CS_LD + cc + 4);
    float v[8] = {a.x * rs, a.y * rs, a.z * rs, a.w * rs, b.x * rs, b.y * rs, b.z * rs, b.w * rs};
    *(uint4*)(QR + (size_t)row * 2048 + n0 + cc) = pack8(v);
  }
  __syncthreads();
}

__device__ __forceinline__ void phase_g5(KParams& p, char* smem, int vb) {
  for (int it = blockIdx.x; it < 2048 + 256; it += gridDim.x) {
    int mt, nt;
    if (it < 2048) {
      tile_map(it, MT * 16, 16, mt, nt, vb);
      g5_tile<128>(p, smem, mt, nt * 128);
    } else {
      tile_map(2048 + ((it - 2048) >> 1), MT * 16, 16, mt, nt, vb);
      g5_tile<64>(p, smem, mt, nt * 128 + ((it - 2048) & 1) * 64);
    }
  }
}

__device__ __forceinline__ void phase_g6(KParams& p, char* smem, int vb) {
  const int tid = opaque_tid();
  u16* As = (u16*)smem;
  u16* Bs = As + 2 * 128 * LDT;
  float* Cs = (float*)smem;
  uint32_t* Cu = (uint32_t*)smem;
  uint32_t* TK0 = (uint32_t*)(smem + 128 * CS_LD * 4);
  const u16* QR = (const u16*)(p.ws + W_ZA);
  const u16* SK = (const u16*)(p.ws + W_SK);
  int* IDX = (int*)(p.ws + W_XN);
  float* GW = (float*)(p.ws + W_XN + (size_t)NTOK * 128 * 4);
  const int row = tid >> 1, half = tid & 1;
  for (int t = blockIdx.x; t < MT * 8; t += gridDim.x) {
    int mt, h;
    tile_map(t, MT * 8, 8, mt, h, vb);
    uint32_t tk[16];
    for (int pp = 0; pp < 2; pp++) {
      f32x4 acc[4][4];
      zero_acc(acc);
      gemm_tile<128>(QR + (size_t)mt * 128 * 2048 + h * 256 + pp * 128, 2048, SK + (size_t)(h * 2 + pp) * 16384, 128, 128, acc,
                smem, tid);
      __syncthreads();
      acc_to_cs(acc, Cs, tid);
      __syncthreads();
#pragma unroll
      for (int g = 0; g < 4; g++) {
        uint32_t sg[16];
#pragma unroll
        for (int q4 = 0; q4 < 4; q4++) {
          const int col = half * 64 + g * 16 + q4 * 4;
          const float4 v = *(const float4*)(Cs + row * CS_LD + col);
          sg[q4 * 4 + 0] = (ordf(v.x) & ~0x7Fu) | (uint32_t)(127 - col);
          sg[q4 * 4 + 1] = (ordf(v.y) & ~0x7Fu) | (uint32_t)(126 - col);
          sg[q4 * 4 + 2] = (ordf(v.z) & ~0x7Fu) | (uint32_t)(125 - col);
          sg[q4 * 4 + 3] = (ordf(v.w) & ~0x7Fu) | (uint32_t)(124 - col);
        }
        sort16_desc(sg);
        if (g == 0) {
#pragma unroll
          for (int q = 0; q < 16; q++) tk[q] = sg[q];
        } else {
          merge16_desc(tk, sg);
        }
      }
      __syncthreads();
      if (half == 1) {
#pragma unroll
        for (int q = 0; q < 16; q++) Cu[row * 16 + q] = tk[q];
      }
      __syncthreads();
      if (half == 0) {
        {
          uint32_t sg[16];
#pragma unroll
          for (int q4 = 0; q4 < 4; q4++) {
            const uint4 u = *(const uint4*)(Cu + row * 16 + q4 * 4);
            sg[q4 * 4] = u.x; sg[q4 * 4 + 1] = u.y; sg[q4 * 4 + 2] = u.z; sg[q4 * 4 + 3] = u.w;
          }
          merge16_desc(tk, sg);
        }
        if (pp == 0) {
#pragma unroll
          for (int q = 0; q < 16; q++) TK0[row * 16 + q] = tk[q];
        } else {
#pragma unroll
          for (int q = 0; q < 16; q++) Cu[2048 + row * 16 + q] = tk[q];
        }
      }
      __syncthreads();
    }
    if (half == 0) {
      float va[16], vb[16];
#pragma unroll
      for (int q = 0; q < 16; q++) {
        va[q] = unordf(TK0[row * 16 + q] & ~0x7Fu);
        vb[q] = unordf(tk[q] & ~0x7Fu);
      }
      uint32_t cd[16];
#pragma unroll
      for (int q = 0; q < 16; q++) cd[q] = (ordf(va[0] + vb[q]) & ~0xFFu) | (uint32_t)(255 - q);
#pragma unroll
      for (int i = 1; i < 16; i++) {
#pragma unroll
        for (int j = 0; j < 16; j++) {
          if ((i + 1) * (j + 1) <= 16) {
            const float sv = va[i] + vb[j];
            const uint32_t key = (ordf(sv) & ~0xFFu) | (uint32_t)(255 - (i * 16 + j));
            INS16(cd, key);
          }
        }
      }
      float ev[16];
      const float m0v = unordf(cd[0] & ~0xFFu);
      float esum = 0.f;
#pragma unroll
      for (int q = 0; q < 16; q++) {
        ev[q] = __expf(unordf(cd[q] & ~0xFFu) - m0v);
        esum += ev[q];
      }
      const float inv = 1.f / esum;
      const size_t ob = (size_t)(mt * 128 + row) * 128 + h * 16;
#pragma unroll
      for (int q = 0; q < 16; q++) {
        const int ij = 255 - (int)(cd[q] & 0xFFu);
        const int i0 = 127 - (int)(TK0[row * 16 + (ij >> 4)] & 0x7Fu);
        const int i1 = 127 - (int)(Cu[2048 + row * 16 + (ij & 15)] & 0x7Fu);
        IDX[ob + q] = i0 * 128 + i1;
        GW[ob + q] = ev[q] * inv;
      }
    }
    __syncthreads();
  }
}

typedef __attribute__((ext_vector_type(2))) float f32x2;
__device__ __forceinline__ void dec16(uint4 u, float* v) {
  f32x2 t;
  t = __builtin_amdgcn_cvt_pk_f32_fp8((int)u.x, false); v[0] = t.x; v[1] = t.y;
  t = __builtin_amdgcn_cvt_pk_f32_fp8((int)u.x, true); v[2] = t.x; v[3] = t.y;
  t = __builtin_amdgcn_cvt_pk_f32_fp8((int)u.y, false); v[4] = t.x; v[5] = t.y;
  t = __builtin_amdgcn_cvt_pk_f32_fp8((int)u.y, true); v[6] = t.x; v[7] = t.y;
  t = __builtin_amdgcn_cvt_pk_f32_fp8((int)u.z, false); v[8] = t.x; v[9] = t.y;
  t = __builtin_amdgcn_cvt_pk_f32_fp8((int)u.z, true); v[10] = t.x; v[11] = t.y;
  t = __builtin_amdgcn_cvt_pk_f32_fp8((int)u.w, false); v[12] = t.x; v[13] = t.y;
  t = __builtin_amdgcn_cvt_pk_f32_fp8((int)u.w, true); v[14] = t.x; v[15] = t.y;
}

__device__ __forceinline__ void phase7(KParams& p) {
  const int tid = opaque_tid(), lane = tid & 63, w = tid >> 6;
  const u16* HG = (const u16*)(p.ws + W_ZB);
  const float* SSQ = (const float*)(p.ws + W_SSQ);
  const int* IDX = (const int*)(p.ws + W_XN);
  const float* GW = (const float*)(p.ws + W_XN + (size_t)NTOK * 128 * 4);
  const unsigned char* EU = (const unsigned char*)(p.ws + W_EU);
  const unsigned char* EV = (const unsigned char*)(p.ws + W_EV);
  const float* ESC = (const float*)(p.ws + W_ESC);
  const int b0 = lane & 1, b1 = (lane >> 1) & 1, b2 = (lane >> 2) & 1;
  const int nwv = gridDim.x * 4;
  int tok = blockIdx.x * 4 + w;
  uint4 nh0 = make_uint4(0u, 0u, 0u, 0u), nh1 = nh0;
  float nrs = 0.f, ngwA = 0.f, ngwB = 0.f;
  int niA = 0, niB = 0;
  if (tok < NTOK) {
    const uint4* hp = (const uint4*)(HG + (size_t)tok * 1024 + lane * 16);
    nh0 = hp[0]; nh1 = hp[1];
    nrs = row_rstd(SSQ, tok);
    niA = IDX[(size_t)tok * 128 + lane]; niB = IDX[(size_t)tok * 128 + 64 + lane];
    ngwA = GW[(size_t)tok * 128 + lane]; ngwB = GW[(size_t)tok * 128 + 64 + lane];
  }
#pragma unroll 1
  for (; tok < NTOK; tok += nwv) {
    const float rs = nrs;
    const int iA = niA, iB = niB;
    const float gwA = ngwA, gwB = ngwB;
    float xh[16];
    unpack8(nh0, xh);
    unpack8(nh1, xh + 8);
#pragma unroll
    for (int i = 0; i < 16; i++) xh[i] *= rs;
    {
      const int nt2 = tok + nwv;
      if (nt2 < NTOK) {
        const uint4* hp = (const uint4*)(HG + (size_t)nt2 * 1024 + lane * 16);
        nh0 = hp[0]; nh1 = hp[1];
        nrs = row_rstd(SSQ, nt2);
        niA = IDX[(size_t)nt2 * 128 + lane]; niB = IDX[(size_t)nt2 * 128 + 64 + lane];
        ngwA = GW[(size_t)nt2 * 128 + lane]; ngwB = GW[(size_t)nt2 * 128 + 64 + lane];
      }
    }
    const float gA = gwA * ESC[16384 + iA], gB = gwB * ESC[16384 + iB];
    const float suA = ESC[iA], suB = ESC[iB];
    float dA = 0.f, dB = 0.f;
#pragma unroll 2
    for (int bb = 0; bb < 16; bb++) {
      const int isrc = bb < 8 ? iA : iB;
      float d[8];
      uint4 ur[8];
#pragma unroll
      for (int k = 0; k < 8; k++) {
        const int id = __builtin_amdgcn_readlane(isrc, (bb & 7) * 8 + k);
        ur[k] = *(const uint4*)(EU + (size_t)id * 1024 + lane * 16);
      }
#pragma unroll
      for (int k = 0; k < 8; k++) {
        float uv[16];
        dec16(ur[k], uv);
        float sacc = 0.f;
#pragma unroll
        for (int i = 0; i < 16; i++) sacc += xh[i] * uv[i];
        d[k] = sacc;
      }
      float e4[4], e2[2], e1;
#pragma unroll
      for (int i = 0; i < 4; i++) {
        const float keep = b0 ? d[2 * i + 1] : d[2 * i];
        const float send = b0 ? d[2 * i] : d[2 * i + 1];
        e4[i] = keep + __shfl_xor(send, 1);
      }
#pragma unroll
      for (int i = 0; i < 2; i++) {
        const float keep = b1 ? e4[2 * i + 1] : e4[2 * i];
        const float send = b1 ? e4[2 * i] : e4[2 * i + 1];
        e2[i] = keep + __shfl_xor(send, 2);
      }
      {
        const float keep = b2 ? e2[1] : e2[0];
        const float send = b2 ? e2[0] : e2[1];
        e1 = keep + __shfl_xor(send, 4);
      }
      e1 += __shfl_xor(e1, 8);
      e1 += __shfl_xor(e1, 16);
      e1 += __shfl_xor(e1, 32);
      const bool mine = (lane >> 3) == (bb & 7);
      if (bb < 8) dA = mine ? e1 : dA; else dB = mine ? e1 : dB;
    }
    const float actA = gelu_tanh(dA * suA) * gA, actB = gelu_tanh(dB * suB) * gB;
    float* ACT = (float*)(p.ws + W_ACT);
    __hip_atomic_store(&ACT[(size_t)tok * 128 + lane], actA, __ATOMIC_RELAXED, __HIP_MEMORY_SCOPE_AGENT);
    __hip_atomic_store(&ACT[(size_t)tok * 128 + 64 + lane], actB, __ATOMIC_RELAXED, __HIP_MEMORY_SCOPE_AGENT);
    asm volatile("s_waitcnt vmcnt(0)" ::: "memory");
    if (lane == 0) __hip_atomic_fetch_add((unsigned*)(p.ws + W_CNT) + (tok >> 3), 1u, __ATOMIC_RELAXED, __HIP_MEMORY_SCOPE_AGENT);
  }
}

__device__ __forceinline__ void phase7b(KParams& p) {
  const int tid = opaque_tid(), lane = tid & 63;
  const char* IDXb = (const char*)(p.ws + W_XN);
  const char* ACTb = (const char*)(p.ws + W_ACT);
  const char* EVb = (const char*)(p.ws + W_EV);
  char* Yb = (char*)(p.out + O_Y);
  unsigned* Q = (unsigned*)(p.ws + W_Q);
  const int esub = lane >> 3, c = lane & 7;
  const int pref = (int)(hw_xcc_id() & 7u);
  const int b3 = (lane >> 3) & 1, b4 = (lane >> 4) & 1, b5 = (lane >> 5) & 1;
  const uint32_t lane4 = (uint32_t)lane * 4u;
  const uint32_t yl = (uint32_t)(c * 16 + b3 * 8 + b4 * 4 + b5 * 2) * 4u;
  for (int k = 0; k < 8; k++) {
    const int sl = (pref + k) & 7;
    const char* Vs = EVb + (size_t)sl * (16384 * 128);
    const uint32_t vl = (uint32_t)c * 16u;
    for (;;) {
      unsigned it = 0;
      if (lane == 0) it = atomicAdd(Q + sl * 64, 1u);
      it = (unsigned)__builtin_amdgcn_readfirstlane((int)it);
      if (it >= (unsigned)(NTOK / 8)) break;
      const int tok0 = (int)it * 8;
      {
        unsigned* cp = (unsigned*)(p.ws + W_CNT) + it;
        unsigned spins = 0;
        while ((unsigned)__builtin_amdgcn_readfirstlane((int)__hip_atomic_load(cp, __ATOMIC_RELAXED, __HIP_MEMORY_SCOPE_AGENT)) < 8u) {
          __builtin_amdgcn_s_sleep(2);
          if (++spins > (1u << 20)) break;
        }
      }
      const char* ib = IDXb + (size_t)tok0 * 512;
      const char* ab = ACTb + (size_t)tok0 * 512;
      char* yb = Yb + (size_t)tok0 * 4096 + sl * 512;
      int nidA = *(const int*)(ib + lane4), nidB = *(const int*)(ib + 256 + lane4);
      float nacA = __hip_atomic_load((const float*)(ab + lane4), __ATOMIC_RELAXED, __HIP_MEMORY_SCOPE_AGENT), nacB = __hip_atomic_load((const float*)(ab + 256 + lane4), __ATOMIC_RELAXED, __HIP_MEMORY_SCOPE_AGENT);
      float2 nyv = *(const float2*)(yb + yl);
#pragma unroll 1
      for (int t = 0; t < 8; t++) {
        const int idA = nidA, idB = nidB;
        const float acA = nacA, acB = nacB;
        const float2 yv = nyv;
        char* ybt = yb;
        if (t < 7) {
          ib += 512; ab += 512; yb += 4096;
          nidA = *(const int*)(ib + lane4); nidB = *(const int*)(ib + 256 + lane4);
          nacA = __hip_atomic_load((const float*)(ab + lane4), __ATOMIC_RELAXED, __HIP_MEMORY_SCOPE_AGENT); nacB = __hip_atomic_load((const float*)(ab + 256 + lane4), __ATOMIC_RELAXED, __HIP_MEMORY_SCOPE_AGENT);
          nyv = *(const float2*)(yb + yl);
        }
        float o[16];
#pragma unroll
        for (int q = 0; q < 16; q++) o[q] = 0.f;
#pragma unroll
        for (int hf = 0; hf < 2; hf++) {
          uint4 vr[8];
#pragma unroll
          for (int i = 0; i < 8; i++) {
            const uint32_t id = (uint32_t)__shfl(hf ? idB : idA, i * 8 + esub);
            vr[i] = *(const uint4*)(Vs + (id * 128u + vl));
          }
#pragma unroll
          for (int i = 0; i < 8; i++) {
            float vv[16];
            dec16(vr[i], vv);
            const float a = __shfl(hf ? acB : acA, i * 8 + esub);
#pragma unroll
            for (int q = 0; q < 16; q++) o[q] += a * vv[q];
          }
        }
        float r8[8], r4[4], r2[2];
#pragma unroll
        for (int q = 0; q < 8; q++) {
          const float keep = b3 ? o[q + 8] : o[q];
          const float send = b3 ? o[q] : o[q + 8];
          r8[q] = keep + __shfl_xor(send, 8);
        }
#pragma unroll
        for (int q = 0; q < 4; q++) {
          const float keep = b4 ? r8[q + 4] : r8[q];
          const float send = b4 ? r8[q] : r8[q + 4];
          r4[q] = keep + __shfl_xor(send, 16);
        }
#pragma unroll
        for (int q = 0; q < 2; q++) {
          const float keep = b5 ? r4[q + 2] : r4[q];
          const float send = b5 ? r4[q] : r4[q + 2];
          r2[q] = keep + __shfl_xor(send, 32);
        }
        float2 h = yv;
        h.x += r2[0];
        h.y += r2[1];
        *(float2*)(ybt + yl) = h;
      }
    }
  }
}

#define XB_TMO      128
#define XB_XCNT(j)  (256  + 64 * (j))
#define XB_XSUB(j)  (1280 + 64 * (j))
#define XB_XGEN(j)  (2304 + 64 * (j))
#define XB_TOP      3328
#define XB_TOPGEN   3392
#define XCD_BAR_WORDS 3456
#define XB_SPIN_CAP (1u << 18)
#define LAS __attribute__((address_space(3)))
__device__ __forceinline__ unsigned xb_ld(unsigned* p) { return __hip_atomic_load(p, __ATOMIC_RELAXED, __HIP_MEMORY_SCOPE_AGENT); }
__device__ __forceinline__ unsigned xb_add(unsigned* p, unsigned v) { return __hip_atomic_fetch_add(p, v, __ATOMIC_RELAXED, __HIP_MEMORY_SCOPE_AGENT); }
__device__ __forceinline__ unsigned xb_xcc_id() { return (unsigned)__builtin_amdgcn_s_getreg((3 << 11) | 20) & 0xFu; }
#define XB_SPIN(cond, bar) do { unsigned _sp = 0; while (cond) { __builtin_amdgcn_s_sleep(1); \
    if ((++_sp & 255u) == 0u) { if (xb_ld(&(bar)[XB_TMO])) break; if (_sp > XB_SPIN_CAP) { atomicAdd(&(bar)[XB_TMO], 1u); break; } } } } while (0)
struct XcdBarrier { unsigned* bar; unsigned x; volatile LAS unsigned* st; };
__device__ __forceinline__ XcdBarrier xcd_barrier_post(unsigned* bar, volatile LAS unsigned* st) {
  XcdBarrier b; b.bar = bar; b.x = xb_xcc_id(); b.st = st;
  if (threadIdx.x == 0) st[2] = xb_add(&bar[XB_XCNT(b.x)], 1u);
  return b;
}
__device__ __forceinline__ void xcd_barrier_complete(unsigned* bar, unsigned x, unsigned& nloc, unsigned& nx) {
  const unsigned G = gridDim.x * gridDim.y * gridDim.z;
  unsigned sum, cnt, mine, sp = 0u;
  for (;;) {
    sum = 0u; cnt = 0u; mine = 0u;
#pragma unroll
    for (unsigned j = 0; j < 16; ++j) { const unsigned c = xb_ld(&bar[XB_XCNT(j)]); sum += c; cnt += (c > 0u) ? 1u : 0u; mine = (j == x) ? c : mine; }
    if (sum == G) break;
    __builtin_amdgcn_s_sleep(1);
    if ((++sp & 255u) == 0u) { if (xb_ld(&bar[XB_TMO])) break; if (sp > XB_SPIN_CAP) { atomicAdd(&bar[XB_TMO], 1u); break; } }
  }
  nloc = mine > 0u ? mine : 1u; nx = cnt > 0u ? cnt : 1u;
}
__device__ __forceinline__ void xcd_barrier(const XcdBarrier& b) {
  asm volatile("s_waitcnt vmcnt(0)" ::: "memory");
  __syncthreads();
  if (threadIdx.x == 0) {
    unsigned* bar = b.bar;
    __builtin_amdgcn_s_waitcnt(0);
    unsigned nloc = b.st[0], nx = b.st[1];
    if (nloc == 0u) { xcd_barrier_complete(bar, b.x, nloc, nx); b.st[0] = nloc; b.st[1] = nx; }
    const unsigned old = xb_add(&bar[XB_XSUB(b.x)], 1u);
    const unsigned gen = old / nloc;
    if (old + 1u == (gen + 1u) * nloc) {
      __builtin_amdgcn_fence(__ATOMIC_RELEASE, "agent");
      asm volatile("s_waitcnt vmcnt(0)" ::: "memory");
      const unsigned og = xb_add(&bar[XB_TOP], 1u);
      const unsigned tg = og / nx;
      if (og + 1u == (tg + 1u) * nx) xb_add(&bar[XB_TOPGEN], 1u);
      else XB_SPIN(xb_ld(&bar[XB_TOPGEN]) == tg, bar);
      __builtin_amdgcn_fence(__ATOMIC_ACQUIRE, "agent");
      xb_add(&bar[XB_XGEN(b.x)], 1u);
      asm volatile("s_waitcnt vmcnt(0)" ::: "memory");
    } else {
      XB_SPIN(xb_ld(&bar[XB_XGEN(b.x)]) == gen, bar);
      __builtin_amdgcn_fence(__ATOMIC_ACQUIRE, "agent");
      asm volatile("s_waitcnt vmcnt(0)" ::: "memory");
    }
  }
  __syncthreads();
}

#ifndef REP_MASK
#define REP_MASK 0
#endif
#define REPS(k) for (int _rep = 0; _rep < (((REP_MASK) >> (k)) & 1) + 1; _rep++)
__global__ void __launch_bounds__(256, 2) fwd_megakernel(Params p_) {
  extern __shared__ __attribute__((aligned(16))) char smem[];
  cg::grid_group grid = cg::this_grid();
  if (p_.ws == nullptr) grid.sync();
  volatile LAS unsigned* xst = (volatile LAS unsigned*)(smem + SMEM_BYTES - 16);
  if (threadIdx.x == 0) { xst[0] = 0u; xst[1] = 0u; xst[2] = 0u; xst[3] = 0u; }
  __syncthreads();
  const XcdBarrier xb = xcd_barrier_post((unsigned*)(p_.ws + W_BAR), xst);
  REPS(0) { phase0(*fresh_params(), smem); xcd_barrier(xb); }
  if (threadIdx.x == 0) {
    unsigned* bar = (unsigned*)(p_.ws + W_BAR);
    const unsigned per = gridDim.x >> 3;
    bool uni = (gridDim.x & 7u) == 0u;
    for (unsigned j = 0; j < 16; ++j) { const unsigned cnt = xb_ld(&bar[XB_XCNT(j)]); if (cnt != (j < 8 ? per : 0u)) uni = false; }
    xst[3] = uni ? (xb.x * per + xst[2]) : blockIdx.x;
  }
  __syncthreads();
  const int vb = (int)xst[3];
  REPS(1) { phase_g1(*fresh_params(), smem, vb); xcd_barrier(xb); }
  REPS(2) {
    for (int it = blockIdx.x; it < MT * 16 + 1536; it += gridDim.x) {
      if (it < MT * 16) { const int mt = it >> 4; lru_tile(*fresh_params(), smem, mt, it & 15, mt < 128 ? 2 : 1); }
      else attn_item(*fresh_params(), smem, it - MT * 16);
    }
    xcd_barrier(xb);
  }
  REPS(4) { phase_g3(*fresh_params(), smem, vb); xcd_barrier(xb); }
  REPS(5) { phase_g4(*fresh_params(), smem, vb); xcd_barrier(xb); }
  REPS(6) { phase_g5(*fresh_params(), smem, vb); xcd_barrier(xb); }
  REPS(7) { phase_g6(*fresh_params(), smem, vb); xcd_barrier(xb); }
  phase7(*fresh_params());
  phase7b(*fresh_params());
}

extern "C" void kernel_launch(void* const* d_in, const int* in_sizes, int n_in, void* d_out, int out_size, void* d_ws,
                              size_t ws_size, hipStream_t stream) {
  static int grid_blocks = 0;
  if (!grid_blocks) {
    int dev = 0, cus = 0, per_cu = 0;
    hipGetDevice(&dev);
    hipDeviceGetAttribute(&cus, hipDeviceAttributeMultiprocessorCount, dev);
    hipFuncSetAttribute((const void*)fwd_megakernel, hipFuncAttributeMaxDynamicSharedMemorySize, SMEM_BYTES);
    hipOccupancyMaxActiveBlocksPerMultiprocessor(&per_cu, fwd_megakernel, 256, SMEM_BYTES);
    if (per_cu < 1) per_cu = 1;
    grid_blocks = cus * per_cu;
  }
  Params p{};
  const float** pp = (const float**)&p;
  for (int i = 0; i < 26; i++) pp[i] = (const float*)d_in[i];
  p.out = (float*)d_out;
  p.ws = (char*)d_ws;
  (void)hipMemsetAsync((char*)d_ws + W_BAR, 0, (size_t)3456 * 4 + 8 * 256 + 2048 * 4 + 2176 * 4, stream);
  void* args[] = {&p};
  hipError_t e = hipLaunchCooperativeKernel((void*)fwd_megakernel, dim3(grid_blocks), dim3(256), args, SMEM_BYTES, stream);
  if (e != hipSuccess) fprintf(stderr, "cooperative launch failed: %s (grid %d)\n", hipGetErrorString(e), grid_blocks);
}
```
